# Optimizing an MI355X kernel written in HIP

```python
import math
import jax
import jax.numpy as jnp
from jax import lax
import numpy as np

D_MODEL = 1024
BATCH = 2
SEQ = 8192
DEPTH = 2

GRID_W = 64
CTX_LEN = 256
EPS = 1e-6
ROPE_BASE = 10000.0
QBLK = 128

HEAD_DIM = 64
SWA_HEADS = 4
SWA_KV_HEADS = 2
WINDOW = 128

DIFF_HEADS = 4
DIFF_QK_DIM = 32
DIFF_V_DIM = 64

MLA_HEADS = 4
MLA_Q_RANK = 192
MLA_KV_RANK = 128
MLA_NOPE = 64
MLA_ROPE = 32
MLA_V = 64

GDN_HEADS = 4
GDN_DK = 64
GDN_DV = 64
GDN_CONV = 5
GDN_CHUNK = 64
GDN_QKV = 2 * GDN_HEADS * GDN_DK + GDN_HEADS * GDN_DV

N_EXPERTS = 64
N_GROUPS = 8
TOPK_GROUPS = 4
TOP_K = 6
EXPERT_FF = 256
SHARED_FF = 256
ROUTED_SCALE = 2.5
MOE_BLOCK = 128

IN_SPLITS = (
    SWA_HEADS * HEAD_DIM,
    SWA_KV_HEADS * HEAD_DIM,
    SWA_KV_HEADS * HEAD_DIM,
    DIFF_HEADS * 2 * DIFF_QK_DIM,
    DIFF_HEADS * 2 * DIFF_QK_DIM,
    DIFF_HEADS * DIFF_V_DIM,
    MLA_Q_RANK,
    MLA_KV_RANK,
    MLA_ROPE,
    GDN_QKV,
    GDN_HEADS * GDN_DV,
    GDN_HEADS,
    GDN_HEADS,
    GDN_HEADS,
    GDN_HEADS,
)
IN_WIDTH = sum(IN_SPLITS)
MIX_WIDTH = SWA_HEADS * HEAD_DIM + DIFF_HEADS * DIFF_V_DIM + MLA_HEADS * MLA_V + GDN_HEADS * GDN_DV

kernel_name = 'hybrid_parallel_heads_moe_diffusion_block'


def rmsnorm(x, g):
    xf = x.astype(jnp.float32)
    y = xf * lax.rsqrt(jnp.mean(xf * xf, axis=-1, keepdims=True) + EPS)
    return (y * g.astype(jnp.float32)).astype(x.dtype)


def l2norm(x):
    xf = x.astype(jnp.float32)
    return (xf * lax.rsqrt(jnp.sum(xf * xf, axis=-1, keepdims=True) + EPS)).astype(x.dtype)


def axial_rope(rows, dim):
    quarter = dim // 4
    inv = ROPE_BASE ** (-jnp.arange(quarter, dtype=jnp.float32) / quarter)
    r = jnp.repeat(jnp.arange(rows, dtype=jnp.float32), GRID_W)
    col = jnp.tile(jnp.arange(GRID_W, dtype=jnp.float32), rows)
    ang = jnp.concatenate([r[:, None] * inv, col[:, None] * inv], axis=-1)
    return jnp.cos(ang), jnp.sin(ang)


def apply_rope(x, cos, sin):
    half = x.shape[-1] // 2
    shape = (x.shape[1],) + (1,) * (x.ndim - 3) + (half,)
    c = cos.reshape(shape).astype(x.dtype)
    s = sin.reshape(shape).astype(x.dtype)
    x1, x2 = x[..., :half], x[..., half:]
    return jnp.concatenate([x1 * c - x2 * s, x2 * c + x1 * s], axis=-1)


def sweep_query_blocks(fn, *qs):
    B, T = qs[0].shape[:2]
    nb = T // QBLK
    blocks = tuple(jnp.moveaxis(q.reshape((B, nb, QBLK) + q.shape[2:]), 1, 0) for q in qs)
    out = lax.map(lambda args: fn(*args), blocks)
    out = jnp.moveaxis(out, 0, 1)
    return out.reshape((B, T) + out.shape[3:])


def swa_attention(q, k, v, qc, kc, vc, sinks, need_ctx):
    B, S = q.shape[:2]
    C = kc.shape[1]
    G = SWA_HEADS // SWA_KV_HEADS
    nb = S // WINDOW
    scale = HEAD_DIM ** -0.5
    sink = sinks.astype(jnp.float32).reshape(SWA_KV_HEADS, G)[:, :, None, None]

    def band(t):
        tb = jnp.pad(t, ((0, 0), (WINDOW, WINDOW), (0, 0), (0, 0))).reshape(B, nb + 2, WINDOW, SWA_KV_HEADS, HEAD_DIM)
        return jnp.concatenate([tb[:, :-2], tb[:, 1:-1], tb[:, 2:]], axis=2)

    kw, vw = band(k), band(v)
    qb = q.reshape(B, nb, WINDOW, SWA_KV_HEADS, G, HEAD_DIM)
    qpos = jnp.arange(nb)[:, None] * WINDOW + jnp.arange(WINDOW)[None, :]
    kpos = jnp.arange(nb)[:, None] * WINDOW - WINDOW + jnp.arange(3 * WINDOW)[None, :]
    kp = kpos[:, None, :]
    valid = (jnp.abs(kp - qpos[:, :, None]) <= WINDOW) & (kp >= 0) & (kp < S)
    s_loc = jnp.einsum('bnqhgd,bnkhd->bnhgqk', qb, kw).astype(jnp.float32) * scale
    s_loc = jnp.where(valid[None, :, None, None], s_loc, -jnp.inf)
    s_ctx = jnp.einsum('bnqhgd,bkhd->bnhgqk', qb, kc).astype(jnp.float32) * scale
    s_sink = jnp.broadcast_to(sink, s_loc.shape[:-1] + (1,))
    p = jax.nn.softmax(jnp.concatenate([s_loc, s_ctx, s_sink], axis=-1), axis=-1)
    L = 3 * WINDOW
    p_loc = p[..., :L].astype(v.dtype)
    p_ctx = p[..., L:L + C].astype(v.dtype)
    o = jnp.einsum('bnhgqk,bnkhd->bnqhgd', p_loc, vw) + jnp.einsum('bnhgqk,bkhd->bnqhgd', p_ctx, vc)
    y = o.reshape(B, S, SWA_HEADS * HEAD_DIM)
    yc = None
    if need_ctx:
        qcg = qc.reshape(B, C, SWA_KV_HEADS, G, HEAD_DIM)
        s = jnp.einsum('bqhgd,bkhd->bhgqk', qcg, kc).astype(jnp.float32) * scale
        s = jnp.concatenate([s, jnp.broadcast_to(sink, s.shape[:-1] + (1,))], axis=-1)
        pc = jax.nn.softmax(s, axis=-1)[..., :C].astype(vc.dtype)
        yc = jnp.einsum('bhgqk,bkhd->bqhgd', pc, vc).reshape(B, C, SWA_HEADS * HEAD_DIM)
    return y, yc


def diff_attention(q, k, v, qc, kc, vc, lam, lam_init, norm_g, need_ctx):
    scale = DIFF_QK_DIM ** -0.5

    def make(keys, vals):
        def fn(qb):
            s = jnp.einsum('bqhmd,bkhmd->bhmqk', qb, keys).astype(jnp.float32) * scale
            p = jax.nn.softmax(s, axis=-1)
            p = (p[:, :, 0] - lam * p[:, :, 1]).astype(vals.dtype)
            return jnp.einsum('bhqk,bkhd->bqhd', p, vals)
        return fn

    def finish(o):
        o = rmsnorm(o, norm_g) * (1.0 - lam_init)
        return o.reshape(o.shape[:2] + (-1,))

    y = finish(sweep_query_blocks(make(jnp.concatenate([k, kc], axis=1), jnp.concatenate([v, vc], axis=1)), q))
    yc = finish(sweep_query_blocks(make(kc, vc), qc)) if need_ctx else None
    return y, yc


def mla_attention(cq, ckv, kr, cq_c, ckv_c, kr_c, gq, gkv, w_uq, w_ukv, rope, need_ctx):
    scale = (MLA_NOPE + MLA_ROPE) ** -0.5

    def queries(cq_, rotate):
        q = (rmsnorm(cq_, gq) @ w_uq).reshape(cq_.shape[:2] + (MLA_HEADS, MLA_NOPE + MLA_ROPE))
        qr = q[..., MLA_NOPE:]
        return q[..., :MLA_NOPE], (apply_rope(qr, *rope) if rotate else qr)

    def keys_values(ckv_, kr_, rotate):
        kv = (rmsnorm(ckv_, gkv) @ w_ukv).reshape(ckv_.shape[:2] + (MLA_HEADS, MLA_NOPE + MLA_V))
        return kv[..., :MLA_NOPE], (apply_rope(kr_, *rope) if rotate else kr_), kv[..., MLA_NOPE:]

    def make(kn_, kr_, v_):
        def fn(qn_b, qr_b):
            s = jnp.einsum('bqhd,bkhd->bhqk', qn_b, kn_) + jnp.einsum('bqhr,bkr->bhqk', qr_b, kr_)
            p = jax.nn.softmax(s.astype(jnp.float32) * scale, axis=-1).astype(v_.dtype)
            return jnp.einsum('bhqk,bkhd->bqhd', p, v_)
        return fn

    kn, krl, v = keys_values(ckv, kr, True)
    kn_c, krc, v_c = keys_values(ckv_c, kr_c, False)
    qn, qr = queries(cq, True)
    y = sweep_query_blocks(make(jnp.concatenate([kn, kn_c], axis=1), jnp.concatenate([krl, krc], axis=1),
                                jnp.concatenate([v, v_c], axis=1)), qn, qr)
    y = y.reshape(y.shape[:2] + (-1,))
    yc = None
    if need_ctx:
        qn_c, qr_c = queries(cq_c, False)
        yc = sweep_query_blocks(make(kn_c, krc, v_c), qn_c, qr_c)
        yc = yc.reshape(yc.shape[:2] + (-1,))
    return y, yc


def short_conv(x, w):
    pad = GDN_CONV // 2
    y = lax.conv_general_dilated(x, w[:, None, :].astype(x.dtype), window_strides=(1,), padding=[(pad, pad)],
                                 dimension_numbers=('NWC', 'WIO', 'NWC'), feature_group_count=x.shape[-1])
    return jax.nn.silu(y)


def gated_delta_chunked(q, k, v, g, beta, state):
    B, T, H, _ = q.shape
    dv = v.shape[-1]
    n = T // GDN_CHUNK
    Cc = GDN_CHUNK

    def to_chunks(t):
        t = jnp.moveaxis(t.astype(jnp.float32), 2, 1)
        return t.reshape((B, H, n, Cc) + t.shape[3:])

    qf, kf, vf = to_chunks(q), to_chunks(k), to_chunks(v)
    gc = jnp.cumsum(to_chunks(g), axis=-1)
    bt = to_chunks(beta)
    kb = kf * bt[..., None]
    vb = vf * bt[..., None]
    tri_incl = jnp.tril(jnp.ones((Cc, Cc), bool))
    tri_strict = jnp.tril(jnp.ones((Cc, Cc), bool), -1)
    diff = gc[..., :, None] - gc[..., None, :]
    decay = jnp.where(tri_incl, jnp.exp(jnp.where(tri_incl, diff, 0.0)), 0.0)
    a_mat = jnp.where(tri_strict, jnp.einsum('bhnid,bhnjd->bhnij', kb, kf) * decay, 0.0)
    eye = jnp.eye(Cc, dtype=jnp.float32)
    tmat = lax.linalg.triangular_solve(a_mat + eye, jnp.broadcast_to(eye, a_mat.shape), left_side=True, lower=True)
    eg = jnp.exp(gc)[..., None]
    u = tmat @ vb
    w = tmat @ (kb * eg)
    attn = jnp.einsum('bhnid,bhnjd->bhnij', qf, kf) * decay
    qg = qf * eg
    glast = gc[..., -1]
    kdec = kf * jnp.exp(glast[..., None] - gc)[..., None]

    def step(S, xs):
        qg_i, w_i, u_i, at_i, kd_i, gl_i = xs
        v_new = u_i - jnp.einsum('bhcd,bhde->bhce', w_i, S)
        o = jnp.einsum('bhcd,bhde->bhce', qg_i, S) + jnp.einsum('bhij,bhje->bhie', at_i, v_new)
        S = S * jnp.exp(gl_i)[..., None, None] + jnp.einsum('bhcd,bhce->bhde', kd_i, v_new)
        return S, o

    xs = tuple(jnp.moveaxis(t, 2, 0) for t in (qg, w, u, attn, kdec, glast))
    S, o = lax.scan(step, state, xs)
    o = jnp.moveaxis(jnp.moveaxis(o, 0, 2).reshape(B, H, T, dv), 1, 2)
    return o.astype(v.dtype), S


def gdn_mixer(qkv, z, af, ab, bf, bb, qkv_c, z_c, af_c, ab_c, bf_c, bb_c,
              conv_w, a_log_f, a_log_b, dtb_f, dtb_b, norm_g, need_ctx):
    f32 = jnp.float32

    def prep(qkv_, af_, ab_, bf_, bb_):
        B, T = qkv_.shape[:2]
        hcv = short_conv(qkv_, conv_w)
        q, k, v = jnp.split(hcv, [GDN_HEADS * GDN_DK, 2 * GDN_HEADS * GDN_DK], axis=-1)
        q = l2norm(q.reshape(B, T, GDN_HEADS, GDN_DK)) * (GDN_DK ** -0.5)
        k = l2norm(k.reshape(B, T, GDN_HEADS, GDN_DK))
        v = v.reshape(B, T, GDN_HEADS, GDN_DV)
        g_f = -jnp.exp(a_log_f.astype(f32)) * jax.nn.softplus(af_.astype(f32) + dtb_f.astype(f32))
        g_b = -jnp.exp(a_log_b.astype(f32)) * jax.nn.softplus(ab_.astype(f32) + dtb_b.astype(f32))
        return q, k, v, g_f, jax.nn.sigmoid(bf_.astype(f32)), g_b, jax.nn.sigmoid(bb_.astype(f32))

    q, k, v, gf, btf, gb, btb = prep(qkv, af, ab, bf, bb)
    qc, kc, vc, gfc, btfc, gbc, btbc = prep(qkv_c, af_c, ab_c, bf_c, bb_c)
    s0 = jnp.zeros((q.shape[0], GDN_HEADS, GDN_DK, GDN_DV), f32)
    flip = lambda t: jnp.flip(t, axis=1)
    oc_f, s_cf = gated_delta_chunked(qc, kc, vc, gfc, btfc, s0)
    oc_b, s_cb = gated_delta_chunked(flip(qc), flip(kc), flip(vc), flip(gbc), flip(btbc), s0)
    o_f, _ = gated_delta_chunked(q, k, v, gf, btf, s_cf)
    o_b, _ = gated_delta_chunked(flip(q), flip(k), flip(v), flip(gb), flip(btb), s_cb)

    def gated_out(o, zz):
        B, T = zz.shape[:2]
        o = rmsnorm(o, norm_g) * jax.nn.silu(zz.reshape(B, T, GDN_HEADS, GDN_DV))
        return o.reshape(B, T, GDN_HEADS * GDN_DV)

    y = gated_out(o_f + flip(o_b), z)
    yc = gated_out(oc_f + flip(oc_b), z_c) if need_ctx else None
    return y, yc


def moe_ffn(x2, w_router, bias, w_gate, w_up, w_down, sw_gate, sw_up, sw_down):
    T, D = x2.shape
    f32 = jnp.float32
    scores = jax.nn.sigmoid(x2.astype(f32) @ w_router.astype(f32))
    choice = scores + bias.astype(f32)
    per_group = N_EXPERTS // N_GROUPS
    grp_score = lax.top_k(choice.reshape(T, N_GROUPS, per_group), 2)[0].sum(-1)
    _, top_g = lax.top_k(grp_score, TOPK_GROUPS)
    gmask = jnp.any(top_g[:, :, None] == jnp.arange(N_GROUPS)[None, None, :], axis=1)
    emask = jnp.repeat(gmask, per_group, axis=1)
    _, idx = lax.top_k(jnp.where(emask, choice, -jnp.inf), TOP_K)
    wts = jnp.take_along_axis(scores, idx, axis=-1)
    wts = wts / jnp.sum(wts, axis=-1, keepdims=True) * ROUTED_SCALE

    A = T * TOP_K
    flat_e = idx.reshape(-1)
    flat_t = jnp.repeat(jnp.arange(T, dtype=jnp.int32), TOP_K)
    flat_w = wts.reshape(-1)
    order = jnp.argsort(flat_e)
    se, st, sw = flat_e[order], flat_t[order], flat_w[order]
    counts = jnp.zeros((N_EXPERTS,), jnp.int32).at[flat_e].add(1)
    start = jnp.cumsum(counts) - counts
    padded = (counts + MOE_BLOCK - 1) // MOE_BLOCK * MOE_BLOCK
    pad_end = jnp.cumsum(padded)
    pad_start = pad_end - padded
    dest = pad_start[se] + (jnp.arange(A, dtype=jnp.int32) - start[se])
    n_blocks = -(-(A + N_EXPERTS * (MOE_BLOCK - 1)) // MOE_BLOCK)
    buf_t = jnp.full((n_blocks * MOE_BLOCK,), T, jnp.int32).at[dest].set(st)
    buf_w = jnp.zeros((n_blocks * MOE_BLOCK,), f32).at[dest].set(sw)
    blk_e = jnp.minimum(jnp.searchsorted(pad_end, jnp.arange(n_blocks, dtype=jnp.int32) * MOE_BLOCK, side='right'),
                        N_EXPERTS - 1)
    xpad = jnp.concatenate([x2, jnp.zeros((1, D), x2.dtype)], axis=0)

    def body(y, blk):
        t_idx, wb, e = blk
        xb = xpad[t_idx]
        hb = jax.nn.silu(xb @ w_gate[e]) * (xb @ w_up[e])
        yb = (hb @ w_down[e]).astype(f32) * wb[:, None]
        return y.at[t_idx].add(yb), None

    y, _ = lax.scan(body, jnp.zeros((T + 1, D), f32),
                    (buf_t.reshape(n_blocks, MOE_BLOCK), buf_w.reshape(n_blocks, MOE_BLOCK), blk_e))
    shared = (jax.nn.silu(x2 @ sw_gate) * (x2 @ sw_up)) @ sw_down
    return y[:T].astype(x2.dtype) + shared


def mix_tokens(h, hc, rope_a, rope_b, rope_c, lam_init, w_in, w_out, sinks, lq1, lk1, lq2, lk2, diff_g,
               mla_gq, mla_gkv, w_uq, w_ukv, conv_w, a_log_f, a_log_b, dtb_f, dtb_b, gdn_g, need_ctx):
    f32 = jnp.float32
    cuts = [int(i) for i in np.cumsum(IN_SPLITS)[:-1]]
    (aq, ak, av, bq, bk, bv, cq, ckv, kr, dqkv, dz, daf, dab, dbf, dbb) = jnp.split(h @ w_in, cuts, axis=-1)
    (aq_c, ak_c, av_c, bq_c, bk_c, bv_c, cq_c, ckv_c, kr_c, dqkv_c, dz_c, daf_c, dab_c, dbf_c, dbb_c) = \
        jnp.split(hc @ w_in, cuts, axis=-1)
    heads = lambda t, *hs: t.reshape(t.shape[:2] + hs)

    y_a, yc_a = swa_attention(
        apply_rope(heads(aq, SWA_HEADS, HEAD_DIM), *rope_a),
        apply_rope(heads(ak, SWA_KV_HEADS, HEAD_DIM), *rope_a),
        heads(av, SWA_KV_HEADS, HEAD_DIM),
        heads(aq_c, SWA_HEADS, HEAD_DIM), heads(ak_c, SWA_KV_HEADS, HEAD_DIM), heads(av_c, SWA_KV_HEADS, HEAD_DIM),
        sinks, need_ctx)

    lam = (jnp.exp(jnp.sum(lq1.astype(f32) * lk1.astype(f32)))
           - jnp.exp(jnp.sum(lq2.astype(f32) * lk2.astype(f32))) + lam_init)
    y_b, yc_b = diff_attention(
        apply_rope(heads(bq, DIFF_HEADS, 2, DIFF_QK_DIM), *rope_b),
        apply_rope(heads(bk, DIFF_HEADS, 2, DIFF_QK_DIM), *rope_b),
        heads(bv, DIFF_HEADS, DIFF_V_DIM),
        heads(bq_c, DIFF_HEADS, 2, DIFF_QK_DIM), heads(bk_c, DIFF_HEADS, 2, DIFF_QK_DIM),
        heads(bv_c, DIFF_HEADS, DIFF_V_DIM), lam, lam_init, diff_g, need_ctx)

    y_c, yc_c = mla_attention(cq, ckv, kr, cq_c, ckv_c, kr_c, mla_gq, mla_gkv, w_uq, w_ukv, rope_c, need_ctx)

    y_d, yc_d = gdn_mixer(dqkv, dz, daf, dab, dbf, dbb, dqkv_c, dz_c, daf_c, dab_c, dbf_c, dbb_c,
                          conv_w, a_log_f, a_log_b, dtb_f, dtb_b, gdn_g, need_ctx)

    y = jnp.concatenate([y_a, y_b, y_c, y_d], axis=-1) @ w_out
    yc = (jnp.concatenate([yc_a, yc_b, yc_c, yc_d], axis=-1) @ w_out) if need_ctx else None
    return y, yc


def setup_inputs(seed: int = 0) -> dict:
    key = jax.random.key(seed)
    keys = iter(jax.random.split(key, 48))
    f32 = jnp.float32
    L, D = DEPTH, D_MODEL

    def normal(shape, scale):
        return jax.random.normal(next(keys), shape, f32) * scale

    def gain(shape):
        return 1.0 + 0.02 * jax.random.normal(next(keys), shape, f32)

    dt = jnp.exp(jax.random.uniform(next(keys), (L, 2, GDN_HEADS), f32, math.log(1e-3), math.log(1e-1)))
    dt_bias = dt + jnp.log(-jnp.expm1(-dt))
    a_log = jnp.log(jax.random.uniform(next(keys), (L, 2, GDN_HEADS), f32, 1.0, 16.0))
    return {
        'x': normal((BATCH, SEQ, D), 1.0),
        'c': normal((BATCH, D), 1.0),
        'ctx': normal((BATCH, CTX_LEN, D), 1.0),
        'c_ctx': normal((D,), 1.0),
        'w_ada': normal((L, D, 6 * D), 0.5 * D ** -0.5),
        'b_ada': normal((L, 6 * D), 0.01),
        'norm1_g': gain((L, D)),
        'norm2_g': gain((L, D)),
        'w_in': normal((L, D, IN_WIDTH), D ** -0.5),
        'w_out': normal((L, MIX_WIDTH, D), MIX_WIDTH ** -0.5),
        'swa_sinks': normal((L, SWA_HEADS), 0.5),
        'diff_lq1': normal((L, DIFF_QK_DIM), 0.1),
        'diff_lk1': normal((L, DIFF_QK_DIM), 0.1),
        'diff_lq2': normal((L, DIFF_QK_DIM), 0.1),
        'diff_lk2': normal((L, DIFF_QK_DIM), 0.1),
        'diff_norm_g': gain((L, DIFF_V_DIM)),
        'mla_q_norm_g': gain((L, MLA_Q_RANK)),
        'mla_kv_norm_g': gain((L, MLA_KV_RANK)),
        'mla_w_uq': normal((L, MLA_Q_RANK, MLA_HEADS * (MLA_NOPE + MLA_ROPE)), MLA_Q_RANK ** -0.5),
        'mla_w_ukv': normal((L, MLA_KV_RANK, MLA_HEADS * (MLA_NOPE + MLA_V)), MLA_KV_RANK ** -0.5),
        'gdn_conv_w': normal((L, GDN_CONV, GDN_QKV), GDN_CONV ** -0.5),
        'gdn_a_log_f': a_log[:, 0],
        'gdn_a_log_b': a_log[:, 1],
        'gdn_dt_bias_f': dt_bias[:, 0],
        'gdn_dt_bias_b': dt_bias[:, 1],
        'gdn_norm_g': gain((L, GDN_DV)),
        'moe_w_router': normal((L, D, N_EXPERTS), D ** -0.5),
        'moe_bias': normal((L, N_EXPERTS), 0.01),
        'moe_w_gate': normal((L, N_EXPERTS, D, EXPERT_FF), D ** -0.5),
        'moe_w_up': normal((L, N_EXPERTS, D, EXPERT_FF), D ** -0.5),
        'moe_w_down': normal((L, N_EXPERTS, EXPERT_FF, D), EXPERT_FF ** -0.5),
        'shared_w_gate': normal((L, D, SHARED_FF), D ** -0.5),
        'shared_w_up': normal((L, D, SHARED_FF), D ** -0.5),
        'shared_w_down': normal((L, SHARED_FF, D), SHARED_FF ** -0.5),
        'final_norm_g': gain((D,)),
    }


def reference(x, c, ctx, c_ctx, w_ada, b_ada, norm1_g, norm2_g, w_in, w_out, swa_sinks,
              diff_lq1, diff_lk1, diff_lq2, diff_lk2, diff_norm_g, mla_q_norm_g, mla_kv_norm_g,
              mla_w_uq, mla_w_ukv, gdn_conv_w, gdn_a_log_f, gdn_a_log_b, gdn_dt_bias_f, gdn_dt_bias_b,
              gdn_norm_g, moe_w_router, moe_bias, moe_w_gate, moe_w_up, moe_w_down,
              shared_w_gate, shared_w_up, shared_w_down, final_norm_g):
    B, S, D = x.shape
    rows = S // GRID_W
    rope_a = axial_rope(rows, HEAD_DIM)
    rope_b = axial_rope(rows, DIFF_QK_DIM)
    rope_c = axial_rope(rows, MLA_ROPE)
    s_lat = jax.nn.silu(c)
    s_ctx = jax.nn.silu(c_ctx)
    xc = ctx
    for l in range(DEPTH):
        last = l == DEPTH - 1
        lam_init = 0.8 - 0.6 * math.exp(-0.3 * l)
        mod = (s_lat @ w_ada[l] + b_ada[l]).reshape(B, 6, 1, D)
        modc = (s_ctx @ w_ada[l] + b_ada[l]).reshape(6, D)
        h = rmsnorm(x, norm1_g[l]) * (1.0 + mod[:, 1]) + mod[:, 0]
        hc = rmsnorm(xc, norm1_g[l]) * (1.0 + modc[1]) + modc[0]
        y, yc = mix_tokens(h, hc, rope_a, rope_b, rope_c, lam_init, w_in[l], w_out[l], swa_sinks[l],
                           diff_lq1[l], diff_lk1[l], diff_lq2[l], diff_lk2[l], diff_norm_g[l],
                           mla_q_norm_g[l], mla_kv_norm_g[l], mla_w_uq[l], mla_w_ukv[l],
                           gdn_conv_w[l], gdn_a_log_f[l], gdn_a_log_b[l], gdn_dt_bias_f[l], gdn_dt_bias_b[l],
                           gdn_norm_g[l], not last)
        x = x + mod[:, 2] * y
        h = rmsnorm(x, norm2_g[l]) * (1.0 + mod[:, 4]) + mod[:, 3]
        moe_args = (moe_w_router[l], moe_bias[l], moe_w_gate[l], moe_w_up[l], moe_w_down[l],
                    shared_w_gate[l], shared_w_up[l], shared_w_down[l])
        if last:
            f = moe_ffn(h.reshape(B * S, D), *moe_args).reshape(B, S, D)
        else:
            xc = xc + modc[2] * yc
            hc = rmsnorm(xc, norm2_g[l]) * (1.0 + modc[4]) + modc[3]
            f_all = moe_ffn(jnp.concatenate([h.reshape(B * S, D), hc.reshape(-1, D)], axis=0), *moe_args)
            f = f_all[:B * S].reshape(B, S, D)
            xc = xc + modc[5] * f_all[B * S:].reshape(xc.shape)
        x = x + mod[:, 5] * f
    return rmsnorm(x, final_norm_g)
```

```cpp
#include <hip/hip_runtime.h>
#include <hip/hip_cooperative_groups.h>
#include <cstdio>
#include <cstdint>
namespace cg = cooperative_groups;

#define DEVI __device__ __forceinline__
typedef unsigned short u16;
using bf16x8 = __attribute__((ext_vector_type(8))) short;
using f32x4  = __attribute__((ext_vector_type(4))) float;
using f32x16 = __attribute__((ext_vector_type(16))) float;
using u32x4 = __attribute__((ext_vector_type(4))) unsigned;
using u32x2 = __attribute__((ext_vector_type(2))) unsigned;

constexpr int DM = 1024, SEQ = 8192, CTXL = 256, NKEY = SEQ + CTXL;
constexpr int TL = 2 * SEQ, TC = 2 * CTXL, T = TL + TC;
constexpr int LDP = 2688, INW = 2672;
constexpr int C_AQ = 0, C_AK = 256, C_AV = 384, C_BQ = 512, C_BK = 768, C_BV = 1024, C_CQ = 1280, C_CKV = 1472,
              C_KR = 1600, C_DQKV = 1632, C_DZ = 2400, C_GATE = 2656;
constexpr int NE = 64, NSLOT = 6 * T;
constexpr int NCHUNK = T / 64;
constexpr int NGITEM = NCHUNK * 8;

constexpr size_t al256(size_t x) { return (x + 255) & ~(size_t)255; }
constexpr size_t O_MOD   = 0;
constexpr size_t O_XA    = O_MOD + al256((size_t)2 * 3 * 6144 * 4);
constexpr size_t O_H     = O_XA + (size_t)T * DM * 4;
constexpr size_t O_Y     = O_H + (size_t)T * DM * 2;
constexpr size_t O_WINT  = O_Y + (size_t)T * DM * 2;
constexpr size_t O_WOUTT = O_WINT + (size_t)LDP * 1024 * 2;
constexpr size_t O_WUQT  = O_WOUTT + (size_t)1024 * 1024 * 2;
constexpr size_t O_WUKVT = O_WUQT + (size_t)384 * 192 * 2;
constexpr size_t O_WGUT  = O_WUKVT + (size_t)512 * 128 * 2;
constexpr size_t O_WDT   = O_WGUT + (size_t)65 * 512 * 1024 * 2;
constexpr size_t O_WTS   = O_WDT + (size_t)65 * 1024 * 256 * 2;
constexpr size_t O_CNT   = O_WTS + al256((size_t)NSLOT * 4);
constexpr size_t O_TST   = O_CNT + 256;
constexpr size_t O_LIST  = O_TST + 512;
constexpr size_t O_R     = O_LIST + (size_t)NE * T * 4;
constexpr size_t O_P     = O_R;
constexpr size_t O_R2    = O_P + (size_t)T * LDP * 2;
constexpr size_t O_CQN   = O_R2;
constexpr size_t O_CKVN  = O_CQN + (size_t)T * 192 * 2;
constexpr size_t O_MLAQ  = O_CKVN + (size_t)T * 128 * 2;
constexpr size_t O_MLAKV = O_MLAQ + (size_t)T * 384 * 2;
constexpr size_t O_QA    = O_MLAKV + (size_t)T * 512 * 2;
constexpr size_t O_KA    = O_QA + (size_t)2 * 4 * NKEY * 64 * 2;
constexpr size_t O_VTA   = O_KA + (size_t)2 * 2 * NKEY * 64 * 2;
constexpr size_t O_QB    = O_VTA + (size_t)2 * 2 * NKEY * 64 * 2;
constexpr size_t O_KB    = O_QB + (size_t)2 * 8 * NKEY * 32 * 2;
constexpr size_t O_VTB   = O_KB + (size_t)2 * 8 * NKEY * 32 * 2;
constexpr size_t O_QC    = O_VTB + (size_t)2 * 4 * NKEY * 64 * 2;
constexpr size_t O_KC    = O_QC + (size_t)2 * 4 * NKEY * 96 * 2;
constexpr size_t O_VTC   = O_KC + (size_t)2 * 4 * NKEY * 96 * 2;
constexpr size_t O_ATT_END = O_VTC + (size_t)2 * 4 * NKEY * 64 * 2;
constexpr size_t O_GQ    = O_R2;
constexpr size_t O_GK    = O_GQ + (size_t)T * 256 * 4;
constexpr size_t O_GV    = O_GK + (size_t)T * 256 * 4;
constexpr size_t O_GG    = O_GV + (size_t)T * 256 * 4;
constexpr size_t O_GBETA = O_GG + (size_t)2 * T * 4 * 4;
constexpr size_t O_GM    = O_GBETA + (size_t)2 * T * 4 * 4;
constexpr size_t O_GQP   = O_GM + (size_t)NGITEM * 4096 * 2;
constexpr size_t O_GN    = O_GQP + (size_t)NGITEM * 4096 * 2;
constexpr size_t O_GO    = O_GN + (size_t)NGITEM * 4096 * 4;
constexpr size_t O_GDN_END = O_GO + (size_t)2 * T * 256 * 4;
constexpr size_t O_HB    = O_R;
constexpr size_t O_SLOT  = O_HB + (size_t)7 * T * 256 * 2;
constexpr size_t O_MOE_END = O_SLOT + (size_t)NSLOT * 1024 * 2;
constexpr size_t cmax(size_t a, size_t b) { return a > b ? a : b; }
constexpr size_t WS_NEED = cmax(cmax(O_ATT_END, O_GDN_END), O_MOE_END);
static_assert(WS_NEED < (size_t)536000000, "workspace too large");

struct Params {
  const float* in[35];
  float* out;
  char* ws;
};
enum { I_X = 0, I_C, I_CTX, I_CCTX, I_WADA, I_BADA, I_N1G, I_N2G, I_WIN, I_WOUT, I_SINK, I_LQ1, I_LK1, I_LQ2, I_LK2,
       I_DNG, I_MQG, I_MKVG, I_WUQ, I_WUKV, I_CONVW, I_ALF, I_ALB, I_DTF, I_DTB, I_GNG, I_WR, I_RB, I_WG, I_WU, I_WD,
       I_SG, I_SU, I_SD, I_FNG };

DEVI u16 f2bf(float f) { unsigned u = __float_as_uint(f); u += 0x7fffu + ((u >> 16) & 1u); return (u16)(u >> 16); }
DEVI float bf2f(u16 h) { return __uint_as_float(((unsigned)h) << 16); }
DEVI unsigned pack2(float a, float b) { return (unsigned)f2bf(a) | ((unsigned)f2bf(b) << 16); }
DEVI float wave_sum(float v) {
#pragma unroll
  for (int o = 32; o >= 1; o >>= 1) v += __shfl_xor(v, o);
  return v;
}
DEVI float siluf(float x) { return x / (1.f + __expf(-x)); }
DEVI float sigmf(float x) { return 1.f / (1.f + __expf(-x)); }
DEVI int tok_mv(int t) { return t < TL ? (t >> 13) : 2; }
DEVI int tok_b(int t) { return t < TL ? (t >> 13) : ((t - TL) >> 8); }
DEVI int tok_row(int t) { return t < TL ? (t & (SEQ - 1)) : (SEQ + ((t - TL) & (CTXL - 1))); }
DEVI const float* modp(const Params& p, int l, int mv, int j) { return (const float*)(p.ws + O_MOD) + ((size_t)(l * 3 + mv) * 6 + j) * 1024; }

#define MFMA16(a, b, c) __builtin_amdgcn_mfma_f32_16x16x32_bf16((a), (b), (c), 0, 0, 0)
#define MFMA32(a, b, c) __builtin_amdgcn_mfma_f32_32x32x16_bf16((a), (b), (c), 0, 0, 0)

DEVI void st_copy_in(const Params& p, int vb, int nvb) {
  float4* xa = (float4*)(p.ws + O_XA);
  const float4* x = (const float4*)p.in[I_X];
  const float4* cx = (const float4*)p.in[I_CTX];
  const size_t n4 = (size_t)T * DM / 4, nl4 = (size_t)TL * DM / 4;
  for (size_t i = (size_t)vb * 256 + threadIdx.x; i < n4; i += (size_t)nvb * 256) xa[i] = i < nl4 ? x[i] : cx[i - nl4];
}

DEVI void st_mod(const Params& p, int vb, int nvb, char* smem) {
  float* sv = (float*)smem;
  float* red = sv + 3 * 1024;
  for (int i = threadIdx.x; i < 3 * 1024; i += 256) {
    int v = i >> 10, k = i & 1023;
    float c = v < 2 ? p.in[I_C][v * 1024 + k] : p.in[I_CCTX][k];
    sv[i] = siluf(c);
  }
  __syncthreads();
  const int cx = threadIdx.x & 63, kg = threadIdx.x >> 6;
  for (int item = vb; item < 2 * 96; item += nvb) {
    const int l = item / 96, col = (item % 96) * 64 + cx;
    const float* w = p.in[I_WADA] + (size_t)l * 1024 * 6144 + col;
    float a0 = 0.f, a1 = 0.f, a2 = 0.f;
    for (int k = kg * 256; k < kg * 256 + 256; ++k) {
      float wv = w[(size_t)k * 6144];
      a0 += sv[k] * wv; a1 += sv[1024 + k] * wv; a2 += sv[2048 + k] * wv;
    }
    red[(kg * 64 + cx) * 3 + 0] = a0; red[(kg * 64 + cx) * 3 + 1] = a1; red[(kg * 64 + cx) * 3 + 2] = a2;
    __syncthreads();
    if (threadIdx.x < 192) {
      int v = threadIdx.x >> 6, c2 = threadIdx.x & 63;
      float s = 0.f;
      for (int g = 0; g < 4; ++g) s += red[(g * 64 + c2) * 3 + v];
      int colo = (item % 96) * 64 + c2;
      ((float*)(p.ws + O_MOD))[(size_t)(l * 3 + v) * 6144 + colo] = s + p.in[I_BADA][l * 6144 + colo];
    }
    __syncthreads();
  }
}

DEVI void tr_tile(const float* __restrict__ src, int N, u16* __restrict__ dst, int ldd, int rs, int ro, int k0, int n0, float* tile) {
  const int tx = threadIdx.x & 63, ty = threadIdx.x >> 6;
#pragma unroll 4
  for (int r = 0; r < 16; ++r) {
    int k = r * 4 + ty, n = n0 + tx;
    tile[k * 65 + tx] = n < N ? src[(size_t)(k0 + k) * N + n] : 0.f;
  }
  __syncthreads();
#pragma unroll 4
  for (int r = 0; r < 16; ++r) {
    int n = r * 4 + ty;
    dst[(size_t)((n0 + n) * rs + ro) * ldd + k0 + tx] = f2bf(tile[tx * 65 + n]);
  }
  __syncthreads();
}
constexpr int TR_IN = 16 * 42, TR_OUT = 256, TR_UQ = 18, TR_UKV = 16, TR_E = 4096, TR_S = 64;
constexpr int TR_TOTAL = TR_IN + TR_OUT + TR_UQ + TR_UKV + 3 * TR_E + 3 * TR_S;
DEVI void st_prep_w(const Params& p, int l, int vb, int nvb, char* smem) {
  float* tile = (float*)smem;
  if (vb == 0 && threadIdx.x < 64) ((int*)(p.ws + O_CNT))[threadIdx.x] = 0;
  for (int item = vb; item < TR_TOTAL; item += nvb) {
    int it = item;
    if (it < TR_IN) { tr_tile(p.in[I_WIN] + (size_t)l * 1024 * INW, INW, (u16*)(p.ws + O_WINT), 1024, 1, 0, (it / 42) * 64, (it % 42) * 64, tile); continue; }
    it -= TR_IN;
    if (it < TR_OUT) { tr_tile(p.in[I_WOUT] + (size_t)l * 1024 * 1024, 1024, (u16*)(p.ws + O_WOUTT), 1024, 1, 0, (it / 16) * 64, (it % 16) * 64, tile); continue; }
    it -= TR_OUT;
    if (it < TR_UQ) { tr_tile(p.in[I_WUQ] + (size_t)l * 192 * 384, 384, (u16*)(p.ws + O_WUQT), 192, 1, 0, (it / 6) * 64, (it % 6) * 64, tile); continue; }
    it -= TR_UQ;
    if (it < TR_UKV) { tr_tile(p.in[I_WUKV] + (size_t)l * 128 * 512, 512, (u16*)(p.ws + O_WUKVT), 128, 1, 0, (it / 8) * 64, (it % 8) * 64, tile); continue; }
    it -= TR_UKV;
    if (it < 2 * TR_E) {
      int which = it / TR_E; it %= TR_E;
      int e = it >> 6, tt = it & 63;
      const float* src = p.in[which ? I_WU : I_WG] + ((size_t)l * NE + e) * 1024 * 256;
      tr_tile(src, 256, (u16*)(p.ws + O_WGUT) + (size_t)e * 512 * 1024, 1024, 2, which, (tt >> 2) * 64, (tt & 3) * 64, tile); continue;
    }
    it -= 2 * TR_E;
    if (it < TR_E) {
      int e = it >> 6, tt = it & 63;
      const float* src = p.in[I_WD] + ((size_t)l * NE + e) * 256 * 1024;
      tr_tile(src, 1024, (u16*)(p.ws + O_WDT) + (size_t)e * 1024 * 256, 256, 1, 0, (tt >> 4) * 64, (tt & 15) * 64, tile); continue;
    }
    it -= TR_E;
    if (it < 2 * TR_S) {
      int which = it / TR_S; int tt = it % TR_S;
      const float* src = p.in[which ? I_SU : I_SG] + (size_t)l * 1024 * 256;
      tr_tile(src, 256, (u16*)(p.ws + O_WGUT) + (size_t)64 * 512 * 1024, 1024, 2, which, (tt >> 2) * 64, (tt & 3) * 64, tile); continue;
    }
    it -= 2 * TR_S;
    { int tt = it;
      const float* src = p.in[I_SD] + (size_t)l * 256 * 1024;
      tr_tile(src, 1024, (u16*)(p.ws + O_WDT) + (size_t)64 * 1024 * 256, 256, 1, 0, (tt >> 4) * 64, (tt & 15) * 64, tile); }
  }
}

DEVI void st_norm1(const Params& p, int l, int vb, int nvb) {
  const int lane = threadIdx.x & 63, wid = threadIdx.x >> 6;
  const float* g = p.in[I_N1G] + l * 1024;
  for (int t = vb * 4 + wid; t < T; t += nvb * 4) {
    const int mv = tok_mv(t);
    const float* sh = modp(p, l, mv, 0); const float* sc = modp(p, l, mv, 1);
    const float4* xr = (const float4*)((const float*)(p.ws + O_XA) + (size_t)t * 1024);
    float4 v[4]; float ss = 0.f;
#pragma unroll
    for (int i = 0; i < 4; ++i) { v[i] = xr[i * 64 + lane]; ss += v[i].x * v[i].x + v[i].y * v[i].y + v[i].z * v[i].z + v[i].w * v[i].w; }
    ss = wave_sum(ss);
    const float rstd = rsqrtf(ss * (1.f / 1024.f) + 1e-6f);
    u16* hr = (u16*)(p.ws + O_H) + (size_t)t * 1024;
#pragma unroll
    for (int i = 0; i < 4; ++i) {
      int c = i * 256 + lane * 4;
      float4 gg = *(const float4*)(g + c), s4 = *(const float4*)(sc + c), h4 = *(const float4*)(sh + c);
      float o0 = v[i].x * rstd * gg.x * (1.f + s4.x) + h4.x, o1 = v[i].y * rstd * gg.y * (1.f + s4.y) + h4.y;
      float o2 = v[i].z * rstd * gg.z * (1.f + s4.z) + h4.z, o3 = v[i].w * rstd * gg.w * (1.f + s4.w) + h4.w;
      u32x2 pk; pk[0] = pack2(o0, o1); pk[1] = pack2(o2, o3);
      *(u32x2*)(hr + c) = pk;
    }
  }
}

constexpr int GLD = 72;
template <class ARow, class Epi>
DEVI void gemm128(ARow arow, const u16* __restrict__ Bt, int ldb, int K, Epi epi, char* smem) {
  u16* sA = (u16*)smem; u16* sB = sA + 128 * GLD;
  const int tid = threadIdx.x, lane = tid & 63, wid = tid >> 6, wr = wid >> 1, wc = wid & 1, fr = lane & 15, fq = lane >> 4;
  const u16* ap[4]; const u16* bp[4];
#pragma unroll
  for (int i = 0; i < 4; ++i) { int q = tid + 256 * i, row = q >> 3, cc = q & 7; ap[i] = arow(row) + cc * 8; bp[i] = Bt + (size_t)row * ldb + cc * 8; }
  u32x4 ra[4], rb[4];
#pragma unroll
  for (int i = 0; i < 4; ++i) { ra[i] = *(const u32x4*)ap[i]; rb[i] = *(const u32x4*)bp[i]; }
  f32x4 acc[4][4];
#pragma unroll
  for (int m = 0; m < 4; ++m)
#pragma unroll
    for (int n = 0; n < 4; ++n) acc[m][n] = f32x4{0.f, 0.f, 0.f, 0.f};
  const int nk = K >> 6;
  for (int kt = 0; kt < nk; ++kt) {
    __syncthreads();
#pragma unroll
    for (int i = 0; i < 4; ++i) { int q = tid + 256 * i, row = q >> 3, cc = q & 7; *(u32x4*)&sA[row * GLD + cc * 8] = ra[i]; *(u32x4*)&sB[row * GLD + cc * 8] = rb[i]; }
    __syncthreads();
    if (kt + 1 < nk) {
#pragma unroll
      for (int i = 0; i < 4; ++i) { ra[i] = *(const u32x4*)(ap[i] + (kt + 1) * 64); rb[i] = *(const u32x4*)(bp[i] + (kt + 1) * 64); }
    }
#pragma unroll
    for (int ks = 0; ks < 2; ++ks) {
      bf16x8 af[4], bfr[4];
#pragma unroll
      for (int m = 0; m < 4; ++m) af[m] = *(const bf16x8*)&sA[(wr * 64 + m * 16 + fr) * GLD + ks * 32 + fq * 8];
#pragma unroll
      for (int n = 0; n < 4; ++n) bfr[n] = *(const bf16x8*)&sB[(wc * 64 + n * 16 + fr) * GLD + ks * 32 + fq * 8];
#pragma unroll
      for (int m = 0; m < 4; ++m)
#pragma unroll
        for (int n = 0; n < 4; ++n) acc[m][n] = MFMA16(bfr[n], af[m], acc[m][n]);
    }
  }
#pragma unroll
  for (int m = 0; m < 4; ++m)
#pragma unroll
    for (int n = 0; n < 4; ++n) epi(wr * 64 + m * 16 + fr, wc * 64 + n * 16 + fq * 4, acc[m][n]);
  __syncthreads();
}

DEVI void st_inproj(const Params& p, int vb, int nvb, char* smem) {
  const u16* H = (const u16*)(p.ws + O_H); const u16* W = (const u16*)(p.ws + O_WINT); u16* P = (u16*)(p.ws + O_P);
  for (int item = vb; item < 132 * 21; item += nvb) {
    const int m0 = (item / 21) * 128, n0 = (item % 21) * 128;
    gemm128([&](int r) { return H + (size_t)(m0 + r) * 1024; }, W + (size_t)n0 * 1024, 1024, 1024,
            [&](int r, int c, f32x4 v) { u32x2 pk; pk[0] = pack2(v[0], v[1]); pk[1] = pack2(v[2], v[3]); *(u32x2*)(P + (size_t)(m0 + r) * LDP + n0 + c) = pk; }, smem);
  }
}

DEVI void rope_cs(int i, int half, int s, float& c, float& sn) {
  const int quarter = half >> 1;
  const int ii = i < quarter ? i : i - quarter;
  const float pos = i < quarter ? (float)(s >> 6) : (float)(s & 63);
  const float inv = powf(10000.f, -(float)ii / (float)quarter);
  const float ang = pos * inv;
  c = cosf(ang); sn = sinf(ang);
}
DEVI void st_scatter(const Params& p, int l, int vb, int nvb) {
  const int lane = threadIdx.x & 63, wid = threadIdx.x >> 6;
  const u16* P = (const u16*)(p.ws + O_P);
  u16* QA = (u16*)(p.ws + O_QA); u16* KA = (u16*)(p.ws + O_KA); u16* VTA = (u16*)(p.ws + O_VTA);
  u16* QB = (u16*)(p.ws + O_QB); u16* KB = (u16*)(p.ws + O_KB); u16* VTB = (u16*)(p.ws + O_VTB);
  u16* KC = (u16*)(p.ws + O_KC);
  u16* CQN = (u16*)(p.ws + O_CQN); u16* CKVN = (u16*)(p.ws + O_CKVN);
  for (int t = vb * 4 + wid; t < T; t += nvb * 4) {
    const u16* pr = P + (size_t)t * LDP;
    const int b = tok_b(t), row = tok_row(t); const bool lat = t < TL; const int s = t & (SEQ - 1);
    {
      const int i = lane & 31;
      float c = 1.f, sn = 0.f; if (lat) rope_cs(i, 32, s, c, sn);
#pragma unroll
      for (int r = 0; r < 3; ++r) {
        const int hh = r * 2 + (lane >> 5);
        const int cb = hh < 4 ? C_AQ + hh * 64 : C_AK + (hh - 4) * 64;
        float x1 = bf2f(pr[cb + i]), x2 = bf2f(pr[cb + 32 + i]);
        float y1 = x1 * c - x2 * sn, y2 = x2 * c + x1 * sn;
        u16* dst = hh < 4 ? QA + ((size_t)(b * 4 + hh) * NKEY + row) * 64 : KA + ((size_t)(b * 2 + (hh - 4)) * NKEY + row) * 64;
        dst[i] = f2bf(y1); dst[32 + i] = f2bf(y2);
      }
#pragma unroll
      for (int r = 0; r < 2; ++r) VTA[((size_t)(b * 2 + r) * 64 + lane) * NKEY + row] = pr[C_AV + r * 64 + lane];
    }
    {
      const int i = lane & 15;
      float c = 1.f, sn = 0.f; if (lat) rope_cs(i, 16, s, c, sn);
#pragma unroll
      for (int r = 0; r < 4; ++r) {
        const int hm = r * 4 + (lane >> 4);
        const int cb = hm < 8 ? C_BQ + hm * 32 : C_BK + (hm - 8) * 32;
        float x1 = bf2f(pr[cb + i]), x2 = bf2f(pr[cb + 16 + i]);
        float y1 = x1 * c - x2 * sn, y2 = x2 * c + x1 * sn;
        u16* dst = hm < 8 ? QB + ((size_t)(b * 8 + hm) * NKEY + row) * 32 : KB + ((size_t)(b * 8 + (hm - 8)) * NKEY + row) * 32;
        dst[i] = f2bf(y1); dst[16 + i] = f2bf(y2);
      }
#pragma unroll
      for (int r = 0; r < 4; ++r) VTB[((size_t)(b * 4 + r) * 64 + lane) * NKEY + row] = pr[C_BV + r * 64 + lane];
      if (lane < 16) {
        float x1 = bf2f(pr[C_KR + i]), x2 = bf2f(pr[C_KR + 16 + i]);
        u16 y1 = f2bf(x1 * c - x2 * sn), y2 = f2bf(x2 * c + x1 * sn);
#pragma unroll
        for (int h = 0; h < 4; ++h) { u16* dst = KC + ((size_t)(b * 4 + h) * NKEY + row) * 96 + 64; dst[i] = y1; dst[16 + i] = y2; }
      }
    }
    {
      float q0 = bf2f(pr[C_CQ + lane]), q1 = bf2f(pr[C_CQ + 64 + lane]), q2 = bf2f(pr[C_CQ + 128 + lane]);
      float ss = wave_sum(q0 * q0 + q1 * q1 + q2 * q2);
      float rs = rsqrtf(ss * (1.f / 192.f) + 1e-6f);
      const float* g = p.in[I_MQG] + l * 192;
      u16* d = CQN + (size_t)t * 192;
      d[lane] = f2bf(q0 * rs * g[lane]); d[64 + lane] = f2bf(q1 * rs * g[64 + lane]); d[128 + lane] = f2bf(q2 * rs * g[128 + lane]);
      float k0 = bf2f(pr[C_CKV + lane]), k1 = bf2f(pr[C_CKV + 64 + lane]);
      float s2 = wave_sum(k0 * k0 + k1 * k1);
      float r2 = rsqrtf(s2 * (1.f / 128.f) + 1e-6f);
      const float* g2 = p.in[I_MKVG] + l * 128;
      u16* d2 = CKVN + (size_t)t * 128;
      d2[lane] = f2bf(k0 * r2 * g2[lane]); d2[64 + lane] = f2bf(k1 * r2 * g2[64 + lane]);
    }
  }
}

DEVI void st_mla_up(const Params& p, int vb, int nvb, char* smem) {
  const u16* CQN = (const u16*)(p.ws + O_CQN); const u16* CKVN = (const u16*)(p.ws + O_CKVN);
  u16* MQ = (u16*)(p.ws + O_MLAQ); u16* MKV = (u16*)(p.ws + O_MLAKV);
  for (int item = vb; item < 132 * 7; item += nvb) {
    const int m0 = (item / 7) * 128, nn = item % 7;
    if (nn < 3) {
      const int n0 = nn * 128;
      gemm128([&](int r) { return CQN + (size_t)(m0 + r) * 192; }, (const u16*)(p.ws + O_WUQT) + (size_t)n0 * 192, 192, 192,
              [&](int r, int c, f32x4 v) { u32x2 pk; pk[0] = pack2(v[0], v[1]); pk[1] = pack2(v[2], v[3]); *(u32x2*)(MQ + (size_t)(m0 + r) * 384 + n0 + c) = pk; }, smem);
    } else {
      const int n0 = (nn - 3) * 128;
      gemm128([&](int r) { return CKVN + (size_t)(m0 + r) * 128; }, (const u16*)(p.ws + O_WUKVT) + (size_t)n0 * 128, 128, 128,
              [&](int r, int c, f32x4 v) { u32x2 pk; pk[0] = pack2(v[0], v[1]); pk[1] = pack2(v[2], v[3]); *(u32x2*)(MKV + (size_t)(m0 + r) * 512 + n0 + c) = pk; }, smem);
    }
  }
}
DEVI void st_mla_scatter(const Params& p, int vb, int nvb) {
  const int lane = threadIdx.x & 63, wid = threadIdx.x >> 6;
  const u16* MQ = (const u16*)(p.ws + O_MLAQ); const u16* MKV = (const u16*)(p.ws + O_MLAKV);
  u16* QC = (u16*)(p.ws + O_QC); u16* KC = (u16*)(p.ws + O_KC); u16* VTC = (u16*)(p.ws + O_VTC);
  for (int t = vb * 4 + wid; t < T; t += nvb * 4) {
    const int b = tok_b(t), row = tok_row(t); const bool lat = t < TL; const int s = t & (SEQ - 1);
    const u16* q = MQ + (size_t)t * 384; const u16* kv = MKV + (size_t)t * 512;
    const int i = lane & 15;
    float c = 1.f, sn = 0.f; if (lat) rope_cs(i, 16, s, c, sn);
#pragma unroll
    for (int h = 0; h < 4; ++h) {
      u16* qd = QC + ((size_t)(b * 4 + h) * NKEY + row) * 96;
      qd[lane] = q[h * 96 + lane];
      if (lane < 16) {
        float x1 = bf2f(q[h * 96 + 64 + i]), x2 = bf2f(q[h * 96 + 80 + i]);
        qd[64 + i] = f2bf(x1 * c - x2 * sn); qd[80 + i] = f2bf(x2 * c + x1 * sn);
      }
      KC[((size_t)(b * 4 + h) * NKEY + row) * 96 + lane] = kv[h * 128 + lane];
      VTC[((size_t)(b * 4 + h) * 64 + lane) * NKEY + row] = kv[h * 128 + 64 + lane];
    }
  }
}

template <int DQK>
DEVI void attn_run(const u16* __restrict__ Qp, int qrow0, const u16* __restrict__ Kp, const u16* __restrict__ Vtp,
                   int a0, int a1, int b0, int b1, bool winB, int qpos0, float c2, float sink2,
                   f32x16 (&O)[2], char* smem) {
  constexpr int KLD = DQK + 8, NS = DQK / 16;
  u16* sK = (u16*)smem; u16* sV = sK + 64 * KLD;
  const int tid = threadIdx.x, lane = tid & 63, wid = tid >> 6, r31 = lane & 31, hh = lane >> 5;
  const int qrow = qrow0 + wid * 32 + r31;
  bf16x8 qf[NS];
#pragma unroll
  for (int s = 0; s < NS; ++s) qf[s] = *(const bf16x8*)(Qp + (size_t)qrow * DQK + s * 16 + hh * 8);
#pragma unroll
  for (int i = 0; i < 16; ++i) { O[0][i] = 0.f; O[1][i] = 0.f; }
  float m = -30000.f, lsum = 0.f;
  const int na = (a1 - a0) >> 6, nb = (b1 - b0) >> 6;
  const int qpos = qpos0 + wid * 32 + r31;
  for (int ti = 0; ti < na + nb; ++ti) {
    const bool inB = ti >= na;
    const int key0 = inB ? b0 + (ti - na) * 64 : a0 + ti * 64;
    __syncthreads();
    for (int q = tid; q < 64 * (DQK / 8); q += 256) {
      int r = q / (DQK / 8), cc = q % (DQK / 8);
      *(u32x4*)&sK[r * KLD + cc * 8] = *(const u32x4*)(Kp + (size_t)(key0 + r) * DQK + cc * 8);
    }
#pragma unroll
    for (int i = 0; i < 2; ++i) {
      int q = tid + 256 * i, r = q >> 3, cc = q & 7;
      *(u32x4*)&sV[r * 72 + cc * 8] = *(const u32x4*)(Vtp + (size_t)r * NKEY + key0 + cc * 8);
    }
    __syncthreads();
    f32x16 st[2];
#pragma unroll
    for (int k2 = 0; k2 < 2; ++k2) {
#pragma unroll
      for (int i = 0; i < 16; ++i) st[k2][i] = 0.f;
#pragma unroll
      for (int s = 0; s < NS; ++s) {
        bf16x8 kf = *(const bf16x8*)&sK[(k2 * 32 + r31) * KLD + s * 16 + hh * 8];
        st[k2] = MFMA32(kf, qf[s], st[k2]);
      }
    }
    const bool msk = winB && inB;
    float mx = -1e30f;
#pragma unroll
    for (int k2 = 0; k2 < 2; ++k2)
#pragma unroll
      for (int g = 0; g < 16; ++g) {
        float v = st[k2][g] * c2;
        if (msk) { int kp = key0 + k2 * 32 + (g & 3) + 8 * (g >> 2) + 4 * hh; int d = kp - qpos; if (d > 128 || d < -128) v = -1e30f; }
        st[k2][g] = v; mx = fmaxf(mx, v);
      }
    mx = fmaxf(mx, __shfl_xor(mx, 32));
    const float mn = fmaxf(m, mx);
    const float alpha = __builtin_amdgcn_exp2f(m - mn);
    m = mn;
    float ps = 0.f;
#pragma unroll
    for (int k2 = 0; k2 < 2; ++k2)
#pragma unroll
      for (int g = 0; g < 16; ++g) { float pv = __builtin_amdgcn_exp2f(st[k2][g] - mn); st[k2][g] = pv; ps += pv; }
    lsum = lsum * alpha + ps;
#pragma unroll
    for (int i = 0; i < 16; ++i) { O[0][i] *= alpha; O[1][i] *= alpha; }
#pragma unroll
    for (int k2 = 0; k2 < 2; ++k2)
#pragma unroll
      for (int s2 = 0; s2 < 2; ++s2) {
        bf16x8 pf;
#pragma unroll
        for (int j = 0; j < 8; ++j) pf[j] = (short)f2bf(st[k2][8 * s2 + j]);
#pragma unroll
        for (int dvt = 0; dvt < 2; ++dvt) {
          const u16* vp = &sV[(dvt * 32 + r31) * 72 + k2 * 32 + s2 * 16 + 4 * hh];
          u32x2 lo = *(const u32x2*)vp, hi = *(const u32x2*)(vp + 8);
          u32x4 vv; vv[0] = lo[0]; vv[1] = lo[1]; vv[2] = hi[0]; vv[3] = hi[1];
          bf16x8 vf = __builtin_bit_cast(bf16x8, vv);
          O[dvt] = MFMA32(vf, pf, O[dvt]);
        }
      }
  }
  if (sink2 > -1e29f) {
    const float mn = fmaxf(m, sink2);
    const float alpha = __builtin_amdgcn_exp2f(m - mn);
    lsum = lsum * alpha + (hh == 0 ? __builtin_amdgcn_exp2f(sink2 - mn) : 0.f);
#pragma unroll
    for (int i = 0; i < 16; ++i) { O[0][i] *= alpha; O[1][i] *= alpha; }
  }
  const float ltot = lsum + __shfl_xor(lsum, 32);
  const float inv = 1.f / ltot;
#pragma unroll
  for (int i = 0; i < 16; ++i) { O[0][i] *= inv; O[1][i] *= inv; }
  __syncthreads();
}
DEVI void attn_store(const f32x16 (&O)[2], u16* Y, int b, int qrow0, int col0) {
  const int lane = threadIdx.x & 63, wid = threadIdx.x >> 6, r31 = lane & 31, hh = lane >> 5;
  const int qrow = qrow0 + wid * 32 + r31;
  const int t = qrow < SEQ ? b * SEQ + qrow : TL + b * CTXL + (qrow - SEQ);
  u16* yr = Y + (size_t)t * 1024 + col0;
#pragma unroll
  for (int dvt = 0; dvt < 2; ++dvt)
#pragma unroll
    for (int g4 = 0; g4 < 4; ++g4) {
      u32x2 pk; pk[0] = pack2(O[dvt][g4 * 4 + 0], O[dvt][g4 * 4 + 1]); pk[1] = pack2(O[dvt][g4 * 4 + 2], O[dvt][g4 * 4 + 3]);
      *(u32x2*)(yr + dvt * 32 + 8 * g4 + 4 * hh) = pk;
    }
}
constexpr float LOG2E = 1.4426950408889634f;
DEVI void st_attn(const Params& p, int l, int vb, int nvb, char* smem) {
  u16* Y = (u16*)(p.ws + O_Y);
  const int lane = threadIdx.x & 63;
  const float lam_init = 0.8f - 0.6f * expf(-0.3f * (float)l);
  float d1 = lane < 32 ? p.in[I_LQ1][l * 32 + lane] * p.in[I_LK1][l * 32 + lane] : 0.f;
  float d2 = lane < 32 ? p.in[I_LQ2][l * 32 + lane] * p.in[I_LK2][l * 32 + lane] : 0.f;
  const float lam = expf(wave_sum(d1)) - expf(wave_sum(d2)) + lam_init;
  for (int item = vb; item < 3 * 528; item += nvb) {
    const int mixer = item / 528, rem = item % 528;
    const int b = rem / 264, h = (rem / 66) & 3, qb = rem % 66;
    const bool lat = qb < 64;
    const int qrow0 = qb * 128;
    f32x16 O[2];
    if (mixer == 0) {
      const float c2 = rsqrtf(96.f) * LOG2E;
      attn_run<96>((const u16*)(p.ws + O_QC) + (size_t)(b * 4 + h) * NKEY * 96, qrow0, (const u16*)(p.ws + O_KC) + (size_t)(b * 4 + h) * NKEY * 96,
                   (const u16*)(p.ws + O_VTC) + (size_t)(b * 4 + h) * 64 * NKEY, lat ? 0 : SEQ, NKEY, 0, 0, false, 0, c2, -1e30f, O, smem);
      attn_store(O, Y, b, qrow0, 512 + h * 64);
    } else if (mixer == 1) {
      const float c2 = rsqrtf(32.f) * LOG2E;
      f32x16 O1[2];
      attn_run<32>((const u16*)(p.ws + O_QB) + (size_t)(b * 8 + h * 2) * NKEY * 32, qrow0, (const u16*)(p.ws + O_KB) + (size_t)(b * 8 + h * 2) * NKEY * 32,
                   (const u16*)(p.ws + O_VTB) + (size_t)(b * 4 + h) * 64 * NKEY, lat ? 0 : SEQ, NKEY, 0, 0, false, 0, c2, -1e30f, O, smem);
      attn_run<32>((const u16*)(p.ws + O_QB) + (size_t)(b * 8 + h * 2 + 1) * NKEY * 32, qrow0, (const u16*)(p.ws + O_KB) + (size_t)(b * 8 + h * 2 + 1) * NKEY * 32,
                   (const u16*)(p.ws + O_VTB) + (size_t)(b * 4 + h) * 64 * NKEY, lat ? 0 : SEQ, NKEY, 0, 0, false, 0, c2, -1e30f, O1, smem);
      const int hh = lane >> 5;
      float ss = 0.f;
#pragma unroll
      for (int dvt = 0; dvt < 2; ++dvt)
#pragma unroll
        for (int g = 0; g < 16; ++g) { float o = O[dvt][g] - lam * O1[dvt][g]; O[dvt][g] = o; ss += o * o; }
      ss += __shfl_xor(ss, 32);
      const float rs = rsqrtf(ss * (1.f / 64.f) + 1e-6f) * (1.f - lam_init);
      const float* dg = p.in[I_DNG] + l * 64;
#pragma unroll
      for (int dvt = 0; dvt < 2; ++dvt)
#pragma unroll
        for (int g = 0; g < 16; ++g) O[dvt][g] *= rs * dg[dvt * 32 + (g & 3) + 8 * (g >> 2) + 4 * hh];
      attn_store(O, Y, b, qrow0, 256 + h * 64);
    } else {
      const float c2 = 0.125f * LOG2E;
      const float sink2 = p.in[I_SINK][l * 4 + h] * LOG2E;
      const int hk = h >> 1;
      int b0 = 0, b1 = 0;
      if (lat) { b0 = (qb - 1) * 128; if (b0 < 0) b0 = 0; b1 = (qb + 2) * 128; if (b1 > SEQ) b1 = SEQ; }
      attn_run<64>((const u16*)(p.ws + O_QA) + (size_t)(b * 4 + h) * NKEY * 64, qrow0, (const u16*)(p.ws + O_KA) + (size_t)(b * 2 + hk) * NKEY * 64,
                   (const u16*)(p.ws + O_VTA) + (size_t)(b * 2 + hk) * 64 * NKEY, SEQ, NKEY, b0, b1, true, qrow0, c2, sink2, O, smem);
      attn_store(O, Y, b, qrow0, h * 64);
    }
  }
}

DEVI void st_gdn_prep(const Params& p, int l, int vb, int nvb) {
  const int lane = threadIdx.x & 63, wid = threadIdx.x >> 6;
  const u16* P = (const u16*)(p.ws + O_P);
  float* GQ = (float*)(p.ws + O_GQ); float* GK = (float*)(p.ws + O_GK); float* GV = (float*)(p.ws + O_GV);
  float* GG = (float*)(p.ws + O_GG); float* GB = (float*)(p.ws + O_GBETA);
  const float* cw = p.in[I_CONVW] + (size_t)l * 5 * 768;
  for (int t = vb * 4 + wid; t < T; t += nvb * 4) {
    int base, pos, len;
    if (t < TL) { base = t & ~(SEQ - 1); pos = t & (SEQ - 1); len = SEQ; } else { int j = t - TL; base = TL + (j & ~(CTXL - 1)); pos = j & (CTXL - 1); len = CTXL; }
#pragma unroll
    for (int i = 0; i < 12; ++i) {
      const int c = lane + 64 * i;
      float acc = 0.f;
#pragma unroll
      for (int j = 0; j < 5; ++j) {
        int pp = pos + j - 2;
        if (pp >= 0 && pp < len) acc += cw[j * 768 + c] * bf2f(P[(size_t)(base + pp) * LDP + C_DQKV + c]);
      }
      float y = siluf(acc);
      if (i < 8) {
        float ss = wave_sum(y * y);
        float r = rsqrtf(ss + 1e-6f);
        if (i < 4) GQ[(size_t)t * 256 + i * 64 + lane] = y * r * 0.125f;
        else GK[(size_t)t * 256 + (i - 4) * 64 + lane] = y * r;
      } else GV[(size_t)t * 256 + (i - 8) * 64 + lane] = y;
    }
    if (lane < 16) {
      const int which = lane >> 2, hd = lane & 3;
      const float val = bf2f(P[(size_t)t * LDP + C_GATE + lane]);
      if (which < 2) {
        const float al = which ? p.in[I_ALB][l * 4 + hd] : p.in[I_ALF][l * 4 + hd];
        const float dt = which ? p.in[I_DTB][l * 4 + hd] : p.in[I_DTF][l * 4 + hd];
        const float xx = val + dt;
        const float sp = fmaxf(xx, 0.f) + log1pf(expf(-fabsf(xx)));
        GG[((size_t)which * T + t) * 4 + hd] = -expf(al) * sp;
      } else GB[((size_t)(which - 2) * T + t) * 4 + hd] = sigmf(val);
    }
  }
}

DEVI int gdn_chunk_t0(int ci) { return ci < 256 ? (ci >> 7) * SEQ + (ci & 127) * 64 : TL + ((ci - 256) >> 2) * CTXL + ((ci - 256) & 3) * 64; }

DEVI void st_gdn_chunk(const Params& p, int vb, int nvb, char* smem) {
  float* R1 = (float*)smem;
  float* sk = R1; float* sq = R1 + 64 * 65; float* X = R1;
  float* sA = R1 + 2 * 64 * 65;
  float* sAt = sA + 64 * 65;
  float* sgc = sAt + 64 * 65; float* sbeta = sgc + 64;
  const float* GQ = (const float*)(p.ws + O_GQ); const float* GK = (const float*)(p.ws + O_GK); const float* GV = (const float*)(p.ws + O_GV);
  const float* GG = (const float*)(p.ws + O_GG); const float* GB = (const float*)(p.ws + O_GBETA);
  u16* GM = (u16*)(p.ws + O_GM); u16* GQP = (u16*)(p.ws + O_GQP); float* GN = (float*)(p.ws + O_GN); float* GO = (float*)(p.ws + O_GO);
  const int tid = threadIdx.x, lane = tid & 63;
  for (int item = vb; item < NGITEM; item += nvb) {
    const int ci = item >> 3, hd = (item >> 1) & 3, dir = item & 1;
    const int t0 = gdn_chunk_t0(ci);
    auto tok = [&](int i) { return dir ? t0 + 63 - i : t0 + i; };
    if (tid < 64) {
      float g = GG[((size_t)dir * T + tok(tid)) * 4 + hd];
#pragma unroll
      for (int o = 1; o < 64; o <<= 1) { float u = __shfl_up(g, o); if (lane >= o) g += u; }
      sgc[tid] = g; sbeta[tid] = GB[((size_t)dir * T + tok(tid)) * 4 + hd];
    }
    for (int e = tid; e < 4096; e += 256) {
      int i = e >> 6, d = e & 63; size_t a = (size_t)tok(i) * 256 + hd * 64 + d;
      sk[i * 65 + d] = GK[a]; sq[i * 65 + d] = GQ[a];
    }
    __syncthreads();
    const float glast = sgc[63];
    for (int r = 0; r < 16; ++r) {
      const int i = r * 4 + (tid >> 6), j = lane;
      float kk = 0.f, qk = 0.f;
#pragma unroll 8
      for (int d = 0; d < 64; ++d) { float kj = sk[j * 65 + d]; kk += sk[i * 65 + d] * kj; qk += sq[i * 65 + d] * kj; }
      const float dec = i >= j ? expf(sgc[i] - sgc[j]) : 0.f;
      sA[i * 65 + j] = i > j ? sbeta[i] * kk * dec : 0.f;
      sAt[i * 65 + j] = i >= j ? qk * dec : 0.f;
    }
    __syncthreads();
    for (int e = tid; e < 64 * 128; e += 256) {
      int i = e >> 7, c = e & 127; size_t a = (size_t)tok(i) * 256 + hd * 64 + (c & 63);
      X[i * 129 + c] = c < 64 ? GV[a] * sbeta[i] : GK[a] * sbeta[i] * expf(sgc[i]);
    }
    __syncthreads();
    if (tid < 128) {
      for (int i = 1; i < 64; ++i) {
        float acc = X[i * 129 + tid];
        for (int j = 0; j < i; ++j) acc -= sA[i * 65 + j] * X[j * 129 + tid];
        X[i * 129 + tid] = acc;
      }
    }
    __syncthreads();
    for (int e = tid; e < 4096; e += 256) {
      int j = e >> 6, d = e & 63;
      sA[j * 65 + d] = GK[(size_t)tok(j) * 256 + hd * 64 + d] * expf(glast - sgc[j]);
    }
    __syncthreads();
    const float eglast = expf(glast);
    for (int r = 0; r < 16; ++r) {
      const int a = r * 4 + (tid >> 6), bc = lane;
      float lo = 0.f, qw = 0.f, nn = 0.f, mm = 0.f;
#pragma unroll 8
      for (int j = 0; j < 64; ++j) {
        const float at = sAt[a * 65 + j], kd = sA[j * 65 + a], xu = X[j * 129 + bc], xw = X[j * 129 + 64 + bc];
        lo += at * xu; qw += at * xw; nn += kd * xu; mm += kd * xw;
      }
      const size_t ta = (size_t)tok(a) * 256 + hd * 64 + bc;
      GO[(size_t)dir * T * 256 + ta] = lo;
      GQP[(size_t)item * 4096 + a * 64 + bc] = f2bf(GQ[ta] * expf(sgc[a]) - qw);
      GN[(size_t)item * 4096 + a * 64 + bc] = nn;
      GM[(size_t)item * 4096 + a * 64 + bc] = f2bf((a == bc ? eglast : 0.f) - mm);
    }
    __syncthreads();
  }
}

DEVI void st_gdn_scan(const Params& p, int vb, int nvb, char* smem) {
  const int lane = threadIdx.x & 63, wid = threadIdx.x >> 6;
  float* sS = (float*)smem + wid * 64 * 64;
  const u16* GM = (const u16*)(p.ws + O_GM); const u16* GQP = (const u16*)(p.ws + O_GQP); const float* GN = (const float*)(p.ws + O_GN);
  float* GO = (float*)(p.ws + O_GO);
  for (int chain = vb * 4 + wid; chain < 16; chain += nvb * 4) {
    const int b = chain >> 3, hd = (chain >> 1) & 3, dir = chain & 1;
    float S[64];
#pragma unroll
    for (int d = 0; d < 64; ++d) S[d] = 0.f;
    for (int n = 0; n < 132; ++n) {
      int ci;
      if (n < 4) ci = 256 + b * 4 + (dir ? 3 - n : n);
      else ci = b * 128 + (dir ? 127 - (n - 4) : (n - 4));
      const int item = ci * 8 + hd * 2 + dir;
      const int t0 = gdn_chunk_t0(ci);
      const u16* qp = GQP + (size_t)item * 4096; const u16* mp = GM + (size_t)item * 4096; const float* np = GN + (size_t)item * 4096;
      for (int i = 0; i < 64; ++i) {
        float acc = 0.f;
#pragma unroll
        for (int d = 0; d < 64; ++d) acc += bf2f(qp[i * 64 + d]) * S[d];
        const int t = dir ? t0 + 63 - i : t0 + i;
        GO[(size_t)dir * T * 256 + (size_t)t * 256 + hd * 64 + lane] += acc;
      }
      for (int d = 0; d < 64; ++d) {
        float acc = np[d * 64 + lane];
#pragma unroll
        for (int e = 0; e < 64; ++e) acc += bf2f(mp[d * 64 + e]) * S[e];
        sS[d * 64 + lane] = acc;
      }
#pragma unroll
      for (int d = 0; d < 64; ++d) S[d] = sS[d * 64 + lane];
    }
  }
}

DEVI void st_gdn_out(const Params& p, int l, int vb, int nvb) {
  const int lane = threadIdx.x & 63, wid = threadIdx.x >> 6;
  const float* GO = (const float*)(p.ws + O_GO); const u16* P = (const u16*)(p.ws + O_P); u16* Y = (u16*)(p.ws + O_Y);
  const float g = p.in[I_GNG][l * 64 + lane];
  for (int t = vb * 4 + wid; t < T; t += nvb * 4) {
#pragma unroll
    for (int hd = 0; hd < 4; ++hd) {
      float o = GO[(size_t)t * 256 + hd * 64 + lane] + GO[(size_t)T * 256 + (size_t)t * 256 + hd * 64 + lane];
      float ss = wave_sum(o * o);
      float z = bf2f(P[(size_t)t * LDP + C_DZ + hd * 64 + lane]);
      Y[(size_t)t * 1024 + 768 + hd * 64 + lane] = f2bf(o * rsqrtf(ss * (1.f / 64.f) + 1e-6f) * g * siluf(z));
    }
  }
}

DEVI void st_outproj(const Params& p, int l, int vb, int nvb, char* smem) {
  const u16* Y = (const u16*)(p.ws + O_Y); const u16* W = (const u16*)(p.ws + O_WOUTT); float* XA = (float*)(p.ws + O_XA);
  for (int item = vb; item < 132 * 8; item += nvb) {
    const int m0 = (item >> 3) * 128, n0 = (item & 7) * 128;
    gemm128([&](int r) { return Y + (size_t)(m0 + r) * 1024; }, W + (size_t)n0 * 1024, 1024, 1024,
            [&](int r, int c, f32x4 v) {
              const int t = m0 + r; const float* gt = modp(p, l, tok_mv(t), 2) + n0 + c;
              float4* xp = (float4*)(XA + (size_t)t * 1024 + n0 + c); float4 x = *xp;
              x.x += gt[0] * v[0]; x.y += gt[1] * v[1]; x.z += gt[2] * v[2]; x.w += gt[3] * v[3]; *xp = x;
            }, smem);
  }
}

DEVI void st_norm2_route(const Params& p, int l, int vb, int nvb, char* smem) {
  const int lane = threadIdx.x & 63, wid = threadIdx.x >> 6;
  float* shh = (float*)smem + wid * 1024;
  const float* g = p.in[I_N2G] + l * 1024;
  const float* wr = p.in[I_WR] + (size_t)l * 1024 * 64;
  const float bias = p.in[I_RB][l * 64 + lane];
  float* WTS = (float*)(p.ws + O_WTS); int* CNT = (int*)(p.ws + O_CNT); int* LIST = (int*)(p.ws + O_LIST);
  for (int t = vb * 4 + wid; t < T; t += nvb * 4) {
    const int mv = tok_mv(t);
    const float* sh = modp(p, l, mv, 3); const float* sc = modp(p, l, mv, 4);
    const float4* xr = (const float4*)((const float*)(p.ws + O_XA) + (size_t)t * 1024);
    float4 v[4]; float ss = 0.f;
#pragma unroll
    for (int i = 0; i < 4; ++i) { v[i] = xr[i * 64 + lane]; ss += v[i].x * v[i].x + v[i].y * v[i].y + v[i].z * v[i].z + v[i].w * v[i].w; }
    ss = wave_sum(ss);
    const float rstd = rsqrtf(ss * (1.f / 1024.f) + 1e-6f);
    u16* hr = (u16*)(p.ws + O_H) + (size_t)t * 1024;
    __syncthreads();
#pragma unroll
    for (int i = 0; i < 4; ++i) {
      int c = i * 256 + lane * 4;
      float4 gg = *(const float4*)(g + c), s4 = *(const float4*)(sc + c), h4 = *(const float4*)(sh + c);
      float4 o;
      o.x = v[i].x * rstd * gg.x * (1.f + s4.x) + h4.x; o.y = v[i].y * rstd * gg.y * (1.f + s4.y) + h4.y;
      o.z = v[i].z * rstd * gg.z * (1.f + s4.z) + h4.z; o.w = v[i].w * rstd * gg.w * (1.f + s4.w) + h4.w;
      u32x2 pk; pk[0] = pack2(o.x, o.y); pk[1] = pack2(o.z, o.w);
      *(u32x2*)(hr + c) = pk;
      *(float4*)(shh + c) = o;
    }
    __syncthreads();
    float logit = 0.f;
#pragma unroll 8
    for (int k = 0; k < 1024; ++k) logit += shh[k] * wr[k * 64 + lane];
    const float s = 1.f / (1.f + expf(-logit));
    const float c = s + bias;
    float m1 = c;
    m1 = fmaxf(m1, __shfl_xor(m1, 1)); m1 = fmaxf(m1, __shfl_xor(m1, 2)); m1 = fmaxf(m1, __shfl_xor(m1, 4));
    const unsigned long long bal = __ballot(c == m1);
    const int grp = lane >> 3;
    const unsigned gm = (unsigned)((bal >> (grp * 8)) & 0xffull);
    const int first = __ffs(gm) - 1;
    float m2 = ((lane & 7) == first) ? -INFINITY : c;
    m2 = fmaxf(m2, __shfl_xor(m2, 1)); m2 = fmaxf(m2, __shfl_xor(m2, 2)); m2 = fmaxf(m2, __shfl_xor(m2, 4));
    const float gs = m1 + m2;
    int grank = 0;
#pragma unroll
    for (int gg = 0; gg < 8; ++gg) { float o = __shfl(gs, gg * 8); grank += (o > gs || (o == gs && gg < grp)) ? 1 : 0; }
    const bool gsel = grank < 4;
    const float mc = gsel ? c : -INFINITY;
    int rank = 0;
#pragma unroll
    for (int e = 0; e < 64; ++e) { float o = __shfl(mc, e); rank += (o > mc || (o == mc && e < lane)) ? 1 : 0; }
    const bool sel = gsel && rank < 6;
    const float ssum = wave_sum(sel ? s : 0.f);
    if (sel) {
      const int slot = t * 6 + rank;
      WTS[slot] = s / ssum * 2.5f;
      const int pos = atomicAdd(&CNT[lane], 1);
      LIST[(size_t)lane * T + pos] = slot;
    }
  }
}
DEVI void st_tiles(const Params& p) {
  if (blockIdx.x == 0 && threadIdx.x == 0) {
    const int* CNT = (const int*)(p.ws + O_CNT); int* TST = (int*)(p.ws + O_TST);
    int acc = 0;
    for (int e = 0; e < 64; ++e) { TST[e] = acc; acc += (CNT[e] + 127) >> 7; }
    TST[64] = acc; TST[65] = acc + T / 128;
  }
}

DEVI int find_expert(const int* TST, int tile) { int e = 0; while (e < 64 && tile >= TST[e + 1]) ++e; return e; }
DEVI void st_moe1(const Params& p, int vb, int nvb, char* smem) {
  const int* TST = (const int*)(p.ws + O_TST); const int* CNT = (const int*)(p.ws + O_CNT); const int* LIST = (const int*)(p.ws + O_LIST);
  const u16* H = (const u16*)(p.ws + O_H); u16* HB = (u16*)(p.ws + O_HB);
  int* sslot = (int*)(smem + 2 * 128 * GLD * 2);
  const int total = TST[65];
  for (int item = vb; item < total * 4; item += nvb) {
    const int tile = item >> 2, n0 = (item & 3) * 128;
    const int e = find_expert(TST, tile);
    const int lt = tile - TST[e];
    const int cnt = e < 64 ? CNT[e] : T;
    __syncthreads();
    if (threadIdx.x < 128) {
      int i = lt * 128 + threadIdx.x;
      int slot = -1;
      if (i < cnt) slot = e < 64 ? LIST[(size_t)e * T + i] : NSLOT + i;
      sslot[threadIdx.x] = slot;
    }
    __syncthreads();
    gemm128([&](int r) { int sl = sslot[r]; int tk = sl < 0 ? 0 : (sl < NSLOT ? sl / 6 : sl - NSLOT); return H + (size_t)tk * 1024; },
            (const u16*)(p.ws + O_WGUT) + ((size_t)e * 512 + n0) * 1024, 1024, 1024,
            [&](int r, int c, f32x4 v) {
              int sl = sslot[r]; if (sl < 0) return;
              float h0 = siluf(v[0]) * v[1], h1 = siluf(v[2]) * v[3];
              *(unsigned*)(HB + (size_t)sl * 256 + ((n0 + c) >> 1)) = pack2(h0, h1);
            }, smem);
  }
}
DEVI void st_moe2(const Params& p, int vb, int nvb, char* smem) {
  const int* TST = (const int*)(p.ws + O_TST); const int* CNT = (const int*)(p.ws + O_CNT); const int* LIST = (const int*)(p.ws + O_LIST);
  const u16* HB = (const u16*)(p.ws + O_HB); u16* SO = (u16*)(p.ws + O_SLOT); const float* WTS = (const float*)(p.ws + O_WTS);
  int* sslot = (int*)(smem + 2 * 128 * GLD * 2);
  const int total = TST[64];
  for (int item = vb; item < total * 8; item += nvb) {
    const int tile = item >> 3, n0 = (item & 7) * 128;
    const int e = find_expert(TST, tile);
    const int lt = tile - TST[e];
    const int cnt = CNT[e];
    __syncthreads();
    if (threadIdx.x < 128) { int i = lt * 128 + threadIdx.x; sslot[threadIdx.x] = i < cnt ? LIST[(size_t)e * T + i] : -1; }
    __syncthreads();
    gemm128([&](int r) { int sl = sslot[r]; return HB + (size_t)(sl < 0 ? 0 : sl) * 256; },
            (const u16*)(p.ws + O_WDT) + ((size_t)e * 1024 + n0) * 256, 256, 256,
            [&](int r, int c, f32x4 v) {
              int sl = sslot[r]; if (sl < 0) return;
              const float w = WTS[sl];
              u32x2 pk; pk[0] = pack2(v[0] * w, v[1] * w); pk[1] = pack2(v[2] * w, v[3] * w);
              *(u32x2*)(SO + (size_t)sl * 1024 + n0 + c) = pk;
            }, smem);
  }
}
DEVI void st_moe3(const Params& p, int l, int vb, int nvb, char* smem) {
  const u16* HB = (const u16*)(p.ws + O_HB); const u16* SO = (const u16*)(p.ws + O_SLOT); float* XA = (float*)(p.ws + O_XA);
  for (int item = vb; item < 132 * 8; item += nvb) {
    const int m0 = (item >> 3) * 128, n0 = (item & 7) * 128;
    gemm128([&](int r) { return HB + (size_t)(NSLOT + m0 + r) * 256; }, (const u16*)(p.ws + O_WDT) + ((size_t)64 * 1024 + n0) * 256, 256, 256,
            [&](int r, int c, f32x4 v) {
              const int t = m0 + r; const float* gt = modp(p, l, tok_mv(t), 5) + n0 + c;
              float a0 = 0.f, a1 = 0.f, a2 = 0.f, a3 = 0.f;
#pragma unroll
              for (int k = 0; k < 6; ++k) {
                u32x2 pk = *(const u32x2*)(SO + (size_t)(t * 6 + k) * 1024 + n0 + c);
                a0 += bf2f((u16)(pk[0] & 0xffff)); a1 += bf2f((u16)(pk[0] >> 16)); a2 += bf2f((u16)(pk[1] & 0xffff)); a3 += bf2f((u16)(pk[1] >> 16));
              }
              float4* xp = (float4*)(XA + (size_t)t * 1024 + n0 + c); float4 x = *xp;
              x.x += gt[0] * (a0 + v[0]); x.y += gt[1] * (a1 + v[1]); x.z += gt[2] * (a2 + v[2]); x.w += gt[3] * (a3 + v[3]); *xp = x;
              __builtin_amdgcn_sched_barrier(0);
            }, smem);
  }
}

DEVI void st_final(const Params& p, int vb, int nvb) {
  const int lane = threadIdx.x & 63, wid = threadIdx.x >> 6;
  const float* g = p.in[I_FNG];
  for (int t = vb * 4 + wid; t < TL; t += nvb * 4) {
    const float4* xr = (const float4*)((const float*)(p.ws + O_XA) + (size_t)t * 1024);
    float4 v[4]; float ss = 0.f;
#pragma unroll
    for (int i = 0; i < 4; ++i) { v[i] = xr[i * 64 + lane]; ss += v[i].x * v[i].x + v[i].y * v[i].y + v[i].z * v[i].z + v[i].w * v[i].w; }
    ss = wave_sum(ss);
    const float rstd = rsqrtf(ss * (1.f / 1024.f) + 1e-6f);
    float4* o = (float4*)(p.out + (size_t)t * 1024);
#pragma unroll
    for (int i = 0; i < 4; ++i) {
      float4 gg = *(const float4*)(g + i * 256 + lane * 4);
      float4 r; r.x = v[i].x * rstd * gg.x; r.y = v[i].y * rstd * gg.y; r.z = v[i].z * rstd * gg.z; r.w = v[i].w * rstd * gg.w;
      o[i * 64 + lane] = r;
    }
  }
}

enum { S_COPY = 0, S_MOD, S_PREPW, S_NORM1, S_INPROJ, S_SCATTER, S_MLAUP, S_MLASC, S_ATTN, S_GPREP, S_GCHUNK, S_GSCAN, S_GOUT,
       S_OUTPROJ, S_ROUTE, S_TILES, S_MOE1, S_MOE2, S_MOE3, S_FINAL };
constexpr int SMEM_BYTES = 80 * 1024;

template <int STAGE>
__global__ void __launch_bounds__(256, 2) k_stage(Params p, int l) {
  extern __shared__ __attribute__((aligned(16))) char smem[];
  const int vb = blockIdx.x, nvb = gridDim.x;
  if constexpr (STAGE == S_COPY) st_copy_in(p, vb, nvb);
  else if constexpr (STAGE == S_MOD) st_mod(p, vb, nvb, smem);
  else if constexpr (STAGE == S_PREPW) st_prep_w(p, l, vb, nvb, smem);
  else if constexpr (STAGE == S_NORM1) st_norm1(p, l, vb, nvb);
  else if constexpr (STAGE == S_INPROJ) st_inproj(p, vb, nvb, smem);
  else if constexpr (STAGE == S_SCATTER) st_scatter(p, l, vb, nvb);
  else if constexpr (STAGE == S_MLAUP) st_mla_up(p, vb, nvb, smem);
  else if constexpr (STAGE == S_MLASC) st_mla_scatter(p, vb, nvb);
  else if constexpr (STAGE == S_ATTN) st_attn(p, l, vb, nvb, smem);
  else if constexpr (STAGE == S_GPREP) st_gdn_prep(p, l, vb, nvb);
  else if constexpr (STAGE == S_GCHUNK) st_gdn_chunk(p, vb, nvb, smem);
  else if constexpr (STAGE == S_GSCAN) st_gdn_scan(p, vb, nvb, smem);
  else if constexpr (STAGE == S_GOUT) st_gdn_out(p, l, vb, nvb);
  else if constexpr (STAGE == S_OUTPROJ) st_outproj(p, l, vb, nvb, smem);
  else if constexpr (STAGE == S_ROUTE) st_norm2_route(p, l, vb, nvb, smem);
  else if constexpr (STAGE == S_TILES) st_tiles(p);
  else if constexpr (STAGE == S_MOE1) st_moe1(p, vb, nvb, smem);
  else if constexpr (STAGE == S_MOE2) st_moe2(p, vb, nvb, smem);
  else if constexpr (STAGE == S_MOE3) st_moe3(p, l, vb, nvb, smem);
  else if constexpr (STAGE == S_FINAL) st_final(p, vb, nvb);
}

template <int STAGE>
static void launch(const Params& p, int l, int grid, hipStream_t stream) {
  static bool attr = false;
  if (!attr) { (void)hipFuncSetAttribute((const void*)k_stage<STAGE>, hipFuncAttributeMaxDynamicSharedMemorySize, SMEM_BYTES); attr = true; }
  hipLaunchKernelGGL(k_stage<STAGE>, dim3(grid), dim3(256), SMEM_BYTES, stream, p, l);
}

extern "C" void kernel_launch(void* const* d_in, const int* in_sizes, int n_in, void* d_out, int out_size, void* d_ws, size_t ws_size,
                              hipStream_t stream) {
  Params p{};
  for (int i = 0; i < 35; ++i) p.in[i] = (const float*)d_in[i];
  p.out = (float*)d_out; p.ws = (char*)d_ws;
  if (ws_size < WS_NEED) { fprintf(stderr, "workspace too small: %zu < %zu\n", ws_size, (size_t)WS_NEED); return; }
  const int G = 512;
  launch<S_COPY>(p, 0, G, stream);
  launch<S_MOD>(p, 0, 192, stream);
  for (int l = 0; l < 2; ++l) {
    launch<S_PREPW>(p, l, 1024, stream);
    launch<S_NORM1>(p, l, G, stream);
    launch<S_INPROJ>(p, l, G, stream);
    launch<S_SCATTER>(p, l, G, stream);
    launch<S_MLAUP>(p, l, G, stream);
    launch<S_MLASC>(p, l, G, stream);
    launch<S_ATTN>(p, l, G, stream);
    launch<S_GPREP>(p, l, G, stream);
    launch<S_GCHUNK>(p, l, G, stream);
    launch<S_GSCAN>(p, l, 16, stream);
    launch<S_GOUT>(p, l, G, stream);
    launch<S_OUTPROJ>(p, l, G, stream);
    launch<S_ROUTE>(p, l, G, stream);
    launch<S_TILES>(p, l, 1, stream);
    launch<S_MOE1>(p, l, G, stream);
    launch<S_MOE2>(p, l, G, stream);
    launch<S_MOE3>(p, l, G, stream);
  }
  launch<S_FINAL>(p, 0, G, stream);
}
```

```cpp
#include <hip/hip_runtime.h>
#include <hip/hip_cooperative_groups.h>
#include <cstdio>
#include <cstdint>
namespace cg = cooperative_groups;

#define DEVI __device__ __forceinline__
typedef unsigned short u16;
using bf16x8 = __attribute__((ext_vector_type(8))) short;
using f32x4  = __attribute__((ext_vector_type(4))) float;
using f32x16 = __attribute__((ext_vector_type(16))) float;
using u32x4 = __attribute__((ext_vector_type(4))) unsigned;
using u32x2 = __attribute__((ext_vector_type(2))) unsigned;

constexpr int DM = 1024, SEQ = 8192, CTXL = 256, NKEY = SEQ + CTXL;
constexpr int TL = 2 * SEQ, TC = 2 * CTXL, T = TL + TC;
constexpr int LDP = 2688, INW = 2672;
constexpr int C_AQ = 0, C_AK = 256, C_AV = 384, C_BQ = 512, C_BK = 768, C_BV = 1024, C_CQ = 1280, C_CKV = 1472,
              C_KR = 1600, C_DQKV = 1632, C_DZ = 2400, C_GATE = 2656;
constexpr int NE = 64, NSLOT = 6 * T;
constexpr int NCHUNK = T / 64;
constexpr int NGITEM = NCHUNK * 8;

constexpr size_t al256(size_t x) { return (x + 255) & ~(size_t)255; }
constexpr size_t O_MOD   = 0;
constexpr size_t O_XA    = O_MOD + al256((size_t)2 * 3 * 6144 * 4);
constexpr size_t O_H     = O_XA + (size_t)T * DM * 4;
constexpr size_t O_Y     = O_H + (size_t)T * DM * 2;
constexpr size_t O_WINT  = O_Y + (size_t)T * DM * 2;
constexpr size_t O_WOUTT = O_WINT + (size_t)LDP * 1024 * 2;
constexpr size_t O_WUQT  = O_WOUTT + (size_t)1024 * 1024 * 2;
constexpr size_t O_WUKVT = O_WUQT + (size_t)384 * 192 * 2;
constexpr size_t O_WGUT  = O_WUKVT + (size_t)512 * 128 * 2;
constexpr size_t O_WDT   = O_WGUT + (size_t)65 * 512 * 1024 * 2;
constexpr size_t O_WTS   = O_WDT + (size_t)65 * 1024 * 256 * 2;
constexpr size_t O_CNT   = O_WTS + al256((size_t)NSLOT * 4);
constexpr size_t O_TST   = O_CNT + 256;
constexpr size_t O_TAB   = O_TST;
constexpr size_t O_LIST  = O_TST + 512;
constexpr size_t O_R     = O_LIST + (size_t)NE * T * 4;
constexpr size_t O_P     = O_R;
constexpr size_t O_R2    = O_P + (size_t)T * LDP * 2;
constexpr size_t O_CQN   = O_R2;
constexpr size_t O_CKVN  = O_CQN + (size_t)T * 192 * 2;
constexpr size_t O_MLAQ  = O_CKVN + (size_t)T * 128 * 2;
constexpr size_t O_MLAKV = O_MLAQ + (size_t)T * 384 * 2;
constexpr size_t O_QA    = O_MLAKV + (size_t)T * 512 * 2;
constexpr size_t O_KA    = O_QA + (size_t)2 * 4 * NKEY * 64 * 2;
constexpr size_t O_VTA   = O_KA + (size_t)2 * 2 * NKEY * 64 * 2;
constexpr size_t O_QB    = O_VTA + (size_t)2 * 2 * NKEY * 64 * 2;
constexpr size_t O_KB    = O_QB + (size_t)2 * 8 * NKEY * 32 * 2;
constexpr size_t O_VTB   = O_KB + (size_t)2 * 8 * NKEY * 32 * 2;
constexpr size_t O_QC    = O_VTB + (size_t)2 * 4 * NKEY * 64 * 2;
constexpr size_t O_KC    = O_QC + (size_t)2 * 4 * NKEY * 96 * 2;
constexpr size_t O_VTC   = O_KC + (size_t)2 * 4 * NKEY * 96 * 2;
constexpr size_t O_ATT_END = O_VTC + (size_t)2 * 4 * NKEY * 64 * 2;
constexpr size_t O_GQ    = O_R2;
constexpr size_t O_GK    = O_GQ + (size_t)T * 256 * 4;
constexpr size_t O_GV    = O_GK + (size_t)T * 256 * 4;
constexpr size_t O_GG    = O_GV + (size_t)T * 256 * 4;
constexpr size_t O_GBETA = O_GG + (size_t)2 * T * 4 * 4;
constexpr size_t O_GM    = O_GBETA + (size_t)2 * T * 4 * 4;
constexpr size_t O_GQP   = O_GM + (size_t)NGITEM * 4096 * 2;
constexpr size_t O_GN    = O_GQP + (size_t)NGITEM * 4096 * 2;
constexpr size_t O_GO    = O_GN + (size_t)NGITEM * 4096 * 4;
constexpr size_t O_GDN_END = O_GO + (size_t)2 * T * 256 * 4;
constexpr size_t O_HB    = O_R;
constexpr size_t O_SLOT  = O_HB + (size_t)7 * T * 256 * 2;
constexpr size_t O_MOE_END = O_SLOT + (size_t)NSLOT * 1024 * 2;
constexpr size_t cmax(size_t a, size_t b) { return a > b ? a : b; }
constexpr size_t WS_NEED = cmax(cmax(O_ATT_END, O_GDN_END), O_MOE_END);
static_assert(WS_NEED < (size_t)536000000, "workspace too large");

struct KArgs {
  const float* in[35];
  float* out;
  char* ws;
};
struct Params {
  char* ws;
  float* out;
  const float* const* in;
  int tid;
};
enum { I_X = 0, I_C, I_CTX, I_CCTX, I_WADA, I_BADA, I_N1G, I_N2G, I_WIN, I_WOUT, I_SINK, I_LQ1, I_LK1, I_LQ2, I_LK2,
       I_DNG, I_MQG, I_MKVG, I_WUQ, I_WUKV, I_CONVW, I_ALF, I_ALB, I_DTF, I_DTB, I_GNG, I_WR, I_RB, I_WG, I_WU, I_WD,
       I_SG, I_SU, I_SD, I_FNG };

DEVI u16 f2bf(float f) { unsigned u = __float_as_uint(f); u += 0x7fffu + ((u >> 16) & 1u); return (u16)(u >> 16); }
DEVI float bf2f(u16 h) { return __uint_as_float(((unsigned)h) << 16); }
DEVI unsigned pack2(float a, float b) { return (unsigned)f2bf(a) | ((unsigned)f2bf(b) << 16); }
DEVI float wave_sum(float v) {
#pragma unroll
  for (int o = 32; o >= 1; o >>= 1) v += __shfl_xor(v, o);
  return v;
}
DEVI float siluf(float x) { return x / (1.f + __expf(-x)); }
DEVI float sigmf(float x) { return 1.f / (1.f + __expf(-x)); }
DEVI int tok_mv(int t) { return t < TL ? (t >> 13) : 2; }
DEVI int tok_b(int t) { return t < TL ? (t >> 13) : ((t - TL) >> 8); }
DEVI int tok_row(int t) { return t < TL ? (t & (SEQ - 1)) : (SEQ + ((t - TL) & (CTXL - 1))); }
DEVI const float* modp(const Params& p, int l, int mv, int j) { return (const float*)(p.ws + O_MOD) + ((size_t)(l * 3 + mv) * 6 + j) * 1024; }

#define MFMA16(a, b, c) __builtin_amdgcn_mfma_f32_16x16x32_bf16((a), (b), (c), 0, 0, 0)
#define MFMA32(a, b, c) __builtin_amdgcn_mfma_f32_32x32x16_bf16((a), (b), (c), 0, 0, 0)

DEVI void st_copy_in(const Params& p, int vb, int nvb) {
  float4* xa = (float4*)(p.ws + O_XA);
  const float4* x = (const float4*)p.in[I_X];
  const float4* cx = (const float4*)p.in[I_CTX];
  const size_t n4 = (size_t)T * DM / 4, nl4 = (size_t)TL * DM / 4;
  for (size_t i = (size_t)vb * 256 + p.tid; i < n4; i += (size_t)nvb * 256) xa[i] = i < nl4 ? x[i] : cx[i - nl4];
}

DEVI void st_mod(const Params& p, int vb, int nvb, char* smem) {
  float* sv = (float*)smem;
  float* red = sv + 3 * 1024;
  for (int i = p.tid; i < 3 * 1024; i += 256) {
    int v = i >> 10, k = i & 1023;
    float c = v < 2 ? p.in[I_C][v * 1024 + k] : p.in[I_CCTX][k];
    sv[i] = siluf(c);
  }
  __syncthreads();
  const int cx = p.tid & 63, kg = p.tid >> 6;
  for (int item = vb; item < 2 * 96; item += nvb) {
    const int l = item / 96, col = (item % 96) * 64 + cx;
    const float* w = p.in[I_WADA] + (size_t)l * 1024 * 6144 + col;
    float a0 = 0.f, a1 = 0.f, a2 = 0.f;
    for (int k = kg * 256; k < kg * 256 + 256; ++k) {
      float wv = w[(size_t)k * 6144];
      a0 += sv[k] * wv; a1 += sv[1024 + k] * wv; a2 += sv[2048 + k] * wv;
    }
    red[(kg * 64 + cx) * 3 + 0] = a0; red[(kg * 64 + cx) * 3 + 1] = a1; red[(kg * 64 + cx) * 3 + 2] = a2;
    __syncthreads();
    if (p.tid < 192) {
      int v = p.tid >> 6, c2 = p.tid & 63;
      float s = 0.f;
      for (int g = 0; g < 4; ++g) s += red[(g * 64 + c2) * 3 + v];
      int colo = (item % 96) * 64 + c2;
      ((float*)(p.ws + O_MOD))[(size_t)(l * 3 + v) * 6144 + colo] = s + p.in[I_BADA][l * 6144 + colo];
    }
    __syncthreads();
  }
}

DEVI void tr_tile(int tid, const float* __restrict__ src, int N, u16* __restrict__ dst, int ldd, int rs, int ro, int k0, int n0, float* tile) {
  const int tx = tid & 63, ty = tid >> 6;
#pragma unroll 4
  for (int r = 0; r < 16; ++r) {
    int k = r * 4 + ty, n = n0 + tx;
    tile[k * 65 + tx] = n < N ? src[(size_t)(k0 + k) * N + n] : 0.f;
  }
  __syncthreads();
#pragma unroll 4
  for (int r = 0; r < 16; ++r) {
    int n = r * 4 + ty;
    dst[(size_t)((n0 + n) * rs + ro) * ldd + k0 + tx] = f2bf(tile[tx * 65 + n]);
  }
  __syncthreads();
}
constexpr int TR_IN = 16 * 42, TR_OUT = 256, TR_UQ = 18, TR_UKV = 16, TR_E = 4096, TR_S = 64;
constexpr int TR_TOTAL = TR_IN + TR_OUT + TR_UQ + TR_UKV + 3 * TR_E + 3 * TR_S;
DEVI void st_prep_w(const Params& p, int l, int vb, int nvb, char* smem) {
  float* tile = (float*)smem;
  if (vb == 0 && p.tid < 64) ((int*)(p.ws + O_CNT))[p.tid] = 0;
  for (int item = vb; item < TR_TOTAL; item += nvb) {
    int it = item;
    if (it < TR_IN) { tr_tile(p.tid, p.in[I_WIN] + (size_t)l * 1024 * INW, INW, (u16*)(p.ws + O_WINT), 1024, 1, 0, (it / 42) * 64, (it % 42) * 64, tile); continue; }
    it -= TR_IN;
    if (it < TR_OUT) { tr_tile(p.tid, p.in[I_WOUT] + (size_t)l * 1024 * 1024, 1024, (u16*)(p.ws + O_WOUTT), 1024, 1, 0, (it / 16) * 64, (it % 16) * 64, tile); continue; }
    it -= TR_OUT;
    if (it < TR_UQ) { tr_tile(p.tid, p.in[I_WUQ] + (size_t)l * 192 * 384, 384, (u16*)(p.ws + O_WUQT), 192, 1, 0, (it / 6) * 64, (it % 6) * 64, tile); continue; }
    it -= TR_UQ;
    if (it < TR_UKV) { tr_tile(p.tid, p.in[I_WUKV] + (size_t)l * 128 * 512, 512, (u16*)(p.ws + O_WUKVT), 128, 1, 0, (it / 8) * 64, (it % 8) * 64, tile); continue; }
    it -= TR_UKV;
    if (it < 2 * TR_E) {
      int which = it / TR_E; it %= TR_E;
      int e = it >> 6, tt = it & 63;
      const float* src = p.in[which ? I_WU : I_WG] + ((size_t)l * NE + e) * 1024 * 256;
      tr_tile(p.tid, src, 256, (u16*)(p.ws + O_WGUT) + (size_t)e * 512 * 1024, 1024, 2, which, (tt >> 2) * 64, (tt & 3) * 64, tile); continue;
    }
    it -= 2 * TR_E;
    if (it < TR_E) {
      int e = it >> 6, tt = it & 63;
      const float* src = p.in[I_WD] + ((size_t)l * NE + e) * 256 * 1024;
      tr_tile(p.tid, src, 1024, (u16*)(p.ws + O_WDT) + (size_t)e * 1024 * 256, 256, 1, 0, (tt >> 4) * 64, (tt & 15) * 64, tile); continue;
    }
    it -= TR_E;
    if (it < 2 * TR_S) {
      int which = it / TR_S; int tt = it % TR_S;
      const float* src = p.in[which ? I_SU : I_SG] + (size_t)l * 1024 * 256;
      tr_tile(p.tid, src, 256, (u16*)(p.ws + O_WGUT) + (size_t)64 * 512 * 1024, 1024, 2, which, (tt >> 2) * 64, (tt & 3) * 64, tile); continue;
    }
    it -= 2 * TR_S;
    { int tt = it;
      const float* src = p.in[I_SD] + (size_t)l * 256 * 1024;
      tr_tile(p.tid, src, 1024, (u16*)(p.ws + O_WDT) + (size_t)64 * 1024 * 256, 256, 1, 0, (tt >> 4) * 64, (tt & 15) * 64, tile); }
  }
}

DEVI void st_norm1(const Params& p, int l, int vb, int nvb) {
  const int lane = p.tid & 63, wid = p.tid >> 6;
  const float* g = p.in[I_N1G] + l * 1024;
  for (int t = vb * 4 + wid; t < T; t += nvb * 4) {
    const int mv = tok_mv(t);
    const float* sh = modp(p, l, mv, 0); const float* sc = modp(p, l, mv, 1);
    const float4* xr = (const float4*)((const float*)(p.ws + O_XA) + (size_t)t * 1024);
    float4 v[4]; float ss = 0.f;
#pragma unroll
    for (int i = 0; i < 4; ++i) { v[i] = xr[i * 64 + lane]; ss += v[i].x * v[i].x + v[i].y * v[i].y + v[i].z * v[i].z + v[i].w * v[i].w; }
    ss = wave_sum(ss);
    const float rstd = rsqrtf(ss * (1.f / 1024.f) + 1e-6f);
    u16* hr = (u16*)(p.ws + O_H) + (size_t)t * 1024;
#pragma unroll
    for (int i = 0; i < 4; ++i) {
      int c = i * 256 + lane * 4;
      float4 gg = *(const float4*)(g + c), s4 = *(const float4*)(sc + c), h4 = *(const float4*)(sh + c);
      float o0 = v[i].x * rstd * gg.x * (1.f + s4.x) + h4.x, o1 = v[i].y * rstd * gg.y * (1.f + s4.y) + h4.y;
      float o2 = v[i].z * rstd * gg.z * (1.f + s4.z) + h4.z, o3 = v[i].w * rstd * gg.w * (1.f + s4.w) + h4.w;
      u32x2 pk; pk[0] = pack2(o0, o1); pk[1] = pack2(o2, o3);
      *(u32x2*)(hr + c) = pk;
    }
  }
}

constexpr int GLD = 72;
template <class ARow, class Epi>
DEVI void gemm128(int tid, ARow arow, const u16* __restrict__ Bt, int ldb, int K, Epi epi, char* smem) {
  u16* sA = (u16*)smem; u16* sB = sA + 128 * GLD;
  const int lane = tid & 63, wid = tid >> 6, wr = wid >> 1, wc = wid & 1, fr = lane & 15, fq = lane >> 4;
  const u16* ap[4]; const u16* bp[4];
#pragma unroll
  for (int i = 0; i < 4; ++i) { int q = tid + 256 * i, row = q >> 3, cc = q & 7; ap[i] = arow(row) + cc * 8; bp[i] = Bt + (size_t)row * ldb + cc * 8; }
  u32x4 ra[4], rb[4];
#pragma unroll
  for (int i = 0; i < 4; ++i) { ra[i] = *(const u32x4*)ap[i]; rb[i] = *(const u32x4*)bp[i]; }
  f32x4 acc[4][4];
#pragma unroll
  for (int m = 0; m < 4; ++m)
#pragma unroll
    for (int n = 0; n < 4; ++n) acc[m][n] = f32x4{0.f, 0.f, 0.f, 0.f};
  const int nk = K >> 6;
  for (int kt = 0; kt < nk; ++kt) {
    __syncthreads();
#pragma unroll
    for (int i = 0; i < 4; ++i) { int q = tid + 256 * i, row = q >> 3, cc = q & 7; *(u32x4*)&sA[row * GLD + cc * 8] = ra[i]; *(u32x4*)&sB[row * GLD + cc * 8] = rb[i]; }
    __syncthreads();
    if (kt + 1 < nk) {
#pragma unroll
      for (int i = 0; i < 4; ++i) { ra[i] = *(const u32x4*)(ap[i] + (kt + 1) * 64); rb[i] = *(const u32x4*)(bp[i] + (kt + 1) * 64); }
    }
#pragma unroll
    for (int ks = 0; ks < 2; ++ks) {
      bf16x8 af[4], bfr[4];
#pragma unroll
      for (int m = 0; m < 4; ++m) af[m] = *(const bf16x8*)&sA[(wr * 64 + m * 16 + fr) * GLD + ks * 32 + fq * 8];
#pragma unroll
      for (int n = 0; n < 4; ++n) bfr[n] = *(const bf16x8*)&sB[(wc * 64 + n * 16 + fr) * GLD + ks * 32 + fq * 8];
#pragma unroll
      for (int m = 0; m < 4; ++m)
#pragma unroll
        for (int n = 0; n < 4; ++n) acc[m][n] = MFMA16(bfr[n], af[m], acc[m][n]);
    }
  }
#pragma unroll
  for (int m = 0; m < 4; ++m)
#pragma unroll
    for (int n = 0; n < 4; ++n) epi(wr * 64 + m * 16 + fr, wc * 64 + n * 16 + fq * 4, acc[m][n]);
  __syncthreads();
}

DEVI void st_inproj(const Params& p, int vb, int nvb, char* smem) {
  const u16* H = (const u16*)(p.ws + O_H); const u16* W = (const u16*)(p.ws + O_WINT); u16* P = (u16*)(p.ws + O_P);
  for (int item = vb; item < 132 * 21; item += nvb) {
    const int m0 = (item / 21) * 128, n0 = (item % 21) * 128;
    gemm128(p.tid, [&](int r) { return H + (size_t)(m0 + r) * 1024; }, W + (size_t)n0 * 1024, 1024, 1024,
            [&](int r, int c, f32x4 v) { u32x2 pk; pk[0] = pack2(v[0], v[1]); pk[1] = pack2(v[2], v[3]); *(u32x2*)(P + (size_t)(m0 + r) * LDP + n0 + c) = pk; }, smem);
  }
}

DEVI void rope_cs(int i, int half, int s, float& c, float& sn) {
  const int quarter = half >> 1;
  const int ii = i < quarter ? i : i - quarter;
  const float pos = i < quarter ? (float)(s >> 6) : (float)(s & 63);
  const float inv = powf(10000.f, -(float)ii / (float)quarter);
  const float ang = pos * inv;
  c = cosf(ang); sn = sinf(ang);
}
DEVI void st_scatter(const Params& p, int l, int vb, int nvb) {
  const int lane = p.tid & 63, wid = p.tid >> 6;
  const u16* P = (const u16*)(p.ws + O_P);
  u16* QA = (u16*)(p.ws + O_QA); u16* KA = (u16*)(p.ws + O_KA); u16* VTA = (u16*)(p.ws + O_VTA);
  u16* QB = (u16*)(p.ws + O_QB); u16* KB = (u16*)(p.ws + O_KB); u16* VTB = (u16*)(p.ws + O_VTB);
  u16* KC = (u16*)(p.ws + O_KC);
  u16* CQN = (u16*)(p.ws + O_CQN); u16* CKVN = (u16*)(p.ws + O_CKVN);
  for (int t = vb * 4 + wid; t < T; t += nvb * 4) {
    const u16* pr = P + (size_t)t * LDP;
    const int b = tok_b(t), row = tok_row(t); const bool lat = t < TL; const int s = t & (SEQ - 1);
    {
      const int i = lane & 31;
      float c = 1.f, sn = 0.f; if (lat) rope_cs(i, 32, s, c, sn);
#pragma unroll
      for (int r = 0; r < 3; ++r) {
        const int hh = r * 2 + (lane >> 5);
        const int cb = hh < 4 ? C_AQ + hh * 64 : C_AK + (hh - 4) * 64;
        float x1 = bf2f(pr[cb + i]), x2 = bf2f(pr[cb + 32 + i]);
        float y1 = x1 * c - x2 * sn, y2 = x2 * c + x1 * sn;
        u16* dst = hh < 4 ? QA + ((size_t)(b * 4 + hh) * NKEY + row) * 64 : KA + ((size_t)(b * 2 + (hh - 4)) * NKEY + row) * 64;
        dst[i] = f2bf(y1); dst[32 + i] = f2bf(y2);
      }
#pragma unroll
      for (int r = 0; r < 2; ++r) VTA[((size_t)(b * 2 + r) * 64 + lane) * NKEY + row] = pr[C_AV + r * 64 + lane];
    }
    {
      const int i = lane & 15;
      float c = 1.f, sn = 0.f; if (lat) rope_cs(i, 16, s, c, sn);
#pragma unroll
      for (int r = 0; r < 4; ++r) {
        const int hm = r * 4 + (lane >> 4);
        const int cb = hm < 8 ? C_BQ + hm * 32 : C_BK + (hm - 8) * 32;
        float x1 = bf2f(pr[cb + i]), x2 = bf2f(pr[cb + 16 + i]);
        float y1 = x1 * c - x2 * sn, y2 = x2 * c + x1 * sn;
        u16* dst = hm < 8 ? QB + ((size_t)(b * 8 + hm) * NKEY + row) * 32 : KB + ((size_t)(b * 8 + (hm - 8)) * NKEY + row) * 32;
        dst[i] = f2bf(y1); dst[16 + i] = f2bf(y2);
      }
#pragma unroll
      for (int r = 0; r < 4; ++r) VTB[((size_t)(b * 4 + r) * 64 + lane) * NKEY + row] = pr[C_BV + r * 64 + lane];
      if (lane < 16) {
        float x1 = bf2f(pr[C_KR + i]), x2 = bf2f(pr[C_KR + 16 + i]);
        u16 y1 = f2bf(x1 * c - x2 * sn), y2 = f2bf(x2 * c + x1 * sn);
#pragma unroll
        for (int h = 0; h < 4; ++h) { u16* dst = KC + ((size_t)(b * 4 + h) * NKEY + row) * 96 + 64; dst[i] = y1; dst[16 + i] = y2; }
      }
    }
    {
      float q0 = bf2f(pr[C_CQ + lane]), q1 = bf2f(pr[C_CQ + 64 + lane]), q2 = bf2f(pr[C_CQ + 128 + lane]);
      float ss = wave_sum(q0 * q0 + q1 * q1 + q2 * q2);
      float rs = rsqrtf(ss * (1.f / 192.f) + 1e-6f);
      const float* g = p.in[I_MQG] + l * 192;
      u16* d = CQN + (size_t)t * 192;
      d[lane] = f2bf(q0 * rs * g[lane]); d[64 + lane] = f2bf(q1 * rs * g[64 + lane]); d[128 + lane] = f2bf(q2 * rs * g[128 + lane]);
      float k0 = bf2f(pr[C_CKV + lane]), k1 = bf2f(pr[C_CKV + 64 + lane]);
      float s2 = wave_sum(k0 * k0 + k1 * k1);
      float r2 = rsqrtf(s2 * (1.f / 128.f) + 1e-6f);
      const float* g2 = p.in[I_MKVG] + l * 128;
      u16* d2 = CKVN + (size_t)t * 128;
      d2[lane] = f2bf(k0 * r2 * g2[lane]); d2[64 + lane] = f2bf(k1 * r2 * g2[64 + lane]);
    }
  }
}

DEVI void st_mla_up(const Params& p, int vb, int nvb, char* smem) {
  const u16* CQN = (const u16*)(p.ws + O_CQN); const u16* CKVN = (const u16*)(p.ws + O_CKVN);
  u16* MQ = (u16*)(p.ws + O_MLAQ); u16* MKV = (u16*)(p.ws + O_MLAKV);
  for (int item = vb; item < 132 * 7; item += nvb) {
    const int m0 = (item / 7) * 128, nn = item % 7;
    if (nn < 3) {
      const int n0 = nn * 128;
      gemm128(p.tid, [&](int r) { return CQN + (size_t)(m0 + r) * 192; }, (const u16*)(p.ws + O_WUQT) + (size_t)n0 * 192, 192, 192,
              [&](int r, int c, f32x4 v) { u32x2 pk; pk[0] = pack2(v[0], v[1]); pk[1] = pack2(v[2], v[3]); *(u32x2*)(MQ + (size_t)(m0 + r) * 384 + n0 + c) = pk; }, smem);
    } else {
      const int n0 = (nn - 3) * 128;
      gemm128(p.tid, [&](int r) { return CKVN + (size_t)(m0 + r) * 128; }, (const u16*)(p.ws + O_WUKVT) + (size_t)n0 * 128, 128, 128,
              [&](int r, int c, f32x4 v) { u32x2 pk; pk[0] = pack2(v[0], v[1]); pk[1] = pack2(v[2], v[3]); *(u32x2*)(MKV + (size_t)(m0 + r) * 512 + n0 + c) = pk; }, smem);
    }
  }
}
DEVI void st_mla_scatter(const Params& p, int vb, int nvb) {
  const int lane = p.tid & 63, wid = p.tid >> 6;
  const u16* MQ = (const u16*)(p.ws + O_MLAQ); const u16* MKV = (const u16*)(p.ws + O_MLAKV);
  u16* QC = (u16*)(p.ws + O_QC); u16* KC = (u16*)(p.ws + O_KC); u16* VTC = (u16*)(p.ws + O_VTC);
  for (int t = vb * 4 + wid; t < T; t += nvb * 4) {
    const int b = tok_b(t), row = tok_row(t); const bool lat = t < TL; const int s = t & (SEQ - 1);
    const u16* q = MQ + (size_t)t * 384; const u16* kv = MKV + (size_t)t * 512;
    const int i = lane & 15;
    float c = 1.f, sn = 0.f; if (lat) rope_cs(i, 16, s, c, sn);
#pragma unroll
    for (int h = 0; h < 4; ++h) {
      u16* qd = QC + ((size_t)(b * 4 + h) * NKEY + row) * 96;
      qd[lane] = q[h * 96 + lane];
      if (lane < 16) {
        float x1 = bf2f(q[h * 96 + 64 + i]), x2 = bf2f(q[h * 96 + 80 + i]);
        qd[64 + i] = f2bf(x1 * c - x2 * sn); qd[80 + i] = f2bf(x2 * c + x1 * sn);
      }
      KC[((size_t)(b * 4 + h) * NKEY + row) * 96 + lane] = kv[h * 128 + lane];
      VTC[((size_t)(b * 4 + h) * 64 + lane) * NKEY + row] = kv[h * 128 + 64 + lane];
    }
  }
}

template <int DQK>
DEVI void attn_run(int tid, const u16* __restrict__ Qp, int qrow0, const u16* __restrict__ Kp, const u16* __restrict__ Vtp,
                   int a0, int a1, int b0, int b1, bool winB, int qpos0, float c2, float sink2,
                   f32x16 (&O)[2], char* smem) {
  constexpr int KLD = DQK + 8, NS = DQK / 16;
  u16* sK = (u16*)smem; u16* sV = sK + 64 * KLD;
  const int lane = tid & 63, wid = tid >> 6, r31 = lane & 31, hh = lane >> 5;
  const int qrow = qrow0 + wid * 32 + r31;
  bf16x8 qf[NS];
#pragma unroll
  for (int s = 0; s < NS; ++s) qf[s] = *(const bf16x8*)(Qp + (size_t)qrow * DQK + s * 16 + hh * 8);
#pragma unroll
  for (int i = 0; i < 16; ++i) { O[0][i] = 0.f; O[1][i] = 0.f; }
  float m = -30000.f, lsum = 0.f;
  const int na = (a1 - a0) >> 6, nb = (b1 - b0) >> 6;
  const int qpos = qpos0 + wid * 32 + r31;
  for (int ti = 0; ti < na + nb; ++ti) {
    const bool inB = ti >= na;
    const int key0 = inB ? b0 + (ti - na) * 64 : a0 + ti * 64;
    __syncthreads();
    for (int q = tid; q < 64 * (DQK / 8); q += 256) {
      int r = q / (DQK / 8), cc = q % (DQK / 8);
      *(u32x4*)&sK[r * KLD + cc * 8] = *(const u32x4*)(Kp + (size_t)(key0 + r) * DQK + cc * 8);
    }
#pragma unroll
    for (int i = 0; i < 2; ++i) {
      int q = tid + 256 * i, r = q >> 3, cc = q & 7;
      *(u32x4*)&sV[r * 72 + cc * 8] = *(const u32x4*)(Vtp + (size_t)r * NKEY + key0 + cc * 8);
    }
    __syncthreads();
    f32x16 st[2];
#pragma unroll
    for (int k2 = 0; k2 < 2; ++k2) {
#pragma unroll
      for (int i = 0; i < 16; ++i) st[k2][i] = 0.f;
#pragma unroll
      for (int s = 0; s < NS; ++s) {
        bf16x8 kf = *(const bf16x8*)&sK[(k2 * 32 + r31) * KLD + s * 16 + hh * 8];
        st[k2] = MFMA32(kf, qf[s], st[k2]);
      }
    }
    const bool msk = winB && inB;
    float mx = -1e30f;
#pragma unroll
    for (int k2 = 0; k2 < 2; ++k2)
#pragma unroll
      for (int g = 0; g < 16; ++g) {
        float v = st[k2][g] * c2;
        if (msk) { int kp = key0 + k2 * 32 + (g & 3) + 8 * (g >> 2) + 4 * hh; int d = kp - qpos; if (d > 128 || d < -128) v = -1e30f; }
        st[k2][g] = v; mx = fmaxf(mx, v);
      }
    mx = fmaxf(mx, __shfl_xor(mx, 32));
    const float mn = fmaxf(m, mx);
    const float alpha = __builtin_amdgcn_exp2f(m - mn);
    m = mn;
    float ps = 0.f;
#pragma unroll
    for (int k2 = 0; k2 < 2; ++k2)
#pragma unroll
      for (int g = 0; g < 16; ++g) { float pv = __builtin_amdgcn_exp2f(st[k2][g] - mn); st[k2][g] = pv; ps += pv; }
    lsum = lsum * alpha + ps;
#pragma unroll
    for (int i = 0; i < 16; ++i) { O[0][i] *= alpha; O[1][i] *= alpha; }
#pragma unroll
    for (int k2 = 0; k2 < 2; ++k2)
#pragma unroll
      for (int s2 = 0; s2 < 2; ++s2) {
        bf16x8 pf;
#pragma unroll
        for (int j = 0; j < 8; ++j) pf[j] = (short)f2bf(st[k2][8 * s2 + j]);
#pragma unroll
        for (int dvt = 0; dvt < 2; ++dvt) {
          const u16* vp = &sV[(dvt * 32 + r31) * 72 + k2 * 32 + s2 * 16 + 4 * hh];
          u32x2 lo = *(const u32x2*)vp, hi = *(const u32x2*)(vp + 8);
          u32x4 vv; vv[0] = lo[0]; vv[1] = lo[1]; vv[2] = hi[0]; vv[3] = hi[1];
          bf16x8 vf = __builtin_bit_cast(bf16x8, vv);
          O[dvt] = MFMA32(vf, pf, O[dvt]);
        }
      }
  }
  if (sink2 > -1e29f) {
    const float mn = fmaxf(m, sink2);
    const float alpha = __builtin_amdgcn_exp2f(m - mn);
    lsum = lsum * alpha + (hh == 0 ? __builtin_amdgcn_exp2f(sink2 - mn) : 0.f);
#pragma unroll
    for (int i = 0; i < 16; ++i) { O[0][i] *= alpha; O[1][i] *= alpha; }
  }
  const float ltot = lsum + __shfl_xor(lsum, 32);
  const float inv = 1.f / ltot;
#pragma unroll
  for (int i = 0; i < 16; ++i) { O[0][i] *= inv; O[1][i] *= inv; }
  __syncthreads();
}
DEVI void attn_store(int tid, const f32x16 (&O)[2], u16* Y, int b, int qrow0, int col0) {
  const int lane = tid & 63, wid = tid >> 6, r31 = lane & 31, hh = lane >> 5;
  const int qrow = qrow0 + wid * 32 + r31;
  const int t = qrow < SEQ ? b * SEQ + qrow : TL + b * CTXL + (qrow - SEQ);
  u16* yr = Y + (size_t)t * 1024 + col0;
#pragma unroll
  for (int dvt = 0; dvt < 2; ++dvt)
#pragma unroll
    for (int g4 = 0; g4 < 4; ++g4) {
      u32x2 pk; pk[0] = pack2(O[dvt][g4 * 4 + 0], O[dvt][g4 * 4 + 1]); pk[1] = pack2(O[dvt][g4 * 4 + 2], O[dvt][g4 * 4 + 3]);
      *(u32x2*)(yr + dvt * 32 + 8 * g4 + 4 * hh) = pk;
    }
}
constexpr float LOG2E = 1.4426950408889634f;
DEVI void st_attn(const Params& p, int l, int vb, int nvb, char* smem) {
  u16* Y = (u16*)(p.ws + O_Y);
  const int lane = p.tid & 63;
  const float lam_init = 0.8f - 0.6f * expf(-0.3f * (float)l);
  float d1 = lane < 32 ? p.in[I_LQ1][l * 32 + lane] * p.in[I_LK1][l * 32 + lane] : 0.f;
  float d2 = lane < 32 ? p.in[I_LQ2][l * 32 + lane] * p.in[I_LK2][l * 32 + lane] : 0.f;
  const float lam = expf(wave_sum(d1)) - expf(wave_sum(d2)) + lam_init;
  for (int item = vb; item < 3 * 528; item += nvb) {
    const int mixer = item / 528, rem = item % 528;
    const int b = rem / 264, h = (rem / 66) & 3, qb = rem % 66;
    const bool lat = qb < 64;
    const int qrow0 = qb * 128;
    f32x16 O[2];
    if (mixer == 0) {
      const float c2 = rsqrtf(96.f) * LOG2E;
      attn_run<96>(p.tid, (const u16*)(p.ws + O_QC) + (size_t)(b * 4 + h) * NKEY * 96, qrow0, (const u16*)(p.ws + O_KC) + (size_t)(b * 4 + h) * NKEY * 96,
                   (const u16*)(p.ws + O_VTC) + (size_t)(b * 4 + h) * 64 * NKEY, lat ? 0 : SEQ, NKEY, 0, 0, false, 0, c2, -1e30f, O, smem);
      attn_store(p.tid, O, Y, b, qrow0, 512 + h * 64);
    } else if (mixer == 1) {
      const float c2 = rsqrtf(32.f) * LOG2E;
      f32x16 O1[2];
      attn_run<32>(p.tid, (const u16*)(p.ws + O_QB) + (size_t)(b * 8 + h * 2) * NKEY * 32, qrow0, (const u16*)(p.ws + O_KB) + (size_t)(b * 8 + h * 2) * NKEY * 32,
                   (const u16*)(p.ws + O_VTB) + (size_t)(b * 4 + h) * 64 * NKEY, lat ? 0 : SEQ, NKEY, 0, 0, false, 0, c2, -1e30f, O, smem);
      attn_run<32>(p.tid, (const u16*)(p.ws + O_QB) + (size_t)(b * 8 + h * 2 + 1) * NKEY * 32, qrow0, (const u16*)(p.ws + O_KB) + (size_t)(b * 8 + h * 2 + 1) * NKEY * 32,
                   (const u16*)(p.ws + O_VTB) + (size_t)(b * 4 + h) * 64 * NKEY, lat ? 0 : SEQ, NKEY, 0, 0, false, 0, c2, -1e30f, O1, smem);
      const int hh = lane >> 5;
      float ss = 0.f;
#pragma unroll
      for (int dvt = 0; dvt < 2; ++dvt)
#pragma unroll
        for (int g = 0; g < 16; ++g) { float o = O[dvt][g] - lam * O1[dvt][g]; O[dvt][g] = o; ss += o * o; }
      ss += __shfl_xor(ss, 32);
      const float rs = rsqrtf(ss * (1.f / 64.f) + 1e-6f) * (1.f - lam_init);
      const float* dg = p.in[I_DNG] + l * 64;
#pragma unroll
      for (int dvt = 0; dvt < 2; ++dvt)
#pragma unroll
        for (int g = 0; g < 16; ++g) O[dvt][g] *= rs * dg[dvt * 32 + (g & 3) + 8 * (g >> 2) + 4 * hh];
      attn_store(p.tid, O, Y, b, qrow0, 256 + h * 64);
    } else {
      const float c2 = 0.125f * LOG2E;
      const float sink2 = p.in[I_SINK][l * 4 + h] * LOG2E;
      const int hk = h >> 1;
      int b0 = 0, b1 = 0;
      if (lat) { b0 = (qb - 1) * 128; if (b0 < 0) b0 = 0; b1 = (qb + 2) * 128; if (b1 > SEQ) b1 = SEQ; }
      attn_run<64>(p.tid, (const u16*)(p.ws + O_QA) + (size_t)(b * 4 + h) * NKEY * 64, qrow0, (const u16*)(p.ws + O_KA) + (size_t)(b * 2 + hk) * NKEY * 64,
                   (const u16*)(p.ws + O_VTA) + (size_t)(b * 2 + hk) * 64 * NKEY, SEQ, NKEY, b0, b1, true, qrow0, c2, sink2, O, smem);
      attn_store(p.tid, O, Y, b, qrow0, h * 64);
    }
  }
}

DEVI void st_gdn_prep(const Params& p, int l, int vb, int nvb) {
  const int lane = p.tid & 63, wid = p.tid >> 6;
  const u16* P = (const u16*)(p.ws + O_P);
  float* GQ = (float*)(p.ws + O_GQ); float* GK = (float*)(p.ws + O_GK); float* GV = (float*)(p.ws + O_GV);
  float* GG = (float*)(p.ws + O_GG); float* GB = (float*)(p.ws + O_GBETA);
  const float* cw = p.in[I_CONVW] + (size_t)l * 5 * 768;
  for (int t = vb * 4 + wid; t < T; t += nvb * 4) {
    int base, pos, len;
    if (t < TL) { base = t & ~(SEQ - 1); pos = t & (SEQ - 1); len = SEQ; } else { int j = t - TL; base = TL + (j & ~(CTXL - 1)); pos = j & (CTXL - 1); len = CTXL; }
#pragma unroll
    for (int i = 0; i < 12; ++i) {
      const int c = lane + 64 * i;
      float acc = 0.f;
#pragma unroll
      for (int j = 0; j < 5; ++j) {
        int pp = pos + j - 2;
        if (pp >= 0 && pp < len) acc += cw[j * 768 + c] * bf2f(P[(size_t)(base + pp) * LDP + C_DQKV + c]);
      }
      float y = siluf(acc);
      if (i < 8) {
        float ss = wave_sum(y * y);
        float r = rsqrtf(ss + 1e-6f);
        if (i < 4) GQ[(size_t)t * 256 + i * 64 + lane] = y * r * 0.125f;
        else GK[(size_t)t * 256 + (i - 4) * 64 + lane] = y * r;
      } else GV[(size_t)t * 256 + (i - 8) * 64 + lane] = y;
    }
    if (lane < 16) {
      const int which = lane >> 2, hd = lane & 3;
      const float val = bf2f(P[(size_t)t * LDP + C_GATE + lane]);
      if (which < 2) {
        const float al = which ? p.in[I_ALB][l * 4 + hd] : p.in[I_ALF][l * 4 + hd];
        const float dt = which ? p.in[I_DTB][l * 4 + hd] : p.in[I_DTF][l * 4 + hd];
        const float xx = val + dt;
        const float sp = fmaxf(xx, 0.f) + log1pf(expf(-fabsf(xx)));
        GG[((size_t)which * T + t) * 4 + hd] = -expf(al) * sp;
      } else GB[((size_t)(which - 2) * T + t) * 4 + hd] = sigmf(val);
    }
  }
}

DEVI int gdn_chunk_t0(int ci) { return ci < 256 ? (ci >> 7) * SEQ + (ci & 127) * 64 : TL + ((ci - 256) >> 2) * CTXL + ((ci - 256) & 3) * 64; }

DEVI void st_gdn_chunk(const Params& p, int vb, int nvb, char* smem) {
  float* R1 = (float*)smem;
  float* sk = R1; float* sq = R1 + 64 * 65; float* X = R1;
  float* sA = R1 + 2 * 64 * 65;
  float* sAt = sA + 64 * 65;
  float* sgc = sAt + 64 * 65; float* sbeta = sgc + 64;
  const float* GQ = (const float*)(p.ws + O_GQ); const float* GK = (const float*)(p.ws + O_GK); const float* GV = (const float*)(p.ws + O_GV);
  const float* GG = (const float*)(p.ws + O_GG); const float* GB = (const float*)(p.ws + O_GBETA);
  u16* GM = (u16*)(p.ws + O_GM); u16* GQP = (u16*)(p.ws + O_GQP); float* GN = (float*)(p.ws + O_GN); float* GO = (float*)(p.ws + O_GO);
  const int tid = p.tid, lane = tid & 63;
  for (int item = vb; item < NGITEM; item += nvb) {
    const int ci = item >> 3, hd = (item >> 1) & 3, dir = item & 1;
    const int t0 = gdn_chunk_t0(ci);
    auto tok = [&](int i) { return dir ? t0 + 63 - i : t0 + i; };
    if (tid < 64) {
      float g = GG[((size_t)dir * T + tok(tid)) * 4 + hd];
#pragma unroll
      for (int o = 1; o < 64; o <<= 1) { float u = __shfl_up(g, o); if (lane >= o) g += u; }
      sgc[tid] = g; sbeta[tid] = GB[((size_t)dir * T + tok(tid)) * 4 + hd];
    }
    for (int e = tid; e < 4096; e += 256) {
      int i = e >> 6, d = e & 63; size_t a = (size_t)tok(i) * 256 + hd * 64 + d;
      sk[i * 65 + d] = GK[a]; sq[i * 65 + d] = GQ[a];
    }
    __syncthreads();
    const float glast = sgc[63];
    for (int r = 0; r < 16; ++r) {
      const int i = r * 4 + (tid >> 6), j = lane;
      float kk = 0.f, qk = 0.f;
#pragma unroll 8
      for (int d = 0; d < 64; ++d) { float kj = sk[j * 65 + d]; kk += sk[i * 65 + d] * kj; qk += sq[i * 65 + d] * kj; }
      const float dec = i >= j ? expf(sgc[i] - sgc[j]) : 0.f;
      sA[i * 65 + j] = i > j ? sbeta[i] * kk * dec : 0.f;
      sAt[i * 65 + j] = i >= j ? qk * dec : 0.f;
    }
    __syncthreads();
    for (int e = tid; e < 64 * 128; e += 256) {
      int i = e >> 7, c = e & 127; size_t a = (size_t)tok(i) * 256 + hd * 64 + (c & 63);
      X[i * 129 + c] = c < 64 ? GV[a] * sbeta[i] : GK[a] * sbeta[i] * expf(sgc[i]);
    }
    __syncthreads();
    if (tid < 128) {
      for (int i = 1; i < 64; ++i) {
        float acc = X[i * 129 + tid];
        for (int j = 0; j < i; ++j) acc -= sA[i * 65 + j] * X[j * 129 + tid];
        X[i * 129 + tid] = acc;
      }
    }
    __syncthreads();
    for (int e = tid; e < 4096; e += 256) {
      int j = e >> 6, d = e & 63;
      sA[j * 65 + d] = GK[(size_t)tok(j) * 256 + hd * 64 + d] * expf(glast - sgc[j]);
    }
    __syncthreads();
    const float eglast = expf(glast);
    for (int r = 0; r < 16; ++r) {
      const int a = r * 4 + (tid >> 6), bc = lane;
      float lo = 0.f, qw = 0.f, nn = 0.f, mm = 0.f;
#pragma unroll 8
      for (int j = 0; j < 64; ++j) {
        const float at = sAt[a * 65 + j], kd = sA[j * 65 + a], xu = X[j * 129 + bc], xw = X[j * 129 + 64 + bc];
        lo += at * xu; qw += at * xw; nn += kd * xu; mm += kd * xw;
      }
      const size_t ta = (size_t)tok(a) * 256 + hd * 64 + bc;
      GO[(size_t)dir * T * 256 + ta] = lo;
      GQP[(size_t)item * 4096 + a * 64 + bc] = f2bf(GQ[ta] * expf(sgc[a]) - qw);
      GN[(size_t)item * 4096 + a * 64 + bc] = nn;
      GM[(size_t)item * 4096 + a * 64 + bc] = f2bf((a == bc ? eglast : 0.f) - mm);
    }
    __syncthreads();
  }
}

DEVI void st_gdn_scan(const Params& p, int vb, int nvb, char* smem) {
  const int lane = p.tid & 63, wid = p.tid >> 6;
  float* sS = (float*)smem + wid * 64 * 64;
  const u16* GM = (const u16*)(p.ws + O_GM); const u16* GQP = (const u16*)(p.ws + O_GQP); const float* GN = (const float*)(p.ws + O_GN);
  float* GO = (float*)(p.ws + O_GO);
  for (int chain = vb * 4 + wid; chain < 16; chain += nvb * 4) {
    const int b = chain >> 3, hd = (chain >> 1) & 3, dir = chain & 1;
    float S[64];
#pragma unroll
    for (int d = 0; d < 64; ++d) S[d] = 0.f;
    for (int n = 0; n < 132; ++n) {
      int ci;
      if (n < 4) ci = 256 + b * 4 + (dir ? 3 - n : n);
      else ci = b * 128 + (dir ? 127 - (n - 4) : (n - 4));
      const int item = ci * 8 + hd * 2 + dir;
      const int t0 = gdn_chunk_t0(ci);
      const u16* qp = GQP + (size_t)item * 4096; const u16* mp = GM + (size_t)item * 4096; const float* np = GN + (size_t)item * 4096;
      for (int i = 0; i < 64; ++i) {
        float acc = 0.f;
#pragma unroll
        for (int d = 0; d < 64; ++d) acc += bf2f(qp[i * 64 + d]) * S[d];
        const int t = dir ? t0 + 63 - i : t0 + i;
        GO[(size_t)dir * T * 256 + (size_t)t * 256 + hd * 64 + lane] += acc;
      }
      for (int d = 0; d < 64; ++d) {
        float acc = np[d * 64 + lane];
#pragma unroll
        for (int e = 0; e < 64; ++e) acc += bf2f(mp[d * 64 + e]) * S[e];
        sS[d * 64 + lane] = acc;
      }
#pragma unroll
      for (int d = 0; d < 64; ++d) S[d] = sS[d * 64 + lane];
    }
  }
}

DEVI void st_gdn_out(const Params& p, int l, int vb, int nvb) {
  const int lane = p.tid & 63, wid = p.tid >> 6;
  const float* GO = (const float*)(p.ws + O_GO); const u16* P = (const u16*)(p.ws + O_P); u16* Y = (u16*)(p.ws + O_Y);
  const float g = p.in[I_GNG][l * 64 + lane];
  for (int t = vb * 4 + wid; t < T; t += nvb * 4) {
#pragma unroll
    for (int hd = 0; hd < 4; ++hd) {
      float o = GO[(size_t)t * 256 + hd * 64 + lane] + GO[(size_t)T * 256 + (size_t)t * 256 + hd * 64 + lane];
      float ss = wave_sum(o * o);
      float z = bf2f(P[(size_t)t * LDP + C_DZ + hd * 64 + lane]);
      Y[(size_t)t * 1024 + 768 + hd * 64 + lane] = f2bf(o * rsqrtf(ss * (1.f / 64.f) + 1e-6f) * g * siluf(z));
    }
  }
}

DEVI void st_outproj(const Params& p, int l, int vb, int nvb, char* smem) {
  const u16* Y = (const u16*)(p.ws + O_Y); const u16* W = (const u16*)(p.ws + O_WOUTT); float* XA = (float*)(p.ws + O_XA);
  for (int item = vb; item < 132 * 8; item += nvb) {
    const int m0 = (item >> 3) * 128, n0 = (item & 7) * 128;
    gemm128(p.tid, [&](int r) { return Y + (size_t)(m0 + r) * 1024; }, W + (size_t)n0 * 1024, 1024, 1024,
            [&](int r, int c, f32x4 v) {
              const int t = m0 + r; const float* gt = modp(p, l, tok_mv(t), 2) + n0 + c;
              float4* xp = (float4*)(XA + (size_t)t * 1024 + n0 + c); float4 x = *xp;
              x.x += gt[0] * v[0]; x.y += gt[1] * v[1]; x.z += gt[2] * v[2]; x.w += gt[3] * v[3]; *xp = x;
            }, smem);
  }
}

DEVI void st_norm2_route(const Params& p, int l, int vb, int nvb, char* smem) {
  const int lane = p.tid & 63, wid = p.tid >> 6;
  float* shh = (float*)smem + wid * 1024;
  const float* g = p.in[I_N2G] + l * 1024;
  const float* wr = p.in[I_WR] + (size_t)l * 1024 * 64;
  const float bias = p.in[I_RB][l * 64 + lane];
  float* WTS = (float*)(p.ws + O_WTS); int* CNT = (int*)(p.ws + O_CNT); int* LIST = (int*)(p.ws + O_LIST);
  for (int t = vb * 4 + wid; t < T; t += nvb * 4) {
    const int mv = tok_mv(t);
    const float* sh = modp(p, l, mv, 3); const float* sc = modp(p, l, mv, 4);
    const float4* xr = (const float4*)((const float*)(p.ws + O_XA) + (size_t)t * 1024);
    float4 v[4]; float ss = 0.f;
#pragma unroll
    for (int i = 0; i < 4; ++i) { v[i] = xr[i * 64 + lane]; ss += v[i].x * v[i].x + v[i].y * v[i].y + v[i].z * v[i].z + v[i].w * v[i].w; }
    ss = wave_sum(ss);
    const float rstd = rsqrtf(ss * (1.f / 1024.f) + 1e-6f);
    u16* hr = (u16*)(p.ws + O_H) + (size_t)t * 1024;
    __syncthreads();
#pragma unroll
    for (int i = 0; i < 4; ++i) {
      int c = i * 256 + lane * 4;
      float4 gg = *(const float4*)(g + c), s4 = *(const float4*)(sc + c), h4 = *(const float4*)(sh + c);
      float4 o;
      o.x = v[i].x * rstd * gg.x * (1.f + s4.x) + h4.x; o.y = v[i].y * rstd * gg.y * (1.f + s4.y) + h4.y;
      o.z = v[i].z * rstd * gg.z * (1.f + s4.z) + h4.z; o.w = v[i].w * rstd * gg.w * (1.f + s4.w) + h4.w;
      u32x2 pk; pk[0] = pack2(o.x, o.y); pk[1] = pack2(o.z, o.w);
      *(u32x2*)(hr + c) = pk;
      *(float4*)(shh + c) = o;
    }
    __syncthreads();
    float logit = 0.f;
#pragma unroll 8
    for (int k = 0; k < 1024; ++k) logit += shh[k] * wr[k * 64 + lane];
    const float s = 1.f / (1.f + expf(-logit));
    const float c = s + bias;
    float m1 = c;
    m1 = fmaxf(m1, __shfl_xor(m1, 1)); m1 = fmaxf(m1, __shfl_xor(m1, 2)); m1 = fmaxf(m1, __shfl_xor(m1, 4));
    const unsigned long long bal = __ballot(c == m1);
    const int grp = lane >> 3;
    const unsigned gm = (unsigned)((bal >> (grp * 8)) & 0xffull);
    const int first = __ffs(gm) - 1;
    float m2 = ((lane & 7) == first) ? -INFINITY : c;
    m2 = fmaxf(m2, __shfl_xor(m2, 1)); m2 = fmaxf(m2, __shfl_xor(m2, 2)); m2 = fmaxf(m2, __shfl_xor(m2, 4));
    const float gs = m1 + m2;
    int grank = 0;
#pragma unroll
    for (int gg = 0; gg < 8; ++gg) { float o = __shfl(gs, gg * 8); grank += (o > gs || (o == gs && gg < grp)) ? 1 : 0; }
    const bool gsel = grank < 4;
    const float mc = gsel ? c : -INFINITY;
    int rank = 0;
#pragma unroll
    for (int e = 0; e < 64; ++e) { float o = __shfl(mc, e); rank += (o > mc || (o == mc && e < lane)) ? 1 : 0; }
    const bool sel = gsel && rank < 6;
    const float ssum = wave_sum(sel ? s : 0.f);
    if (sel) {
      const int slot = t * 6 + rank;
      WTS[slot] = s / ssum * 2.5f;
      const int pos = atomicAdd(&CNT[lane], 1);
      LIST[(size_t)lane * T + pos] = slot;
    }
  }
}
DEVI int find_expert(const int* TST, int tile) { int e = 0; while (e < 64 && tile >= TST[e + 1]) ++e; return e; }
DEVI void build_tst(const Params& p, int* tst) {
  __syncthreads();
  if (p.tid == 0) {
    const int* CNT = (const int*)(p.ws + O_CNT);
    int acc = 0;
    for (int e = 0; e < 64; ++e) { tst[e] = acc; acc += (CNT[e] + 127) >> 7; }
    tst[64] = acc; tst[65] = acc + T / 128;
  }
  __syncthreads();
}
DEVI void st_moe1(const Params& p, int vb, int nvb, char* smem) {
  const int* CNT = (const int*)(p.ws + O_CNT); const int* LIST = (const int*)(p.ws + O_LIST);
  const u16* H = (const u16*)(p.ws + O_H); u16* HB = (u16*)(p.ws + O_HB);
  int* sslot = (int*)(smem + 2 * 128 * GLD * 2);
  int* TST = sslot + 128;
  build_tst(p, TST);
  const int total = TST[65];
  for (int item = vb; item < total * 4; item += nvb) {
    const int tile = item >> 2, n0 = (item & 3) * 128;
    const int e = find_expert(TST, tile);
    const int lt = tile - TST[e];
    const int cnt = e < 64 ? CNT[e] : T;
    __syncthreads();
    if (p.tid < 128) {
      int i = lt * 128 + p.tid;
      int slot = -1;
      if (i < cnt) slot = e < 64 ? LIST[(size_t)e * T + i] : NSLOT + i;
      sslot[p.tid] = slot;
    }
    __syncthreads();
    gemm128(p.tid, [&](int r) { int sl = sslot[r]; int tk = sl < 0 ? 0 : (sl < NSLOT ? sl / 6 : sl - NSLOT); return H + (size_t)tk * 1024; },
            (const u16*)(p.ws + O_WGUT) + ((size_t)e * 512 + n0) * 1024, 1024, 1024,
            [&](int r, int c, f32x4 v) {
              int sl = sslot[r]; if (sl < 0) return;
              float h0 = siluf(v[0]) * v[1], h1 = siluf(v[2]) * v[3];
              *(unsigned*)(HB + (size_t)sl * 256 + ((n0 + c) >> 1)) = pack2(h0, h1);
            }, smem);
  }
}
DEVI void st_moe2(const Params& p, int vb, int nvb, char* smem) {
  const int* CNT = (const int*)(p.ws + O_CNT); const int* LIST = (const int*)(p.ws + O_LIST);
  const u16* HB = (const u16*)(p.ws + O_HB); u16* SO = (u16*)(p.ws + O_SLOT); const float* WTS = (const float*)(p.ws + O_WTS);
  int* sslot = (int*)(smem + 2 * 128 * GLD * 2);
  int* TST = sslot + 128;
  build_tst(p, TST);
  const int total = TST[64];
  for (int item = vb; item < total * 8; item += nvb) {
    const int tile = item >> 3, n0 = (item & 7) * 128;
    const int e = find_expert(TST, tile);
    const int lt = tile - TST[e];
    const int cnt = CNT[e];
    __syncthreads();
    if (p.tid < 128) { int i = lt * 128 + p.tid; sslot[p.tid] = i < cnt ? LIST[(size_t)e * T + i] : -1; }
    __syncthreads();
    gemm128(p.tid, [&](int r) { int sl = sslot[r]; return HB + (size_t)(sl < 0 ? 0 : sl) * 256; },
            (const u16*)(p.ws + O_WDT) + ((size_t)e * 1024 + n0) * 256, 256, 256,
            [&](int r, int c, f32x4 v) {
              int sl = sslot[r]; if (sl < 0) return;
              const float w = WTS[sl];
              u32x2 pk; pk[0] = pack2(v[0] * w, v[1] * w); pk[1] = pack2(v[2] * w, v[3] * w);
              *(u32x2*)(SO + (size_t)sl * 1024 + n0 + c) = pk;
            }, smem);
  }
}
DEVI void st_moe3(const Params& p, int l, int vb, int nvb, char* smem) {
  const u16* HB = (const u16*)(p.ws + O_HB); const u16* SO = (const u16*)(p.ws + O_SLOT); float* XA = (float*)(p.ws + O_XA);
  for (int item = vb; item < 132 * 8; item += nvb) {
    const int m0 = (item >> 3) * 128, n0 = (item & 7) * 128;
    gemm128(p.tid, [&](int r) { return HB + (size_t)(NSLOT + m0 + r) * 256; }, (const u16*)(p.ws + O_WDT) + ((size_t)64 * 1024 + n0) * 256, 256, 256,
            [&](int r, int c, f32x4 v) {
              const int t = m0 + r; const float* gt = modp(p, l, tok_mv(t), 5) + n0 + c;
              float a0 = 0.f, a1 = 0.f, a2 = 0.f, a3 = 0.f;
#pragma unroll
              for (int k = 0; k < 6; ++k) {
                u32x2 pk = *(const u32x2*)(SO + (size_t)(t * 6 + k) * 1024 + n0 + c);
                a0 += bf2f((u16)(pk[0] & 0xffff)); a1 += bf2f((u16)(pk[0] >> 16)); a2 += bf2f((u16)(pk[1] & 0xffff)); a3 += bf2f((u16)(pk[1] >> 16));
              }
              float4* xp = (float4*)(XA + (size_t)t * 1024 + n0 + c); float4 x = *xp;
              x.x += gt[0] * (a0 + v[0]); x.y += gt[1] * (a1 + v[1]); x.z += gt[2] * (a2 + v[2]); x.w += gt[3] * (a3 + v[3]); *xp = x;
              __builtin_amdgcn_sched_barrier(0);
            }, smem);
  }
}

DEVI void st_final(const Params& p, int vb, int nvb) {
  const int lane = p.tid & 63, wid = p.tid >> 6;
  const float* g = p.in[I_FNG];
  for (int t = vb * 4 + wid; t < TL; t += nvb * 4) {
    const float4* xr = (const float4*)((const float*)(p.ws + O_XA) + (size_t)t * 1024);
    float4 v[4]; float ss = 0.f;
#pragma unroll
    for (int i = 0; i < 4; ++i) { v[i] = xr[i * 64 + lane]; ss += v[i].x * v[i].x + v[i].y * v[i].y + v[i].z * v[i].z + v[i].w * v[i].w; }
    ss = wave_sum(ss);
    const float rstd = rsqrtf(ss * (1.f / 1024.f) + 1e-6f);
    float4* o = (float4*)(p.out + (size_t)t * 1024);
#pragma unroll
    for (int i = 0; i < 4; ++i) {
      float4 gg = *(const float4*)(g + i * 256 + lane * 4);
      float4 r; r.x = v[i].x * rstd * gg.x; r.y = v[i].y * rstd * gg.y; r.z = v[i].z * rstd * gg.z; r.w = v[i].w * rstd * gg.w;
      o[i * 64 + lane] = r;
    }
  }
}

constexpr int SMEM_BYTES = 80 * 1024;

DEVI unsigned long long launder_ptr(unsigned long long v) {
  unsigned lo = __builtin_amdgcn_readfirstlane((unsigned)v), hi = __builtin_amdgcn_readfirstlane((unsigned)(v >> 32));
  asm volatile("s_mov_b32 %0, %1" : "=s"(lo) : "s"(lo));
  asm volatile("s_mov_b32 %0, %1" : "=s"(hi) : "s"(hi));
  return ((unsigned long long)hi << 32) | lo;
}
DEVI Params mkctx(const KArgs& a) {
  Params c;
  c.ws = (char*)launder_ptr((unsigned long long)a.ws);
  c.out = (float*)launder_ptr((unsigned long long)a.out);
  c.in = (const float* const*)(c.ws + O_TAB);
  c.tid = threadIdx.x;
  asm volatile("" : "+v"(c.tid));
  return c;
}
#define STAGE(call) { const Params p = mkctx(a); call; }

__global__ void __launch_bounds__(256, 2) mega(KArgs a) {
  extern __shared__ __attribute__((aligned(16))) char smem[];
  cg::grid_group grid = cg::this_grid();
  const int vb = blockIdx.x, nvb = gridDim.x;
  if (threadIdx.x == 0) {
    const float** tab = (const float**)(a.ws + O_TAB);
#pragma unroll
    for (int i = 0; i < 35; ++i) tab[i] = a.in[i];
  }
  __syncthreads();
  STAGE(st_copy_in(p, vb, nvb));
  STAGE(st_mod(p, vb, nvb, smem));
  grid.sync();
  for (int l = 0; l < 2; ++l) {
    STAGE(st_prep_w(p, l, vb, nvb, smem));
    STAGE(st_norm1(p, l, vb, nvb));
    grid.sync();
    STAGE(st_inproj(p, vb, nvb, smem));
    grid.sync();
    STAGE(st_scatter(p, l, vb, nvb));
    grid.sync();
    STAGE(st_mla_up(p, vb, nvb, smem));
    grid.sync();
    STAGE(st_mla_scatter(p, vb, nvb));
    grid.sync();
    STAGE(st_attn(p, l, vb, nvb, smem));
    grid.sync();
    STAGE(st_gdn_prep(p, l, vb, nvb));
    grid.sync();
    STAGE(st_gdn_chunk(p, vb, nvb, smem));
    grid.sync();
    STAGE(st_gdn_scan(p, vb, nvb, smem));
    grid.sync();
    STAGE(st_gdn_out(p, l, vb, nvb));
    grid.sync();
    STAGE(st_outproj(p, l, vb, nvb, smem));
    grid.sync();
    STAGE(st_norm2_route(p, l, vb, nvb, smem));
    grid.sync();
    STAGE(st_moe1(p, vb, nvb, smem));
    grid.sync();
    STAGE(st_moe2(p, vb, nvb, smem));
    grid.sync();
    STAGE(st_moe3(p, l, vb, nvb, smem));
    grid.sync();
  }
  STAGE(st_final(p, vb, nvb));
}

extern "C" void kernel_launch(void* const* d_in, const int* in_sizes, int n_in, void* d_out, int out_size, void* d_ws, size_t ws_size,
                              hipStream_t stream) {
  static int grid_blocks = 0;
  if (!grid_blocks) {
    int dev = 0, cus = 0, per_cu = 0;
    (void)hipGetDevice(&dev);
    (void)hipDeviceGetAttribute(&cus, hipDeviceAttributeMultiprocessorCount, dev);
    (void)hipFuncSetAttribute((const void*)mega, hipFuncAttributeMaxDynamicSharedMemorySize, SMEM_BYTES);
    (void)hipOccupancyMaxActiveBlocksPerMultiprocessor(&per_cu, mega, 256, SMEM_BYTES);
    if (per_cu > 2) per_cu = 2;
    if (per_cu < 1) per_cu = 1;
    grid_blocks = cus * per_cu;
  }
  KArgs p{};
  for (int i = 0; i < 35; ++i) p.in[i] = (const float*)d_in[i];
  p.out = (float*)d_out; p.ws = (char*)d_ws;
  if (ws_size < WS_NEED) { fprintf(stderr, "workspace too small: %zu < %zu\n", ws_size, (size_t)WS_NEED); return; }
  void* args[] = {&p};
  hipError_t e = hipLaunchCooperativeKernel((void*)mega, dim3(grid_blocks), dim3(256), args, SMEM_BYTES, stream);
  if (e != hipSuccess) fprintf(stderr, "cooperative launch failed: %s (grid %d)\n", hipGetErrorString(e), grid_blocks);
}
```

```cpp
#include <hip/hip_runtime.h>
#include <hip/hip_cooperative_groups.h>
#include <cstdio>
#include <cstdint>
namespace cg = cooperative_groups;

#define DEVI __device__ __forceinline__
typedef unsigned short u16;
using bf16x8 = __attribute__((ext_vector_type(8))) short;
using f32x4  = __attribute__((ext_vector_type(4))) float;
using f32x2  = __attribute__((ext_vector_type(2))) float;
using f32x16 = __attribute__((ext_vector_type(16))) float;
using u32x4 = __attribute__((ext_vector_type(4))) unsigned;
using u32x2 = __attribute__((ext_vector_type(2))) unsigned;
typedef __bf16 bf16x2_t __attribute__((ext_vector_type(2)));

constexpr int DM = 1024, SEQ = 8192, CTXL = 256, NKEY = SEQ + CTXL;
constexpr int TL = 2 * SEQ, TC = 2 * CTXL, T = TL + TC;
constexpr int INW = 2672;
constexpr int NIN = 2816;
constexpr int LDPP = 1408;
constexpr int PP_CQ = 0, PP_CKV = 192, PP_DQKV = 320, PP_DZ = 1088, PP_GATE = 1344;
constexpr int NE = 64, NSLOT = 6 * T;
constexpr int NCHUNK = T / 64;
constexpr int NGITEM = NCHUNK * 8;
constexpr float LOG2E = 1.4426950408889634f;

constexpr size_t al256(size_t x) { return (x + 255) & ~(size_t)255; }
constexpr size_t O_MOD   = 0;
constexpr size_t O_ROPE  = O_MOD + al256((size_t)2 * 3 * 6144 * 4);
constexpr size_t O_XA    = O_ROPE + (size_t)SEQ * 48 * 8;
constexpr size_t O_H     = O_XA + (size_t)T * DM * 4;
constexpr size_t O_Y     = O_H + (size_t)T * DM * 2;
constexpr size_t O_WINT  = O_Y + (size_t)T * DM * 2;
constexpr size_t O_WOUTT = O_WINT + (size_t)NIN * 1024 * 2;
constexpr size_t O_WUQT  = O_WOUTT + (size_t)1024 * 1024 * 2;
constexpr size_t O_WUKVT = O_WUQT + (size_t)384 * 192 * 2;
constexpr size_t O_WGUT  = O_WUKVT + (size_t)512 * 128 * 2;
constexpr size_t O_WDT   = O_WGUT + (size_t)65 * 512 * 1024 * 2;
constexpr size_t O_WTS   = O_WDT + (size_t)65 * 1024 * 256 * 2;
constexpr size_t O_CNT   = O_WTS + al256((size_t)NSLOT * 4);
constexpr size_t O_TAB   = O_CNT + 256;
constexpr size_t O_BAR   = O_TAB + 512;
constexpr size_t O_LIST  = O_BAR + 256;
constexpr size_t O_R     = O_LIST + (size_t)NE * T * 4;
constexpr size_t O_PP    = O_R;
constexpr size_t O_QA    = O_PP + (size_t)T * LDPP * 2;
constexpr size_t O_KA    = O_QA + (size_t)2 * 4 * NKEY * 64 * 2;
constexpr size_t O_VTA   = O_KA + (size_t)2 * 2 * NKEY * 64 * 2;
constexpr size_t O_QB    = O_VTA + (size_t)2 * 2 * NKEY * 64 * 2;
constexpr size_t O_KB    = O_QB + (size_t)2 * 8 * NKEY * 32 * 2;
constexpr size_t O_VTB   = O_KB + (size_t)2 * 8 * NKEY * 32 * 2;
constexpr size_t O_QC    = O_VTB + (size_t)2 * 4 * NKEY * 64 * 2;
constexpr size_t O_KC    = O_QC + (size_t)2 * 4 * NKEY * 96 * 2;
constexpr size_t O_VTC   = O_KC + (size_t)2 * 4 * NKEY * 96 * 2;
constexpr size_t O_CQN   = O_VTC + (size_t)2 * 4 * NKEY * 64 * 2;
constexpr size_t O_CKVN  = O_CQN + (size_t)T * 192 * 2;
constexpr size_t O_OB    = O_CKVN + (size_t)T * 128 * 2;
constexpr size_t O_GQ    = O_OB + (size_t)T * 512 * 2;
constexpr size_t O_GK    = O_GQ + (size_t)T * 256 * 2;
constexpr size_t O_GV    = O_GK + (size_t)T * 256 * 2;
constexpr size_t O_GG    = O_GV + (size_t)T * 256 * 2;
constexpr size_t O_GBETA = O_GG + (size_t)2 * T * 4 * 4;
constexpr size_t O_GM    = O_GBETA + (size_t)2 * T * 4 * 4;
constexpr size_t O_GQP   = O_GM + (size_t)NGITEM * 4096 * 2;
constexpr size_t O_GN    = O_GQP + (size_t)NGITEM * 4096 * 2;
constexpr size_t O_GLO   = O_GN + (size_t)NGITEM * 4096 * 2;
constexpr size_t O_GO    = O_GLO + (size_t)NGITEM * 4096 * 2;
constexpr size_t O_MIX_END = O_GO + (size_t)2 * T * 256 * 4;
constexpr size_t O_HB    = O_R;
constexpr size_t O_SLOT  = O_HB + (size_t)7 * T * 256 * 2;
constexpr size_t O_MOE_END = O_SLOT + (size_t)NSLOT * 1024 * 2;
constexpr size_t cmax(size_t a, size_t b) { return a > b ? a : b; }
constexpr size_t WS_NEED = cmax(O_MIX_END, O_MOE_END);
static_assert(WS_NEED < (size_t)556000000, "workspace too large");

struct KArgs {
  const float* in[35];
  float* out;
  char* ws;
};
struct Params {
  char* ws;
  float* out;
  const float* const* in;
  int tid;
};
enum { I_X = 0, I_C, I_CTX, I_CCTX, I_WADA, I_BADA, I_N1G, I_N2G, I_WIN, I_WOUT, I_SINK, I_LQ1, I_LK1, I_LQ2, I_LK2,
       I_DNG, I_MQG, I_MKVG, I_WUQ, I_WUKV, I_CONVW, I_ALF, I_ALB, I_DTF, I_DTB, I_GNG, I_WR, I_RB, I_WG, I_WU, I_WD,
       I_SG, I_SU, I_SD, I_FNG };

DEVI u16 f2bf(float f) { unsigned u = __float_as_uint(f); u += 0x7fffu + ((u >> 16) & 1u); return (u16)(u >> 16); }
DEVI float bf2f(u16 h) { return __uint_as_float(((unsigned)h) << 16); }
DEVI float bflo(unsigned v) { return __uint_as_float(v << 16); }
DEVI float bfhi(unsigned v) { return __uint_as_float(v & 0xffff0000u); }
DEVI unsigned pack2(float a, float b) { f32x2 v = {a, b}; return __builtin_bit_cast(unsigned, __builtin_convertvector(v, bf16x2_t)); }
DEVI float wave_sum(float v) {
#pragma unroll
  for (int o = 32; o >= 1; o >>= 1) v += __shfl_xor(v, o);
  return v;
}
DEVI float half_sum(float v) {
#pragma unroll
  for (int o = 16; o >= 1; o >>= 1) v += __shfl_xor(v, o);
  return v;
}
DEVI float siluf(float x) { return x / (1.f + __expf(-x)); }
DEVI float sigmf(float x) { return 1.f / (1.f + __expf(-x)); }
DEVI int tok_mv(int t) { return t < TL ? (t >> 13) : 2; }
DEVI int tok_b(int t) { return t < TL ? (t >> 13) : ((t - TL) >> 8); }
DEVI int tok_row(int t) { return t < TL ? (t & (SEQ - 1)) : (SEQ + ((t - TL) & (CTXL - 1))); }
DEVI const float* modp(const Params& p, int l, int mv, int j) { return (const float*)(p.ws + O_MOD) + ((size_t)(l * 3 + mv) * 6 + j) * 1024; }

#define MFMA16(a, b, c) __builtin_amdgcn_mfma_f32_16x16x32_bf16((a), (b), (c), 0, 0, 0)
#define MFMA32(a, b, c) __builtin_amdgcn_mfma_f32_32x32x16_bf16((a), (b), (c), 0, 0, 0)

DEVI void st_copy_in(const Params& p, int vb, int nvb) {
  float4* xa = (float4*)(p.ws + O_XA);
  const float4* x = (const float4*)p.in[I_X];
  const float4* cx = (const float4*)p.in[I_CTX];
  const size_t n4 = (size_t)T * DM / 4, nl4 = (size_t)TL * DM / 4;
  for (size_t i = (size_t)vb * 256 + p.tid; i < n4; i += (size_t)nvb * 256) xa[i] = i < nl4 ? x[i] : cx[i - nl4];
}
DEVI void rope_cs(int i, int half, int s, float& c, float& sn) {
  const int quarter = half >> 1;
  const int ii = i < quarter ? i : i - quarter;
  const float pos = i < quarter ? (float)(s >> 6) : (float)(s & 63);
  const float inv = powf(10000.f, -(float)ii / (float)quarter);
  const float ang = pos * inv;
  c = cosf(ang); sn = sinf(ang);
}
DEVI void st_rope_table(const Params& p, int vb, int nvb) {
  f32x2* R = (f32x2*)(p.ws + O_ROPE);
  for (int e = vb * 256 + p.tid; e < SEQ * 48; e += nvb * 256) {
    const int s = e / 48, i = e % 48;
    float c, sn;
    if (i < 32) rope_cs(i, 32, s, c, sn); else rope_cs(i - 32, 16, s, c, sn);
    R[e] = f32x2{c, sn};
  }
}
DEVI void st_mod(const Params& p, int vb, int nvb, char* smem) {
  float* sv = (float*)smem;
  float* red = sv + 3 * 1024;
  for (int i = p.tid; i < 3 * 1024; i += 256) {
    int v = i >> 10, k = i & 1023;
    float c = v < 2 ? p.in[I_C][v * 1024 + k] : p.in[I_CCTX][k];
    sv[i] = siluf(c);
  }
  __syncthreads();
  const int cgp = p.tid & 7, kg = p.tid >> 3;
  for (int item = vb; item < 2 * 192; item += nvb) {
    const int l = item / 192, c0 = (item % 192) * 32;
    const float* w = p.in[I_WADA] + (size_t)l * 1024 * 6144 + c0 + cgp * 4;
    f32x4 a0 = {0.f, 0.f, 0.f, 0.f}, a1 = a0, a2 = a0;
#pragma unroll 8
    for (int kk = 0; kk < 32; ++kk) {
      const int k = kg * 32 + kk;
      const f32x4 wv = *(const f32x4*)(w + (size_t)k * 6144);
      a0 += sv[k] * wv; a1 += sv[1024 + k] * wv; a2 += sv[2048 + k] * wv;
    }
    float* rp = red + (kg * 8 + cgp) * 12;
    *(f32x4*)rp = a0; *(f32x4*)(rp + 4) = a1; *(f32x4*)(rp + 8) = a2;
    __syncthreads();
    if (p.tid < 96) {
      const int v = p.tid >> 5, c = p.tid & 31;
      float s = 0.f;
#pragma unroll 8
      for (int g = 0; g < 32; ++g) s += red[(g * 8 + (c >> 2)) * 12 + v * 4 + (c & 3)];
      ((float*)(p.ws + O_MOD))[(size_t)(l * 3 + v) * 6144 + c0 + c] = s + p.in[I_BADA][l * 6144 + c0 + c];
    }
    __syncthreads();
  }
}

template <class RowFn>
DEVI void tr_tile(int tid, const float* __restrict__ src, int N, u16* __restrict__ dst, int ldd, RowFn drow, int k0, int n0, float* tile) {
  const int tx = tid & 63, ty = tid >> 6;
#pragma unroll 4
  for (int r = 0; r < 16; ++r) {
    int k = r * 4 + ty, n = n0 + tx;
    tile[k * 65 + tx] = n < N ? src[(size_t)(k0 + k) * N + n] : 0.f;
  }
  __syncthreads();
#pragma unroll 4
  for (int r = 0; r < 16; ++r) {
    int n = r * 4 + ty;
    const int dr = drow(n0 + n);
    if (dr >= 0) dst[(size_t)dr * ldd + k0 + tx] = f2bf(tile[tx * 65 + n]);
  }
  __syncthreads();
}
DEVI int win_row(int n) {
  if (n < 1280) return n;
  if (n < 1600) return 1408 + (n - 1280);
  if (n < 1632) return 1280 + (n - 1600);
  if (n < INW) return 1408 + 320 + (n - 1632);
  return -1;
}
constexpr int TR_IN = 16 * 42, TR_OUT = 256, TR_UQ = 18, TR_UKV = 16, TR_E = 4096, TR_S = 64;
constexpr int TR_P1 = TR_IN + TR_OUT + TR_UQ + TR_UKV;
constexpr int TR_P2 = 3 * TR_E + 3 * TR_S;
DEVI void prep_w1_tile(const Params& p, int l, int it, float* tile) {
  if (it < TR_IN) { tr_tile(p.tid, p.in[I_WIN] + (size_t)l * 1024 * INW, INW, (u16*)(p.ws + O_WINT), 1024, [](int n) { return win_row(n); }, (it / 42) * 64, (it % 42) * 64, tile); return; }
  it -= TR_IN;
  if (it < TR_OUT) { tr_tile(p.tid, p.in[I_WOUT] + (size_t)l * 1024 * 1024, 1024, (u16*)(p.ws + O_WOUTT), 1024, [](int n) { return n; }, (it / 16) * 64, (it % 16) * 64, tile); return; }
  it -= TR_OUT;
  if (it < TR_UQ) { tr_tile(p.tid, p.in[I_WUQ] + (size_t)l * 192 * 384, 384, (u16*)(p.ws + O_WUQT), 192, [](int n) { return n; }, (it / 6) * 64, (it % 6) * 64, tile); return; }
  it -= TR_UQ;
  tr_tile(p.tid, p.in[I_WUKV] + (size_t)l * 128 * 512, 512, (u16*)(p.ws + O_WUKVT), 128,
          [](int n) { const int h = n >> 7, j = n & 127; return j < 64 ? h * 64 + j : 256 + h * 64 + (j - 64); }, (it / 8) * 64, (it % 8) * 64, tile);
}
DEVI void prep_w2_tile(const Params& p, int l, int it, float* tile) {
  if (it < 2 * TR_E) {
    const int which = it / TR_E; it %= TR_E;
    const int e = it >> 6, tt = it & 63;
    const float* src = p.in[which ? I_WU : I_WG] + ((size_t)l * NE + e) * 1024 * 256;
    tr_tile(p.tid, src, 256, (u16*)(p.ws + O_WGUT) + (size_t)e * 512 * 1024, 1024, [which](int n) { return 2 * n + which; }, (tt >> 2) * 64, (tt & 3) * 64, tile); return;
  }
  it -= 2 * TR_E;
  if (it < TR_E) {
    const int e = it >> 6, tt = it & 63;
    const float* src = p.in[I_WD] + ((size_t)l * NE + e) * 256 * 1024;
    tr_tile(p.tid, src, 1024, (u16*)(p.ws + O_WDT) + (size_t)e * 1024 * 256, 256, [](int n) { return n; }, (tt >> 4) * 64, (tt & 15) * 64, tile); return;
  }
  it -= TR_E;
  if (it < 2 * TR_S) {
    const int which = it / TR_S; const int tt = it % TR_S;
    const float* src = p.in[which ? I_SU : I_SG] + (size_t)l * 1024 * 256;
    tr_tile(p.tid, src, 256, (u16*)(p.ws + O_WGUT) + (size_t)64 * 512 * 1024, 1024, [which](int n) { return 2 * n + which; }, (tt >> 2) * 64, (tt & 3) * 64, tile); return;
  }
  it -= 2 * TR_S;
  { const int tt = it;
    const float* src = p.in[I_SD] + (size_t)l * 256 * 1024;
    tr_tile(p.tid, src, 1024, (u16*)(p.ws + O_WDT) + (size_t)64 * 1024 * 256, 256, [](int n) { return n; }, (tt >> 4) * 64, (tt & 15) * 64, tile); }
}
DEVI void st_prep_w1(const Params& p, int l, int vb, int nvb, char* smem) {
  float* tile = (float*)smem;
  if (vb == 0 && p.tid < 64) ((int*)(p.ws + O_CNT))[p.tid] = 0;
  for (int e = vb * 256 + p.tid; e < 144 * 128; e += nvb * 256) {
    const int r = e >> 7, c8 = e & 127;
    const int row = r < 96 ? 1312 + r : 2768 + (r - 96);
    *(u32x4*)((u16*)(p.ws + O_WINT) + (size_t)row * 1024 + c8 * 8) = u32x4{0u, 0u, 0u, 0u};
  }
  for (int item = vb; item < TR_P1; item += nvb) prep_w1_tile(p, l, item, tile);
}

DEVI void st_norm1(const Params& p, int l, int vb, int nvb) {
  const int lane = p.tid & 63, wid = p.tid >> 6;
  const float* g = p.in[I_N1G] + l * 1024;
  for (int t4 = (vb * 4 + wid) * 4; t4 < T; t4 += nvb * 16) {
    const int mv = tok_mv(t4);
    const float* sh = modp(p, l, mv, 0); const float* sc = modp(p, l, mv, 1);
    f32x4 v[4][4]; float ss[4];
#pragma unroll
    for (int u = 0; u < 4; ++u) {
      const f32x4* xr = (const f32x4*)((const float*)(p.ws + O_XA) + (size_t)(t4 + u) * 1024);
#pragma unroll
      for (int i = 0; i < 4; ++i) v[u][i] = xr[i * 64 + lane];
    }
#pragma unroll
    for (int u = 0; u < 4; ++u) {
      float a = 0.f;
#pragma unroll
      for (int i = 0; i < 4; ++i) a += v[u][i][0] * v[u][i][0] + v[u][i][1] * v[u][i][1] + v[u][i][2] * v[u][i][2] + v[u][i][3] * v[u][i][3];
      ss[u] = a;
    }
#pragma unroll
    for (int o = 32; o >= 1; o >>= 1) {
#pragma unroll
      for (int u = 0; u < 4; ++u) ss[u] += __shfl_xor(ss[u], o);
    }
#pragma unroll
    for (int i = 0; i < 4; ++i) {
      const int c = i * 256 + lane * 4;
      const f32x4 gg = *(const f32x4*)(g + c), s4 = *(const f32x4*)(sc + c), h4 = *(const f32x4*)(sh + c);
      const f32x4 gs = gg * (1.f + s4);
#pragma unroll
      for (int u = 0; u < 4; ++u) {
        const float rstd = rsqrtf(ss[u] * (1.f / 1024.f) + 1e-6f);
        const f32x4 o = v[u][i] * rstd * gs + h4;
        u32x2 pk; pk[0] = pack2(o[0], o[1]); pk[1] = pack2(o[2], o[3]);
        *(u32x2*)((u16*)(p.ws + O_H) + (size_t)(t4 + u) * 1024 + c) = pk;
      }
    }
  }
}

constexpr int GLD = 72;
template <bool SWAP, class ARow>
DEVI void gemm_core(int tid, ARow arow, const u16* __restrict__ Bt, int ldb, int K, f32x4 (&acc)[4][4], char* smem) {
  u16* sA = (u16*)smem; u16* sB = sA + 128 * GLD;
  const int lane = tid & 63, wid = tid >> 6, wr = wid >> 1, wc = wid & 1, fr = lane & 15, fq = lane >> 4;
  const u16* ap[4]; const u16* bp[4];
#pragma unroll
  for (int i = 0; i < 4; ++i) { int q = tid + 256 * i, row = q >> 3, cc = q & 7; ap[i] = arow(row) + cc * 8; bp[i] = Bt + (size_t)row * ldb + cc * 8; }
  u32x4 ra[4], rb[4];
#pragma unroll
  for (int i = 0; i < 4; ++i) { ra[i] = *(const u32x4*)ap[i]; rb[i] = *(const u32x4*)bp[i]; }
#pragma unroll
  for (int m = 0; m < 4; ++m)
#pragma unroll
    for (int n = 0; n < 4; ++n) acc[m][n] = f32x4{0.f, 0.f, 0.f, 0.f};
  const int nk = K >> 6;
  for (int kt = 0; kt < nk; ++kt) {
    __syncthreads();
#pragma unroll
    for (int i = 0; i < 4; ++i) { int q = tid + 256 * i, row = q >> 3, cc = q & 7; *(u32x4*)&sA[row * GLD + cc * 8] = ra[i]; *(u32x4*)&sB[row * GLD + cc * 8] = rb[i]; }
    __syncthreads();
    if (kt + 1 < nk) {
#pragma unroll
      for (int i = 0; i < 4; ++i) { ra[i] = *(const u32x4*)(ap[i] + (kt + 1) * 64); rb[i] = *(const u32x4*)(bp[i] + (kt + 1) * 64); }
    }
#pragma unroll
    for (int ks = 0; ks < 2; ++ks) {
      bf16x8 af[4], bfr[4];
#pragma unroll
      for (int m = 0; m < 4; ++m) af[m] = *(const bf16x8*)&sA[(wr * 64 + m * 16 + fr) * GLD + ks * 32 + fq * 8];
#pragma unroll
      for (int n = 0; n < 4; ++n) bfr[n] = *(const bf16x8*)&sB[(wc * 64 + n * 16 + fr) * GLD + ks * 32 + fq * 8];
#pragma unroll
      for (int m = 0; m < 4; ++m)
#pragma unroll
        for (int n = 0; n < 4; ++n) acc[m][n] = SWAP ? MFMA16(af[m], bfr[n], acc[m][n]) : MFMA16(bfr[n], af[m], acc[m][n]);
    }
  }
  __syncthreads();
}
template <class ARow, class Epi>
DEVI void gemm128(int tid, ARow arow, const u16* __restrict__ Bt, int ldb, int K, Epi epi, char* smem) {
  f32x4 acc[4][4];
  gemm_core<false>(tid, arow, Bt, ldb, K, acc, smem);
  const int lane = tid & 63, wid = tid >> 6, wr = wid >> 1, wc = wid & 1, fr = lane & 15, fq = lane >> 4;
#pragma unroll
  for (int m = 0; m < 4; ++m)
#pragma unroll
    for (int n = 0; n < 4; ++n) epi(wr * 64 + m * 16 + fr, wc * 64 + n * 16 + fq * 4, acc[m][n]);
}

DEVI void rope4(const f32x4 x1, const f32x4 x2, const f32x2* rp, bool lat, float scale, u32x2& o1, u32x2& o2) {
  f32x4 c = {1.f, 1.f, 1.f, 1.f}, s = {0.f, 0.f, 0.f, 0.f};
  if (lat) {
    const f32x4 a = *(const f32x4*)rp, b = *(const f32x4*)(rp + 2);
    c = f32x4{a[0], a[2], b[0], b[2]}; s = f32x4{a[1], a[3], b[1], b[3]};
  }
  const f32x4 y1 = (x1 * c - x2 * s) * scale, y2 = (x2 * c + x1 * s) * scale;
  o1[0] = pack2(y1[0], y1[1]); o1[1] = pack2(y1[2], y1[3]);
  o2[0] = pack2(y2[0], y2[1]); o2[1] = pack2(y2[2], y2[3]);
}
DEVI void inproj_item(const Params& p, int item, char* smem) {
  const u16* H = (const u16*)(p.ws + O_H); const u16* W = (const u16*)(p.ws + O_WINT);
  const f32x2* ROPE = (const f32x2*)(p.ws + O_ROPE);
  const int tid = p.tid, lane = tid & 63, wid = tid >> 6, wr = wid >> 1, wc = wid & 1, fr = lane & 15, fq = lane >> 4;
  {
    const int m0 = (item / 22) * 128, nt = item % 22;
    const bool lat = m0 < TL;
    const int b = tok_b(m0), rowbase = tok_row(m0);
    f32x4 acc[4][4];
    auto arow = [&](int r) { return H + (size_t)(m0 + r) * 1024; };
    if (nt == 3 || nt == 8 || nt == 9) {
      gemm_core<true>(tid, arow, W + (size_t)nt * 128 * 1024, 1024, 1024, acc, smem);
      u16* vt = nt == 3 ? (u16*)(p.ws + O_VTA) + (size_t)(b * 2 + wc) * 64 * NKEY
                        : (u16*)(p.ws + O_VTB) + (size_t)(b * 4 + (nt - 8) * 2 + wc) * 64 * NKEY;
#pragma unroll
      for (int m = 0; m < 4; ++m)
#pragma unroll
        for (int n = 0; n < 4; ++n) {
          u32x2 pk; pk[0] = pack2(acc[m][n][0], acc[m][n][1]); pk[1] = pack2(acc[m][n][2], acc[m][n][3]);
          *(u32x2*)(vt + (size_t)(n * 16 + fr) * NKEY + rowbase + wr * 64 + m * 16 + fq * 4) = pk;
        }
      return;
    }
    gemm_core<false>(tid, arow, W + (size_t)nt * 128 * 1024, 1024, 1024, acc, smem);
    if (nt < 3) {
      u16* dst; float scale;
      if (nt < 2) { dst = (u16*)(p.ws + O_QA) + ((size_t)(b * 4 + nt * 2 + wc) * NKEY + rowbase) * 64; scale = 0.125f * LOG2E; }
      else { dst = (u16*)(p.ws + O_KA) + ((size_t)(b * 2 + wc) * NKEY + rowbase) * 64; scale = 1.f; }
#pragma unroll
      for (int m = 0; m < 4; ++m) {
        const int rl = wr * 64 + m * 16 + fr;
#pragma unroll
        for (int pi = 0; pi < 2; ++pi) {
          const int d0 = pi * 16 + fq * 4;
          u32x2 o1, o2;
          rope4(acc[m][pi], acc[m][pi + 2], ROPE + (size_t)(rowbase + rl) * 48 + d0, lat, scale, o1, o2);
          *(u32x2*)(dst + (size_t)rl * 64 + d0) = o1; *(u32x2*)(dst + (size_t)rl * 64 + 32 + d0) = o2;
        }
      }
    } else if (nt < 8) {
      const bool isq = nt < 6;
      u16* base = isq ? (u16*)(p.ws + O_QB) : (u16*)(p.ws + O_KB);
      const float scale = isq ? 0.17677669529663687f * LOG2E : 1.f;
      const int hm0 = ((nt - 4) & 1) * 4 + wc * 2;
#pragma unroll
      for (int m = 0; m < 4; ++m) {
        const int rl = wr * 64 + m * 16 + fr;
#pragma unroll
        for (int g = 0; g < 2; ++g) {
          u16* dst = base + ((size_t)(b * 8 + hm0 + g) * NKEY + rowbase + rl) * 32;
          u32x2 o1, o2;
          rope4(acc[m][2 * g], acc[m][2 * g + 1], ROPE + (size_t)(rowbase + rl) * 48 + 32 + fq * 4, lat, scale, o1, o2);
          *(u32x2*)(dst + fq * 4) = o1; *(u32x2*)(dst + 16 + fq * 4) = o2;
        }
      }
    } else if (nt == 10) {
      if (wc == 0) {
#pragma unroll
        for (int m = 0; m < 4; ++m) {
          const int rl = wr * 64 + m * 16 + fr;
          u32x2 o1, o2;
          rope4(acc[m][0], acc[m][1], ROPE + (size_t)(rowbase + rl) * 48 + 32 + fq * 4, lat, 1.f, o1, o2);
#pragma unroll
          for (int h = 0; h < 4; ++h) {
            u16* dst = (u16*)(p.ws + O_KC) + ((size_t)(b * 4 + h) * NKEY + rowbase + rl) * 96 + 64;
            *(u32x2*)(dst + fq * 4) = o1; *(u32x2*)(dst + 16 + fq * 4) = o2;
          }
        }
      }
    } else {
      u16* PP = (u16*)(p.ws + O_PP);
#pragma unroll
      for (int m = 0; m < 4; ++m)
#pragma unroll
        for (int n = 0; n < 4; ++n) {
          u32x2 pk; pk[0] = pack2(acc[m][n][0], acc[m][n][1]); pk[1] = pack2(acc[m][n][2], acc[m][n][3]);
          *(u32x2*)(PP + (size_t)(m0 + wr * 64 + m * 16 + fr) * LDPP + (nt - 11) * 128 + wc * 64 + n * 16 + fq * 4) = pk;
        }
    }
  }
}

DEVI void st_tokprep(const Params& p, int l, int vb, int nvb) {
  const int lane = p.tid & 63, wid = p.tid >> 6;
  const u16* PP = (const u16*)(p.ws + O_PP);
  u16* GQ = (u16*)(p.ws + O_GQ); u16* GK = (u16*)(p.ws + O_GK); u16* GV = (u16*)(p.ws + O_GV);
  float* GG = (float*)(p.ws + O_GG); float* GB = (float*)(p.ws + O_GBETA);
  u16* CQN = (u16*)(p.ws + O_CQN); u16* CKVN = (u16*)(p.ws + O_CKVN);
  const float* cwp = p.in[I_CONVW] + (size_t)l * 5 * 768;
  f32x2 cw[6][5];
#pragma unroll
  for (int i = 0; i < 6; ++i)
#pragma unroll
    for (int j = 0; j < 5; ++j) cw[i][j] = *(const f32x2*)(cwp + j * 768 + 2 * lane + 128 * i);
  const float* gq = p.in[I_MQG] + l * 192; const float* gkv = p.in[I_MKVG] + l * 128;
  const float gq0 = gq[lane], gq1 = gq[64 + lane], gq2 = gq[128 + lane], gk0 = gkv[lane], gk1 = gkv[64 + lane];
  for (int t = vb * 4 + wid; t < T; t += nvb * 4) {
    int base, pos, len;
    if (t < TL) { base = t & ~(SEQ - 1); pos = t & (SEQ - 1); len = SEQ; } else { int j = t - TL; base = TL + (j & ~(CTXL - 1)); pos = j & (CTXL - 1); len = CTXL; }
    unsigned xin[5][6];
#pragma unroll
    for (int j = 0; j < 5; ++j) {
      const int pp = pos + j - 2;
      const bool ok = pp >= 0 && pp < len;
      const u16* row = PP + (size_t)(base + (ok ? pp : pos)) * LDPP + PP_DQKV + 2 * lane;
#pragma unroll
      for (int i = 0; i < 6; ++i) { unsigned v = *(const unsigned*)(row + 128 * i); xin[j][i] = ok ? v : 0u; }
    }
    const u16* pr = PP + (size_t)t * LDPP;
    const float q0 = bf2f(pr[PP_CQ + lane]), q1 = bf2f(pr[PP_CQ + 64 + lane]), q2 = bf2f(pr[PP_CQ + 128 + lane]);
    const float k0 = bf2f(pr[PP_CKV + lane]), k1 = bf2f(pr[PP_CKV + 64 + lane]);
    const float gate_in = lane < 16 ? bf2f(pr[PP_GATE + lane]) : 0.f;
#pragma unroll
    for (int i = 0; i < 6; ++i) {
      float a0 = 0.f, a1 = 0.f;
#pragma unroll
      for (int j = 0; j < 5; ++j) { a0 += cw[i][j][0] * bflo(xin[j][i]); a1 += cw[i][j][1] * bfhi(xin[j][i]); }
      float y0 = siluf(a0), y1 = siluf(a1);
      const int c = 2 * lane + 128 * i;
      if (i < 4) {
        const float ss = half_sum(y0 * y0 + y1 * y1);
        const float r = rsqrtf(ss + 1e-6f) * (i < 2 ? 0.125f : 1.f);
        u16* dst = i < 2 ? GQ + (size_t)t * 256 + c : GK + (size_t)t * 256 + (c - 256);
        *(unsigned*)dst = pack2(y0 * r, y1 * r);
      } else *(unsigned*)(GV + (size_t)t * 256 + (c - 512)) = pack2(y0, y1);
    }
    if (lane < 16) {
      const int which = lane >> 2, hd = lane & 3;
      if (which < 2) {
        const float al = which ? p.in[I_ALB][l * 4 + hd] : p.in[I_ALF][l * 4 + hd];
        const float dt = which ? p.in[I_DTB][l * 4 + hd] : p.in[I_DTF][l * 4 + hd];
        const float xx = gate_in + dt;
        const float sp = fmaxf(xx, 0.f) + log1pf(expf(-fabsf(xx)));
        GG[((size_t)which * T + t) * 4 + hd] = -expf(al) * sp;
      } else GB[((size_t)(which - 2) * T + t) * 4 + hd] = sigmf(gate_in);
    }
    {
      float ss = q0 * q0 + q1 * q1 + q2 * q2, s2 = k0 * k0 + k1 * k1;
#pragma unroll
      for (int o = 32; o >= 1; o >>= 1) { ss += __shfl_xor(ss, o); s2 += __shfl_xor(s2, o); }
      const float rs = rsqrtf(ss * (1.f / 192.f) + 1e-6f), r2 = rsqrtf(s2 * (1.f / 128.f) + 1e-6f);
      u16* d = CQN + (size_t)t * 192;
      d[lane] = f2bf(q0 * rs * gq0); d[64 + lane] = f2bf(q1 * rs * gq1); d[128 + lane] = f2bf(q2 * rs * gq2);
      u16* d2 = CKVN + (size_t)t * 128;
      d2[lane] = f2bf(k0 * r2 * gk0); d2[64 + lane] = f2bf(k1 * r2 * gk1);
    }
  }
}

DEVI void mla_up_tile(const Params& p, int mt, int nn, char* smem) {
  const int tid = p.tid, lane = tid & 63, wid = tid >> 6, wr = wid >> 1, wc = wid & 1, fr = lane & 15, fq = lane >> 4;
  const int m0 = mt * 128;
  const bool lat = m0 < TL;
  const int b = tok_b(m0), rowbase = tok_row(m0);
  f32x4 acc[4][4];
  if (nn < 3) {
    const u16* CQN = (const u16*)(p.ws + O_CQN);
    gemm_core<false>(tid, [&](int r) { return CQN + (size_t)(m0 + r) * 192; }, (const u16*)(p.ws + O_WUQT) + (size_t)nn * 128 * 192, 192, 192, acc, smem);
    const f32x2* ROPE = (const f32x2*)(p.ws + O_ROPE);
    const float scale = 0.10206207261596577f * LOG2E;
    u16* QC = (u16*)(p.ws + O_QC);
#pragma unroll
    for (int m = 0; m < 4; ++m) {
      const int rl = wr * 64 + m * 16 + fr;
#pragma unroll
      for (int n = 0; n < 4; ++n) {
        const int cb = nn * 128 + wc * 64 + n * 16;
        const int h = cb / 96, db = cb - h * 96;
        u16* dst = QC + ((size_t)(b * 4 + h) * NKEY + rowbase + rl) * 96;
        if (db < 64) {
          u32x2 pk; pk[0] = pack2(acc[m][n][0] * scale, acc[m][n][1] * scale); pk[1] = pack2(acc[m][n][2] * scale, acc[m][n][3] * scale);
          *(u32x2*)(dst + db + fq * 4) = pk;
        } else if (db == 64 && n < 3) {
          u32x2 o1, o2;
          rope4(acc[m][n], acc[m][n + 1], ROPE + (size_t)(rowbase + rl) * 48 + 32 + fq * 4, lat, scale, o1, o2);
          *(u32x2*)(dst + 64 + fq * 4) = o1; *(u32x2*)(dst + 80 + fq * 4) = o2;
        }
      }
    }
  } else {
    const u16* CKVN = (const u16*)(p.ws + O_CKVN);
    auto arow = [&](int r) { return CKVN + (size_t)(m0 + r) * 128; };
    const u16* Wt = (const u16*)(p.ws + O_WUKVT) + (size_t)(nn - 3) * 128 * 128;
    if (nn < 5) {
      gemm_core<false>(tid, arow, Wt, 128, 128, acc, smem);
      u16* KC = (u16*)(p.ws + O_KC) + ((size_t)(b * 4 + (nn - 3) * 2 + wc) * NKEY + rowbase) * 96;
#pragma unroll
      for (int m = 0; m < 4; ++m)
#pragma unroll
        for (int n = 0; n < 4; ++n) {
          u32x2 pk; pk[0] = pack2(acc[m][n][0], acc[m][n][1]); pk[1] = pack2(acc[m][n][2], acc[m][n][3]);
          *(u32x2*)(KC + (size_t)(wr * 64 + m * 16 + fr) * 96 + n * 16 + fq * 4) = pk;
        }
    } else {
      gemm_core<true>(tid, arow, Wt, 128, 128, acc, smem);
      u16* vt = (u16*)(p.ws + O_VTC) + (size_t)(b * 4 + (nn - 5) * 2 + wc) * 64 * NKEY;
#pragma unroll
      for (int m = 0; m < 4; ++m)
#pragma unroll
        for (int n = 0; n < 4; ++n) {
          u32x2 pk; pk[0] = pack2(acc[m][n][0], acc[m][n][1]); pk[1] = pack2(acc[m][n][2], acc[m][n][3]);
          *(u32x2*)(vt + (size_t)(n * 16 + fr) * NKEY + rowbase + wr * 64 + m * 16 + fq * 4) = pk;
        }
    }
  }
}
DEVI int permcol(int x) { return (x & 32) + 8 * ((x >> 2) & 3) + 4 * ((x >> 4) & 1) + (x & 3); }
DEVI int cidx(int d, int e) { return ((((e >> 4) * 4 + (d >> 4)) * 64) + (e & 15) + 16 * ((d >> 2) & 3)) * 4 + (d & 3); }
DEVI int gdn_chunk_t0(int ci) { return ci < 256 ? (ci >> 7) * SEQ + (ci & 127) * 64 : TL + ((ci - 256) >> 2) * CTXL + ((ci - 256) & 3) * 64; }

DEVI void gdn_chunk_item(const Params& p, int item, char* smem) {
  u16* sK = (u16*)smem;
  float* sA = (float*)(smem + 9216);
  u16* sXt = (u16*)smem;
  u16* sAt = (u16*)(smem + 26624);
  u16* sKt = (u16*)(smem + 35840);
  float* sX = (float*)(smem + 45056);
  float* sgc = (float*)(smem + 77824); float* sbeta = sgc + 64; float* seg = sbeta + 64; float* skd = seg + 64;
  const u16* GQ = (const u16*)(p.ws + O_GQ); const u16* GK = (const u16*)(p.ws + O_GK); const u16* GV = (const u16*)(p.ws + O_GV);
  const float* GG = (const float*)(p.ws + O_GG); const float* GB = (const float*)(p.ws + O_GBETA);
  u16* GM = (u16*)(p.ws + O_GM); u16* GQP = (u16*)(p.ws + O_GQP); u16* GN = (u16*)(p.ws + O_GN); u16* GLO = (u16*)(p.ws + O_GLO);
  const int tid = p.tid, lane = tid & 63, w = tid >> 6, i15 = lane & 15, q = lane >> 4;
  {
    const int ci = item >> 3, hd = (item >> 1) & 3, dir = item & 1;
    const int t0 = gdn_chunk_t0(ci);
    auto tok = [&](int i) { return dir ? t0 + 63 - i : t0 + i; };
    __syncthreads();
    if (tid < 64) {
      float g = GG[((size_t)dir * T + tok(tid)) * 4 + hd];
#pragma unroll
      for (int o = 1; o < 64; o <<= 1) { float u = __shfl_up(g, o); if (lane >= o) g += u; }
      const float gl = __shfl(g, 63);
      sgc[tid] = g; sbeta[tid] = GB[((size_t)dir * T + tok(tid)) * 4 + hd]; seg[tid] = expf(g); skd[tid] = expf(gl - g);
    }
    __syncthreads();
    const float eglast = seg[63];
#pragma unroll
    for (int i = 0; i < 2; ++i) {
      const int ch = tid + 256 * i, j = ch >> 3, cc = ch & 7;
      const u32x4 kv = *(const u32x4*)(GK + (size_t)tok(j) * 256 + hd * 64 + cc * 8);
      *(u32x4*)&sK[j * 72 + cc * 8] = kv;
      const float kd = skd[j];
#pragma unroll
      for (int e = 0; e < 4; ++e) {
        sKt[(cc * 8 + 2 * e) * 72 + j] = f2bf(bf2f((u16)(kv[e] & 0xffff)) * kd);
        sKt[(cc * 8 + 2 * e + 1) * 72 + j] = f2bf(bf2f((u16)(kv[e] >> 16)) * kd);
      }
    }
    for (int e = tid; e < 64 * 64; e += 256) {
      const int j = e >> 6, c = e & 63;
      sX[j * 128 + c] = bf2f(GV[(size_t)tok(j) * 256 + hd * 64 + c]) * sbeta[j];
    }
    __syncthreads();
    for (int e = tid; e < 64 * 64; e += 256) {
      const int j = e >> 6, c = e & 63;
      sX[j * 128 + 64 + c] = bf2f(sK[j * 72 + c]) * sbeta[j] * seg[j];
    }
    {
      f32x4 kk[4], qk[4];
#pragma unroll
      for (int nt = 0; nt < 4; ++nt) { kk[nt] = f32x4{0.f, 0.f, 0.f, 0.f}; qk[nt] = f32x4{0.f, 0.f, 0.f, 0.f}; }
#pragma unroll
      for (int ks = 0; ks < 2; ++ks) {
        const bf16x8 ak = *(const bf16x8*)&sK[(16 * w + i15) * 72 + ks * 32 + q * 8];
        const bf16x8 aq = *(const bf16x8*)(GQ + (size_t)tok(16 * w + i15) * 256 + hd * 64 + ks * 32 + q * 8);
#pragma unroll
        for (int nt = 0; nt < 4; ++nt) {
          const bf16x8 bk = *(const bf16x8*)&sK[(16 * nt + i15) * 72 + ks * 32 + q * 8];
          kk[nt] = MFMA16(ak, bk, kk[nt]); qk[nt] = MFMA16(aq, bk, qk[nt]);
        }
      }
#pragma unroll
      for (int nt = 0; nt < 4; ++nt)
#pragma unroll
        for (int r = 0; r < 4; ++r) {
          const int i = 16 * w + 4 * q + r, j = 16 * nt + i15;
          const float dec = i >= j ? expf(sgc[i] - sgc[j]) : 0.f;
          sA[i * 68 + j] = i > j ? sbeta[i] * kk[nt][r] * dec : 0.f;
          sAt[i * 72 + j] = f2bf(i >= j ? qk[nt][r] * dec : 0.f);
        }
    }
    __syncthreads();
    if (tid < 128) {
      const int c = tid;
      for (int ib = 0; ib < 16; ++ib) {
        float a0 = sX[(4 * ib) * 128 + c], a1 = sX[(4 * ib + 1) * 128 + c], a2 = sX[(4 * ib + 2) * 128 + c], a3 = sX[(4 * ib + 3) * 128 + c];
#pragma unroll 2
        for (int g = 0; g < ib; ++g) {
          const float x0 = sX[(4 * g) * 128 + c], x1 = sX[(4 * g + 1) * 128 + c], x2 = sX[(4 * g + 2) * 128 + c], x3 = sX[(4 * g + 3) * 128 + c];
          const f32x4 r0 = *(const f32x4*)&sA[(4 * ib) * 68 + 4 * g], r1 = *(const f32x4*)&sA[(4 * ib + 1) * 68 + 4 * g];
          const f32x4 r2 = *(const f32x4*)&sA[(4 * ib + 2) * 68 + 4 * g], r3 = *(const f32x4*)&sA[(4 * ib + 3) * 68 + 4 * g];
          a0 -= r0[0] * x0 + r0[1] * x1 + r0[2] * x2 + r0[3] * x3;
          a1 -= r1[0] * x0 + r1[1] * x1 + r1[2] * x2 + r1[3] * x3;
          a2 -= r2[0] * x0 + r2[1] * x1 + r2[2] * x2 + r2[3] * x3;
          a3 -= r3[0] * x0 + r3[1] * x1 + r3[2] * x2 + r3[3] * x3;
        }
        const f32x4 d1 = *(const f32x4*)&sA[(4 * ib + 1) * 68 + 4 * ib], d2 = *(const f32x4*)&sA[(4 * ib + 2) * 68 + 4 * ib], d3 = *(const f32x4*)&sA[(4 * ib + 3) * 68 + 4 * ib];
        a1 -= d1[0] * a0;
        a2 -= d2[0] * a0 + d2[1] * a1;
        a3 -= d3[0] * a0 + d3[1] * a1 + d3[2] * a2;
        sX[(4 * ib) * 128 + c] = a0; sX[(4 * ib + 1) * 128 + c] = a1; sX[(4 * ib + 2) * 128 + c] = a2; sX[(4 * ib + 3) * 128 + c] = a3;
      }
    }
    __syncthreads();
    {
      const int c = tid & 127, jh = (tid >> 7) * 32;
#pragma unroll
      for (int g = 0; g < 4; ++g) {
        u32x4 pk;
#pragma unroll
        for (int e = 0; e < 4; ++e) pk[e] = pack2(sX[(jh + 8 * g + 2 * e) * 128 + c], sX[(jh + 8 * g + 2 * e + 1) * 128 + c]);
        *(u32x4*)&sXt[c * 72 + jh + 8 * g] = pk;
      }
    }
    __syncthreads();
    {
      f32x4 r1[8], r2[8];
#pragma unroll
      for (int ct = 0; ct < 8; ++ct) { r1[ct] = f32x4{0.f, 0.f, 0.f, 0.f}; r2[ct] = f32x4{0.f, 0.f, 0.f, 0.f}; }
#pragma unroll
      for (int ks = 0; ks < 2; ++ks) {
        const bf16x8 aa = *(const bf16x8*)&sAt[(16 * w + i15) * 72 + ks * 32 + q * 8];
        const bf16x8 ak = *(const bf16x8*)&sKt[(16 * w + i15) * 72 + ks * 32 + q * 8];
#pragma unroll
        for (int ct = 0; ct < 8; ++ct) {
          const bf16x8 bx = *(const bf16x8*)&sXt[(16 * ct + i15) * 72 + ks * 32 + q * 8];
          r1[ct] = MFMA16(aa, bx, r1[ct]); r2[ct] = MFMA16(ak, bx, r2[ct]);
        }
      }
      const size_t ib = (size_t)item * 4096;
#pragma unroll
      for (int ct = 0; ct < 4; ++ct) {
        u32x2 a, b;
        a[0] = pack2(r1[ct][0], r1[ct][1]); a[1] = pack2(r1[ct][2], r1[ct][3]);
        b[0] = pack2(r2[ct][0], r2[ct][1]); b[1] = pack2(r2[ct][2], r2[ct][3]);
        *(u32x2*)(GLO + ib + ((ct * 4 + w) * 64 + lane) * 4) = a;
        *(u32x2*)(GN + ib + ((ct * 4 + w) * 64 + lane) * 4) = b;
      }
#pragma unroll
      for (int ct = 4; ct < 8; ++ct)
#pragma unroll
        for (int r = 0; r < 4; ++r) {
          const int row = 16 * w + 4 * q + r, col = 16 * (ct - 4) + i15;
          const float qv = bf2f(GQ[(size_t)tok(row) * 256 + hd * 64 + col]);
          GQP[ib + row * 64 + permcol(col)] = f2bf(qv * seg[row] - r1[ct][r]);
          GM[ib + row * 64 + permcol(col)] = f2bf((row == col ? eglast : 0.f) - r2[ct][r]);
        }
    }
    __syncthreads();
  }
}

DEVI void gdn_scan_chain(const Params& p, int chain, char* smem) {
  const int tid = p.tid, lane = tid & 63, w = tid >> 6, i15 = lane & 15, q = lane >> 4;
  u16* sM = (u16*)smem;
  u16* sQ = sM + 2 * 64 * 72;
  const u16* GM = (const u16*)(p.ws + O_GM); const u16* GQP = (const u16*)(p.ws + O_GQP);
  const u16* GN = (const u16*)(p.ws + O_GN); const u16* GLO = (const u16*)(p.ws + O_GLO);
  float* GO = (float*)(p.ws + O_GO);
  {
    const int b = chain >> 3, hd = (chain >> 1) & 3, dir = chain & 1;
    f32x4 S[4];
#pragma unroll
    for (int r = 0; r < 4; ++r) S[r] = f32x4{0.f, 0.f, 0.f, 0.f};
    auto item_of = [&](int n) {
      int ci = n < 4 ? 256 + b * 4 + (dir ? 3 - n : n) : b * 128 + (dir ? 127 - (n - 4) : (n - 4));
      return ci * 8 + hd * 2 + dir;
    };
    u32x4 pm[2], pq[2]; u32x2 pn[4], pl[4];
    auto prefetch = [&](int n) {
      const size_t base = (size_t)item_of(n) * 4096;
#pragma unroll
      for (int i = 0; i < 2; ++i) {
        const int ch = tid + 256 * i;
        pm[i] = *(const u32x4*)(GM + base + ch * 8);
        pq[i] = *(const u32x4*)(GQP + base + ch * 8);
      }
#pragma unroll
      for (int rb = 0; rb < 4; ++rb) {
        pn[rb] = *(const u32x2*)(GN + base + ((w * 4 + rb) * 64 + lane) * 4);
        pl[rb] = *(const u32x2*)(GLO + base + ((w * 4 + rb) * 64 + lane) * 4);
      }
    };
    prefetch(0);
    __syncthreads();
    for (int n = 0; n < 132; ++n) {
      const int buf = n & 1;
      u16* bM = sM + buf * 64 * 72; u16* bQ = sQ + buf * 64 * 72;
#pragma unroll
      for (int i = 0; i < 2; ++i) {
        const int ch = tid + 256 * i, row = ch >> 3, cc = ch & 7;
        *(u32x4*)&bM[row * 72 + cc * 8] = pm[i];
        *(u32x4*)&bQ[row * 72 + cc * 8] = pq[i];
      }
      f32x4 accs[4], acco[4];
#pragma unroll
      for (int rb = 0; rb < 4; ++rb) {
        accs[rb] = f32x4{bf2f((u16)(pn[rb][0] & 0xffff)), bf2f((u16)(pn[rb][0] >> 16)), bf2f((u16)(pn[rb][1] & 0xffff)), bf2f((u16)(pn[rb][1] >> 16))};
        acco[rb] = f32x4{bf2f((u16)(pl[rb][0] & 0xffff)), bf2f((u16)(pl[rb][0] >> 16)), bf2f((u16)(pl[rb][1] & 0xffff)), bf2f((u16)(pl[rb][1] >> 16))};
      }
      const int ci = n < 4 ? 256 + b * 4 + (dir ? 3 - n : n) : b * 128 + (dir ? 127 - (n - 4) : (n - 4));
      const int t0 = gdn_chunk_t0(ci);
      __syncthreads();
      if (n + 1 < 132) prefetch(n + 1);
      bf16x8 sb[2];
#pragma unroll
      for (int kb = 0; kb < 2; ++kb)
#pragma unroll
        for (int jj = 0; jj < 8; ++jj) sb[kb][jj] = (short)f2bf(S[2 * kb + (jj >> 2)][jj & 3]);
#pragma unroll
      for (int kb = 0; kb < 2; ++kb)
#pragma unroll
        for (int rb = 0; rb < 4; ++rb) {
          const bf16x8 am = *(const bf16x8*)&bM[(rb * 16 + i15) * 72 + kb * 32 + q * 8];
          const bf16x8 aq = *(const bf16x8*)&bQ[(rb * 16 + i15) * 72 + kb * 32 + q * 8];
          accs[rb] = MFMA16(am, sb[kb], accs[rb]);
          acco[rb] = MFMA16(aq, sb[kb], acco[rb]);
        }
#pragma unroll
      for (int rb = 0; rb < 4; ++rb) {
        S[rb] = accs[rb];
#pragma unroll
        for (int r = 0; r < 4; ++r) {
          const int i = rb * 16 + q * 4 + r;
          const int t = dir ? t0 + 63 - i : t0 + i;
          GO[(size_t)dir * T * 256 + (size_t)t * 256 + hd * 64 + w * 16 + i15] = acco[rb][r];
        }
      }
    }
    __syncthreads();
  }
}


template <int DQK>
DEVI void attn_run(int tid, const u16* __restrict__ Qp, int qrow0, const u16* __restrict__ Kp, const u16* __restrict__ Vtp,
                   int a0, int a1, int b0, int b1, int qpos0, float sink2, f32x16 (&O)[2], char* smem) {
  constexpr int KLD = DQK + 8, NS = DQK / 16, KCH = DQK / 8, NKL = (64 * KCH) / 256;
  constexpr int BUF = 64 * KLD + 64 * 72;
  u16* sbase = (u16*)smem;
  const int lane = tid & 63, wid = tid >> 6, r31 = lane & 31, hh = lane >> 5;
  const int qrow = qrow0 + wid * 32 + r31;
  bf16x8 qf[NS];
#pragma unroll
  for (int s = 0; s < NS; ++s) qf[s] = *(const bf16x8*)(Qp + (size_t)qrow * DQK + s * 16 + hh * 8);
#pragma unroll
  for (int i = 0; i < 16; ++i) { O[0][i] = 0.f; O[1][i] = 0.f; }
  float m = -30000.f, lsum = 0.f;
  const int na = (a1 - a0) >> 6, nt = na + ((b1 - b0) >> 6);
  const int qpos = qpos0 + wid * 32 + r31;
  u32x4 rk[NKL], rv[2];
  auto gload = [&](int ti) {
    const int key0 = ti >= na ? b0 + (ti - na) * 64 : a0 + ti * 64;
#pragma unroll
    for (int i = 0; i < NKL; ++i) { const int q = tid + 256 * i, r = q / KCH, cc = q % KCH; rk[i] = *(const u32x4*)(Kp + (size_t)(key0 + r) * DQK + cc * 8); }
#pragma unroll
    for (int i = 0; i < 2; ++i) { const int q = tid + 256 * i, r = q >> 3, cc = q & 7; rv[i] = *(const u32x4*)(Vtp + (size_t)r * NKEY + key0 + cc * 8); }
  };
  auto lstore = [&](int buf) {
    u16* sK = sbase + buf * BUF; u16* sV = sK + 64 * KLD;
#pragma unroll
    for (int i = 0; i < NKL; ++i) { const int q = tid + 256 * i, r = q / KCH, cc = q % KCH; *(u32x4*)&sK[r * KLD + cc * 8] = rk[i]; }
#pragma unroll
    for (int i = 0; i < 2; ++i) { const int q = tid + 256 * i, r = q >> 3, cc = q & 7; *(u32x4*)&sV[r * 72 + cc * 8] = rv[i]; }
  };
  gload(0);
  __syncthreads();
  lstore(0);
  __syncthreads();
  for (int ti = 0; ti < nt; ++ti) {
    if (ti + 1 < nt) gload(ti + 1);
    const u16* sK = sbase + (ti & 1) * BUF; const u16* sV = sK + 64 * KLD;
    const bool inB = ti >= na;
    const int key0 = inB ? b0 + (ti - na) * 64 : a0 + ti * 64;
    f32x16 st[2];
#pragma unroll
    for (int k2 = 0; k2 < 2; ++k2) {
#pragma unroll
      for (int i = 0; i < 16; ++i) st[k2][i] = 0.f;
#pragma unroll
      for (int s = 0; s < NS; ++s) {
        const bf16x8 kf = *(const bf16x8*)&sK[(k2 * 32 + r31) * KLD + s * 16 + hh * 8];
        st[k2] = MFMA32(kf, qf[s], st[k2]);
      }
    }
    if (inB) {
#pragma unroll
      for (int k2 = 0; k2 < 2; ++k2)
#pragma unroll
        for (int g = 0; g < 16; ++g) {
          const int d = key0 + k2 * 32 + (g & 3) + 8 * (g >> 2) + 4 * hh - qpos;
          if (d > 128 || d < -128) st[k2][g] = -1e30f;
        }
    }
    float mx = st[0][0];
#pragma unroll
    for (int g = 1; g < 16; ++g) mx = fmaxf(mx, st[0][g]);
#pragma unroll
    for (int g = 0; g < 16; ++g) mx = fmaxf(mx, st[1][g]);
    mx = fmaxf(mx, __shfl_xor(mx, 32));
    if (__any(mx > m + 8.f)) {
      const float mn = fmaxf(m, mx);
      const float alpha = __builtin_amdgcn_exp2f(m - mn);
      m = mn; lsum *= alpha;
#pragma unroll
      for (int i = 0; i < 16; ++i) { O[0][i] *= alpha; O[1][i] *= alpha; }
    }
    float ps = 0.f;
#pragma unroll
    for (int k2 = 0; k2 < 2; ++k2)
#pragma unroll
      for (int g = 0; g < 16; ++g) { const float pv = __builtin_amdgcn_exp2f(st[k2][g] - m); st[k2][g] = pv; ps += pv; }
    lsum += ps;
#pragma unroll
    for (int k2 = 0; k2 < 2; ++k2)
#pragma unroll
      for (int s2 = 0; s2 < 2; ++s2) {
        u32x4 pp;
#pragma unroll
        for (int j = 0; j < 4; ++j) pp[j] = pack2(st[k2][8 * s2 + 2 * j], st[k2][8 * s2 + 2 * j + 1]);
        const bf16x8 pf = __builtin_bit_cast(bf16x8, pp);
#pragma unroll
        for (int dvt = 0; dvt < 2; ++dvt) {
          const u16* vp = &sV[(dvt * 32 + r31) * 72 + k2 * 32 + s2 * 16 + 4 * hh];
          const u32x2 lo = *(const u32x2*)vp, hi = *(const u32x2*)(vp + 8);
          u32x4 vv; vv[0] = lo[0]; vv[1] = lo[1]; vv[2] = hi[0]; vv[3] = hi[1];
          O[dvt] = MFMA32(__builtin_bit_cast(bf16x8, vv), pf, O[dvt]);
        }
      }
    if (ti + 1 < nt) lstore((ti + 1) & 1);
    __syncthreads();
  }
  if (sink2 > -1e29f) {
    const float mn = fmaxf(m, sink2);
    const float alpha = __builtin_amdgcn_exp2f(m - mn);
    lsum = lsum * alpha + (hh == 0 ? __builtin_amdgcn_exp2f(sink2 - mn) : 0.f);
#pragma unroll
    for (int i = 0; i < 16; ++i) { O[0][i] *= alpha; O[1][i] *= alpha; }
  }
  const float ltot = lsum + __shfl_xor(lsum, 32);
  const float inv = 1.f / ltot;
#pragma unroll
  for (int i = 0; i < 16; ++i) { O[0][i] *= inv; O[1][i] *= inv; }
}
DEVI void attn_store(int tid, const f32x16 (&O)[2], u16* dst, int ld, int b, int qrow0, int col0) {
  const int lane = tid & 63, wid = tid >> 6, r31 = lane & 31, hh = lane >> 5;
  const int qrow = qrow0 + wid * 32 + r31;
  const int t = qrow < SEQ ? b * SEQ + qrow : TL + b * CTXL + (qrow - SEQ);
  u16* yr = dst + (size_t)t * ld + col0;
#pragma unroll
  for (int dvt = 0; dvt < 2; ++dvt)
#pragma unroll
    for (int g4 = 0; g4 < 4; ++g4) {
      u32x2 pk; pk[0] = pack2(O[dvt][g4 * 4 + 0], O[dvt][g4 * 4 + 1]); pk[1] = pack2(O[dvt][g4 * 4 + 2], O[dvt][g4 * 4 + 3]);
      *(u32x2*)(yr + dvt * 32 + 8 * g4 + 4 * hh) = pk;
    }
}
DEVI void attn_item(const Params& p, int l, int mixer, int b, int h, int qb, char* smem) {
  const bool lat = qb < 64;
  const int qrow0 = qb * 128;
  f32x16 O[2];
  if (mixer == 0) {
    attn_run<32>(p.tid, (const u16*)(p.ws + O_QB) + (size_t)(b * 8 + h) * NKEY * 32, qrow0, (const u16*)(p.ws + O_KB) + (size_t)(b * 8 + h) * NKEY * 32,
                 (const u16*)(p.ws + O_VTB) + (size_t)(b * 4 + (h >> 1)) * 64 * NKEY, lat ? 0 : SEQ, NKEY, 0, 0, 0, -1e30f, O, smem);
    attn_store(p.tid, O, (u16*)(p.ws + O_OB), 512, b, qrow0, h * 64);
  } else if (mixer == 1) {
    attn_run<96>(p.tid, (const u16*)(p.ws + O_QC) + (size_t)(b * 4 + h) * NKEY * 96, qrow0, (const u16*)(p.ws + O_KC) + (size_t)(b * 4 + h) * NKEY * 96,
                 (const u16*)(p.ws + O_VTC) + (size_t)(b * 4 + h) * 64 * NKEY, lat ? 0 : SEQ, NKEY, 0, 0, 0, -1e30f, O, smem);
    attn_store(p.tid, O, (u16*)(p.ws + O_Y), 1024, b, qrow0, 512 + h * 64);
  } else {
    const float sink2 = p.in[I_SINK][l * 4 + h] * LOG2E;
    const int hk = h >> 1;
    int b0 = 0, b1 = 0;
    if (lat) { b0 = (qb - 1) * 128; if (b0 < 0) b0 = 0; b1 = (qb + 2) * 128; if (b1 > SEQ) b1 = SEQ; }
    attn_run<64>(p.tid, (const u16*)(p.ws + O_QA) + (size_t)(b * 4 + h) * NKEY * 64, qrow0, (const u16*)(p.ws + O_KA) + (size_t)(b * 2 + hk) * NKEY * 64,
                 (const u16*)(p.ws + O_VTA) + (size_t)(b * 2 + hk) * 64 * NKEY, SEQ, NKEY, b0, b1, qrow0, sink2, O, smem);
    attn_store(p.tid, O, (u16*)(p.ws + O_Y), 1024, b, qrow0, h * 64);
  }
}

constexpr int SMEM_BYTES = 80 * 1024;

constexpr int Q_SCAN = 16, Q_BL = 1024, Q_CL = 512, Q_AL = 512, Q_CTX = 64, Q_PREP = TR_P2 / 8;
DEVI unsigned long long launder_ptr(unsigned long long v) {
  unsigned lo = __builtin_amdgcn_readfirstlane((unsigned)v), hi = __builtin_amdgcn_readfirstlane((unsigned)(v >> 32));
  asm volatile("s_mov_b32 %0, %1" : "=s"(lo) : "s"(lo));
  asm volatile("s_mov_b32 %0, %1" : "=s"(hi) : "s"(hi));
  return ((unsigned long long)hi << 32) | lo;
}
DEVI Params mkctx(const KArgs& a) {
  Params c;
  c.ws = (char*)launder_ptr((unsigned long long)a.ws);
  c.out = (float*)launder_ptr((unsigned long long)a.out);
  c.in = (const float* const*)(c.ws + O_TAB);
  c.tid = threadIdx.x;
  asm volatile("" : "+v"(c.tid));
  return c;
}
DEVI void st_mixer_queue(const KArgs& a, int l, char* smem) {
  int* sitem = (int*)(smem + SMEM_BYTES - 16);
  const int nctx = l == 0 ? Q_CTX : 0;
  const int total = Q_SCAN + Q_BL + Q_CL + Q_AL + nctx + Q_PREP;
  for (;;) {
    const Params p = mkctx(a);
    unsigned* head = (unsigned*)(p.ws + O_BAR) + 16 + l;
    __syncthreads();
    if (p.tid == 0) *sitem = (int)atomicAdd(head, 1u);
    __syncthreads();
    int it = *sitem;
    if (it >= total) break;
    if (it < Q_SCAN) { gdn_scan_chain(p, it, smem); continue; }
    it -= Q_SCAN;
    const int natt = Q_BL + Q_CL + Q_AL + nctx;
    if (it < natt) {
      int mixer, b, h, qb;
      if (it < Q_BL) { mixer = 0; b = it >> 9; h = (it >> 6) & 7; qb = it & 63; }
      else if (it < Q_BL + Q_CL + Q_AL) { const int j = it - Q_BL; mixer = 1 + (j >> 9); b = (j >> 8) & 1; h = (j >> 6) & 3; qb = j & 63; }
      else {
        const int j = it - (Q_BL + Q_CL + Q_AL);
        if (j < 32) { mixer = 0; b = j >> 4; h = (j >> 1) & 7; qb = 64 + (j & 1); }
        else { const int jj = (j - 32) & 15; mixer = 1 + ((j - 32) >> 4); b = jj >> 3; h = (jj >> 1) & 3; qb = 64 + (jj & 1); }
      }
      attn_item(p, l, mixer, b, h, qb, smem);
      continue;
    }
    it -= natt;
#pragma unroll 1
    for (int k = 0; k < 8; ++k) prep_w2_tile(p, l, it * 8 + k, (float*)smem);
  }
}

DEVI void st_mix_finish(const Params& p, int l, int vb, int nvb) {
  const int lane = p.tid & 63, wid = p.tid >> 6;
  const float* GO = (const float*)(p.ws + O_GO); const u16* PP = (const u16*)(p.ws + O_PP); const u16* OB = (const u16*)(p.ws + O_OB);
  u16* Y = (u16*)(p.ws + O_Y);
  const float lam_init = 0.8f - 0.6f * expf(-0.3f * (float)l);
  float d1 = lane < 32 ? p.in[I_LQ1][l * 32 + lane] * p.in[I_LK1][l * 32 + lane] : 0.f;
  float d2 = lane < 32 ? p.in[I_LQ2][l * 32 + lane] * p.in[I_LK2][l * 32 + lane] : 0.f;
  const float lam = expf(wave_sum(d1)) - expf(wave_sum(d2)) + lam_init;
  const float gg = p.in[I_GNG][l * 64 + lane];
  const float dg = p.in[I_DNG][l * 64 + lane] * (1.f - lam_init);
  const int tend = l == 0 ? T : TL;
  for (int t = vb * 4 + wid; t < tend; t += nvb * 4) {
    float ob0[4], ob1[4], go[4], z[4];
#pragma unroll
    for (int hd = 0; hd < 4; ++hd) {
      ob0[hd] = bf2f(OB[(size_t)t * 512 + (hd * 2) * 64 + lane]); ob1[hd] = bf2f(OB[(size_t)t * 512 + (hd * 2 + 1) * 64 + lane]);
      go[hd] = GO[(size_t)t * 256 + hd * 64 + lane] + GO[(size_t)T * 256 + (size_t)t * 256 + hd * 64 + lane];
      z[hd] = bf2f(PP[(size_t)t * LDPP + PP_DZ + hd * 64 + lane]);
    }
    float ssb[4], ssg[4], od[4];
#pragma unroll
    for (int hd = 0; hd < 4; ++hd) { od[hd] = ob0[hd] - lam * ob1[hd]; ssb[hd] = od[hd] * od[hd]; ssg[hd] = go[hd] * go[hd]; }
#pragma unroll
    for (int o = 32; o >= 1; o >>= 1) {
#pragma unroll
      for (int hd = 0; hd < 4; ++hd) { ssb[hd] += __shfl_xor(ssb[hd], o); ssg[hd] += __shfl_xor(ssg[hd], o); }
    }
#pragma unroll
    for (int hd = 0; hd < 4; ++hd) {
      Y[(size_t)t * 1024 + 256 + hd * 64 + lane] = f2bf(od[hd] * rsqrtf(ssb[hd] * (1.f / 64.f) + 1e-6f) * dg);
      Y[(size_t)t * 1024 + 768 + hd * 64 + lane] = f2bf(go[hd] * rsqrtf(ssg[hd] * (1.f / 64.f) + 1e-6f) * gg * siluf(z[hd]));
    }
  }
}

constexpr int RLD = 1026;
DEVI void st_norm2_route(const Params& p, int l, int vb, int nvb, char* smem) {
  const int lane = p.tid & 63, wid = p.tid >> 6, i15 = lane & 15, q = lane >> 4;
  float* shh = (float*)smem;
  float* slog = shh + 16 * RLD;
  const float* g = p.in[I_N2G] + l * 1024;
  const float* wr = p.in[I_WR] + (size_t)l * 1024 * 64;
  const float bias = p.in[I_RB][l * 64 + lane];
  float* WTS = (float*)(p.ws + O_WTS); int* CNT = (int*)(p.ws + O_CNT); int* LIST = (int*)(p.ws + O_LIST);
  for (int grp = vb; grp < T / 16; grp += nvb) {
    const int tb = grp * 16 + wid * 4;
    const int mv = tok_mv(tb);
    const float* sh = modp(p, l, mv, 3); const float* sc = modp(p, l, mv, 4);
    {
      f32x4 v[4][4]; float ss[4];
#pragma unroll
      for (int u = 0; u < 4; ++u) {
        const f32x4* xr = (const f32x4*)((const float*)(p.ws + O_XA) + (size_t)(tb + u) * 1024);
#pragma unroll
        for (int i = 0; i < 4; ++i) v[u][i] = xr[i * 64 + lane];
      }
#pragma unroll
      for (int u = 0; u < 4; ++u) {
        float a = 0.f;
#pragma unroll
        for (int i = 0; i < 4; ++i) a += v[u][i][0] * v[u][i][0] + v[u][i][1] * v[u][i][1] + v[u][i][2] * v[u][i][2] + v[u][i][3] * v[u][i][3];
        ss[u] = a;
      }
#pragma unroll
      for (int o = 32; o >= 1; o >>= 1) {
#pragma unroll
        for (int u = 0; u < 4; ++u) ss[u] += __shfl_xor(ss[u], o);
      }
#pragma unroll
      for (int i = 0; i < 4; ++i) {
        const int c = i * 256 + lane * 4;
        const f32x4 gg = *(const f32x4*)(g + c), s4 = *(const f32x4*)(sc + c), h4 = *(const f32x4*)(sh + c);
        const f32x4 gs = gg * (1.f + s4);
#pragma unroll
        for (int u = 0; u < 4; ++u) {
          const float rstd = rsqrtf(ss[u] * (1.f / 1024.f) + 1e-6f);
          const f32x4 o = v[u][i] * rstd * gs + h4;
          u32x2 pk; pk[0] = pack2(o[0], o[1]); pk[1] = pack2(o[2], o[3]);
          *(u32x2*)((u16*)(p.ws + O_H) + (size_t)(tb + u) * 1024 + c) = pk;
          float* d = shh + (wid * 4 + u) * RLD + c;
          *(f32x2*)d = f32x2{o[0], o[1]}; *(f32x2*)(d + 2) = f32x2{o[2], o[3]};
        }
      }
    }
    __syncthreads();
    {
      f32x4 a0 = {0.f, 0.f, 0.f, 0.f}, a1 = a0;
      const float* ap = shh + i15 * RLD + q;
      const float* bp = wr + (size_t)q * 64 + wid * 16 + i15;
#pragma unroll 8
      for (int kk = 0; kk < 256; kk += 2) {
        a0 = __builtin_amdgcn_mfma_f32_16x16x4f32(ap[4 * kk], bp[(size_t)(4 * kk) * 64], a0, 0, 0, 0);
        a1 = __builtin_amdgcn_mfma_f32_16x16x4f32(ap[4 * kk + 4], bp[(size_t)(4 * kk + 4) * 64], a1, 0, 0, 0);
      }
#pragma unroll
      for (int r = 0; r < 4; ++r) slog[(4 * q + r) * 64 + wid * 16 + i15] = a0[r] + a1[r];
    }
    __syncthreads();
#pragma unroll 1
    for (int u = 0; u < 4; ++u) {
      const int t = tb + u;
      const float logit = slog[(wid * 4 + u) * 64 + lane];
      const float s = 1.f / (1.f + expf(-logit));
      const float c = s + bias;
      float m1 = c;
      m1 = fmaxf(m1, __shfl_xor(m1, 1)); m1 = fmaxf(m1, __shfl_xor(m1, 2)); m1 = fmaxf(m1, __shfl_xor(m1, 4));
      const unsigned long long bal = __ballot(c == m1);
      const int grpi = lane >> 3;
      const unsigned gm = (unsigned)((bal >> (grpi * 8)) & 0xffull);
      const int first = __ffs(gm) - 1;
      float m2 = ((lane & 7) == first) ? -INFINITY : c;
      m2 = fmaxf(m2, __shfl_xor(m2, 1)); m2 = fmaxf(m2, __shfl_xor(m2, 2)); m2 = fmaxf(m2, __shfl_xor(m2, 4));
      const float gs = m1 + m2;
      int grank = 0;
#pragma unroll
      for (int gg = 0; gg < 8; ++gg) { float o = __shfl(gs, gg * 8); grank += (o > gs || (o == gs && gg < grpi)) ? 1 : 0; }
      const bool gsel = grank < 4;
      const float mc = gsel ? c : -INFINITY;
      int rank = 0;
#pragma unroll
      for (int e = 0; e < 64; ++e) { float o = __shfl(mc, e); rank += (o > mc || (o == mc && e < lane)) ? 1 : 0; }
      const bool sel = gsel && rank < 6;
      const float ssum = wave_sum(sel ? s : 0.f);
      if (sel) {
        const int slot = t * 6 + rank;
        WTS[slot] = s / ssum * 2.5f;
        const int pos = atomicAdd(&CNT[lane], 1);
        LIST[(size_t)lane * T + pos] = slot;
      }
    }
    __syncthreads();
  }
}
DEVI void st_outproj(const Params& p, int l, int vb, int nvb, char* smem) {
  const u16* Y = (const u16*)(p.ws + O_Y); const u16* W = (const u16*)(p.ws + O_WOUTT); float* XA = (float*)(p.ws + O_XA);
  for (int item = vb; item < 132 * 8; item += nvb) {
    const int m0 = (item >> 3) * 128, n0 = (item & 7) * 128;
    gemm128(p.tid, [&](int r) { return Y + (size_t)(m0 + r) * 1024; }, W + (size_t)n0 * 1024, 1024, 1024,
            [&](int r, int c, f32x4 v) {
              const int t = m0 + r; const float* gt = modp(p, l, tok_mv(t), 2) + n0 + c;
              float4* xp = (float4*)(XA + (size_t)t * 1024 + n0 + c); float4 x = *xp;
              x.x += gt[0] * v[0]; x.y += gt[1] * v[1]; x.z += gt[2] * v[2]; x.w += gt[3] * v[3]; *xp = x;
            }, smem);
  }
}

DEVI int find_expert(const int* TST, int tile) { int e = 0; while (e < 64 && tile >= TST[e + 1]) ++e; return e; }
DEVI void build_tst(const Params& p, int* tst) {
  __syncthreads();
  if (p.tid == 0) {
    const int* CNT = (const int*)(p.ws + O_CNT);
    int acc = 0;
    for (int e = 0; e < 64; ++e) { tst[e] = acc; acc += (__hip_atomic_load(&CNT[e], __ATOMIC_RELAXED, __HIP_MEMORY_SCOPE_AGENT) + 127) >> 7; }
    tst[64] = acc; tst[65] = acc + T / 128;
  }
  __syncthreads();
}
DEVI void st_moe1(const Params& p, int vb, int nvb, char* smem) {
  const int* CNT = (const int*)(p.ws + O_CNT); const int* LIST = (const int*)(p.ws + O_LIST);
  const u16* H = (const u16*)(p.ws + O_H); u16* HB = (u16*)(p.ws + O_HB);
  int* sslot = (int*)(smem + 2 * 128 * GLD * 2);
  int* TST = sslot + 128;
  build_tst(p, TST);
  const int total = TST[65];
  for (int item = vb; item < total * 4; item += nvb) {
    const int tile = item >> 2, n0 = (item & 3) * 128;
    const int e = find_expert(TST, tile);
    const int lt = tile - TST[e];
    const int cnt = e < 64 ? __hip_atomic_load(&CNT[e], __ATOMIC_RELAXED, __HIP_MEMORY_SCOPE_AGENT) : T;
    __syncthreads();
    if (p.tid < 128) {
      int i = lt * 128 + p.tid;
      int slot = -1;
      if (i < cnt) slot = e < 64 ? LIST[(size_t)e * T + i] : NSLOT + i;
      sslot[p.tid] = slot;
    }
    __syncthreads();
    gemm128(p.tid, [&](int r) { int sl = sslot[r]; int tk = sl < 0 ? 0 : (sl < NSLOT ? sl / 6 : sl - NSLOT); return H + (size_t)tk * 1024; },
            (const u16*)(p.ws + O_WGUT) + ((size_t)e * 512 + n0) * 1024, 1024, 1024,
            [&](int r, int c, f32x4 v) {
              int sl = sslot[r]; if (sl < 0) return;
              float h0 = siluf(v[0]) * v[1], h1 = siluf(v[2]) * v[3];
              *(unsigned*)(HB + (size_t)sl * 256 + ((n0 + c) >> 1)) = pack2(h0, h1);
            }, smem);
  }
}
DEVI void st_moe2(const Params& p, int vb, int nvb, char* smem) {
  const int* CNT = (const int*)(p.ws + O_CNT); const int* LIST = (const int*)(p.ws + O_LIST);
  const u16* HB = (const u16*)(p.ws + O_HB); u16* SO = (u16*)(p.ws + O_SLOT); const float* WTS = (const float*)(p.ws + O_WTS);
  int* sslot = (int*)(smem + 2 * 128 * GLD * 2);
  int* TST = sslot + 128;
  build_tst(p, TST);
  const int total = TST[64];
  for (int item = vb; item < total * 8; item += nvb) {
    const int tile = item >> 3, n0 = (item & 7) * 128;
    const int e = find_expert(TST, tile);
    const int lt = tile - TST[e];
    const int cnt = __hip_atomic_load(&CNT[e], __ATOMIC_RELAXED, __HIP_MEMORY_SCOPE_AGENT);
    __syncthreads();
    if (p.tid < 128) { int i = lt * 128 + p.tid; sslot[p.tid] = i < cnt ? LIST[(size_t)e * T + i] : -1; }
    __syncthreads();
    gemm128(p.tid, [&](int r) { int sl = sslot[r]; return HB + (size_t)(sl < 0 ? 0 : sl) * 256; },
            (const u16*)(p.ws + O_WDT) + ((size_t)e * 1024 + n0) * 256, 256, 256,
            [&](int r, int c, f32x4 v) {
              int sl = sslot[r]; if (sl < 0) return;
              const float w = WTS[sl];
              u32x2 pk; pk[0] = pack2(v[0] * w, v[1] * w); pk[1] = pack2(v[2] * w, v[3] * w);
              *(u32x2*)(SO + (size_t)sl * 1024 + n0 + c) = pk;
            }, smem);
  }
}
DEVI void st_moe3(const Params& p, int l, int vb, int nvb, char* smem) {
  const u16* HB = (const u16*)(p.ws + O_HB); const u16* SO = (const u16*)(p.ws + O_SLOT); float* XA = (float*)(p.ws + O_XA);
  for (int item = vb; item < 132 * 8; item += nvb) {
    const int m0 = (item >> 3) * 128, n0 = (item & 7) * 128;
    gemm128(p.tid, [&](int r) { return HB + (size_t)(NSLOT + m0 + r) * 256; }, (const u16*)(p.ws + O_WDT) + ((size_t)64 * 1024 + n0) * 256, 256, 256,
            [&](int r, int c, f32x4 v) {
              const int t = m0 + r; const float* gt = modp(p, l, tok_mv(t), 5) + n0 + c;
              float a0 = 0.f, a1 = 0.f, a2 = 0.f, a3 = 0.f;
#pragma unroll
              for (int k = 0; k < 6; ++k) {
                u32x2 pk = *(const u32x2*)(SO + (size_t)(t * 6 + k) * 1024 + n0 + c);
                a0 += bf2f((u16)(pk[0] & 0xffff)); a1 += bf2f((u16)(pk[0] >> 16)); a2 += bf2f((u16)(pk[1] & 0xffff)); a3 += bf2f((u16)(pk[1] >> 16));
              }
              float4* xp = (float4*)(XA + (size_t)t * 1024 + n0 + c); float4 x = *xp;
              x.x += gt[0] * (a0 + v[0]); x.y += gt[1] * (a1 + v[1]); x.z += gt[2] * (a2 + v[2]); x.w += gt[3] * (a3 + v[3]); *xp = x;
              __builtin_amdgcn_sched_barrier(0);
            }, smem);
  }
}

DEVI void st_final(const Params& p, int vb, int nvb) {
  const int lane = p.tid & 63, wid = p.tid >> 6;
  const float* g = p.in[I_FNG];
  for (int t = vb * 4 + wid; t < TL; t += nvb * 4) {
    const float4* xr = (const float4*)((const float*)(p.ws + O_XA) + (size_t)t * 1024);
    float4 v[4]; float ss = 0.f;
#pragma unroll
    for (int i = 0; i < 4; ++i) { v[i] = xr[i * 64 + lane]; ss += v[i].x * v[i].x + v[i].y * v[i].y + v[i].z * v[i].z + v[i].w * v[i].w; }
    ss = wave_sum(ss);
    const float rstd = rsqrtf(ss * (1.f / 1024.f) + 1e-6f);
    float4* o = (float4*)(p.out + (size_t)t * 1024);
#pragma unroll
    for (int i = 0; i < 4; ++i) {
      float4 gg = *(const float4*)(g + i * 256 + lane * 4);
      float4 r; r.x = v[i].x * rstd * gg.x; r.y = v[i].y * rstd * gg.y; r.z = v[i].z * rstd * gg.z; r.w = v[i].w * rstd * gg.w;
      o[i * 64 + lane] = r;
    }
  }
}

#define STAGE(call) { const Params p = mkctx(a); call; }

DEVI void grid_barrier(unsigned* cnt, unsigned target) {
  asm volatile("s_waitcnt vmcnt(0)" ::: "memory");
  __syncthreads();
  if (threadIdx.x == 0) {
    __builtin_amdgcn_fence(__ATOMIC_RELEASE, "agent");
    asm volatile("s_waitcnt vmcnt(0)" ::: "memory");
    __hip_atomic_fetch_add(cnt, 1u, __ATOMIC_RELAXED, __HIP_MEMORY_SCOPE_AGENT);
    unsigned spins = 0;
    while (__hip_atomic_load(cnt, __ATOMIC_RELAXED, __HIP_MEMORY_SCOPE_AGENT) < target) {
      __builtin_amdgcn_s_sleep(2);
      if (++spins > (1u << 26)) break;
    }
    __builtin_amdgcn_fence(__ATOMIC_ACQUIRE, "agent");
    asm volatile("s_waitcnt vmcnt(0)" ::: "memory");
  }
  __syncthreads();
}
#define GSYNC() { ++epoch; grid_barrier(bar, epoch * nblk); }

__global__ void __launch_bounds__(256, 2) mega(KArgs a) {
  extern __shared__ __attribute__((aligned(16))) char smem[];
  cg::grid_group grid = cg::this_grid();
  const int vb = blockIdx.x, nvb = gridDim.x;
  unsigned* bar = (unsigned*)(a.ws + O_BAR); unsigned epoch = 0; const unsigned nblk = gridDim.x;
  if (threadIdx.x == 0) {
    const float** tab = (const float**)(a.ws + O_TAB);
#pragma unroll
    for (int i = 0; i < 35; ++i) tab[i] = a.in[i];
  }
  __syncthreads();
  STAGE(st_copy_in(p, vb, nvb));
  STAGE(st_rope_table(p, vb, nvb));
  STAGE(st_mod(p, vb, nvb, smem));
  STAGE(st_prep_w1(p, 0, vb, nvb, smem));
  grid.sync();
  for (int l = 0; l < 2; ++l) {
    if (l == 1) STAGE(st_prep_w1(p, 1, vb, nvb, smem));
    STAGE(st_norm1(p, l, vb, nvb));
    GSYNC();
    for (int item = vb; item < 132 * 22; item += nvb) { const Params p = mkctx(a); inproj_item(p, item, smem); }
    GSYNC();
    STAGE(st_tokprep(p, l, vb, nvb));
    GSYNC();
    {
      for (int item = vb; item < 132 * 7 + NGITEM; item += nvb) {
        const Params p = mkctx(a);
        if (item < 132 * 7) mla_up_tile(p, item / 7, item % 7, smem);
        else gdn_chunk_item(p, item - 132 * 7, smem);
      }
    }
    GSYNC();
    st_mixer_queue(a, l, smem);
    GSYNC();
    STAGE(st_mix_finish(p, l, vb, nvb));
    GSYNC();
    STAGE(st_outproj(p, l, vb, nvb, smem));
    GSYNC();
    STAGE(st_norm2_route(p, l, vb, nvb, smem));
    GSYNC();
    STAGE(st_moe1(p, vb, nvb, smem));
    GSYNC();
    STAGE(st_moe2(p, vb, nvb, smem));
    GSYNC();
    STAGE(st_moe3(p, l, vb, nvb, smem));
    GSYNC();
  }
  STAGE(st_final(p, vb, nvb));
}

extern "C" void kernel_launch(void* const* d_in, const int* in_sizes, int n_in, void* d_out, int out_size, void* d_ws, size_t ws_size,
                              hipStream_t stream) {
  static int grid_blocks = 0;
  if (!grid_blocks) {
    int dev = 0, cus = 0, per_cu = 0;
    (void)hipGetDevice(&dev);
    (void)hipDeviceGetAttribute(&cus, hipDeviceAttributeMultiprocessorCount, dev);
    (void)hipFuncSetAttribute((const void*)mega, hipFuncAttributeMaxDynamicSharedMemorySize, SMEM_BYTES);
    (void)hipOccupancyMaxActiveBlocksPerMultiprocessor(&per_cu, mega, 256, SMEM_BYTES);
    if (per_cu > 2) per_cu = 2;
    if (per_cu < 1) per_cu = 1;
    grid_blocks = cus * per_cu;
  }
  KArgs p{};
  for (int i = 0; i < 35; ++i) p.in[i] = (const float*)d_in[i];
  p.out = (float*)d_out; p.ws = (char*)d_ws;
  if (ws_size < WS_NEED) { fprintf(stderr, "workspace too small: %zu < %zu\n", ws_size, (size_t)WS_NEED); return; }
  (void)hipMemsetAsync((char*)d_ws + O_BAR, 0, 256, stream);
  void* args[] = {&p};
  hipError_t e = hipLaunchCooperativeKernel((void*)mega, dim3(grid_blocks), dim3(256), args, SMEM_BYTES, stream);
  if (e != hipSuccess) fprintf(stderr, "cooperative launch failed: %s (grid %d)\n", hipGetErrorString(e), grid_blocks);
}
```

```cpp
#include <hip/hip_runtime.h>
#include <hip/hip_cooperative_groups.h>
#include <cstdio>
#include <cstdint>
namespace cg = cooperative_groups;

#define DEVI __device__ __forceinline__
typedef unsigned short u16;
using bf16x8 = __attribute__((ext_vector_type(8))) short;
using f32x4  = __attribute__((ext_vector_type(4))) float;
using f32x2  = __attribute__((ext_vector_type(2))) float;
using f32x16 = __attribute__((ext_vector_type(16))) float;
using u32x4 = __attribute__((ext_vector_type(4))) unsigned;
using u32x2 = __attribute__((ext_vector_type(2))) unsigned;
typedef __bf16 bf16x2_t __attribute__((ext_vector_type(2)));

constexpr int DM = 1024, SEQ = 8192, CTXL = 256, NKEY = SEQ + CTXL;
constexpr int TL = 2 * SEQ, TC = 2 * CTXL, T = TL + TC;
constexpr int INW = 2672;
constexpr int NIN = 2816;
constexpr int LDPP = 1408;
constexpr int PP_CQ = 0, PP_CKV = 192, PP_DQKV = 320, PP_DZ = 1088, PP_GATE = 1344;
constexpr int NE = 64, NSLOT = 6 * T;
constexpr int NCHUNK = T / 64;
constexpr int NGITEM = NCHUNK * 8;
constexpr float LOG2E = 1.4426950408889634f;

constexpr size_t al256(size_t x) { return (x + 255) & ~(size_t)255; }
constexpr size_t O_MOD   = 0;
constexpr size_t O_ROPE  = O_MOD + al256((size_t)2 * 3 * 6144 * 4);
constexpr size_t O_XA    = O_ROPE + (size_t)SEQ * 48 * 8;
constexpr size_t O_H     = O_XA + (size_t)T * DM * 4;
constexpr size_t O_WINT  = O_H + (size_t)T * DM * 2;
constexpr size_t O_WOUTT = O_WINT + (size_t)NIN * 1024 * 2;
constexpr size_t O_WUQT  = O_WOUTT + (size_t)1024 * 1024 * 2;
constexpr size_t O_WUKVT = O_WUQT + (size_t)384 * 192 * 2;
constexpr size_t O_WGUT  = O_WUKVT + (size_t)512 * 128 * 2;
constexpr size_t O_WDT   = O_WGUT + (size_t)65 * 512 * 1024 * 2;
constexpr size_t O_WTS   = O_WDT + (size_t)65 * 1024 * 256 * 2;
constexpr size_t O_CNT   = O_WTS + al256((size_t)NSLOT * 4);
constexpr size_t O_TAB   = O_CNT + 256;
constexpr size_t O_BAR   = O_TAB + 512;
constexpr size_t O_XBAR  = O_BAR + 256;
constexpr size_t O_LIST  = O_XBAR + 16384;
constexpr size_t O_R     = O_LIST + (size_t)NE * T * 4;
constexpr size_t O_Y     = O_R;
constexpr size_t O_PP    = O_Y + (size_t)T * DM * 2;
constexpr size_t O_QA    = O_PP + (size_t)T * LDPP * 2;
constexpr size_t O_KA    = O_QA + (size_t)2 * 4 * NKEY * 64 * 2;
constexpr size_t O_VTA   = O_KA + (size_t)2 * 2 * NKEY * 64 * 2;
constexpr size_t O_QB    = O_VTA + (size_t)2 * 2 * NKEY * 64 * 2;
constexpr size_t O_KB    = O_QB + (size_t)2 * 8 * NKEY * 32 * 2;
constexpr size_t O_VTB   = O_KB + (size_t)2 * 8 * NKEY * 32 * 2;
constexpr size_t O_QC    = O_VTB + (size_t)2 * 4 * NKEY * 64 * 2;
constexpr size_t O_KC    = O_QC + (size_t)2 * 4 * NKEY * 96 * 2;
constexpr size_t O_VTC   = O_KC + (size_t)2 * 4 * NKEY * 96 * 2;
constexpr size_t O_CQN   = O_VTC + (size_t)2 * 4 * NKEY * 64 * 2;
constexpr size_t O_CKVN  = O_CQN + (size_t)T * 192 * 2;
constexpr size_t O_OB    = O_CKVN + (size_t)T * 128 * 2;
constexpr size_t O_GQ    = O_OB + (size_t)T * 512 * 2;
constexpr size_t O_GK    = O_GQ + (size_t)T * 256 * 2;
constexpr size_t O_GV    = O_GK + (size_t)T * 256 * 2;
constexpr size_t O_GG    = O_GV + (size_t)T * 256 * 2;
constexpr size_t O_GBETA = O_GG + (size_t)2 * T * 4 * 4;
constexpr size_t O_GM    = O_GBETA + (size_t)2 * T * 4 * 4;
constexpr size_t O_GQP   = O_GM + (size_t)NGITEM * 4096 * 2;
constexpr size_t O_GN    = O_GQP + (size_t)NGITEM * 4096 * 2;
constexpr size_t O_GLO   = O_GN + (size_t)NGITEM * 4096 * 2;
constexpr size_t O_GO    = O_GLO + (size_t)NGITEM * 4096 * 2;
constexpr size_t O_MIX_END = O_GO + (size_t)2 * T * 256 * 4;
constexpr size_t O_HB    = O_R;
constexpr size_t O_SLOT  = O_HB + (size_t)7 * T * 256 * 2;
constexpr size_t O_MOE_END = O_SLOT + (size_t)7 * T * 1024 * 2;
constexpr size_t cmax(size_t a, size_t b) { return a > b ? a : b; }
constexpr size_t WS_NEED = cmax(O_MIX_END, O_MOE_END);
static_assert(WS_NEED < (size_t)556000000, "workspace too large");

struct KArgs {
  const float* in[35];
  float* out;
  char* ws;
};
typedef const __attribute__((address_space(1))) float gcfloat;
struct Params {
  char* ws;
  float* out;
  gcfloat* const* in;
  int tid;
};
#define pin(p, i) ((const float*)(p).in[i])
enum { I_X = 0, I_C, I_CTX, I_CCTX, I_WADA, I_BADA, I_N1G, I_N2G, I_WIN, I_WOUT, I_SINK, I_LQ1, I_LK1, I_LQ2, I_LK2,
       I_DNG, I_MQG, I_MKVG, I_WUQ, I_WUKV, I_CONVW, I_ALF, I_ALB, I_DTF, I_DTB, I_GNG, I_WR, I_RB, I_WG, I_WU, I_WD,
       I_SG, I_SU, I_SD, I_FNG };

DEVI u16 f2bf(float f) { unsigned u = __float_as_uint(f); u += 0x7fffu + ((u >> 16) & 1u); return (u16)(u >> 16); }
DEVI float bf2f(u16 h) { return __uint_as_float(((unsigned)h) << 16); }
DEVI float bflo(unsigned v) { return __uint_as_float(v << 16); }
DEVI float bfhi(unsigned v) { return __uint_as_float(v & 0xffff0000u); }
DEVI unsigned pack2(float a, float b) { f32x2 v = {a, b}; return __builtin_bit_cast(unsigned, __builtin_convertvector(v, bf16x2_t)); }
DEVI f32x4 fzero4() { float z = 0.f; asm volatile("" : "+v"(z)); return f32x4{z, z, z, z}; }
DEVI float wave_sum(float v) {
#pragma unroll
  for (int o = 32; o >= 1; o >>= 1) v += __shfl_xor(v, o);
  return v;
}
DEVI float half_sum(float v) {
#pragma unroll
  for (int o = 16; o >= 1; o >>= 1) v += __shfl_xor(v, o);
  return v;
}
DEVI float siluf(float x) { return x / (1.f + __expf(-x)); }
DEVI float sigmf(float x) { return 1.f / (1.f + __expf(-x)); }
DEVI int tok_mv(int t) { return t < TL ? (t >> 13) : 2; }
DEVI int tok_b(int t) { return t < TL ? (t >> 13) : ((t - TL) >> 8); }
DEVI int tok_row(int t) { return t < TL ? (t & (SEQ - 1)) : (SEQ + ((t - TL) & (CTXL - 1))); }
DEVI const float* modp(const Params& p, int l, int mv, int j) { return (const float*)(p.ws + O_MOD) + ((size_t)(l * 3 + mv) * 6 + j) * 1024; }

#define MFMA16(a, b, c) __builtin_amdgcn_mfma_f32_16x16x32_bf16((a), (b), (c), 0, 0, 0)
#define MFMA32(a, b, c) __builtin_amdgcn_mfma_f32_32x32x16_bf16((a), (b), (c), 0, 0, 0)

DEVI void st_copy_in(const Params& p, int vb, int nvb) {
  float4* xa = (float4*)(p.ws + O_XA);
  const float4* x = (const float4*)pin(p, I_X);
  const float4* cx = (const float4*)pin(p, I_CTX);
  const size_t n4 = (size_t)T * DM / 4, nl4 = (size_t)TL * DM / 4;
  for (size_t i = (size_t)vb * 256 + p.tid; i < n4; i += (size_t)nvb * 256) xa[i] = i < nl4 ? x[i] : cx[i - nl4];
}
DEVI void rope_cs(int i, int half, int s, float& c, float& sn) {
  const int quarter = half >> 1;
  const int ii = i < quarter ? i : i - quarter;
  const float pos = i < quarter ? (float)(s >> 6) : (float)(s & 63);
  const float inv = powf(10000.f, -(float)ii / (float)quarter);
  const float ang = pos * inv;
  c = cosf(ang); sn = sinf(ang);
}
DEVI void st_rope_table(const Params& p, int vb, int nvb) {
  f32x2* R = (f32x2*)(p.ws + O_ROPE);
  for (int e = vb * 256 + p.tid; e < SEQ * 48; e += nvb * 256) {
    const int s = e / 48, i = e % 48;
    float c, sn;
    if (i < 32) rope_cs(i, 32, s, c, sn); else rope_cs(i - 32, 16, s, c, sn);
    R[e] = f32x2{c, sn};
  }
}
DEVI void st_mod(const Params& p, int vb, int nvb, char* smem) {
  float* sv = (float*)smem;
  float* red = sv + 3 * 1024;
  for (int i = p.tid; i < 3 * 1024; i += 256) {
    int v = i >> 10, k = i & 1023;
    float c = v < 2 ? pin(p, I_C)[v * 1024 + k] : pin(p, I_CCTX)[k];
    sv[i] = siluf(c);
  }
  __syncthreads();
  const int cgp = p.tid & 7, kg = p.tid >> 3;
  for (int item = vb; item < 2 * 192; item += nvb) {
    const int l = item / 192, c0 = (item % 192) * 32;
    const float* w = pin(p, I_WADA) + (size_t)l * 1024 * 6144 + c0 + cgp * 4;
    f32x4 a0 = fzero4(), a1 = a0, a2 = a0;
#pragma unroll 8
    for (int kk = 0; kk < 32; ++kk) {
      const int k = kg * 32 + kk;
      const f32x4 wv = *(const f32x4*)(w + (size_t)k * 6144);
      a0 += sv[k] * wv; a1 += sv[1024 + k] * wv; a2 += sv[2048 + k] * wv;
    }
    float* rp = red + (kg * 8 + cgp) * 12;
    *(f32x4*)rp = a0; *(f32x4*)(rp + 4) = a1; *(f32x4*)(rp + 8) = a2;
    __syncthreads();
    if (p.tid < 96) {
      const int v = p.tid >> 5, c = p.tid & 31;
      float s = 0.f;
#pragma unroll 8
      for (int g = 0; g < 32; ++g) s += red[(g * 8 + (c >> 2)) * 12 + v * 4 + (c & 3)];
      ((float*)(p.ws + O_MOD))[(size_t)(l * 3 + v) * 6144 + c0 + c] = s + pin(p, I_BADA)[l * 6144 + c0 + c];
    }
    __syncthreads();
  }
}

template <class RowFn>
DEVI void tr_tile(int tid, const float* __restrict__ src, int N, u16* __restrict__ dst, int ldd, RowFn drow, int k0, int n0, float* tile) {
  {
    const int kq = tid >> 4, n4 = (tid & 15) * 4;
    f32x4 v[4];
#pragma unroll
    for (int r = 0; r < 4; ++r) {
      const int k = r * 16 + kq;
      v[r] = n0 + n4 < N ? *(const f32x4*)(src + (size_t)(k0 + k) * N + n0 + n4) : fzero4();
    }
#pragma unroll
    for (int r = 0; r < 4; ++r) {
      const int k = r * 16 + kq;
      tile[k * 65 + n4] = v[r][0]; tile[k * 65 + n4 + 1] = v[r][1]; tile[k * 65 + n4 + 2] = v[r][2]; tile[k * 65 + n4 + 3] = v[r][3];
    }
  }
  __syncthreads();
  {
    const int n = tid >> 2, kc = (tid & 3) * 16;
    const int dr = drow(n0 + n);
    if (dr >= 0) {
      u32x4 o0, o1;
#pragma unroll
      for (int e = 0; e < 4; ++e) {
        o0[e] = pack2(tile[(kc + 2 * e) * 65 + n], tile[(kc + 2 * e + 1) * 65 + n]);
        o1[e] = pack2(tile[(kc + 8 + 2 * e) * 65 + n], tile[(kc + 8 + 2 * e + 1) * 65 + n]);
      }
      u16* d = dst + (size_t)dr * ldd + k0 + kc;
      *(u32x4*)d = o0; *(u32x4*)(d + 8) = o1;
    }
  }
  __syncthreads();
}
DEVI int win_row(int n) {
  if (n < 1280) return n;
  if (n < 1600) return 1408 + (n - 1280);
  if (n < 1632) return 1280 + (n - 1600);
  if (n < INW) return 1408 + 320 + (n - 1632);
  return -1;
}
constexpr int TR_IN = 16 * 42, TR_OUT = 256, TR_UQ = 18, TR_UKV = 16, TR_E = 4096, TR_S = 64;
constexpr int TR_P1 = TR_IN + TR_OUT + TR_UQ + TR_UKV;
constexpr int TR_P2 = 3 * TR_E + 3 * TR_S;
DEVI void prep_w1_tile(const Params& p, int l, int it, float* tile) {
  if (it < TR_IN) { tr_tile(p.tid, pin(p, I_WIN) + (size_t)l * 1024 * INW, INW, (u16*)(p.ws + O_WINT), 1024, [](int n) { return win_row(n); }, (it / 42) * 64, (it % 42) * 64, tile); return; }
  it -= TR_IN;
  if (it < TR_OUT) { tr_tile(p.tid, pin(p, I_WOUT) + (size_t)l * 1024 * 1024, 1024, (u16*)(p.ws + O_WOUTT), 1024, [](int n) { return n; }, (it / 16) * 64, (it % 16) * 64, tile); return; }
  it -= TR_OUT;
  if (it < TR_UQ) { tr_tile(p.tid, pin(p, I_WUQ) + (size_t)l * 192 * 384, 384, (u16*)(p.ws + O_WUQT), 192, [](int n) { return n; }, (it / 6) * 64, (it % 6) * 64, tile); return; }
  it -= TR_UQ;
  tr_tile(p.tid, pin(p, I_WUKV) + (size_t)l * 128 * 512, 512, (u16*)(p.ws + O_WUKVT), 128,
          [](int n) { const int h = n >> 7, j = n & 127; return j < 64 ? h * 64 + j : 256 + h * 64 + (j - 64); }, (it / 8) * 64, (it % 8) * 64, tile);
}
DEVI void prep_w2_tile(const Params& p, int l, int it, float* tile) {
  if (it < 2 * TR_E) {
    const int which = it / TR_E; it %= TR_E;
    const int e = it >> 6, tt = it & 63;
    const float* src = pin(p, which ? I_WU : I_WG) + ((size_t)l * NE + e) * 1024 * 256;
    tr_tile(p.tid, src, 256, (u16*)(p.ws + O_WGUT) + (size_t)e * 512 * 1024, 1024, [which](int n) { return 2 * n + which; }, (tt >> 2) * 64, (tt & 3) * 64, tile); return;
  }
  it -= 2 * TR_E;
  if (it < TR_E) {
    const int e = it >> 6, tt = it & 63;
    const float* src = pin(p, I_WD) + ((size_t)l * NE + e) * 256 * 1024;
    tr_tile(p.tid, src, 1024, (u16*)(p.ws + O_WDT) + (size_t)e * 1024 * 256, 256, [](int n) { return n; }, (tt >> 4) * 64, (tt & 15) * 64, tile); return;
  }
  it -= TR_E;
  if (it < 2 * TR_S) {
    const int which = it / TR_S; const int tt = it % TR_S;
    const float* src = pin(p, which ? I_SU : I_SG) + (size_t)l * 1024 * 256;
    tr_tile(p.tid, src, 256, (u16*)(p.ws + O_WGUT) + (size_t)64 * 512 * 1024, 1024, [which](int n) { return 2 * n + which; }, (tt >> 2) * 64, (tt & 3) * 64, tile); return;
  }
  it -= 2 * TR_S;
  { const int tt = it;
    const float* src = pin(p, I_SD) + (size_t)l * 256 * 1024;
    tr_tile(p.tid, src, 1024, (u16*)(p.ws + O_WDT) + (size_t)64 * 1024 * 256, 256, [](int n) { return n; }, (tt >> 4) * 64, (tt & 15) * 64, tile); }
}
DEVI void st_prep_w1(const Params& p, int l, int vb, int nvb, char* smem) {
  float* tile = (float*)smem;
  if (vb == 0 && p.tid < 64) ((int*)(p.ws + O_CNT))[p.tid] = 0;
  for (int e = vb * 256 + p.tid; e < 144 * 128; e += nvb * 256) {
    const int r = e >> 7, c8 = e & 127;
    const int row = r < 96 ? 1312 + r : 2768 + (r - 96);
    *(u32x4*)((u16*)(p.ws + O_WINT) + (size_t)row * 1024 + c8 * 8) = __builtin_bit_cast(u32x4, fzero4());
  }
  for (int item = vb; item < TR_P1; item += nvb) prep_w1_tile(p, l, item, tile);
}

DEVI void st_norm1(const Params& p, int l, int vb, int nvb) {
  const int lane = p.tid & 63, wid = p.tid >> 6;
  const float* g = pin(p, I_N1G) + l * 1024;
  for (int t4 = (vb * 4 + wid) * 4; t4 < T; t4 += nvb * 16) {
    const int mv = tok_mv(t4);
    const float* sh = modp(p, l, mv, 0); const float* sc = modp(p, l, mv, 1);
    f32x4 v[4][4]; float ss[4];
#pragma unroll
    for (int u = 0; u < 4; ++u) {
      const f32x4* xr = (const f32x4*)((const float*)(p.ws + O_XA) + (size_t)(t4 + u) * 1024);
#pragma unroll
      for (int i = 0; i < 4; ++i) v[u][i] = xr[i * 64 + lane];
    }
#pragma unroll
    for (int u = 0; u < 4; ++u) {
      float a = 0.f;
#pragma unroll
      for (int i = 0; i < 4; ++i) a += v[u][i][0] * v[u][i][0] + v[u][i][1] * v[u][i][1] + v[u][i][2] * v[u][i][2] + v[u][i][3] * v[u][i][3];
      ss[u] = a;
    }
#pragma unroll
    for (int o = 32; o >= 1; o >>= 1) {
#pragma unroll
      for (int u = 0; u < 4; ++u) ss[u] += __shfl_xor(ss[u], o);
    }
#pragma unroll
    for (int i = 0; i < 4; ++i) {
      const int c = i * 256 + lane * 4;
      const f32x4 gg = *(const f32x4*)(g + c), s4 = *(const f32x4*)(sc + c), h4 = *(const f32x4*)(sh + c);
      const f32x4 gs = gg * (1.f + s4);
#pragma unroll
      for (int u = 0; u < 4; ++u) {
        const float rstd = rsqrtf(ss[u] * (1.f / 1024.f) + 1e-6f);
        const f32x4 o = v[u][i] * rstd * gs + h4;
        u32x2 pk; pk[0] = pack2(o[0], o[1]); pk[1] = pack2(o[2], o[3]);
        *(u32x2*)((u16*)(p.ws + O_H) + (size_t)(t4 + u) * 1024 + c) = pk;
      }
    }
  }
}

constexpr int GLD = 72;
template <bool SWAP, class ARow>
DEVI void gemm_core(int tid, ARow arow, const u16* __restrict__ Bt, int ldb, int K, f32x4 (&acc)[4][4], char* smem) {
  u16* sA = (u16*)smem; u16* sB = sA + 128 * GLD;
  const int lane = tid & 63, wid = tid >> 6, wr = wid >> 1, wc = wid & 1, fr = lane & 15, fq = lane >> 4;
  const u16* ap[4]; const u16* bp[4];
#pragma unroll
  for (int i = 0; i < 4; ++i) { int q = tid + 256 * i, row = q >> 3, cc = q & 7; ap[i] = arow(row) + cc * 8; bp[i] = Bt + (size_t)row * ldb + cc * 8; }
  u32x4 ra[4], rb[4];
#pragma unroll
  for (int i = 0; i < 4; ++i) { ra[i] = *(const u32x4*)ap[i]; rb[i] = *(const u32x4*)bp[i]; }
#pragma unroll
  for (int m = 0; m < 4; ++m)
#pragma unroll
    for (int n = 0; n < 4; ++n) acc[m][n] = fzero4();
  const int nk = K >> 6;
  for (int kt = 0; kt < nk; ++kt) {
    __syncthreads();
#pragma unroll
    for (int i = 0; i < 4; ++i) { int q = tid + 256 * i, row = q >> 3, cc = q & 7; *(u32x4*)&sA[row * GLD + cc * 8] = ra[i]; *(u32x4*)&sB[row * GLD + cc * 8] = rb[i]; }
    __syncthreads();
    if (kt + 1 < nk) {
#pragma unroll
      for (int i = 0; i < 4; ++i) { ra[i] = *(const u32x4*)(ap[i] + (kt + 1) * 64); rb[i] = *(const u32x4*)(bp[i] + (kt + 1) * 64); }
    }
#pragma unroll
    for (int ks = 0; ks < 2; ++ks) {
      bf16x8 af[4], bfr[4];
#pragma unroll
      for (int m = 0; m < 4; ++m) af[m] = *(const bf16x8*)&sA[(wr * 64 + m * 16 + fr) * GLD + ks * 32 + fq * 8];
#pragma unroll
      for (int n = 0; n < 4; ++n) bfr[n] = *(const bf16x8*)&sB[(wc * 64 + n * 16 + fr) * GLD + ks * 32 + fq * 8];
#pragma unroll
      for (int m = 0; m < 4; ++m)
#pragma unroll
        for (int n = 0; n < 4; ++n) acc[m][n] = SWAP ? MFMA16(af[m], bfr[n], acc[m][n]) : MFMA16(bfr[n], af[m], acc[m][n]);
    }
  }
  __syncthreads();
}
template <class ARow, class Epi>
DEVI void gemm128(int tid, ARow arow, const u16* __restrict__ Bt, int ldb, int K, Epi epi, char* smem) {
  f32x4 acc[4][4];
  gemm_core<false>(tid, arow, Bt, ldb, K, acc, smem);
  const int lane = tid & 63, wid = tid >> 6, wr = wid >> 1, wc = wid & 1, fr = lane & 15, fq = lane >> 4;
#pragma unroll
  for (int m = 0; m < 4; ++m)
#pragma unroll
    for (int n = 0; n < 4; ++n) epi(wr * 64 + m * 16 + fr, wc * 64 + n * 16 + fq * 4, acc[m][n]);
}

DEVI void rope4(const f32x4 x1, const f32x4 x2, const f32x2* rp, bool lat, float scale, u32x2& o1, u32x2& o2) {
  f32x4 s = fzero4(), c = s + 1.f;
  if (lat) {
    const f32x4 a = *(const f32x4*)rp, b = *(const f32x4*)(rp + 2);
    c = f32x4{a[0], a[2], b[0], b[2]}; s = f32x4{a[1], a[3], b[1], b[3]};
  }
  const f32x4 y1 = (x1 * c - x2 * s) * scale, y2 = (x2 * c + x1 * s) * scale;
  o1[0] = pack2(y1[0], y1[1]); o1[1] = pack2(y1[2], y1[3]);
  o2[0] = pack2(y2[0], y2[1]); o2[1] = pack2(y2[2], y2[3]);
}
DEVI void inproj_item(const Params& p, int item, char* smem) {
  const u16* H = (const u16*)(p.ws + O_H); const u16* W = (const u16*)(p.ws + O_WINT);
  const f32x2* ROPE = (const f32x2*)(p.ws + O_ROPE);
  const int tid = p.tid, lane = tid & 63, wid = tid >> 6, wr = wid >> 1, wc = wid & 1, fr = lane & 15, fq = lane >> 4;
  {
    const int m0 = (item / 22) * 128, nt = item % 22;
    const bool lat = m0 < TL;
    const int b = tok_b(m0), rowbase = tok_row(m0);
    f32x4 acc[4][4];
    auto arow = [&](int r) { return H + (size_t)(m0 + r) * 1024; };
    if (nt == 3 || nt == 8 || nt == 9) {
      gemm_core<true>(tid, arow, W + (size_t)nt * 128 * 1024, 1024, 1024, acc, smem);
      u16* vt = nt == 3 ? (u16*)(p.ws + O_VTA) + (size_t)(b * 2 + wc) * 64 * NKEY
                        : (u16*)(p.ws + O_VTB) + (size_t)(b * 4 + (nt - 8) * 2 + wc) * 64 * NKEY;
#pragma unroll
      for (int m = 0; m < 4; ++m)
#pragma unroll
        for (int n = 0; n < 4; ++n) {
          u32x2 pk; pk[0] = pack2(acc[m][n][0], acc[m][n][1]); pk[1] = pack2(acc[m][n][2], acc[m][n][3]);
          *(u32x2*)(vt + (size_t)(n * 16 + fr) * NKEY + rowbase + wr * 64 + m * 16 + (((fq & 1) << 1) | (fq >> 1)) * 4) = pk;
        }
      return;
    }
    gemm_core<false>(tid, arow, W + (size_t)nt * 128 * 1024, 1024, 1024, acc, smem);
    if (nt < 3) {
      u16* dst; float scale;
      if (nt < 2) { dst = (u16*)(p.ws + O_QA) + ((size_t)(b * 4 + nt * 2 + wc) * NKEY + rowbase) * 64; scale = 0.125f * LOG2E; }
      else { dst = (u16*)(p.ws + O_KA) + ((size_t)(b * 2 + wc) * NKEY + rowbase) * 64; scale = 1.f; }
#pragma unroll
      for (int m = 0; m < 4; ++m) {
        const int rl = wr * 64 + m * 16 + fr;
#pragma unroll
        for (int pi = 0; pi < 2; ++pi) {
          const int d0 = pi * 16 + fq * 4;
          u32x2 o1, o2;
          rope4(acc[m][pi], acc[m][pi + 2], ROPE + (size_t)(rowbase + rl) * 48 + d0, lat, scale, o1, o2);
          *(u32x2*)(dst + (size_t)rl * 64 + d0) = o1; *(u32x2*)(dst + (size_t)rl * 64 + 32 + d0) = o2;
        }
      }
    } else if (nt < 8) {
      const bool isq = nt < 6;
      u16* base = isq ? (u16*)(p.ws + O_QB) : (u16*)(p.ws + O_KB);
      const float scale = isq ? 0.17677669529663687f * LOG2E : 1.f;
      const int hm0 = ((nt - 4) & 1) * 4 + wc * 2;
#pragma unroll
      for (int m = 0; m < 4; ++m) {
        const int rl = wr * 64 + m * 16 + fr;
#pragma unroll
        for (int g = 0; g < 2; ++g) {
          u16* dst = base + ((size_t)(b * 8 + hm0 + g) * NKEY + rowbase + rl) * 32;
          u32x2 o1, o2;
          rope4(acc[m][2 * g], acc[m][2 * g + 1], ROPE + (size_t)(rowbase + rl) * 48 + 32 + fq * 4, lat, scale, o1, o2);
          *(u32x2*)(dst + fq * 4) = o1; *(u32x2*)(dst + 16 + fq * 4) = o2;
        }
      }
    } else if (nt == 10) {
      if (wc == 0) {
#pragma unroll
        for (int m = 0; m < 4; ++m) {
          const int rl = wr * 64 + m * 16 + fr;
          u32x2 o1, o2;
          rope4(acc[m][0], acc[m][1], ROPE + (size_t)(rowbase + rl) * 48 + 32 + fq * 4, lat, 1.f, o1, o2);
#pragma unroll
          for (int h = 0; h < 4; ++h) {
            u16* dst = (u16*)(p.ws + O_KC) + ((size_t)(b * 4 + h) * NKEY + rowbase + rl) * 96 + 64;
            *(u32x2*)(dst + fq * 4) = o1; *(u32x2*)(dst + 16 + fq * 4) = o2;
          }
        }
      }
    } else {
      u16* PP = (u16*)(p.ws + O_PP);
#pragma unroll
      for (int m = 0; m < 4; ++m)
#pragma unroll
        for (int n = 0; n < 4; ++n) {
          u32x2 pk; pk[0] = pack2(acc[m][n][0], acc[m][n][1]); pk[1] = pack2(acc[m][n][2], acc[m][n][3]);
          *(u32x2*)(PP + (size_t)(m0 + wr * 64 + m * 16 + fr) * LDPP + (nt - 11) * 128 + wc * 64 + n * 16 + fq * 4) = pk;
        }
    }
  }
}

DEVI void st_tokprep(const Params& p, int l, int vb, int nvb) {
  const int lane = p.tid & 63, wid = p.tid >> 6;
  const u16* PP = (const u16*)(p.ws + O_PP);
  u16* GQ = (u16*)(p.ws + O_GQ); u16* GK = (u16*)(p.ws + O_GK); u16* GV = (u16*)(p.ws + O_GV);
  float* GG = (float*)(p.ws + O_GG); float* GB = (float*)(p.ws + O_GBETA);
  u16* CQN = (u16*)(p.ws + O_CQN); u16* CKVN = (u16*)(p.ws + O_CKVN);
  const float* cwp = pin(p, I_CONVW) + (size_t)l * 5 * 768;
  f32x2 cw[6][5];
#pragma unroll
  for (int i = 0; i < 6; ++i)
#pragma unroll
    for (int j = 0; j < 5; ++j) cw[i][j] = *(const f32x2*)(cwp + j * 768 + 2 * lane + 128 * i);
  const float* gq = pin(p, I_MQG) + l * 192; const float* gkv = pin(p, I_MKVG) + l * 128;
  const float gq0 = gq[lane], gq1 = gq[64 + lane], gq2 = gq[128 + lane], gk0 = gkv[lane], gk1 = gkv[64 + lane];
  for (int t = vb * 4 + wid; t < T; t += nvb * 4) {
    int base, pos, len;
    if (t < TL) { base = t & ~(SEQ - 1); pos = t & (SEQ - 1); len = SEQ; } else { int j = t - TL; base = TL + (j & ~(CTXL - 1)); pos = j & (CTXL - 1); len = CTXL; }
    unsigned xin[5][6];
#pragma unroll
    for (int j = 0; j < 5; ++j) {
      const int pp = pos + j - 2;
      const bool ok = pp >= 0 && pp < len;
      const u16* row = PP + (size_t)(base + (ok ? pp : pos)) * LDPP + PP_DQKV + 2 * lane;
#pragma unroll
      for (int i = 0; i < 6; ++i) { unsigned v = *(const unsigned*)(row + 128 * i); xin[j][i] = ok ? v : 0u; }
    }
    const u16* pr = PP + (size_t)t * LDPP;
    const float q0 = bf2f(pr[PP_CQ + lane]), q1 = bf2f(pr[PP_CQ + 64 + lane]), q2 = bf2f(pr[PP_CQ + 128 + lane]);
    const float k0 = bf2f(pr[PP_CKV + lane]), k1 = bf2f(pr[PP_CKV + 64 + lane]);
    const float gate_in = lane < 16 ? bf2f(pr[PP_GATE + lane]) : 0.f;
#pragma unroll
    for (int i = 0; i < 6; ++i) {
      float a0 = 0.f, a1 = 0.f;
#pragma unroll
      for (int j = 0; j < 5; ++j) { a0 += cw[i][j][0] * bflo(xin[j][i]); a1 += cw[i][j][1] * bfhi(xin[j][i]); }
      float y0 = siluf(a0), y1 = siluf(a1);
      const int c = 2 * lane + 128 * i;
      if (i < 4) {
        const float ss = half_sum(y0 * y0 + y1 * y1);
        const float r = rsqrtf(ss + 1e-6f) * (i < 2 ? 0.125f : 1.f);
        u16* dst = i < 2 ? GQ + (size_t)t * 256 + c : GK + (size_t)t * 256 + (c - 256);
        *(unsigned*)dst = pack2(y0 * r, y1 * r);
      } else *(unsigned*)(GV + (size_t)t * 256 + (c - 512)) = pack2(y0, y1);
    }
    if (lane < 16) {
      const int which = lane >> 2, hd = lane & 3;
      if (which < 2) {
        const float al = which ? pin(p, I_ALB)[l * 4 + hd] : pin(p, I_ALF)[l * 4 + hd];
        const float dt = which ? pin(p, I_DTB)[l * 4 + hd] : pin(p, I_DTF)[l * 4 + hd];
        const float xx = gate_in + dt;
        const float sp = fmaxf(xx, 0.f) + log1pf(expf(-fabsf(xx)));
        GG[((size_t)which * T + t) * 4 + hd] = -expf(al) * sp;
      } else GB[((size_t)(which - 2) * T + t) * 4 + hd] = sigmf(gate_in);
    }
    {
      float ss = q0 * q0 + q1 * q1 + q2 * q2, s2 = k0 * k0 + k1 * k1;
#pragma unroll
      for (int o = 32; o >= 1; o >>= 1) { ss += __shfl_xor(ss, o); s2 += __shfl_xor(s2, o); }
      const float rs = rsqrtf(ss * (1.f / 192.f) + 1e-6f), r2 = rsqrtf(s2 * (1.f / 128.f) + 1e-6f);
      u16* d = CQN + (size_t)t * 192;
      d[lane] = f2bf(q0 * rs * gq0); d[64 + lane] = f2bf(q1 * rs * gq1); d[128 + lane] = f2bf(q2 * rs * gq2);
      u16* d2 = CKVN + (size_t)t * 128;
      d2[lane] = f2bf(k0 * r2 * gk0); d2[64 + lane] = f2bf(k1 * r2 * gk1);
    }
  }
}

DEVI void mla_up_tile(const Params& p, int mt, int nn, char* smem) {
  const int tid = p.tid, lane = tid & 63, wid = tid >> 6, wr = wid >> 1, wc = wid & 1, fr = lane & 15, fq = lane >> 4;
  const int m0 = mt * 128;
  const bool lat = m0 < TL;
  const int b = tok_b(m0), rowbase = tok_row(m0);
  f32x4 acc[4][4];
  if (nn < 3) {
    const u16* CQN = (const u16*)(p.ws + O_CQN);
    gemm_core<false>(tid, [&](int r) { return CQN + (size_t)(m0 + r) * 192; }, (const u16*)(p.ws + O_WUQT) + (size_t)nn * 128 * 192, 192, 192, acc, smem);
    const f32x2* ROPE = (const f32x2*)(p.ws + O_ROPE);
    const float scale = 0.10206207261596577f * LOG2E;
    u16* QC = (u16*)(p.ws + O_QC);
#pragma unroll
    for (int m = 0; m < 4; ++m) {
      const int rl = wr * 64 + m * 16 + fr;
#pragma unroll
      for (int n = 0; n < 4; ++n) {
        const int cb = nn * 128 + wc * 64 + n * 16;
        const int h = cb / 96, db = cb - h * 96;
        u16* dst = QC + ((size_t)(b * 4 + h) * NKEY + rowbase + rl) * 96;
        if (db < 64) {
          u32x2 pk; pk[0] = pack2(acc[m][n][0] * scale, acc[m][n][1] * scale); pk[1] = pack2(acc[m][n][2] * scale, acc[m][n][3] * scale);
          *(u32x2*)(dst + db + fq * 4) = pk;
        } else if (db == 64 && n < 3) {
          u32x2 o1, o2;
          rope4(acc[m][n], acc[m][n + 1], ROPE + (size_t)(rowbase + rl) * 48 + 32 + fq * 4, lat, scale, o1, o2);
          *(u32x2*)(dst + 64 + fq * 4) = o1; *(u32x2*)(dst + 80 + fq * 4) = o2;
        }
      }
    }
  } else {
    const u16* CKVN = (const u16*)(p.ws + O_CKVN);
    auto arow = [&](int r) { return CKVN + (size_t)(m0 + r) * 128; };
    const u16* Wt = (const u16*)(p.ws + O_WUKVT) + (size_t)(nn - 3) * 128 * 128;
    if (nn < 5) {
      gemm_core<false>(tid, arow, Wt, 128, 128, acc, smem);
      u16* KC = (u16*)(p.ws + O_KC) + ((size_t)(b * 4 + (nn - 3) * 2 + wc) * NKEY + rowbase) * 96;
#pragma unroll
      for (int m = 0; m < 4; ++m)
#pragma unroll
        for (int n = 0; n < 4; ++n) {
          u32x2 pk; pk[0] = pack2(acc[m][n][0], acc[m][n][1]); pk[1] = pack2(acc[m][n][2], acc[m][n][3]);
          *(u32x2*)(KC + (size_t)(wr * 64 + m * 16 + fr) * 96 + n * 16 + fq * 4) = pk;
        }
    } else {
      gemm_core<true>(tid, arow, Wt, 128, 128, acc, smem);
      u16* vt = (u16*)(p.ws + O_VTC) + (size_t)(b * 4 + (nn - 5) * 2 + wc) * 64 * NKEY;
#pragma unroll
      for (int m = 0; m < 4; ++m)
#pragma unroll
        for (int n = 0; n < 4; ++n) {
          u32x2 pk; pk[0] = pack2(acc[m][n][0], acc[m][n][1]); pk[1] = pack2(acc[m][n][2], acc[m][n][3]);
          *(u32x2*)(vt + (size_t)(n * 16 + fr) * NKEY + rowbase + wr * 64 + m * 16 + (((fq & 1) << 1) | (fq >> 1)) * 4) = pk;
        }
    }
  }
}
DEVI int permcol(int x) { return (x & 32) + 8 * ((x >> 2) & 3) + 4 * ((x >> 4) & 1) + (x & 3); }
DEVI int cidx(int d, int e) { return ((((e >> 4) * 4 + (d >> 4)) * 64) + (e & 15) + 16 * ((d >> 2) & 3)) * 4 + (d & 3); }
DEVI int gdn_chunk_t0(int ci) { return ci < 256 ? (ci >> 7) * SEQ + (ci & 127) * 64 : TL + ((ci - 256) >> 2) * CTXL + ((ci - 256) & 3) * 64; }

DEVI void gdn_chunk_item(const Params& p, int item, char* smem) {
  u16* sK = (u16*)smem;
  float* sA = (float*)(smem + 9216);
  u16* sXt = (u16*)smem;
  u16* sAt = (u16*)(smem + 26624);
  u16* sKt = (u16*)(smem + 35840);
  float* sX = (float*)(smem + 45056);
  float* sgc = (float*)(smem + 77824); float* sbeta = sgc + 64; float* seg = sbeta + 64; float* skd = seg + 64;
  const u16* GQ = (const u16*)(p.ws + O_GQ); const u16* GK = (const u16*)(p.ws + O_GK); const u16* GV = (const u16*)(p.ws + O_GV);
  const float* GG = (const float*)(p.ws + O_GG); const float* GB = (const float*)(p.ws + O_GBETA);
  u16* GM = (u16*)(p.ws + O_GM); u16* GQP = (u16*)(p.ws + O_GQP); u16* GN = (u16*)(p.ws + O_GN); u16* GLO = (u16*)(p.ws + O_GLO);
  const int tid = p.tid, lane = tid & 63, w = tid >> 6, i15 = lane & 15, q = lane >> 4;
  {
    const int ci = item >> 3, hd = (item >> 1) & 3, dir = item & 1;
    const int t0 = gdn_chunk_t0(ci);
    auto tok = [&](int i) { return dir ? t0 + 63 - i : t0 + i; };
    __syncthreads();
    if (tid < 64) {
      float g = GG[((size_t)dir * T + tok(tid)) * 4 + hd];
#pragma unroll
      for (int o = 1; o < 64; o <<= 1) { float u = __shfl_up(g, o); if (lane >= o) g += u; }
      const float gl = __shfl(g, 63);
      sgc[tid] = g; sbeta[tid] = GB[((size_t)dir * T + tok(tid)) * 4 + hd]; seg[tid] = expf(g); skd[tid] = expf(gl - g);
    }
    __syncthreads();
    const float eglast = seg[63];
#pragma unroll
    for (int i = 0; i < 2; ++i) {
      const int ch = tid + 256 * i, j = ch >> 3, cc = ch & 7;
      const u32x4 kv = *(const u32x4*)(GK + (size_t)tok(j) * 256 + hd * 64 + cc * 8);
      *(u32x4*)&sK[j * 72 + cc * 8] = kv;
      const float kd = skd[j];
#pragma unroll
      for (int e = 0; e < 4; ++e) {
        sKt[(cc * 8 + 2 * e) * 72 + j] = f2bf(bf2f((u16)(kv[e] & 0xffff)) * kd);
        sKt[(cc * 8 + 2 * e + 1) * 72 + j] = f2bf(bf2f((u16)(kv[e] >> 16)) * kd);
      }
    }
    for (int e = tid; e < 64 * 64; e += 256) {
      const int j = e >> 6, c = e & 63;
      sX[j * 128 + c] = bf2f(GV[(size_t)tok(j) * 256 + hd * 64 + c]) * sbeta[j];
    }
    __syncthreads();
    for (int e = tid; e < 64 * 64; e += 256) {
      const int j = e >> 6, c = e & 63;
      sX[j * 128 + 64 + c] = bf2f(sK[j * 72 + c]) * sbeta[j] * seg[j];
    }
    {
      f32x4 kk[4], qk[4];
#pragma unroll
      for (int nt = 0; nt < 4; ++nt) { kk[nt] = fzero4(); qk[nt] = fzero4(); }
#pragma unroll
      for (int ks = 0; ks < 2; ++ks) {
        const bf16x8 ak = *(const bf16x8*)&sK[(16 * w + i15) * 72 + ks * 32 + q * 8];
        const bf16x8 aq = *(const bf16x8*)(GQ + (size_t)tok(16 * w + i15) * 256 + hd * 64 + ks * 32 + q * 8);
#pragma unroll
        for (int nt = 0; nt < 4; ++nt) {
          const bf16x8 bk = *(const bf16x8*)&sK[(16 * nt + i15) * 72 + ks * 32 + q * 8];
          kk[nt] = MFMA16(ak, bk, kk[nt]); qk[nt] = MFMA16(aq, bk, qk[nt]);
        }
      }
#pragma unroll
      for (int nt = 0; nt < 4; ++nt)
#pragma unroll
        for (int r = 0; r < 4; ++r) {
          const int i = 16 * w + 4 * q + r, j = 16 * nt + i15;
          const float dec = i >= j ? expf(sgc[i] - sgc[j]) : 0.f;
          sA[i * 68 + j] = i > j ? sbeta[i] * kk[nt][r] * dec : 0.f;
          sAt[i * 72 + j] = f2bf(i >= j ? qk[nt][r] * dec : 0.f);
        }
    }
    __syncthreads();
    if (tid < 128) {
      const int c = tid;
      for (int ib = 0; ib < 16; ++ib) {
        float a0 = sX[(4 * ib) * 128 + c], a1 = sX[(4 * ib + 1) * 128 + c], a2 = sX[(4 * ib + 2) * 128 + c], a3 = sX[(4 * ib + 3) * 128 + c];
#pragma unroll 2
        for (int g = 0; g < ib; ++g) {
          const float x0 = sX[(4 * g) * 128 + c], x1 = sX[(4 * g + 1) * 128 + c], x2 = sX[(4 * g + 2) * 128 + c], x3 = sX[(4 * g + 3) * 128 + c];
          const f32x4 r0 = *(const f32x4*)&sA[(4 * ib) * 68 + 4 * g], r1 = *(const f32x4*)&sA[(4 * ib + 1) * 68 + 4 * g];
          const f32x4 r2 = *(const f32x4*)&sA[(4 * ib + 2) * 68 + 4 * g], r3 = *(const f32x4*)&sA[(4 * ib + 3) * 68 + 4 * g];
          a0 -= r0[0] * x0 + r0[1] * x1 + r0[2] * x2 + r0[3] * x3;
          a1 -= r1[0] * x0 + r1[1] * x1 + r1[2] * x2 + r1[3] * x3;
          a2 -= r2[0] * x0 + r2[1] * x1 + r2[2] * x2 + r2[3] * x3;
          a3 -= r3[0] * x0 + r3[1] * x1 + r3[2] * x2 + r3[3] * x3;
        }
        const f32x4 d1 = *(const f32x4*)&sA[(4 * ib + 1) * 68 + 4 * ib], d2 = *(const f32x4*)&sA[(4 * ib + 2) * 68 + 4 * ib], d3 = *(const f32x4*)&sA[(4 * ib + 3) * 68 + 4 * ib];
        a1 -= d1[0] * a0;
        a2 -= d2[0] * a0 + d2[1] * a1;
        a3 -= d3[0] * a0 + d3[1] * a1 + d3[2] * a2;
        sX[(4 * ib) * 128 + c] = a0; sX[(4 * ib + 1) * 128 + c] = a1; sX[(4 * ib + 2) * 128 + c] = a2; sX[(4 * ib + 3) * 128 + c] = a3;
      }
    }
    __syncthreads();
    {
      const int c = tid & 127, jh = (tid >> 7) * 32;
#pragma unroll
      for (int g = 0; g < 4; ++g) {
        u32x4 pk;
#pragma unroll
        for (int e = 0; e < 4; ++e) pk[e] = pack2(sX[(jh + 8 * g + 2 * e) * 128 + c], sX[(jh + 8 * g + 2 * e + 1) * 128 + c]);
        *(u32x4*)&sXt[c * 72 + jh + 8 * g] = pk;
      }
    }
    __syncthreads();
    {
      f32x4 r1[8], r2[8];
#pragma unroll
      for (int ct = 0; ct < 8; ++ct) { r1[ct] = fzero4(); r2[ct] = fzero4(); }
#pragma unroll
      for (int ks = 0; ks < 2; ++ks) {
        const bf16x8 aa = *(const bf16x8*)&sAt[(16 * w + i15) * 72 + ks * 32 + q * 8];
        const bf16x8 ak = *(const bf16x8*)&sKt[(16 * w + i15) * 72 + ks * 32 + q * 8];
#pragma unroll
        for (int ct = 0; ct < 8; ++ct) {
          const bf16x8 bx = *(const bf16x8*)&sXt[(16 * ct + i15) * 72 + ks * 32 + q * 8];
          r1[ct] = MFMA16(aa, bx, r1[ct]); r2[ct] = MFMA16(ak, bx, r2[ct]);
        }
      }
      const size_t ib = (size_t)item * 4096;
#pragma unroll
      for (int ct = 0; ct < 4; ++ct) {
        u32x2 a, b;
        a[0] = pack2(r1[ct][0], r1[ct][1]); a[1] = pack2(r1[ct][2], r1[ct][3]);
        b[0] = pack2(r2[ct][0], r2[ct][1]); b[1] = pack2(r2[ct][2], r2[ct][3]);
        *(u32x2*)(GLO + ib + ((ct * 4 + w) * 64 + lane) * 4) = a;
        *(u32x2*)(GN + ib + ((ct * 4 + w) * 64 + lane) * 4) = b;
      }
#pragma unroll
      for (int ct = 4; ct < 8; ++ct)
#pragma unroll
        for (int r = 0; r < 4; ++r) {
          const int row = 16 * w + 4 * q + r, col = 16 * (ct - 4) + i15;
          const float qv = bf2f(GQ[(size_t)tok(row) * 256 + hd * 64 + col]);
          GQP[ib + row * 64 + permcol(col)] = f2bf(qv * seg[row] - r1[ct][r]);
          GM[ib + row * 64 + permcol(col)] = f2bf((row == col ? eglast : 0.f) - r2[ct][r]);
        }
    }
    __syncthreads();
  }
}

DEVI void gdn_scan_chain(const Params& p, int chain, char* smem) {
  const int tid = p.tid, lane = tid & 63, w = tid >> 6, i15 = lane & 15, q = lane >> 4;
  u16* sM = (u16*)smem;
  u16* sQ = sM + 2 * 64 * 72;
  const u16* GM = (const u16*)(p.ws + O_GM); const u16* GQP = (const u16*)(p.ws + O_GQP);
  const u16* GN = (const u16*)(p.ws + O_GN); const u16* GLO = (const u16*)(p.ws + O_GLO);
  float* GO = (float*)(p.ws + O_GO);
  {
    const int b = chain >> 3, hd = (chain >> 1) & 3, dir = chain & 1;
    f32x4 S[4];
#pragma unroll
    for (int r = 0; r < 4; ++r) S[r] = fzero4();
    auto item_of = [&](int n) {
      int ci = n < 4 ? 256 + b * 4 + (dir ? 3 - n : n) : b * 128 + (dir ? 127 - (n - 4) : (n - 4));
      return ci * 8 + hd * 2 + dir;
    };
    u32x4 pm[2], pq[2]; u32x2 pn[4], pl[4];
    auto prefetch = [&](int n) {
      const size_t base = (size_t)item_of(n) * 4096;
#pragma unroll
      for (int i = 0; i < 2; ++i) {
        const int ch = tid + 256 * i;
        pm[i] = *(const u32x4*)(GM + base + ch * 8);
        pq[i] = *(const u32x4*)(GQP + base + ch * 8);
      }
#pragma unroll
      for (int rb = 0; rb < 4; ++rb) {
        pn[rb] = *(const u32x2*)(GN + base + ((w * 4 + rb) * 64 + lane) * 4);
        pl[rb] = *(const u32x2*)(GLO + base + ((w * 4 + rb) * 64 + lane) * 4);
      }
    };
    prefetch(0);
    __syncthreads();
    for (int n = 0; n < 132; ++n) {
      const int buf = n & 1;
      u16* bM = sM + buf * 64 * 72; u16* bQ = sQ + buf * 64 * 72;
#pragma unroll
      for (int i = 0; i < 2; ++i) {
        const int ch = tid + 256 * i, row = ch >> 3, cc = ch & 7;
        *(u32x4*)&bM[row * 72 + cc * 8] = pm[i];
        *(u32x4*)&bQ[row * 72 + cc * 8] = pq[i];
      }
      f32x4 accs[4], acco[4];
#pragma unroll
      for (int rb = 0; rb < 4; ++rb) {
        accs[rb] = f32x4{bf2f((u16)(pn[rb][0] & 0xffff)), bf2f((u16)(pn[rb][0] >> 16)), bf2f((u16)(pn[rb][1] & 0xffff)), bf2f((u16)(pn[rb][1] >> 16))};
        acco[rb] = f32x4{bf2f((u16)(pl[rb][0] & 0xffff)), bf2f((u16)(pl[rb][0] >> 16)), bf2f((u16)(pl[rb][1] & 0xffff)), bf2f((u16)(pl[rb][1] >> 16))};
      }
      const int ci = n < 4 ? 256 + b * 4 + (dir ? 3 - n : n) : b * 128 + (dir ? 127 - (n - 4) : (n - 4));
      const int t0 = gdn_chunk_t0(ci);
      __syncthreads();
      if (n + 1 < 132) prefetch(n + 1);
      bf16x8 sb[2];
#pragma unroll
      for (int kb = 0; kb < 2; ++kb)
#pragma unroll
        for (int jj = 0; jj < 8; ++jj) sb[kb][jj] = (short)f2bf(S[2 * kb + (jj >> 2)][jj & 3]);
#pragma unroll
      for (int kb = 0; kb < 2; ++kb)
#pragma unroll
        for (int rb = 0; rb < 4; ++rb) {
          const bf16x8 am = *(const bf16x8*)&bM[(rb * 16 + i15) * 72 + kb * 32 + q * 8];
          const bf16x8 aq = *(const bf16x8*)&bQ[(rb * 16 + i15) * 72 + kb * 32 + q * 8];
          accs[rb] = MFMA16(am, sb[kb], accs[rb]);
          acco[rb] = MFMA16(aq, sb[kb], acco[rb]);
        }
#pragma unroll
      for (int rb = 0; rb < 4; ++rb) {
        S[rb] = accs[rb];
#pragma unroll
        for (int r = 0; r < 4; ++r) {
          const int i = rb * 16 + q * 4 + r;
          const int t = dir ? t0 + 63 - i : t0 + i;
          GO[(size_t)dir * T * 256 + (size_t)t * 256 + hd * 64 + w * 16 + i15] = acco[rb][r];
        }
      }
    }
    __syncthreads();
  }
}


template <int DQK>
DEVI void attn_run(int tid, const u16* __restrict__ Qp, int qrow0, const u16* __restrict__ Kp, const u16* __restrict__ Vtp,
                   int a0, int a1, int b0, int b1, int qpos0, float sink2, f32x16 (&O)[2], char* smem) {
  constexpr int KLD = DQK + 8, NS = DQK / 16, KCH = DQK / 8, NKL = (64 * KCH) / 256;
  constexpr int BUF = 64 * KLD + 64 * 72;
  u16* sbase = (u16*)smem;
  const int lane = tid & 63, wid = tid >> 6, r31 = lane & 31, hh = lane >> 5;
  const int qrow = qrow0 + wid * 32 + r31;
  bf16x8 qf[NS];
#pragma unroll
  for (int s = 0; s < NS; ++s) qf[s] = *(const bf16x8*)(Qp + (size_t)qrow * DQK + s * 16 + hh * 8);
#pragma unroll
  for (int i = 0; i < 16; ++i) { O[0][i] = 0.f; O[1][i] = 0.f; }
  float m = -30000.f, lsum = 0.f;
  const int na = (a1 - a0) >> 6, nt = na + ((b1 - b0) >> 6);
  const int qpos = qpos0 + wid * 32 + r31;
  u32x4 rk[NKL], rv[2];
  auto gload = [&](int ti) {
    const int key0 = ti >= na ? b0 + (ti - na) * 64 : a0 + ti * 64;
#pragma unroll
    for (int i = 0; i < NKL; ++i) { const int q = tid + 256 * i, r = q / KCH, cc = q % KCH; rk[i] = *(const u32x4*)(Kp + (size_t)(key0 + r) * DQK + cc * 8); }
#pragma unroll
    for (int i = 0; i < 2; ++i) { const int q = tid + 256 * i, r = q >> 3, cc = q & 7; rv[i] = *(const u32x4*)(Vtp + (size_t)r * NKEY + key0 + cc * 8); }
  };
  auto lstore = [&](int buf) {
    u16* sK = sbase + buf * BUF; u16* sV = sK + 64 * KLD;
#pragma unroll
    for (int i = 0; i < NKL; ++i) { const int q = tid + 256 * i, r = q / KCH, cc = q % KCH; *(u32x4*)&sK[r * KLD + cc * 8] = rk[i]; }
#pragma unroll
    for (int i = 0; i < 2; ++i) { const int q = tid + 256 * i, r = q >> 3, cc = q & 7; *(u32x4*)&sV[r * 72 + cc * 8] = rv[i]; }
  };
  m = -30000.f;
  gload(0);
  __syncthreads();
  lstore(0);
  __syncthreads();
  for (int ti = 0; ti < nt; ++ti) {
    if (ti + 1 < nt) gload(ti + 1);
    const u16* sK = sbase + (ti & 1) * BUF; const u16* sV = sK + 64 * KLD;
    const bool inB = ti >= na;
    const int key0 = inB ? b0 + (ti - na) * 64 : a0 + ti * 64;
    f32x16 st[2];
#pragma unroll
    for (int k2 = 0; k2 < 2; ++k2) {
#pragma unroll
      for (int i = 0; i < 16; ++i) st[k2][i] = 0.f;
#pragma unroll
      for (int s = 0; s < NS; ++s) {
        const bf16x8 kf = *(const bf16x8*)&sK[(k2 * 32 + r31) * KLD + s * 16 + hh * 8];
        st[k2] = MFMA32(kf, qf[s], st[k2]);
      }
    }
    if (inB) {
#pragma unroll
      for (int k2 = 0; k2 < 2; ++k2)
#pragma unroll
        for (int g = 0; g < 16; ++g) {
          const int d = key0 + k2 * 32 + (g & 3) + 8 * (g >> 2) + 4 * hh - qpos;
          if (d > 128 || d < -128) st[k2][g] = -1e30f;
        }
    }
    float mx = st[0][0];
#pragma unroll
    for (int g = 1; g < 16; ++g) mx = fmaxf(mx, st[0][g]);
#pragma unroll
    for (int g = 0; g < 16; ++g) mx = fmaxf(mx, st[1][g]);
    { auto rr = __builtin_amdgcn_permlane32_swap(__float_as_uint(mx), __float_as_uint(mx), false, false);
      mx = fmaxf(__uint_as_float(rr[0]), __uint_as_float(rr[1])); }
    if (__any(mx > m + 8.f)) {
      const float mn = fmaxf(m, mx);
      const float alpha = __builtin_amdgcn_exp2f(m - mn);
      m = mn; lsum *= alpha;
#pragma unroll
      for (int i = 0; i < 16; ++i) { O[0][i] *= alpha; O[1][i] *= alpha; }
    }
    f32x2 ps2 = {0.f, 0.f};
#pragma unroll
    for (int k2 = 0; k2 < 2; ++k2)
#pragma unroll
      for (int g = 0; g < 16; g += 2) {
        const float p0 = __builtin_amdgcn_exp2f(st[k2][g] - m), p1 = __builtin_amdgcn_exp2f(st[k2][g + 1] - m);
        st[k2][g] = p0; st[k2][g + 1] = p1;
        ps2 += f32x2{p0, p1};
      }
    lsum += ps2[0] + ps2[1];
#pragma unroll
    for (int k2 = 0; k2 < 2; ++k2)
#pragma unroll
      for (int s2 = 0; s2 < 2; ++s2) {
        u32x4 pp;
#pragma unroll
        for (int j = 0; j < 4; ++j) pp[j] = pack2(st[k2][8 * s2 + 2 * j], st[k2][8 * s2 + 2 * j + 1]);
        const bf16x8 pf = __builtin_bit_cast(bf16x8, pp);
#pragma unroll
        for (int dvt = 0; dvt < 2; ++dvt) {
          const bf16x8 vf = *(const bf16x8*)&sV[(dvt * 32 + r31) * 72 + k2 * 32 + s2 * 16 + 8 * hh];
          O[dvt] = MFMA32(vf, pf, O[dvt]);
        }
      }
    if (ti + 1 < nt) lstore((ti + 1) & 1);
    __syncthreads();
  }
  if (sink2 > -1e29f) {
    const float mn = fmaxf(m, sink2);
    const float alpha = __builtin_amdgcn_exp2f(m - mn);
    lsum = lsum * alpha + (hh == 0 ? __builtin_amdgcn_exp2f(sink2 - mn) : 0.f);
#pragma unroll
    for (int i = 0; i < 16; ++i) { O[0][i] *= alpha; O[1][i] *= alpha; }
  }
  const float ltot = lsum + __shfl_xor(lsum, 32);
  const float inv = 1.f / ltot;
#pragma unroll
  for (int i = 0; i < 16; ++i) { O[0][i] *= inv; O[1][i] *= inv; }
}
DEVI void attn_store(int tid, const f32x16 (&O)[2], u16* dst, int ld, int b, int qrow0, int col0) {
  const int lane = tid & 63, wid = tid >> 6, r31 = lane & 31, hh = lane >> 5;
  const int qrow = qrow0 + wid * 32 + r31;
  const int t = qrow < SEQ ? b * SEQ + qrow : TL + b * CTXL + (qrow - SEQ);
  u16* yr = dst + (size_t)t * ld + col0;
#pragma unroll
  for (int dvt = 0; dvt < 2; ++dvt)
#pragma unroll
    for (int g4 = 0; g4 < 4; ++g4) {
      u32x2 pk; pk[0] = pack2(O[dvt][g4 * 4 + 0], O[dvt][g4 * 4 + 1]); pk[1] = pack2(O[dvt][g4 * 4 + 2], O[dvt][g4 * 4 + 3]);
      *(u32x2*)(yr + dvt * 32 + 8 * g4 + 4 * hh) = pk;
    }
}
DEVI void attn_item(const Params& p, int l, int mixer, int b, int h, int qb, char* smem) {
  const bool lat = qb < 64;
  const int qrow0 = qb * 128;
  f32x16 O[2];
  if (mixer == 0) {
    attn_run<32>(p.tid, (const u16*)(p.ws + O_QB) + (size_t)(b * 8 + h) * NKEY * 32, qrow0, (const u16*)(p.ws + O_KB) + (size_t)(b * 8 + h) * NKEY * 32,
                 (const u16*)(p.ws + O_VTB) + (size_t)(b * 4 + (h >> 1)) * 64 * NKEY, lat ? 0 : SEQ, NKEY, 0, 0, 0, -1e30f, O, smem);
    attn_store(p.tid, O, (u16*)(p.ws + O_OB), 512, b, qrow0, h * 64);
  } else if (mixer == 1) {
    attn_run<96>(p.tid, (const u16*)(p.ws + O_QC) + (size_t)(b * 4 + h) * NKEY * 96, qrow0, (const u16*)(p.ws + O_KC) + (size_t)(b * 4 + h) * NKEY * 96,
                 (const u16*)(p.ws + O_VTC) + (size_t)(b * 4 + h) * 64 * NKEY, lat ? 0 : SEQ, NKEY, 0, 0, 0, -1e30f, O, smem);
    attn_store(p.tid, O, (u16*)(p.ws + O_Y), 1024, b, qrow0, 512 + h * 64);
  } else {
    const float sink2 = pin(p, I_SINK)[l * 4 + h] * LOG2E;
    const int hk = h >> 1;
    int b0 = 0, b1 = 0;
    if (lat) { b0 = (qb - 1) * 128; if (b0 < 0) b0 = 0; b1 = (qb + 2) * 128; if (b1 > SEQ) b1 = SEQ; }
    attn_run<64>(p.tid, (const u16*)(p.ws + O_QA) + (size_t)(b * 4 + h) * NKEY * 64, qrow0, (const u16*)(p.ws + O_KA) + (size_t)(b * 2 + hk) * NKEY * 64,
                 (const u16*)(p.ws + O_VTA) + (size_t)(b * 2 + hk) * 64 * NKEY, SEQ, NKEY, b0, b1, qrow0, sink2, O, smem);
    attn_store(p.tid, O, (u16*)(p.ws + O_Y), 1024, b, qrow0, h * 64);
  }
}

constexpr int SMEM_BYTES = 78848 + 64;

DEVI unsigned long long launder_ptr(unsigned long long v) {
  unsigned lo = __builtin_amdgcn_readfirstlane((unsigned)v), hi = __builtin_amdgcn_readfirstlane((unsigned)(v >> 32));
  asm volatile("s_mov_b32 %0, %1" : "=s"(lo) : "s"(lo));
  asm volatile("s_mov_b32 %0, %1" : "=s"(hi) : "s"(hi));
  return ((unsigned long long)hi << 32) | lo;
}
DEVI Params mkctx(const KArgs& a) {
  Params c;
  typedef __attribute__((address_space(1))) char gchar;
  typedef __attribute__((address_space(1))) float gfloat;
  c.ws = (char*)(gchar*)launder_ptr((unsigned long long)a.ws);
  c.out = (float*)(gfloat*)launder_ptr((unsigned long long)a.out);
  c.in = (gcfloat* const*)(c.ws + O_TAB);
  c.tid = threadIdx.x;
  asm volatile("" : "+v"(c.tid));
  return c;
}
DEVI void st_mixer_queue(const KArgs& a, int l, char* smem) {
  int* sitem = (int*)(smem + SMEM_BYTES - 16);
  const int g = blockIdx.x & 7;
  const int nctx = l == 0 ? 8 : 0;
  constexpr int NPREP = TR_P2 / 8 / 8;
  const int total = 2 + 128 + 64 + 64 + nctx + NPREP;
  for (;;) {
    const Params p = mkctx(a);
    unsigned* head = (unsigned*)(p.ws + O_BAR) + 16 + l * 8 + g;
    __syncthreads();
    if (p.tid == 0) *sitem = (int)atomicAdd(head, 1u);
    __syncthreads();
    int it = *sitem;
    if (it >= total) break;
    if (it < 2) { gdn_scan_chain(p, 2 * g + it, smem); continue; }
    it -= 2;
    if (it < 256 + nctx) {
      int mixer, b, h, qb;
      if (it < 128) { const int pr = 2 * g + (it >> 6); mixer = 0; b = pr >> 3; h = pr & 7; qb = it & 63; }
      else if (it < 256) { mixer = 1 + ((it - 128) >> 6); b = g >> 2; h = g & 3; qb = it & 63; }
      else {
        const int j = it - 256;
        if (j < 4) { const int pr = 2 * g + (j >> 1); mixer = 0; b = pr >> 3; h = pr & 7; qb = 64 + (j & 1); }
        else { mixer = 1 + ((j - 4) >> 1); b = g >> 2; h = g & 3; qb = 64 + (j & 1); }
      }
      attn_item(p, l, mixer, b, h, qb, smem);
      continue;
    }
    it -= 256 + nctx;
#pragma unroll 1
    for (int k = 0; k < 8; ++k) prep_w2_tile(p, l, (it * 8 + g) * 8 + k, (float*)smem);
  }
}

DEVI void st_mix_finish(const Params& p, int l, int vb, int nvb) {
  const int lane = p.tid & 63, wid = p.tid >> 6;
  const float* GO = (const float*)(p.ws + O_GO); const u16* PP = (const u16*)(p.ws + O_PP); const u16* OB = (const u16*)(p.ws + O_OB);
  u16* Y = (u16*)(p.ws + O_Y);
  const float lam_init = 0.8f - 0.6f * expf(-0.3f * (float)l);
  float d1 = lane < 32 ? pin(p, I_LQ1)[l * 32 + lane] * pin(p, I_LK1)[l * 32 + lane] : 0.f;
  float d2 = lane < 32 ? pin(p, I_LQ2)[l * 32 + lane] * pin(p, I_LK2)[l * 32 + lane] : 0.f;
  const float lam = expf(wave_sum(d1)) - expf(wave_sum(d2)) + lam_init;
  const float gg = pin(p, I_GNG)[l * 64 + lane];
  const float dg = pin(p, I_DNG)[l * 64 + lane] * (1.f - lam_init);
  const int tend = l == 0 ? T : TL;
  for (int t = vb * 4 + wid; t < tend; t += nvb * 4) {
    float ob0[4], ob1[4], go[4], z[4];
#pragma unroll
    for (int hd = 0; hd < 4; ++hd) {
      ob0[hd] = bf2f(OB[(size_t)t * 512 + (hd * 2) * 64 + lane]); ob1[hd] = bf2f(OB[(size_t)t * 512 + (hd * 2 + 1) * 64 + lane]);
      go[hd] = GO[(size_t)t * 256 + hd * 64 + lane] + GO[(size_t)T * 256 + (size_t)t * 256 + hd * 64 + lane];
      z[hd] = bf2f(PP[(size_t)t * LDPP + PP_DZ + hd * 64 + lane]);
    }
    float ssb[4], ssg[4], od[4];
#pragma unroll
    for (int hd = 0; hd < 4; ++hd) { od[hd] = ob0[hd] - lam * ob1[hd]; ssb[hd] = od[hd] * od[hd]; ssg[hd] = go[hd] * go[hd]; }
#pragma unroll
    for (int o = 32; o >= 1; o >>= 1) {
#pragma unroll
      for (int hd = 0; hd < 4; ++hd) { ssb[hd] += __shfl_xor(ssb[hd], o); ssg[hd] += __shfl_xor(ssg[hd], o); }
    }
#pragma unroll
    for (int hd = 0; hd < 4; ++hd) {
      Y[(size_t)t * 1024 + 256 + hd * 64 + lane] = f2bf(od[hd] * rsqrtf(ssb[hd] * (1.f / 64.f) + 1e-6f) * dg);
      Y[(size_t)t * 1024 + 768 + hd * 64 + lane] = f2bf(go[hd] * rsqrtf(ssg[hd] * (1.f / 64.f) + 1e-6f) * gg * siluf(z[hd]));
    }
  }
}

constexpr int RLD = 1026;
DEVI void st_norm2_route(const Params& p, int l, int vb, int nvb, char* smem) {
  const int lane = p.tid & 63, wid = p.tid >> 6, i15 = lane & 15, q = lane >> 4;
  float* shh = (float*)smem;
  float* slog = shh + 16 * RLD;
  const float* g = pin(p, I_N2G) + l * 1024;
  const float* wr = pin(p, I_WR) + (size_t)l * 1024 * 64;
  const float bias = pin(p, I_RB)[l * 64 + lane];
  float* WTS = (float*)(p.ws + O_WTS); int* CNT = (int*)(p.ws + O_CNT); int* LIST = (int*)(p.ws + O_LIST);
  for (int grp = vb; grp < T / 16; grp += nvb) {
    const int tb = grp * 16 + wid * 4;
    const int mv = tok_mv(tb);
    const float* sh = modp(p, l, mv, 3); const float* sc = modp(p, l, mv, 4);
    {
      f32x4 v[4][4]; float ss[4];
#pragma unroll
      for (int u = 0; u < 4; ++u) {
        const f32x4* xr = (const f32x4*)((const float*)(p.ws + O_XA) + (size_t)(tb + u) * 1024);
#pragma unroll
        for (int i = 0; i < 4; ++i) v[u][i] = xr[i * 64 + lane];
      }
#pragma unroll
      for (int u = 0; u < 4; ++u) {
        float a = 0.f;
#pragma unroll
        for (int i = 0; i < 4; ++i) a += v[u][i][0] * v[u][i][0] + v[u][i][1] * v[u][i][1] + v[u][i][2] * v[u][i][2] + v[u][i][3] * v[u][i][3];
        ss[u] = a;
      }
#pragma unroll
      for (int o = 32; o >= 1; o >>= 1) {
#pragma unroll
        for (int u = 0; u < 4; ++u) ss[u] += __shfl_xor(ss[u], o);
      }
#pragma unroll
      for (int i = 0; i < 4; ++i) {
        const int c = i * 256 + lane * 4;
        const f32x4 gg = *(const f32x4*)(g + c), s4 = *(const f32x4*)(sc + c), h4 = *(const f32x4*)(sh + c);
        const f32x4 gs = gg * (1.f + s4);
#pragma unroll
        for (int u = 0; u < 4; ++u) {
          const float rstd = rsqrtf(ss[u] * (1.f / 1024.f) + 1e-6f);
          const f32x4 o = v[u][i] * rstd * gs + h4;
          u32x2 pk; pk[0] = pack2(o[0], o[1]); pk[1] = pack2(o[2], o[3]);
          *(u32x2*)((u16*)(p.ws + O_H) + (size_t)(tb + u) * 1024 + c) = pk;
          float* d = shh + (wid * 4 + u) * RLD + c;
          *(f32x2*)d = f32x2{o[0], o[1]}; *(f32x2*)(d + 2) = f32x2{o[2], o[3]};
        }
      }
    }
    __syncthreads();
    {
      f32x4 a0 = fzero4(), a1 = a0;
      const float* ap = shh + i15 * RLD + q;
      const float* bp = wr + (size_t)q * 64 + wid * 16 + i15;
#pragma unroll 8
      for (int kk = 0; kk < 256; kk += 2) {
        a0 = __builtin_amdgcn_mfma_f32_16x16x4f32(ap[4 * kk], bp[(size_t)(4 * kk) * 64], a0, 0, 0, 0);
        a1 = __builtin_amdgcn_mfma_f32_16x16x4f32(ap[4 * kk + 4], bp[(size_t)(4 * kk + 4) * 64], a1, 0, 0, 0);
      }
#pragma unroll
      for (int r = 0; r < 4; ++r) slog[(4 * q + r) * 64 + wid * 16 + i15] = a0[r] + a1[r];
    }
    __syncthreads();
#pragma unroll 1
    for (int u = 0; u < 4; ++u) {
      const int t = tb + u;
      const float logit = slog[(wid * 4 + u) * 64 + lane];
      const float s = 1.f / (1.f + expf(-logit));
      const float c = s + bias;
      float m1 = c;
      m1 = fmaxf(m1, __shfl_xor(m1, 1)); m1 = fmaxf(m1, __shfl_xor(m1, 2)); m1 = fmaxf(m1, __shfl_xor(m1, 4));
      const unsigned long long bal = __ballot(c == m1);
      const int grpi = lane >> 3;
      const unsigned gm = (unsigned)((bal >> (grpi * 8)) & 0xffull);
      const int first = __ffs(gm) - 1;
      float m2 = ((lane & 7) == first) ? -INFINITY : c;
      m2 = fmaxf(m2, __shfl_xor(m2, 1)); m2 = fmaxf(m2, __shfl_xor(m2, 2)); m2 = fmaxf(m2, __shfl_xor(m2, 4));
      const float gs = m1 + m2;
      int grank = 0;
#pragma unroll
      for (int gg = 0; gg < 8; ++gg) { float o = __shfl(gs, gg * 8); grank += (o > gs || (o == gs && gg < grpi)) ? 1 : 0; }
      const bool gsel = grank < 4;
      const float mc = gsel ? c : -INFINITY;
      int rank = 0;
#pragma unroll
      for (int e = 0; e < 64; ++e) { float o = __shfl(mc, e); rank += (o > mc || (o == mc && e < lane)) ? 1 : 0; }
      const bool sel = gsel && rank < 6;
      const float ssum = wave_sum(sel ? s : 0.f);
      if (sel) {
        const int slot = t * 6 + rank;
        WTS[slot] = s / ssum * 2.5f;
        const int pos = atomicAdd(&CNT[lane], 1);
        LIST[(size_t)lane * T + pos] = slot;
      }
    }
    __syncthreads();
  }
}
DEVI void st_outproj(const Params& p, int l, int vb, int nvb, char* smem) {
  const u16* Y = (const u16*)(p.ws + O_Y); const u16* W = (const u16*)(p.ws + O_WOUTT); float* XA = (float*)(p.ws + O_XA);
  const int g = vb & 7, nmg = (132 - g + 7) >> 3;
  for (int i = vb >> 3; i < nmg * 8; i += nvb >> 3) {
    const int m0 = (g + 8 * (i >> 3)) * 128, n0 = (i & 7) * 128;
    gemm128(p.tid, [&](int r) { return Y + (size_t)(m0 + r) * 1024; }, W + (size_t)n0 * 1024, 1024, 1024,
            [&](int r, int c, f32x4 v) {
              const int t = m0 + r; const float* gt = modp(p, l, tok_mv(t), 2) + n0 + c;
              float4* xp = (float4*)(XA + (size_t)t * 1024 + n0 + c); float4 x = *xp;
              x.x += gt[0] * v[0]; x.y += gt[1] * v[1]; x.z += gt[2] * v[2]; x.w += gt[3] * v[3]; *xp = x;
              __builtin_amdgcn_sched_barrier(0);
            }, smem);
  }
}

DEVI void grp_tiles(const Params& p, int* tst, int g, int shift, int nshared) {
  __syncthreads();
  if (p.tid < 64) {
    const int* CNT = (const int*)(p.ws + O_CNT);
    const int lane = p.tid;
    int c = 0;
    if (lane < 8) c = (__hip_atomic_load(&CNT[g + 8 * lane], __ATOMIC_RELAXED, __HIP_MEMORY_SCOPE_AGENT) + (1 << shift) - 1) >> shift;
    int incl = c;
#pragma unroll
    for (int o = 1; o < 8; o <<= 1) { int u = __shfl_up(incl, o); if (lane >= o) incl += u; }
    if (lane < 8) tst[lane] = incl - c;
    if (lane == 7) { tst[8] = incl; tst[9] = incl + (nshared - g + 7) / 8; }
  }
  __syncthreads();
}
DEVI void grp_find(const int* tst, int tile, int g, int& e, int& lt) {
  int j = 0;
#pragma unroll
  for (int k = 1; k <= 8; ++k) j += tile >= tst[k] ? 1 : 0;
  if (j < 8) { e = g + 8 * j; lt = tile - tst[j]; } else { e = 64; lt = g + 8 * (tile - tst[8]); }
}
DEVI void st_moe1(const Params& p, int vb, int nvb, char* smem) {
  const int* CNT = (const int*)(p.ws + O_CNT); const int* LIST = (const int*)(p.ws + O_LIST);
  const u16* H = (const u16*)(p.ws + O_H); u16* HB = (u16*)(p.ws + O_HB);
  int* sslot = (int*)(smem + 2 * 128 * GLD * 2);
  int* TST = sslot + 128;
  const int g = vb & 7;
  grp_tiles(p, TST, g, 7, T / 128);
  const int total = TST[9];
  for (int item = vb >> 3; item < total * 4; item += nvb >> 3) {
    const int tile = item >> 2, n0 = (item & 3) * 128;
    int e, lt; grp_find(TST, tile, g, e, lt);
    const int cnt = e < 64 ? __hip_atomic_load(&CNT[e], __ATOMIC_RELAXED, __HIP_MEMORY_SCOPE_AGENT) : T;
    __syncthreads();
    if (p.tid < 128) {
      int i = lt * 128 + p.tid;
      int slot = -1;
      if (i < cnt) slot = e < 64 ? LIST[(size_t)e * T + i] : NSLOT + i;
      sslot[p.tid] = slot;
    }
    __syncthreads();
    gemm128(p.tid, [&](int r) { int sl = sslot[r]; int tk = sl < 0 ? 0 : (sl < NSLOT ? sl / 6 : sl - NSLOT); return H + (size_t)tk * 1024; },
            (const u16*)(p.ws + O_WGUT) + ((size_t)e * 512 + n0) * 1024, 1024, 1024,
            [&](int r, int c, f32x4 v) {
              int sl = sslot[r]; if (sl < 0) return;
              float h0 = siluf(v[0]) * v[1], h1 = siluf(v[2]) * v[3];
              *(unsigned*)(HB + (size_t)sl * 256 + ((n0 + c) >> 1)) = pack2(h0, h1);
            }, smem);
  }
}
DEVI void st_moe2(const Params& p, int vb, int nvb, char* smem) {
  const int* CNT = (const int*)(p.ws + O_CNT); const int* LIST = (const int*)(p.ws + O_LIST);
  const u16* HB = (const u16*)(p.ws + O_HB); u16* SO = (u16*)(p.ws + O_SLOT); const float* WTS = (const float*)(p.ws + O_WTS);
  constexpr int ALD = 264;
  u16* sA = (u16*)smem;
  u16* sB = sA + 64 * ALD;
  int* sslot = (int*)(sB + 2 * 128 * 72);
  int* TST = sslot + 64;
  const int tid = p.tid, lane = tid & 63, wid = tid >> 6, wr = wid >> 1, wc = wid & 1, fr = lane & 15, fq = lane >> 4;
  const int g = vb & 7;
  grp_tiles(p, TST, g, 6, T / 64);
  const int total = TST[9];
  for (int item = vb >> 3; item < total; item += nvb >> 3) {
    int e, lt; grp_find(TST, item, g, e, lt);
    const int cnt = e < 64 ? __hip_atomic_load(&CNT[e], __ATOMIC_RELAXED, __HIP_MEMORY_SCOPE_AGENT) : T;
    __syncthreads();
    if (tid < 64) { const int i = lt * 64 + tid; sslot[tid] = i < cnt ? (e < 64 ? LIST[(size_t)e * T + i] : NSLOT + i) : -1; }
    __syncthreads();
    const u16* Bbase = (const u16*)(p.ws + O_WDT) + (size_t)e * 1024 * 256;
    u32x4 rb0[4], rb1[4], rb2[4];
    const u16* bthr = Bbase + (size_t)(tid >> 3) * 256 + (tid & 7) * 8;
    auto gloadB = [&](u32x4 (&rb)[4], int bt) {
      int off = (bt >> 2) * 128 * 256 + (bt & 3) * 64;
      asm volatile("" : "+s"(off));
      const u16* src = bthr + off;
#pragma unroll
      for (int i = 0; i < 4; ++i) rb[i] = *(const u32x4*)(src + i * 32 * 256);
    };
    auto lstoreB = [&](const u32x4 (&rb)[4], int buf) {
      u16* d = sB + buf * 128 * 72;
#pragma unroll
      for (int i = 0; i < 4; ++i) { const int q = tid + 256 * i, r = q >> 3, cc = q & 7; *(u32x4*)&d[r * 72 + cc * 8] = rb[i]; }
    };
    gloadB(rb0, 0); gloadB(rb1, 1); gloadB(rb2, 2);
#pragma unroll
    for (int hf = 0; hf < 2; ++hf) {
      u32x4 ra[4];
#pragma unroll
      for (int i = 0; i < 4; ++i) { const int q = tid + 256 * (4 * hf + i), r = q >> 5, cc = q & 31; const int sl = sslot[r]; ra[i] = *(const u32x4*)(HB + (size_t)(sl < 0 ? 0 : sl) * 256 + cc * 8); }
#pragma unroll
      for (int i = 0; i < 4; ++i) { const int q = tid + 256 * (4 * hf + i), r = q >> 5, cc = q & 31; *(u32x4*)&sA[r * ALD + cc * 8] = ra[i]; }
      __builtin_amdgcn_sched_barrier(0);
    }
    int slot_m[2]; float w_m[2];
#pragma unroll
    for (int m = 0; m < 2; ++m) { const int sl = sslot[wr * 32 + m * 16 + fr]; slot_m[m] = sl; w_m[m] = (sl >= 0 && sl < NSLOT) ? WTS[sl] : 1.f; }
    lstoreB(rb0, 0); gloadB(rb0, 3);
    __syncthreads();
    f32x4 acc[2][4];
    auto compute = [&](int bt, int buf) {
      const int nt = bt >> 2, kt = bt & 3;
      const u16* b = sB + buf * 128 * 72;
      if (kt == 0) {
#pragma unroll
        for (int m = 0; m < 2; ++m)
#pragma unroll
          for (int n = 0; n < 4; ++n) acc[m][n] = fzero4();
      }
#pragma unroll
      for (int ks = 0; ks < 2; ++ks) {
        bf16x8 af[2], bfr[4];
#pragma unroll
        for (int m = 0; m < 2; ++m) af[m] = *(const bf16x8*)&sA[(wr * 32 + m * 16 + fr) * ALD + kt * 64 + ks * 32 + fq * 8];
#pragma unroll
        for (int n = 0; n < 4; ++n) bfr[n] = *(const bf16x8*)&b[(wc * 64 + n * 16 + fr) * 72 + ks * 32 + fq * 8];
#pragma unroll
        for (int m = 0; m < 2; ++m)
#pragma unroll
          for (int n = 0; n < 4; ++n) acc[m][n] = MFMA16(bfr[n], af[m], acc[m][n]);
      }
      if (kt == 3) {
#pragma unroll
        for (int m = 0; m < 2; ++m) {
          if (slot_m[m] >= 0) {
            const float w = w_m[m];
#pragma unroll
            for (int n = 0; n < 4; ++n) {
              u32x2 pk; pk[0] = pack2(acc[m][n][0] * w, acc[m][n][1] * w); pk[1] = pack2(acc[m][n][2] * w, acc[m][n][3] * w);
              *(u32x2*)(SO + (size_t)slot_m[m] * 1024 + nt * 128 + wc * 64 + n * 16 + fq * 4) = pk;
            }
          }
        }
      }
    };
#pragma unroll
    for (int bt = 0; bt < 30; bt += 3) {
      compute(bt, bt & 1);           lstoreB(rb1, (bt + 1) & 1); if (bt + 4 < 32) gloadB(rb1, bt + 4); __syncthreads(); __builtin_amdgcn_sched_barrier(0);
      compute(bt + 1, (bt + 1) & 1); lstoreB(rb2, (bt + 2) & 1); if (bt + 5 < 32) gloadB(rb2, bt + 5); __syncthreads(); __builtin_amdgcn_sched_barrier(0);
      compute(bt + 2, (bt + 2) & 1); lstoreB(rb0, (bt + 3) & 1); if (bt + 6 < 32) gloadB(rb0, bt + 6); __syncthreads(); __builtin_amdgcn_sched_barrier(0);
    }
    compute(30, 0); lstoreB(rb1, 1); __syncthreads(); __builtin_amdgcn_sched_barrier(0);
    compute(31, 1); __syncthreads();
  }
}

DEVI void st_combine(const Params& p, int l, int vb, int nvb) {
  const int lane = p.tid & 63, wid = p.tid >> 6;
  const u16* SO = (const u16*)(p.ws + O_SLOT);
  const bool last = l == 1;
  const float* gnext = last ? pin(p, I_FNG) : pin(p, I_N1G) + 1024;
  const int tend = last ? TL : T;
  for (int t = vb * 4 + wid; t < tend; t += nvb * 4) {
    const int mv = tok_mv(t);
    const float* g5 = modp(p, l, mv, 5);
    float* xr = (float*)(p.ws + O_XA) + (size_t)t * 1024;
    u32x2 sv[7][4]; f32x4 xv[4];
#pragma unroll
    for (int k = 0; k < 7; ++k) {
      const u16* row = SO + (size_t)(k < 6 ? t * 6 + k : NSLOT + t) * 1024;
#pragma unroll
      for (int i = 0; i < 4; ++i) sv[k][i] = *(const u32x2*)(row + i * 256 + lane * 4);
    }
#pragma unroll
    for (int i = 0; i < 4; ++i) xv[i] = *(const f32x4*)(xr + i * 256 + lane * 4);
    float ss = 0.f;
#pragma unroll
    for (int i = 0; i < 4; ++i) {
      f32x4 a = fzero4();
#pragma unroll
      for (int k = 0; k < 7; ++k) { a[0] += bflo(sv[k][i][0]); a[1] += bfhi(sv[k][i][0]); a[2] += bflo(sv[k][i][1]); a[3] += bfhi(sv[k][i][1]); }
      const f32x4 g = *(const f32x4*)(g5 + i * 256 + lane * 4);
      xv[i] += g * a;
      ss += xv[i][0] * xv[i][0] + xv[i][1] * xv[i][1] + xv[i][2] * xv[i][2] + xv[i][3] * xv[i][3];
    }
    ss = wave_sum(ss);
    const float rstd = rsqrtf(ss * (1.f / 1024.f) + 1e-6f);
    if (!last) {
      const float* sh = modp(p, 1, mv, 0); const float* sc = modp(p, 1, mv, 1);
#pragma unroll
      for (int i = 0; i < 4; ++i) {
        const int c = i * 256 + lane * 4;
        *(f32x4*)(xr + c) = xv[i];
        const f32x4 gg = *(const f32x4*)(gnext + c), s4 = *(const f32x4*)(sc + c), h4 = *(const f32x4*)(sh + c);
        const f32x4 o = xv[i] * rstd * gg * (1.f + s4) + h4;
        u32x2 pk; pk[0] = pack2(o[0], o[1]); pk[1] = pack2(o[2], o[3]);
        *(u32x2*)((u16*)(p.ws + O_H) + (size_t)t * 1024 + c) = pk;
      }
    } else {
#pragma unroll
      for (int i = 0; i < 4; ++i) {
        const int c = i * 256 + lane * 4;
        const f32x4 gg = *(const f32x4*)(gnext + c);
        *(f32x4*)(p.out + (size_t)t * 1024 + c) = xv[i] * rstd * gg;
      }
    }
  }
}

#define STAGE(call) { const Params p = mkctx(a); call; }

#define XB_TMO      128
#define XB_XCNT(j)  (256  + 64 * (j))
#define XB_XSUB(j)  (1280 + 64 * (j))
#define XB_XGEN(j)  (2304 + 64 * (j))
#define XB_TOP      3328
#define XB_TOPGEN   3392
#define XCD_BAR_WORDS 3456
#define XB_SPIN_CAP (1u << 20)
#define LAS __attribute__((address_space(3)))
DEVI unsigned xb_ld(unsigned* p)              { return __hip_atomic_load(p, __ATOMIC_RELAXED, __HIP_MEMORY_SCOPE_AGENT); }
DEVI unsigned xb_add(unsigned* p, unsigned v) { return __hip_atomic_fetch_add(p, v, __ATOMIC_RELAXED, __HIP_MEMORY_SCOPE_AGENT); }
DEVI unsigned xb_xcc_id() { return (unsigned)__builtin_amdgcn_s_getreg((3 << 11) | 20) & 0xFu; }
#define XB_SPIN(cond, bar) do { unsigned _sp = 0; while (cond) { __builtin_amdgcn_s_sleep(1); \
    if ((++_sp & 255u) == 0u) { if (xb_ld(&(bar)[XB_TMO])) break; if (_sp > XB_SPIN_CAP) { atomicAdd(&(bar)[XB_TMO], 1u); break; } } } } while (0)
struct XcdBarrier { unsigned* bar; unsigned x; volatile LAS unsigned* st; };
DEVI XcdBarrier xcd_barrier_post(unsigned* bar, volatile LAS unsigned* st) {
  XcdBarrier b; b.bar = bar; b.x = xb_xcc_id(); b.st = st;
  if (threadIdx.x == 0) (void)xb_add(&bar[XB_XCNT(b.x)], 1u);
  return b;
}
DEVI void xcd_barrier_complete(unsigned* bar, unsigned x, unsigned& nloc, unsigned& nx) {
  const unsigned G = gridDim.x * gridDim.y * gridDim.z;
  unsigned sum, cnt, mine, sp = 0u;
  for (;;) {
    sum = 0u; cnt = 0u; mine = 0u;
#pragma unroll
    for (unsigned j = 0; j < 16; ++j) { const unsigned c = xb_ld(&bar[XB_XCNT(j)]); sum += c; cnt += (c > 0u) ? 1u : 0u; mine = (j == x) ? c : mine; }
    if (sum == G) break;
    __builtin_amdgcn_s_sleep(1);
    if ((++sp & 255u) == 0u) { if (xb_ld(&bar[XB_TMO])) break; if (sp > XB_SPIN_CAP) { atomicAdd(&bar[XB_TMO], 1u); break; } }
  }
  nloc = mine > 0u ? mine : 1u; nx = cnt > 0u ? cnt : 1u;
}
DEVI void xcd_barrier(const XcdBarrier& b) {
  asm volatile("s_waitcnt vmcnt(0)" ::: "memory");
  __syncthreads();
  if (threadIdx.x == 0) {
    unsigned* bar = b.bar;
    __builtin_amdgcn_s_waitcnt(0);
    unsigned nloc = b.st[0], nx = b.st[1];
    if (nloc == 0u) { xcd_barrier_complete(bar, b.x, nloc, nx); b.st[0] = nloc; b.st[1] = nx; }
    const unsigned old = xb_add(&bar[XB_XSUB(b.x)], 1u);
    const unsigned gen = old / nloc;
    if (old + 1u == (gen + 1u) * nloc) {
      __builtin_amdgcn_fence(__ATOMIC_RELEASE, "agent");
      asm volatile("s_waitcnt vmcnt(0)" ::: "memory");
      const unsigned og = xb_add(&bar[XB_TOP], 1u);
      const unsigned tg = og / nx;
      if (og + 1u == (tg + 1u) * nx) xb_add(&bar[XB_TOPGEN], 1u);
      else XB_SPIN(xb_ld(&bar[XB_TOPGEN]) == tg, bar);
      __builtin_amdgcn_fence(__ATOMIC_ACQUIRE, "agent");
      xb_add(&bar[XB_XGEN(b.x)], 1u);
      asm volatile("s_waitcnt vmcnt(0)" ::: "memory");
    } else {
      XB_SPIN(xb_ld(&bar[XB_XGEN(b.x)]) == gen, bar);
      __builtin_amdgcn_fence(__ATOMIC_ACQUIRE, "agent");
      asm volatile("s_waitcnt vmcnt(0)" ::: "memory");
    }
  }
  __syncthreads();
}
#define GSYNC() { XcdBarrier xb_; xb_.bar = (unsigned*)(mkctx(a).ws + O_XBAR); xb_.x = xb_xcc_id(); xb_.st = (volatile LAS unsigned*)(smem + SMEM_BYTES - 32); xcd_barrier(xb_); }

__global__ void __launch_bounds__(256, 2) mega(KArgs a) {
  extern __shared__ __attribute__((aligned(16))) char smem[];
  cg::grid_group grid = cg::this_grid();
  const int vb = blockIdx.x, nvb = gridDim.x;
  volatile LAS unsigned* xst = (volatile LAS unsigned*)(smem + SMEM_BYTES - 32);
  if (threadIdx.x == 0) { xst[0] = 0u; xst[1] = 0u; }
  __syncthreads();
  (void)xcd_barrier_post((unsigned*)(a.ws + O_XBAR), xst);
  if (threadIdx.x == 0) {
    const float** tab = (const float**)(a.ws + O_TAB);
#pragma unroll
    for (int i = 0; i < 35; ++i) tab[i] = a.in[i];
  }
  __syncthreads();
  STAGE(st_copy_in(p, vb, nvb));
  STAGE(st_rope_table(p, vb, nvb));
  STAGE(st_mod(p, vb, nvb, smem));
  STAGE(st_prep_w1(p, 0, vb, nvb, smem));
  grid.sync();
  for (int l = 0; l < 2; ++l) {
    if (l == 0) { STAGE(st_norm1(p, 0, vb, nvb)); GSYNC(); }
    {
      const int g = vb & 7, nng = (22 - g + 7) >> 3;
      for (int i = vb >> 3; i < 132 * nng; i += nvb >> 3) { const Params p = mkctx(a); inproj_item(p, (i / nng) * 22 + g + 8 * (i % nng), smem); }
    }
    GSYNC();
    STAGE(st_tokprep(p, l, vb, nvb));
    GSYNC();
    {
      for (int item = vb; item < 132 * 7 + NGITEM; item += nvb) {
        const Params p = mkctx(a);
        if (item < 132 * 7) mla_up_tile(p, item / 7, item % 7, smem);
        else gdn_chunk_item(p, item - 132 * 7, smem);
      }
    }
    GSYNC();
    st_mixer_queue(a, l, smem);
    GSYNC();
    STAGE(st_mix_finish(p, l, vb, nvb));
    GSYNC();
    STAGE(st_outproj(p, l, vb, nvb, smem));
    GSYNC();
    STAGE(st_norm2_route(p, l, vb, nvb, smem));
    GSYNC();
    STAGE(st_moe1(p, vb, nvb, smem));
    GSYNC();
    STAGE(st_moe2(p, vb, nvb, smem));
    GSYNC();
    if (l == 0) STAGE(st_prep_w1(p, 1, vb, nvb, smem));
    STAGE(st_combine(p, l, vb, nvb));
    if (l == 0) GSYNC();
  }
}

extern "C" void kernel_launch(void* const* d_in, const int* in_sizes, int n_in, void* d_out, int out_size, void* d_ws, size_t ws_size,
                              hipStream_t stream) {
  static int grid_blocks = 0;
  if (!grid_blocks) {
    int dev = 0, cus = 0, per_cu = 0;
    (void)hipGetDevice(&dev);
    (void)hipDeviceGetAttribute(&cus, hipDeviceAttributeMultiprocessorCount, dev);
    (void)hipFuncSetAttribute((const void*)mega, hipFuncAttributeMaxDynamicSharedMemorySize, SMEM_BYTES);
    (void)hipOccupancyMaxActiveBlocksPerMultiprocessor(&per_cu, mega, 256, SMEM_BYTES);
    if (per_cu > 2) per_cu = 2;
    if (per_cu < 1) per_cu = 1;
    grid_blocks = cus * per_cu;
  }
  KArgs p{};
  for (int i = 0; i < 35; ++i) p.in[i] = (const float*)d_in[i];
  p.out = (float*)d_out; p.ws = (char*)d_ws;
  if (ws_size < WS_NEED) { fprintf(stderr, "workspace too small: %zu < %zu\n", ws_size, (size_t)WS_NEED); return; }
  (void)hipMemsetAsync((char*)d_ws + O_BAR, 0, 256 + 16384, stream);
  void* args[] = {&p};
  hipError_t e = hipLaunchCooperativeKernel((void*)mega, dim3(grid_blocks), dim3(256), args, SMEM_BYTES, stream);
  if (e != hipSuccess) fprintf(stderr, "cooperative launch failed: %s (grid %d)\n", hipGetErrorString(e), grid_blocks);
}
```

```cpp
#include <hip/hip_runtime.h>
#include <hip/hip_cooperative_groups.h>
#include <cstdio>
#include <cstdint>
namespace cg = cooperative_groups;

#define DEVI __device__ __forceinline__
typedef unsigned short u16;
using bf16x8 = __attribute__((ext_vector_type(8))) short;
using f32x4  = __attribute__((ext_vector_type(4))) float;
using f32x2  = __attribute__((ext_vector_type(2))) float;
using f32x16 = __attribute__((ext_vector_type(16))) float;
using u32x4 = __attribute__((ext_vector_type(4))) unsigned;
using u32x2 = __attribute__((ext_vector_type(2))) unsigned;
typedef __bf16 bf16x2_t __attribute__((ext_vector_type(2)));

constexpr int DM = 1024, SEQ = 8192, CTXL = 256, NKEY = SEQ + CTXL;
constexpr int TL = 2 * SEQ, TC = 2 * CTXL, T = TL + TC;
constexpr int INW = 2672;
constexpr int NIN = 2816;
constexpr int LDPP = 1408;
constexpr int PP_CQ = 0, PP_CKV = 192, PP_DQKV = 320, PP_DZ = 1088, PP_GATE = 1344;
constexpr int NE = 64, NSLOT = 6 * T;
constexpr int LDW = 1088;
constexpr int LDH = 1088;
constexpr int NCHUNK = T / 64;
constexpr int NGITEM = NCHUNK * 8;
constexpr float LOG2E = 1.4426950408889634f;

constexpr size_t al256(size_t x) { return (x + 255) & ~(size_t)255; }
constexpr size_t O_MOD   = 0;
constexpr size_t O_ROPE  = O_MOD + al256((size_t)2 * 3 * 6144 * 4);
constexpr size_t O_XA    = O_ROPE + (size_t)SEQ * 48 * 8;
constexpr size_t O_H     = O_XA + (size_t)T * DM * 4;
constexpr size_t O_WINT  = O_H + (size_t)T * LDH * 2;
constexpr size_t O_WOUTT = O_WINT + (size_t)NIN * LDW * 2;
constexpr size_t O_WUQT  = O_WOUTT + (size_t)1024 * LDW * 2;
constexpr size_t O_WUKVT = O_WUQT + (size_t)384 * 192 * 2;
constexpr size_t O_WGUT  = O_WUKVT + (size_t)512 * 128 * 2;
constexpr size_t O_WDT   = O_WGUT + (size_t)65 * 512 * LDW * 2;
constexpr size_t O_WTS   = O_WDT + (size_t)65 * 1024 * 256 * 2;
constexpr size_t O_CNT   = O_WTS + al256((size_t)NSLOT * 4);
constexpr size_t O_TAB   = O_CNT + 256;
constexpr size_t O_BAR   = O_TAB + 512;
constexpr size_t O_XBAR  = O_BAR + 256;
constexpr size_t O_LIST  = O_XBAR + 16384;
constexpr size_t O_R     = O_LIST + (size_t)NE * T * 4;
constexpr size_t O_Y     = O_R;
constexpr size_t O_PP    = O_Y + (size_t)T * DM * 2;
constexpr size_t O_QA    = O_PP + (size_t)T * LDPP * 2;
constexpr size_t O_KA    = O_QA + (size_t)2 * 4 * NKEY * 64 * 2;
constexpr size_t O_VTA   = O_KA + (size_t)2 * 2 * NKEY * 64 * 2;
constexpr size_t O_QB    = O_VTA + (size_t)2 * 2 * NKEY * 64 * 2;
constexpr size_t O_KB    = O_QB + (size_t)2 * 8 * NKEY * 32 * 2;
constexpr size_t O_VTB   = O_KB + (size_t)2 * 8 * NKEY * 32 * 2;
constexpr size_t O_QC    = O_VTB + (size_t)2 * 4 * NKEY * 64 * 2;
constexpr size_t O_KC    = O_QC + (size_t)2 * 4 * NKEY * 96 * 2;
constexpr size_t O_VTC   = O_KC + (size_t)2 * 4 * NKEY * 96 * 2;
constexpr size_t O_CQN   = O_VTC + (size_t)2 * 4 * NKEY * 64 * 2;
constexpr size_t O_CKVN  = O_CQN + (size_t)T * 192 * 2;
constexpr size_t O_OB    = O_CKVN + (size_t)T * 128 * 2;
constexpr size_t O_GQ    = O_OB + (size_t)T * 512 * 2;
constexpr size_t O_GK    = O_GQ + (size_t)T * 256 * 2;
constexpr size_t O_GV    = O_GK + (size_t)T * 256 * 2;
constexpr size_t O_GG    = O_GV + (size_t)T * 256 * 2;
constexpr size_t O_GBETA = O_GG + (size_t)2 * T * 4 * 4;
constexpr size_t O_GM    = O_GBETA + (size_t)2 * T * 4 * 4;
constexpr size_t O_GQP   = O_GM + (size_t)NGITEM * 4096 * 2;
constexpr size_t O_GN    = O_GQP + (size_t)NGITEM * 4096 * 2;
constexpr size_t O_GLO   = O_GN + (size_t)NGITEM * 4096 * 2;
constexpr size_t O_GO    = O_GLO + (size_t)NGITEM * 4096 * 2;
constexpr size_t O_MIX_END = O_GO + (size_t)2 * T * 256 * 4;
constexpr size_t O_HB    = O_R;
constexpr size_t O_SLOT  = O_HB + (size_t)7 * T * 256 * 2;
constexpr size_t O_MOE_END = O_SLOT + (size_t)7 * T * 1024 * 2;
constexpr size_t cmax(size_t a, size_t b) { return a > b ? a : b; }
constexpr size_t WS_NEED = cmax(O_MIX_END, O_MOE_END);
static_assert(WS_NEED < (size_t)556000000, "workspace too large");

struct KArgs {
  const float* in[35];
  float* out;
  char* ws;
};
typedef const __attribute__((address_space(1))) float gcfloat;
struct Params {
  char* ws;
  float* out;
  gcfloat* const* in;
  int tid;
};
#define pin(p, i) ((const float*)(p).in[i])
enum { I_X = 0, I_C, I_CTX, I_CCTX, I_WADA, I_BADA, I_N1G, I_N2G, I_WIN, I_WOUT, I_SINK, I_LQ1, I_LK1, I_LQ2, I_LK2,
       I_DNG, I_MQG, I_MKVG, I_WUQ, I_WUKV, I_CONVW, I_ALF, I_ALB, I_DTF, I_DTB, I_GNG, I_WR, I_RB, I_WG, I_WU, I_WD,
       I_SG, I_SU, I_SD, I_FNG };

DEVI u16 f2bf(float f) { unsigned u = __float_as_uint(f); u += 0x7fffu + ((u >> 16) & 1u); return (u16)(u >> 16); }
DEVI float bf2f(u16 h) { return __uint_as_float(((unsigned)h) << 16); }
DEVI float bflo(unsigned v) { return __uint_as_float(v << 16); }
DEVI float bfhi(unsigned v) { return __uint_as_float(v & 0xffff0000u); }
DEVI unsigned pack2(float a, float b) { f32x2 v = {a, b}; return __builtin_bit_cast(unsigned, __builtin_convertvector(v, bf16x2_t)); }
DEVI f32x4 fzero4() { float z = 0.f; asm volatile("" : "+v"(z)); return f32x4{z, z, z, z}; }
DEVI float wave_sum(float v) {
#pragma unroll
  for (int o = 32; o >= 1; o >>= 1) v += __shfl_xor(v, o);
  return v;
}
DEVI float half_sum(float v) {
#pragma unroll
  for (int o = 16; o >= 1; o >>= 1) v += __shfl_xor(v, o);
  return v;
}
DEVI float siluf(float x) { return x / (1.f + __expf(-x)); }
DEVI float sigmf(float x) { return 1.f / (1.f + __expf(-x)); }
DEVI int tok_mv(int t) { return t < TL ? (t >> 13) : 2; }
DEVI int tok_b(int t) { return t < TL ? (t >> 13) : ((t - TL) >> 8); }
DEVI int tok_row(int t) { return t < TL ? (t & (SEQ - 1)) : (SEQ + ((t - TL) & (CTXL - 1))); }
DEVI const float* modp(const Params& p, int l, int mv, int j) { return (const float*)(p.ws + O_MOD) + ((size_t)(l * 3 + mv) * 6 + j) * 1024; }

#define MFMA16(a, b, c) __builtin_amdgcn_mfma_f32_16x16x32_bf16((a), (b), (c), 0, 0, 0)
#define MFMA32(a, b, c) __builtin_amdgcn_mfma_f32_32x32x16_bf16((a), (b), (c), 0, 0, 0)

DEVI void st_copy_in(const Params& p, int vb, int nvb) {
  float4* xa = (float4*)(p.ws + O_XA);
  const float4* x = (const float4*)pin(p, I_X);
  const float4* cx = (const float4*)pin(p, I_CTX);
  const size_t n4 = (size_t)T * DM / 4, nl4 = (size_t)TL * DM / 4;
  for (size_t i = (size_t)vb * 256 + p.tid; i < n4; i += (size_t)nvb * 256) xa[i] = i < nl4 ? x[i] : cx[i - nl4];
}
DEVI void rope_cs(int i, int half, int s, float& c, float& sn) {
  const int quarter = half >> 1;
  const int ii = i < quarter ? i : i - quarter;
  const float pos = i < quarter ? (float)(s >> 6) : (float)(s & 63);
  const float inv = powf(10000.f, -(float)ii / (float)quarter);
  const float ang = pos * inv;
  c = cosf(ang); sn = sinf(ang);
}
DEVI void st_rope_table(const Params& p, int vb, int nvb) {
  f32x2* R = (f32x2*)(p.ws + O_ROPE);
  for (int e = vb * 256 + p.tid; e < SEQ * 48; e += nvb * 256) {
    const int s = e / 48, i = e % 48;
    float c, sn;
    if (i < 32) rope_cs(i, 32, s, c, sn); else rope_cs(i - 32, 16, s, c, sn);
    R[e] = f32x2{c, sn};
  }
}
DEVI void st_mod(const Params& p, int vb, int nvb, char* smem) {
  float* sv = (float*)smem;
  float* red = sv + 3 * 1024;
  for (int i = p.tid; i < 3 * 1024; i += 256) {
    int v = i >> 10, k = i & 1023;
    float c = v < 2 ? pin(p, I_C)[v * 1024 + k] : pin(p, I_CCTX)[k];
    sv[i] = siluf(c);
  }
  __syncthreads();
  const int cgp = p.tid & 7, kg = p.tid >> 3;
  for (int item = vb; item < 2 * 192; item += nvb) {
    const int l = item / 192, c0 = (item % 192) * 32;
    const float* w = pin(p, I_WADA) + (size_t)l * 1024 * 6144 + c0 + cgp * 4;
    f32x4 a0 = fzero4(), a1 = a0, a2 = a0;
#pragma unroll 8
    for (int kk = 0; kk < 32; ++kk) {
      const int k = kg * 32 + kk;
      const f32x4 wv = *(const f32x4*)(w + (size_t)k * 6144);
      a0 += sv[k] * wv; a1 += sv[1024 + k] * wv; a2 += sv[2048 + k] * wv;
    }
    float* rp = red + (kg * 8 + cgp) * 12;
    *(f32x4*)rp = a0; *(f32x4*)(rp + 4) = a1; *(f32x4*)(rp + 8) = a2;
    __syncthreads();
    if (p.tid < 96) {
      const int v = p.tid >> 5, c = p.tid & 31;
      float s = 0.f;
#pragma unroll 8
      for (int g = 0; g < 32; ++g) s += red[(g * 8 + (c >> 2)) * 12 + v * 4 + (c & 3)];
      ((float*)(p.ws + O_MOD))[(size_t)(l * 3 + v) * 6144 + c0 + c] = s + pin(p, I_BADA)[l * 6144 + c0 + c];
    }
    __syncthreads();
  }
}

template <class RowFn>
DEVI void tr_tile(int tid, const float* __restrict__ src, int N, u16* __restrict__ dst, int ldd, RowFn drow, int k0, int n0, float* tile) {
  {
    const int kq = tid >> 4, n4 = (tid & 15) * 4;
    f32x4 v[4];
#pragma unroll
    for (int r = 0; r < 4; ++r) {
      const int k = r * 16 + kq;
      v[r] = n0 + n4 < N ? *(const f32x4*)(src + (size_t)(k0 + k) * N + n0 + n4) : fzero4();
    }
#pragma unroll
    for (int r = 0; r < 4; ++r) {
      const int k = r * 16 + kq;
      tile[k * 65 + n4] = v[r][0]; tile[k * 65 + n4 + 1] = v[r][1]; tile[k * 65 + n4 + 2] = v[r][2]; tile[k * 65 + n4 + 3] = v[r][3];
    }
  }
  __syncthreads();
  {
    const int n = tid >> 2, kc = (tid & 3) * 16;
    const int dr = drow(n0 + n);
    if (dr >= 0) {
      u32x4 o0, o1;
#pragma unroll
      for (int e = 0; e < 4; ++e) {
        o0[e] = pack2(tile[(kc + 2 * e) * 65 + n], tile[(kc + 2 * e + 1) * 65 + n]);
        o1[e] = pack2(tile[(kc + 8 + 2 * e) * 65 + n], tile[(kc + 8 + 2 * e + 1) * 65 + n]);
      }
      u16* d = dst + (size_t)dr * ldd + k0 + kc;
      *(u32x4*)d = o0; *(u32x4*)(d + 8) = o1;
    }
  }
  __syncthreads();
}
DEVI int win_row(int n) {
  if (n < 1280) return n;
  if (n < 1600) return 1408 + (n - 1280);
  if (n < 1632) return 1280 + (n - 1600);
  if (n < INW) return 1408 + 320 + (n - 1632);
  return -1;
}
constexpr int TR_IN = 16 * 42, TR_OUT = 256, TR_UQ = 18, TR_UKV = 16, TR_E = 4096, TR_S = 64;
constexpr int TR_P1 = TR_IN + TR_OUT + TR_UQ + TR_UKV;
constexpr int TR_P2 = 3 * TR_E + 3 * TR_S;
DEVI void prep_w1_tile(const Params& p, int l, int it, float* tile) {
  if (it < TR_IN) { tr_tile(p.tid, pin(p, I_WIN) + (size_t)l * 1024 * INW, INW, (u16*)(p.ws + O_WINT), LDW, [](int n) { return win_row(n); }, (it / 42) * 64, (it % 42) * 64, tile); return; }
  it -= TR_IN;
  if (it < TR_OUT) { tr_tile(p.tid, pin(p, I_WOUT) + (size_t)l * 1024 * 1024, 1024, (u16*)(p.ws + O_WOUTT), LDW, [](int n) { return n; }, (it / 16) * 64, (it % 16) * 64, tile); return; }
  it -= TR_OUT;
  if (it < TR_UQ) { tr_tile(p.tid, pin(p, I_WUQ) + (size_t)l * 192 * 384, 384, (u16*)(p.ws + O_WUQT), 192, [](int n) { return n; }, (it / 6) * 64, (it % 6) * 64, tile); return; }
  it -= TR_UQ;
  tr_tile(p.tid, pin(p, I_WUKV) + (size_t)l * 128 * 512, 512, (u16*)(p.ws + O_WUKVT), 128,
          [](int n) { const int h = n >> 7, j = n & 127; return j < 64 ? h * 64 + j : 256 + h * 64 + (j - 64); }, (it / 8) * 64, (it % 8) * 64, tile);
}
DEVI void prep_w2_tile(const Params& p, int l, int it, float* tile) {
  if (it < 2 * TR_E) {
    const int which = it / TR_E; it %= TR_E;
    const int e = it >> 6, tt = it & 63;
    const float* src = pin(p, which ? I_WU : I_WG) + ((size_t)l * NE + e) * 1024 * 256;
    tr_tile(p.tid, src, 256, (u16*)(p.ws + O_WGUT) + (size_t)e * 512 * LDW, LDW, [which](int n) { return 2 * n + which; }, (tt >> 2) * 64, (tt & 3) * 64, tile); return;
  }
  it -= 2 * TR_E;
  if (it < TR_E) {
    const int e = it >> 6, tt = it & 63;
    const float* src = pin(p, I_WD) + ((size_t)l * NE + e) * 256 * 1024;
    tr_tile(p.tid, src, 1024, (u16*)(p.ws + O_WDT) + (size_t)e * 1024 * 256, 256, [](int n) { return n; }, (tt >> 4) * 64, (tt & 15) * 64, tile); return;
  }
  it -= TR_E;
  if (it < 2 * TR_S) {
    const int which = it / TR_S; const int tt = it % TR_S;
    const float* src = pin(p, which ? I_SU : I_SG) + (size_t)l * 1024 * 256;
    tr_tile(p.tid, src, 256, (u16*)(p.ws + O_WGUT) + (size_t)64 * 512 * LDW, LDW, [which](int n) { return 2 * n + which; }, (tt >> 2) * 64, (tt & 3) * 64, tile); return;
  }
  it -= 2 * TR_S;
  { const int tt = it;
    const float* src = pin(p, I_SD) + (size_t)l * 256 * 1024;
    tr_tile(p.tid, src, 1024, (u16*)(p.ws + O_WDT) + (size_t)64 * 1024 * 256, 256, [](int n) { return n; }, (tt >> 4) * 64, (tt & 15) * 64, tile); }
}
DEVI void st_prep_w1(const Params& p, int l, int vb, int nvb, char* smem) {
  float* tile = (float*)smem;
  if (vb == 0 && p.tid < 64) ((int*)(p.ws + O_CNT))[p.tid] = 0;
  for (int e = vb * 256 + p.tid; e < 144 * 128; e += nvb * 256) {
    const int r = e >> 7, c8 = e & 127;
    const int row = r < 96 ? 1312 + r : 2768 + (r - 96);
    *(u32x4*)((u16*)(p.ws + O_WINT) + (size_t)row * LDW + c8 * 8) = __builtin_bit_cast(u32x4, fzero4());
  }
  for (int item = vb; item < TR_P1; item += nvb) prep_w1_tile(p, l, item, tile);
}

DEVI void st_norm1(const Params& p, int l, int vb, int nvb) {
  const int lane = p.tid & 63, wid = p.tid >> 6;
  const float* g = pin(p, I_N1G) + l * 1024;
  for (int t4 = (vb * 4 + wid) * 4; t4 < T; t4 += nvb * 16) {
    const int mv = tok_mv(t4);
    const float* sh = modp(p, l, mv, 0); const float* sc = modp(p, l, mv, 1);
    f32x4 v[4][4]; float ss[4];
#pragma unroll
    for (int u = 0; u < 4; ++u) {
      const int t = t4 + u;
      const f32x4* xr = (const f32x4*)(t < TL ? pin(p, I_X) + (size_t)t * 1024 : pin(p, I_CTX) + (size_t)(t - TL) * 1024);
#pragma unroll
      for (int i = 0; i < 4; ++i) v[u][i] = xr[i * 64 + lane];
    }
#pragma unroll
    for (int u = 0; u < 4; ++u) {
      float a = 0.f;
#pragma unroll
      for (int i = 0; i < 4; ++i) a += v[u][i][0] * v[u][i][0] + v[u][i][1] * v[u][i][1] + v[u][i][2] * v[u][i][2] + v[u][i][3] * v[u][i][3];
      ss[u] = a;
    }
#pragma unroll
    for (int o = 32; o >= 1; o >>= 1) {
#pragma unroll
      for (int u = 0; u < 4; ++u) ss[u] += __shfl_xor(ss[u], o);
    }
#pragma unroll
    for (int i = 0; i < 4; ++i) {
      const int c = i * 256 + lane * 4;
      const f32x4 gg = *(const f32x4*)(g + c), s4 = *(const f32x4*)(sc + c), h4 = *(const f32x4*)(sh + c);
      const f32x4 gs = gg * (1.f + s4);
#pragma unroll
      for (int u = 0; u < 4; ++u) {
        const float rstd = rsqrtf(ss[u] * (1.f / 1024.f) + 1e-6f);
        const f32x4 o = v[u][i] * rstd * gs + h4;
        u32x2 pk; pk[0] = pack2(o[0], o[1]); pk[1] = pack2(o[2], o[3]);
        *(u32x2*)((u16*)(p.ws + O_H) + (size_t)(t4 + u) * LDH + c) = pk;
      }
    }
  }
}

constexpr int GLD = 72;
typedef const __attribute__((address_space(1))) unsigned gcu32;
typedef __attribute__((address_space(3))) unsigned lu32;
template <bool SWAP, class ARow>
DEVI void gemm_core(int tid, ARow arow, const u16* __restrict__ Bt, int ldb, int K, f32x4 (&acc)[4][4], char* smem) {
  constexpr int TILE = 128 * 64;
  u16* sbuf = (u16*)smem;
  const int lane = tid & 63, wid = tid >> 6, wr = wid >> 1, wc = wid & 1, fr = lane & 15, fq = lane >> 4;
  const u16* ap[4]; const u16* bp[4];
#pragma unroll
  for (int i = 0; i < 4; ++i) {
    const int q = tid + 256 * i, row = q >> 3, cs = (q & 7) ^ (row & 7);
    ap[i] = arow(row) + cs * 8; bp[i] = Bt + (size_t)row * ldb + cs * 8;
  }
  const int nk = K >> 6;
  auto stage = [&](int kt, int buf) {
    int off = kt * 64; asm volatile("" : "+s"(off));
    u16* dA = sbuf + buf * 2 * TILE + tid * 8; u16* dB = dA + TILE;
#pragma unroll
    for (int i = 0; i < 4; ++i) {
      __builtin_amdgcn_global_load_lds((gcu32*)(ap[i] + off), (lu32*)(dA + i * 2048), 16, 0, 0);
      __builtin_amdgcn_global_load_lds((gcu32*)(bp[i] + off), (lu32*)(dB + i * 2048), 16, 0, 0);
    }
  };
  auto compute = [&](int buf) {
    const u16* sA = sbuf + buf * 2 * TILE; const u16* sB = sA + TILE;
#pragma unroll
    for (int ks = 0; ks < 2; ++ks) {
      bf16x8 af[4], bfr[4];
#pragma unroll
      for (int m = 0; m < 4; ++m) { const int R = wr * 64 + m * 16 + fr; af[m] = *(const bf16x8*)&sA[R * 64 + (((ks * 4 + fq) ^ (R & 7)) << 3)]; }
#pragma unroll
      for (int n = 0; n < 4; ++n) { const int R = wc * 64 + n * 16 + fr; bfr[n] = *(const bf16x8*)&sB[R * 64 + (((ks * 4 + fq) ^ (R & 7)) << 3)]; }
#pragma unroll
      for (int m = 0; m < 4; ++m)
#pragma unroll
        for (int n = 0; n < 4; ++n) acc[m][n] = SWAP ? MFMA16(af[m], bfr[n], acc[m][n]) : MFMA16(bfr[n], af[m], acc[m][n]);
    }
  };
#pragma unroll
  for (int m = 0; m < 4; ++m)
#pragma unroll
    for (int n = 0; n < 4; ++n) acc[m][n] = fzero4();
  __syncthreads();
  stage(0, 0);
  asm volatile("s_waitcnt vmcnt(0)" ::: "memory");
  __syncthreads();
  for (int kt = 0; kt < nk; ++kt) {
    if (kt + 1 < nk) stage(kt + 1, (kt + 1) & 1);
    compute(kt & 1);
    asm volatile("s_waitcnt vmcnt(0)" ::: "memory");
    __syncthreads();
  }
}
template <class ARow, class Epi>
DEVI void gemm128(int tid, ARow arow, const u16* __restrict__ Bt, int ldb, int K, Epi epi, char* smem) {
  f32x4 acc[4][4];
  gemm_core<false>(tid, arow, Bt, ldb, K, acc, smem);
  const int lane = tid & 63, wid = tid >> 6, wr = wid >> 1, wc = wid & 1, fr = lane & 15, fq = lane >> 4;
#pragma unroll
  for (int m = 0; m < 4; ++m)
#pragma unroll
    for (int n = 0; n < 4; ++n) epi(wr * 64 + m * 16 + fr, wc * 64 + n * 16 + fq * 4, acc[m][n]);
}

DEVI void rope4(const f32x4 x1, const f32x4 x2, const f32x2* rp, bool lat, float scale, u32x2& o1, u32x2& o2) {
  f32x4 s = fzero4(), c = s + 1.f;
  if (lat) {
    const f32x4 a = *(const f32x4*)rp, b = *(const f32x4*)(rp + 2);
    c = f32x4{a[0], a[2], b[0], b[2]}; s = f32x4{a[1], a[3], b[1], b[3]};
  }
  const f32x4 y1 = (x1 * c - x2 * s) * scale, y2 = (x2 * c + x1 * s) * scale;
  o1[0] = pack2(y1[0], y1[1]); o1[1] = pack2(y1[2], y1[3]);
  o2[0] = pack2(y2[0], y2[1]); o2[1] = pack2(y2[2], y2[3]);
}
DEVI void inproj_item(const Params& p, int item, char* smem) {
  const u16* H = (const u16*)(p.ws + O_H); const u16* W = (const u16*)(p.ws + O_WINT);
  const f32x2* ROPE = (const f32x2*)(p.ws + O_ROPE);
  const int tid = p.tid, lane = tid & 63, wid = tid >> 6, wr = wid >> 1, wc = wid & 1, fr = lane & 15, fq = lane >> 4;
  {
    const int m0 = (item / 22) * 128, nt = item % 22;
    const bool lat = m0 < TL;
    const int b = tok_b(m0), rowbase = tok_row(m0);
    f32x4 acc[4][4];
    auto arow = [&](int r) { return H + (size_t)(m0 + r) * LDH; };
    if (nt == 3 || nt == 8 || nt == 9) {
      gemm_core<true>(tid, arow, W + (size_t)nt * 128 * LDW, LDW, 1024, acc, smem);
      u16* vt = nt == 3 ? (u16*)(p.ws + O_VTA) + (size_t)(b * 2 + wc) * 64 * NKEY
                        : (u16*)(p.ws + O_VTB) + (size_t)(b * 4 + (nt - 8) * 2 + wc) * 64 * NKEY;
#pragma unroll
      for (int m = 0; m < 4; ++m)
#pragma unroll
        for (int n = 0; n < 4; ++n) {
          u32x2 pk; pk[0] = pack2(acc[m][n][0], acc[m][n][1]); pk[1] = pack2(acc[m][n][2], acc[m][n][3]);
          *(u32x2*)(vt + (size_t)(n * 16 + fr) * NKEY + rowbase + wr * 64 + m * 16 + (((fq & 1) << 1) | (fq >> 1)) * 4) = pk;
        }
      return;
    }
    gemm_core<false>(tid, arow, W + (size_t)nt * 128 * LDW, LDW, 1024, acc, smem);
    if (nt < 3) {
      u16* dst; float scale;
      if (nt < 2) { dst = (u16*)(p.ws + O_QA) + ((size_t)(b * 4 + nt * 2 + wc) * NKEY + rowbase) * 64; scale = 0.125f * LOG2E; }
      else { dst = (u16*)(p.ws + O_KA) + ((size_t)(b * 2 + wc) * NKEY + rowbase) * 64; scale = 1.f; }
#pragma unroll
      for (int m = 0; m < 4; ++m) {
        const int rl = wr * 64 + m * 16 + fr;
#pragma unroll
        for (int pi = 0; pi < 2; ++pi) {
          const int d0 = pi * 16 + fq * 4;
          u32x2 o1, o2;
          rope4(acc[m][pi], acc[m][pi + 2], ROPE + (size_t)(rowbase + rl) * 48 + d0, lat, scale, o1, o2);
          *(u32x2*)(dst + (size_t)rl * 64 + d0) = o1; *(u32x2*)(dst + (size_t)rl * 64 + 32 + d0) = o2;
        }
      }
    } else if (nt < 8) {
      const bool isq = nt < 6;
      u16* base = isq ? (u16*)(p.ws + O_QB) : (u16*)(p.ws + O_KB);
      const float scale = isq ? 0.17677669529663687f * LOG2E : 1.f;
      const int hm0 = ((nt - 4) & 1) * 4 + wc * 2;
#pragma unroll
      for (int m = 0; m < 4; ++m) {
        const int rl = wr * 64 + m * 16 + fr;
#pragma unroll
        for (int g = 0; g < 2; ++g) {
          u16* dst = base + ((size_t)(b * 8 + hm0 + g) * NKEY + rowbase + rl) * 32;
          u32x2 o1, o2;
          rope4(acc[m][2 * g], acc[m][2 * g + 1], ROPE + (size_t)(rowbase + rl) * 48 + 32 + fq * 4, lat, scale, o1, o2);
          *(u32x2*)(dst + fq * 4) = o1; *(u32x2*)(dst + 16 + fq * 4) = o2;
        }
      }
    } else if (nt == 10) {
      if (wc == 0) {
#pragma unroll
        for (int m = 0; m < 4; ++m) {
          const int rl = wr * 64 + m * 16 + fr;
          u32x2 o1, o2;
          rope4(acc[m][0], acc[m][1], ROPE + (size_t)(rowbase + rl) * 48 + 32 + fq * 4, lat, 1.f, o1, o2);
#pragma unroll
          for (int h = 0; h < 4; ++h) {
            u16* dst = (u16*)(p.ws + O_KC) + ((size_t)(b * 4 + h) * NKEY + rowbase + rl) * 96 + 64;
            *(u32x2*)(dst + fq * 4) = o1; *(u32x2*)(dst + 16 + fq * 4) = o2;
          }
        }
      }
    } else {
      u16* PP = (u16*)(p.ws + O_PP);
#pragma unroll
      for (int m = 0; m < 4; ++m)
#pragma unroll
        for (int n = 0; n < 4; ++n) {
          u32x2 pk; pk[0] = pack2(acc[m][n][0], acc[m][n][1]); pk[1] = pack2(acc[m][n][2], acc[m][n][3]);
          *(u32x2*)(PP + (size_t)(m0 + wr * 64 + m * 16 + fr) * LDPP + (nt - 11) * 128 + wc * 64 + n * 16 + fq * 4) = pk;
        }
    }
  }
}

DEVI void st_tokprep(const Params& p, int l, int vb, int nvb) {
  const int lane = p.tid & 63, wid = p.tid >> 6;
  const u16* PP = (const u16*)(p.ws + O_PP);
  u16* GQ = (u16*)(p.ws + O_GQ); u16* GK = (u16*)(p.ws + O_GK); u16* GV = (u16*)(p.ws + O_GV);
  float* GG = (float*)(p.ws + O_GG); float* GB = (float*)(p.ws + O_GBETA);
  u16* CQN = (u16*)(p.ws + O_CQN); u16* CKVN = (u16*)(p.ws + O_CKVN);
  const float* cwp = pin(p, I_CONVW) + (size_t)l * 5 * 768;
  f32x2 cw[6][5];
#pragma unroll
  for (int i = 0; i < 6; ++i)
#pragma unroll
    for (int j = 0; j < 5; ++j) cw[i][j] = *(const f32x2*)(cwp + j * 768 + 2 * lane + 128 * i);
  const float* gq = pin(p, I_MQG) + l * 192; const float* gkv = pin(p, I_MKVG) + l * 128;
  const float gq0 = gq[lane], gq1 = gq[64 + lane], gq2 = gq[128 + lane], gk0 = gkv[lane], gk1 = gkv[64 + lane];
  for (int t = vb * 4 + wid; t < T; t += nvb * 4) {
    int base, pos, len;
    if (t < TL) { base = t & ~(SEQ - 1); pos = t & (SEQ - 1); len = SEQ; } else { int j = t - TL; base = TL + (j & ~(CTXL - 1)); pos = j & (CTXL - 1); len = CTXL; }
    unsigned xin[5][6];
#pragma unroll
    for (int j = 0; j < 5; ++j) {
      const int pp = pos + j - 2;
      const bool ok = pp >= 0 && pp < len;
      const u16* row = PP + (size_t)(base + (ok ? pp : pos)) * LDPP + PP_DQKV + 2 * lane;
#pragma unroll
      for (int i = 0; i < 6; ++i) { unsigned v = *(const unsigned*)(row + 128 * i); xin[j][i] = ok ? v : 0u; }
    }
    const u16* pr = PP + (size_t)t * LDPP;
    const float q0 = bf2f(pr[PP_CQ + lane]), q1 = bf2f(pr[PP_CQ + 64 + lane]), q2 = bf2f(pr[PP_CQ + 128 + lane]);
    const float k0 = bf2f(pr[PP_CKV + lane]), k1 = bf2f(pr[PP_CKV + 64 + lane]);
    const float gate_in = lane < 16 ? bf2f(pr[PP_GATE + lane]) : 0.f;
#pragma unroll
    for (int i = 0; i < 6; ++i) {
      float a0 = 0.f, a1 = 0.f;
#pragma unroll
      for (int j = 0; j < 5; ++j) { a0 += cw[i][j][0] * bflo(xin[j][i]); a1 += cw[i][j][1] * bfhi(xin[j][i]); }
      float y0 = siluf(a0), y1 = siluf(a1);
      const int c = 2 * lane + 128 * i;
      if (i < 4) {
        const float ss = half_sum(y0 * y0 + y1 * y1);
        const float r = rsqrtf(ss + 1e-6f) * (i < 2 ? 0.125f : 1.f);
        u16* dst = i < 2 ? GQ + (size_t)t * 256 + c : GK + (size_t)t * 256 + (c - 256);
        *(unsigned*)dst = pack2(y0 * r, y1 * r);
      } else *(unsigned*)(GV + (size_t)t * 256 + (c - 512)) = pack2(y0, y1);
    }
    if (lane < 16) {
      const int which = lane >> 2, hd = lane & 3;
      if (which < 2) {
        const float al = which ? pin(p, I_ALB)[l * 4 + hd] : pin(p, I_ALF)[l * 4 + hd];
        const float dt = which ? pin(p, I_DTB)[l * 4 + hd] : pin(p, I_DTF)[l * 4 + hd];
        const float xx = gate_in + dt;
        const float sp = fmaxf(xx, 0.f) + log1pf(expf(-fabsf(xx)));
        GG[((size_t)which * T + t) * 4 + hd] = -expf(al) * sp;
      } else GB[((size_t)(which - 2) * T + t) * 4 + hd] = sigmf(gate_in);
    }
    {
      float ss = q0 * q0 + q1 * q1 + q2 * q2, s2 = k0 * k0 + k1 * k1;
#pragma unroll
      for (int o = 32; o >= 1; o >>= 1) { ss += __shfl_xor(ss, o); s2 += __shfl_xor(s2, o); }
      const float rs = rsqrtf(ss * (1.f / 192.f) + 1e-6f), r2 = rsqrtf(s2 * (1.f / 128.f) + 1e-6f);
      u16* d = CQN + (size_t)t * 192;
      d[lane] = f2bf(q0 * rs * gq0); d[64 + lane] = f2bf(q1 * rs * gq1); d[128 + lane] = f2bf(q2 * rs * gq2);
      u16* d2 = CKVN + (size_t)t * 128;
      d2[lane] = f2bf(k0 * r2 * gk0); d2[64 + lane] = f2bf(k1 * r2 * gk1);
    }
  }
}

DEVI void mla_up_tile(const Params& p, int mt, int nn, char* smem) {
  const int tid = p.tid, lane = tid & 63, wid = tid >> 6, wr = wid >> 1, wc = wid & 1, fr = lane & 15, fq = lane >> 4;
  const int m0 = mt * 128;
  const bool lat = m0 < TL;
  const int b = tok_b(m0), rowbase = tok_row(m0);
  f32x4 acc[4][4];
  if (nn < 3) {
    const u16* CQN = (const u16*)(p.ws + O_CQN);
    gemm_core<false>(tid, [&](int r) { return CQN + (size_t)(m0 + r) * 192; }, (const u16*)(p.ws + O_WUQT) + (size_t)nn * 128 * 192, 192, 192, acc, smem);
    const f32x2* ROPE = (const f32x2*)(p.ws + O_ROPE);
    const float scale = 0.10206207261596577f * LOG2E;
    u16* QC = (u16*)(p.ws + O_QC);
#pragma unroll
    for (int m = 0; m < 4; ++m) {
      const int rl = wr * 64 + m * 16 + fr;
#pragma unroll
      for (int n = 0; n < 4; ++n) {
        const int cb = nn * 128 + wc * 64 + n * 16;
        const int h = cb / 96, db = cb - h * 96;
        u16* dst = QC + ((size_t)(b * 4 + h) * NKEY + rowbase + rl) * 96;
        if (db < 64) {
          u32x2 pk; pk[0] = pack2(acc[m][n][0] * scale, acc[m][n][1] * scale); pk[1] = pack2(acc[m][n][2] * scale, acc[m][n][3] * scale);
          *(u32x2*)(dst + db + fq * 4) = pk;
        } else if (db == 64 && n < 3) {
          u32x2 o1, o2;
          rope4(acc[m][n], acc[m][n + 1], ROPE + (size_t)(rowbase + rl) * 48 + 32 + fq * 4, lat, scale, o1, o2);
          *(u32x2*)(dst + 64 + fq * 4) = o1; *(u32x2*)(dst + 80 + fq * 4) = o2;
        }
      }
    }
  } else {
    const u16* CKVN = (const u16*)(p.ws + O_CKVN);
    auto arow = [&](int r) { return CKVN + (size_t)(m0 + r) * 128; };
    const u16* Wt = (const u16*)(p.ws + O_WUKVT) + (size_t)(nn - 3) * 128 * 128;
    if (nn < 5) {
      gemm_core<false>(tid, arow, Wt, 128, 128, acc, smem);
      u16* KC = (u16*)(p.ws + O_KC) + ((size_t)(b * 4 + (nn - 3) * 2 + wc) * NKEY + rowbase) * 96;
#pragma unroll
      for (int m = 0; m < 4; ++m)
#pragma unroll
        for (int n = 0; n < 4; ++n) {
          u32x2 pk; pk[0] = pack2(acc[m][n][0], acc[m][n][1]); pk[1] = pack2(acc[m][n][2], acc[m][n][3]);
          *(u32x2*)(KC + (size_t)(wr * 64 + m * 16 + fr) * 96 + n * 16 + fq * 4) = pk;
        }
    } else {
      gemm_core<true>(tid, arow, Wt, 128, 128, acc, smem);
      u16* vt = (u16*)(p.ws + O_VTC) + (size_t)(b * 4 + (nn - 5) * 2 + wc) * 64 * NKEY;
#pragma unroll
      for (int m = 0; m < 4; ++m)
#pragma unroll
        for (int n = 0; n < 4; ++n) {
          u32x2 pk; pk[0] = pack2(acc[m][n][0], acc[m][n][1]); pk[1] = pack2(acc[m][n][2], acc[m][n][3]);
          *(u32x2*)(vt + (size_t)(n * 16 + fr) * NKEY + rowbase + wr * 64 + m * 16 + (((fq & 1) << 1) | (fq >> 1)) * 4) = pk;
        }
    }
  }
}
DEVI int permcol(int x) { return (x & 32) + 8 * ((x >> 2) & 3) + 4 * ((x >> 4) & 1) + (x & 3); }
DEVI int cidx(int d, int e) { return ((((e >> 4) * 4 + (d >> 4)) * 64) + (e & 15) + 16 * ((d >> 2) & 3)) * 4 + (d & 3); }
DEVI int gdn_chunk_t0(int ci) { return ci < 256 ? (ci >> 7) * SEQ + (ci & 127) * 64 : TL + ((ci - 256) >> 2) * CTXL + ((ci - 256) & 3) * 64; }

DEVI void gdn_chunk_item(const Params& p, int item, char* smem) {
  u16* sK = (u16*)smem;
  float* sA = (float*)(smem + 9216);
  u16* sXt = (u16*)smem;
  u16* sAt = (u16*)(smem + 26624);
  u16* sKt = (u16*)(smem + 35840);
  float* sX = (float*)(smem + 45056);
  float* sgc = (float*)(smem + 77824); float* sbeta = sgc + 64; float* seg = sbeta + 64; float* skd = seg + 64;
  const u16* GQ = (const u16*)(p.ws + O_GQ); const u16* GK = (const u16*)(p.ws + O_GK); const u16* GV = (const u16*)(p.ws + O_GV);
  const float* GG = (const float*)(p.ws + O_GG); const float* GB = (const float*)(p.ws + O_GBETA);
  u16* GM = (u16*)(p.ws + O_GM); u16* GQP = (u16*)(p.ws + O_GQP); u16* GN = (u16*)(p.ws + O_GN); u16* GLO = (u16*)(p.ws + O_GLO);
  const int tid = p.tid, lane = tid & 63, w = tid >> 6, i15 = lane & 15, q = lane >> 4;
  {
    const int ci = item >> 3, hd = (item >> 1) & 3, dir = item & 1;
    const int t0 = gdn_chunk_t0(ci);
    auto tok = [&](int i) { return dir ? t0 + 63 - i : t0 + i; };
    __syncthreads();
    if (tid < 64) {
      float g = GG[((size_t)dir * T + tok(tid)) * 4 + hd];
#pragma unroll
      for (int o = 1; o < 64; o <<= 1) { float u = __shfl_up(g, o); if (lane >= o) g += u; }
      const float gl = __shfl(g, 63);
      sgc[tid] = g; sbeta[tid] = GB[((size_t)dir * T + tok(tid)) * 4 + hd]; seg[tid] = expf(g); skd[tid] = expf(gl - g);
    }
    __syncthreads();
    const float eglast = seg[63];
#pragma unroll
    for (int i = 0; i < 2; ++i) {
      const int ch = tid + 256 * i, j = ch >> 3, cc = ch & 7;
      const u32x4 kv = *(const u32x4*)(GK + (size_t)tok(j) * 256 + hd * 64 + cc * 8);
      *(u32x4*)&sK[j * 72 + cc * 8] = kv;
      const float kd = skd[j];
#pragma unroll
      for (int e = 0; e < 4; ++e) {
        sKt[(cc * 8 + 2 * e) * 72 + j] = f2bf(bf2f((u16)(kv[e] & 0xffff)) * kd);
        sKt[(cc * 8 + 2 * e + 1) * 72 + j] = f2bf(bf2f((u16)(kv[e] >> 16)) * kd);
      }
    }
#pragma unroll
    for (int i = 0; i < 2; ++i) {
      const int ch = tid + 256 * i, j = ch >> 3, cc = ch & 7;
      const u32x4 vv = *(const u32x4*)(GV + (size_t)tok(j) * 256 + hd * 64 + cc * 8);
      const float bj = sbeta[j];
      float* d = sX + j * 128 + cc * 8;
#pragma unroll
      for (int e = 0; e < 4; ++e) { d[2 * e] = bflo(vv[e]) * bj; d[2 * e + 1] = bfhi(vv[e]) * bj; }
    }
    __syncthreads();
    for (int e = tid; e < 64 * 64; e += 256) {
      const int j = e >> 6, c = e & 63;
      sX[j * 128 + 64 + c] = bf2f(sK[j * 72 + c]) * sbeta[j] * seg[j];
    }
    {
      f32x4 kk[4], qk[4];
#pragma unroll
      for (int nt = 0; nt < 4; ++nt) { kk[nt] = fzero4(); qk[nt] = fzero4(); }
#pragma unroll
      for (int ks = 0; ks < 2; ++ks) {
        const bf16x8 ak = *(const bf16x8*)&sK[(16 * w + i15) * 72 + ks * 32 + q * 8];
        const bf16x8 aq = *(const bf16x8*)(GQ + (size_t)tok(16 * w + i15) * 256 + hd * 64 + ks * 32 + q * 8);
#pragma unroll
        for (int nt = 0; nt < 4; ++nt) {
          const bf16x8 bk = *(const bf16x8*)&sK[(16 * nt + i15) * 72 + ks * 32 + q * 8];
          kk[nt] = MFMA16(ak, bk, kk[nt]); qk[nt] = MFMA16(aq, bk, qk[nt]);
        }
      }
#pragma unroll
      for (int nt = 0; nt < 4; ++nt)
#pragma unroll
        for (int r = 0; r < 4; ++r) {
          const int i = 16 * w + 4 * q + r, j = 16 * nt + i15;
          const float dec = i >= j ? expf(sgc[i] - sgc[j]) : 0.f;
          sA[i * 68 + j] = i > j ? sbeta[i] * kk[nt][r] * dec : 0.f;
          sAt[i * 72 + j] = f2bf(i >= j ? qk[nt][r] * dec : 0.f);
        }
    }
    __syncthreads();
    if (tid < 128) {
      const int c = tid;
      for (int ib = 0; ib < 16; ++ib) {
        float a0 = sX[(4 * ib) * 128 + c], a1 = sX[(4 * ib + 1) * 128 + c], a2 = sX[(4 * ib + 2) * 128 + c], a3 = sX[(4 * ib + 3) * 128 + c];
#pragma unroll 4
        for (int g = 0; g < ib; ++g) {
          const float x0 = sX[(4 * g) * 128 + c], x1 = sX[(4 * g + 1) * 128 + c], x2 = sX[(4 * g + 2) * 128 + c], x3 = sX[(4 * g + 3) * 128 + c];
          const f32x4 r0 = *(const f32x4*)&sA[(4 * ib) * 68 + 4 * g], r1 = *(const f32x4*)&sA[(4 * ib + 1) * 68 + 4 * g];
          const f32x4 r2 = *(const f32x4*)&sA[(4 * ib + 2) * 68 + 4 * g], r3 = *(const f32x4*)&sA[(4 * ib + 3) * 68 + 4 * g];
          a0 -= r0[0] * x0 + r0[1] * x1 + r0[2] * x2 + r0[3] * x3;
          a1 -= r1[0] * x0 + r1[1] * x1 + r1[2] * x2 + r1[3] * x3;
          a2 -= r2[0] * x0 + r2[1] * x1 + r2[2] * x2 + r2[3] * x3;
          a3 -= r3[0] * x0 + r3[1] * x1 + r3[2] * x2 + r3[3] * x3;
        }
        const f32x4 d1 = *(const f32x4*)&sA[(4 * ib + 1) * 68 + 4 * ib], d2 = *(const f32x4*)&sA[(4 * ib + 2) * 68 + 4 * ib], d3 = *(const f32x4*)&sA[(4 * ib + 3) * 68 + 4 * ib];
        a1 -= d1[0] * a0;
        a2 -= d2[0] * a0 + d2[1] * a1;
        a3 -= d3[0] * a0 + d3[1] * a1 + d3[2] * a2;
        sX[(4 * ib) * 128 + c] = a0; sX[(4 * ib + 1) * 128 + c] = a1; sX[(4 * ib + 2) * 128 + c] = a2; sX[(4 * ib + 3) * 128 + c] = a3;
      }
    }
    __syncthreads();
    {
      const int c = tid & 127, jh = (tid >> 7) * 32;
#pragma unroll
      for (int g = 0; g < 4; ++g) {
        u32x4 pk;
#pragma unroll
        for (int e = 0; e < 4; ++e) pk[e] = pack2(sX[(jh + 8 * g + 2 * e) * 128 + c], sX[(jh + 8 * g + 2 * e + 1) * 128 + c]);
        *(u32x4*)&sXt[c * 72 + jh + 8 * g] = pk;
      }
    }
    __syncthreads();
    {
      f32x4 r1[8], r2[8];
#pragma unroll
      for (int ct = 0; ct < 8; ++ct) { r1[ct] = fzero4(); r2[ct] = fzero4(); }
#pragma unroll
      for (int ks = 0; ks < 2; ++ks) {
        const bf16x8 aa = *(const bf16x8*)&sAt[(16 * w + i15) * 72 + ks * 32 + q * 8];
        const bf16x8 ak = *(const bf16x8*)&sKt[(16 * w + i15) * 72 + ks * 32 + q * 8];
#pragma unroll
        for (int ct = 0; ct < 8; ++ct) {
          const bf16x8 bx = *(const bf16x8*)&sXt[(16 * ct + i15) * 72 + ks * 32 + q * 8];
          r1[ct] = MFMA16(aa, bx, r1[ct]); r2[ct] = MFMA16(ak, bx, r2[ct]);
        }
      }
      const size_t ib = (size_t)item * 4096;
#pragma unroll
      for (int ct = 0; ct < 4; ++ct) {
        u32x2 a, b;
        a[0] = pack2(r1[ct][0], r1[ct][1]); a[1] = pack2(r1[ct][2], r1[ct][3]);
        b[0] = pack2(r2[ct][0], r2[ct][1]); b[1] = pack2(r2[ct][2], r2[ct][3]);
        *(u32x2*)(GLO + ib + ((ct * 4 + w) * 64 + lane) * 4) = a;
        *(u32x2*)(GN + ib + ((ct * 4 + w) * 64 + lane) * 4) = b;
      }
#pragma unroll
      for (int ct = 4; ct < 8; ++ct)
#pragma unroll
        for (int r = 0; r < 4; ++r) {
          const int row = 16 * w + 4 * q + r, col = 16 * (ct - 4) + i15;
          const float qv = bf2f(GQ[(size_t)tok(row) * 256 + hd * 64 + col]);
          GQP[ib + row * 64 + permcol(col)] = f2bf(qv * seg[row] - r1[ct][r]);
          GM[ib + row * 64 + permcol(col)] = f2bf((row == col ? eglast : 0.f) - r2[ct][r]);
        }
    }
    __syncthreads();
  }
}

DEVI void gdn_scan_chain(const Params& p, int chain, char* smem) {
  const int tid = p.tid, lane = tid & 63, w = tid >> 6, i15 = lane & 15, q = lane >> 4;
  u16* sM = (u16*)smem;
  u16* sQ = sM + 2 * 64 * 72;
  const u16* GM = (const u16*)(p.ws + O_GM); const u16* GQP = (const u16*)(p.ws + O_GQP);
  const u16* GN = (const u16*)(p.ws + O_GN); const u16* GLO = (const u16*)(p.ws + O_GLO);
  float* GO = (float*)(p.ws + O_GO);
  {
    const int b = chain >> 3, hd = (chain >> 1) & 3, dir = chain & 1;
    f32x4 S[4];
#pragma unroll
    for (int r = 0; r < 4; ++r) S[r] = fzero4();
    auto item_of = [&](int n) {
      int ci = n < 4 ? 256 + b * 4 + (dir ? 3 - n : n) : b * 128 + (dir ? 127 - (n - 4) : (n - 4));
      return ci * 8 + hd * 2 + dir;
    };
    u32x4 pm[2], pq[2]; u32x2 pn[4], pl[4];
    auto prefetch = [&](int n) {
      const size_t base = (size_t)item_of(n) * 4096;
#pragma unroll
      for (int i = 0; i < 2; ++i) {
        const int ch = tid + 256 * i;
        pm[i] = *(const u32x4*)(GM + base + ch * 8);
        pq[i] = *(const u32x4*)(GQP + base + ch * 8);
      }
#pragma unroll
      for (int rb = 0; rb < 4; ++rb) {
        pn[rb] = *(const u32x2*)(GN + base + ((w * 4 + rb) * 64 + lane) * 4);
        pl[rb] = *(const u32x2*)(GLO + base + ((w * 4 + rb) * 64 + lane) * 4);
      }
    };
    prefetch(0);
    __syncthreads();
    for (int n = 0; n < 132; ++n) {
      const int buf = n & 1;
      u16* bM = sM + buf * 64 * 72; u16* bQ = sQ + buf * 64 * 72;
#pragma unroll
      for (int i = 0; i < 2; ++i) {
        const int ch = tid + 256 * i, row = ch >> 3, cc = ch & 7;
        *(u32x4*)&bM[row * 72 + cc * 8] = pm[i];
        *(u32x4*)&bQ[row * 72 + cc * 8] = pq[i];
      }
      f32x4 accs[4], acco[4];
#pragma unroll
      for (int rb = 0; rb < 4; ++rb) {
        accs[rb] = f32x4{bf2f((u16)(pn[rb][0] & 0xffff)), bf2f((u16)(pn[rb][0] >> 16)), bf2f((u16)(pn[rb][1] & 0xffff)), bf2f((u16)(pn[rb][1] >> 16))};
        acco[rb] = f32x4{bf2f((u16)(pl[rb][0] & 0xffff)), bf2f((u16)(pl[rb][0] >> 16)), bf2f((u16)(pl[rb][1] & 0xffff)), bf2f((u16)(pl[rb][1] >> 16))};
      }
      const int ci = n < 4 ? 256 + b * 4 + (dir ? 3 - n : n) : b * 128 + (dir ? 127 - (n - 4) : (n - 4));
      const int t0 = gdn_chunk_t0(ci);
      __syncthreads();
      if (n + 1 < 132) prefetch(n + 1);
      bf16x8 sb[2];
#pragma unroll
      for (int kb = 0; kb < 2; ++kb)
#pragma unroll
        for (int jj = 0; jj < 8; ++jj) sb[kb][jj] = (short)f2bf(S[2 * kb + (jj >> 2)][jj & 3]);
#pragma unroll
      for (int kb = 0; kb < 2; ++kb)
#pragma unroll
        for (int rb = 0; rb < 4; ++rb) {
          const bf16x8 am = *(const bf16x8*)&bM[(rb * 16 + i15) * 72 + kb * 32 + q * 8];
          const bf16x8 aq = *(const bf16x8*)&bQ[(rb * 16 + i15) * 72 + kb * 32 + q * 8];
          accs[rb] = MFMA16(am, sb[kb], accs[rb]);
          acco[rb] = MFMA16(aq, sb[kb], acco[rb]);
        }
#pragma unroll
      for (int rb = 0; rb < 4; ++rb) {
        S[rb] = accs[rb];
#pragma unroll
        for (int r = 0; r < 4; ++r) {
          const int i = rb * 16 + q * 4 + r;
          const int t = dir ? t0 + 63 - i : t0 + i;
          GO[(size_t)dir * T * 256 + (size_t)t * 256 + hd * 64 + w * 16 + i15] = acco[rb][r];
        }
      }
    }
    __syncthreads();
  }
}


template <int DQK>
DEVI void attn_run(int tid, const u16* __restrict__ Qp, int qrow0, const u16* __restrict__ Kp, const u16* __restrict__ Vtp,
                   int a0, int a1, int b0, int b1, int qpos0, float sink2, f32x16 (&O)[2], char* smem) {
  constexpr int KLD = DQK + 8, NS = DQK / 16, KCH = DQK / 8, NKL = (64 * KCH) / 256;
  constexpr int BUF = 64 * KLD + 64 * 72;
  u16* sbase = (u16*)smem;
  const int lane = tid & 63, wid = tid >> 6, r31 = lane & 31, hh = lane >> 5;
  const int qrow = qrow0 + wid * 32 + r31;
  bf16x8 qf[NS];
#pragma unroll
  for (int s = 0; s < NS; ++s) qf[s] = *(const bf16x8*)(Qp + (size_t)qrow * DQK + s * 16 + hh * 8);
#pragma unroll
  for (int i = 0; i < 16; ++i) { O[0][i] = 0.f; O[1][i] = 0.f; }
  float m = -30000.f, lsum = 0.f;
  const int na = (a1 - a0) >> 6, nt = na + ((b1 - b0) >> 6);
  const int qpos = qpos0 + wid * 32 + r31;
  u32x4 rk[NKL], rv[2];
  auto gload = [&](int ti) {
    const int key0 = ti >= na ? b0 + (ti - na) * 64 : a0 + ti * 64;
#pragma unroll
    for (int i = 0; i < NKL; ++i) { const int q = tid + 256 * i, r = q / KCH, cc = q % KCH; rk[i] = *(const u32x4*)(Kp + (size_t)(key0 + r) * DQK + cc * 8); }
#pragma unroll
    for (int i = 0; i < 2; ++i) { const int q = tid + 256 * i, r = q >> 3, cc = q & 7; rv[i] = *(const u32x4*)(Vtp + (size_t)r * NKEY + key0 + cc * 8); }
  };
  auto lstore = [&](int buf) {
    u16* sK = sbase + buf * BUF; u16* sV = sK + 64 * KLD;
#pragma unroll
    for (int i = 0; i < NKL; ++i) { const int q = tid + 256 * i, r = q / KCH, cc = q % KCH; *(u32x4*)&sK[r * KLD + cc * 8] = rk[i]; }
#pragma unroll
    for (int i = 0; i < 2; ++i) { const int q = tid + 256 * i, r = q >> 3, cc = q & 7; *(u32x4*)&sV[r * 72 + cc * 8] = rv[i]; }
  };
  m = -30000.f;
  gload(0);
  __syncthreads();
  lstore(0);
  __syncthreads();
  for (int ti = 0; ti < nt; ++ti) {
    if (ti + 1 < nt) gload(ti + 1);
    const u16* sK = sbase + (ti & 1) * BUF; const u16* sV = sK + 64 * KLD;
    const bool inB = ti >= na;
    const int key0 = inB ? b0 + (ti - na) * 64 : a0 + ti * 64;
    f32x16 st[2];
#pragma unroll
    for (int k2 = 0; k2 < 2; ++k2) {
#pragma unroll
      for (int i = 0; i < 16; ++i) st[k2][i] = 0.f;
#pragma unroll
      for (int s = 0; s < NS; ++s) {
        const bf16x8 kf = *(const bf16x8*)&sK[(k2 * 32 + r31) * KLD + s * 16 + hh * 8];
        st[k2] = MFMA32(kf, qf[s], st[k2]);
      }
    }
    if (inB) {
#pragma unroll
      for (int k2 = 0; k2 < 2; ++k2)
#pragma unroll
        for (int g = 0; g < 16; ++g) {
          const int d = key0 + k2 * 32 + (g & 3) + 8 * (g >> 2) + 4 * hh - qpos;
          if (d > 128 || d < -128) st[k2][g] = -1e30f;
        }
    }
    bf16x8 vfr[2][2][2];
#pragma unroll
    for (int k2 = 0; k2 < 2; ++k2)
#pragma unroll
      for (int s2 = 0; s2 < 2; ++s2)
#pragma unroll
        for (int dvt = 0; dvt < 2; ++dvt) vfr[k2][s2][dvt] = *(const bf16x8*)&sV[(dvt * 32 + r31) * 72 + k2 * 32 + s2 * 16 + 8 * hh];
    float mx = st[0][0];
#pragma unroll
    for (int g = 1; g < 16; ++g) mx = fmaxf(mx, st[0][g]);
#pragma unroll
    for (int g = 0; g < 16; ++g) mx = fmaxf(mx, st[1][g]);
    { auto rr = __builtin_amdgcn_permlane32_swap(__float_as_uint(mx), __float_as_uint(mx), false, false);
      mx = fmaxf(__uint_as_float(rr[0]), __uint_as_float(rr[1])); }
    if (__any(mx > m + 8.f)) {
      const float mn = fmaxf(m, mx);
      const float alpha = __builtin_amdgcn_exp2f(m - mn);
      m = mn; lsum *= alpha;
#pragma unroll
      for (int i = 0; i < 16; ++i) { O[0][i] *= alpha; O[1][i] *= alpha; }
    }
    f32x2 ps2 = {0.f, 0.f};
#pragma unroll
    for (int k2 = 0; k2 < 2; ++k2)
#pragma unroll
      for (int g = 0; g < 16; g += 2) {
        const float p0 = __builtin_amdgcn_exp2f(st[k2][g] - m), p1 = __builtin_amdgcn_exp2f(st[k2][g + 1] - m);
        st[k2][g] = p0; st[k2][g + 1] = p1;
        ps2 += f32x2{p0, p1};
      }
    lsum += ps2[0] + ps2[1];
#pragma unroll
    for (int k2 = 0; k2 < 2; ++k2)
#pragma unroll
      for (int s2 = 0; s2 < 2; ++s2) {
        u32x4 pp;
#pragma unroll
        for (int j = 0; j < 4; ++j) pp[j] = pack2(st[k2][8 * s2 + 2 * j], st[k2][8 * s2 + 2 * j + 1]);
        const bf16x8 pf = __builtin_bit_cast(bf16x8, pp);
#pragma unroll
        for (int dvt = 0; dvt < 2; ++dvt) {
          O[dvt] = MFMA32(vfr[k2][s2][dvt], pf, O[dvt]);
        }
      }
    if (ti + 1 < nt) lstore((ti + 1) & 1);
    __syncthreads();
  }
  if (sink2 > -1e29f) {
    const float mn = fmaxf(m, sink2);
    const float alpha = __builtin_amdgcn_exp2f(m - mn);
    lsum = lsum * alpha + (hh == 0 ? __builtin_amdgcn_exp2f(sink2 - mn) : 0.f);
#pragma unroll
    for (int i = 0; i < 16; ++i) { O[0][i] *= alpha; O[1][i] *= alpha; }
  }
  const float ltot = lsum + __shfl_xor(lsum, 32);
  const float inv = 1.f / ltot;
#pragma unroll
  for (int i = 0; i < 16; ++i) { O[0][i] *= inv; O[1][i] *= inv; }
}
DEVI void attn_store(int tid, const f32x16 (&O)[2], u16* dst, int ld, int b, int qrow0, int col0) {
  const int lane = tid & 63, wid = tid >> 6, r31 = lane & 31, hh = lane >> 5;
  const int qrow = qrow0 + wid * 32 + r31;
  const int t = qrow < SEQ ? b * SEQ + qrow : TL + b * CTXL + (qrow - SEQ);
  u16* yr = dst + (size_t)t * ld + col0;
#pragma unroll
  for (int dvt = 0; dvt < 2; ++dvt)
#pragma unroll
    for (int g4 = 0; g4 < 4; ++g4) {
      u32x2 pk; pk[0] = pack2(O[dvt][g4 * 4 + 0], O[dvt][g4 * 4 + 1]); pk[1] = pack2(O[dvt][g4 * 4 + 2], O[dvt][g4 * 4 + 3]);
      *(u32x2*)(yr + dvt * 32 + 8 * g4 + 4 * hh) = pk;
    }
}
DEVI void attn_item(const Params& p, int l, int mixer, int b, int h, int qb, char* smem) {
  const bool lat = qb < 64;
  const int qrow0 = qb * 128;
  f32x16 O[2];
  if (mixer == 0) {
    attn_run<32>(p.tid, (const u16*)(p.ws + O_QB) + (size_t)(b * 8 + h) * NKEY * 32, qrow0, (const u16*)(p.ws + O_KB) + (size_t)(b * 8 + h) * NKEY * 32,
                 (const u16*)(p.ws + O_VTB) + (size_t)(b * 4 + (h >> 1)) * 64 * NKEY, lat ? 0 : SEQ, NKEY, 0, 0, 0, -1e30f, O, smem);
    attn_store(p.tid, O, (u16*)(p.ws + O_OB), 512, b, qrow0, h * 64);
  } else if (mixer == 1) {
    attn_run<96>(p.tid, (const u16*)(p.ws + O_QC) + (size_t)(b * 4 + h) * NKEY * 96, qrow0, (const u16*)(p.ws + O_KC) + (size_t)(b * 4 + h) * NKEY * 96,
                 (const u16*)(p.ws + O_VTC) + (size_t)(b * 4 + h) * 64 * NKEY, lat ? 0 : SEQ, NKEY, 0, 0, 0, -1e30f, O, smem);
    attn_store(p.tid, O, (u16*)(p.ws + O_Y), 1024, b, qrow0, 512 + h * 64);
  } else {
    const float sink2 = pin(p, I_SINK)[l * 4 + h] * LOG2E;
    const int hk = h >> 1;
    int b0 = 0, b1 = 0;
    if (lat) { b0 = (qb - 1) * 128; if (b0 < 0) b0 = 0; b1 = (qb + 2) * 128; if (b1 > SEQ) b1 = SEQ; }
    attn_run<64>(p.tid, (const u16*)(p.ws + O_QA) + (size_t)(b * 4 + h) * NKEY * 64, qrow0, (const u16*)(p.ws + O_KA) + (size_t)(b * 2 + hk) * NKEY * 64,
                 (const u16*)(p.ws + O_VTA) + (size_t)(b * 2 + hk) * 64 * NKEY, SEQ, NKEY, b0, b1, qrow0, sink2, O, smem);
    attn_store(p.tid, O, (u16*)(p.ws + O_Y), 1024, b, qrow0, h * 64);
  }
}

constexpr int SMEM_BYTES = 78848 + 64;

DEVI unsigned long long launder_ptr(unsigned long long v) {
  unsigned lo = __builtin_amdgcn_readfirstlane((unsigned)v), hi = __builtin_amdgcn_readfirstlane((unsigned)(v >> 32));
  asm volatile("s_mov_b32 %0, %1" : "=s"(lo) : "s"(lo));
  asm volatile("s_mov_b32 %0, %1" : "=s"(hi) : "s"(hi));
  return ((unsigned long long)hi << 32) | lo;
}
DEVI Params mkctx(const KArgs& a) {
  Params c;
  typedef __attribute__((address_space(1))) char gchar;
  typedef __attribute__((address_space(1))) float gfloat;
  c.ws = (char*)(gchar*)launder_ptr((unsigned long long)a.ws);
  c.out = (float*)(gfloat*)launder_ptr((unsigned long long)a.out);
  c.in = (gcfloat* const*)(c.ws + O_TAB);
  c.tid = threadIdx.x;
  asm volatile("" : "+v"(c.tid));
  return c;
}
DEVI void st_mixer_queue(const KArgs& a, int l, char* smem) {
  int* sitem = (int*)(smem + SMEM_BYTES - 16);
  const int g = blockIdx.x & 7;
  const int nctx = l == 0 ? 8 : 0;
  constexpr int NPREP = TR_P2 / 8 / 8;
  const int total = 2 + 128 + 64 + 64 + nctx + NPREP;
  for (;;) {
    const Params p = mkctx(a);
    unsigned* head = (unsigned*)(p.ws + O_BAR) + 16 + l * 8 + g;
    __syncthreads();
    if (p.tid == 0) *sitem = (int)atomicAdd(head, 1u);
    __syncthreads();
    int it = *sitem;
    if (it >= total) break;
    if (it < 2) { gdn_scan_chain(p, 2 * g + it, smem); continue; }
    it -= 2;
    if (it < 256 + nctx) {
      int mixer, b, h, qb;
      if (it < 128) { const int pr = 2 * g + (it >> 6); mixer = 0; b = pr >> 3; h = pr & 7; qb = it & 63; }
      else if (it < 256) { mixer = 1 + ((it - 128) >> 6); b = g >> 2; h = g & 3; qb = it & 63; }
      else {
        const int j = it - 256;
        if (j < 4) { const int pr = 2 * g + (j >> 1); mixer = 0; b = pr >> 3; h = pr & 7; qb = 64 + (j & 1); }
        else { mixer = 1 + ((j - 4) >> 1); b = g >> 2; h = g & 3; qb = 64 + (j & 1); }
      }
      attn_item(p, l, mixer, b, h, qb, smem);
      continue;
    }
    it -= 256 + nctx;
#pragma unroll 1
    for (int k = 0; k < 8; ++k) prep_w2_tile(p, l, (it * 8 + g) * 8 + k, (float*)smem);
  }
}

DEVI void st_mix_finish(const Params& p, int l, int vb, int nvb) {
  const int lane = p.tid & 63, wid = p.tid >> 6;
  const float* GO = (const float*)(p.ws + O_GO); const u16* PP = (const u16*)(p.ws + O_PP); const u16* OB = (const u16*)(p.ws + O_OB);
  u16* Y = (u16*)(p.ws + O_Y);
  const float lam_init = 0.8f - 0.6f * expf(-0.3f * (float)l);
  float d1 = lane < 32 ? pin(p, I_LQ1)[l * 32 + lane] * pin(p, I_LK1)[l * 32 + lane] : 0.f;
  float d2 = lane < 32 ? pin(p, I_LQ2)[l * 32 + lane] * pin(p, I_LK2)[l * 32 + lane] : 0.f;
  const float lam = expf(wave_sum(d1)) - expf(wave_sum(d2)) + lam_init;
  const int hd = lane >> 4, d0 = (lane & 15) * 4;
  const f32x4 gg = *(const f32x4*)(pin(p, I_GNG) + l * 64 + d0);
  const f32x4 dg = *(const f32x4*)(pin(p, I_DNG) + l * 64 + d0) * (1.f - lam_init);
  const int tend = l == 0 ? T : TL;
  for (int t0 = (vb * 4 + wid) * 2; t0 < tend; t0 += nvb * 8) {
    u32x2 o0[2], o1[2], zz[2]; f32x4 gf[2], gb[2];
#pragma unroll
    for (int u = 0; u < 2; ++u) {
      const size_t t = t0 + u;
      o0[u] = *(const u32x2*)(OB + t * 512 + (hd * 2) * 64 + d0);
      o1[u] = *(const u32x2*)(OB + t * 512 + (hd * 2 + 1) * 64 + d0);
      gf[u] = *(const f32x4*)(GO + t * 256 + hd * 64 + d0);
      gb[u] = *(const f32x4*)(GO + (size_t)T * 256 + t * 256 + hd * 64 + d0);
      zz[u] = *(const u32x2*)(PP + t * LDPP + PP_DZ + hd * 64 + d0);
    }
    f32x4 od[2], go[2]; float ssb[2], ssg[2];
#pragma unroll
    for (int u = 0; u < 2; ++u) {
      const f32x4 a = {bflo(o0[u][0]), bfhi(o0[u][0]), bflo(o0[u][1]), bfhi(o0[u][1])};
      const f32x4 b = {bflo(o1[u][0]), bfhi(o1[u][0]), bflo(o1[u][1]), bfhi(o1[u][1])};
      od[u] = a - lam * b; go[u] = gf[u] + gb[u];
      ssb[u] = od[u][0] * od[u][0] + od[u][1] * od[u][1] + od[u][2] * od[u][2] + od[u][3] * od[u][3];
      ssg[u] = go[u][0] * go[u][0] + go[u][1] * go[u][1] + go[u][2] * go[u][2] + go[u][3] * go[u][3];
    }
#pragma unroll
    for (int o = 8; o >= 1; o >>= 1) {
#pragma unroll
      for (int u = 0; u < 2; ++u) { ssb[u] += __shfl_xor(ssb[u], o); ssg[u] += __shfl_xor(ssg[u], o); }
    }
#pragma unroll
    for (int u = 0; u < 2; ++u) {
      const size_t t = t0 + u;
      const f32x4 yb = od[u] * (rsqrtf(ssb[u] * (1.f / 64.f) + 1e-6f)) * dg;
      const f32x4 z = {bflo(zz[u][0]), bfhi(zz[u][0]), bflo(zz[u][1]), bfhi(zz[u][1])};
      const f32x4 sz = {siluf(z[0]), siluf(z[1]), siluf(z[2]), siluf(z[3])};
      const f32x4 yd = go[u] * (rsqrtf(ssg[u] * (1.f / 64.f) + 1e-6f)) * gg * sz;
      u32x2 pb, pd;
      pb[0] = pack2(yb[0], yb[1]); pb[1] = pack2(yb[2], yb[3]);
      pd[0] = pack2(yd[0], yd[1]); pd[1] = pack2(yd[2], yd[3]);
      *(u32x2*)(Y + t * 1024 + 256 + hd * 64 + d0) = pb;
      *(u32x2*)(Y + t * 1024 + 768 + hd * 64 + d0) = pd;
    }
  }
}

constexpr int RLD = 1026;
DEVI void st_norm2_route(const Params& p, int l, int vb, int nvb, char* smem) {
  const int lane = p.tid & 63, wid = p.tid >> 6, i15 = lane & 15, q = lane >> 4;
  float* shh = (float*)smem;
  float* slog = shh + 16 * RLD;
  const float* g = pin(p, I_N2G) + l * 1024;
  const float* wr = pin(p, I_WR) + (size_t)l * 1024 * 64;
  const float bias = pin(p, I_RB)[l * 64 + lane];
  float* WTS = (float*)(p.ws + O_WTS); int* CNT = (int*)(p.ws + O_CNT); int* LIST = (int*)(p.ws + O_LIST);
  const int ntok = l == 0 ? T : TL;
  for (int grp = vb; grp < ntok / 16; grp += nvb) {
    const int tb = grp * 16 + wid * 4;
    const int mv = tok_mv(tb);
    const float* sh = modp(p, l, mv, 3); const float* sc = modp(p, l, mv, 4);
    {
      f32x4 v[4][4]; float ss[4];
#pragma unroll
      for (int u = 0; u < 4; ++u) {
        const f32x4* xr = (const f32x4*)((const float*)(p.ws + O_XA) + (size_t)(tb + u) * 1024);
#pragma unroll
        for (int i = 0; i < 4; ++i) v[u][i] = xr[i * 64 + lane];
      }
#pragma unroll
      for (int u = 0; u < 4; ++u) {
        float a = 0.f;
#pragma unroll
        for (int i = 0; i < 4; ++i) a += v[u][i][0] * v[u][i][0] + v[u][i][1] * v[u][i][1] + v[u][i][2] * v[u][i][2] + v[u][i][3] * v[u][i][3];
        ss[u] = a;
      }
#pragma unroll
      for (int o = 32; o >= 1; o >>= 1) {
#pragma unroll
        for (int u = 0; u < 4; ++u) ss[u] += __shfl_xor(ss[u], o);
      }
#pragma unroll
      for (int i = 0; i < 4; ++i) {
        const int c = i * 256 + lane * 4;
        const f32x4 gg = *(const f32x4*)(g + c), s4 = *(const f32x4*)(sc + c), h4 = *(const f32x4*)(sh + c);
        const f32x4 gs = gg * (1.f + s4);
#pragma unroll
        for (int u = 0; u < 4; ++u) {
          const float rstd = rsqrtf(ss[u] * (1.f / 1024.f) + 1e-6f);
          const f32x4 o = v[u][i] * rstd * gs + h4;
          u32x2 pk; pk[0] = pack2(o[0], o[1]); pk[1] = pack2(o[2], o[3]);
          *(u32x2*)((u16*)(p.ws + O_H) + (size_t)(tb + u) * LDH + c) = pk;
          float* d = shh + (wid * 4 + u) * RLD + c;
          *(f32x2*)d = f32x2{o[0], o[1]}; *(f32x2*)(d + 2) = f32x2{o[2], o[3]};
        }
      }
    }
    __syncthreads();
    {
      f32x4 a0 = fzero4(), a1 = a0;
      const float* ap = shh + i15 * RLD + q;
      const float* bp = wr + (size_t)q * 64 + wid * 16 + i15;
#pragma unroll 1
      for (int kb = 0; kb < 256; kb += 32) {
        float bv[32];
#pragma unroll
        for (int j = 0; j < 32; ++j) bv[j] = bp[(size_t)(4 * (kb + j)) * 64];
#pragma unroll
        for (int j = 0; j < 32; j += 2) {
          a0 = __builtin_amdgcn_mfma_f32_16x16x4f32(ap[4 * (kb + j)], bv[j], a0, 0, 0, 0);
          a1 = __builtin_amdgcn_mfma_f32_16x16x4f32(ap[4 * (kb + j) + 4], bv[j + 1], a1, 0, 0, 0);
        }
      }
#pragma unroll
      for (int r = 0; r < 4; ++r) slog[(4 * q + r) * 64 + wid * 16 + i15] = a0[r] + a1[r];
    }
    __syncthreads();
#pragma unroll 1
    for (int u = 0; u < 4; ++u) {
      const int t = tb + u;
      const float logit = slog[(wid * 4 + u) * 64 + lane];
      const float s = 1.f / (1.f + expf(-logit));
      const float c = s + bias;
      float m1 = c;
      m1 = fmaxf(m1, __shfl_xor(m1, 1)); m1 = fmaxf(m1, __shfl_xor(m1, 2)); m1 = fmaxf(m1, __shfl_xor(m1, 4));
      const unsigned long long bal = __ballot(c == m1);
      const int grpi = lane >> 3;
      const unsigned gm = (unsigned)((bal >> (grpi * 8)) & 0xffull);
      const int first = __ffs(gm) - 1;
      float m2 = ((lane & 7) == first) ? -INFINITY : c;
      m2 = fmaxf(m2, __shfl_xor(m2, 1)); m2 = fmaxf(m2, __shfl_xor(m2, 2)); m2 = fmaxf(m2, __shfl_xor(m2, 4));
      const float gs = m1 + m2;
      int grank = 0;
#pragma unroll
      for (int gg = 0; gg < 8; ++gg) { float o = __shfl(gs, gg * 8); grank += (o > gs || (o == gs && gg < grpi)) ? 1 : 0; }
      const bool gsel = grank < 4;
      const float mc = gsel ? c : -INFINITY;
      int rank = 0;
#pragma unroll
      for (int e = 0; e < 64; ++e) { float o = __shfl(mc, e); rank += (o > mc || (o == mc && e < lane)) ? 1 : 0; }
      const bool sel = gsel && rank < 6;
      const float ssum = wave_sum(sel ? s : 0.f);
      if (sel) {
        const int slot = t * 6 + rank;
        WTS[slot] = s / ssum * 2.5f;
        const int pos = atomicAdd(&CNT[lane], 1);
        LIST[(size_t)lane * T + pos] = slot;
      }
    }
    __syncthreads();
  }
}
DEVI void st_outproj(const Params& p, int l, int vb, int nvb, char* smem) {
  const u16* Y = (const u16*)(p.ws + O_Y); const u16* W = (const u16*)(p.ws + O_WOUTT); float* XA = (float*)(p.ws + O_XA);
  const int nmt = l == 0 ? 132 : 128;
  const int g = vb & 7, nmg = (nmt - g + 7) >> 3;
  for (int i = vb >> 3; i < nmg * 8; i += nvb >> 3) {
    const int m0 = (g + 8 * (i >> 3)) * 128, n0 = (i & 7) * 128;
    gemm128(p.tid, [&](int r) { return Y + (size_t)(m0 + r) * 1024; }, W + (size_t)n0 * LDW, LDW, 1024,
            [&](int r, int c, f32x4 v) {
              const int t = m0 + r; const float* gt = modp(p, l, tok_mv(t), 2) + n0 + c;
              float4* xp = (float4*)(XA + (size_t)t * 1024 + n0 + c);
              const float* xin = l == 0 ? (t < TL ? pin(p, I_X) + (size_t)t * 1024 : pin(p, I_CTX) + (size_t)(t - TL) * 1024) + n0 + c : (const float*)xp;
              float4 x = *(const float4*)xin;
              x.x += gt[0] * v[0]; x.y += gt[1] * v[1]; x.z += gt[2] * v[2]; x.w += gt[3] * v[3]; *xp = x;
              __builtin_amdgcn_sched_barrier(0);
            }, smem);
  }
}

DEVI void grp_tiles(const Params& p, int* tst, int g, int shift, int nshared) {
  __syncthreads();
  if (p.tid < 64) {
    const int* CNT = (const int*)(p.ws + O_CNT);
    const int lane = p.tid;
    int c = 0;
    if (lane < 8) c = (__hip_atomic_load(&CNT[g + 8 * lane], __ATOMIC_RELAXED, __HIP_MEMORY_SCOPE_AGENT) + (1 << shift) - 1) >> shift;
    int incl = c;
#pragma unroll
    for (int o = 1; o < 8; o <<= 1) { int u = __shfl_up(incl, o); if (lane >= o) incl += u; }
    if (lane < 8) tst[lane] = incl - c;
    if (lane == 7) { tst[8] = incl; tst[9] = incl + (nshared - g + 7) / 8; }
  }
  __syncthreads();
}
DEVI void grp_find(const int* tst, int tile, int g, int& e, int& lt) {
  int j = 0;
#pragma unroll
  for (int k = 1; k <= 8; ++k) j += tile >= tst[k] ? 1 : 0;
  if (j < 8) { e = g + 8 * j; lt = tile - tst[j]; } else { e = 64; lt = g + 8 * (tile - tst[8]); }
}
DEVI void st_moe1(const Params& p, int l, int vb, int nvb, char* smem) {
  const int* CNT = (const int*)(p.ws + O_CNT); const int* LIST = (const int*)(p.ws + O_LIST);
  const u16* H = (const u16*)(p.ws + O_H); u16* HB = (u16*)(p.ws + O_HB);
  int* sslot = (int*)(smem + 4 * 128 * GLD * 2);
  int* TST = sslot + 128;
  const int g = vb & 7;
  const int nsh = l == 0 ? T : TL;
  grp_tiles(p, TST, g, 7, nsh / 128);
  const int total = TST[9];
  for (int item = vb >> 3; item < total * 4; item += nvb >> 3) {
    const int tile = item >> 2, n0 = (item & 3) * 128;
    int e, lt; grp_find(TST, tile, g, e, lt);
    const int cnt = e < 64 ? __hip_atomic_load(&CNT[e], __ATOMIC_RELAXED, __HIP_MEMORY_SCOPE_AGENT) : nsh;
    __syncthreads();
    if (p.tid < 128) {
      int i = lt * 128 + p.tid;
      int slot = -1;
      if (i < cnt) slot = e < 64 ? LIST[(size_t)e * T + i] : NSLOT + i;
      sslot[p.tid] = slot;
    }
    __syncthreads();
    gemm128(p.tid, [&](int r) { int sl = sslot[r]; int tk = sl < 0 ? 0 : (sl < NSLOT ? sl / 6 : sl - NSLOT); return H + (size_t)tk * LDH; },
            (const u16*)(p.ws + O_WGUT) + ((size_t)e * 512 + n0) * LDW, LDW, 1024,
            [&](int r, int c, f32x4 v) {
              int sl = sslot[r]; if (sl < 0) return;
              float h0 = siluf(v[0]) * v[1], h1 = siluf(v[2]) * v[3];
              *(unsigned*)(HB + (size_t)sl * 256 + ((n0 + c) >> 1)) = pack2(h0, h1);
            }, smem);
  }
}
DEVI void st_moe2(const Params& p, int l, int vb, int nvb, char* smem) {
  const int* CNT = (const int*)(p.ws + O_CNT); const int* LIST = (const int*)(p.ws + O_LIST);
  const u16* HB = (const u16*)(p.ws + O_HB); u16* SO = (u16*)(p.ws + O_SLOT); const float* WTS = (const float*)(p.ws + O_WTS);
  constexpr int ALD = 264;
  u16* sA = (u16*)smem;
  u16* sB = sA + 64 * ALD;
  int* sslot = (int*)(sB + 2 * 128 * 72);
  int* TST = sslot + 64;
  const int tid = p.tid, lane = tid & 63, wid = tid >> 6, wr = wid >> 1, wc = wid & 1, fr = lane & 15, fq = lane >> 4;
  const int g = vb & 7;
  const int nsh = l == 0 ? T : TL;
  grp_tiles(p, TST, g, 6, nsh / 64);
  const int total = TST[9];
  for (int item = vb >> 3; item < total; item += nvb >> 3) {
    int e, lt; grp_find(TST, item, g, e, lt);
    const int cnt = e < 64 ? __hip_atomic_load(&CNT[e], __ATOMIC_RELAXED, __HIP_MEMORY_SCOPE_AGENT) : nsh;
    __syncthreads();
    if (tid < 64) { const int i = lt * 64 + tid; sslot[tid] = i < cnt ? (e < 64 ? LIST[(size_t)e * T + i] : NSLOT + i) : -1; }
    __syncthreads();
    const u16* Bbase = (const u16*)(p.ws + O_WDT) + (size_t)e * 1024 * 256;
    u32x4 rb0[4], rb1[4], rb2[4];
    const u16* bthr = Bbase + (size_t)(tid >> 3) * 256 + (tid & 7) * 8;
    auto gloadB = [&](u32x4 (&rb)[4], int bt) {
      int off = (bt >> 2) * 128 * 256 + (bt & 3) * 64;
      asm volatile("" : "+s"(off));
      const u16* src = bthr + off;
#pragma unroll
      for (int i = 0; i < 4; ++i) rb[i] = *(const u32x4*)(src + i * 32 * 256);
    };
    auto lstoreB = [&](const u32x4 (&rb)[4], int buf) {
      u16* d = sB + buf * 128 * 72;
#pragma unroll
      for (int i = 0; i < 4; ++i) { const int q = tid + 256 * i, r = q >> 3, cc = q & 7; *(u32x4*)&d[r * 72 + cc * 8] = rb[i]; }
    };
    gloadB(rb0, 0); gloadB(rb1, 1); gloadB(rb2, 2);
#pragma unroll
    for (int hf = 0; hf < 2; ++hf) {
      u32x4 ra[4];
#pragma unroll
      for (int i = 0; i < 4; ++i) { const int q = tid + 256 * (4 * hf + i), r = q >> 5, cc = q & 31; const int sl = sslot[r]; ra[i] = *(const u32x4*)(HB + (size_t)(sl < 0 ? 0 : sl) * 256 + cc * 8); }
#pragma unroll
      for (int i = 0; i < 4; ++i) { const int q = tid + 256 * (4 * hf + i), r = q >> 5, cc = q & 31; *(u32x4*)&sA[r * ALD + cc * 8] = ra[i]; }
      __builtin_amdgcn_sched_barrier(0);
    }
    int slot_m[2]; float w_m[2];
#pragma unroll
    for (int m = 0; m < 2; ++m) { const int sl = sslot[wr * 32 + m * 16 + fr]; slot_m[m] = sl; w_m[m] = (sl >= 0 && sl < NSLOT) ? WTS[sl] : 1.f; }
    lstoreB(rb0, 0); gloadB(rb0, 3);
    __syncthreads();
    f32x4 acc[2][4];
    auto compute = [&](int bt, int buf) {
      const int nt = bt >> 2, kt = bt & 3;
      const u16* b = sB + buf * 128 * 72;
      if (kt == 0) {
#pragma unroll
        for (int m = 0; m < 2; ++m)
#pragma unroll
          for (int n = 0; n < 4; ++n) acc[m][n] = fzero4();
      }
#pragma unroll
      for (int ks = 0; ks < 2; ++ks) {
        bf16x8 af[2], bfr[4];
#pragma unroll
        for (int m = 0; m < 2; ++m) af[m] = *(const bf16x8*)&sA[(wr * 32 + m * 16 + fr) * ALD + kt * 64 + ks * 32 + fq * 8];
#pragma unroll
        for (int n = 0; n < 4; ++n) bfr[n] = *(const bf16x8*)&b[(wc * 64 + n * 16 + fr) * 72 + ks * 32 + fq * 8];
#pragma unroll
        for (int m = 0; m < 2; ++m)
#pragma unroll
          for (int n = 0; n < 4; ++n) acc[m][n] = MFMA16(bfr[n], af[m], acc[m][n]);
      }
      if (kt == 3) {
#pragma unroll
        for (int m = 0; m < 2; ++m) {
          if (slot_m[m] >= 0) {
            const float w = w_m[m];
#pragma unroll
            for (int n = 0; n < 4; ++n) {
              u32x2 pk; pk[0] = pack2(acc[m][n][0] * w, acc[m][n][1] * w); pk[1] = pack2(acc[m][n][2] * w, acc[m][n][3] * w);
              *(u32x2*)(SO + (size_t)slot_m[m] * 1024 + nt * 128 + wc * 64 + n * 16 + fq * 4) = pk;
            }
          }
        }
      }
    };
#pragma unroll
    for (int bt = 0; bt < 30; bt += 3) {
      compute(bt, bt & 1);           lstoreB(rb1, (bt + 1) & 1); if (bt + 4 < 32) gloadB(rb1, bt + 4); __syncthreads(); __builtin_amdgcn_sched_barrier(0);
      compute(bt + 1, (bt + 1) & 1); lstoreB(rb2, (bt + 2) & 1); if (bt + 5 < 32) gloadB(rb2, bt + 5); __syncthreads(); __builtin_amdgcn_sched_barrier(0);
      compute(bt + 2, (bt + 2) & 1); lstoreB(rb0, (bt + 3) & 1); if (bt + 6 < 32) gloadB(rb0, bt + 6); __syncthreads(); __builtin_amdgcn_sched_barrier(0);
    }
    compute(30, 0); lstoreB(rb1, 1); __syncthreads(); __builtin_amdgcn_sched_barrier(0);
    compute(31, 1); __syncthreads();
  }
}

DEVI void st_combine(const Params& p, int l, int vb, int nvb) {
  const int lane = p.tid & 63, wid = p.tid >> 6;
  const u16* SO = (const u16*)(p.ws + O_SLOT);
  const bool last = l == 1;
  const float* gnext = last ? pin(p, I_FNG) : pin(p, I_N1G) + 1024;
  const int tend = last ? TL : T;
  for (int t0 = (vb * 4 + wid) * 2; t0 < tend; t0 += nvb * 8) {
    const int mv = tok_mv(t0);
    const float* g5 = modp(p, l, mv, 5);
    u32x4 sv[2][7][2]; f32x4 xv[2][4];
#pragma unroll
    for (int u = 0; u < 2; ++u) {
      const int t = t0 + u;
#pragma unroll
      for (int k = 0; k < 7; ++k) {
        const u16* row = SO + (size_t)(k < 6 ? t * 6 + k : NSLOT + t) * 1024;
        sv[u][k][0] = *(const u32x4*)(row + lane * 8); sv[u][k][1] = *(const u32x4*)(row + 512 + lane * 8);
      }
      const float* xr = (const float*)(p.ws + O_XA) + (size_t)t * 1024;
      xv[u][0] = *(const f32x4*)(xr + lane * 8); xv[u][1] = *(const f32x4*)(xr + lane * 8 + 4);
      xv[u][2] = *(const f32x4*)(xr + 512 + lane * 8); xv[u][3] = *(const f32x4*)(xr + 512 + lane * 8 + 4);
    }
    f32x4 gq[4];
    gq[0] = *(const f32x4*)(g5 + lane * 8); gq[1] = *(const f32x4*)(g5 + lane * 8 + 4);
    gq[2] = *(const f32x4*)(g5 + 512 + lane * 8); gq[3] = *(const f32x4*)(g5 + 512 + lane * 8 + 4);
    float ss[2];
#pragma unroll
    for (int u = 0; u < 2; ++u) {
      float acc = 0.f;
#pragma unroll
      for (int hf = 0; hf < 2; ++hf) {
        f32x4 a0 = fzero4(), a1 = a0;
#pragma unroll
        for (int k = 0; k < 7; ++k) {
          const u32x4 v = sv[u][k][hf];
          a0[0] += bflo(v[0]); a0[1] += bfhi(v[0]); a0[2] += bflo(v[1]); a0[3] += bfhi(v[1]);
          a1[0] += bflo(v[2]); a1[1] += bfhi(v[2]); a1[2] += bflo(v[3]); a1[3] += bfhi(v[3]);
        }
        xv[u][2 * hf] += gq[2 * hf] * a0; xv[u][2 * hf + 1] += gq[2 * hf + 1] * a1;
#pragma unroll
        for (int e = 0; e < 4; ++e) acc += xv[u][2 * hf][e] * xv[u][2 * hf][e] + xv[u][2 * hf + 1][e] * xv[u][2 * hf + 1][e];
      }
      ss[u] = acc;
    }
#pragma unroll
    for (int o = 32; o >= 1; o >>= 1) { ss[0] += __shfl_xor(ss[0], o); ss[1] += __shfl_xor(ss[1], o); }
    f32x4 gn[4];
    gn[0] = *(const f32x4*)(gnext + lane * 8); gn[1] = *(const f32x4*)(gnext + lane * 8 + 4);
    gn[2] = *(const f32x4*)(gnext + 512 + lane * 8); gn[3] = *(const f32x4*)(gnext + 512 + lane * 8 + 4);
    if (!last) {
      const float* sh = modp(p, 1, mv, 0); const float* sc = modp(p, 1, mv, 1);
#pragma unroll
      for (int q = 0; q < 4; ++q) {
        const int c = (q >> 1) * 512 + lane * 8 + (q & 1) * 4;
        const f32x4 s4 = *(const f32x4*)(sc + c), h4 = *(const f32x4*)(sh + c);
        const f32x4 gs = gn[q] * (1.f + s4);
#pragma unroll
        for (int u = 0; u < 2; ++u) {
          const size_t t = t0 + u;
          const float rstd = rsqrtf(ss[u] * (1.f / 1024.f) + 1e-6f);
          *(f32x4*)((float*)(p.ws + O_XA) + t * 1024 + c) = xv[u][q];
          const f32x4 o = xv[u][q] * rstd * gs + h4;
          u32x2 pk; pk[0] = pack2(o[0], o[1]); pk[1] = pack2(o[2], o[3]);
          *(u32x2*)((u16*)(p.ws + O_H) + t * LDH + c) = pk;
        }
      }
    } else {
#pragma unroll
      for (int q = 0; q < 4; ++q) {
        const int c = (q >> 1) * 512 + lane * 8 + (q & 1) * 4;
#pragma unroll
        for (int u = 0; u < 2; ++u) {
          const size_t t = t0 + u;
          const float rstd = rsqrtf(ss[u] * (1.f / 1024.f) + 1e-6f);
          *(f32x4*)(p.out + t * 1024 + c) = xv[u][q] * rstd * gn[q];
        }
      }
    }
  }
}


#define STAGE(call) { const Params p = mkctx(a); call; }

#define XB_TMO      128
#define XB_XCNT(j)  (256  + 64 * (j))
#define XB_XSUB(j)  (1280 + 64 * (j))
#define XB_XGEN(j)  (2304 + 64 * (j))
#define XB_TOP      3328
#define XB_TOPGEN   3392
#define XCD_BAR_WORDS 3456
#define XB_SPIN_CAP (1u << 20)
#define LAS __attribute__((address_space(3)))
DEVI unsigned xb_ld(unsigned* p)              { return __hip_atomic_load(p, __ATOMIC_RELAXED, __HIP_MEMORY_SCOPE_AGENT); }
DEVI unsigned xb_add(unsigned* p, unsigned v) { return __hip_atomic_fetch_add(p, v, __ATOMIC_RELAXED, __HIP_MEMORY_SCOPE_AGENT); }
DEVI unsigned xb_xcc_id() { return (unsigned)__builtin_amdgcn_s_getreg((3 << 11) | 20) & 0xFu; }
#define XB_SPIN(cond, bar) do { unsigned _sp = 0; while (cond) { __builtin_amdgcn_s_sleep(1); \
    if ((++_sp & 255u) == 0u) { if (xb_ld(&(bar)[XB_TMO])) break; if (_sp > XB_SPIN_CAP) { atomicAdd(&(bar)[XB_TMO], 1u); break; } } } } while (0)
struct XcdBarrier { unsigned* bar; unsigned x; volatile LAS unsigned* st; };
DEVI XcdBarrier xcd_barrier_post(unsigned* bar, volatile LAS unsigned* st) {
  XcdBarrier b; b.bar = bar; b.x = xb_xcc_id(); b.st = st;
  if (threadIdx.x == 0) (void)xb_add(&bar[XB_XCNT(b.x)], 1u);
  return b;
}
DEVI void xcd_barrier_complete(unsigned* bar, unsigned x, unsigned& nloc, unsigned& nx) {
  const unsigned G = gridDim.x * gridDim.y * gridDim.z;
  unsigned sum, cnt, mine, sp = 0u;
  for (;;) {
    sum = 0u; cnt = 0u; mine = 0u;
#pragma unroll
    for (unsigned j = 0; j < 16; ++j) { const unsigned c = xb_ld(&bar[XB_XCNT(j)]); sum += c; cnt += (c > 0u) ? 1u : 0u; mine = (j == x) ? c : mine; }
    if (sum == G) break;
    __builtin_amdgcn_s_sleep(1);
    if ((++sp & 255u) == 0u) { if (xb_ld(&bar[XB_TMO])) break; if (sp > XB_SPIN_CAP) { atomicAdd(&bar[XB_TMO], 1u); break; } }
  }
  nloc = mine > 0u ? mine : 1u; nx = cnt > 0u ? cnt : 1u;
}
DEVI void xcd_barrier(const XcdBarrier& b) {
  asm volatile("s_waitcnt vmcnt(0)" ::: "memory");
  __syncthreads();
  if (threadIdx.x == 0) {
    unsigned* bar = b.bar;
    __builtin_amdgcn_s_waitcnt(0);
    unsigned nloc = b.st[0], nx = b.st[1];
    if (nloc == 0u) { xcd_barrier_complete(bar, b.x, nloc, nx); b.st[0] = nloc; b.st[1] = nx; }
    const unsigned old = xb_add(&bar[XB_XSUB(b.x)], 1u);
    const unsigned gen = old / nloc;
    if (old + 1u == (gen + 1u) * nloc) {
      __builtin_amdgcn_fence(__ATOMIC_RELEASE, "agent");
      asm volatile("s_waitcnt vmcnt(0)" ::: "memory");
      const unsigned og = xb_add(&bar[XB_TOP], 1u);
      const unsigned tg = og / nx;
      if (og + 1u == (tg + 1u) * nx) xb_add(&bar[XB_TOPGEN], 1u);
      else XB_SPIN(xb_ld(&bar[XB_TOPGEN]) == tg, bar);
      __builtin_amdgcn_fence(__ATOMIC_ACQUIRE, "agent");
      xb_add(&bar[XB_XGEN(b.x)], 1u);
      asm volatile("s_waitcnt vmcnt(0)" ::: "memory");
    } else {
      XB_SPIN(xb_ld(&bar[XB_XGEN(b.x)]) == gen, bar);
      __builtin_amdgcn_fence(__ATOMIC_ACQUIRE, "agent");
      asm volatile("s_waitcnt vmcnt(0)" ::: "memory");
    }
  }
  __syncthreads();
}
#define GSYNC() { XcdBarrier xb_; xb_.bar = (unsigned*)(mkctx(a).ws + O_XBAR); xb_.x = xb_xcc_id(); xb_.st = (volatile LAS unsigned*)(smem + SMEM_BYTES - 32); xcd_barrier(xb_); }

__global__ void __launch_bounds__(256, 2) mega(KArgs a) {
  extern __shared__ __attribute__((aligned(16))) char smem[];
  cg::grid_group grid = cg::this_grid();
  const int vb = blockIdx.x, nvb = gridDim.x;
  volatile LAS unsigned* xst = (volatile LAS unsigned*)(smem + SMEM_BYTES - 32);
  if (threadIdx.x == 0) { xst[0] = 0u; xst[1] = 0u; }
  __syncthreads();
  (void)xcd_barrier_post((unsigned*)(a.ws + O_XBAR), xst);
  if (threadIdx.x == 0) {
    const float** tab = (const float**)(a.ws + O_TAB);
#pragma unroll
    for (int i = 0; i < 35; ++i) tab[i] = a.in[i];
  }
  __syncthreads();
  STAGE(st_rope_table(p, vb, nvb));
  STAGE(st_mod(p, vb, nvb, smem));
  STAGE(st_prep_w1(p, 0, vb, nvb, smem));
  grid.sync();
  for (int l = 0; l < 2; ++l) {
    if (l == 0) { STAGE(st_norm1(p, 0, vb, nvb)); GSYNC(); }
    {
      const int g = vb & 7;
      for (int i = vb >> 3; i < 363; i += nvb >> 3) {
        int mt, nt;
        if (i < 264) { mt = i >> 1; nt = g + 8 * (i & 1); }
        else { const int j = i - 264, pc = g + 8 * (j / 33); nt = 16 + (pc >> 2); mt = (pc & 3) * 33 + (j % 33); }
        const Params p = mkctx(a); inproj_item(p, mt * 22 + nt, smem);
      }
    }
    GSYNC();
    STAGE(st_tokprep(p, l, vb, nvb));
    GSYNC();
    {
      for (int item = vb; item < 132 * 7 + NGITEM; item += nvb) {
        const Params p = mkctx(a);
        if (item < 132 * 7) mla_up_tile(p, item / 7, item % 7, smem);
        else gdn_chunk_item(p, item - 132 * 7, smem);
      }
    }
    GSYNC();
    st_mixer_queue(a, l, smem);
    GSYNC();
    STAGE(st_mix_finish(p, l, vb, nvb));
    GSYNC();
    STAGE(st_outproj(p, l, vb, nvb, smem));
    GSYNC();
    STAGE(st_norm2_route(p, l, vb, nvb, smem));
    GSYNC();
    STAGE(st_moe1(p, l, vb, nvb, smem));
    GSYNC();
    STAGE(st_moe2(p, l, vb, nvb, smem));
    GSYNC();
    if (l == 0) STAGE(st_prep_w1(p, 1, vb, nvb, smem));
    STAGE(st_combine(p, l, vb, nvb));
    if (l == 0) GSYNC();
  }
}

extern "C" void kernel_launch(void* const* d_in, const int* in_sizes, int n_in, void* d_out, int out_size, void* d_ws, size_t ws_size,
                              hipStream_t stream) {
  static int grid_blocks = 0;
  if (!grid_blocks) {
    int dev = 0, cus = 0, per_cu = 0;
    (void)hipGetDevice(&dev);
    (void)hipDeviceGetAttribute(&cus, hipDeviceAttributeMultiprocessorCount, dev);
    (void)hipFuncSetAttribute((const void*)mega, hipFuncAttributeMaxDynamicSharedMemorySize, SMEM_BYTES);
    (void)hipOccupancyMaxActiveBlocksPerMultiprocessor(&per_cu, mega, 256, SMEM_BYTES);
    if (per_cu > 2) per_cu = 2;
    if (per_cu < 1) per_cu = 1;
    grid_blocks = cus * per_cu;
  }
  KArgs p{};
  for (int i = 0; i < 35; ++i) p.in[i] = (const float*)d_in[i];
  p.out = (float*)d_out; p.ws = (char*)d_ws;
  if (ws_size < WS_NEED) { fprintf(stderr, "workspace too small: %zu < %zu\n", ws_size, (size_t)WS_NEED); return; }
  (void)hipMemsetAsync((char*)d_ws + O_BAR, 0, 256 + 16384, stream);
  void* args[] = {&p};
  hipError_t e = hipLaunchCooperativeKernel((void*)mega, dim3(grid_blocks), dim3(256), args, SMEM_BYTES, stream);
  if (e != hipSuccess) fprintf(stderr, "cooperative launch failed: %s (grid %d)\n", hipGetErrorString(e), grid_blocks);
}
```

```cpp
#include <hip/hip_runtime.h>
#include <hip/hip_cooperative_groups.h>
#include <cstdio>
#include <cstdint>
namespace cg = cooperative_groups;

#define DEVI __device__ __forceinline__
typedef unsigned short u16;
using bf16x8 = __attribute__((ext_vector_type(8))) short;
using f32x4  = __attribute__((ext_vector_type(4))) float;
using f32x2  = __attribute__((ext_vector_type(2))) float;
using f32x16 = __attribute__((ext_vector_type(16))) float;
using u32x4 = __attribute__((ext_vector_type(4))) unsigned;
using u32x2 = __attribute__((ext_vector_type(2))) unsigned;
typedef __bf16 bf16x2_t __attribute__((ext_vector_type(2)));

constexpr int DM = 1024, SEQ = 8192, CTXL = 256, NKEY = SEQ + CTXL;
constexpr int TL = 2 * SEQ, TC = 2 * CTXL, T = TL + TC;
constexpr int INW = 2672;
constexpr int NIN = 2816;
constexpr int LDPP = 1408;
constexpr int PP_CQ = 0, PP_CKV = 192, PP_DQKV = 320, PP_DZ = 1088, PP_GATE = 1344;
constexpr int NE = 64, NSLOT = 6 * T;
constexpr int LDW = 1088;
constexpr int LDH = 1088;
constexpr int NCHUNK = T / 64;
constexpr int NGITEM = NCHUNK * 8;
constexpr float LOG2E = 1.4426950408889634f;

constexpr size_t al256(size_t x) { return (x + 255) & ~(size_t)255; }
constexpr size_t O_MOD   = 0;
constexpr size_t O_ROPE  = O_MOD + al256((size_t)2 * 3 * 6144 * 4);
constexpr size_t O_XA    = O_ROPE + (size_t)SEQ * 48 * 8;
constexpr size_t O_H     = O_XA + (size_t)T * DM * 4;
constexpr size_t O_WINT  = O_H + (size_t)T * LDH * 2;
constexpr size_t O_WOUTT = O_WINT + (size_t)NIN * LDW * 2;
constexpr size_t O_WUQT  = O_WOUTT + (size_t)1024 * LDW * 2;
constexpr size_t O_WUKVT = O_WUQT + (size_t)384 * 192 * 2;
constexpr size_t O_WGUT  = O_WUKVT + (size_t)512 * 128 * 2;
constexpr size_t O_WDT   = O_WGUT + (size_t)65 * 512 * LDW * 2;
constexpr size_t O_WTS   = O_WDT + (size_t)65 * 1024 * 256 * 2;
constexpr size_t O_CNT   = O_WTS + al256((size_t)NSLOT * 4);
constexpr size_t O_TAB   = O_CNT + 256;
constexpr size_t O_BAR   = O_TAB + 512;
constexpr size_t O_XBAR  = O_BAR + 256;
constexpr size_t O_LIST  = O_XBAR + 16384;
constexpr size_t O_R     = O_LIST + (size_t)NE * T * 4;
constexpr size_t O_Y     = O_R;
constexpr size_t O_PP    = O_Y + (size_t)T * DM * 2;
constexpr size_t O_QA    = O_PP + (size_t)T * LDPP * 2;
constexpr size_t O_KA    = O_QA + (size_t)2 * 4 * NKEY * 64 * 2;
constexpr size_t O_VTA   = O_KA + (size_t)2 * 2 * NKEY * 64 * 2;
constexpr size_t O_QB    = O_VTA + (size_t)2 * 2 * NKEY * 64 * 2;
constexpr size_t O_KB    = O_QB + (size_t)2 * 8 * NKEY * 32 * 2;
constexpr size_t O_VTB   = O_KB + (size_t)2 * 8 * NKEY * 32 * 2;
constexpr size_t O_QC    = O_VTB + (size_t)2 * 4 * NKEY * 64 * 2;
constexpr size_t O_KC    = O_QC + (size_t)2 * 4 * NKEY * 96 * 2;
constexpr size_t O_VTC   = O_KC + (size_t)2 * 4 * NKEY * 96 * 2;
constexpr size_t O_CQN   = O_VTC + (size_t)2 * 4 * NKEY * 64 * 2;
constexpr size_t O_CKVN  = O_CQN + (size_t)T * 192 * 2;
constexpr size_t O_OB    = O_CKVN + (size_t)T * 128 * 2;
constexpr size_t O_GQ    = O_OB + (size_t)T * 512 * 2;
constexpr size_t O_GK    = O_GQ + (size_t)T * 256 * 2;
constexpr size_t O_GV    = O_GK + (size_t)T * 256 * 2;
constexpr size_t O_GG    = O_GV + (size_t)T * 256 * 2;
constexpr size_t O_GBETA = O_GG + (size_t)2 * T * 4 * 4;
constexpr size_t O_GM    = O_GBETA + (size_t)2 * T * 4 * 4;
constexpr size_t O_GQP   = O_GM + (size_t)NGITEM * 4096 * 2;
constexpr size_t O_GN    = O_GQP + (size_t)NGITEM * 4096 * 2;
constexpr size_t O_GLO   = O_GN + (size_t)NGITEM * 4096 * 2;
constexpr size_t O_GO    = O_GLO + (size_t)NGITEM * 4096 * 2;
constexpr size_t O_MIX_END = O_GO + (size_t)2 * T * 256 * 4;
constexpr size_t O_HB    = O_R;
constexpr size_t O_SLOT  = O_HB + (size_t)7 * T * 256 * 2;
constexpr size_t O_MOE_END = O_SLOT + (size_t)7 * T * 1024 * 2;
constexpr size_t cmax(size_t a, size_t b) { return a > b ? a : b; }
constexpr size_t WS_NEED = cmax(O_MIX_END, O_MOE_END);
static_assert(WS_NEED < (size_t)556000000, "workspace too large");

struct KArgs {
  const float* in[35];
  float* out;
  char* ws;
};
typedef const __attribute__((address_space(1))) float gcfloat;
struct Params {
  char* ws;
  float* out;
  gcfloat* const* in;
  int tid;
};
#define pin(p, i) ((const float*)(p).in[i])
enum { I_X = 0, I_C, I_CTX, I_CCTX, I_WADA, I_BADA, I_N1G, I_N2G, I_WIN, I_WOUT, I_SINK, I_LQ1, I_LK1, I_LQ2, I_LK2,
       I_DNG, I_MQG, I_MKVG, I_WUQ, I_WUKV, I_CONVW, I_ALF, I_ALB, I_DTF, I_DTB, I_GNG, I_WR, I_RB, I_WG, I_WU, I_WD,
       I_SG, I_SU, I_SD, I_FNG };

DEVI u16 f2bf(float f) { unsigned u = __float_as_uint(f); u += 0x7fffu + ((u >> 16) & 1u); return (u16)(u >> 16); }
DEVI float bf2f(u16 h) { return __uint_as_float(((unsigned)h) << 16); }
DEVI float bflo(unsigned v) { return __uint_as_float(v << 16); }
DEVI float bfhi(unsigned v) { return __uint_as_float(v & 0xffff0000u); }
DEVI unsigned pack2(float a, float b) { f32x2 v = {a, b}; return __builtin_bit_cast(unsigned, __builtin_convertvector(v, bf16x2_t)); }
DEVI f32x4 fzero4() { float z = 0.f; asm volatile("" : "+v"(z)); return f32x4{z, z, z, z}; }
DEVI float wave_sum(float v) {
#pragma unroll
  for (int o = 32; o >= 1; o >>= 1) v += __shfl_xor(v, o);
  return v;
}
DEVI float half_sum(float v) {
#pragma unroll
  for (int o = 16; o >= 1; o >>= 1) v += __shfl_xor(v, o);
  return v;
}
DEVI float siluf(float x) { return x / (1.f + __expf(-x)); }
DEVI float sigmf(float x) { return 1.f / (1.f + __expf(-x)); }
DEVI int tok_mv(int t) { return t < TL ? (t >> 13) : 2; }
DEVI int tok_b(int t) { return t < TL ? (t >> 13) : ((t - TL) >> 8); }
DEVI int tok_row(int t) { return t < TL ? (t & (SEQ - 1)) : (SEQ + ((t - TL) & (CTXL - 1))); }
DEVI const float* modp(const Params& p, int l, int mv, int j) { return (const float*)(p.ws + O_MOD) + ((size_t)(l * 3 + mv) * 6 + j) * 1024; }

#define MFMA16(a, b, c) __builtin_amdgcn_mfma_f32_16x16x32_bf16((a), (b), (c), 0, 0, 0)
#define MFMA32(a, b, c) __builtin_amdgcn_mfma_f32_32x32x16_bf16((a), (b), (c), 0, 0, 0)

DEVI void st_copy_in(const Params& p, int vb, int nvb) {
  float4* xa = (float4*)(p.ws + O_XA);
  const float4* x = (const float4*)pin(p, I_X);
  const float4* cx = (const float4*)pin(p, I_CTX);
  const size_t n4 = (size_t)T * DM / 4, nl4 = (size_t)TL * DM / 4;
  for (size_t i = (size_t)vb * 256 + p.tid; i < n4; i += (size_t)nvb * 256) xa[i] = i < nl4 ? x[i] : cx[i - nl4];
}
DEVI void rope_cs(int i, int half, int s, float& c, float& sn) {
  const int quarter = half >> 1;
  const int ii = i < quarter ? i : i - quarter;
  const float pos = i < quarter ? (float)(s >> 6) : (float)(s & 63);
  const float inv = powf(10000.f, -(float)ii / (float)quarter);
  const float ang = pos * inv;
  c = cosf(ang); sn = sinf(ang);
}
DEVI void st_rope_table(const Params& p, int vb, int nvb) {
  f32x2* R = (f32x2*)(p.ws + O_ROPE);
  for (int e = vb * 256 + p.tid; e < SEQ * 48; e += nvb * 256) {
    const int s = e / 48, i = e % 48;
    float c, sn;
    if (i < 32) rope_cs(i, 32, s, c, sn); else rope_cs(i - 32, 16, s, c, sn);
    R[e] = f32x2{c, sn};
  }
}
DEVI void st_mod(const Params& p, int vb, int nvb, char* smem) {
  float* sv = (float*)smem;
  float* red = sv + 3 * 1024;
  for (int i = p.tid; i < 3 * 1024; i += 256) {
    int v = i >> 10, k = i & 1023;
    float c = v < 2 ? pin(p, I_C)[v * 1024 + k] : pin(p, I_CCTX)[k];
    sv[i] = siluf(c);
  }
  __syncthreads();
  const int cgp = p.tid & 7, kg = p.tid >> 3;
  for (int item = vb; item < 2 * 192; item += nvb) {
    const int l = item / 192, c0 = (item % 192) * 32;
    const float* w = pin(p, I_WADA) + (size_t)l * 1024 * 6144 + c0 + cgp * 4;
    f32x4 a0 = fzero4(), a1 = a0, a2 = a0;
#pragma unroll 8
    for (int kk = 0; kk < 32; ++kk) {
      const int k = kg * 32 + kk;
      const f32x4 wv = *(const f32x4*)(w + (size_t)k * 6144);
      a0 += sv[k] * wv; a1 += sv[1024 + k] * wv; a2 += sv[2048 + k] * wv;
    }
    float* rp = red + (kg * 8 + cgp) * 12;
    *(f32x4*)rp = a0; *(f32x4*)(rp + 4) = a1; *(f32x4*)(rp + 8) = a2;
    __syncthreads();
    if (p.tid < 96) {
      const int v = p.tid >> 5, c = p.tid & 31;
      float s = 0.f;
#pragma unroll 8
      for (int g = 0; g < 32; ++g) s += red[(g * 8 + (c >> 2)) * 12 + v * 4 + (c & 3)];
      ((float*)(p.ws + O_MOD))[(size_t)(l * 3 + v) * 6144 + c0 + c] = s + pin(p, I_BADA)[l * 6144 + c0 + c];
    }
    __syncthreads();
  }
}

template <class RowFn>
DEVI void tr_tile(int tid, const float* __restrict__ src, int N, u16* __restrict__ dst, int ldd, RowFn drow, int k0, int n0, float* tile) {
  {
    const int kq = tid >> 4, n4 = (tid & 15) * 4;
    f32x4 v[4];
#pragma unroll
    for (int r = 0; r < 4; ++r) {
      const int k = r * 16 + kq;
      v[r] = n0 + n4 < N ? *(const f32x4*)(src + (size_t)(k0 + k) * N + n0 + n4) : fzero4();
    }
#pragma unroll
    for (int r = 0; r < 4; ++r) {
      const int k = r * 16 + kq;
      tile[k * 65 + n4] = v[r][0]; tile[k * 65 + n4 + 1] = v[r][1]; tile[k * 65 + n4 + 2] = v[r][2]; tile[k * 65 + n4 + 3] = v[r][3];
    }
  }
  __syncthreads();
  {
    const int n = tid >> 2, kc = (tid & 3) * 16;
    const int dr = drow(n0 + n);
    if (dr >= 0) {
      u32x4 o0, o1;
#pragma unroll
      for (int e = 0; e < 4; ++e) {
        o0[e] = pack2(tile[(kc + 2 * e) * 65 + n], tile[(kc + 2 * e + 1) * 65 + n]);
        o1[e] = pack2(tile[(kc + 8 + 2 * e) * 65 + n], tile[(kc + 8 + 2 * e + 1) * 65 + n]);
      }
      u16* d = dst + (size_t)dr * ldd + k0 + kc;
      *(u32x4*)d = o0; *(u32x4*)(d + 8) = o1;
    }
  }
  __syncthreads();
}
DEVI int win_row(int n) {
  if (n < 1280) return n;
  if (n < 1600) return 1408 + (n - 1280);
  if (n < 1632) return 1280 + (n - 1600);
  if (n < INW) return 1408 + 320 + (n - 1632);
  return -1;
}
constexpr int TR_IN = 16 * 42, TR_OUT = 256, TR_UQ = 18, TR_UKV = 16, TR_E = 4096, TR_S = 64;
constexpr int TR_P1 = TR_IN + TR_OUT + TR_UQ + TR_UKV;
constexpr int TR_P2 = 3 * TR_E + 3 * TR_S;
DEVI void prep_w1_tile(const Params& p, int l, int it, float* tile) {
  if (it < TR_IN) { tr_tile(p.tid, pin(p, I_WIN) + (size_t)l * 1024 * INW, INW, (u16*)(p.ws + O_WINT), LDW, [](int n) { return win_row(n); }, (it / 42) * 64, (it % 42) * 64, tile); return; }
  it -= TR_IN;
  if (it < TR_OUT) { tr_tile(p.tid, pin(p, I_WOUT) + (size_t)l * 1024 * 1024, 1024, (u16*)(p.ws + O_WOUTT), LDW, [](int n) { return n; }, (it / 16) * 64, (it % 16) * 64, tile); return; }
  it -= TR_OUT;
  if (it < TR_UQ) { tr_tile(p.tid, pin(p, I_WUQ) + (size_t)l * 192 * 384, 384, (u16*)(p.ws + O_WUQT), 192, [](int n) { return n; }, (it / 6) * 64, (it % 6) * 64, tile); return; }
  it -= TR_UQ;
  tr_tile(p.tid, pin(p, I_WUKV) + (size_t)l * 128 * 512, 512, (u16*)(p.ws + O_WUKVT), 128,
          [](int n) { const int h = n >> 7, j = n & 127; return j < 64 ? h * 64 + j : 256 + h * 64 + (j - 64); }, (it / 8) * 64, (it % 8) * 64, tile);
}
DEVI void prep_w2_tile(const Params& p, int l, int it, float* tile) {
  if (it < 2 * TR_E) {
    const int which = it / TR_E; it %= TR_E;
    const int e = it >> 6, tt = it & 63;
    const float* src = pin(p, which ? I_WU : I_WG) + ((size_t)l * NE + e) * 1024 * 256;
    tr_tile(p.tid, src, 256, (u16*)(p.ws + O_WGUT) + (size_t)e * 512 * LDW, LDW, [which](int n) { return 2 * n + which; }, (tt >> 2) * 64, (tt & 3) * 64, tile); return;
  }
  it -= 2 * TR_E;
  if (it < TR_E) {
    const int e = it >> 6, tt = it & 63;
    const float* src = pin(p, I_WD) + ((size_t)l * NE + e) * 256 * 1024;
    tr_tile(p.tid, src, 1024, (u16*)(p.ws + O_WDT) + (size_t)e * 1024 * 256, 256, [](int n) { return n; }, (tt >> 4) * 64, (tt & 15) * 64, tile); return;
  }
  it -= TR_E;
  if (it < 2 * TR_S) {
    const int which = it / TR_S; const int tt = it % TR_S;
    const float* src = pin(p, which ? I_SU : I_SG) + (size_t)l * 1024 * 256;
    tr_tile(p.tid, src, 256, (u16*)(p.ws + O_WGUT) + (size_t)64 * 512 * LDW, LDW, [which](int n) { return 2 * n + which; }, (tt >> 2) * 64, (tt & 3) * 64, tile); return;
  }
  it -= 2 * TR_S;
  { const int tt = it;
    const float* src = pin(p, I_SD) + (size_t)l * 256 * 1024;
    tr_tile(p.tid, src, 1024, (u16*)(p.ws + O_WDT) + (size_t)64 * 1024 * 256, 256, [](int n) { return n; }, (tt >> 4) * 64, (tt & 15) * 64, tile); }
}
DEVI void st_prep_w1(const Params& p, int l, int vb, int nvb, char* smem) {
  float* tile = (float*)smem;
  if (vb == 0 && p.tid < 64) ((int*)(p.ws + O_CNT))[p.tid] = 0;
  for (int e = vb * 256 + p.tid; e < 144 * 128; e += nvb * 256) {
    const int r = e >> 7, c8 = e & 127;
    const int row = r < 96 ? 1312 + r : 2768 + (r - 96);
    *(u32x4*)((u16*)(p.ws + O_WINT) + (size_t)row * LDW + c8 * 8) = __builtin_bit_cast(u32x4, fzero4());
  }
  for (int item = vb; item < TR_P1; item += nvb) prep_w1_tile(p, l, item, tile);
}

DEVI void st_norm1(const Params& p, int l, int vb, int nvb) {
  const int lane = p.tid & 63, wid = p.tid >> 6;
  const float* g = pin(p, I_N1G) + l * 1024;
  for (int t4 = (vb * 4 + wid) * 4; t4 < T; t4 += nvb * 16) {
    const int mv = tok_mv(t4);
    const float* sh = modp(p, l, mv, 0); const float* sc = modp(p, l, mv, 1);
    f32x4 v[4][4]; float ss[4];
#pragma unroll
    for (int u = 0; u < 4; ++u) {
      const int t = t4 + u;
      const f32x4* xr = (const f32x4*)(t < TL ? pin(p, I_X) + (size_t)t * 1024 : pin(p, I_CTX) + (size_t)(t - TL) * 1024);
#pragma unroll
      for (int i = 0; i < 4; ++i) v[u][i] = xr[i * 64 + lane];
    }
#pragma unroll
    for (int u = 0; u < 4; ++u) {
      float a = 0.f;
#pragma unroll
      for (int i = 0; i < 4; ++i) a += v[u][i][0] * v[u][i][0] + v[u][i][1] * v[u][i][1] + v[u][i][2] * v[u][i][2] + v[u][i][3] * v[u][i][3];
      ss[u] = a;
    }
#pragma unroll
    for (int o = 32; o >= 1; o >>= 1) {
#pragma unroll
      for (int u = 0; u < 4; ++u) ss[u] += __shfl_xor(ss[u], o);
    }
#pragma unroll
    for (int i = 0; i < 4; ++i) {
      const int c = i * 256 + lane * 4;
      const f32x4 gg = *(const f32x4*)(g + c), s4 = *(const f32x4*)(sc + c), h4 = *(const f32x4*)(sh + c);
      const f32x4 gs = gg * (1.f + s4);
#pragma unroll
      for (int u = 0; u < 4; ++u) {
        const float rstd = rsqrtf(ss[u] * (1.f / 1024.f) + 1e-6f);
        const f32x4 o = v[u][i] * rstd * gs + h4;
        u32x2 pk; pk[0] = pack2(o[0], o[1]); pk[1] = pack2(o[2], o[3]);
        *(u32x2*)((u16*)(p.ws + O_H) + (size_t)(t4 + u) * LDH + c) = pk;
      }
    }
  }
}

constexpr int GLD = 72;
typedef const __attribute__((address_space(1))) unsigned gcu32;
typedef __attribute__((address_space(3))) unsigned lu32;
template <bool SWAP, class ARow>
DEVI void gemm_core(int tid, ARow arow, const u16* __restrict__ Bt, int ldb, int K, f32x4 (&acc)[4][4], char* smem) {
  constexpr int TILE = 128 * 64;
  u16* sbuf = (u16*)smem;
  const int lane = tid & 63, wid = tid >> 6, wr = wid >> 1, wc = wid & 1, fr = lane & 15, fq = lane >> 4;
  const u16* ap[4]; const u16* bp[4];
#pragma unroll
  for (int i = 0; i < 4; ++i) {
    const int q = tid + 256 * i, row = q >> 3, cs = (q & 7) ^ (row & 7);
    ap[i] = arow(row) + cs * 8; bp[i] = Bt + (size_t)row * ldb + cs * 8;
  }
  const int nk = K >> 6;
  auto stage = [&](int kt, int buf) {
    int off = kt * 64; asm volatile("" : "+s"(off));
    u16* dA = sbuf + buf * 2 * TILE + tid * 8; u16* dB = dA + TILE;
#pragma unroll
    for (int i = 0; i < 4; ++i) {
      __builtin_amdgcn_global_load_lds((gcu32*)(ap[i] + off), (lu32*)(dA + i * 2048), 16, 0, 0);
      __builtin_amdgcn_global_load_lds((gcu32*)(bp[i] + off), (lu32*)(dB + i * 2048), 16, 0, 0);
    }
  };
  auto compute = [&](int buf) {
    const u16* sA = sbuf + buf * 2 * TILE; const u16* sB = sA + TILE;
#pragma unroll
    for (int ks = 0; ks < 2; ++ks) {
      bf16x8 af[4], bfr[4];
#pragma unroll
      for (int m = 0; m < 4; ++m) { const int R = wr * 64 + m * 16 + fr; af[m] = *(const bf16x8*)&sA[R * 64 + (((ks * 4 + fq) ^ (R & 7)) << 3)]; }
#pragma unroll
      for (int n = 0; n < 4; ++n) { const int R = wc * 64 + n * 16 + fr; bfr[n] = *(const bf16x8*)&sB[R * 64 + (((ks * 4 + fq) ^ (R & 7)) << 3)]; }
#pragma unroll
      for (int m = 0; m < 4; ++m)
#pragma unroll
        for (int n = 0; n < 4; ++n) acc[m][n] = SWAP ? MFMA16(af[m], bfr[n], acc[m][n]) : MFMA16(bfr[n], af[m], acc[m][n]);
    }
  };
#pragma unroll
  for (int m = 0; m < 4; ++m)
#pragma unroll
    for (int n = 0; n < 4; ++n) acc[m][n] = fzero4();
  __syncthreads();
  stage(0, 0);
  asm volatile("s_waitcnt vmcnt(0)" ::: "memory");
  __syncthreads();
  for (int kt = 0; kt < nk; ++kt) {
    if (kt + 1 < nk) stage(kt + 1, (kt + 1) & 1);
    compute(kt & 1);
    asm volatile("s_waitcnt vmcnt(0)" ::: "memory");
    __syncthreads();
  }
}
template <class ARow, class Epi>
DEVI void gemm128(int tid, ARow arow, const u16* __restrict__ Bt, int ldb, int K, Epi epi, char* smem) {
  f32x4 acc[4][4];
  gemm_core<false>(tid, arow, Bt, ldb, K, acc, smem);
  const int lane = tid & 63, wid = tid >> 6, wr = wid >> 1, wc = wid & 1, fr = lane & 15, fq = lane >> 4;
#pragma unroll
  for (int m = 0; m < 4; ++m)
#pragma unroll
    for (int n = 0; n < 4; ++n) epi(wr * 64 + m * 16 + fr, wc * 64 + n * 16 + fq * 4, acc[m][n]);
}

DEVI void rope4(const f32x4 x1, const f32x4 x2, const f32x2* rp, bool lat, float scale, u32x2& o1, u32x2& o2) {
  f32x4 s = fzero4(), c = s + 1.f;
  if (lat) {
    const f32x4 a = *(const f32x4*)rp, b = *(const f32x4*)(rp + 2);
    c = f32x4{a[0], a[2], b[0], b[2]}; s = f32x4{a[1], a[3], b[1], b[3]};
  }
  const f32x4 y1 = (x1 * c - x2 * s) * scale, y2 = (x2 * c + x1 * s) * scale;
  o1[0] = pack2(y1[0], y1[1]); o1[1] = pack2(y1[2], y1[3]);
  o2[0] = pack2(y2[0], y2[1]); o2[1] = pack2(y2[2], y2[3]);
}
DEVI void inproj_item(const Params& p, int item, char* smem) {
  const u16* H = (const u16*)(p.ws + O_H); const u16* W = (const u16*)(p.ws + O_WINT);
  const f32x2* ROPE = (const f32x2*)(p.ws + O_ROPE);
  const int tid = p.tid, lane = tid & 63, wid = tid >> 6, wr = wid >> 1, wc = wid & 1, fr = lane & 15, fq = lane >> 4;
  {
    const int m0 = (item / 22) * 128, nt = item % 22;
    const bool lat = m0 < TL;
    const int b = tok_b(m0), rowbase = tok_row(m0);
    f32x4 acc[4][4];
    auto arow = [&](int r) { return H + (size_t)(m0 + r) * LDH; };
    if (nt == 3 || nt == 8 || nt == 9) {
      gemm_core<true>(tid, arow, W + (size_t)nt * 128 * LDW, LDW, 1024, acc, smem);
      u16* vt = nt == 3 ? (u16*)(p.ws + O_VTA) + (size_t)(b * 2 + wc) * 64 * NKEY
                        : (u16*)(p.ws + O_VTB) + (size_t)(b * 4 + (nt - 8) * 2 + wc) * 64 * NKEY;
#pragma unroll
      for (int m = 0; m < 4; ++m)
#pragma unroll
        for (int n = 0; n < 4; ++n) {
          u32x2 pk; pk[0] = pack2(acc[m][n][0], acc[m][n][1]); pk[1] = pack2(acc[m][n][2], acc[m][n][3]);
          *(u32x2*)(vt + (size_t)(n * 16 + fr) * NKEY + rowbase + wr * 64 + m * 16 + (((fq & 1) << 1) | (fq >> 1)) * 4) = pk;
        }
      return;
    }
    gemm_core<false>(tid, arow, W + (size_t)nt * 128 * LDW, LDW, 1024, acc, smem);
    if (nt < 3) {
      u16* dst; float scale;
      if (nt < 2) { dst = (u16*)(p.ws + O_QA) + ((size_t)(b * 4 + nt * 2 + wc) * NKEY + rowbase) * 64; scale = 0.125f * LOG2E; }
      else { dst = (u16*)(p.ws + O_KA) + ((size_t)(b * 2 + wc) * NKEY + rowbase) * 64; scale = 1.f; }
#pragma unroll
      for (int m = 0; m < 4; ++m) {
        const int rl = wr * 64 + m * 16 + fr;
#pragma unroll
        for (int pi = 0; pi < 2; ++pi) {
          const int d0 = pi * 16 + fq * 4;
          u32x2 o1, o2;
          rope4(acc[m][pi], acc[m][pi + 2], ROPE + (size_t)(rowbase + rl) * 48 + d0, lat, scale, o1, o2);
          *(u32x2*)(dst + (size_t)rl * 64 + d0) = o1; *(u32x2*)(dst + (size_t)rl * 64 + 32 + d0) = o2;
        }
      }
    } else if (nt < 8) {
      const bool isq = nt < 6;
      u16* base = isq ? (u16*)(p.ws + O_QB) : (u16*)(p.ws + O_KB);
      const float scale = isq ? 0.17677669529663687f * LOG2E : 1.f;
      const int hm0 = ((nt - 4) & 1) * 4 + wc * 2;
#pragma unroll
      for (int m = 0; m < 4; ++m) {
        const int rl = wr * 64 + m * 16 + fr;
#pragma unroll
        for (int g = 0; g < 2; ++g) {
          u16* dst = base + ((size_t)(b * 8 + hm0 + g) * NKEY + rowbase + rl) * 32;
          u32x2 o1, o2;
          rope4(acc[m][2 * g], acc[m][2 * g + 1], ROPE + (size_t)(rowbase + rl) * 48 + 32 + fq * 4, lat, scale, o1, o2);
          *(u32x2*)(dst + fq * 4) = o1; *(u32x2*)(dst + 16 + fq * 4) = o2;
        }
      }
    } else if (nt == 10) {
      if (wc == 0) {
#pragma unroll
        for (int m = 0; m < 4; ++m) {
          const int rl = wr * 64 + m * 16 + fr;
          u32x2 o1, o2;
          rope4(acc[m][0], acc[m][1], ROPE + (size_t)(rowbase + rl) * 48 + 32 + fq * 4, lat, 1.f, o1, o2);
#pragma unroll
          for (int h = 0; h < 4; ++h) {
            u16* dst = (u16*)(p.ws + O_KC) + ((size_t)(b * 4 + h) * NKEY + rowbase + rl) * 96 + 64;
            *(u32x2*)(dst + fq * 4) = o1; *(u32x2*)(dst + 16 + fq * 4) = o2;
          }
        }
      }
    } else {
      u16* PP = (u16*)(p.ws + O_PP);
#pragma unroll
      for (int m = 0; m < 4; ++m)
#pragma unroll
        for (int n = 0; n < 4; ++n) {
          u32x2 pk; pk[0] = pack2(acc[m][n][0], acc[m][n][1]); pk[1] = pack2(acc[m][n][2], acc[m][n][3]);
          *(u32x2*)(PP + (size_t)(m0 + wr * 64 + m * 16 + fr) * LDPP + (nt - 11) * 128 + wc * 64 + n * 16 + fq * 4) = pk;
        }
    }
  }
}

DEVI void st_tokprep(const Params& p, int l, int vb, int nvb) {
  const int lane = p.tid & 63, wid = p.tid >> 6;
  const u16* PP = (const u16*)(p.ws + O_PP);
  u16* GQ = (u16*)(p.ws + O_GQ); u16* GK = (u16*)(p.ws + O_GK); u16* GV = (u16*)(p.ws + O_GV);
  float* GG = (float*)(p.ws + O_GG); float* GB = (float*)(p.ws + O_GBETA);
  u16* CQN = (u16*)(p.ws + O_CQN); u16* CKVN = (u16*)(p.ws + O_CKVN);
  const float* cwp = pin(p, I_CONVW) + (size_t)l * 5 * 768;
  f32x2 cw[6][5];
#pragma unroll
  for (int i = 0; i < 6; ++i)
#pragma unroll
    for (int j = 0; j < 5; ++j) cw[i][j] = *(const f32x2*)(cwp + j * 768 + 2 * lane + 128 * i);
  const float* gq = pin(p, I_MQG) + l * 192; const float* gkv = pin(p, I_MKVG) + l * 128;
  const float gq0 = gq[lane], gq1 = gq[64 + lane], gq2 = gq[128 + lane], gk0 = gkv[lane], gk1 = gkv[64 + lane];
  for (int t = vb * 4 + wid; t < T; t += nvb * 4) {
    int base, pos, len;
    if (t < TL) { base = t & ~(SEQ - 1); pos = t & (SEQ - 1); len = SEQ; } else { int j = t - TL; base = TL + (j & ~(CTXL - 1)); pos = j & (CTXL - 1); len = CTXL; }
    unsigned xin[5][6];
#pragma unroll
    for (int j = 0; j < 5; ++j) {
      const int pp = pos + j - 2;
      const bool ok = pp >= 0 && pp < len;
      const u16* row = PP + (size_t)(base + (ok ? pp : pos)) * LDPP + PP_DQKV + 2 * lane;
#pragma unroll
      for (int i = 0; i < 6; ++i) { unsigned v = *(const unsigned*)(row + 128 * i); xin[j][i] = ok ? v : 0u; }
    }
    const u16* pr = PP + (size_t)t * LDPP;
    const float q0 = bf2f(pr[PP_CQ + lane]), q1 = bf2f(pr[PP_CQ + 64 + lane]), q2 = bf2f(pr[PP_CQ + 128 + lane]);
    const float k0 = bf2f(pr[PP_CKV + lane]), k1 = bf2f(pr[PP_CKV + 64 + lane]);
    const float gate_in = lane < 16 ? bf2f(pr[PP_GATE + lane]) : 0.f;
#pragma unroll
    for (int i = 0; i < 6; ++i) {
      float a0 = 0.f, a1 = 0.f;
#pragma unroll
      for (int j = 0; j < 5; ++j) { a0 += cw[i][j][0] * bflo(xin[j][i]); a1 += cw[i][j][1] * bfhi(xin[j][i]); }
      float y0 = siluf(a0), y1 = siluf(a1);
      const int c = 2 * lane + 128 * i;
      if (i < 4) {
        const float ss = half_sum(y0 * y0 + y1 * y1);
        const float r = rsqrtf(ss + 1e-6f) * (i < 2 ? 0.125f : 1.f);
        u16* dst = i < 2 ? GQ + (size_t)t * 256 + c : GK + (size_t)t * 256 + (c - 256);
        *(unsigned*)dst = pack2(y0 * r, y1 * r);
      } else *(unsigned*)(GV + (size_t)t * 256 + (c - 512)) = pack2(y0, y1);
    }
    if (lane < 16) {
      const int which = lane >> 2, hd = lane & 3;
      if (which < 2) {
        const float al = which ? pin(p, I_ALB)[l * 4 + hd] : pin(p, I_ALF)[l * 4 + hd];
        const float dt = which ? pin(p, I_DTB)[l * 4 + hd] : pin(p, I_DTF)[l * 4 + hd];
        const float xx = gate_in + dt;
        const float sp = fmaxf(xx, 0.f) + log1pf(expf(-fabsf(xx)));
        GG[((size_t)which * T + t) * 4 + hd] = -expf(al) * sp;
      } else GB[((size_t)(which - 2) * T + t) * 4 + hd] = sigmf(gate_in);
    }
    {
      float ss = q0 * q0 + q1 * q1 + q2 * q2, s2 = k0 * k0 + k1 * k1;
#pragma unroll
      for (int o = 32; o >= 1; o >>= 1) { ss += __shfl_xor(ss, o); s2 += __shfl_xor(s2, o); }
      const float rs = rsqrtf(ss * (1.f / 192.f) + 1e-6f), r2 = rsqrtf(s2 * (1.f / 128.f) + 1e-6f);
      u16* d = CQN + (size_t)t * 192;
      d[lane] = f2bf(q0 * rs * gq0); d[64 + lane] = f2bf(q1 * rs * gq1); d[128 + lane] = f2bf(q2 * rs * gq2);
      u16* d2 = CKVN + (size_t)t * 128;
      d2[lane] = f2bf(k0 * r2 * gk0); d2[64 + lane] = f2bf(k1 * r2 * gk1);
    }
  }
}

DEVI void mla_up_tile(const Params& p, int mt, int nn, char* smem) {
  const int tid = p.tid, lane = tid & 63, wid = tid >> 6, wr = wid >> 1, wc = wid & 1, fr = lane & 15, fq = lane >> 4;
  const int m0 = mt * 128;
  const bool lat = m0 < TL;
  const int b = tok_b(m0), rowbase = tok_row(m0);
  f32x4 acc[4][4];
  if (nn < 3) {
    const u16* CQN = (const u16*)(p.ws + O_CQN);
    gemm_core<false>(tid, [&](int r) { return CQN + (size_t)(m0 + r) * 192; }, (const u16*)(p.ws + O_WUQT) + (size_t)nn * 128 * 192, 192, 192, acc, smem);
    const f32x2* ROPE = (const f32x2*)(p.ws + O_ROPE);
    const float scale = 0.10206207261596577f * LOG2E;
    u16* QC = (u16*)(p.ws + O_QC);
#pragma unroll
    for (int m = 0; m < 4; ++m) {
      const int rl = wr * 64 + m * 16 + fr;
#pragma unroll
      for (int n = 0; n < 4; ++n) {
        const int cb = nn * 128 + wc * 64 + n * 16;
        const int h = cb / 96, db = cb - h * 96;
        u16* dst = QC + ((size_t)(b * 4 + h) * NKEY + rowbase + rl) * 96;
        if (db < 64) {
          u32x2 pk; pk[0] = pack2(acc[m][n][0] * scale, acc[m][n][1] * scale); pk[1] = pack2(acc[m][n][2] * scale, acc[m][n][3] * scale);
          *(u32x2*)(dst + db + fq * 4) = pk;
        } else if (db == 64 && n < 3) {
          u32x2 o1, o2;
          rope4(acc[m][n], acc[m][n + 1], ROPE + (size_t)(rowbase + rl) * 48 + 32 + fq * 4, lat, scale, o1, o2);
          *(u32x2*)(dst + 64 + fq * 4) = o1; *(u32x2*)(dst + 80 + fq * 4) = o2;
        }
      }
    }
  } else {
    const u16* CKVN = (const u16*)(p.ws + O_CKVN);
    auto arow = [&](int r) { return CKVN + (size_t)(m0 + r) * 128; };
    const u16* Wt = (const u16*)(p.ws + O_WUKVT) + (size_t)(nn - 3) * 128 * 128;
    if (nn < 5) {
      gemm_core<false>(tid, arow, Wt, 128, 128, acc, smem);
      u16* KC = (u16*)(p.ws + O_KC) + ((size_t)(b * 4 + (nn - 3) * 2 + wc) * NKEY + rowbase) * 96;
#pragma unroll
      for (int m = 0; m < 4; ++m)
#pragma unroll
        for (int n = 0; n < 4; ++n) {
          u32x2 pk; pk[0] = pack2(acc[m][n][0], acc[m][n][1]); pk[1] = pack2(acc[m][n][2], acc[m][n][3]);
          *(u32x2*)(KC + (size_t)(wr * 64 + m * 16 + fr) * 96 + n * 16 + fq * 4) = pk;
        }
    } else {
      gemm_core<true>(tid, arow, Wt, 128, 128, acc, smem);
      u16* vt = (u16*)(p.ws + O_VTC) + (size_t)(b * 4 + (nn - 5) * 2 + wc) * 64 * NKEY;
#pragma unroll
      for (int m = 0; m < 4; ++m)
#pragma unroll
        for (int n = 0; n < 4; ++n) {
          u32x2 pk; pk[0] = pack2(acc[m][n][0], acc[m][n][1]); pk[1] = pack2(acc[m][n][2], acc[m][n][3]);
          *(u32x2*)(vt + (size_t)(n * 16 + fr) * NKEY + rowbase + wr * 64 + m * 16 + (((fq & 1) << 1) | (fq >> 1)) * 4) = pk;
        }
    }
  }
}
DEVI int permcol(int x) { return (x & 32) + 8 * ((x >> 2) & 3) + 4 * ((x >> 4) & 1) + (x & 3); }
DEVI int cidx(int d, int e) { return ((((e >> 4) * 4 + (d >> 4)) * 64) + (e & 15) + 16 * ((d >> 2) & 3)) * 4 + (d & 3); }
DEVI int gdn_chunk_t0(int ci) { return ci < 256 ? (ci >> 7) * SEQ + (ci & 127) * 64 : TL + ((ci - 256) >> 2) * CTXL + ((ci - 256) & 3) * 64; }

DEVI void gdn_chunk_item(const Params& p, int item, char* smem) {
  u16* sK = (u16*)smem;
  float* sA = (float*)(smem + 9216);
  u16* sXt = (u16*)smem;
  u16* sAt = (u16*)(smem + 26624);
  u16* sKt = (u16*)(smem + 35840);
  float* sX = (float*)(smem + 45056);
  float* sgc = (float*)(smem + 77824); float* sbeta = sgc + 64; float* seg = sbeta + 64; float* skd = seg + 64;
  const u16* GQ = (const u16*)(p.ws + O_GQ); const u16* GK = (const u16*)(p.ws + O_GK); const u16* GV = (const u16*)(p.ws + O_GV);
  const float* GG = (const float*)(p.ws + O_GG); const float* GB = (const float*)(p.ws + O_GBETA);
  u16* GM = (u16*)(p.ws + O_GM); u16* GQP = (u16*)(p.ws + O_GQP); u16* GN = (u16*)(p.ws + O_GN); u16* GLO = (u16*)(p.ws + O_GLO);
  const int tid = p.tid, lane = tid & 63, w = tid >> 6, i15 = lane & 15, q = lane >> 4;
  {
    const int ci = item >> 3, hd = (item >> 1) & 3, dir = item & 1;
    const int t0 = gdn_chunk_t0(ci);
    auto tok = [&](int i) { return dir ? t0 + 63 - i : t0 + i; };
    __syncthreads();
    if (tid < 64) {
      float g = GG[((size_t)dir * T + tok(tid)) * 4 + hd];
#pragma unroll
      for (int o = 1; o < 64; o <<= 1) { float u = __shfl_up(g, o); if (lane >= o) g += u; }
      const float gl = __shfl(g, 63);
      sgc[tid] = g; sbeta[tid] = GB[((size_t)dir * T + tok(tid)) * 4 + hd]; seg[tid] = expf(g); skd[tid] = expf(gl - g);
    }
    __syncthreads();
    const float eglast = seg[63];
#pragma unroll
    for (int i = 0; i < 2; ++i) {
      const int ch = tid + 256 * i, j = ch >> 3, cc = ch & 7;
      const u32x4 kv = *(const u32x4*)(GK + (size_t)tok(j) * 256 + hd * 64 + cc * 8);
      *(u32x4*)&sK[j * 72 + cc * 8] = kv;
      const float kd = skd[j];
#pragma unroll
      for (int e = 0; e < 4; ++e) {
        sKt[(cc * 8 + 2 * e) * 72 + j] = f2bf(bf2f((u16)(kv[e] & 0xffff)) * kd);
        sKt[(cc * 8 + 2 * e + 1) * 72 + j] = f2bf(bf2f((u16)(kv[e] >> 16)) * kd);
      }
    }
#pragma unroll
    for (int i = 0; i < 2; ++i) {
      const int ch = tid + 256 * i, j = ch >> 3, cc = ch & 7;
      const u32x4 vv = *(const u32x4*)(GV + (size_t)tok(j) * 256 + hd * 64 + cc * 8);
      const float bj = sbeta[j];
      float* d = sX + j * 128 + cc * 8;
#pragma unroll
      for (int e = 0; e < 4; ++e) { d[2 * e] = bflo(vv[e]) * bj; d[2 * e + 1] = bfhi(vv[e]) * bj; }
    }
    __syncthreads();
    for (int e = tid; e < 64 * 64; e += 256) {
      const int j = e >> 6, c = e & 63;
      sX[j * 128 + 64 + c] = bf2f(sK[j * 72 + c]) * sbeta[j] * seg[j];
    }
    {
      f32x4 kk[4], qk[4];
#pragma unroll
      for (int nt = 0; nt < 4; ++nt) { kk[nt] = fzero4(); qk[nt] = fzero4(); }
#pragma unroll
      for (int ks = 0; ks < 2; ++ks) {
        const bf16x8 ak = *(const bf16x8*)&sK[(16 * w + i15) * 72 + ks * 32 + q * 8];
        const bf16x8 aq = *(const bf16x8*)(GQ + (size_t)tok(16 * w + i15) * 256 + hd * 64 + ks * 32 + q * 8);
#pragma unroll
        for (int nt = 0; nt < 4; ++nt) {
          const bf16x8 bk = *(const bf16x8*)&sK[(16 * nt + i15) * 72 + ks * 32 + q * 8];
          kk[nt] = MFMA16(ak, bk, kk[nt]); qk[nt] = MFMA16(aq, bk, qk[nt]);
        }
      }
#pragma unroll
      for (int nt = 0; nt < 4; ++nt)
#pragma unroll
        for (int r = 0; r < 4; ++r) {
          const int i = 16 * w + 4 * q + r, j = 16 * nt + i15;
          const float dec = i >= j ? expf(sgc[i] - sgc[j]) : 0.f;
          sA[i * 68 + j] = i > j ? sbeta[i] * kk[nt][r] * dec : 0.f;
          sAt[i * 72 + j] = f2bf(i >= j ? qk[nt][r] * dec : 0.f);
        }
    }
    __syncthreads();
    if (tid < 128) {
      const int c = tid;
      for (int ib = 0; ib < 16; ++ib) {
        float a0 = sX[(4 * ib) * 128 + c], a1 = sX[(4 * ib + 1) * 128 + c], a2 = sX[(4 * ib + 2) * 128 + c], a3 = sX[(4 * ib + 3) * 128 + c];
#pragma unroll 4
        for (int g = 0; g < ib; ++g) {
          const float x0 = sX[(4 * g) * 128 + c], x1 = sX[(4 * g + 1) * 128 + c], x2 = sX[(4 * g + 2) * 128 + c], x3 = sX[(4 * g + 3) * 128 + c];
          const f32x4 r0 = *(const f32x4*)&sA[(4 * ib) * 68 + 4 * g], r1 = *(const f32x4*)&sA[(4 * ib + 1) * 68 + 4 * g];
          const f32x4 r2 = *(const f32x4*)&sA[(4 * ib + 2) * 68 + 4 * g], r3 = *(const f32x4*)&sA[(4 * ib + 3) * 68 + 4 * g];
          a0 -= r0[0] * x0 + r0[1] * x1 + r0[2] * x2 + r0[3] * x3;
          a1 -= r1[0] * x0 + r1[1] * x1 + r1[2] * x2 + r1[3] * x3;
          a2 -= r2[0] * x0 + r2[1] * x1 + r2[2] * x2 + r2[3] * x3;
          a3 -= r3[0] * x0 + r3[1] * x1 + r3[2] * x2 + r3[3] * x3;
        }
        const f32x4 d1 = *(const f32x4*)&sA[(4 * ib + 1) * 68 + 4 * ib], d2 = *(const f32x4*)&sA[(4 * ib + 2) * 68 + 4 * ib], d3 = *(const f32x4*)&sA[(4 * ib + 3) * 68 + 4 * ib];
        a1 -= d1[0] * a0;
        a2 -= d2[0] * a0 + d2[1] * a1;
        a3 -= d3[0] * a0 + d3[1] * a1 + d3[2] * a2;
        sX[(4 * ib) * 128 + c] = a0; sX[(4 * ib + 1) * 128 + c] = a1; sX[(4 * ib + 2) * 128 + c] = a2; sX[(4 * ib + 3) * 128 + c] = a3;
      }
    }
    __syncthreads();
    {
      const int c = tid & 127, jh = (tid >> 7) * 32;
#pragma unroll
      for (int g = 0; g < 4; ++g) {
        u32x4 pk;
#pragma unroll
        for (int e = 0; e < 4; ++e) pk[e] = pack2(sX[(jh + 8 * g + 2 * e) * 128 + c], sX[(jh + 8 * g + 2 * e + 1) * 128 + c]);
        *(u32x4*)&sXt[c * 72 + jh + 8 * g] = pk;
      }
    }
    __syncthreads();
    {
      f32x4 r1[8], r2[8];
#pragma unroll
      for (int ct = 0; ct < 8; ++ct) { r1[ct] = fzero4(); r2[ct] = fzero4(); }
#pragma unroll
      for (int ks = 0; ks < 2; ++ks) {
        const bf16x8 aa = *(const bf16x8*)&sAt[(16 * w + i15) * 72 + ks * 32 + q * 8];
        const bf16x8 ak = *(const bf16x8*)&sKt[(16 * w + i15) * 72 + ks * 32 + q * 8];
#pragma unroll
        for (int ct = 0; ct < 8; ++ct) {
          const bf16x8 bx = *(const bf16x8*)&sXt[(16 * ct + i15) * 72 + ks * 32 + q * 8];
          r1[ct] = MFMA16(aa, bx, r1[ct]); r2[ct] = MFMA16(ak, bx, r2[ct]);
        }
      }
      const size_t ib = (size_t)item * 4096;
#pragma unroll
      for (int ct = 0; ct < 4; ++ct) {
        u32x2 a, b;
        a[0] = pack2(r1[ct][0], r1[ct][1]); a[1] = pack2(r1[ct][2], r1[ct][3]);
        b[0] = pack2(r2[ct][0], r2[ct][1]); b[1] = pack2(r2[ct][2], r2[ct][3]);
        *(u32x2*)(GLO + ib + ((ct * 4 + w) * 64 + lane) * 4) = a;
        *(u32x2*)(GN + ib + ((ct * 4 + w) * 64 + lane) * 4) = b;
      }
#pragma unroll
      for (int ct = 4; ct < 8; ++ct)
#pragma unroll
        for (int r = 0; r < 4; ++r) {
          const int row = 16 * w + 4 * q + r, col = 16 * (ct - 4) + i15;
          const float qv = bf2f(GQ[(size_t)tok(row) * 256 + hd * 64 + col]);
          GQP[ib + row * 64 + permcol(col)] = f2bf(qv * seg[row] - r1[ct][r]);
          GM[ib + row * 64 + permcol(col)] = f2bf((row == col ? eglast : 0.f) - r2[ct][r]);
        }
    }
    __syncthreads();
  }
}

DEVI void gdn_scan_chain(const Params& p, int chain, char* smem) {
  const int tid = p.tid, lane = tid & 63, w = tid >> 6, i15 = lane & 15, q = lane >> 4;
  u16* sM = (u16*)smem;
  u16* sQ = sM + 2 * 64 * 72;
  const u16* GM = (const u16*)(p.ws + O_GM); const u16* GQP = (const u16*)(p.ws + O_GQP);
  const u16* GN = (const u16*)(p.ws + O_GN); const u16* GLO = (const u16*)(p.ws + O_GLO);
  float* GO = (float*)(p.ws + O_GO);
  {
    const int b = chain >> 3, hd = (chain >> 1) & 3, dir = chain & 1;
    f32x4 S[4];
#pragma unroll
    for (int r = 0; r < 4; ++r) S[r] = fzero4();
    auto item_of = [&](int n) {
      int ci = n < 4 ? 256 + b * 4 + (dir ? 3 - n : n) : b * 128 + (dir ? 127 - (n - 4) : (n - 4));
      return ci * 8 + hd * 2 + dir;
    };
    u32x4 pm[2], pq[2]; u32x2 pn[4], pl[4];
    auto prefetch = [&](int n) {
      const size_t base = (size_t)item_of(n) * 4096;
#pragma unroll
      for (int i = 0; i < 2; ++i) {
        const int ch = tid + 256 * i;
        pm[i] = *(const u32x4*)(GM + base + ch * 8);
        pq[i] = *(const u32x4*)(GQP + base + ch * 8);
      }
#pragma unroll
      for (int rb = 0; rb < 4; ++rb) {
        pn[rb] = *(const u32x2*)(GN + base + ((w * 4 + rb) * 64 + lane) * 4);
        pl[rb] = *(const u32x2*)(GLO + base + ((w * 4 + rb) * 64 + lane) * 4);
      }
    };
    prefetch(0);
    __syncthreads();
    for (int n = 0; n < 132; ++n) {
      const int buf = n & 1;
      u16* bM = sM + buf * 64 * 72; u16* bQ = sQ + buf * 64 * 72;
#pragma unroll
      for (int i = 0; i < 2; ++i) {
        const int ch = tid + 256 * i, row = ch >> 3, cc = ch & 7;
        *(u32x4*)&bM[row * 72 + cc * 8] = pm[i];
        *(u32x4*)&bQ[row * 72 + cc * 8] = pq[i];
      }
      f32x4 accs[4], acco[4];
#pragma unroll
      for (int rb = 0; rb < 4; ++rb) {
        accs[rb] = f32x4{bf2f((u16)(pn[rb][0] & 0xffff)), bf2f((u16)(pn[rb][0] >> 16)), bf2f((u16)(pn[rb][1] & 0xffff)), bf2f((u16)(pn[rb][1] >> 16))};
        acco[rb] = f32x4{bf2f((u16)(pl[rb][0] & 0xffff)), bf2f((u16)(pl[rb][0] >> 16)), bf2f((u16)(pl[rb][1] & 0xffff)), bf2f((u16)(pl[rb][1] >> 16))};
      }
      const int ci = n < 4 ? 256 + b * 4 + (dir ? 3 - n : n) : b * 128 + (dir ? 127 - (n - 4) : (n - 4));
      const int t0 = gdn_chunk_t0(ci);
      __syncthreads();
      if (n + 1 < 132) prefetch(n + 1);
      bf16x8 sb[2];
#pragma unroll
      for (int kb = 0; kb < 2; ++kb)
#pragma unroll
        for (int jj = 0; jj < 8; ++jj) sb[kb][jj] = (short)f2bf(S[2 * kb + (jj >> 2)][jj & 3]);
#pragma unroll
      for (int kb = 0; kb < 2; ++kb)
#pragma unroll
        for (int rb = 0; rb < 4; ++rb) {
          const bf16x8 am = *(const bf16x8*)&bM[(rb * 16 + i15) * 72 + kb * 32 + q * 8];
          const bf16x8 aq = *(const bf16x8*)&bQ[(rb * 16 + i15) * 72 + kb * 32 + q * 8];
          accs[rb] = MFMA16(am, sb[kb], accs[rb]);
          acco[rb] = MFMA16(aq, sb[kb], acco[rb]);
        }
#pragma unroll
      for (int rb = 0; rb < 4; ++rb) {
        S[rb] = accs[rb];
#pragma unroll
        for (int r = 0; r < 4; ++r) {
          const int i = rb * 16 + q * 4 + r;
          const int t = dir ? t0 + 63 - i : t0 + i;
          GO[(size_t)dir * T * 256 + (size_t)t * 256 + hd * 64 + w * 16 + i15] = acco[rb][r];
        }
      }
    }
    __syncthreads();
  }
}


template <int DQK>
DEVI void attn_run(int tid, const u16* __restrict__ Qp, int qrow0, const u16* __restrict__ Kp, const u16* __restrict__ Vtp,
                   int a0, int a1, int b0, int b1, int qpos0, float sink2, f32x16 (&O)[2], char* smem) {
  constexpr int KLD = DQK + 8, NS = DQK / 16, KCH = DQK / 8, NKL = (64 * KCH) / 256;
  constexpr int BUF = 64 * KLD + 64 * 72;
  u16* sbase = (u16*)smem;
  const int lane = tid & 63, wid = tid >> 6, r31 = lane & 31, hh = lane >> 5;
  const int qrow = qrow0 + wid * 32 + r31;
  bf16x8 qf[NS];
#pragma unroll
  for (int s = 0; s < NS; ++s) qf[s] = *(const bf16x8*)(Qp + (size_t)qrow * DQK + s * 16 + hh * 8);
#pragma unroll
  for (int i = 0; i < 16; ++i) { O[0][i] = 0.f; O[1][i] = 0.f; }
  float m = -30000.f, lsum = 0.f;
  const int na = (a1 - a0) >> 6, nt = na + ((b1 - b0) >> 6);
  const int qpos = qpos0 + wid * 32 + r31;
  u32x4 rk[NKL], rv[2];
  auto gload = [&](int ti) {
    const int key0 = ti >= na ? b0 + (ti - na) * 64 : a0 + ti * 64;
#pragma unroll
    for (int i = 0; i < NKL; ++i) { const int q = tid + 256 * i, r = q / KCH, cc = q % KCH; rk[i] = *(const u32x4*)(Kp + (size_t)(key0 + r) * DQK + cc * 8); }
#pragma unroll
    for (int i = 0; i < 2; ++i) { const int q = tid + 256 * i, r = q >> 3, cc = q & 7; rv[i] = *(const u32x4*)(Vtp + (size_t)r * NKEY + key0 + cc * 8); }
  };
  auto lstore = [&](int buf) {
    u16* sK = sbase + buf * BUF; u16* sV = sK + 64 * KLD;
#pragma unroll
    for (int i = 0; i < NKL; ++i) { const int q = tid + 256 * i, r = q / KCH, cc = q % KCH; *(u32x4*)&sK[r * KLD + cc * 8] = rk[i]; }
#pragma unroll
    for (int i = 0; i < 2; ++i) { const int q = tid + 256 * i, r = q >> 3, cc = q & 7; *(u32x4*)&sV[r * 72 + cc * 8] = rv[i]; }
  };
  m = 0.f;
  f32x16 negm;
#pragma unroll
  for (int i = 0; i < 16; ++i) negm[i] = 0.f;
  gload(0);
  __syncthreads();
  lstore(0);
  __syncthreads();
  for (int ti = 0; ti < nt; ++ti) {
    if (ti + 1 < nt) gload(ti + 1);
    const u16* sK = sbase + (ti & 1) * BUF; const u16* sV = sK + 64 * KLD;
    const bool inB = ti >= na;
    const int key0 = inB ? b0 + (ti - na) * 64 : a0 + ti * 64;
    f32x16 st[2];
#pragma unroll
    for (int k2 = 0; k2 < 2; ++k2) {
      {
        const bf16x8 kf = *(const bf16x8*)&sK[(k2 * 32 + r31) * KLD + hh * 8];
        asm volatile("v_mfma_f32_32x32x16_bf16 %0, %1, %2, %3" : "=&v"(st[k2]) : "v"(kf), "v"(qf[0]), "v"(negm));
      }
#pragma unroll
      for (int s = 1; s < NS; ++s) {
        const bf16x8 kf = *(const bf16x8*)&sK[(k2 * 32 + r31) * KLD + s * 16 + hh * 8];
        st[k2] = MFMA32(kf, qf[s], st[k2]);
      }
    }
    if (inB) {
#pragma unroll
      for (int k2 = 0; k2 < 2; ++k2)
#pragma unroll
        for (int g = 0; g < 16; ++g) {
          const int d = key0 + k2 * 32 + (g & 3) + 8 * (g >> 2) + 4 * hh - qpos;
          if (d > 128 || d < -128) st[k2][g] = -1e30f;
        }
    }
    bf16x8 vfr[2][2][2];
#pragma unroll
    for (int k2 = 0; k2 < 2; ++k2)
#pragma unroll
      for (int s2 = 0; s2 < 2; ++s2)
#pragma unroll
        for (int dvt = 0; dvt < 2; ++dvt) vfr[k2][s2][dvt] = *(const bf16x8*)&sV[(dvt * 32 + r31) * 72 + k2 * 32 + s2 * 16 + 8 * hh];
    float mx = st[0][0];
#pragma unroll
    for (int g = 1; g < 16; ++g) mx = fmaxf(mx, st[0][g]);
#pragma unroll
    for (int g = 0; g < 16; ++g) mx = fmaxf(mx, st[1][g]);
    { auto rr = __builtin_amdgcn_permlane32_swap(__float_as_uint(mx), __float_as_uint(mx), false, false);
      mx = fmaxf(__uint_as_float(rr[0]), __uint_as_float(rr[1])); }
    if (ti == 0 || __any(mx > 8.f)) {
      const float delta = ti == 0 ? fmaxf(mx, -1e4f) : fmaxf(mx, 0.f);
      if (ti != 0) {
        const float alpha = __builtin_amdgcn_exp2f(-delta);
        lsum *= alpha;
#pragma unroll
        for (int i = 0; i < 16; ++i) { O[0][i] *= alpha; O[1][i] *= alpha; }
      }
      m += delta;
#pragma unroll
      for (int i = 0; i < 16; ++i) { negm[i] = -m; st[0][i] -= delta; st[1][i] -= delta; }
    }
    f32x2 ps2 = {0.f, 0.f};
#pragma unroll
    for (int k2 = 0; k2 < 2; ++k2)
#pragma unroll
      for (int g = 0; g < 16; g += 2) {
        const float p0 = __builtin_amdgcn_exp2f(st[k2][g]), p1 = __builtin_amdgcn_exp2f(st[k2][g + 1]);
        st[k2][g] = p0; st[k2][g + 1] = p1;
        ps2 += f32x2{p0, p1};
      }
    lsum += ps2[0] + ps2[1];
#pragma unroll
    for (int k2 = 0; k2 < 2; ++k2)
#pragma unroll
      for (int s2 = 0; s2 < 2; ++s2) {
        u32x4 pp;
#pragma unroll
        for (int j = 0; j < 4; ++j) pp[j] = pack2(st[k2][8 * s2 + 2 * j], st[k2][8 * s2 + 2 * j + 1]);
        const bf16x8 pf = __builtin_bit_cast(bf16x8, pp);
#pragma unroll
        for (int dvt = 0; dvt < 2; ++dvt) {
          O[dvt] = MFMA32(vfr[k2][s2][dvt], pf, O[dvt]);
        }
      }
    if (ti + 1 < nt) lstore((ti + 1) & 1);
    __syncthreads();
  }
  if (sink2 > -1e29f) {
    const float mn = fmaxf(m, sink2);
    const float alpha = __builtin_amdgcn_exp2f(m - mn);
    lsum = lsum * alpha + (hh == 0 ? __builtin_amdgcn_exp2f(sink2 - mn) : 0.f);
#pragma unroll
    for (int i = 0; i < 16; ++i) { O[0][i] *= alpha; O[1][i] *= alpha; }
  }
  const float ltot = lsum + __shfl_xor(lsum, 32);
  const float inv = 1.f / ltot;
#pragma unroll
  for (int i = 0; i < 16; ++i) { O[0][i] *= inv; O[1][i] *= inv; }
}
DEVI void attn_store(int tid, const f32x16 (&O)[2], u16* dst, int ld, int b, int qrow0, int col0) {
  const int lane = tid & 63, wid = tid >> 6, r31 = lane & 31, hh = lane >> 5;
  const int qrow = qrow0 + wid * 32 + r31;
  const int t = qrow < SEQ ? b * SEQ + qrow : TL + b * CTXL + (qrow - SEQ);
  u16* yr = dst + (size_t)t * ld + col0;
#pragma unroll
  for (int dvt = 0; dvt < 2; ++dvt)
#pragma unroll
    for (int g4 = 0; g4 < 4; ++g4) {
      u32x2 pk; pk[0] = pack2(O[dvt][g4 * 4 + 0], O[dvt][g4 * 4 + 1]); pk[1] = pack2(O[dvt][g4 * 4 + 2], O[dvt][g4 * 4 + 3]);
      *(u32x2*)(yr + dvt * 32 + 8 * g4 + 4 * hh) = pk;
    }
}
DEVI void attn_item(const Params& p, int l, int mixer, int b, int h, int qb, char* smem) {
  const bool lat = qb < 64;
  const int qrow0 = qb * 128;
  f32x16 O[2];
  if (mixer == 0) {
    attn_run<32>(p.tid, (const u16*)(p.ws + O_QB) + (size_t)(b * 8 + h) * NKEY * 32, qrow0, (const u16*)(p.ws + O_KB) + (size_t)(b * 8 + h) * NKEY * 32,
                 (const u16*)(p.ws + O_VTB) + (size_t)(b * 4 + (h >> 1)) * 64 * NKEY, lat ? 0 : SEQ, NKEY, 0, 0, 0, -1e30f, O, smem);
    attn_store(p.tid, O, (u16*)(p.ws + O_OB), 512, b, qrow0, h * 64);
  } else if (mixer == 1) {
    attn_run<96>(p.tid, (const u16*)(p.ws + O_QC) + (size_t)(b * 4 + h) * NKEY * 96, qrow0, (const u16*)(p.ws + O_KC) + (size_t)(b * 4 + h) * NKEY * 96,
                 (const u16*)(p.ws + O_VTC) + (size_t)(b * 4 + h) * 64 * NKEY, lat ? 0 : SEQ, NKEY, 0, 0, 0, -1e30f, O, smem);
    attn_store(p.tid, O, (u16*)(p.ws + O_Y), 1024, b, qrow0, 512 + h * 64);
  } else {
    const float sink2 = pin(p, I_SINK)[l * 4 + h] * LOG2E;
    const int hk = h >> 1;
    int b0 = 0, b1 = 0;
    if (lat) { b0 = (qb - 1) * 128; if (b0 < 0) b0 = 0; b1 = (qb + 2) * 128; if (b1 > SEQ) b1 = SEQ; }
    attn_run<64>(p.tid, (const u16*)(p.ws + O_QA) + (size_t)(b * 4 + h) * NKEY * 64, qrow0, (const u16*)(p.ws + O_KA) + (size_t)(b * 2 + hk) * NKEY * 64,
                 (const u16*)(p.ws + O_VTA) + (size_t)(b * 2 + hk) * 64 * NKEY, SEQ, NKEY, b0, b1, qrow0, sink2, O, smem);
    attn_store(p.tid, O, (u16*)(p.ws + O_Y), 1024, b, qrow0, h * 64);
  }
}

constexpr int SMEM_BYTES = 78848 + 64;

DEVI unsigned long long launder_ptr(unsigned long long v) {
  unsigned lo = __builtin_amdgcn_readfirstlane((unsigned)v), hi = __builtin_amdgcn_readfirstlane((unsigned)(v >> 32));
  asm volatile("s_mov_b32 %0, %1" : "=s"(lo) : "s"(lo));
  asm volatile("s_mov_b32 %0, %1" : "=s"(hi) : "s"(hi));
  return ((unsigned long long)hi << 32) | lo;
}
DEVI Params mkctx(const KArgs& a) {
  Params c;
  typedef __attribute__((address_space(1))) char gchar;
  typedef __attribute__((address_space(1))) float gfloat;
  c.ws = (char*)(gchar*)launder_ptr((unsigned long long)a.ws);
  c.out = (float*)(gfloat*)launder_ptr((unsigned long long)a.out);
  c.in = (gcfloat* const*)(c.ws + O_TAB);
  c.tid = threadIdx.x;
  asm volatile("" : "+v"(c.tid));
  return c;
}
DEVI void st_mixer_queue(const KArgs& a, int l, char* smem) {
  int* sitem = (int*)(smem + SMEM_BYTES - 16);
  const int g = blockIdx.x & 7;
  const int nctx = l == 0 ? 8 : 0;
  constexpr int NPREP = TR_P2 / 8 / 8;
  const int total = 2 + 128 + 64 + 64 + nctx + NPREP;
  for (;;) {
    const Params p = mkctx(a);
    unsigned* head = (unsigned*)(p.ws + O_BAR) + 16 + l * 8 + g;
    __syncthreads();
    if (p.tid == 0) *sitem = (int)atomicAdd(head, 1u);
    __syncthreads();
    int it = *sitem;
    if (it >= total) break;
    if (it < 2) { gdn_scan_chain(p, 2 * g + it, smem); continue; }
    it -= 2;
    if (it < 256 + nctx) {
      int mixer, b, h, qb;
      if (it < 128) { const int pr = 2 * g + (it >> 6); mixer = 0; b = pr >> 3; h = pr & 7; qb = it & 63; }
      else if (it < 256) { mixer = 1 + ((it - 128) >> 6); b = g >> 2; h = g & 3; qb = it & 63; }
      else {
        const int j = it - 256;
        if (j < 4) { const int pr = 2 * g + (j >> 1); mixer = 0; b = pr >> 3; h = pr & 7; qb = 64 + (j & 1); }
        else { mixer = 1 + ((j - 4) >> 1); b = g >> 2; h = g & 3; qb = 64 + (j & 1); }
      }
      attn_item(p, l, mixer, b, h, qb, smem);
      continue;
    }
    it -= 256 + nctx;
#pragma unroll 1
    for (int k = 0; k < 8; ++k) prep_w2_tile(p, l, (it * 8 + g) * 8 + k, (float*)smem);
  }
}

DEVI void st_mix_finish(const Params& p, int l, int vb, int nvb) {
  const int lane = p.tid & 63, wid = p.tid >> 6;
  const float* GO = (const float*)(p.ws + O_GO); const u16* PP = (const u16*)(p.ws + O_PP); const u16* OB = (const u16*)(p.ws + O_OB);
  u16* Y = (u16*)(p.ws + O_Y);
  const float lam_init = 0.8f - 0.6f * expf(-0.3f * (float)l);
  float d1 = lane < 32 ? pin(p, I_LQ1)[l * 32 + lane] * pin(p, I_LK1)[l * 32 + lane] : 0.f;
  float d2 = lane < 32 ? pin(p, I_LQ2)[l * 32 + lane] * pin(p, I_LK2)[l * 32 + lane] : 0.f;
  const float lam = expf(wave_sum(d1)) - expf(wave_sum(d2)) + lam_init;
  const int hd = lane >> 4, d0 = (lane & 15) * 4;
  const f32x4 gg = *(const f32x4*)(pin(p, I_GNG) + l * 64 + d0);
  const f32x4 dg = *(const f32x4*)(pin(p, I_DNG) + l * 64 + d0) * (1.f - lam_init);
  const int tend = l == 0 ? T : TL;
  for (int t0 = (vb * 4 + wid) * 2; t0 < tend; t0 += nvb * 8) {
    u32x2 o0[2], o1[2], zz[2]; f32x4 gf[2], gb[2];
#pragma unroll
    for (int u = 0; u < 2; ++u) {
      const size_t t = t0 + u;
      o0[u] = *(const u32x2*)(OB + t * 512 + (hd * 2) * 64 + d0);
      o1[u] = *(const u32x2*)(OB + t * 512 + (hd * 2 + 1) * 64 + d0);
      gf[u] = *(const f32x4*)(GO + t * 256 + hd * 64 + d0);
      gb[u] = *(const f32x4*)(GO + (size_t)T * 256 + t * 256 + hd * 64 + d0);
      zz[u] = *(const u32x2*)(PP + t * LDPP + PP_DZ + hd * 64 + d0);
    }
    f32x4 od[2], go[2]; float ssb[2], ssg[2];
#pragma unroll
    for (int u = 0; u < 2; ++u) {
      const f32x4 a = {bflo(o0[u][0]), bfhi(o0[u][0]), bflo(o0[u][1]), bfhi(o0[u][1])};
      const f32x4 b = {bflo(o1[u][0]), bfhi(o1[u][0]), bflo(o1[u][1]), bfhi(o1[u][1])};
      od[u] = a - lam * b; go[u] = gf[u] + gb[u];
      ssb[u] = od[u][0] * od[u][0] + od[u][1] * od[u][1] + od[u][2] * od[u][2] + od[u][3] * od[u][3];
      ssg[u] = go[u][0] * go[u][0] + go[u][1] * go[u][1] + go[u][2] * go[u][2] + go[u][3] * go[u][3];
    }
#pragma unroll
    for (int o = 8; o >= 1; o >>= 1) {
#pragma unroll
      for (int u = 0; u < 2; ++u) { ssb[u] += __shfl_xor(ssb[u], o); ssg[u] += __shfl_xor(ssg[u], o); }
    }
#pragma unroll
    for (int u = 0; u < 2; ++u) {
      const size_t t = t0 + u;
      const f32x4 yb = od[u] * (rsqrtf(ssb[u] * (1.f / 64.f) + 1e-6f)) * dg;
      const f32x4 z = {bflo(zz[u][0]), bfhi(zz[u][0]), bflo(zz[u][1]), bfhi(zz[u][1])};
      const f32x4 sz = {siluf(z[0]), siluf(z[1]), siluf(z[2]), siluf(z[3])};
      const f32x4 yd = go[u] * (rsqrtf(ssg[u] * (1.f / 64.f) + 1e-6f)) * gg * sz;
      u32x2 pb, pd;
      pb[0] = pack2(yb[0], yb[1]); pb[1] = pack2(yb[2], yb[3]);
      pd[0] = pack2(yd[0], yd[1]); pd[1] = pack2(yd[2], yd[3]);
      *(u32x2*)(Y + t * 1024 + 256 + hd * 64 + d0) = pb;
      *(u32x2*)(Y + t * 1024 + 768 + hd * 64 + d0) = pd;
    }
  }
}

constexpr int RLD = 1026;
DEVI void st_norm2_route(const Params& p, int l, int vb, int nvb, char* smem) {
  const int lane = p.tid & 63, wid = p.tid >> 6, i15 = lane & 15, q = lane >> 4;
  float* shh = (float*)smem;
  float* slog = shh + 16 * RLD;
  const float* g = pin(p, I_N2G) + l * 1024;
  const float* wr = pin(p, I_WR) + (size_t)l * 1024 * 64;
  const float bias = pin(p, I_RB)[l * 64 + lane];
  float* WTS = (float*)(p.ws + O_WTS); int* CNT = (int*)(p.ws + O_CNT); int* LIST = (int*)(p.ws + O_LIST);
  const int ntok = l == 0 ? T : TL;
  for (int grp = vb; grp < ntok / 16; grp += nvb) {
    const int tb = grp * 16 + wid * 4;
    const int mv = tok_mv(tb);
    const float* sh = modp(p, l, mv, 3); const float* sc = modp(p, l, mv, 4);
    {
      f32x4 v[4][4]; float ss[4];
#pragma unroll
      for (int u = 0; u < 4; ++u) {
        const f32x4* xr = (const f32x4*)((const float*)(p.ws + O_XA) + (size_t)(tb + u) * 1024);
#pragma unroll
        for (int i = 0; i < 4; ++i) v[u][i] = xr[i * 64 + lane];
      }
#pragma unroll
      for (int u = 0; u < 4; ++u) {
        float a = 0.f;
#pragma unroll
        for (int i = 0; i < 4; ++i) a += v[u][i][0] * v[u][i][0] + v[u][i][1] * v[u][i][1] + v[u][i][2] * v[u][i][2] + v[u][i][3] * v[u][i][3];
        ss[u] = a;
      }
#pragma unroll
      for (int o = 32; o >= 1; o >>= 1) {
#pragma unroll
        for (int u = 0; u < 4; ++u) ss[u] += __shfl_xor(ss[u], o);
      }
#pragma unroll
      for (int i = 0; i < 4; ++i) {
        const int c = i * 256 + lane * 4;
        const f32x4 gg = *(const f32x4*)(g + c), s4 = *(const f32x4*)(sc + c), h4 = *(const f32x4*)(sh + c);
        const f32x4 gs = gg * (1.f + s4);
#pragma unroll
        for (int u = 0; u < 4; ++u) {
          const float rstd = rsqrtf(ss[u] * (1.f / 1024.f) + 1e-6f);
          const f32x4 o = v[u][i] * rstd * gs + h4;
          u32x2 pk; pk[0] = pack2(o[0], o[1]); pk[1] = pack2(o[2], o[3]);
          *(u32x2*)((u16*)(p.ws + O_H) + (size_t)(tb + u) * LDH + c) = pk;
          float* d = shh + (wid * 4 + u) * RLD + c;
          *(f32x2*)d = f32x2{o[0], o[1]}; *(f32x2*)(d + 2) = f32x2{o[2], o[3]};
        }
      }
    }
    __syncthreads();
    {
      f32x4 a0 = fzero4(), a1 = a0;
      const float* ap = shh + i15 * RLD + q;
      const float* bp = wr + (size_t)q * 64 + wid * 16 + i15;
#pragma unroll 1
      for (int kb = 0; kb < 256; kb += 32) {
        float bv[32];
#pragma unroll
        for (int j = 0; j < 32; ++j) bv[j] = bp[(size_t)(4 * (kb + j)) * 64];
#pragma unroll
        for (int j = 0; j < 32; j += 2) {
          a0 = __builtin_amdgcn_mfma_f32_16x16x4f32(ap[4 * (kb + j)], bv[j], a0, 0, 0, 0);
          a1 = __builtin_amdgcn_mfma_f32_16x16x4f32(ap[4 * (kb + j) + 4], bv[j + 1], a1, 0, 0, 0);
        }
      }
#pragma unroll
      for (int r = 0; r < 4; ++r) slog[(4 * q + r) * 64 + wid * 16 + i15] = a0[r] + a1[r];
    }
    __syncthreads();
#pragma unroll 1
    for (int u = 0; u < 4; ++u) {
      const int t = tb + u;
      const float logit = slog[(wid * 4 + u) * 64 + lane];
      const float s = 1.f / (1.f + expf(-logit));
      const float c = s + bias;
      float m1 = c;
      m1 = fmaxf(m1, __shfl_xor(m1, 1)); m1 = fmaxf(m1, __shfl_xor(m1, 2)); m1 = fmaxf(m1, __shfl_xor(m1, 4));
      const unsigned long long bal = __ballot(c == m1);
      const int grpi = lane >> 3;
      const unsigned gm = (unsigned)((bal >> (grpi * 8)) & 0xffull);
      const int first = __ffs(gm) - 1;
      float m2 = ((lane & 7) == first) ? -INFINITY : c;
      m2 = fmaxf(m2, __shfl_xor(m2, 1)); m2 = fmaxf(m2, __shfl_xor(m2, 2)); m2 = fmaxf(m2, __shfl_xor(m2, 4));
      const float gs = m1 + m2;
      int grank = 0;
#pragma unroll
      for (int gg = 0; gg < 8; ++gg) { float o = __shfl(gs, gg * 8); grank += (o > gs || (o == gs && gg < grpi)) ? 1 : 0; }
      const bool gsel = grank < 4;
      const float mc = gsel ? c : -INFINITY;
      int rank = 0;
#pragma unroll
      for (int e = 0; e < 64; ++e) { float o = __shfl(mc, e); rank += (o > mc || (o == mc && e < lane)) ? 1 : 0; }
      const bool sel = gsel && rank < 6;
      const float ssum = wave_sum(sel ? s : 0.f);
      if (sel) {
        const int slot = t * 6 + rank;
        WTS[slot] = s / ssum * 2.5f;
        const int pos = atomicAdd(&CNT[lane], 1);
        LIST[(size_t)lane * T + pos] = slot;
      }
    }
    __syncthreads();
  }
}
DEVI void st_outproj(const Params& p, int l, int vb, int nvb, char* smem) {
  const u16* Y = (const u16*)(p.ws + O_Y); const u16* W = (const u16*)(p.ws + O_WOUTT); float* XA = (float*)(p.ws + O_XA);
  const int nmt = l == 0 ? 132 : 128;
  const int g = vb & 7, nmg = (nmt - g + 7) >> 3;
  for (int i = vb >> 3; i < nmg * 8; i += nvb >> 3) {
    const int m0 = (g + 8 * (i >> 3)) * 128, n0 = (i & 7) * 128;
    gemm128(p.tid, [&](int r) { return Y + (size_t)(m0 + r) * 1024; }, W + (size_t)n0 * LDW, LDW, 1024,
            [&](int r, int c, f32x4 v) {
              const int t = m0 + r; const float* gt = modp(p, l, tok_mv(t), 2) + n0 + c;
              float4* xp = (float4*)(XA + (size_t)t * 1024 + n0 + c);
              const float* xin = l == 0 ? (t < TL ? pin(p, I_X) + (size_t)t * 1024 : pin(p, I_CTX) + (size_t)(t - TL) * 1024) + n0 + c : (const float*)xp;
              float4 x = *(const float4*)xin;
              x.x += gt[0] * v[0]; x.y += gt[1] * v[1]; x.z += gt[2] * v[2]; x.w += gt[3] * v[3]; *xp = x;
              __builtin_amdgcn_sched_barrier(0);
            }, smem);
  }
}

DEVI void grp_tiles(const Params& p, int* tst, int g, int shift, int nshared) {
  __syncthreads();
  if (p.tid < 64) {
    const int* CNT = (const int*)(p.ws + O_CNT);
    const int lane = p.tid;
    int c = 0;
    if (lane < 8) c = (__hip_atomic_load(&CNT[g + 8 * lane], __ATOMIC_RELAXED, __HIP_MEMORY_SCOPE_AGENT) + (1 << shift) - 1) >> shift;
    int incl = c;
#pragma unroll
    for (int o = 1; o < 8; o <<= 1) { int u = __shfl_up(incl, o); if (lane >= o) incl += u; }
    if (lane < 8) tst[lane] = incl - c;
    if (lane == 7) { tst[8] = incl; tst[9] = incl + (nshared - g + 7) / 8; }
  }
  __syncthreads();
}
DEVI void grp_find(const int* tst, int tile, int g, int& e, int& lt) {
  int j = 0;
#pragma unroll
  for (int k = 1; k <= 8; ++k) j += tile >= tst[k] ? 1 : 0;
  if (j < 8) { e = g + 8 * j; lt = tile - tst[j]; } else { e = 64; lt = g + 8 * (tile - tst[8]); }
}
DEVI void st_moe1(const Params& p, int l, int vb, int nvb, char* smem) {
  const int* CNT = (const int*)(p.ws + O_CNT); const int* LIST = (const int*)(p.ws + O_LIST);
  const u16* H = (const u16*)(p.ws + O_H); u16* HB = (u16*)(p.ws + O_HB);
  int* sslot = (int*)(smem + 4 * 128 * GLD * 2);
  int* TST = sslot + 128;
  const int g = vb & 7;
  const int nsh = l == 0 ? T : TL;
  grp_tiles(p, TST, g, 7, nsh / 128);
  const int total = TST[9];
  for (int item = vb >> 3; item < total * 4; item += nvb >> 3) {
    const int tile = item >> 2, n0 = (item & 3) * 128;
    int e, lt; grp_find(TST, tile, g, e, lt);
    const int cnt = e < 64 ? __hip_atomic_load(&CNT[e], __ATOMIC_RELAXED, __HIP_MEMORY_SCOPE_AGENT) : nsh;
    __syncthreads();
    if (p.tid < 128) {
      int i = lt * 128 + p.tid;
      int slot = -1;
      if (i < cnt) slot = e < 64 ? LIST[(size_t)e * T + i] : NSLOT + i;
      sslot[p.tid] = slot;
    }
    __syncthreads();
    gemm128(p.tid, [&](int r) { int sl = sslot[r]; int tk = sl < 0 ? 0 : (sl < NSLOT ? sl / 6 : sl - NSLOT); return H + (size_t)tk * LDH; },
            (const u16*)(p.ws + O_WGUT) + ((size_t)e * 512 + n0) * LDW, LDW, 1024,
            [&](int r, int c, f32x4 v) {
              int sl = sslot[r]; if (sl < 0) return;
              float h0 = siluf(v[0]) * v[1], h1 = siluf(v[2]) * v[3];
              *(unsigned*)(HB + (size_t)sl * 256 + ((n0 + c) >> 1)) = pack2(h0, h1);
            }, smem);
  }
}
DEVI void st_moe2(const Params& p, int l, int vb, int nvb, char* smem) {
  const int* CNT = (const int*)(p.ws + O_CNT); const int* LIST = (const int*)(p.ws + O_LIST);
  const u16* HB = (const u16*)(p.ws + O_HB); u16* SO = (u16*)(p.ws + O_SLOT); const float* WTS = (const float*)(p.ws + O_WTS);
  constexpr int ALD = 264;
  u16* sA = (u16*)smem;
  u16* sB = sA + 64 * ALD;
  int* sslot = (int*)(sB + 2 * 128 * 72);
  int* TST = sslot + 64;
  const int tid = p.tid, lane = tid & 63, wid = tid >> 6, wr = wid >> 1, wc = wid & 1, fr = lane & 15, fq = lane >> 4;
  const int g = vb & 7;
  const int nsh = l == 0 ? T : TL;
  grp_tiles(p, TST, g, 6, nsh / 64);
  const int total = TST[9];
  for (int item = vb >> 3; item < total; item += nvb >> 3) {
    int e, lt; grp_find(TST, item, g, e, lt);
    const int cnt = e < 64 ? __hip_atomic_load(&CNT[e], __ATOMIC_RELAXED, __HIP_MEMORY_SCOPE_AGENT) : nsh;
    __syncthreads();
    if (tid < 64) { const int i = lt * 64 + tid; sslot[tid] = i < cnt ? (e < 64 ? LIST[(size_t)e * T + i] : NSLOT + i) : -1; }
    __syncthreads();
    const u16* Bbase = (const u16*)(p.ws + O_WDT) + (size_t)e * 1024 * 256;
    u32x4 rb0[4], rb1[4], rb2[4];
    const u16* bthr = Bbase + (size_t)(tid >> 3) * 256 + (tid & 7) * 8;
    auto gloadB = [&](u32x4 (&rb)[4], int bt) {
      int off = (bt >> 2) * 128 * 256 + (bt & 3) * 64;
      asm volatile("" : "+s"(off));
      const u16* src = bthr + off;
#pragma unroll
      for (int i = 0; i < 4; ++i) rb[i] = *(const u32x4*)(src + i * 32 * 256);
    };
    auto lstoreB = [&](const u32x4 (&rb)[4], int buf) {
      u16* d = sB + buf * 128 * 72;
#pragma unroll
      for (int i = 0; i < 4; ++i) { const int q = tid + 256 * i, r = q >> 3, cc = q & 7; *(u32x4*)&d[r * 72 + cc * 8] = rb[i]; }
    };
    gloadB(rb0, 0); gloadB(rb1, 1); gloadB(rb2, 2);
#pragma unroll
    for (int hf = 0; hf < 2; ++hf) {
      u32x4 ra[4];
#pragma unroll
      for (int i = 0; i < 4; ++i) { const int q = tid + 256 * (4 * hf + i), r = q >> 5, cc = q & 31; const int sl = sslot[r]; ra[i] = *(const u32x4*)(HB + (size_t)(sl < 0 ? 0 : sl) * 256 + cc * 8); }
#pragma unroll
      for (int i = 0; i < 4; ++i) { const int q = tid + 256 * (4 * hf + i), r = q >> 5, cc = q & 31; *(u32x4*)&sA[r * ALD + cc * 8] = ra[i]; }
      __builtin_amdgcn_sched_barrier(0);
    }
    int slot_m[2]; float w_m[2];
#pragma unroll
    for (int m = 0; m < 2; ++m) { const int sl = sslot[wr * 32 + m * 16 + fr]; slot_m[m] = sl; w_m[m] = (sl >= 0 && sl < NSLOT) ? WTS[sl] : 1.f; }
    lstoreB(rb0, 0); gloadB(rb0, 3);
    __syncthreads();
    f32x4 acc[2][4];
    auto compute = [&](int bt, int buf) {
      const int nt = bt >> 2, kt = bt & 3;
      const u16* b = sB + buf * 128 * 72;
      if (kt == 0) {
#pragma unroll
        for (int m = 0; m < 2; ++m)
#pragma unroll
          for (int n = 0; n < 4; ++n) acc[m][n] = fzero4();
      }
#pragma unroll
      for (int ks = 0; ks < 2; ++ks) {
        bf16x8 af[2], bfr[4];
#pragma unroll
        for (int m = 0; m < 2; ++m) af[m] = *(const bf16x8*)&sA[(wr * 32 + m * 16 + fr) * ALD + kt * 64 + ks * 32 + fq * 8];
#pragma unroll
        for (int n = 0; n < 4; ++n) bfr[n] = *(const bf16x8*)&b[(wc * 64 + n * 16 + fr) * 72 + ks * 32 + fq * 8];
#pragma unroll
        for (int m = 0; m < 2; ++m)
#pragma unroll
          for (int n = 0; n < 4; ++n) acc[m][n] = MFMA16(bfr[n], af[m], acc[m][n]);
      }
      if (kt == 3) {
#pragma unroll
        for (int m = 0; m < 2; ++m) {
          if (slot_m[m] >= 0) {
            const float w = w_m[m];
#pragma unroll
            for (int n = 0; n < 4; ++n) {
              u32x2 pk; pk[0] = pack2(acc[m][n][0] * w, acc[m][n][1] * w); pk[1] = pack2(acc[m][n][2] * w, acc[m][n][3] * w);
              *(u32x2*)(SO + (size_t)slot_m[m] * 1024 + nt * 128 + wc * 64 + n * 16 + fq * 4) = pk;
            }
          }
        }
      }
    };
#pragma unroll
    for (int bt = 0; bt < 30; bt += 3) {
      compute(bt, bt & 1);           lstoreB(rb1, (bt + 1) & 1); if (bt + 4 < 32) gloadB(rb1, bt + 4); __syncthreads(); __builtin_amdgcn_sched_barrier(0);
      compute(bt + 1, (bt + 1) & 1); lstoreB(rb2, (bt + 2) & 1); if (bt + 5 < 32) gloadB(rb2, bt + 5); __syncthreads(); __builtin_amdgcn_sched_barrier(0);
      compute(bt + 2, (bt + 2) & 1); lstoreB(rb0, (bt + 3) & 1); if (bt + 6 < 32) gloadB(rb0, bt + 6); __syncthreads(); __builtin_amdgcn_sched_barrier(0);
    }
    compute(30, 0); lstoreB(rb1, 1); __syncthreads(); __builtin_amdgcn_sched_barrier(0);
    compute(31, 1); __syncthreads();
  }
}

DEVI void st_combine(const Params& p, int l, int vb, int nvb) {
  const int lane = p.tid & 63, wid = p.tid >> 6;
  const u16* SO = (const u16*)(p.ws + O_SLOT);
  const bool last = l == 1;
  const float* gnext = last ? pin(p, I_FNG) : pin(p, I_N1G) + 1024;
  const int tend = last ? TL : T;
  for (int t0 = (vb * 4 + wid) * 2; t0 < tend; t0 += nvb * 8) {
    const int mv = tok_mv(t0);
    const float* g5 = modp(p, l, mv, 5);
    u32x4 sv[2][7][2]; f32x4 xv[2][4];
#pragma unroll
    for (int u = 0; u < 2; ++u) {
      const int t = t0 + u;
#pragma unroll
      for (int k = 0; k < 7; ++k) {
        const u16* row = SO + (size_t)(k < 6 ? t * 6 + k : NSLOT + t) * 1024;
        sv[u][k][0] = *(const u32x4*)(row + lane * 8); sv[u][k][1] = *(const u32x4*)(row + 512 + lane * 8);
      }
      const float* xr = (const float*)(p.ws + O_XA) + (size_t)t * 1024;
      xv[u][0] = *(const f32x4*)(xr + lane * 8); xv[u][1] = *(const f32x4*)(xr + lane * 8 + 4);
      xv[u][2] = *(const f32x4*)(xr + 512 + lane * 8); xv[u][3] = *(const f32x4*)(xr + 512 + lane * 8 + 4);
    }
    f32x4 gq[4];
    gq[0] = *(const f32x4*)(g5 + lane * 8); gq[1] = *(const f32x4*)(g5 + lane * 8 + 4);
    gq[2] = *(const f32x4*)(g5 + 512 + lane * 8); gq[3] = *(const f32x4*)(g5 + 512 + lane * 8 + 4);
    float ss[2];
#pragma unroll
    for (int u = 0; u < 2; ++u) {
      float acc = 0.f;
#pragma unroll
      for (int hf = 0; hf < 2; ++hf) {
        f32x4 a0 = fzero4(), a1 = a0;
#pragma unroll
        for (int k = 0; k < 7; ++k) {
          const u32x4 v = sv[u][k][hf];
          a0[0] += bflo(v[0]); a0[1] += bfhi(v[0]); a0[2] += bflo(v[1]); a0[3] += bfhi(v[1]);
          a1[0] += bflo(v[2]); a1[1] += bfhi(v[2]); a1[2] += bflo(v[3]); a1[3] += bfhi(v[3]);
        }
        xv[u][2 * hf] += gq[2 * hf] * a0; xv[u][2 * hf + 1] += gq[2 * hf + 1] * a1;
#pragma unroll
        for (int e = 0; e < 4; ++e) acc += xv[u][2 * hf][e] * xv[u][2 * hf][e] + xv[u][2 * hf + 1][e] * xv[u][2 * hf + 1][e];
      }
      ss[u] = acc;
    }
#pragma unroll
    for (int o = 32; o >= 1; o >>= 1) { ss[0] += __shfl_xor(ss[0], o); ss[1] += __shfl_xor(ss[1], o); }
    f32x4 gn[4];
    gn[0] = *(const f32x4*)(gnext + lane * 8); gn[1] = *(const f32x4*)(gnext + lane * 8 + 4);
    gn[2] = *(const f32x4*)(gnext + 512 + lane * 8); gn[3] = *(const f32x4*)(gnext + 512 + lane * 8 + 4);
    if (!last) {
      const float* sh = modp(p, 1, mv, 0); const float* sc = modp(p, 1, mv, 1);
#pragma unroll
      for (int q = 0; q < 4; ++q) {
        const int c = (q >> 1) * 512 + lane * 8 + (q & 1) * 4;
        const f32x4 s4 = *(const f32x4*)(sc + c), h4 = *(const f32x4*)(sh + c);
        const f32x4 gs = gn[q] * (1.f + s4);
#pragma unroll
        for (int u = 0; u < 2; ++u) {
          const size_t t = t0 + u;
          const float rstd = rsqrtf(ss[u] * (1.f / 1024.f) + 1e-6f);
          *(f32x4*)((float*)(p.ws + O_XA) + t * 1024 + c) = xv[u][q];
          const f32x4 o = xv[u][q] * rstd * gs + h4;
          u32x2 pk; pk[0] = pack2(o[0], o[1]); pk[1] = pack2(o[2], o[3]);
          *(u32x2*)((u16*)(p.ws + O_H) + t * LDH + c) = pk;
        }
      }
    } else {
#pragma unroll
      for (int q = 0; q < 4; ++q) {
        const int c = (q >> 1) * 512 + lane * 8 + (q & 1) * 4;
#pragma unroll
        for (int u = 0; u < 2; ++u) {
          const size_t t = t0 + u;
          const float rstd = rsqrtf(ss[u] * (1.f / 1024.f) + 1e-6f);
          *(f32x4*)(p.out + t * 1024 + c) = xv[u][q] * rstd * gn[q];
        }
      }
    }
  }
}


#define STAGE(call) { const Params p = mkctx(a); call; }

#define XB_TMO      128
#define XB_XCNT(j)  (256  + 64 * (j))
#define XB_XSUB(j)  (1280 + 64 * (j))
#define XB_XGEN(j)  (2304 + 64 * (j))
#define XB_TOP      3328
#define XB_TOPGEN   3392
#define XCD_BAR_WORDS 3456
#define XB_SPIN_CAP (1u << 20)
#define LAS __attribute__((address_space(3)))
DEVI unsigned xb_ld(unsigned* p)              { return __hip_atomic_load(p, __ATOMIC_RELAXED, __HIP_MEMORY_SCOPE_AGENT); }
DEVI unsigned xb_add(unsigned* p, unsigned v) { return __hip_atomic_fetch_add(p, v, __ATOMIC_RELAXED, __HIP_MEMORY_SCOPE_AGENT); }
DEVI unsigned xb_xcc_id() { return (unsigned)__builtin_amdgcn_s_getreg((3 << 11) | 20) & 0xFu; }
#define XB_SPIN(cond, bar) do { unsigned _sp = 0; while (cond) { __builtin_amdgcn_s_sleep(1); \
    if ((++_sp & 255u) == 0u) { if (xb_ld(&(bar)[XB_TMO])) break; if (_sp > XB_SPIN_CAP) { atomicAdd(&(bar)[XB_TMO], 1u); break; } } } } while (0)
struct XcdBarrier { unsigned* bar; unsigned x; volatile LAS unsigned* st; };
DEVI XcdBarrier xcd_barrier_post(unsigned* bar, volatile LAS unsigned* st) {
  XcdBarrier b; b.bar = bar; b.x = xb_xcc_id(); b.st = st;
  if (threadIdx.x == 0) (void)xb_add(&bar[XB_XCNT(b.x)], 1u);
  return b;
}
DEVI void xcd_barrier_complete(unsigned* bar, unsigned x, unsigned& nloc, unsigned& nx) {
  const unsigned G = gridDim.x * gridDim.y * gridDim.z;
  unsigned sum, cnt, mine, sp = 0u;
  for (;;) {
    sum = 0u; cnt = 0u; mine = 0u;
#pragma unroll
    for (unsigned j = 0; j < 16; ++j) { const unsigned c = xb_ld(&bar[XB_XCNT(j)]); sum += c; cnt += (c > 0u) ? 1u : 0u; mine = (j == x) ? c : mine; }
    if (sum == G) break;
    __builtin_amdgcn_s_sleep(1);
    if ((++sp & 255u) == 0u) { if (xb_ld(&bar[XB_TMO])) break; if (sp > XB_SPIN_CAP) { atomicAdd(&bar[XB_TMO], 1u); break; } }
  }
  nloc = mine > 0u ? mine : 1u; nx = cnt > 0u ? cnt : 1u;
}
DEVI void xcd_barrier(const XcdBarrier& b) {
  asm volatile("s_waitcnt vmcnt(0)" ::: "memory");
  __syncthreads();
  if (threadIdx.x == 0) {
    unsigned* bar = b.bar;
    __builtin_amdgcn_s_waitcnt(0);
    unsigned nloc = b.st[0], nx = b.st[1];
    if (nloc == 0u) { xcd_barrier_complete(bar, b.x, nloc, nx); b.st[0] = nloc; b.st[1] = nx; }
    const unsigned old = xb_add(&bar[XB_XSUB(b.x)], 1u);
    const unsigned gen = old / nloc;
    if (old + 1u == (gen + 1u) * nloc) {
      __builtin_amdgcn_fence(__ATOMIC_RELEASE, "agent");
      asm volatile("s_waitcnt vmcnt(0)" ::: "memory");
      const unsigned og = xb_add(&bar[XB_TOP], 1u);
      const unsigned tg = og / nx;
      if (og + 1u == (tg + 1u) * nx) xb_add(&bar[XB_TOPGEN], 1u);
      else XB_SPIN(xb_ld(&bar[XB_TOPGEN]) == tg, bar);
      __builtin_amdgcn_fence(__ATOMIC_ACQUIRE, "agent");
      xb_add(&bar[XB_XGEN(b.x)], 1u);
      asm volatile("s_waitcnt vmcnt(0)" ::: "memory");
    } else {
      XB_SPIN(xb_ld(&bar[XB_XGEN(b.x)]) == gen, bar);
      __builtin_amdgcn_fence(__ATOMIC_ACQUIRE, "agent");
      asm volatile("s_waitcnt vmcnt(0)" ::: "memory");
    }
  }
  __syncthreads();
}
#define GSYNC() { XcdBarrier xb_; xb_.bar = (unsigned*)(mkctx(a).ws + O_XBAR); xb_.x = xb_xcc_id(); xb_.st = (volatile LAS unsigned*)(smem + SMEM_BYTES - 32); xcd_barrier(xb_); }

__global__ void __launch_bounds__(256, 2) mega(KArgs a) {
  extern __shared__ __attribute__((aligned(16))) char smem[];
  cg::grid_group grid = cg::this_grid();
  const int vb = blockIdx.x, nvb = gridDim.x;
  volatile LAS unsigned* xst = (volatile LAS unsigned*)(smem + SMEM_BYTES - 32);
  if (threadIdx.x == 0) { xst[0] = 0u; xst[1] = 0u; }
  __syncthreads();
  (void)xcd_barrier_post((unsigned*)(a.ws + O_XBAR), xst);
  if (threadIdx.x == 0) {
    const float** tab = (const float**)(a.ws + O_TAB);
#pragma unroll
    for (int i = 0; i < 35; ++i) tab[i] = a.in[i];
  }
  __syncthreads();
  STAGE(st_rope_table(p, vb, nvb));
  STAGE(st_mod(p, vb, nvb, smem));
  STAGE(st_prep_w1(p, 0, vb, nvb, smem));
  grid.sync();
  for (int l = 0; l < 2; ++l) {
    if (l == 0) { STAGE(st_norm1(p, 0, vb, nvb)); GSYNC(); }
    {
      const int g = vb & 7;
      for (int i = vb >> 3; i < 363; i += nvb >> 3) {
        int mt, nt;
        if (i < 264) { mt = i >> 1; nt = g + 8 * (i & 1); }
        else { const int j = i - 264, pc = g + 8 * (j / 33); nt = 16 + (pc >> 2); mt = (pc & 3) * 33 + (j % 33); }
        const Params p = mkctx(a); inproj_item(p, mt * 22 + nt, smem);
      }
    }
    GSYNC();
    STAGE(st_tokprep(p, l, vb, nvb));
    GSYNC();
    {
      for (int item = vb; item < 132 * 7 + NGITEM; item += nvb) {
        const Params p = mkctx(a);
        if (item < 132 * 7) mla_up_tile(p, item / 7, item % 7, smem);
        else gdn_chunk_item(p, item - 132 * 7, smem);
      }
    }
    GSYNC();
    st_mixer_queue(a, l, smem);
    GSYNC();
    STAGE(st_mix_finish(p, l, vb, nvb));
    GSYNC();
    STAGE(st_outproj(p, l, vb, nvb, smem));
    GSYNC();
    STAGE(st_norm2_route(p, l, vb, nvb, smem));
    GSYNC();
    STAGE(st_moe1(p, l, vb, nvb, smem));
    GSYNC();
    STAGE(st_moe2(p, l, vb, nvb, smem));
    GSYNC();
    if (l == 0) STAGE(st_prep_w1(p, 1, vb, nvb, smem));
    STAGE(st_combine(p, l, vb, nvb));
    if (l == 0) GSYNC();
  }
}

extern "C" void kernel_launch(void* const* d_in, const int* in_sizes, int n_in, void* d_out, int out_size, void* d_ws, size_t ws_size,
                              hipStream_t stream) {
  static int grid_blocks = 0;
  if (!grid_blocks) {
    int dev = 0, cus = 0, per_cu = 0;
    (void)hipGetDevice(&dev);
    (void)hipDeviceGetAttribute(&cus, hipDeviceAttributeMultiprocessorCount, dev);
    (void)hipFuncSetAttribute((const void*)mega, hipFuncAttributeMaxDynamicSharedMemorySize, SMEM_BYTES);
    (void)hipOccupancyMaxActiveBlocksPerMultiprocessor(&per_cu, mega, 256, SMEM_BYTES);
    if (per_cu > 2) per_cu = 2;
    if (per_cu < 1) per_cu = 1;
    grid_blocks = cus * per_cu;
  }
  KArgs p{};
  for (int i = 0; i < 35; ++i) p.in[i] = (const float*)d_in[i];
  p.out = (float*)d_out; p.ws = (char*)d_ws;
  if (ws_size < WS_NEED) { fprintf(stderr, "workspace too small: %zu < %zu\n", ws_size, (size_t)WS_NEED); return; }
  (void)hipMemsetAsync((char*)d_ws + O_BAR, 0, 256 + 16384, stream);
  void* args[] = {&p};
  hipError_t e = hipLaunchCooperativeKernel((void*)mega, dim3(grid_blocks), dim3(256), args, SMEM_BYTES, stream);
  if (e != hipSuccess) fprintf(stderr, "cooperative launch failed: %s (grid %d)\n", hipGetErrorString(e), grid_blocks);
}
```

```cpp
#include <hip/hip_runtime.h>
#include <hip/hip_cooperative_groups.h>
#include <cstdio>
#include <cstdint>
namespace cg = cooperative_groups;

#define DEVI __device__ __forceinline__
typedef unsigned short u16;
using bf16x8 = __attribute__((ext_vector_type(8))) short;
using f32x4  = __attribute__((ext_vector_type(4))) float;
using f32x2  = __attribute__((ext_vector_type(2))) float;
using f32x16 = __attribute__((ext_vector_type(16))) float;
using u32x4 = __attribute__((ext_vector_type(4))) unsigned;
using u32x2 = __attribute__((ext_vector_type(2))) unsigned;
typedef __bf16 bf16x2_t __attribute__((ext_vector_type(2)));

constexpr int DM = 1024, SEQ = 8192, CTXL = 256, NKEY = SEQ + CTXL;
constexpr int TL = 2 * SEQ, TC = 2 * CTXL, T = TL + TC;
constexpr int INW = 2672;
constexpr int NIN = 2816;
constexpr int LDPP = 1408;
constexpr int PP_CQ = 0, PP_CKV = 192, PP_DQKV = 320, PP_DZ = 1088, PP_GATE = 1344;
constexpr int NE = 64, NSLOT = 6 * T;
constexpr int LDW = 1088;
constexpr int LDH = 1088;
constexpr int NCHUNK = T / 64;
constexpr int NGITEM = NCHUNK * 8;
constexpr float LOG2E = 1.4426950408889634f;

constexpr size_t al256(size_t x) { return (x + 255) & ~(size_t)255; }
constexpr size_t O_MOD   = 0;
constexpr size_t O_ROPE  = O_MOD + al256((size_t)2 * 3 * 6144 * 4);
constexpr size_t O_XA    = O_ROPE + (size_t)SEQ * 48 * 8;
constexpr size_t O_H     = O_XA + (size_t)T * DM * 4;
constexpr size_t O_WINT  = O_H + (size_t)T * LDH * 2;
constexpr size_t O_WOUTT = O_WINT + (size_t)NIN * LDW * 2;
constexpr size_t O_WUQT  = O_WOUTT + (size_t)1024 * LDW * 2;
constexpr size_t O_WUKVT = O_WUQT + (size_t)384 * 192 * 2;
constexpr size_t O_WGUT  = O_WUKVT + (size_t)512 * 128 * 2;
constexpr size_t O_WDT   = O_WGUT + (size_t)65 * 512 * LDW * 2;
constexpr size_t O_WTS   = O_WDT + (size_t)65 * 1024 * 256 * 2;
constexpr size_t O_CNT   = O_WTS + al256((size_t)NSLOT * 4);
constexpr size_t O_TAB   = O_CNT + 256;
constexpr size_t O_BAR   = O_TAB + 512;
constexpr size_t O_XBAR  = O_BAR + 256;
constexpr size_t O_LIST  = O_XBAR + 16384;
constexpr size_t O_R     = O_LIST + (size_t)NE * T * 4;
constexpr size_t O_Y     = O_R;
constexpr size_t O_PP    = O_Y + (size_t)T * DM * 2;
constexpr size_t O_QA    = O_PP + (size_t)T * LDPP * 2;
constexpr size_t O_KA    = O_QA + (size_t)2 * 4 * NKEY * 64 * 2;
constexpr size_t O_VTA   = O_KA + (size_t)2 * 2 * NKEY * 64 * 2;
constexpr size_t O_QB    = O_VTA + (size_t)2 * 2 * NKEY * 64 * 2;
constexpr size_t O_KB    = O_QB + (size_t)2 * 8 * NKEY * 32 * 2;
constexpr size_t O_VTB   = O_KB + (size_t)2 * 8 * NKEY * 32 * 2;
constexpr size_t O_QC    = O_VTB + (size_t)2 * 4 * NKEY * 64 * 2;
constexpr size_t O_KC    = O_QC + (size_t)2 * 4 * NKEY * 96 * 2;
constexpr size_t O_VTC   = O_KC + (size_t)2 * 4 * NKEY * 96 * 2;
constexpr size_t O_CQN   = O_VTC + (size_t)2 * 4 * NKEY * 64 * 2;
constexpr size_t O_CKVN  = O_CQN + (size_t)T * 192 * 2;
constexpr size_t O_OB    = O_CKVN + (size_t)T * 128 * 2;
constexpr size_t O_GQ    = O_OB + (size_t)T * 512 * 2;
constexpr size_t O_GK    = O_GQ + (size_t)T * 256 * 2;
constexpr size_t O_GV    = O_GK + (size_t)T * 256 * 2;
constexpr size_t O_GG    = O_GV + (size_t)T * 256 * 2;
constexpr size_t O_GBETA = O_GG + (size_t)2 * T * 4 * 4;
constexpr size_t O_GM    = O_GBETA + (size_t)2 * T * 4 * 4;
constexpr size_t O_GQP   = O_GM + (size_t)NGITEM * 4096 * 2;
constexpr size_t O_GN    = O_GQP + (size_t)NGITEM * 4096 * 2;
constexpr size_t O_GLO   = O_GN + (size_t)NGITEM * 4096 * 2;
constexpr size_t O_GO    = O_GLO + (size_t)NGITEM * 4096 * 2;
constexpr size_t O_MIX_END = O_GO + (size_t)2 * T * 256 * 4;
constexpr size_t O_HB    = O_R;
constexpr size_t O_SLOT  = O_HB + (size_t)7 * T * 256 * 2;
constexpr size_t O_MOE_END = O_SLOT + (size_t)7 * T * 1024 * 2;
constexpr size_t cmax(size_t a, size_t b) { return a > b ? a : b; }
constexpr size_t WS_NEED = cmax(O_MIX_END, O_MOE_END);
static_assert(WS_NEED < (size_t)556000000, "workspace too large");

struct KArgs {
  const float* in[35];
  float* out;
  char* ws;
};
typedef const __attribute__((address_space(1))) float gcfloat;
struct Params {
  char* ws;
  float* out;
  gcfloat* const* in;
  int tid;
};
#define pin(p, i) ((const float*)(p).in[i])
enum { I_X = 0, I_C, I_CTX, I_CCTX, I_WADA, I_BADA, I_N1G, I_N2G, I_WIN, I_WOUT, I_SINK, I_LQ1, I_LK1, I_LQ2, I_LK2,
       I_DNG, I_MQG, I_MKVG, I_WUQ, I_WUKV, I_CONVW, I_ALF, I_ALB, I_DTF, I_DTB, I_GNG, I_WR, I_RB, I_WG, I_WU, I_WD,
       I_SG, I_SU, I_SD, I_FNG };

DEVI u16 f2bf(float f) { unsigned u = __float_as_uint(f); u += 0x7fffu + ((u >> 16) & 1u); return (u16)(u >> 16); }
DEVI float bf2f(u16 h) { return __uint_as_float(((unsigned)h) << 16); }
DEVI float bflo(unsigned v) { return __uint_as_float(v << 16); }
DEVI float bfhi(unsigned v) { return __uint_as_float(v & 0xffff0000u); }
DEVI unsigned pack2(float a, float b) { f32x2 v = {a, b}; return __builtin_bit_cast(unsigned, __builtin_convertvector(v, bf16x2_t)); }
DEVI f32x4 fzero4() { float z = 0.f; asm volatile("" : "+v"(z)); return f32x4{z, z, z, z}; }
DEVI float wave_sum(float v) {
#pragma unroll
  for (int o = 32; o >= 1; o >>= 1) v += __shfl_xor(v, o);
  return v;
}
DEVI float half_sum(float v) {
#pragma unroll
  for (int o = 16; o >= 1; o >>= 1) v += __shfl_xor(v, o);
  return v;
}
DEVI float siluf(float x) { return x / (1.f + __expf(-x)); }
DEVI float sigmf(float x) { return 1.f / (1.f + __expf(-x)); }
DEVI int tok_mv(int t) { return t < TL ? (t >> 13) : 2; }
DEVI int tok_b(int t) { return t < TL ? (t >> 13) : ((t - TL) >> 8); }
DEVI int tok_row(int t) { return t < TL ? (t & (SEQ - 1)) : (SEQ + ((t - TL) & (CTXL - 1))); }
DEVI const float* modp(const Params& p, int l, int mv, int j) { return (const float*)(p.ws + O_MOD) + ((size_t)(l * 3 + mv) * 6 + j) * 1024; }

#define MFMA16(a, b, c) __builtin_amdgcn_mfma_f32_16x16x32_bf16((a), (b), (c), 0, 0, 0)
#define MFMA32(a, b, c) __builtin_amdgcn_mfma_f32_32x32x16_bf16((a), (b), (c), 0, 0, 0)

DEVI void st_copy_in(const Params& p, int vb, int nvb) {
  float4* xa = (float4*)(p.ws + O_XA);
  const float4* x = (const float4*)pin(p, I_X);
  const float4* cx = (const float4*)pin(p, I_CTX);
  const size_t n4 = (size_t)T * DM / 4, nl4 = (size_t)TL * DM / 4;
  for (size_t i = (size_t)vb * 256 + p.tid; i < n4; i += (size_t)nvb * 256) xa[i] = i < nl4 ? x[i] : cx[i - nl4];
}
DEVI void rope_cs(int i, int half, int s, float& c, float& sn) {
  const int quarter = half >> 1;
  const int ii = i < quarter ? i : i - quarter;
  const float pos = i < quarter ? (float)(s >> 6) : (float)(s & 63);
  const float inv = powf(10000.f, -(float)ii / (float)quarter);
  const float ang = pos * inv;
  c = cosf(ang); sn = sinf(ang);
}
DEVI void st_rope_table(const Params& p, int vb, int nvb) {
  f32x2* R = (f32x2*)(p.ws + O_ROPE);
  for (int e = vb * 256 + p.tid; e < SEQ * 48; e += nvb * 256) {
    const int s = e / 48, i = e % 48;
    float c, sn;
    if (i < 32) rope_cs(i, 32, s, c, sn); else rope_cs(i - 32, 16, s, c, sn);
    R[e] = f32x2{c, sn};
  }
}
DEVI void st_mod(const Params& p, int vb, int nvb, char* smem) {
  float* sv = (float*)smem;
  float* red = sv + 3 * 1024;
  for (int i = p.tid; i < 3 * 1024; i += 256) {
    int v = i >> 10, k = i & 1023;
    float c = v < 2 ? pin(p, I_C)[v * 1024 + k] : pin(p, I_CCTX)[k];
    sv[i] = siluf(c);
  }
  __syncthreads();
  const int cgp = p.tid & 7, kg = p.tid >> 3;
  for (int item = vb; item < 2 * 192; item += nvb) {
    const int l = item / 192, c0 = (item % 192) * 32;
    const float* w = pin(p, I_WADA) + (size_t)l * 1024 * 6144 + c0 + cgp * 4;
    f32x4 a0 = fzero4(), a1 = a0, a2 = a0;
#pragma unroll 8
    for (int kk = 0; kk < 32; ++kk) {
      const int k = kg * 32 + kk;
      const f32x4 wv = *(const f32x4*)(w + (size_t)k * 6144);
      a0 += sv[k] * wv; a1 += sv[1024 + k] * wv; a2 += sv[2048 + k] * wv;
    }
    float* rp = red + (kg * 8 + cgp) * 12;
    *(f32x4*)rp = a0; *(f32x4*)(rp + 4) = a1; *(f32x4*)(rp + 8) = a2;
    __syncthreads();
    if (p.tid < 96) {
      const int v = p.tid >> 5, c = p.tid & 31;
      float s = 0.f;
#pragma unroll 8
      for (int g = 0; g < 32; ++g) s += red[(g * 8 + (c >> 2)) * 12 + v * 4 + (c & 3)];
      ((float*)(p.ws + O_MOD))[(size_t)(l * 3 + v) * 6144 + c0 + c] = s + pin(p, I_BADA)[l * 6144 + c0 + c];
    }
    __syncthreads();
  }
}

template <class RowFn>
DEVI void tr_tile(int tid, const float* __restrict__ src, int N, u16* __restrict__ dst, int ldd, RowFn drow, int k0, int n0, float* tile) {
  {
    const int kq = tid >> 4, n4 = (tid & 15) * 4;
    f32x4 v[4];
#pragma unroll
    for (int r = 0; r < 4; ++r) {
      const int k = r * 16 + kq;
      v[r] = n0 + n4 < N ? *(const f32x4*)(src + (size_t)(k0 + k) * N + n0 + n4) : fzero4();
    }
#pragma unroll
    for (int r = 0; r < 4; ++r) {
      const int k = r * 16 + kq;
      tile[k * 65 + n4] = v[r][0]; tile[k * 65 + n4 + 1] = v[r][1]; tile[k * 65 + n4 + 2] = v[r][2]; tile[k * 65 + n4 + 3] = v[r][3];
    }
  }
  __syncthreads();
  {
    const int n = tid >> 2, kc = (tid & 3) * 16;
    const int dr = drow(n0 + n);
    if (dr >= 0) {
      u32x4 o0, o1;
#pragma unroll
      for (int e = 0; e < 4; ++e) {
        o0[e] = pack2(tile[(kc + 2 * e) * 65 + n], tile[(kc + 2 * e + 1) * 65 + n]);
        o1[e] = pack2(tile[(kc + 8 + 2 * e) * 65 + n], tile[(kc + 8 + 2 * e + 1) * 65 + n]);
      }
      u16* d = dst + (size_t)dr * ldd + k0 + kc;
      *(u32x4*)d = o0; *(u32x4*)(d + 8) = o1;
    }
  }
  __syncthreads();
}
DEVI int win_row(int n) {
  if (n < 1280) return n;
  if (n < 1600) return 1408 + (n - 1280);
  if (n < 1632) return 1280 + (n - 1600);
  if (n < INW) return 1408 + 320 + (n - 1632);
  return -1;
}
constexpr int TR_IN = 16 * 42, TR_OUT = 256, TR_UQ = 18, TR_UKV = 16, TR_E = 4096, TR_S = 64;
constexpr int TR_P1 = TR_IN + TR_OUT + TR_UQ + TR_UKV;
constexpr int TR_P2 = 3 * TR_E + 3 * TR_S;
DEVI void prep_w1_tile(const Params& p, int l, int it, float* tile) {
  if (it < TR_IN) { tr_tile(p.tid, pin(p, I_WIN) + (size_t)l * 1024 * INW, INW, (u16*)(p.ws + O_WINT), LDW, [](int n) { return win_row(n); }, (it / 42) * 64, (it % 42) * 64, tile); return; }
  it -= TR_IN;
  if (it < TR_OUT) { tr_tile(p.tid, pin(p, I_WOUT) + (size_t)l * 1024 * 1024, 1024, (u16*)(p.ws + O_WOUTT), LDW, [](int n) { return n; }, (it / 16) * 64, (it % 16) * 64, tile); return; }
  it -= TR_OUT;
  if (it < TR_UQ) { tr_tile(p.tid, pin(p, I_WUQ) + (size_t)l * 192 * 384, 384, (u16*)(p.ws + O_WUQT), 192, [](int n) { return n; }, (it / 6) * 64, (it % 6) * 64, tile); return; }
  it -= TR_UQ;
  tr_tile(p.tid, pin(p, I_WUKV) + (size_t)l * 128 * 512, 512, (u16*)(p.ws + O_WUKVT), 128,
          [](int n) { const int h = n >> 7, j = n & 127; return j < 64 ? h * 64 + j : 256 + h * 64 + (j - 64); }, (it / 8) * 64, (it % 8) * 64, tile);
}
DEVI void prep_w2_tile(const Params& p, int l, int it, float* tile) {
  if (it < 2 * TR_E) {
    const int which = it / TR_E; it %= TR_E;
    const int e = it >> 6, tt = it & 63;
    const float* src = pin(p, which ? I_WU : I_WG) + ((size_t)l * NE + e) * 1024 * 256;
    tr_tile(p.tid, src, 256, (u16*)(p.ws + O_WGUT) + (size_t)e * 512 * LDW, LDW, [which](int n) { return 2 * n + which; }, (tt >> 2) * 64, (tt & 3) * 64, tile); return;
  }
  it -= 2 * TR_E;
  if (it < TR_E) {
    const int e = it >> 6, tt = it & 63;
    const float* src = pin(p, I_WD) + ((size_t)l * NE + e) * 256 * 1024;
    tr_tile(p.tid, src, 1024, (u16*)(p.ws + O_WDT) + (size_t)e * 1024 * 256, 256, [](int n) { return n; }, (tt >> 4) * 64, (tt & 15) * 64, tile); return;
  }
  it -= TR_E;
  if (it < 2 * TR_S) {
    const int which = it / TR_S; const int tt = it % TR_S;
    const float* src = pin(p, which ? I_SU : I_SG) + (size_t)l * 1024 * 256;
    tr_tile(p.tid, src, 256, (u16*)(p.ws + O_WGUT) + (size_t)64 * 512 * LDW, LDW, [which](int n) { return 2 * n + which; }, (tt >> 2) * 64, (tt & 3) * 64, tile); return;
  }
  it -= 2 * TR_S;
  { const int tt = it;
    const float* src = pin(p, I_SD) + (size_t)l * 256 * 1024;
    tr_tile(p.tid, src, 1024, (u16*)(p.ws + O_WDT) + (size_t)64 * 1024 * 256, 256, [](int n) { return n; }, (tt >> 4) * 64, (tt & 15) * 64, tile); }
}
DEVI void st_prep_w1(const Params& p, int l, int vb, int nvb, char* smem) {
  float* tile = (float*)smem;
  if (vb == 0 && p.tid < 64) ((int*)(p.ws + O_CNT))[p.tid] = 0;
  for (int e = vb * 256 + p.tid; e < 144 * 128; e += nvb * 256) {
    const int r = e >> 7, c8 = e & 127;
    const int row = r < 96 ? 1312 + r : 2768 + (r - 96);
    *(u32x4*)((u16*)(p.ws + O_WINT) + (size_t)row * LDW + c8 * 8) = __builtin_bit_cast(u32x4, fzero4());
  }
  for (int item = vb; item < TR_P1; item += nvb) prep_w1_tile(p, l, item, tile);
}

DEVI void st_norm1(const Params& p, int l, int vb, int nvb) {
  const int lane = p.tid & 63, wid = p.tid >> 6;
  const float* g = pin(p, I_N1G) + l * 1024;
  for (int t4 = (vb * 4 + wid) * 4; t4 < T; t4 += nvb * 16) {
    const int mv = tok_mv(t4);
    const float* sh = modp(p, l, mv, 0); const float* sc = modp(p, l, mv, 1);
    f32x4 v[4][4]; float ss[4];
#pragma unroll
    for (int u = 0; u < 4; ++u) {
      const int t = t4 + u;
      const f32x4* xr = (const f32x4*)(t < TL ? pin(p, I_X) + (size_t)t * 1024 : pin(p, I_CTX) + (size_t)(t - TL) * 1024);
#pragma unroll
      for (int i = 0; i < 4; ++i) v[u][i] = xr[i * 64 + lane];
    }
#pragma unroll
    for (int u = 0; u < 4; ++u) {
      float a = 0.f;
#pragma unroll
      for (int i = 0; i < 4; ++i) a += v[u][i][0] * v[u][i][0] + v[u][i][1] * v[u][i][1] + v[u][i][2] * v[u][i][2] + v[u][i][3] * v[u][i][3];
      ss[u] = a;
    }
#pragma unroll
    for (int o = 32; o >= 1; o >>= 1) {
#pragma unroll
      for (int u = 0; u < 4; ++u) ss[u] += __shfl_xor(ss[u], o);
    }
#pragma unroll
    for (int i = 0; i < 4; ++i) {
      const int c = i * 256 + lane * 4;
      const f32x4 gg = *(const f32x4*)(g + c), s4 = *(const f32x4*)(sc + c), h4 = *(const f32x4*)(sh + c);
      const f32x4 gs = gg * (1.f + s4);
#pragma unroll
      for (int u = 0; u < 4; ++u) {
        const float rstd = rsqrtf(ss[u] * (1.f / 1024.f) + 1e-6f);
        const f32x4 o = v[u][i] * rstd * gs + h4;
        u32x2 pk; pk[0] = pack2(o[0], o[1]); pk[1] = pack2(o[2], o[3]);
        *(u32x2*)((u16*)(p.ws + O_H) + (size_t)(t4 + u) * LDH + c) = pk;
      }
    }
  }
}

constexpr int GLD = 72;
typedef const __attribute__((address_space(1))) unsigned gcu32;
typedef __attribute__((address_space(3))) unsigned lu32;
template <bool SWAP, class ARow>
DEVI void gemm_core(int tid, ARow arow, const u16* __restrict__ Bt, int ldb, int K, f32x4 (&acc)[4][4], char* smem) {
  constexpr int TILE = 128 * 64;
  u16* sbuf = (u16*)smem;
  const int lane = tid & 63, wid = tid >> 6, wr = wid >> 1, wc = wid & 1, fr = lane & 15, fq = lane >> 4;
  const u16* ap[4]; const u16* bp[4];
#pragma unroll
  for (int i = 0; i < 4; ++i) {
    const int q = tid + 256 * i, row = q >> 3, cs = (q & 7) ^ (row & 7);
    ap[i] = arow(row) + cs * 8; bp[i] = Bt + (size_t)row * ldb + cs * 8;
  }
  const int nk = K >> 6;
  auto stage = [&](int kt, int buf) {
    int off = kt * 64; asm volatile("" : "+s"(off));
    u16* dA = sbuf + buf * 2 * TILE + tid * 8; u16* dB = dA + TILE;
#pragma unroll
    for (int i = 0; i < 4; ++i) {
      __builtin_amdgcn_global_load_lds((gcu32*)(ap[i] + off), (lu32*)(dA + i * 2048), 16, 0, 0);
      __builtin_amdgcn_global_load_lds((gcu32*)(bp[i] + off), (lu32*)(dB + i * 2048), 16, 0, 0);
    }
  };
  auto compute = [&](int buf) {
    const u16* sA = sbuf + buf * 2 * TILE; const u16* sB = sA + TILE;
#pragma unroll
    for (int ks = 0; ks < 2; ++ks) {
      bf16x8 af[4], bfr[4];
#pragma unroll
      for (int m = 0; m < 4; ++m) { const int R = wr * 64 + m * 16 + fr; af[m] = *(const bf16x8*)&sA[R * 64 + (((ks * 4 + fq) ^ (R & 7)) << 3)]; }
#pragma unroll
      for (int n = 0; n < 4; ++n) { const int R = wc * 64 + n * 16 + fr; bfr[n] = *(const bf16x8*)&sB[R * 64 + (((ks * 4 + fq) ^ (R & 7)) << 3)]; }
#pragma unroll
      for (int m = 0; m < 4; ++m)
#pragma unroll
        for (int n = 0; n < 4; ++n) acc[m][n] = SWAP ? MFMA16(af[m], bfr[n], acc[m][n]) : MFMA16(bfr[n], af[m], acc[m][n]);
    }
  };
#pragma unroll
  for (int m = 0; m < 4; ++m)
#pragma unroll
    for (int n = 0; n < 4; ++n) acc[m][n] = fzero4();
  __syncthreads();
  stage(0, 0);
  asm volatile("s_waitcnt vmcnt(0)" ::: "memory");
  __syncthreads();
  for (int kt = 0; kt < nk; ++kt) {
    if (kt + 1 < nk) stage(kt + 1, (kt + 1) & 1);
    compute(kt & 1);
    asm volatile("s_waitcnt vmcnt(0)" ::: "memory");
    __syncthreads();
  }
}
template <class ARow, class Epi>
DEVI void gemm128(int tid, ARow arow, const u16* __restrict__ Bt, int ldb, int K, Epi epi, char* smem) {
  f32x4 acc[4][4];
  gemm_core<false>(tid, arow, Bt, ldb, K, acc, smem);
  const int lane = tid & 63, wid = tid >> 6, wr = wid >> 1, wc = wid & 1, fr = lane & 15, fq = lane >> 4;
#pragma unroll
  for (int m = 0; m < 4; ++m)
#pragma unroll
    for (int n = 0; n < 4; ++n) epi(wr * 64 + m * 16 + fr, wc * 64 + n * 16 + fq * 4, acc[m][n]);
}

DEVI void rope4(const f32x4 x1, const f32x4 x2, const f32x2* rp, bool lat, float scale, u32x2& o1, u32x2& o2) {
  f32x4 s = fzero4(), c = s + 1.f;
  if (lat) {
    const f32x4 a = *(const f32x4*)rp, b = *(const f32x4*)(rp + 2);
    c = f32x4{a[0], a[2], b[0], b[2]}; s = f32x4{a[1], a[3], b[1], b[3]};
  }
  const f32x4 y1 = (x1 * c - x2 * s) * scale, y2 = (x2 * c + x1 * s) * scale;
  o1[0] = pack2(y1[0], y1[1]); o1[1] = pack2(y1[2], y1[3]);
  o2[0] = pack2(y2[0], y2[1]); o2[1] = pack2(y2[2], y2[3]);
}
DEVI void inproj_item(const Params& p, int item, char* smem) {
  const u16* H = (const u16*)(p.ws + O_H); const u16* W = (const u16*)(p.ws + O_WINT);
  const f32x2* ROPE = (const f32x2*)(p.ws + O_ROPE);
  const int tid = p.tid, lane = tid & 63, wid = tid >> 6, wr = wid >> 1, wc = wid & 1, fr = lane & 15, fq = lane >> 4;
  {
    const int m0 = (item / 22) * 128, nt = item % 22;
    const bool lat = m0 < TL;
    const int b = tok_b(m0), rowbase = tok_row(m0);
    f32x4 acc[4][4];
    auto arow = [&](int r) { return H + (size_t)(m0 + r) * LDH; };
    if (nt == 3 || nt == 8 || nt == 9) {
      gemm_core<true>(tid, arow, W + (size_t)nt * 128 * LDW, LDW, 1024, acc, smem);
      u16* vt = nt == 3 ? (u16*)(p.ws + O_VTA) + (size_t)(b * 2 + wc) * 64 * NKEY
                        : (u16*)(p.ws + O_VTB) + (size_t)(b * 4 + (nt - 8) * 2 + wc) * 64 * NKEY;
#pragma unroll
      for (int m = 0; m < 4; ++m)
#pragma unroll
        for (int n = 0; n < 4; ++n) {
          u32x2 pk; pk[0] = pack2(acc[m][n][0], acc[m][n][1]); pk[1] = pack2(acc[m][n][2], acc[m][n][3]);
          *(u32x2*)(vt + (size_t)(n * 16 + fr) * NKEY + rowbase + wr * 64 + m * 16 + (((fq & 1) << 1) | (fq >> 1)) * 4) = pk;
        }
      return;
    }
    gemm_core<false>(tid, arow, W + (size_t)nt * 128 * LDW, LDW, 1024, acc, smem);
    if (nt < 3) {
      u16* dst; float scale;
      if (nt < 2) { dst = (u16*)(p.ws + O_QA) + ((size_t)(b * 4 + nt * 2 + wc) * NKEY + rowbase) * 64; scale = 0.125f * LOG2E; }
      else { dst = (u16*)(p.ws + O_KA) + ((size_t)(b * 2 + wc) * NKEY + rowbase) * 64; scale = 1.f; }
#pragma unroll
      for (int m = 0; m < 4; ++m) {
        const int rl = wr * 64 + m * 16 + fr;
#pragma unroll
        for (int pi = 0; pi < 2; ++pi) {
          const int d0 = pi * 16 + fq * 4;
          u32x2 o1, o2;
          rope4(acc[m][pi], acc[m][pi + 2], ROPE + (size_t)(rowbase + rl) * 48 + d0, lat, scale, o1, o2);
          *(u32x2*)(dst + (size_t)rl * 64 + d0) = o1; *(u32x2*)(dst + (size_t)rl * 64 + 32 + d0) = o2;
        }
      }
    } else if (nt < 8) {
      const bool isq = nt < 6;
      u16* base = isq ? (u16*)(p.ws + O_QB) : (u16*)(p.ws + O_KB);
      const float scale = isq ? 0.17677669529663687f * LOG2E : 1.f;
      const int hm0 = ((nt - 4) & 1) * 4 + wc * 2;
#pragma unroll
      for (int m = 0; m < 4; ++m) {
        const int rl = wr * 64 + m * 16 + fr;
#pragma unroll
        for (int g = 0; g < 2; ++g) {
          u16* dst = base + ((size_t)(b * 8 + hm0 + g) * NKEY + rowbase + rl) * 32;
          u32x2 o1, o2;
          rope4(acc[m][2 * g], acc[m][2 * g + 1], ROPE + (size_t)(rowbase + rl) * 48 + 32 + fq * 4, lat, scale, o1, o2);
          *(u32x2*)(dst + fq * 4) = o1; *(u32x2*)(dst + 16 + fq * 4) = o2;
        }
      }
    } else if (nt == 10) {
      if (wc == 0) {
#pragma unroll
        for (int m = 0; m < 4; ++m) {
          const int rl = wr * 64 + m * 16 + fr;
          u32x2 o1, o2;
          rope4(acc[m][0], acc[m][1], ROPE + (size_t)(rowbase + rl) * 48 + 32 + fq * 4, lat, 1.f, o1, o2);
#pragma unroll
          for (int h = 0; h < 4; ++h) {
            u16* dst = (u16*)(p.ws + O_KC) + ((size_t)(b * 4 + h) * NKEY + rowbase + rl) * 96 + 64;
            *(u32x2*)(dst + fq * 4) = o1; *(u32x2*)(dst + 16 + fq * 4) = o2;
          }
        }
      }
    } else {
      u16* PP = (u16*)(p.ws + O_PP);
#pragma unroll
      for (int m = 0; m < 4; ++m)
#pragma unroll
        for (int n = 0; n < 4; ++n) {
          u32x2 pk; pk[0] = pack2(acc[m][n][0], acc[m][n][1]); pk[1] = pack2(acc[m][n][2], acc[m][n][3]);
          *(u32x2*)(PP + (size_t)(m0 + wr * 64 + m * 16 + fr) * LDPP + (nt - 11) * 128 + wc * 64 + n * 16 + fq * 4) = pk;
        }
    }
  }
}

DEVI void st_tokprep(const Params& p, int l, int vb, int nvb) {
  const int lane = p.tid & 63, wid = p.tid >> 6;
  const u16* PP = (const u16*)(p.ws + O_PP);
  u16* GQ = (u16*)(p.ws + O_GQ); u16* GK = (u16*)(p.ws + O_GK); u16* GV = (u16*)(p.ws + O_GV);
  float* GG = (float*)(p.ws + O_GG); float* GB = (float*)(p.ws + O_GBETA);
  u16* CQN = (u16*)(p.ws + O_CQN); u16* CKVN = (u16*)(p.ws + O_CKVN);
  const float* cwp = pin(p, I_CONVW) + (size_t)l * 5 * 768;
  f32x2 cw[6][5];
#pragma unroll
  for (int i = 0; i < 6; ++i)
#pragma unroll
    for (int j = 0; j < 5; ++j) cw[i][j] = *(const f32x2*)(cwp + j * 768 + 2 * lane + 128 * i);
  const float* gq = pin(p, I_MQG) + l * 192; const float* gkv = pin(p, I_MKVG) + l * 128;
  const float gq0 = gq[lane], gq1 = gq[64 + lane], gq2 = gq[128 + lane], gk0 = gkv[lane], gk1 = gkv[64 + lane];
  for (int t = vb * 4 + wid; t < T; t += nvb * 4) {
    int base, pos, len;
    if (t < TL) { base = t & ~(SEQ - 1); pos = t & (SEQ - 1); len = SEQ; } else { int j = t - TL; base = TL + (j & ~(CTXL - 1)); pos = j & (CTXL - 1); len = CTXL; }
    unsigned xin[5][6];
#pragma unroll
    for (int j = 0; j < 5; ++j) {
      const int pp = pos + j - 2;
      const bool ok = pp >= 0 && pp < len;
      const u16* row = PP + (size_t)(base + (ok ? pp : pos)) * LDPP + PP_DQKV + 2 * lane;
#pragma unroll
      for (int i = 0; i < 6; ++i) { unsigned v = *(const unsigned*)(row + 128 * i); xin[j][i] = ok ? v : 0u; }
    }
    const u16* pr = PP + (size_t)t * LDPP;
    const float q0 = bf2f(pr[PP_CQ + lane]), q1 = bf2f(pr[PP_CQ + 64 + lane]), q2 = bf2f(pr[PP_CQ + 128 + lane]);
    const float k0 = bf2f(pr[PP_CKV + lane]), k1 = bf2f(pr[PP_CKV + 64 + lane]);
    const float gate_in = lane < 16 ? bf2f(pr[PP_GATE + lane]) : 0.f;
#pragma unroll
    for (int i = 0; i < 6; ++i) {
      float a0 = 0.f, a1 = 0.f;
#pragma unroll
      for (int j = 0; j < 5; ++j) { a0 += cw[i][j][0] * bflo(xin[j][i]); a1 += cw[i][j][1] * bfhi(xin[j][i]); }
      float y0 = siluf(a0), y1 = siluf(a1);
      const int c = 2 * lane + 128 * i;
      if (i < 4) {
        const float ss = half_sum(y0 * y0 + y1 * y1);
        const float r = rsqrtf(ss + 1e-6f) * (i < 2 ? 0.125f : 1.f);
        u16* dst = i < 2 ? GQ + (size_t)t * 256 + c : GK + (size_t)t * 256 + (c - 256);
        *(unsigned*)dst = pack2(y0 * r, y1 * r);
      } else *(unsigned*)(GV + (size_t)t * 256 + (c - 512)) = pack2(y0, y1);
    }
    if (lane < 16) {
      const int which = lane >> 2, hd = lane & 3;
      if (which < 2) {
        const float al = which ? pin(p, I_ALB)[l * 4 + hd] : pin(p, I_ALF)[l * 4 + hd];
        const float dt = which ? pin(p, I_DTB)[l * 4 + hd] : pin(p, I_DTF)[l * 4 + hd];
        const float xx = gate_in + dt;
        const float sp = fmaxf(xx, 0.f) + log1pf(expf(-fabsf(xx)));
        GG[((size_t)which * T + t) * 4 + hd] = -expf(al) * sp;
      } else GB[((size_t)(which - 2) * T + t) * 4 + hd] = sigmf(gate_in);
    }
    {
      float ss = q0 * q0 + q1 * q1 + q2 * q2, s2 = k0 * k0 + k1 * k1;
#pragma unroll
      for (int o = 32; o >= 1; o >>= 1) { ss += __shfl_xor(ss, o); s2 += __shfl_xor(s2, o); }
      const float rs = rsqrtf(ss * (1.f / 192.f) + 1e-6f), r2 = rsqrtf(s2 * (1.f / 128.f) + 1e-6f);
      u16* d = CQN + (size_t)t * 192;
      d[lane] = f2bf(q0 * rs * gq0); d[64 + lane] = f2bf(q1 * rs * gq1); d[128 + lane] = f2bf(q2 * rs * gq2);
      u16* d2 = CKVN + (size_t)t * 128;
      d2[lane] = f2bf(k0 * r2 * gk0); d2[64 + lane] = f2bf(k1 * r2 * gk1);
    }
  }
}

DEVI void mla_up_tile(const Params& p, int mt, int nn, char* smem) {
  const int tid = p.tid, lane = tid & 63, wid = tid >> 6, wr = wid >> 1, wc = wid & 1, fr = lane & 15, fq = lane >> 4;
  const int m0 = mt * 128;
  const bool lat = m0 < TL;
  const int b = tok_b(m0), rowbase = tok_row(m0);
  f32x4 acc[4][4];
  if (nn < 3) {
    const u16* CQN = (const u16*)(p.ws + O_CQN);
    gemm_core<false>(tid, [&](int r) { return CQN + (size_t)(m0 + r) * 192; }, (const u16*)(p.ws + O_WUQT) + (size_t)nn * 128 * 192, 192, 192, acc, smem);
    const f32x2* ROPE = (const f32x2*)(p.ws + O_ROPE);
    const float scale = 0.10206207261596577f * LOG2E;
    u16* QC = (u16*)(p.ws + O_QC);
#pragma unroll
    for (int m = 0; m < 4; ++m) {
      const int rl = wr * 64 + m * 16 + fr;
#pragma unroll
      for (int n = 0; n < 4; ++n) {
        const int cb = nn * 128 + wc * 64 + n * 16;
        const int h = cb / 96, db = cb - h * 96;
        u16* dst = QC + ((size_t)(b * 4 + h) * NKEY + rowbase + rl) * 96;
        if (db < 64) {
          u32x2 pk; pk[0] = pack2(acc[m][n][0] * scale, acc[m][n][1] * scale); pk[1] = pack2(acc[m][n][2] * scale, acc[m][n][3] * scale);
          *(u32x2*)(dst + db + fq * 4) = pk;
        } else if (db == 64 && n < 3) {
          u32x2 o1, o2;
          rope4(acc[m][n], acc[m][n + 1], ROPE + (size_t)(rowbase + rl) * 48 + 32 + fq * 4, lat, scale, o1, o2);
          *(u32x2*)(dst + 64 + fq * 4) = o1; *(u32x2*)(dst + 80 + fq * 4) = o2;
        }
      }
    }
  } else {
    const u16* CKVN = (const u16*)(p.ws + O_CKVN);
    auto arow = [&](int r) { return CKVN + (size_t)(m0 + r) * 128; };
    const u16* Wt = (const u16*)(p.ws + O_WUKVT) + (size_t)(nn - 3) * 128 * 128;
    if (nn < 5) {
      gemm_core<false>(tid, arow, Wt, 128, 128, acc, smem);
      u16* KC = (u16*)(p.ws + O_KC) + ((size_t)(b * 4 + (nn - 3) * 2 + wc) * NKEY + rowbase) * 96;
#pragma unroll
      for (int m = 0; m < 4; ++m)
#pragma unroll
        for (int n = 0; n < 4; ++n) {
          u32x2 pk; pk[0] = pack2(acc[m][n][0], acc[m][n][1]); pk[1] = pack2(acc[m][n][2], acc[m][n][3]);
          *(u32x2*)(KC + (size_t)(wr * 64 + m * 16 + fr) * 96 + n * 16 + fq * 4) = pk;
        }
    } else {
      gemm_core<true>(tid, arow, Wt, 128, 128, acc, smem);
      u16* vt = (u16*)(p.ws + O_VTC) + (size_t)(b * 4 + (nn - 5) * 2 + wc) * 64 * NKEY;
#pragma unroll
      for (int m = 0; m < 4; ++m)
#pragma unroll
        for (int n = 0; n < 4; ++n) {
          u32x2 pk; pk[0] = pack2(acc[m][n][0], acc[m][n][1]); pk[1] = pack2(acc[m][n][2], acc[m][n][3]);
          *(u32x2*)(vt + (size_t)(n * 16 + fr) * NKEY + rowbase + wr * 64 + m * 16 + (((fq & 1) << 1) | (fq >> 1)) * 4) = pk;
        }
    }
  }
}
DEVI int permcol(int x) { return (x & 32) + 8 * ((x >> 2) & 3) + 4 * ((x >> 4) & 1) + (x & 3); }
DEVI int cidx(int d, int e) { return ((((e >> 4) * 4 + (d >> 4)) * 64) + (e & 15) + 16 * ((d >> 2) & 3)) * 4 + (d & 3); }
DEVI int gdn_chunk_t0(int ci) { return ci < 256 ? (ci >> 7) * SEQ + (ci & 127) * 64 : TL + ((ci - 256) >> 2) * CTXL + ((ci - 256) & 3) * 64; }

DEVI void gdn_chunk_item(const Params& p, int item, char* smem) {
  u16* sK = (u16*)smem;
  float* sA = (float*)(smem + 9216);
  u16* sXt = (u16*)smem;
  u16* sAt = (u16*)(smem + 26624);
  u16* sKt = (u16*)(smem + 35840);
  float* sX = (float*)(smem + 45056);
  float* sgc = (float*)(smem + 77824); float* sbeta = sgc + 64; float* seg = sbeta + 64; float* skd = seg + 64;
  const u16* GQ = (const u16*)(p.ws + O_GQ); const u16* GK = (const u16*)(p.ws + O_GK); const u16* GV = (const u16*)(p.ws + O_GV);
  const float* GG = (const float*)(p.ws + O_GG); const float* GB = (const float*)(p.ws + O_GBETA);
  u16* GM = (u16*)(p.ws + O_GM); u16* GQP = (u16*)(p.ws + O_GQP); u16* GN = (u16*)(p.ws + O_GN); u16* GLO = (u16*)(p.ws + O_GLO);
  const int tid = p.tid, lane = tid & 63, w = tid >> 6, i15 = lane & 15, q = lane >> 4;
  {
    const int ci = item >> 3, hd = (item >> 1) & 3, dir = item & 1;
    const int t0 = gdn_chunk_t0(ci);
    auto tok = [&](int i) { return dir ? t0 + 63 - i : t0 + i; };
    __syncthreads();
    if (tid < 64) {
      float g = GG[((size_t)dir * T + tok(tid)) * 4 + hd];
#pragma unroll
      for (int o = 1; o < 64; o <<= 1) { float u = __shfl_up(g, o); if (lane >= o) g += u; }
      const float gl = __shfl(g, 63);
      sgc[tid] = g; sbeta[tid] = GB[((size_t)dir * T + tok(tid)) * 4 + hd]; seg[tid] = expf(g); skd[tid] = expf(gl - g);
    }
    __syncthreads();
    const float eglast = seg[63];
#pragma unroll
    for (int i = 0; i < 2; ++i) {
      const int ch = tid + 256 * i, j = ch >> 3, cc = ch & 7;
      const u32x4 kv = *(const u32x4*)(GK + (size_t)tok(j) * 256 + hd * 64 + cc * 8);
      *(u32x4*)&sK[j * 72 + cc * 8] = kv;
      const float kd = skd[j];
#pragma unroll
      for (int e = 0; e < 4; ++e) {
        sKt[(cc * 8 + 2 * e) * 72 + j] = f2bf(bf2f((u16)(kv[e] & 0xffff)) * kd);
        sKt[(cc * 8 + 2 * e + 1) * 72 + j] = f2bf(bf2f((u16)(kv[e] >> 16)) * kd);
      }
    }
#pragma unroll
    for (int i = 0; i < 2; ++i) {
      const int ch = tid + 256 * i, j = ch >> 3, cc = ch & 7;
      const u32x4 vv = *(const u32x4*)(GV + (size_t)tok(j) * 256 + hd * 64 + cc * 8);
      const float bj = sbeta[j];
      float* d = sX + j * 128 + cc * 8;
#pragma unroll
      for (int e = 0; e < 4; ++e) { d[2 * e] = bflo(vv[e]) * bj; d[2 * e + 1] = bfhi(vv[e]) * bj; }
    }
    __syncthreads();
    for (int e = tid; e < 64 * 64; e += 256) {
      const int j = e >> 6, c = e & 63;
      sX[j * 128 + 64 + c] = bf2f(sK[j * 72 + c]) * sbeta[j] * seg[j];
    }
    {
      f32x4 kk[4], qk[4];
#pragma unroll
      for (int nt = 0; nt < 4; ++nt) { kk[nt] = fzero4(); qk[nt] = fzero4(); }
#pragma unroll
      for (int ks = 0; ks < 2; ++ks) {
        const bf16x8 ak = *(const bf16x8*)&sK[(16 * w + i15) * 72 + ks * 32 + q * 8];
        const bf16x8 aq = *(const bf16x8*)(GQ + (size_t)tok(16 * w + i15) * 256 + hd * 64 + ks * 32 + q * 8);
#pragma unroll
        for (int nt = 0; nt < 4; ++nt) {
          const bf16x8 bk = *(const bf16x8*)&sK[(16 * nt + i15) * 72 + ks * 32 + q * 8];
          kk[nt] = MFMA16(ak, bk, kk[nt]); qk[nt] = MFMA16(aq, bk, qk[nt]);
        }
      }
#pragma unroll
      for (int nt = 0; nt < 4; ++nt)
#pragma unroll
        for (int r = 0; r < 4; ++r) {
          const int i = 16 * w + 4 * q + r, j = 16 * nt + i15;
          const float dec = i >= j ? expf(sgc[i] - sgc[j]) : 0.f;
          sA[i * 68 + j] = i > j ? sbeta[i] * kk[nt][r] * dec : 0.f;
          sAt[i * 72 + j] = f2bf(i >= j ? qk[nt][r] * dec : 0.f);
        }
    }
    __syncthreads();
    if (tid < 128) {
      const int c = tid;
      for (int ib = 0; ib < 16; ++ib) {
        float a0 = sX[(4 * ib) * 128 + c], a1 = sX[(4 * ib + 1) * 128 + c], a2 = sX[(4 * ib + 2) * 128 + c], a3 = sX[(4 * ib + 3) * 128 + c];
#pragma unroll 4
        for (int g = 0; g < ib; ++g) {
          const float x0 = sX[(4 * g) * 128 + c], x1 = sX[(4 * g + 1) * 128 + c], x2 = sX[(4 * g + 2) * 128 + c], x3 = sX[(4 * g + 3) * 128 + c];
          const f32x4 r0 = *(const f32x4*)&sA[(4 * ib) * 68 + 4 * g], r1 = *(const f32x4*)&sA[(4 * ib + 1) * 68 + 4 * g];
          const f32x4 r2 = *(const f32x4*)&sA[(4 * ib + 2) * 68 + 4 * g], r3 = *(const f32x4*)&sA[(4 * ib + 3) * 68 + 4 * g];
          a0 -= r0[0] * x0 + r0[1] * x1 + r0[2] * x2 + r0[3] * x3;
          a1 -= r1[0] * x0 + r1[1] * x1 + r1[2] * x2 + r1[3] * x3;
          a2 -= r2[0] * x0 + r2[1] * x1 + r2[2] * x2 + r2[3] * x3;
          a3 -= r3[0] * x0 + r3[1] * x1 + r3[2] * x2 + r3[3] * x3;
        }
        const f32x4 d1 = *(const f32x4*)&sA[(4 * ib + 1) * 68 + 4 * ib], d2 = *(const f32x4*)&sA[(4 * ib + 2) * 68 + 4 * ib], d3 = *(const f32x4*)&sA[(4 * ib + 3) * 68 + 4 * ib];
        a1 -= d1[0] * a0;
        a2 -= d2[0] * a0 + d2[1] * a1;
        a3 -= d3[0] * a0 + d3[1] * a1 + d3[2] * a2;
        sX[(4 * ib) * 128 + c] = a0; sX[(4 * ib + 1) * 128 + c] = a1; sX[(4 * ib + 2) * 128 + c] = a2; sX[(4 * ib + 3) * 128 + c] = a3;
      }
    }
    __syncthreads();
    {
      const int c = tid & 127, jh = (tid >> 7) * 32;
#pragma unroll
      for (int g = 0; g < 4; ++g) {
        u32x4 pk;
#pragma unroll
        for (int e = 0; e < 4; ++e) pk[e] = pack2(sX[(jh + 8 * g + 2 * e) * 128 + c], sX[(jh + 8 * g + 2 * e + 1) * 128 + c]);
        *(u32x4*)&sXt[c * 72 + jh + 8 * g] = pk;
      }
    }
    __syncthreads();
    {
      f32x4 r1[8], r2[8];
#pragma unroll
      for (int ct = 0; ct < 8; ++ct) { r1[ct] = fzero4(); r2[ct] = fzero4(); }
#pragma unroll
      for (int ks = 0; ks < 2; ++ks) {
        const bf16x8 aa = *(const bf16x8*)&sAt[(16 * w + i15) * 72 + ks * 32 + q * 8];
        const bf16x8 ak = *(const bf16x8*)&sKt[(16 * w + i15) * 72 + ks * 32 + q * 8];
#pragma unroll
        for (int ct = 0; ct < 8; ++ct) {
          const bf16x8 bx = *(const bf16x8*)&sXt[(16 * ct + i15) * 72 + ks * 32 + q * 8];
          r1[ct] = MFMA16(aa, bx, r1[ct]); r2[ct] = MFMA16(ak, bx, r2[ct]);
        }
      }
      const size_t ib = (size_t)item * 4096;
#pragma unroll
      for (int ct = 0; ct < 4; ++ct) {
        u32x2 a, b;
        a[0] = pack2(r1[ct][0], r1[ct][1]); a[1] = pack2(r1[ct][2], r1[ct][3]);
        b[0] = pack2(r2[ct][0], r2[ct][1]); b[1] = pack2(r2[ct][2], r2[ct][3]);
        *(u32x2*)(GLO + ib + ((ct * 4 + w) * 64 + lane) * 4) = a;
        *(u32x2*)(GN + ib + ((ct * 4 + w) * 64 + lane) * 4) = b;
      }
#pragma unroll
      for (int ct = 4; ct < 8; ++ct)
#pragma unroll
        for (int r = 0; r < 4; ++r) {
          const int row = 16 * w + 4 * q + r, col = 16 * (ct - 4) + i15;
          const float qv = bf2f(GQ[(size_t)tok(row) * 256 + hd * 64 + col]);
          GQP[ib + row * 64 + permcol(col)] = f2bf(qv * seg[row] - r1[ct][r]);
          GM[ib + row * 64 + permcol(col)] = f2bf((row == col ? eglast : 0.f) - r2[ct][r]);
        }
    }
    __syncthreads();
  }
}

DEVI void gdn_scan_chain(const Params& p, int chain, char* smem) {
  const int tid = p.tid, lane = tid & 63, w = tid >> 6, i15 = lane & 15, q = lane >> 4;
  u16* sM = (u16*)smem;
  u16* sQ = sM + 2 * 64 * 72;
  const u16* GM = (const u16*)(p.ws + O_GM); const u16* GQP = (const u16*)(p.ws + O_GQP);
  const u16* GN = (const u16*)(p.ws + O_GN); const u16* GLO = (const u16*)(p.ws + O_GLO);
  float* GO = (float*)(p.ws + O_GO);
  {
    const int b = chain >> 3, hd = (chain >> 1) & 3, dir = chain & 1;
    f32x4 S[4];
#pragma unroll
    for (int r = 0; r < 4; ++r) S[r] = fzero4();
    auto item_of = [&](int n) {
      int ci = n < 4 ? 256 + b * 4 + (dir ? 3 - n : n) : b * 128 + (dir ? 127 - (n - 4) : (n - 4));
      return ci * 8 + hd * 2 + dir;
    };
    u32x4 pm[2], pq[2]; u32x2 pn[4], pl[4];
    auto prefetch = [&](int n) {
      const size_t base = (size_t)item_of(n) * 4096;
#pragma unroll
      for (int i = 0; i < 2; ++i) {
        const int ch = tid + 256 * i;
        pm[i] = *(const u32x4*)(GM + base + ch * 8);
        pq[i] = *(const u32x4*)(GQP + base + ch * 8);
      }
#pragma unroll
      for (int rb = 0; rb < 4; ++rb) {
        pn[rb] = *(const u32x2*)(GN + base + ((w * 4 + rb) * 64 + lane) * 4);
        pl[rb] = *(const u32x2*)(GLO + base + ((w * 4 + rb) * 64 + lane) * 4);
      }
    };
    prefetch(0);
    __syncthreads();
    for (int n = 0; n < 132; ++n) {
      const int buf = n & 1;
      u16* bM = sM + buf * 64 * 72; u16* bQ = sQ + buf * 64 * 72;
#pragma unroll
      for (int i = 0; i < 2; ++i) {
        const int ch = tid + 256 * i, row = ch >> 3, cc = ch & 7;
        *(u32x4*)&bM[row * 72 + cc * 8] = pm[i];
        *(u32x4*)&bQ[row * 72 + cc * 8] = pq[i];
      }
      f32x4 accs[4], acco[4];
#pragma unroll
      for (int rb = 0; rb < 4; ++rb) {
        accs[rb] = f32x4{bf2f((u16)(pn[rb][0] & 0xffff)), bf2f((u16)(pn[rb][0] >> 16)), bf2f((u16)(pn[rb][1] & 0xffff)), bf2f((u16)(pn[rb][1] >> 16))};
        acco[rb] = f32x4{bf2f((u16)(pl[rb][0] & 0xffff)), bf2f((u16)(pl[rb][0] >> 16)), bf2f((u16)(pl[rb][1] & 0xffff)), bf2f((u16)(pl[rb][1] >> 16))};
      }
      const int ci = n < 4 ? 256 + b * 4 + (dir ? 3 - n : n) : b * 128 + (dir ? 127 - (n - 4) : (n - 4));
      const int t0 = gdn_chunk_t0(ci);
      __syncthreads();
      if (n + 1 < 132) prefetch(n + 1);
      bf16x8 sb[2];
#pragma unroll
      for (int kb = 0; kb < 2; ++kb)
#pragma unroll
        for (int jj = 0; jj < 8; ++jj) sb[kb][jj] = (short)f2bf(S[2 * kb + (jj >> 2)][jj & 3]);
#pragma unroll
      for (int kb = 0; kb < 2; ++kb)
#pragma unroll
        for (int rb = 0; rb < 4; ++rb) {
          const bf16x8 am = *(const bf16x8*)&bM[(rb * 16 + i15) * 72 + kb * 32 + q * 8];
          const bf16x8 aq = *(const bf16x8*)&bQ[(rb * 16 + i15) * 72 + kb * 32 + q * 8];
          accs[rb] = MFMA16(am, sb[kb], accs[rb]);
          acco[rb] = MFMA16(aq, sb[kb], acco[rb]);
        }
#pragma unroll
      for (int rb = 0; rb < 4; ++rb) {
        S[rb] = accs[rb];
#pragma unroll
        for (int r = 0; r < 4; ++r) {
          const int i = rb * 16 + q * 4 + r;
          const int t = dir ? t0 + 63 - i : t0 + i;
          GO[(size_t)dir * T * 256 + (size_t)t * 256 + hd * 64 + w * 16 + i15] = acco[rb][r];
        }
      }
    }
    __syncthreads();
  }
}


template <int DQK>
DEVI void attn_run(int tid, const u16* __restrict__ Qp, int qrow0, const u16* __restrict__ Kp, const u16* __restrict__ Vtp,
                   int a0, int a1, int b0, int b1, int qpos0, float sink2, f32x16 (&O)[2], char* smem) {
  constexpr int KLD = DQK + 8, NS = DQK / 16, KCH = DQK / 8, NKL = (64 * KCH) / 256;
  constexpr int BUF = 64 * KLD + 64 * 72;
  u16* sbase = (u16*)smem;
  const int lane = tid & 63, wid = tid >> 6, r31 = lane & 31, hh = lane >> 5;
  const int qrow = qrow0 + wid * 32 + r31;
  bf16x8 qf[NS];
#pragma unroll
  for (int s = 0; s < NS; ++s) qf[s] = *(const bf16x8*)(Qp + (size_t)qrow * DQK + s * 16 + hh * 8);
#pragma unroll
  for (int i = 0; i < 16; ++i) { O[0][i] = 0.f; O[1][i] = 0.f; }
  float m = -30000.f, lsum = 0.f;
  const int na = (a1 - a0) >> 6, nt = na + ((b1 - b0) >> 6);
  const int qpos = qpos0 + wid * 32 + r31;
  u32x4 rk[NKL], rv[2];
  auto gload = [&](int ti) {
    const int key0 = ti >= na ? b0 + (ti - na) * 64 : a0 + ti * 64;
#pragma unroll
    for (int i = 0; i < NKL; ++i) { const int q = tid + 256 * i, r = q / KCH, cc = q % KCH; rk[i] = *(const u32x4*)(Kp + (size_t)(key0 + r) * DQK + cc * 8); }
#pragma unroll
    for (int i = 0; i < 2; ++i) { const int q = tid + 256 * i, r = q >> 3, cc = q & 7; rv[i] = *(const u32x4*)(Vtp + (size_t)r * NKEY + key0 + cc * 8); }
  };
  auto lstore = [&](int buf) {
    u16* sK = sbase + buf * BUF; u16* sV = sK + 64 * KLD;
#pragma unroll
    for (int i = 0; i < NKL; ++i) { const int q = tid + 256 * i, r = q / KCH, cc = q % KCH; *(u32x4*)&sK[r * KLD + cc * 8] = rk[i]; }
#pragma unroll
    for (int i = 0; i < 2; ++i) { const int q = tid + 256 * i, r = q >> 3, cc = q & 7; *(u32x4*)&sV[r * 72 + cc * 8] = rv[i]; }
  };
  m = 0.f;
  f32x16 negm;
#pragma unroll
  for (int i = 0; i < 16; ++i) negm[i] = 0.f;
  gload(0);
  __syncthreads();
  lstore(0);
  __syncthreads();
  for (int ti = 0; ti < nt; ++ti) {
    if (ti + 1 < nt) gload(ti + 1);
    const u16* sK = sbase + (ti & 1) * BUF; const u16* sV = sK + 64 * KLD;
    const bool inB = ti >= na;
    const int key0 = inB ? b0 + (ti - na) * 64 : a0 + ti * 64;
    f32x16 st[2];
#pragma unroll
    for (int k2 = 0; k2 < 2; ++k2) {
      {
        const bf16x8 kf = *(const bf16x8*)&sK[(k2 * 32 + r31) * KLD + hh * 8];
        asm volatile("v_mfma_f32_32x32x16_bf16 %0, %1, %2, %3" : "=&v"(st[k2]) : "v"(kf), "v"(qf[0]), "v"(negm));
      }
#pragma unroll
      for (int s = 1; s < NS; ++s) {
        const bf16x8 kf = *(const bf16x8*)&sK[(k2 * 32 + r31) * KLD + s * 16 + hh * 8];
        st[k2] = MFMA32(kf, qf[s], st[k2]);
      }
    }
    if (inB) {
#pragma unroll
      for (int k2 = 0; k2 < 2; ++k2)
#pragma unroll
        for (int g = 0; g < 16; ++g) {
          const int d = key0 + k2 * 32 + (g & 3) + 8 * (g >> 2) + 4 * hh - qpos;
          if (d > 128 || d < -128) st[k2][g] = -1e30f;
        }
    }
    bf16x8 vfr[2][2][2];
#pragma unroll
    for (int k2 = 0; k2 < 2; ++k2)
#pragma unroll
      for (int s2 = 0; s2 < 2; ++s2)
#pragma unroll
        for (int dvt = 0; dvt < 2; ++dvt) vfr[k2][s2][dvt] = *(const bf16x8*)&sV[(dvt * 32 + r31) * 72 + k2 * 32 + s2 * 16 + 8 * hh];
    float mx = st[0][0];
#pragma unroll
    for (int g = 1; g < 16; ++g) mx = fmaxf(mx, st[0][g]);
#pragma unroll
    for (int g = 0; g < 16; ++g) mx = fmaxf(mx, st[1][g]);
    { auto rr = __builtin_amdgcn_permlane32_swap(__float_as_uint(mx), __float_as_uint(mx), false, false);
      mx = fmaxf(__uint_as_float(rr[0]), __uint_as_float(rr[1])); }
    if (ti == 0 || __any(mx > 8.f)) {
      const float delta = ti == 0 ? fmaxf(mx, -1e4f) : fmaxf(mx, 0.f);
      if (ti != 0) {
        const float alpha = __builtin_amdgcn_exp2f(-delta);
        lsum *= alpha;
#pragma unroll
        for (int i = 0; i < 16; ++i) { O[0][i] *= alpha; O[1][i] *= alpha; }
      }
      m += delta;
#pragma unroll
      for (int i = 0; i < 16; ++i) { negm[i] = -m; st[0][i] -= delta; st[1][i] -= delta; }
    }
    f32x2 ps2 = {0.f, 0.f};
#pragma unroll
    for (int k2 = 0; k2 < 2; ++k2)
#pragma unroll
      for (int g = 0; g < 16; g += 2) {
        const float p0 = __builtin_amdgcn_exp2f(st[k2][g]), p1 = __builtin_amdgcn_exp2f(st[k2][g + 1]);
        st[k2][g] = p0; st[k2][g + 1] = p1;
        ps2 += f32x2{p0, p1};
      }
    lsum += ps2[0] + ps2[1];
#pragma unroll
    for (int k2 = 0; k2 < 2; ++k2)
#pragma unroll
      for (int s2 = 0; s2 < 2; ++s2) {
        u32x4 pp;
#pragma unroll
        for (int j = 0; j < 4; ++j) pp[j] = pack2(st[k2][8 * s2 + 2 * j], st[k2][8 * s2 + 2 * j + 1]);
        const bf16x8 pf = __builtin_bit_cast(bf16x8, pp);
#pragma unroll
        for (int dvt = 0; dvt < 2; ++dvt) {
          O[dvt] = MFMA32(vfr[k2][s2][dvt], pf, O[dvt]);
        }
      }
    if (ti + 1 < nt) lstore((ti + 1) & 1);
    __syncthreads();
  }
  if (sink2 > -1e29f) {
    const float mn = fmaxf(m, sink2);
    const float alpha = __builtin_amdgcn_exp2f(m - mn);
    lsum = lsum * alpha + (hh == 0 ? __builtin_amdgcn_exp2f(sink2 - mn) : 0.f);
#pragma unroll
    for (int i = 0; i < 16; ++i) { O[0][i] *= alpha; O[1][i] *= alpha; }
  }
  const float ltot = lsum + __shfl_xor(lsum, 32);
  const float inv = 1.f / ltot;
#pragma unroll
  for (int i = 0; i < 16; ++i) { O[0][i] *= inv; O[1][i] *= inv; }
}
DEVI void attn_store(int tid, const f32x16 (&O)[2], u16* dst, int ld, int b, int qrow0, int col0) {
  const int lane = tid & 63, wid = tid >> 6, r31 = lane & 31, hh = lane >> 5;
  const int qrow = qrow0 + wid * 32 + r31;
  const int t = qrow < SEQ ? b * SEQ + qrow : TL + b * CTXL + (qrow - SEQ);
  u16* yr = dst + (size_t)t * ld + col0;
#pragma unroll
  for (int dvt = 0; dvt < 2; ++dvt)
#pragma unroll
    for (int g4 = 0; g4 < 4; ++g4) {
      u32x2 pk; pk[0] = pack2(O[dvt][g4 * 4 + 0], O[dvt][g4 * 4 + 1]); pk[1] = pack2(O[dvt][g4 * 4 + 2], O[dvt][g4 * 4 + 3]);
      *(u32x2*)(yr + dvt * 32 + 8 * g4 + 4 * hh) = pk;
    }
}
DEVI void attn_item(const Params& p, int l, int mixer, int b, int h, int qb, char* smem) {
  const bool lat = qb < 64;
  const int qrow0 = qb * 128;
  f32x16 O[2];
  if (mixer == 0) {
    attn_run<32>(p.tid, (const u16*)(p.ws + O_QB) + (size_t)(b * 8 + h) * NKEY * 32, qrow0, (const u16*)(p.ws + O_KB) + (size_t)(b * 8 + h) * NKEY * 32,
                 (const u16*)(p.ws + O_VTB) + (size_t)(b * 4 + (h >> 1)) * 64 * NKEY, lat ? 0 : SEQ, NKEY, 0, 0, 0, -1e30f, O, smem);
    attn_store(p.tid, O, (u16*)(p.ws + O_OB), 512, b, qrow0, h * 64);
  } else if (mixer == 1) {
    attn_run<96>(p.tid, (const u16*)(p.ws + O_QC) + (size_t)(b * 4 + h) * NKEY * 96, qrow0, (const u16*)(p.ws + O_KC) + (size_t)(b * 4 + h) * NKEY * 96,
                 (const u16*)(p.ws + O_VTC) + (size_t)(b * 4 + h) * 64 * NKEY, lat ? 0 : SEQ, NKEY, 0, 0, 0, -1e30f, O, smem);
    attn_store(p.tid, O, (u16*)(p.ws + O_Y), 1024, b, qrow0, 512 + h * 64);
  } else {
    const float sink2 = pin(p, I_SINK)[l * 4 + h] * LOG2E;
    const int hk = h >> 1;
    int b0 = 0, b1 = 0;
    if (lat) { b0 = (qb - 1) * 128; if (b0 < 0) b0 = 0; b1 = (qb + 2) * 128; if (b1 > SEQ) b1 = SEQ; }
    attn_run<64>(p.tid, (const u16*)(p.ws + O_QA) + (size_t)(b * 4 + h) * NKEY * 64, qrow0, (const u16*)(p.ws + O_KA) + (size_t)(b * 2 + hk) * NKEY * 64,
                 (const u16*)(p.ws + O_VTA) + (size_t)(b * 2 + hk) * 64 * NKEY, SEQ, NKEY, b0, b1, qrow0, sink2, O, smem);
    attn_store(p.tid, O, (u16*)(p.ws + O_Y), 1024, b, qrow0, h * 64);
  }
}

constexpr int SMEM_BYTES = 78848 + 64;

DEVI unsigned long long launder_ptr(unsigned long long v) {
  unsigned lo = __builtin_amdgcn_readfirstlane((unsigned)v), hi = __builtin_amdgcn_readfirstlane((unsigned)(v >> 32));
  asm volatile("s_mov_b32 %0, %1" : "=s"(lo) : "s"(lo));
  asm volatile("s_mov_b32 %0, %1" : "=s"(hi) : "s"(hi));
  return ((unsigned long long)hi << 32) | lo;
}
DEVI Params mkctx(const KArgs& a) {
  Params c;
  typedef __attribute__((address_space(1))) char gchar;
  typedef __attribute__((address_space(1))) float gfloat;
  c.ws = (char*)(gchar*)launder_ptr((unsigned long long)a.ws);
  c.out = (float*)(gfloat*)launder_ptr((unsigned long long)a.out);
  c.in = (gcfloat* const*)(c.ws + O_TAB);
  c.tid = threadIdx.x;
  asm volatile("" : "+v"(c.tid));
  return c;
}
DEVI void st_mixer_queue(const KArgs& a, int l, char* smem) {
  int* sitem = (int*)(smem + SMEM_BYTES - 16);
  const int g = blockIdx.x & 7;
  const int nctx = l == 0 ? 8 : 0;
  constexpr int NPREP = TR_P2 / 8 / 8;
  const int total = 2 + 128 + 64 + 64 + nctx + NPREP;
  for (;;) {
    const Params p = mkctx(a);
    unsigned* head = (unsigned*)(p.ws + O_BAR) + 16 + l * 8 + g;
    __syncthreads();
    if (p.tid == 0) *sitem = (int)atomicAdd(head, 1u);
    __syncthreads();
    int it = *sitem;
    if (it >= total) break;
    if (it < 2) { gdn_scan_chain(p, 2 * g + it, smem); continue; }
    it -= 2;
    if (it < 256 + nctx) {
      int mixer, b, h, qb;
      if (it < 128) { const int pr = 2 * g + (it >> 6); mixer = 0; b = pr >> 3; h = pr & 7; qb = it & 63; }
      else if (it < 256) { mixer = 1 + ((it - 128) >> 6); b = g >> 2; h = g & 3; qb = it & 63; }
      else {
        const int j = it - 256;
        if (j < 4) { const int pr = 2 * g + (j >> 1); mixer = 0; b = pr >> 3; h = pr & 7; qb = 64 + (j & 1); }
        else { mixer = 1 + ((j - 4) >> 1); b = g >> 2; h = g & 3; qb = 64 + (j & 1); }
      }
      attn_item(p, l, mixer, b, h, qb, smem);
      continue;
    }
    it -= 256 + nctx;
#pragma unroll 1
    for (int k = 0; k < 8; ++k) prep_w2_tile(p, l, (it * 8 + g) * 8 + k, (float*)smem);
  }
}

DEVI void st_mix_finish(const Params& p, int l, int vb, int nvb) {
  const int lane = p.tid & 63, wid = p.tid >> 6;
  const float* GO = (const float*)(p.ws + O_GO); const u16* PP = (const u16*)(p.ws + O_PP); const u16* OB = (const u16*)(p.ws + O_OB);
  u16* Y = (u16*)(p.ws + O_Y);
  const float lam_init = 0.8f - 0.6f * expf(-0.3f * (float)l);
  float d1 = lane < 32 ? pin(p, I_LQ1)[l * 32 + lane] * pin(p, I_LK1)[l * 32 + lane] : 0.f;
  float d2 = lane < 32 ? pin(p, I_LQ2)[l * 32 + lane] * pin(p, I_LK2)[l * 32 + lane] : 0.f;
  const float lam = expf(wave_sum(d1)) - expf(wave_sum(d2)) + lam_init;
  const int hd = lane >> 4, d0 = (lane & 15) * 4;
  const f32x4 gg = *(const f32x4*)(pin(p, I_GNG) + l * 64 + d0);
  const f32x4 dg = *(const f32x4*)(pin(p, I_DNG) + l * 64 + d0) * (1.f - lam_init);
  const int tend = l == 0 ? T : TL;
  for (int t0 = (vb * 4 + wid) * 2; t0 < tend; t0 += nvb * 8) {
    u32x2 o0[2], o1[2], zz[2]; f32x4 gf[2], gb[2];
#pragma unroll
    for (int u = 0; u < 2; ++u) {
      const size_t t = t0 + u;
      o0[u] = *(const u32x2*)(OB + t * 512 + (hd * 2) * 64 + d0);
      o1[u] = *(const u32x2*)(OB + t * 512 + (hd * 2 + 1) * 64 + d0);
      gf[u] = *(const f32x4*)(GO + t * 256 + hd * 64 + d0);
      gb[u] = *(const f32x4*)(GO + (size_t)T * 256 + t * 256 + hd * 64 + d0);
      zz[u] = *(const u32x2*)(PP + t * LDPP + PP_DZ + hd * 64 + d0);
    }
    f32x4 od[2], go[2]; float ssb[2], ssg[2];
#pragma unroll
    for (int u = 0; u < 2; ++u) {
      const f32x4 a = {bflo(o0[u][0]), bfhi(o0[u][0]), bflo(o0[u][1]), bfhi(o0[u][1])};
      const f32x4 b = {bflo(o1[u][0]), bfhi(o1[u][0]), bflo(o1[u][1]), bfhi(o1[u][1])};
      od[u] = a - lam * b; go[u] = gf[u] + gb[u];
      ssb[u] = od[u][0] * od[u][0] + od[u][1] * od[u][1] + od[u][2] * od[u][2] + od[u][3] * od[u][3];
      ssg[u] = go[u][0] * go[u][0] + go[u][1] * go[u][1] + go[u][2] * go[u][2] + go[u][3] * go[u][3];
    }
#pragma unroll
    for (int o = 8; o >= 1; o >>= 1) {
#pragma unroll
      for (int u = 0; u < 2; ++u) { ssb[u] += __shfl_xor(ssb[u], o); ssg[u] += __shfl_xor(ssg[u], o); }
    }
#pragma unroll
    for (int u = 0; u < 2; ++u) {
      const size_t t = t0 + u;
      const f32x4 yb = od[u] * (rsqrtf(ssb[u] * (1.f / 64.f) + 1e-6f)) * dg;
      const f32x4 z = {bflo(zz[u][0]), bfhi(zz[u][0]), bflo(zz[u][1]), bfhi(zz[u][1])};
      const f32x4 sz = {siluf(z[0]), siluf(z[1]), siluf(z[2]), siluf(z[3])};
      const f32x4 yd = go[u] * (rsqrtf(ssg[u] * (1.f / 64.f) + 1e-6f)) * gg * sz;
      u32x2 pb, pd;
      pb[0] = pack2(yb[0], yb[1]); pb[1] = pack2(yb[2], yb[3]);
      pd[0] = pack2(yd[0], yd[1]); pd[1] = pack2(yd[2], yd[3]);
      *(u32x2*)(Y + t * 1024 + 256 + hd * 64 + d0) = pb;
      *(u32x2*)(Y + t * 1024 + 768 + hd * 64 + d0) = pd;
    }
  }
}

constexpr int RLD = 1026;
DEVI void st_norm2_route(const Params& p, int l, int vb, int nvb, char* smem) {
  const int lane = p.tid & 63, wid = p.tid >> 6, i15 = lane & 15, q = lane >> 4;
  float* shh = (float*)smem;
  float* slog = shh + 16 * RLD;
  const float* g = pin(p, I_N2G) + l * 1024;
  const float* wr = pin(p, I_WR) + (size_t)l * 1024 * 64;
  const float bias = pin(p, I_RB)[l * 64 + lane];
  float* WTS = (float*)(p.ws + O_WTS); int* CNT = (int*)(p.ws + O_CNT); int* LIST = (int*)(p.ws + O_LIST);
  const int ntok = l == 0 ? T : TL;
  for (int grp = vb; grp < ntok / 16; grp += nvb) {
    const int tb = grp * 16 + wid * 4;
    const int mv = tok_mv(tb);
    const float* sh = modp(p, l, mv, 3); const float* sc = modp(p, l, mv, 4);
    {
      f32x4 v[4][4]; float ss[4];
#pragma unroll
      for (int u = 0; u < 4; ++u) {
        const f32x4* xr = (const f32x4*)((const float*)(p.ws + O_XA) + (size_t)(tb + u) * 1024);
#pragma unroll
        for (int i = 0; i < 4; ++i) v[u][i] = xr[i * 64 + lane];
      }
#pragma unroll
      for (int u = 0; u < 4; ++u) {
        float a = 0.f;
#pragma unroll
        for (int i = 0; i < 4; ++i) a += v[u][i][0] * v[u][i][0] + v[u][i][1] * v[u][i][1] + v[u][i][2] * v[u][i][2] + v[u][i][3] * v[u][i][3];
        ss[u] = a;
      }
#pragma unroll
      for (int o = 32; o >= 1; o >>= 1) {
#pragma unroll
        for (int u = 0; u < 4; ++u) ss[u] += __shfl_xor(ss[u], o);
      }
#pragma unroll
      for (int i = 0; i < 4; ++i) {
        const int c = i * 256 + lane * 4;
        const f32x4 gg = *(const f32x4*)(g + c), s4 = *(const f32x4*)(sc + c), h4 = *(const f32x4*)(sh + c);
        const f32x4 gs = gg * (1.f + s4);
#pragma unroll
        for (int u = 0; u < 4; ++u) {
          const float rstd = rsqrtf(ss[u] * (1.f / 1024.f) + 1e-6f);
          const f32x4 o = v[u][i] * rstd * gs + h4;
          u32x2 pk; pk[0] = pack2(o[0], o[1]); pk[1] = pack2(o[2], o[3]);
          *(u32x2*)((u16*)(p.ws + O_H) + (size_t)(tb + u) * LDH + c) = pk;
          float* d = shh + (wid * 4 + u) * RLD + c;
          *(f32x2*)d = f32x2{o[0], o[1]}; *(f32x2*)(d + 2) = f32x2{o[2], o[3]};
        }
      }
    }
    __syncthreads();
    {
      f32x4 a0 = fzero4(), a1 = a0;
      const float* ap = shh + i15 * RLD + q;
      const float* bp = wr + (size_t)q * 64 + wid * 16 + i15;
#pragma unroll 1
      for (int kb = 0; kb < 256; kb += 32) {
        float bv[32];
#pragma unroll
        for (int j = 0; j < 32; ++j) bv[j] = bp[(size_t)(4 * (kb + j)) * 64];
#pragma unroll
        for (int j = 0; j < 32; j += 2) {
          a0 = __builtin_amdgcn_mfma_f32_16x16x4f32(ap[4 * (kb + j)], bv[j], a0, 0, 0, 0);
          a1 = __builtin_amdgcn_mfma_f32_16x16x4f32(ap[4 * (kb + j) + 4], bv[j + 1], a1, 0, 0, 0);
        }
      }
#pragma unroll
      for (int r = 0; r < 4; ++r) slog[(4 * q + r) * 64 + wid * 16 + i15] = a0[r] + a1[r];
    }
    __syncthreads();
#pragma unroll 1
    for (int u = 0; u < 4; ++u) {
      const int t = tb + u;
      const float logit = slog[(wid * 4 + u) * 64 + lane];
      const float s = 1.f / (1.f + expf(-logit));
      const float c = s + bias;
      float m1 = c;
      m1 = fmaxf(m1, __shfl_xor(m1, 1)); m1 = fmaxf(m1, __shfl_xor(m1, 2)); m1 = fmaxf(m1, __shfl_xor(m1, 4));
      const unsigned long long bal = __ballot(c == m1);
      const int grpi = lane >> 3;
      const unsigned gm = (unsigned)((bal >> (grpi * 8)) & 0xffull);
      const int first = __ffs(gm) - 1;
      float m2 = ((lane & 7) == first) ? -INFINITY : c;
      m2 = fmaxf(m2, __shfl_xor(m2, 1)); m2 = fmaxf(m2, __shfl_xor(m2, 2)); m2 = fmaxf(m2, __shfl_xor(m2, 4));
      const float gs = m1 + m2;
      int grank = 0;
#pragma unroll
      for (int gg = 0; gg < 8; ++gg) { float o = __shfl(gs, gg * 8); grank += (o > gs || (o == gs && gg < grpi)) ? 1 : 0; }
      const bool gsel = grank < 4;
      const float mc = gsel ? c : -INFINITY;
      int rank = 0;
#pragma unroll
      for (int e = 0; e < 64; ++e) { float o = __shfl(mc, e); rank += (o > mc || (o == mc && e < lane)) ? 1 : 0; }
      const bool sel = gsel && rank < 6;
      const float ssum = wave_sum(sel ? s : 0.f);
      if (sel) {
        const int slot = t * 6 + rank;
        WTS[slot] = s / ssum * 2.5f;
        const int pos = atomicAdd(&CNT[lane], 1);
        LIST[(size_t)lane * T + pos] = slot;
      }
    }
    __syncthreads();
  }
}
DEVI void st_outproj(const Params& p, int l, int vb, int nvb, char* smem) {
  const u16* Y = (const u16*)(p.ws + O_Y); const u16* W = (const u16*)(p.ws + O_WOUTT); float* XA = (float*)(p.ws + O_XA);
  const int nmt = l == 0 ? 132 : 128;
  const int g = vb & 7, nmg = (nmt - g + 7) >> 3;
  for (int i = vb >> 3; i < nmg * 8; i += nvb >> 3) {
    const int m0 = (g + 8 * (i >> 3)) * 128, n0 = (i & 7) * 128;
    gemm128(p.tid, [&](int r) { return Y + (size_t)(m0 + r) * 1024; }, W + (size_t)n0 * LDW, LDW, 1024,
            [&](int r, int c, f32x4 v) {
              const int t = m0 + r; const float* gt = modp(p, l, tok_mv(t), 2) + n0 + c;
              float4* xp = (float4*)(XA + (size_t)t * 1024 + n0 + c);
              const float* xin = l == 0 ? (t < TL ? pin(p, I_X) + (size_t)t * 1024 : pin(p, I_CTX) + (size_t)(t - TL) * 1024) + n0 + c : (const float*)xp;
              float4 x = *(const float4*)xin;
              x.x += gt[0] * v[0]; x.y += gt[1] * v[1]; x.z += gt[2] * v[2]; x.w += gt[3] * v[3]; *xp = x;
              __builtin_amdgcn_sched_barrier(0);
            }, smem);
  }
}

DEVI void grp_tiles(const Params& p, int* tst, int g, int shift, int nshared) {
  __syncthreads();
  if (p.tid < 64) {
    const int* CNT = (const int*)(p.ws + O_CNT);
    const int lane = p.tid;
    int c = 0;
    if (lane < 8) c = (__hip_atomic_load(&CNT[g + 8 * lane], __ATOMIC_RELAXED, __HIP_MEMORY_SCOPE_AGENT) + (1 << shift) - 1) >> shift;
    int incl = c;
#pragma unroll
    for (int o = 1; o < 8; o <<= 1) { int u = __shfl_up(incl, o); if (lane >= o) incl += u; }
    if (lane < 8) tst[lane] = incl - c;
    if (lane == 7) { tst[8] = incl; tst[9] = incl + (nshared - g + 7) / 8; }
  }
  __syncthreads();
}
DEVI void grp_find(const int* tst, int tile, int g, int& e, int& lt) {
  int j = 0;
#pragma unroll
  for (int k = 1; k <= 8; ++k) j += tile >= tst[k] ? 1 : 0;
  if (j < 8) { e = g + 8 * j; lt = tile - tst[j]; } else { e = 64; lt = g + 8 * (tile - tst[8]); }
}
DEVI void st_moe1(const Params& p, int l, int vb, int nvb, char* smem) {
  const int* CNT = (const int*)(p.ws + O_CNT); const int* LIST = (const int*)(p.ws + O_LIST);
  const u16* H = (const u16*)(p.ws + O_H); u16* HB = (u16*)(p.ws + O_HB);
  int* sslot = (int*)(smem + 4 * 128 * GLD * 2);
  int* TST = sslot + 128;
  const int g = vb & 7;
  const int nsh = l == 0 ? T : TL;
  grp_tiles(p, TST, g, 7, nsh / 128);
  const int total = TST[9];
  for (int item = vb >> 3; item < total * 4; item += nvb >> 3) {
    const int tile = item >> 2, n0 = (item & 3) * 128;
    int e, lt; grp_find(TST, tile, g, e, lt);
    const int cnt = e < 64 ? __hip_atomic_load(&CNT[e], __ATOMIC_RELAXED, __HIP_MEMORY_SCOPE_AGENT) : nsh;
    __syncthreads();
    if (p.tid < 128) {
      int i = lt * 128 + p.tid;
      int slot = -1;
      if (i < cnt) slot = e < 64 ? LIST[(size_t)e * T + i] : NSLOT + i;
      sslot[p.tid] = slot;
    }
    __syncthreads();
    gemm128(p.tid, [&](int r) { int sl = sslot[r]; int tk = sl < 0 ? 0 : (sl < NSLOT ? sl / 6 : sl - NSLOT); return H + (size_t)tk * LDH; },
            (const u16*)(p.ws + O_WGUT) + ((size_t)e * 512 + n0) * LDW, LDW, 1024,
            [&](int r, int c, f32x4 v) {
              int sl = sslot[r]; if (sl < 0) return;
              float h0 = siluf(v[0]) * v[1], h1 = siluf(v[2]) * v[3];
              *(unsigned*)(HB + (size_t)sl * 256 + ((n0 + c) >> 1)) = pack2(h0, h1);
            }, smem);
  }
}
DEVI void st_moe2(const Params& p, int l, int vb, int nvb, char* smem) {
  const int* CNT = (const int*)(p.ws + O_CNT); const int* LIST = (const int*)(p.ws + O_LIST);
  const u16* HB = (const u16*)(p.ws + O_HB); u16* SO = (u16*)(p.ws + O_SLOT); const float* WTS = (const float*)(p.ws + O_WTS);
  constexpr int ALD = 264;
  u16* sA = (u16*)smem;
  u16* sB = sA + 64 * ALD;
  int* sslot = (int*)(sB + 2 * 128 * 72);
  int* TST = sslot + 64;
  const int tid = p.tid, lane = tid & 63, wid = tid >> 6, wr = wid >> 1, wc = wid & 1, fr = lane & 15, fq = lane >> 4;
  const int g = vb & 7;
  const int nsh = l == 0 ? T : TL;
  grp_tiles(p, TST, g, 6, nsh / 64);
  const int total = TST[9];
  for (int item = vb >> 3; item < total; item += nvb >> 3) {
    int e, lt; grp_find(TST, item, g, e, lt);
    const int cnt = e < 64 ? __hip_atomic_load(&CNT[e], __ATOMIC_RELAXED, __HIP_MEMORY_SCOPE_AGENT) : nsh;
    __syncthreads();
    if (tid < 64) { const int i = lt * 64 + tid; sslot[tid] = i < cnt ? (e < 64 ? LIST[(size_t)e * T + i] : NSLOT + i) : -1; }
    __syncthreads();
    const u16* Bbase = (const u16*)(p.ws + O_WDT) + (size_t)e * 1024 * 256;
    u32x4 rb0[4], rb1[4], rb2[4];
    const u16* bthr = Bbase + (size_t)(tid >> 3) * 256 + (tid & 7) * 8;
    auto gloadB = [&](u32x4 (&rb)[4], int bt) {
      int off = (bt >> 2) * 128 * 256 + (bt & 3) * 64;
      asm volatile("" : "+s"(off));
      const u16* src = bthr + off;
#pragma unroll
      for (int i = 0; i < 4; ++i) rb[i] = *(const u32x4*)(src + i * 32 * 256);
    };
    auto lstoreB = [&](const u32x4 (&rb)[4], int buf) {
      u16* d = sB + buf * 128 * 72;
#pragma unroll
      for (int i = 0; i < 4; ++i) { const int q = tid + 256 * i, r = q >> 3, cc = q & 7; *(u32x4*)&d[r * 72 + cc * 8] = rb[i]; }
    };
    gloadB(rb0, 0); gloadB(rb1, 1); gloadB(rb2, 2);
#pragma unroll
    for (int hf = 0; hf < 2; ++hf) {
      u32x4 ra[4];
#pragma unroll
      for (int i = 0; i < 4; ++i) { const int q = tid + 256 * (4 * hf + i), r = q >> 5, cc = q & 31; const int sl = sslot[r]; ra[i] = *(const u32x4*)(HB + (size_t)(sl < 0 ? 0 : sl) * 256 + cc * 8); }
#pragma unroll
      for (int i = 0; i < 4; ++i) { const int q = tid + 256 * (4 * hf + i), r = q >> 5, cc = q & 31; *(u32x4*)&sA[r * ALD + cc * 8] = ra[i]; }
      __builtin_amdgcn_sched_barrier(0);
    }
    int slot_m[2]; float w_m[2];
#pragma unroll
    for (int m = 0; m < 2; ++m) { const int sl = sslot[wr * 32 + m * 16 + fr]; slot_m[m] = sl; w_m[m] = (sl >= 0 && sl < NSLOT) ? WTS[sl] : 1.f; }
    lstoreB(rb0, 0); gloadB(rb0, 3);
    __syncthreads();
    f32x4 acc[2][4];
    auto compute = [&](int bt, int buf) {
      const int nt = bt >> 2, kt = bt & 3;
      const u16* b = sB + buf * 128 * 72;
      if (kt == 0) {
#pragma unroll
        for (int m = 0; m < 2; ++m)
#pragma unroll
          for (int n = 0; n < 4; ++n) acc[m][n] = fzero4();
      }
#pragma unroll
      for (int ks = 0; ks < 2; ++ks) {
        bf16x8 af[2], bfr[4];
#pragma unroll
        for (int m = 0; m < 2; ++m) af[m] = *(const bf16x8*)&sA[(wr * 32 + m * 16 + fr) * ALD + kt * 64 + ks * 32 + fq * 8];
#pragma unroll
        for (int n = 0; n < 4; ++n) bfr[n] = *(const bf16x8*)&b[(wc * 64 + n * 16 + fr) * 72 + ks * 32 + fq * 8];
#pragma unroll
        for (int m = 0; m < 2; ++m)
#pragma unroll
          for (int n = 0; n < 4; ++n) acc[m][n] = MFMA16(bfr[n], af[m], acc[m][n]);
      }
      if (kt == 3) {
#pragma unroll
        for (int m = 0; m < 2; ++m) {
          if (slot_m[m] >= 0) {
            const float w = w_m[m];
#pragma unroll
            for (int n = 0; n < 4; ++n) {
              u32x2 pk; pk[0] = pack2(acc[m][n][0] * w, acc[m][n][1] * w); pk[1] = pack2(acc[m][n][2] * w, acc[m][n][3] * w);
              *(u32x2*)(SO + (size_t)slot_m[m] * 1024 + nt * 128 + wc * 64 + n * 16 + fq * 4) = pk;
            }
          }
        }
      }
    };
#pragma unroll
    for (int bt = 0; bt < 30; bt += 3) {
      compute(bt, bt & 1);           lstoreB(rb1, (bt + 1) & 1); if (bt + 4 < 32) gloadB(rb1, bt + 4); __syncthreads(); __builtin_amdgcn_sched_barrier(0);
      compute(bt + 1, (bt + 1) & 1); lstoreB(rb2, (bt + 2) & 1); if (bt + 5 < 32) gloadB(rb2, bt + 5); __syncthreads(); __builtin_amdgcn_sched_barrier(0);
      compute(bt + 2, (bt + 2) & 1); lstoreB(rb0, (bt + 3) & 1); if (bt + 6 < 32) gloadB(rb0, bt + 6); __syncthreads(); __builtin_amdgcn_sched_barrier(0);
    }
    compute(30, 0); lstoreB(rb1, 1); __syncthreads(); __builtin_amdgcn_sched_barrier(0);
    compute(31, 1); __syncthreads();
  }
}

DEVI void st_combine(const Params& p, int l, int vb, int nvb) {
  const int lane = p.tid & 63, wid = p.tid >> 6;
  const u16* SO = (const u16*)(p.ws + O_SLOT);
  const bool last = l == 1;
  const float* gnext = last ? pin(p, I_FNG) : pin(p, I_N1G) + 1024;
  const int tend = last ? TL : T;
  for (int t0 = (vb * 4 + wid) * 2; t0 < tend; t0 += nvb * 8) {
    const int mv = tok_mv(t0);
    const float* g5 = modp(p, l, mv, 5);
    u32x4 sv[2][7][2]; f32x4 xv[2][4];
#pragma unroll
    for (int u = 0; u < 2; ++u) {
      const int t = t0 + u;
#pragma unroll
      for (int k = 0; k < 7; ++k) {
        const u16* row = SO + (size_t)(k < 6 ? t * 6 + k : NSLOT + t) * 1024;
        sv[u][k][0] = *(const u32x4*)(row + lane * 8); sv[u][k][1] = *(const u32x4*)(row + 512 + lane * 8);
      }
      const float* xr = (const float*)(p.ws + O_XA) + (size_t)t * 1024;
      xv[u][0] = *(const f32x4*)(xr + lane * 8); xv[u][1] = *(const f32x4*)(xr + lane * 8 + 4);
      xv[u][2] = *(const f32x4*)(xr + 512 + lane * 8); xv[u][3] = *(const f32x4*)(xr + 512 + lane * 8 + 4);
    }
    f32x4 gq[4];
    gq[0] = *(const f32x4*)(g5 + lane * 8); gq[1] = *(const f32x4*)(g5 + lane * 8 + 4);
    gq[2] = *(const f32x4*)(g5 + 512 + lane * 8); gq[3] = *(const f32x4*)(g5 + 512 + lane * 8 + 4);
    float ss[2];
#pragma unroll
    for (int u = 0; u < 2; ++u) {
      float acc = 0.f;
#pragma unroll
      for (int hf = 0; hf < 2; ++hf) {
        f32x4 a0 = fzero4(), a1 = a0;
#pragma unroll
        for (int k = 0; k < 7; ++k) {
          const u32x4 v = sv[u][k][hf];
          a0[0] += bflo(v[0]); a0[1] += bfhi(v[0]); a0[2] += bflo(v[1]); a0[3] += bfhi(v[1]);
          a1[0] += bflo(v[2]); a1[1] += bfhi(v[2]); a1[2] += bflo(v[3]); a1[3] += bfhi(v[3]);
        }
        xv[u][2 * hf] += gq[2 * hf] * a0; xv[u][2 * hf + 1] += gq[2 * hf + 1] * a1;
#pragma unroll
        for (int e = 0; e < 4; ++e) acc += xv[u][2 * hf][e] * xv[u][2 * hf][e] + xv[u][2 * hf + 1][e] * xv[u][2 * hf + 1][e];
      }
      ss[u] = acc;
    }
#pragma unroll
    for (int o = 32; o >= 1; o >>= 1) { ss[0] += __shfl_xor(ss[0], o); ss[1] += __shfl_xor(ss[1], o); }
    f32x4 gn[4];
    gn[0] = *(const f32x4*)(gnext + lane * 8); gn[1] = *(const f32x4*)(gnext + lane * 8 + 4);
    gn[2] = *(const f32x4*)(gnext + 512 + lane * 8); gn[3] = *(const f32x4*)(gnext + 512 + lane * 8 + 4);
    if (!last) {
      const float* sh = modp(p, 1, mv, 0); const float* sc = modp(p, 1, mv, 1);
#pragma unroll
      for (int q = 0; q < 4; ++q) {
        const int c = (q >> 1) * 512 + lane * 8 + (q & 1) * 4;
        const f32x4 s4 = *(const f32x4*)(sc + c), h4 = *(const f32x4*)(sh + c);
        const f32x4 gs = gn[q] * (1.f + s4);
#pragma unroll
        for (int u = 0; u < 2; ++u) {
          const size_t t = t0 + u;
          const float rstd = rsqrtf(ss[u] * (1.f / 1024.f) + 1e-6f);
          *(f32x4*)((float*)(p.ws + O_XA) + t * 1024 + c) = xv[u][q];
          const f32x4 o = xv[u][q] * rstd * gs + h4;
          u32x2 pk; pk[0] = pack2(o[0], o[1]); pk[1] = pack2(o[2], o[3]);
          *(u32x2*)((u16*)(p.ws + O_H) + t * LDH + c) = pk;
        }
      }
    } else {
#pragma unroll
      for (int q = 0; q < 4; ++q) {
        const int c = (q >> 1) * 512 + lane * 8 + (q & 1) * 4;
#pragma unroll
        for (int u = 0; u < 2; ++u) {
          const size_t t = t0 + u;
          const float rstd = rsqrtf(ss[u] * (1.f / 1024.f) + 1e-6f);
          *(f32x4*)(p.out + t * 1024 + c) = xv[u][q] * rstd * gn[q];
        }
      }
    }
  }
}


#define STAGE(call) { const Params p = mkctx(a); call; }

#define XB_TMO      128
#define XB_XCNT(j)  (256  + 64 * (j))
#define XB_XSUB(j)  (1280 + 64 * (j))
#define XB_XGEN(j)  (2304 + 64 * (j))
#define XB_TOP      3328
#define XB_TOPGEN   3392
#define XCD_BAR_WORDS 3456
#define XB_SPIN_CAP (1u << 20)
#define LAS __attribute__((address_space(3)))
DEVI unsigned xb_ld(unsigned* p)              { return __hip_atomic_load(p, __ATOMIC_RELAXED, __HIP_MEMORY_SCOPE_AGENT); }
DEVI unsigned xb_add(unsigned* p, unsigned v) { return __hip_atomic_fetch_add(p, v, __ATOMIC_RELAXED, __HIP_MEMORY_SCOPE_AGENT); }
DEVI unsigned xb_xcc_id() { return (unsigned)__builtin_amdgcn_s_getreg((3 << 11) | 20) & 0xFu; }
#define XB_SPIN(cond, bar) do { unsigned _sp = 0; while (cond) { __builtin_amdgcn_s_sleep(1); \
    if ((++_sp & 255u) == 0u) { if (xb_ld(&(bar)[XB_TMO])) break; if (_sp > XB_SPIN_CAP) { atomicAdd(&(bar)[XB_TMO], 1u); break; } } } } while (0)
struct XcdBarrier { unsigned* bar; unsigned x; volatile LAS unsigned* st; };
DEVI XcdBarrier xcd_barrier_post(unsigned* bar, volatile LAS unsigned* st) {
  XcdBarrier b; b.bar = bar; b.x = xb_xcc_id(); b.st = st;
  if (threadIdx.x == 0) (void)xb_add(&bar[XB_XCNT(b.x)], 1u);
  return b;
}
DEVI void xcd_barrier_complete(unsigned* bar, unsigned x, unsigned& nloc, unsigned& nx) {
  const unsigned G = gridDim.x * gridDim.y * gridDim.z;
  unsigned sum, cnt, mine, sp = 0u;
  for (;;) {
    sum = 0u; cnt = 0u; mine = 0u;
#pragma unroll
    for (unsigned j = 0; j < 16; ++j) { const unsigned c = xb_ld(&bar[XB_XCNT(j)]); sum += c; cnt += (c > 0u) ? 1u : 0u; mine = (j == x) ? c : mine; }
    if (sum == G) break;
    __builtin_amdgcn_s_sleep(1);
    if ((++sp & 255u) == 0u) { if (xb_ld(&bar[XB_TMO])) break; if (sp > XB_SPIN_CAP) { atomicAdd(&bar[XB_TMO], 1u); break; } }
  }
  nloc = mine > 0u ? mine : 1u; nx = cnt > 0u ? cnt : 1u;
}
DEVI void xcd_barrier(const XcdBarrier& b) {
  asm volatile("s_waitcnt vmcnt(0)" ::: "memory");
  __syncthreads();
  if (threadIdx.x == 0) {
    unsigned* bar = b.bar;
    __builtin_amdgcn_s_waitcnt(0);
    unsigned nloc = b.st[0], nx = b.st[1];
    if (nloc == 0u) { xcd_barrier_complete(bar, b.x, nloc, nx); b.st[0] = nloc; b.st[1] = nx; }
    const unsigned old = xb_add(&bar[XB_XSUB(b.x)], 1u);
    const unsigned gen = old / nloc;
    if (old + 1u == (gen + 1u) * nloc) {
      __builtin_amdgcn_fence(__ATOMIC_RELEASE, "agent");
      asm volatile("s_waitcnt vmcnt(0)" ::: "memory");
      const unsigned og = xb_add(&bar[XB_TOP], 1u);
      const unsigned tg = og / nx;
      if (og + 1u == (tg + 1u) * nx) xb_add(&bar[XB_TOPGEN], 1u);
      else XB_SPIN(xb_ld(&bar[XB_TOPGEN]) == tg, bar);
      __builtin_amdgcn_fence(__ATOMIC_ACQUIRE, "agent");
      xb_add(&bar[XB_XGEN(b.x)], 1u);
      asm volatile("s_waitcnt vmcnt(0)" ::: "memory");
    } else {
      XB_SPIN(xb_ld(&bar[XB_XGEN(b.x)]) == gen, bar);
      __builtin_amdgcn_fence(__ATOMIC_ACQUIRE, "agent");
      asm volatile("s_waitcnt vmcnt(0)" ::: "memory");
    }
  }
  __syncthreads();
}
#define GSYNC() { XcdBarrier xb_; xb_.bar = (unsigned*)(mkctx(a).ws + O_XBAR); xb_.x = xb_xcc_id(); xb_.st = (volatile LAS unsigned*)(smem + SMEM_BYTES - 32); xcd_barrier(xb_); }

__global__ void __launch_bounds__(256, 2) mega(KArgs a) {
  extern __shared__ __attribute__((aligned(16))) char smem[];
  cg::grid_group grid = cg::this_grid();
  const int vb = blockIdx.x, nvb = gridDim.x;
  volatile LAS unsigned* xst = (volatile LAS unsigned*)(smem + SMEM_BYTES - 32);
  if (threadIdx.x == 0) { xst[0] = 0u; xst[1] = 0u; }
  __syncthreads();
  (void)xcd_barrier_post((unsigned*)(a.ws + O_XBAR), xst);
  if (threadIdx.x == 0) {
    const float** tab = (const float**)(a.ws + O_TAB);
#pragma unroll
    for (int i = 0; i < 35; ++i) tab[i] = a.in[i];
  }
  __syncthreads();
  STAGE(st_rope_table(p, vb, nvb));
  STAGE(st_mod(p, vb, nvb, smem));
  STAGE(st_prep_w1(p, 0, vb, nvb, smem));
  if (a.ws == nullptr) grid.sync();
  GSYNC();
  for (int l = 0; l < 2; ++l) {
    if (l == 0) { STAGE(st_norm1(p, 0, vb, nvb)); GSYNC(); }
    {
      const int g = vb & 7;
      for (int i = vb >> 3; i < 363; i += nvb >> 3) {
        int mt, nt;
        if (i < 264) { mt = i >> 1; nt = g + 8 * (i & 1); }
        else { const int j = i - 264, pc = g + 8 * (j / 33); nt = 16 + (pc >> 2); mt = (pc & 3) * 33 + (j % 33); }
        const Params p = mkctx(a); inproj_item(p, mt * 22 + nt, smem);
      }
    }
    GSYNC();
    STAGE(st_tokprep(p, l, vb, nvb));
    GSYNC();
    {
      for (int item = vb; item < 132 * 7 + NGITEM; item += nvb) {
        const Params p = mkctx(a);
        if (item < 132 * 7) mla_up_tile(p, item / 7, item % 7, smem);
        else gdn_chunk_item(p, item - 132 * 7, smem);
      }
    }
    GSYNC();
    st_mixer_queue(a, l, smem);
    GSYNC();
    STAGE(st_mix_finish(p, l, vb, nvb));
    GSYNC();
    STAGE(st_outproj(p, l, vb, nvb, smem));
    GSYNC();
    STAGE(st_norm2_route(p, l, vb, nvb, smem));
    GSYNC();
    STAGE(st_moe1(p, l, vb, nvb, smem));
    GSYNC();
    STAGE(st_moe2(p, l, vb, nvb, smem));
    GSYNC();
    if (l == 0) STAGE(st_prep_w1(p, 1, vb, nvb, smem));
    STAGE(st_combine(p, l, vb, nvb));
    if (l == 0) GSYNC();
  }
}

extern "C" void kernel_launch(void* const* d_in, const int* in_sizes, int n_in, void* d_out, int out_size, void* d_ws, size_t ws_size,
                              hipStream_t stream) {
  static int grid_blocks = 0;
  if (!grid_blocks) {
    int dev = 0, cus = 0, per_cu = 0;
    (void)hipGetDevice(&dev);
    (void)hipDeviceGetAttribute(&cus, hipDeviceAttributeMultiprocessorCount, dev);
    (void)hipFuncSetAttribute((const void*)mega, hipFuncAttributeMaxDynamicSharedMemorySize, SMEM_BYTES);
    (void)hipOccupancyMaxActiveBlocksPerMultiprocessor(&per_cu, mega, 256, SMEM_BYTES);
    if (per_cu > 2) per_cu = 2;
    if (per_cu < 1) per_cu = 1;
    grid_blocks = cus * per_cu;
  }
  KArgs p{};
  for (int i = 0; i < 35; ++i) p.in[i] = (const float*)d_in[i];
  p.out = (float*)d_out; p.ws = (char*)d_ws;
  if (ws_size < WS_NEED) { fprintf(stderr, "workspace too small: %zu < %zu\n", ws_size, (size_t)WS_NEED); return; }
  (void)hipMemsetAsync((char*)d_ws + O_BAR, 0, 256 + 16384, stream);
  void* args[] = {&p};
  hipError_t e = hipLaunchCooperativeKernel((void*)mega, dim3(grid_blocks), dim3(256), args, SMEM_BYTES, stream);
  if (e != hipSuccess) fprintf(stderr, "cooperative launch failed: %s (grid %d)\n", hipGetErrorString(e), grid_blocks);
}
```

```cpp
#include <hip/hip_runtime.h>
#include <hip/hip_cooperative_groups.h>
#include <cstdio>
#include <cstdint>
namespace cg = cooperative_groups;

#define DEVI __device__ __forceinline__
typedef unsigned short u16;
using bf16x8 = __attribute__((ext_vector_type(8))) short;
using f32x4  = __attribute__((ext_vector_type(4))) float;
using f32x2  = __attribute__((ext_vector_type(2))) float;
using f32x16 = __attribute__((ext_vector_type(16))) float;
using u32x4 = __attribute__((ext_vector_type(4))) unsigned;
using u32x2 = __attribute__((ext_vector_type(2))) unsigned;
typedef __bf16 bf16x2_t __attribute__((ext_vector_type(2)));

constexpr int DM = 1024, SEQ = 8192, CTXL = 256, NKEY = SEQ + CTXL;
constexpr int TL = 2 * SEQ, TC = 2 * CTXL, T = TL + TC;
constexpr int INW = 2672;
constexpr int NIN = 2816;
constexpr int LDPP = 1408;
constexpr int PP_CQ = 0, PP_CKV = 192, PP_DQKV = 320, PP_DZ = 1088, PP_GATE = 1344;
constexpr int NE = 64, NSLOT = 6 * T;
constexpr int LDW = 1088;
constexpr int LDH = 1088;
constexpr int NCHUNK = T / 64;
constexpr int NGITEM = NCHUNK * 8;
constexpr float LOG2E = 1.4426950408889634f;

constexpr size_t al256(size_t x) { return (x + 255) & ~(size_t)255; }
constexpr size_t O_MOD   = 0;
constexpr size_t O_ROPE  = O_MOD + al256((size_t)2 * 3 * 6144 * 4);
constexpr size_t O_XA    = O_ROPE + (size_t)SEQ * 48 * 8;
constexpr size_t O_H     = O_XA + (size_t)T * DM * 4;
constexpr size_t O_WINT  = O_H + (size_t)T * LDH * 2;
constexpr size_t O_WOUTT = O_WINT + (size_t)NIN * LDW * 2;
constexpr size_t O_WUQT  = O_WOUTT + (size_t)1024 * LDW * 2;
constexpr size_t O_WUKVT = O_WUQT + (size_t)384 * 192 * 2;
constexpr size_t O_WGUT  = O_WUKVT + (size_t)512 * 128 * 2;
constexpr size_t O_WDT   = O_WGUT + (size_t)65 * 512 * LDW * 2;
constexpr size_t O_WTS   = O_WDT + (size_t)65 * 1024 * 256 * 2;
constexpr size_t O_CNT   = O_WTS + al256((size_t)NSLOT * 4);
constexpr size_t O_TAB   = O_CNT + 256;
constexpr size_t O_BAR   = O_TAB + 512;
constexpr size_t O_XBAR  = O_BAR + 256;
constexpr size_t O_LIST  = O_XBAR + 16384;
constexpr size_t O_R     = O_LIST + (size_t)NE * T * 4;
constexpr size_t O_Y     = O_R;
constexpr size_t O_PP    = O_Y + (size_t)T * DM * 2;
constexpr size_t O_QA    = O_PP + (size_t)T * LDPP * 2;
constexpr size_t O_KA    = O_QA + (size_t)2 * 4 * NKEY * 64 * 2;
constexpr size_t O_VTA   = O_KA + (size_t)2 * 2 * NKEY * 64 * 2;
constexpr size_t O_QB    = O_VTA + (size_t)2 * 2 * NKEY * 64 * 2;
constexpr size_t O_KB    = O_QB + (size_t)2 * 8 * NKEY * 32 * 2;
constexpr size_t O_VTB   = O_KB + (size_t)2 * 8 * NKEY * 32 * 2;
constexpr size_t O_QC    = O_VTB + (size_t)2 * 4 * NKEY * 64 * 2;
constexpr size_t O_KC    = O_QC + (size_t)2 * 4 * NKEY * 96 * 2;
constexpr size_t O_VTC   = O_KC + (size_t)2 * 4 * NKEY * 96 * 2;
constexpr size_t O_CQN   = O_VTC + (size_t)2 * 4 * NKEY * 64 * 2;
constexpr size_t O_CKVN  = O_CQN + (size_t)T * 192 * 2;
constexpr size_t O_OB    = O_CKVN + (size_t)T * 128 * 2;
constexpr size_t O_GQ    = O_OB + (size_t)T * 512 * 2;
constexpr size_t O_GK    = O_GQ + (size_t)T * 256 * 2;
constexpr size_t O_GV    = O_GK + (size_t)T * 256 * 2;
constexpr size_t O_GG    = O_GV + (size_t)T * 256 * 2;
constexpr size_t O_GBETA = O_GG + (size_t)2 * T * 4 * 4;
constexpr size_t O_GM    = O_GBETA + (size_t)2 * T * 4 * 4;
constexpr size_t O_GQP   = O_GM + (size_t)NGITEM * 4096 * 2;
constexpr size_t O_GN    = O_GQP + (size_t)NGITEM * 4096 * 2;
constexpr size_t O_GLO   = O_GN + (size_t)NGITEM * 4096 * 2;
constexpr size_t O_GO    = O_GLO + (size_t)NGITEM * 4096 * 2;
constexpr size_t O_MIX_END = O_GO + (size_t)2 * T * 256 * 4;
constexpr size_t O_HB    = O_R;
constexpr size_t O_SLOT  = O_HB + (size_t)7 * T * 256 * 2;
constexpr size_t O_MOE_END = O_SLOT + (size_t)7 * T * 1024 * 2;
constexpr size_t cmax(size_t a, size_t b) { return a > b ? a : b; }
constexpr size_t WS_NEED = cmax(O_MIX_END, O_MOE_END);
static_assert(WS_NEED < (size_t)556000000, "workspace too large");

struct KArgs {
  const float* in[35];
  float* out;
  char* ws;
};
typedef const __attribute__((address_space(1))) float gcfloat;
struct Params {
  char* ws;
  float* out;
  gcfloat* const* in;
  int tid;
};
#define pin(p, i) ((const float*)(p).in[i])
enum { I_X = 0, I_C, I_CTX, I_CCTX, I_WADA, I_BADA, I_N1G, I_N2G, I_WIN, I_WOUT, I_SINK, I_LQ1, I_LK1, I_LQ2, I_LK2,
       I_DNG, I_MQG, I_MKVG, I_WUQ, I_WUKV, I_CONVW, I_ALF, I_ALB, I_DTF, I_DTB, I_GNG, I_WR, I_RB, I_WG, I_WU, I_WD,
       I_SG, I_SU, I_SD, I_FNG };

DEVI u16 f2bf(float f) { unsigned u = __float_as_uint(f); u += 0x7fffu + ((u >> 16) & 1u); return (u16)(u >> 16); }
DEVI float bf2f(u16 h) { return __uint_as_float(((unsigned)h) << 16); }
DEVI float bflo(unsigned v) { return __uint_as_float(v << 16); }
DEVI float bfhi(unsigned v) { return __uint_as_float(v & 0xffff0000u); }
DEVI unsigned pack2(float a, float b) { f32x2 v = {a, b}; return __builtin_bit_cast(unsigned, __builtin_convertvector(v, bf16x2_t)); }
DEVI f32x4 fzero4() { float z = 0.f; asm volatile("" : "+v"(z)); return f32x4{z, z, z, z}; }
DEVI float wave_sum(float v) {
#pragma unroll
  for (int o = 32; o >= 1; o >>= 1) v += __shfl_xor(v, o);
  return v;
}
DEVI float half_sum(float v) {
#pragma unroll
  for (int o = 16; o >= 1; o >>= 1) v += __shfl_xor(v, o);
  return v;
}
DEVI float siluf(float x) { return x / (1.f + __expf(-x)); }
DEVI float sigmf(float x) { return 1.f / (1.f + __expf(-x)); }
DEVI int tok_mv(int t) { return t < TL ? (t >> 13) : 2; }
DEVI int tok_b(int t) { return t < TL ? (t >> 13) : ((t - TL) >> 8); }
DEVI int tok_row(int t) { return t < TL ? (t & (SEQ - 1)) : (SEQ + ((t - TL) & (CTXL - 1))); }
DEVI const float* modp(const Params& p, int l, int mv, int j) { return (const float*)(p.ws + O_MOD) + ((size_t)(l * 3 + mv) * 6 + j) * 1024; }

#define MFMA16(a, b, c) __builtin_amdgcn_mfma_f32_16x16x32_bf16((a), (b), (c), 0, 0, 0)
#define MFMA32(a, b, c) __builtin_amdgcn_mfma_f32_32x32x16_bf16((a), (b), (c), 0, 0, 0)

DEVI void st_copy_in(const Params& p, int vb, int nvb) {
  float4* xa = (float4*)(p.ws + O_XA);
  const float4* x = (const float4*)pin(p, I_X);
  const float4* cx = (const float4*)pin(p, I_CTX);
  const size_t n4 = (size_t)T * DM / 4, nl4 = (size_t)TL * DM / 4;
  for (size_t i = (size_t)vb * 256 + p.tid; i < n4; i += (size_t)nvb * 256) xa[i] = i < nl4 ? x[i] : cx[i - nl4];
}
DEVI void rope_cs(int i, int half, int s, float& c, float& sn) {
  const int quarter = half >> 1;
  const int ii = i < quarter ? i : i - quarter;
  const float pos = i < quarter ? (float)(s >> 6) : (float)(s & 63);
  const float inv = powf(10000.f, -(float)ii / (float)quarter);
  const float ang = pos * inv;
  c = cosf(ang); sn = sinf(ang);
}
DEVI void st_rope_table(const Params& p, int vb, int nvb) {
  f32x2* R = (f32x2*)(p.ws + O_ROPE);
  for (int e = vb * 256 + p.tid; e < SEQ * 48; e += nvb * 256) {
    const int s = e / 48, i = e % 48;
    float c, sn;
    if (i < 32) rope_cs(i, 32, s, c, sn); else rope_cs(i - 32, 16, s, c, sn);
    R[e] = f32x2{c, sn};
  }
}
DEVI void st_mod(const Params& p, int vb, int nvb, char* smem) {
  float* sv = (float*)smem;
  float* red = sv + 3 * 1024;
  for (int i = p.tid; i < 3 * 1024; i += 256) {
    int v = i >> 10, k = i & 1023;
    float c = v < 2 ? pin(p, I_C)[v * 1024 + k] : pin(p, I_CCTX)[k];
    sv[i] = siluf(c);
  }
  __syncthreads();
  const int cgp = p.tid & 7, kg = p.tid >> 3;
  for (int item = vb; item < 2 * 192; item += nvb) {
    const int l = item / 192, c0 = (item % 192) * 32;
    const float* w = pin(p, I_WADA) + (size_t)l * 1024 * 6144 + c0 + cgp * 4;
    f32x4 a0 = fzero4(), a1 = a0, a2 = a0;
#pragma unroll 8
    for (int kk = 0; kk < 32; ++kk) {
      const int k = kg * 32 + kk;
      const f32x4 wv = *(const f32x4*)(w + (size_t)k * 6144);
      a0 += sv[k] * wv; a1 += sv[1024 + k] * wv; a2 += sv[2048 + k] * wv;
    }
    float* rp = red + (kg * 8 + cgp) * 12;
    *(f32x4*)rp = a0; *(f32x4*)(rp + 4) = a1; *(f32x4*)(rp + 8) = a2;
    __syncthreads();
    if (p.tid < 96) {
      const int v = p.tid >> 5, c = p.tid & 31;
      float s = 0.f;
#pragma unroll 8
      for (int g = 0; g < 32; ++g) s += red[(g * 8 + (c >> 2)) * 12 + v * 4 + (c & 3)];
      ((float*)(p.ws + O_MOD))[(size_t)(l * 3 + v) * 6144 + c0 + c] = s + pin(p, I_BADA)[l * 6144 + c0 + c];
    }
    __syncthreads();
  }
}

template <class RowFn>
DEVI void tr_tile(int tid, const float* __restrict__ src, int N, u16* __restrict__ dst, int ldd, RowFn drow, int k0, int n0, float* tile) {
  {
    const int kq = tid >> 4, n4 = (tid & 15) * 4;
    f32x4 v[4];
#pragma unroll
    for (int r = 0; r < 4; ++r) {
      const int k = r * 16 + kq;
      v[r] = n0 + n4 < N ? *(const f32x4*)(src + (size_t)(k0 + k) * N + n0 + n4) : fzero4();
    }
#pragma unroll
    for (int r = 0; r < 4; ++r) {
      const int k = r * 16 + kq;
      tile[k * 65 + n4] = v[r][0]; tile[k * 65 + n4 + 1] = v[r][1]; tile[k * 65 + n4 + 2] = v[r][2]; tile[k * 65 + n4 + 3] = v[r][3];
    }
  }
  __syncthreads();
  {
    const int n = tid >> 2, kc = (tid & 3) * 16;
    const int dr = drow(n0 + n);
    if (dr >= 0) {
      u32x4 o0, o1;
#pragma unroll
      for (int e = 0; e < 4; ++e) {
        o0[e] = pack2(tile[(kc + 2 * e) * 65 + n], tile[(kc + 2 * e + 1) * 65 + n]);
        o1[e] = pack2(tile[(kc + 8 + 2 * e) * 65 + n], tile[(kc + 8 + 2 * e + 1) * 65 + n]);
      }
      u16* d = dst + (size_t)dr * ldd + k0 + kc;
      *(u32x4*)d = o0; *(u32x4*)(d + 8) = o1;
    }
  }
  __syncthreads();
}
DEVI int win_row(int n) {
  if (n < 1280) return n;
  if (n < 1600) return 1408 + (n - 1280);
  if (n < 1632) return 1280 + (n - 1600);
  if (n < INW) return 1408 + 320 + (n - 1632);
  return -1;
}
constexpr int TR_IN = 16 * 42, TR_OUT = 256, TR_UQ = 18, TR_UKV = 16, TR_E = 4096, TR_S = 64;
constexpr int TR_P1 = TR_IN + TR_OUT + TR_UQ + TR_UKV;
constexpr int TR_P2 = 3 * TR_E + 3 * TR_S;
DEVI void prep_w1_tile(const Params& p, int l, int it, float* tile) {
  if (it < TR_IN) { tr_tile(p.tid, pin(p, I_WIN) + (size_t)l * 1024 * INW, INW, (u16*)(p.ws + O_WINT), LDW, [](int n) { return win_row(n); }, (it / 42) * 64, (it % 42) * 64, tile); return; }
  it -= TR_IN;
  if (it < TR_OUT) { tr_tile(p.tid, pin(p, I_WOUT) + (size_t)l * 1024 * 1024, 1024, (u16*)(p.ws + O_WOUTT), LDW, [](int n) { return n; }, (it / 16) * 64, (it % 16) * 64, tile); return; }
  it -= TR_OUT;
  if (it < TR_UQ) { tr_tile(p.tid, pin(p, I_WUQ) + (size_t)l * 192 * 384, 384, (u16*)(p.ws + O_WUQT), 192, [](int n) { return n; }, (it / 6) * 64, (it % 6) * 64, tile); return; }
  it -= TR_UQ;
  tr_tile(p.tid, pin(p, I_WUKV) + (size_t)l * 128 * 512, 512, (u16*)(p.ws + O_WUKVT), 128,
          [](int n) { const int h = n >> 7, j = n & 127; return j < 64 ? h * 64 + j : 256 + h * 64 + (j - 64); }, (it / 8) * 64, (it % 8) * 64, tile);
}
DEVI void prep_w2_tile(const Params& p, int l, int it, float* tile) {
  if (it < 2 * TR_E) {
    const int which = it / TR_E; it %= TR_E;
    const int e = it >> 6, tt = it & 63;
    const float* src = pin(p, which ? I_WU : I_WG) + ((size_t)l * NE + e) * 1024 * 256;
    tr_tile(p.tid, src, 256, (u16*)(p.ws + O_WGUT) + (size_t)e * 512 * LDW, LDW, [which](int n) { return 2 * n + which; }, (tt >> 2) * 64, (tt & 3) * 64, tile); return;
  }
  it -= 2 * TR_E;
  if (it < TR_E) {
    const int e = it >> 6, tt = it & 63;
    const float* src = pin(p, I_WD) + ((size_t)l * NE + e) * 256 * 1024;
    tr_tile(p.tid, src, 1024, (u16*)(p.ws + O_WDT) + (size_t)e * 1024 * 256, 256, [](int n) { return n; }, (tt >> 4) * 64, (tt & 15) * 64, tile); return;
  }
  it -= TR_E;
  if (it < 2 * TR_S) {
    const int which = it / TR_S; const int tt = it % TR_S;
    const float* src = pin(p, which ? I_SU : I_SG) + (size_t)l * 1024 * 256;
    tr_tile(p.tid, src, 256, (u16*)(p.ws + O_WGUT) + (size_t)64 * 512 * LDW, LDW, [which](int n) { return 2 * n + which; }, (tt >> 2) * 64, (tt & 3) * 64, tile); return;
  }
  it -= 2 * TR_S;
  { const int tt = it;
    const float* src = pin(p, I_SD) + (size_t)l * 256 * 1024;
    tr_tile(p.tid, src, 1024, (u16*)(p.ws + O_WDT) + (size_t)64 * 1024 * 256, 256, [](int n) { return n; }, (tt >> 4) * 64, (tt & 15) * 64, tile); }
}
struct TrDesc { const float* src; u16* dst; int N, ldd, rs, ro, k0, n0; };
DEVI TrDesc w2_desc(const Params& p, int l, int it) {
  TrDesc d;
  if (it < 2 * TR_E) {
    const int which = it / TR_E; it %= TR_E;
    const int e = it >> 6, tt = it & 63;
    d.src = pin(p, which ? I_WU : I_WG) + ((size_t)l * NE + e) * 1024 * 256; d.N = 256;
    d.dst = (u16*)(p.ws + O_WGUT) + (size_t)e * 512 * LDW; d.ldd = LDW; d.rs = 2; d.ro = which; d.k0 = (tt >> 2) * 64; d.n0 = (tt & 3) * 64;
    return d;
  }
  it -= 2 * TR_E;
  if (it < TR_E) {
    const int e = it >> 6, tt = it & 63;
    d.src = pin(p, I_WD) + ((size_t)l * NE + e) * 256 * 1024; d.N = 1024;
    d.dst = (u16*)(p.ws + O_WDT) + (size_t)e * 1024 * 256; d.ldd = 256; d.rs = 1; d.ro = 0; d.k0 = (tt >> 4) * 64; d.n0 = (tt & 15) * 64;
    return d;
  }
  it -= TR_E;
  if (it < 2 * TR_S) {
    const int which = it / TR_S; const int tt = it % TR_S;
    d.src = pin(p, which ? I_SU : I_SG) + (size_t)l * 1024 * 256; d.N = 256;
    d.dst = (u16*)(p.ws + O_WGUT) + (size_t)64 * 512 * LDW; d.ldd = LDW; d.rs = 2; d.ro = which; d.k0 = (tt >> 2) * 64; d.n0 = (tt & 3) * 64;
    return d;
  }
  it -= 2 * TR_S;
  d.src = pin(p, I_SD) + (size_t)l * 256 * 1024; d.N = 1024;
  d.dst = (u16*)(p.ws + O_WDT) + (size_t)64 * 1024 * 256; d.ldd = 256; d.rs = 1; d.ro = 0; d.k0 = (it >> 4) * 64; d.n0 = (it & 15) * 64;
  return d;
}
DEVI void tr_load(int tid, const TrDesc& d, f32x4 (&v)[4]) {
  const int kq = tid >> 4, n4 = (tid & 15) * 4;
#pragma unroll
  for (int r = 0; r < 4; ++r) v[r] = *(const f32x4*)(d.src + (size_t)(d.k0 + r * 16 + kq) * d.N + d.n0 + n4);
}
DEVI void tr_process(int tid, const TrDesc& d, const f32x4 (&v)[4], float* tile) {
  {
    const int kq = tid >> 4, n4 = (tid & 15) * 4;
#pragma unroll
    for (int r = 0; r < 4; ++r) {
      const int k = r * 16 + kq;
      tile[k * 65 + n4] = v[r][0]; tile[k * 65 + n4 + 1] = v[r][1]; tile[k * 65 + n4 + 2] = v[r][2]; tile[k * 65 + n4 + 3] = v[r][3];
    }
  }
  __syncthreads();
  {
    const int n = tid >> 2, kc = (tid & 3) * 16;
    u32x4 o0, o1;
#pragma unroll
    for (int e = 0; e < 4; ++e) {
      o0[e] = pack2(tile[(kc + 2 * e) * 65 + n], tile[(kc + 2 * e + 1) * 65 + n]);
      o1[e] = pack2(tile[(kc + 8 + 2 * e) * 65 + n], tile[(kc + 8 + 2 * e + 1) * 65 + n]);
    }
    u16* o = d.dst + (size_t)((d.n0 + n) * d.rs + d.ro) * d.ldd + d.k0 + kc;
    *(u32x4*)o = o0; *(u32x4*)(o + 8) = o1;
  }
  __syncthreads();
}
DEVI void prep_w2_run8(const Params& p, int l, int it0, float* tile) {
  f32x4 va[4], vb4[4];
  TrDesc da = w2_desc(p, l, it0), db = da;
  __syncthreads();
  tr_load(p.tid, da, va);
#pragma unroll 1
  for (int k = 0; k < 8; k += 2) {
    db = w2_desc(p, l, it0 + k + 1);
    tr_load(p.tid, db, vb4);
    tr_process(p.tid, da, va, tile);
    if (k + 2 < 8) { da = w2_desc(p, l, it0 + k + 2); tr_load(p.tid, da, va); }
    tr_process(p.tid, db, vb4, tile);
  }
}
DEVI void st_prep_w1(const Params& p, int l, int vb, int nvb, char* smem) {
  float* tile = (float*)smem;
  if (vb == 0 && p.tid < 64) ((int*)(p.ws + O_CNT))[p.tid] = 0;
  for (int e = vb * 256 + p.tid; e < 144 * 128; e += nvb * 256) {
    const int r = e >> 7, c8 = e & 127;
    const int row = r < 96 ? 1312 + r : 2768 + (r - 96);
    *(u32x4*)((u16*)(p.ws + O_WINT) + (size_t)row * LDW + c8 * 8) = __builtin_bit_cast(u32x4, fzero4());
  }
  for (int item = vb; item < TR_P1; item += nvb) prep_w1_tile(p, l, item, tile);
}

DEVI void st_norm1(const Params& p, int l, int vb, int nvb) {
  const int lane = p.tid & 63, wid = p.tid >> 6;
  const float* g = pin(p, I_N1G) + l * 1024;
  for (int t4 = (vb * 4 + wid) * 4; t4 < T; t4 += nvb * 16) {
    const int mv = tok_mv(t4);
    const float* sh = modp(p, l, mv, 0); const float* sc = modp(p, l, mv, 1);
    f32x4 v[4][4]; float ss[4];
#pragma unroll
    for (int u = 0; u < 4; ++u) {
      const int t = t4 + u;
      const f32x4* xr = (const f32x4*)(t < TL ? pin(p, I_X) + (size_t)t * 1024 : pin(p, I_CTX) + (size_t)(t - TL) * 1024);
#pragma unroll
      for (int i = 0; i < 4; ++i) v[u][i] = xr[i * 64 + lane];
    }
#pragma unroll
    for (int u = 0; u < 4; ++u) {
      float a = 0.f;
#pragma unroll
      for (int i = 0; i < 4; ++i) a += v[u][i][0] * v[u][i][0] + v[u][i][1] * v[u][i][1] + v[u][i][2] * v[u][i][2] + v[u][i][3] * v[u][i][3];
      ss[u] = a;
    }
#pragma unroll
    for (int o = 32; o >= 1; o >>= 1) {
#pragma unroll
      for (int u = 0; u < 4; ++u) ss[u] += __shfl_xor(ss[u], o);
    }
#pragma unroll
    for (int i = 0; i < 4; ++i) {
      const int c = i * 256 + lane * 4;
      const f32x4 gg = *(const f32x4*)(g + c), s4 = *(const f32x4*)(sc + c), h4 = *(const f32x4*)(sh + c);
      const f32x4 gs = gg * (1.f + s4);
#pragma unroll
      for (int u = 0; u < 4; ++u) {
        const float rstd = rsqrtf(ss[u] * (1.f / 1024.f) + 1e-6f);
        const f32x4 o = v[u][i] * rstd * gs + h4;
        u32x2 pk; pk[0] = pack2(o[0], o[1]); pk[1] = pack2(o[2], o[3]);
        *(u32x2*)((u16*)(p.ws + O_H) + (size_t)(t4 + u) * LDH + c) = pk;
      }
    }
  }
}

constexpr int GLD = 72;
typedef const __attribute__((address_space(1))) unsigned gcu32;
typedef __attribute__((address_space(3))) unsigned lu32;
template <bool SWAP, class ARow>
DEVI void gemm_core(int tid, ARow arow, const u16* __restrict__ Bt, int ldb, int K, f32x4 (&acc)[4][4], char* smem) {
  constexpr int TILE = 128 * 64;
  u16* sbuf = (u16*)smem;
  const int lane = tid & 63, wid = tid >> 6, wr = wid >> 1, wc = wid & 1, fr = lane & 15, fq = lane >> 4;
  const u16* ap[4]; const u16* bp[4];
#pragma unroll
  for (int i = 0; i < 4; ++i) {
    const int q = tid + 256 * i, row = q >> 3, cs = (q & 7) ^ (row & 7);
    ap[i] = arow(row) + cs * 8; bp[i] = Bt + (size_t)row * ldb + cs * 8;
  }
  const int nk = K >> 6;
  auto stage = [&](int kt, int buf) {
    int off = kt * 64; asm volatile("" : "+s"(off));
    u16* dA = sbuf + buf * 2 * TILE + tid * 8; u16* dB = dA + TILE;
#pragma unroll
    for (int i = 0; i < 4; ++i) {
      __builtin_amdgcn_global_load_lds((gcu32*)(ap[i] + off), (lu32*)(dA + i * 2048), 16, 0, 0);
      __builtin_amdgcn_global_load_lds((gcu32*)(bp[i] + off), (lu32*)(dB + i * 2048), 16, 0, 0);
    }
  };
  auto compute = [&](int buf) {
    const u16* sA = sbuf + buf * 2 * TILE; const u16* sB = sA + TILE;
#pragma unroll
    for (int ks = 0; ks < 2; ++ks) {
      bf16x8 af[4], bfr[4];
#pragma unroll
      for (int m = 0; m < 4; ++m) { const int R = wr * 64 + m * 16 + fr; af[m] = *(const bf16x8*)&sA[R * 64 + (((ks * 4 + fq) ^ (R & 7)) << 3)]; }
#pragma unroll
      for (int n = 0; n < 4; ++n) { const int R = wc * 64 + n * 16 + fr; bfr[n] = *(const bf16x8*)&sB[R * 64 + (((ks * 4 + fq) ^ (R & 7)) << 3)]; }
#pragma unroll
      for (int m = 0; m < 4; ++m)
#pragma unroll
        for (int n = 0; n < 4; ++n) acc[m][n] = SWAP ? MFMA16(af[m], bfr[n], acc[m][n]) : MFMA16(bfr[n], af[m], acc[m][n]);
    }
  };
#pragma unroll
  for (int m = 0; m < 4; ++m)
#pragma unroll
    for (int n = 0; n < 4; ++n) acc[m][n] = fzero4();
  __syncthreads();
  stage(0, 0);
  asm volatile("s_waitcnt vmcnt(0)" ::: "memory");
  __syncthreads();
  for (int kt = 0; kt < nk; ++kt) {
    if (kt + 1 < nk) stage(kt + 1, (kt + 1) & 1);
    compute(kt & 1);
    asm volatile("s_waitcnt vmcnt(0)" ::: "memory");
    __syncthreads();
  }
}
template <class ARow, class Epi>
DEVI void gemm128(int tid, ARow arow, const u16* __restrict__ Bt, int ldb, int K, Epi epi, char* smem) {
  f32x4 acc[4][4];
  gemm_core<false>(tid, arow, Bt, ldb, K, acc, smem);
  const int lane = tid & 63, wid = tid >> 6, wr = wid >> 1, wc = wid & 1, fr = lane & 15, fq = lane >> 4;
#pragma unroll
  for (int m = 0; m < 4; ++m)
#pragma unroll
    for (int n = 0; n < 4; ++n) epi(wr * 64 + m * 16 + fr, wc * 64 + n * 16 + fq * 4, acc[m][n]);
}

DEVI void rope4(const f32x4 x1, const f32x4 x2, const f32x2* rp, bool lat, float scale, u32x2& o1, u32x2& o2) {
  f32x4 s = fzero4(), c = s + 1.f;
  if (lat) {
    const f32x4 a = *(const f32x4*)rp, b = *(const f32x4*)(rp + 2);
    c = f32x4{a[0], a[2], b[0], b[2]}; s = f32x4{a[1], a[3], b[1], b[3]};
  }
  const f32x4 y1 = (x1 * c - x2 * s) * scale, y2 = (x2 * c + x1 * s) * scale;
  o1[0] = pack2(y1[0], y1[1]); o1[1] = pack2(y1[2], y1[3]);
  o2[0] = pack2(y2[0], y2[1]); o2[1] = pack2(y2[2], y2[3]);
}
DEVI void inproj_item(const Params& p, int item, char* smem) {
  const u16* H = (const u16*)(p.ws + O_H); const u16* W = (const u16*)(p.ws + O_WINT);
  const f32x2* ROPE = (const f32x2*)(p.ws + O_ROPE);
  const int tid = p.tid, lane = tid & 63, wid = tid >> 6, wr = wid >> 1, wc = wid & 1, fr = lane & 15, fq = lane >> 4;
  {
    const int m0 = (item / 22) * 128, nt = item % 22;
    const bool lat = m0 < TL;
    const int b = tok_b(m0), rowbase = tok_row(m0);
    f32x4 acc[4][4];
    auto arow = [&](int r) { return H + (size_t)(m0 + r) * LDH; };
    if (nt == 3 || nt == 8 || nt == 9) {
      gemm_core<true>(tid, arow, W + (size_t)nt * 128 * LDW, LDW, 1024, acc, smem);
      u16* vt = nt == 3 ? (u16*)(p.ws + O_VTA) + (size_t)(b * 2 + wc) * 64 * NKEY
                        : (u16*)(p.ws + O_VTB) + (size_t)(b * 4 + (nt - 8) * 2 + wc) * 64 * NKEY;
#pragma unroll
      for (int m = 0; m < 4; ++m)
#pragma unroll
        for (int n = 0; n < 4; ++n) {
          u32x2 pk; pk[0] = pack2(acc[m][n][0], acc[m][n][1]); pk[1] = pack2(acc[m][n][2], acc[m][n][3]);
          *(u32x2*)(vt + (size_t)(n * 16 + fr) * NKEY + rowbase + wr * 64 + m * 16 + (((fq & 1) << 1) | (fq >> 1)) * 4) = pk;
        }
      return;
    }
    gemm_core<false>(tid, arow, W + (size_t)nt * 128 * LDW, LDW, 1024, acc, smem);
    if (nt < 3) {
      u16* dst; float scale;
      if (nt < 2) { dst = (u16*)(p.ws + O_QA) + ((size_t)(b * 4 + nt * 2 + wc) * NKEY + rowbase) * 64; scale = 0.125f * LOG2E; }
      else { dst = (u16*)(p.ws + O_KA) + ((size_t)(b * 2 + wc) * NKEY + rowbase) * 64; scale = 1.f; }
#pragma unroll
      for (int m = 0; m < 4; ++m) {
        const int rl = wr * 64 + m * 16 + fr;
#pragma unroll
        for (int pi = 0; pi < 2; ++pi) {
          const int d0 = pi * 16 + fq * 4;
          u32x2 o1, o2;
          rope4(acc[m][pi], acc[m][pi + 2], ROPE + (size_t)(rowbase + rl) * 48 + d0, lat, scale, o1, o2);
          *(u32x2*)(dst + (size_t)rl * 64 + d0) = o1; *(u32x2*)(dst + (size_t)rl * 64 + 32 + d0) = o2;
        }
      }
    } else if (nt < 8) {
      const bool isq = nt < 6;
      u16* base = isq ? (u16*)(p.ws + O_QB) : (u16*)(p.ws + O_KB);
      const float scale = isq ? 0.17677669529663687f * LOG2E : 1.f;
      const int hm0 = ((nt - 4) & 1) * 4 + wc * 2;
#pragma unroll
      for (int m = 0; m < 4; ++m) {
        const int rl = wr * 64 + m * 16 + fr;
#pragma unroll
        for (int g = 0; g < 2; ++g) {
          u16* dst = base + ((size_t)(b * 8 + hm0 + g) * NKEY + rowbase + rl) * 32;
          u32x2 o1, o2;
          rope4(acc[m][2 * g], acc[m][2 * g + 1], ROPE + (size_t)(rowbase + rl) * 48 + 32 + fq * 4, lat, scale, o1, o2);
          *(u32x2*)(dst + fq * 4) = o1; *(u32x2*)(dst + 16 + fq * 4) = o2;
        }
      }
    } else if (nt == 10) {
      if (wc == 0) {
#pragma unroll
        for (int m = 0; m < 4; ++m) {
          const int rl = wr * 64 + m * 16 + fr;
          u32x2 o1, o2;
          rope4(acc[m][0], acc[m][1], ROPE + (size_t)(rowbase + rl) * 48 + 32 + fq * 4, lat, 1.f, o1, o2);
#pragma unroll
          for (int h = 0; h < 4; ++h) {
            u16* dst = (u16*)(p.ws + O_KC) + ((size_t)(b * 4 + h) * NKEY + rowbase + rl) * 96 + 64;
            *(u32x2*)(dst + fq * 4) = o1; *(u32x2*)(dst + 16 + fq * 4) = o2;
          }
        }
      }
    } else {
      u16* PP = (u16*)(p.ws + O_PP);
#pragma unroll
      for (int m = 0; m < 4; ++m)
#pragma unroll
        for (int n = 0; n < 4; ++n) {
          u32x2 pk; pk[0] = pack2(acc[m][n][0], acc[m][n][1]); pk[1] = pack2(acc[m][n][2], acc[m][n][3]);
          *(u32x2*)(PP + (size_t)(m0 + wr * 64 + m * 16 + fr) * LDPP + (nt - 11) * 128 + wc * 64 + n * 16 + fq * 4) = pk;
        }
    }
  }
}

DEVI void st_tokprep(const Params& p, int l, int vb, int nvb) {
  const int lane = p.tid & 63, wid = p.tid >> 6;
  const u16* PP = (const u16*)(p.ws + O_PP);
  u16* GQ = (u16*)(p.ws + O_GQ); u16* GK = (u16*)(p.ws + O_GK); u16* GV = (u16*)(p.ws + O_GV);
  float* GG = (float*)(p.ws + O_GG); float* GB = (float*)(p.ws + O_GBETA);
  u16* CQN = (u16*)(p.ws + O_CQN); u16* CKVN = (u16*)(p.ws + O_CKVN);
  const float* cwp = pin(p, I_CONVW) + (size_t)l * 5 * 768;
  f32x2 cw[6][5];
#pragma unroll
  for (int i = 0; i < 6; ++i)
#pragma unroll
    for (int j = 0; j < 5; ++j) cw[i][j] = *(const f32x2*)(cwp + j * 768 + 2 * lane + 128 * i);
  const float* gq = pin(p, I_MQG) + l * 192; const float* gkv = pin(p, I_MKVG) + l * 128;
  const float gq0 = gq[lane], gq1 = gq[64 + lane], gq2 = gq[128 + lane], gk0 = gkv[lane], gk1 = gkv[64 + lane];
  for (int t = vb * 4 + wid; t < T; t += nvb * 4) {
    int base, pos, len;
    if (t < TL) { base = t & ~(SEQ - 1); pos = t & (SEQ - 1); len = SEQ; } else { int j = t - TL; base = TL + (j & ~(CTXL - 1)); pos = j & (CTXL - 1); len = CTXL; }
    unsigned xin[5][6];
#pragma unroll
    for (int j = 0; j < 5; ++j) {
      const int pp = pos + j - 2;
      const bool ok = pp >= 0 && pp < len;
      const u16* row = PP + (size_t)(base + (ok ? pp : pos)) * LDPP + PP_DQKV + 2 * lane;
#pragma unroll
      for (int i = 0; i < 6; ++i) { unsigned v = *(const unsigned*)(row + 128 * i); xin[j][i] = ok ? v : 0u; }
    }
    const u16* pr = PP + (size_t)t * LDPP;
    const float q0 = bf2f(pr[PP_CQ + lane]), q1 = bf2f(pr[PP_CQ + 64 + lane]), q2 = bf2f(pr[PP_CQ + 128 + lane]);
    const float k0 = bf2f(pr[PP_CKV + lane]), k1 = bf2f(pr[PP_CKV + 64 + lane]);
    const float gate_in = lane < 16 ? bf2f(pr[PP_GATE + lane]) : 0.f;
#pragma unroll
    for (int i = 0; i < 6; ++i) {
      float a0 = 0.f, a1 = 0.f;
#pragma unroll
      for (int j = 0; j < 5; ++j) { a0 += cw[i][j][0] * bflo(xin[j][i]); a1 += cw[i][j][1] * bfhi(xin[j][i]); }
      float y0 = siluf(a0), y1 = siluf(a1);
      const int c = 2 * lane + 128 * i;
      if (i < 4) {
        const float ss = half_sum(y0 * y0 + y1 * y1);
        const float r = rsqrtf(ss + 1e-6f) * (i < 2 ? 0.125f : 1.f);
        u16* dst = i < 2 ? GQ + (size_t)t * 256 + c : GK + (size_t)t * 256 + (c - 256);
        *(unsigned*)dst = pack2(y0 * r, y1 * r);
      } else *(unsigned*)(GV + (size_t)t * 256 + (c - 512)) = pack2(y0, y1);
    }
    if (lane < 16) {
      const int which = lane >> 2, hd = lane & 3;
      if (which < 2) {
        const float al = which ? pin(p, I_ALB)[l * 4 + hd] : pin(p, I_ALF)[l * 4 + hd];
        const float dt = which ? pin(p, I_DTB)[l * 4 + hd] : pin(p, I_DTF)[l * 4 + hd];
        const float xx = gate_in + dt;
        const float sp = fmaxf(xx, 0.f) + log1pf(expf(-fabsf(xx)));
        GG[((size_t)which * T + t) * 4 + hd] = -expf(al) * sp;
      } else GB[((size_t)(which - 2) * T + t) * 4 + hd] = sigmf(gate_in);
    }
    {
      float ss = q0 * q0 + q1 * q1 + q2 * q2, s2 = k0 * k0 + k1 * k1;
#pragma unroll
      for (int o = 32; o >= 1; o >>= 1) { ss += __shfl_xor(ss, o); s2 += __shfl_xor(s2, o); }
      const float rs = rsqrtf(ss * (1.f / 192.f) + 1e-6f), r2 = rsqrtf(s2 * (1.f / 128.f) + 1e-6f);
      u16* d = CQN + (size_t)t * 192;
      d[lane] = f2bf(q0 * rs * gq0); d[64 + lane] = f2bf(q1 * rs * gq1); d[128 + lane] = f2bf(q2 * rs * gq2);
      u16* d2 = CKVN + (size_t)t * 128;
      d2[lane] = f2bf(k0 * r2 * gk0); d2[64 + lane] = f2bf(k1 * r2 * gk1);
    }
  }
}

DEVI void mla_up_tile(const Params& p, int mt, int nn, char* smem) {
  const int tid = p.tid, lane = tid & 63, wid = tid >> 6, wr = wid >> 1, wc = wid & 1, fr = lane & 15, fq = lane >> 4;
  const int m0 = mt * 128;
  const bool lat = m0 < TL;
  const int b = tok_b(m0), rowbase = tok_row(m0);
  f32x4 acc[4][4];
  if (nn < 3) {
    const u16* CQN = (const u16*)(p.ws + O_CQN);
    gemm_core<false>(tid, [&](int r) { return CQN + (size_t)(m0 + r) * 192; }, (const u16*)(p.ws + O_WUQT) + (size_t)nn * 128 * 192, 192, 192, acc, smem);
    const f32x2* ROPE = (const f32x2*)(p.ws + O_ROPE);
    const float scale = 0.10206207261596577f * LOG2E;
    u16* QC = (u16*)(p.ws + O_QC);
#pragma unroll
    for (int m = 0; m < 4; ++m) {
      const int rl = wr * 64 + m * 16 + fr;
#pragma unroll
      for (int n = 0; n < 4; ++n) {
        const int cb = nn * 128 + wc * 64 + n * 16;
        const int h = cb / 96, db = cb - h * 96;
        u16* dst = QC + ((size_t)(b * 4 + h) * NKEY + rowbase + rl) * 96;
        if (db < 64) {
          u32x2 pk; pk[0] = pack2(acc[m][n][0] * scale, acc[m][n][1] * scale); pk[1] = pack2(acc[m][n][2] * scale, acc[m][n][3] * scale);
          *(u32x2*)(dst + db + fq * 4) = pk;
        } else if (db == 64 && n < 3) {
          u32x2 o1, o2;
          rope4(acc[m][n], acc[m][n + 1], ROPE + (size_t)(rowbase + rl) * 48 + 32 + fq * 4, lat, scale, o1, o2);
          *(u32x2*)(dst + 64 + fq * 4) = o1; *(u32x2*)(dst + 80 + fq * 4) = o2;
        }
      }
    }
  } else {
    const u16* CKVN = (const u16*)(p.ws + O_CKVN);
    auto arow = [&](int r) { return CKVN + (size_t)(m0 + r) * 128; };
    const u16* Wt = (const u16*)(p.ws + O_WUKVT) + (size_t)(nn - 3) * 128 * 128;
    if (nn < 5) {
      gemm_core<false>(tid, arow, Wt, 128, 128, acc, smem);
      u16* KC = (u16*)(p.ws + O_KC) + ((size_t)(b * 4 + (nn - 3) * 2 + wc) * NKEY + rowbase) * 96;
#pragma unroll
      for (int m = 0; m < 4; ++m)
#pragma unroll
        for (int n = 0; n < 4; ++n) {
          u32x2 pk; pk[0] = pack2(acc[m][n][0], acc[m][n][1]); pk[1] = pack2(acc[m][n][2], acc[m][n][3]);
          *(u32x2*)(KC + (size_t)(wr * 64 + m * 16 + fr) * 96 + n * 16 + fq * 4) = pk;
        }
    } else {
      gemm_core<true>(tid, arow, Wt, 128, 128, acc, smem);
      u16* vt = (u16*)(p.ws + O_VTC) + (size_t)(b * 4 + (nn - 5) * 2 + wc) * 64 * NKEY;
#pragma unroll
      for (int m = 0; m < 4; ++m)
#pragma unroll
        for (int n = 0; n < 4; ++n) {
          u32x2 pk; pk[0] = pack2(acc[m][n][0], acc[m][n][1]); pk[1] = pack2(acc[m][n][2], acc[m][n][3]);
          *(u32x2*)(vt + (size_t)(n * 16 + fr) * NKEY + rowbase + wr * 64 + m * 16 + (((fq & 1) << 1) | (fq >> 1)) * 4) = pk;
        }
    }
  }
}
DEVI int permcol(int x) { return (x & 32) + 8 * ((x >> 2) & 3) + 4 * ((x >> 4) & 1) + (x & 3); }
DEVI int cidx(int d, int e) { return ((((e >> 4) * 4 + (d >> 4)) * 64) + (e & 15) + 16 * ((d >> 2) & 3)) * 4 + (d & 3); }
DEVI int gdn_chunk_t0(int ci) { return ci < 256 ? (ci >> 7) * SEQ + (ci & 127) * 64 : TL + ((ci - 256) >> 2) * CTXL + ((ci - 256) & 3) * 64; }

DEVI void gdn_chunk_item(const Params& p, int item, char* smem) {
  u16* sK = (u16*)smem;
  float* sA = (float*)(smem + 9216);
  u16* sXt = (u16*)smem;
  u16* sAt = (u16*)(smem + 26624);
  u16* sKt = (u16*)(smem + 35840);
  float* sX = (float*)(smem + 45056);
  float* sgc = (float*)(smem + 77824); float* sbeta = sgc + 64; float* seg = sbeta + 64; float* skd = seg + 64;
  const u16* GQ = (const u16*)(p.ws + O_GQ); const u16* GK = (const u16*)(p.ws + O_GK); const u16* GV = (const u16*)(p.ws + O_GV);
  const float* GG = (const float*)(p.ws + O_GG); const float* GB = (const float*)(p.ws + O_GBETA);
  u16* GM = (u16*)(p.ws + O_GM); u16* GQP = (u16*)(p.ws + O_GQP); u16* GN = (u16*)(p.ws + O_GN); u16* GLO = (u16*)(p.ws + O_GLO);
  const int tid = p.tid, lane = tid & 63, w = tid >> 6, i15 = lane & 15, q = lane >> 4;
  {
    const int ci = item >> 3, hd = (item >> 1) & 3, dir = item & 1;
    const int t0 = gdn_chunk_t0(ci);
    auto tok = [&](int i) { return dir ? t0 + 63 - i : t0 + i; };
    __syncthreads();
    if (tid < 64) {
      float g = GG[((size_t)dir * T + tok(tid)) * 4 + hd];
#pragma unroll
      for (int o = 1; o < 64; o <<= 1) { float u = __shfl_up(g, o); if (lane >= o) g += u; }
      const float gl = __shfl(g, 63);
      sgc[tid] = g; sbeta[tid] = GB[((size_t)dir * T + tok(tid)) * 4 + hd]; seg[tid] = expf(g); skd[tid] = expf(gl - g);
    }
    __syncthreads();
    const float eglast = seg[63];
#pragma unroll
    for (int i = 0; i < 2; ++i) {
      const int ch = tid + 256 * i, j = ch >> 3, cc = ch & 7;
      const u32x4 kv = *(const u32x4*)(GK + (size_t)tok(j) * 256 + hd * 64 + cc * 8);
      *(u32x4*)&sK[j * 72 + cc * 8] = kv;
      const float kd = skd[j];
#pragma unroll
      for (int e = 0; e < 4; ++e) {
        sKt[(cc * 8 + 2 * e) * 72 + j] = f2bf(bf2f((u16)(kv[e] & 0xffff)) * kd);
        sKt[(cc * 8 + 2 * e + 1) * 72 + j] = f2bf(bf2f((u16)(kv[e] >> 16)) * kd);
      }
    }
#pragma unroll
    for (int i = 0; i < 2; ++i) {
      const int ch = tid + 256 * i, j = ch >> 3, cc = ch & 7;
      const u32x4 vv = *(const u32x4*)(GV + (size_t)tok(j) * 256 + hd * 64 + cc * 8);
      const float bj = sbeta[j];
      float* d = sX + j * 128 + cc * 8;
#pragma unroll
      for (int e = 0; e < 4; ++e) { d[2 * e] = bflo(vv[e]) * bj; d[2 * e + 1] = bfhi(vv[e]) * bj; }
    }
    __syncthreads();
    for (int e = tid; e < 64 * 64; e += 256) {
      const int j = e >> 6, c = e & 63;
      sX[j * 128 + 64 + c] = bf2f(sK[j * 72 + c]) * sbeta[j] * seg[j];
    }
    {
      f32x4 kk[4], qk[4];
#pragma unroll
      for (int nt = 0; nt < 4; ++nt) { kk[nt] = fzero4(); qk[nt] = fzero4(); }
#pragma unroll
      for (int ks = 0; ks < 2; ++ks) {
        const bf16x8 ak = *(const bf16x8*)&sK[(16 * w + i15) * 72 + ks * 32 + q * 8];
        const bf16x8 aq = *(const bf16x8*)(GQ + (size_t)tok(16 * w + i15) * 256 + hd * 64 + ks * 32 + q * 8);
#pragma unroll
        for (int nt = 0; nt < 4; ++nt) {
          const bf16x8 bk = *(const bf16x8*)&sK[(16 * nt + i15) * 72 + ks * 32 + q * 8];
          kk[nt] = MFMA16(ak, bk, kk[nt]); qk[nt] = MFMA16(aq, bk, qk[nt]);
        }
      }
#pragma unroll
      for (int nt = 0; nt < 4; ++nt)
#pragma unroll
        for (int r = 0; r < 4; ++r) {
          const int i = 16 * w + 4 * q + r, j = 16 * nt + i15;
          const float dec = i >= j ? expf(sgc[i] - sgc[j]) : 0.f;
          sA[i * 68 + j] = i > j ? sbeta[i] * kk[nt][r] * dec : 0.f;
          sAt[i * 72 + j] = f2bf(i >= j ? qk[nt][r] * dec : 0.f);
        }
    }
    __syncthreads();
    if (tid < 128) {
      const int c = tid;
      for (int ib = 0; ib < 16; ++ib) {
        float a0 = sX[(4 * ib) * 128 + c], a1 = sX[(4 * ib + 1) * 128 + c], a2 = sX[(4 * ib + 2) * 128 + c], a3 = sX[(4 * ib + 3) * 128 + c];
#pragma unroll 4
        for (int g = 0; g < ib; ++g) {
          const float x0 = sX[(4 * g) * 128 + c], x1 = sX[(4 * g + 1) * 128 + c], x2 = sX[(4 * g + 2) * 128 + c], x3 = sX[(4 * g + 3) * 128 + c];
          const f32x4 r0 = *(const f32x4*)&sA[(4 * ib) * 68 + 4 * g], r1 = *(const f32x4*)&sA[(4 * ib + 1) * 68 + 4 * g];
          const f32x4 r2 = *(const f32x4*)&sA[(4 * ib + 2) * 68 + 4 * g], r3 = *(const f32x4*)&sA[(4 * ib + 3) * 68 + 4 * g];
          a0 -= r0[0] * x0 + r0[1] * x1 + r0[2] * x2 + r0[3] * x3;
          a1 -= r1[0] * x0 + r1[1] * x1 + r1[2] * x2 + r1[3] * x3;
          a2 -= r2[0] * x0 + r2[1] * x1 + r2[2] * x2 + r2[3] * x3;
          a3 -= r3[0] * x0 + r3[1] * x1 + r3[2] * x2 + r3[3] * x3;
        }
        const f32x4 d1 = *(const f32x4*)&sA[(4 * ib + 1) * 68 + 4 * ib], d2 = *(const f32x4*)&sA[(4 * ib + 2) * 68 + 4 * ib], d3 = *(const f32x4*)&sA[(4 * ib + 3) * 68 + 4 * ib];
        a1 -= d1[0] * a0;
        a2 -= d2[0] * a0 + d2[1] * a1;
        a3 -= d3[0] * a0 + d3[1] * a1 + d3[2] * a2;
        sX[(4 * ib) * 128 + c] = a0; sX[(4 * ib + 1) * 128 + c] = a1; sX[(4 * ib + 2) * 128 + c] = a2; sX[(4 * ib + 3) * 128 + c] = a3;
      }
    }
    __syncthreads();
    {
      const int c = tid & 127, jh = (tid >> 7) * 32;
#pragma unroll
      for (int g = 0; g < 4; ++g) {
        u32x4 pk;
#pragma unroll
        for (int e = 0; e < 4; ++e) pk[e] = pack2(sX[(jh + 8 * g + 2 * e) * 128 + c], sX[(jh + 8 * g + 2 * e + 1) * 128 + c]);
        *(u32x4*)&sXt[c * 72 + jh + 8 * g] = pk;
      }
    }
    __syncthreads();
    {
      f32x4 r1[8], r2[8];
#pragma unroll
      for (int ct = 0; ct < 8; ++ct) { r1[ct] = fzero4(); r2[ct] = fzero4(); }
#pragma unroll
      for (int ks = 0; ks < 2; ++ks) {
        const bf16x8 aa = *(const bf16x8*)&sAt[(16 * w + i15) * 72 + ks * 32 + q * 8];
        const bf16x8 ak = *(const bf16x8*)&sKt[(16 * w + i15) * 72 + ks * 32 + q * 8];
#pragma unroll
        for (int ct = 0; ct < 8; ++ct) {
          const bf16x8 bx = *(const bf16x8*)&sXt[(16 * ct + i15) * 72 + ks * 32 + q * 8];
          r1[ct] = MFMA16(aa, bx, r1[ct]); r2[ct] = MFMA16(ak, bx, r2[ct]);
        }
      }
      const size_t ib = (size_t)item * 4096;
#pragma unroll
      for (int ct = 0; ct < 4; ++ct) {
        u32x2 a, b;
        a[0] = pack2(r1[ct][0], r1[ct][1]); a[1] = pack2(r1[ct][2], r1[ct][3]);
        b[0] = pack2(r2[ct][0], r2[ct][1]); b[1] = pack2(r2[ct][2], r2[ct][3]);
        *(u32x2*)(GLO + ib + ((ct * 4 + w) * 64 + lane) * 4) = a;
        *(u32x2*)(GN + ib + ((ct * 4 + w) * 64 + lane) * 4) = b;
      }
#pragma unroll
      for (int ct = 4; ct < 8; ++ct)
#pragma unroll
        for (int r = 0; r < 4; ++r) {
          const int row = 16 * w + 4 * q + r, col = 16 * (ct - 4) + i15;
          const float qv = bf2f(GQ[(size_t)tok(row) * 256 + hd * 64 + col]);
          GQP[ib + row * 64 + permcol(col)] = f2bf(qv * seg[row] - r1[ct][r]);
          GM[ib + row * 64 + permcol(col)] = f2bf((row == col ? eglast : 0.f) - r2[ct][r]);
        }
    }
    __syncthreads();
  }
}

DEVI void gdn_scan_chain(const Params& p, int chain, char* smem) {
  const int tid = p.tid, lane = tid & 63, w = tid >> 6, i15 = lane & 15, q = lane >> 4;
  u16* sM = (u16*)smem;
  u16* sQ = sM + 2 * 64 * 72;
  const u16* GM = (const u16*)(p.ws + O_GM); const u16* GQP = (const u16*)(p.ws + O_GQP);
  const u16* GN = (const u16*)(p.ws + O_GN); const u16* GLO = (const u16*)(p.ws + O_GLO);
  float* GO = (float*)(p.ws + O_GO);
  {
    const int b = chain >> 3, hd = (chain >> 1) & 3, dir = chain & 1;
    f32x4 S[4];
#pragma unroll
    for (int r = 0; r < 4; ++r) S[r] = fzero4();
    auto item_of = [&](int n) {
      int ci = n < 4 ? 256 + b * 4 + (dir ? 3 - n : n) : b * 128 + (dir ? 127 - (n - 4) : (n - 4));
      return ci * 8 + hd * 2 + dir;
    };
    u32x4 pm[2], pq[2]; u32x2 pn[4], pl[4];
    auto prefetch = [&](int n) {
      const size_t base = (size_t)item_of(n) * 4096;
#pragma unroll
      for (int i = 0; i < 2; ++i) {
        const int ch = tid + 256 * i;
        pm[i] = *(const u32x4*)(GM + base + ch * 8);
        pq[i] = *(const u32x4*)(GQP + base + ch * 8);
      }
#pragma unroll
      for (int rb = 0; rb < 4; ++rb) {
        pn[rb] = *(const u32x2*)(GN + base + ((w * 4 + rb) * 64 + lane) * 4);
        pl[rb] = *(const u32x2*)(GLO + base + ((w * 4 + rb) * 64 + lane) * 4);
      }
    };
    prefetch(0);
    __syncthreads();
    for (int n = 0; n < 132; ++n) {
      const int buf = n & 1;
      u16* bM = sM + buf * 64 * 72; u16* bQ = sQ + buf * 64 * 72;
#pragma unroll
      for (int i = 0; i < 2; ++i) {
        const int ch = tid + 256 * i, row = ch >> 3, cc = ch & 7;
        *(u32x4*)&bM[row * 72 + cc * 8] = pm[i];
        *(u32x4*)&bQ[row * 72 + cc * 8] = pq[i];
      }
      f32x4 accs[4], acco[4];
#pragma unroll
      for (int rb = 0; rb < 4; ++rb) {
        accs[rb] = f32x4{bf2f((u16)(pn[rb][0] & 0xffff)), bf2f((u16)(pn[rb][0] >> 16)), bf2f((u16)(pn[rb][1] & 0xffff)), bf2f((u16)(pn[rb][1] >> 16))};
        acco[rb] = f32x4{bf2f((u16)(pl[rb][0] & 0xffff)), bf2f((u16)(pl[rb][0] >> 16)), bf2f((u16)(pl[rb][1] & 0xffff)), bf2f((u16)(pl[rb][1] >> 16))};
      }
      const int ci = n < 4 ? 256 + b * 4 + (dir ? 3 - n : n) : b * 128 + (dir ? 127 - (n - 4) : (n - 4));
      const int t0 = gdn_chunk_t0(ci);
      __syncthreads();
      if (n + 1 < 132) prefetch(n + 1);
      bf16x8 sb[2];
#pragma unroll
      for (int kb = 0; kb < 2; ++kb)
#pragma unroll
        for (int jj = 0; jj < 8; ++jj) sb[kb][jj] = (short)f2bf(S[2 * kb + (jj >> 2)][jj & 3]);
#pragma unroll
      for (int kb = 0; kb < 2; ++kb)
#pragma unroll
        for (int rb = 0; rb < 4; ++rb) {
          const bf16x8 am = *(const bf16x8*)&bM[(rb * 16 + i15) * 72 + kb * 32 + q * 8];
          const bf16x8 aq = *(const bf16x8*)&bQ[(rb * 16 + i15) * 72 + kb * 32 + q * 8];
          accs[rb] = MFMA16(am, sb[kb], accs[rb]);
          acco[rb] = MFMA16(aq, sb[kb], acco[rb]);
        }
#pragma unroll
      for (int rb = 0; rb < 4; ++rb) {
        S[rb] = accs[rb];
#pragma unroll
        for (int r = 0; r < 4; ++r) {
          const int i = rb * 16 + q * 4 + r;
          const int t = dir ? t0 + 63 - i : t0 + i;
          GO[(size_t)dir * T * 256 + (size_t)t * 256 + hd * 64 + w * 16 + i15] = acco[rb][r];
        }
      }
    }
    __syncthreads();
  }
}


template <int DQK>
DEVI void attn_run(int tid, const u16* __restrict__ Qp, int qrow0, const u16* __restrict__ Kp, const u16* __restrict__ Vtp,
                   int a0, int a1, int b0, int b1, int qpos0, float sink2, f32x16 (&O)[2], char* smem) {
  constexpr int KLD = DQK + 8, NS = DQK / 16, KCH = DQK / 8, NKL = (64 * KCH) / 256;
  constexpr int BUF = 64 * KLD + 64 * 72;
  u16* sbase = (u16*)smem;
  const int lane = tid & 63, wid = tid >> 6, r31 = lane & 31, hh = lane >> 5;
  const int qrow = qrow0 + wid * 32 + r31;
  bf16x8 qf[NS];
#pragma unroll
  for (int s = 0; s < NS; ++s) qf[s] = *(const bf16x8*)(Qp + (size_t)qrow * DQK + s * 16 + hh * 8);
#pragma unroll
  for (int i = 0; i < 16; ++i) { O[0][i] = 0.f; O[1][i] = 0.f; }
  float m = -30000.f, lsum = 0.f;
  const int na = (a1 - a0) >> 6, nt = na + ((b1 - b0) >> 6);
  const int qpos = qpos0 + wid * 32 + r31;
  u32x4 rk[NKL], rv[2];
  auto gload = [&](int ti) {
    const int key0 = ti >= na ? b0 + (ti - na) * 64 : a0 + ti * 64;
#pragma unroll
    for (int i = 0; i < NKL; ++i) { const int q = tid + 256 * i, r = q / KCH, cc = q % KCH; rk[i] = *(const u32x4*)(Kp + (size_t)(key0 + r) * DQK + cc * 8); }
#pragma unroll
    for (int i = 0; i < 2; ++i) { const int q = tid + 256 * i, r = q >> 3, cc = q & 7; rv[i] = *(const u32x4*)(Vtp + (size_t)r * NKEY + key0 + cc * 8); }
  };
  auto lstore = [&](int buf) {
    u16* sK = sbase + buf * BUF; u16* sV = sK + 64 * KLD;
#pragma unroll
    for (int i = 0; i < NKL; ++i) { const int q = tid + 256 * i, r = q / KCH, cc = q % KCH; *(u32x4*)&sK[r * KLD + cc * 8] = rk[i]; }
#pragma unroll
    for (int i = 0; i < 2; ++i) { const int q = tid + 256 * i, r = q >> 3, cc = q & 7; *(u32x4*)&sV[r * 72 + cc * 8] = rv[i]; }
  };
  m = 0.f;
  f32x16 negm;
#pragma unroll
  for (int i = 0; i < 16; ++i) negm[i] = 0.f;
  gload(0);
  __syncthreads();
  lstore(0);
  __syncthreads();
  for (int ti = 0; ti < nt; ++ti) {
    if (ti + 1 < nt) gload(ti + 1);
    const u16* sK = sbase + (ti & 1) * BUF; const u16* sV = sK + 64 * KLD;
    const bool inB = ti >= na;
    const int key0 = inB ? b0 + (ti - na) * 64 : a0 + ti * 64;
    f32x16 st[2];
#pragma unroll
    for (int k2 = 0; k2 < 2; ++k2) {
      {
        const bf16x8 kf = *(const bf16x8*)&sK[(k2 * 32 + r31) * KLD + hh * 8];
        asm volatile("v_mfma_f32_32x32x16_bf16 %0, %1, %2, %3" : "=&v"(st[k2]) : "v"(kf), "v"(qf[0]), "v"(negm));
      }
#pragma unroll
      for (int s = 1; s < NS; ++s) {
        const bf16x8 kf = *(const bf16x8*)&sK[(k2 * 32 + r31) * KLD + s * 16 + hh * 8];
        st[k2] = MFMA32(kf, qf[s], st[k2]);
      }
    }
    if (inB) {
#pragma unroll
      for (int k2 = 0; k2 < 2; ++k2)
#pragma unroll
        for (int g = 0; g < 16; ++g) {
          const int d = key0 + k2 * 32 + (g & 3) + 8 * (g >> 2) + 4 * hh - qpos;
          if (d > 128 || d < -128) st[k2][g] = -1e30f;
        }
    }
    bf16x8 vfr[2][2][2];
#pragma unroll
    for (int k2 = 0; k2 < 2; ++k2)
#pragma unroll
      for (int s2 = 0; s2 < 2; ++s2)
#pragma unroll
        for (int dvt = 0; dvt < 2; ++dvt) vfr[k2][s2][dvt] = *(const bf16x8*)&sV[(dvt * 32 + r31) * 72 + k2 * 32 + s2 * 16 + 8 * hh];
    float mx = st[0][0];
#pragma unroll
    for (int g = 1; g < 16; ++g) mx = fmaxf(mx, st[0][g]);
#pragma unroll
    for (int g = 0; g < 16; ++g) mx = fmaxf(mx, st[1][g]);
    { auto rr = __builtin_amdgcn_permlane32_swap(__float_as_uint(mx), __float_as_uint(mx), false, false);
      mx = fmaxf(__uint_as_float(rr[0]), __uint_as_float(rr[1])); }
    if (ti == 0 || __any(mx > 8.f)) {
      const float delta = ti == 0 ? fmaxf(mx, -1e4f) : fmaxf(mx, 0.f);
      if (ti != 0) {
        const float alpha = __builtin_amdgcn_exp2f(-delta);
        lsum *= alpha;
#pragma unroll
        for (int i = 0; i < 16; ++i) { O[0][i] *= alpha; O[1][i] *= alpha; }
      }
      m += delta;
#pragma unroll
      for (int i = 0; i < 16; ++i) { negm[i] = -m; st[0][i] -= delta; st[1][i] -= delta; }
    }
    f32x2 ps2 = {0.f, 0.f};
#pragma unroll
    for (int k2 = 0; k2 < 2; ++k2)
#pragma unroll
      for (int g = 0; g < 16; g += 2) {
        const float p0 = __builtin_amdgcn_exp2f(st[k2][g]), p1 = __builtin_amdgcn_exp2f(st[k2][g + 1]);
        st[k2][g] = p0; st[k2][g + 1] = p1;
        ps2 += f32x2{p0, p1};
      }
    lsum += ps2[0] + ps2[1];
#pragma unroll
    for (int k2 = 0; k2 < 2; ++k2)
#pragma unroll
      for (int s2 = 0; s2 < 2; ++s2) {
        u32x4 pp;
#pragma unroll
        for (int j = 0; j < 4; ++j) pp[j] = pack2(st[k2][8 * s2 + 2 * j], st[k2][8 * s2 + 2 * j + 1]);
        const bf16x8 pf = __builtin_bit_cast(bf16x8, pp);
#pragma unroll
        for (int dvt = 0; dvt < 2; ++dvt) {
          O[dvt] = MFMA32(vfr[k2][s2][dvt], pf, O[dvt]);
        }
      }
    if (ti + 1 < nt) lstore((ti + 1) & 1);
    __syncthreads();
  }
  if (sink2 > -1e29f) {
    const float mn = fmaxf(m, sink2);
    const float alpha = __builtin_amdgcn_exp2f(m - mn);
    lsum = lsum * alpha + (hh == 0 ? __builtin_amdgcn_exp2f(sink2 - mn) : 0.f);
#pragma unroll
    for (int i = 0; i < 16; ++i) { O[0][i] *= alpha; O[1][i] *= alpha; }
  }
  const float ltot = lsum + __shfl_xor(lsum, 32);
  const float inv = 1.f / ltot;
#pragma unroll
  for (int i = 0; i < 16; ++i) { O[0][i] *= inv; O[1][i] *= inv; }
}
DEVI void attn_store(int tid, const f32x16 (&O)[2], u16* dst, int ld, int b, int qrow0, int col0) {
  const int lane = tid & 63, wid = tid >> 6, r31 = lane & 31, hh = lane >> 5;
  const int qrow = qrow0 + wid * 32 + r31;
  const int t = qrow < SEQ ? b * SEQ + qrow : TL + b * CTXL + (qrow - SEQ);
  u16* yr = dst + (size_t)t * ld + col0;
#pragma unroll
  for (int dvt = 0; dvt < 2; ++dvt)
#pragma unroll
    for (int g4 = 0; g4 < 4; ++g4) {
      u32x2 pk; pk[0] = pack2(O[dvt][g4 * 4 + 0], O[dvt][g4 * 4 + 1]); pk[1] = pack2(O[dvt][g4 * 4 + 2], O[dvt][g4 * 4 + 3]);
      *(u32x2*)(yr + dvt * 32 + 8 * g4 + 4 * hh) = pk;
    }
}
DEVI void attn_item(const Params& p, int l, int mixer, int b, int h, int qb, char* smem) {
  const bool lat = qb < 64;
  const int qrow0 = qb * 128;
  f32x16 O[2];
  if (mixer == 0) {
    attn_run<32>(p.tid, (const u16*)(p.ws + O_QB) + (size_t)(b * 8 + h) * NKEY * 32, qrow0, (const u16*)(p.ws + O_KB) + (size_t)(b * 8 + h) * NKEY * 32,
                 (const u16*)(p.ws + O_VTB) + (size_t)(b * 4 + (h >> 1)) * 64 * NKEY, lat ? 0 : SEQ, NKEY, 0, 0, 0, -1e30f, O, smem);
    attn_store(p.tid, O, (u16*)(p.ws + O_OB), 512, b, qrow0, h * 64);
  } else if (mixer == 1) {
    attn_run<96>(p.tid, (const u16*)(p.ws + O_QC) + (size_t)(b * 4 + h) * NKEY * 96, qrow0, (const u16*)(p.ws + O_KC) + (size_t)(b * 4 + h) * NKEY * 96,
                 (const u16*)(p.ws + O_VTC) + (size_t)(b * 4 + h) * 64 * NKEY, lat ? 0 : SEQ, NKEY, 0, 0, 0, -1e30f, O, smem);
    attn_store(p.tid, O, (u16*)(p.ws + O_Y), 1024, b, qrow0, 512 + h * 64);
  } else {
    const float sink2 = pin(p, I_SINK)[l * 4 + h] * LOG2E;
    const int hk = h >> 1;
    int b0 = 0, b1 = 0;
    if (lat) { b0 = (qb - 1) * 128; if (b0 < 0) b0 = 0; b1 = (qb + 2) * 128; if (b1 > SEQ) b1 = SEQ; }
    attn_run<64>(p.tid, (const u16*)(p.ws + O_QA) + (size_t)(b * 4 + h) * NKEY * 64, qrow0, (const u16*)(p.ws + O_KA) + (size_t)(b * 2 + hk) * NKEY * 64,
                 (const u16*)(p.ws + O_VTA) + (size_t)(b * 2 + hk) * 64 * NKEY, SEQ, NKEY, b0, b1, qrow0, sink2, O, smem);
    attn_store(p.tid, O, (u16*)(p.ws + O_Y), 1024, b, qrow0, h * 64);
  }
}

constexpr int SMEM_BYTES = 78848 + 64;

DEVI unsigned long long launder_ptr(unsigned long long v) {
  unsigned lo = __builtin_amdgcn_readfirstlane((unsigned)v), hi = __builtin_amdgcn_readfirstlane((unsigned)(v >> 32));
  asm volatile("s_mov_b32 %0, %1" : "=s"(lo) : "s"(lo));
  asm volatile("s_mov_b32 %0, %1" : "=s"(hi) : "s"(hi));
  return ((unsigned long long)hi << 32) | lo;
}
DEVI Params mkctx(const KArgs& a) {
  Params c;
  typedef __attribute__((address_space(1))) char gchar;
  typedef __attribute__((address_space(1))) float gfloat;
  c.ws = (char*)(gchar*)launder_ptr((unsigned long long)a.ws);
  c.out = (float*)(gfloat*)launder_ptr((unsigned long long)a.out);
  c.in = (gcfloat* const*)(c.ws + O_TAB);
  c.tid = threadIdx.x;
  asm volatile("" : "+v"(c.tid));
  return c;
}
DEVI void st_mixer_queue(const KArgs& a, int l, char* smem) {
  int* sitem = (int*)(smem + SMEM_BYTES - 16);
  const int g = blockIdx.x & 7;
  const int nctx = l == 0 ? 8 : 0;
  constexpr int NPREP = TR_P2 / 8 / 8;
  const int total = 2 + 128 + 64 + 64 + nctx + NPREP;
  for (;;) {
    const Params p = mkctx(a);
    unsigned* head = (unsigned*)(p.ws + O_BAR) + 16 + l * 8 + g;
    __syncthreads();
    if (p.tid == 0) *sitem = (int)atomicAdd(head, 1u);
    __syncthreads();
    int it = *sitem;
    if (it >= total) break;
    if (it < 2) { gdn_scan_chain(p, 2 * g + it, smem); continue; }
    it -= 2;
    if (it < 256 + nctx) {
      int mixer, b, h, qb;
      if (it < 128) { const int pr = 2 * g + (it >> 6); mixer = 0; b = pr >> 3; h = pr & 7; qb = it & 63; }
      else if (it < 256) { mixer = 1 + ((it - 128) >> 6); b = g >> 2; h = g & 3; qb = it & 63; }
      else {
        const int j = it - 256;
        if (j < 4) { const int pr = 2 * g + (j >> 1); mixer = 0; b = pr >> 3; h = pr & 7; qb = 64 + (j & 1); }
        else { mixer = 1 + ((j - 4) >> 1); b = g >> 2; h = g & 3; qb = 64 + (j & 1); }
      }
      attn_item(p, l, mixer, b, h, qb, smem);
      continue;
    }
    it -= 256 + nctx;
    prep_w2_run8(p, l, (it * 8 + g) * 8, (float*)smem);
  }
}

DEVI void st_mix_finish(const Params& p, int l, int vb, int nvb) {
  const int lane = p.tid & 63, wid = p.tid >> 6;
  const float* GO = (const float*)(p.ws + O_GO); const u16* PP = (const u16*)(p.ws + O_PP); const u16* OB = (const u16*)(p.ws + O_OB);
  u16* Y = (u16*)(p.ws + O_Y);
  const float lam_init = 0.8f - 0.6f * expf(-0.3f * (float)l);
  float d1 = lane < 32 ? pin(p, I_LQ1)[l * 32 + lane] * pin(p, I_LK1)[l * 32 + lane] : 0.f;
  float d2 = lane < 32 ? pin(p, I_LQ2)[l * 32 + lane] * pin(p, I_LK2)[l * 32 + lane] : 0.f;
  const float lam = expf(wave_sum(d1)) - expf(wave_sum(d2)) + lam_init;
  const int hd = lane >> 4, d0 = (lane & 15) * 4;
  const f32x4 gg = *(const f32x4*)(pin(p, I_GNG) + l * 64 + d0);
  const f32x4 dg = *(const f32x4*)(pin(p, I_DNG) + l * 64 + d0) * (1.f - lam_init);
  const int tend = l == 0 ? T : TL;
  for (int t0 = (vb * 4 + wid) * 2; t0 < tend; t0 += nvb * 8) {
    u32x2 o0[2], o1[2], zz[2]; f32x4 gf[2], gb[2];
#pragma unroll
    for (int u = 0; u < 2; ++u) {
      const size_t t = t0 + u;
      o0[u] = *(const u32x2*)(OB + t * 512 + (hd * 2) * 64 + d0);
      o1[u] = *(const u32x2*)(OB + t * 512 + (hd * 2 + 1) * 64 + d0);
      gf[u] = *(const f32x4*)(GO + t * 256 + hd * 64 + d0);
      gb[u] = *(const f32x4*)(GO + (size_t)T * 256 + t * 256 + hd * 64 + d0);
      zz[u] = *(const u32x2*)(PP + t * LDPP + PP_DZ + hd * 64 + d0);
    }
    f32x4 od[2], go[2]; float ssb[2], ssg[2];
#pragma unroll
    for (int u = 0; u < 2; ++u) {
      const f32x4 a = {bflo(o0[u][0]), bfhi(o0[u][0]), bflo(o0[u][1]), bfhi(o0[u][1])};
      const f32x4 b = {bflo(o1[u][0]), bfhi(o1[u][0]), bflo(o1[u][1]), bfhi(o1[u][1])};
      od[u] = a - lam * b; go[u] = gf[u] + gb[u];
      ssb[u] = od[u][0] * od[u][0] + od[u][1] * od[u][1] + od[u][2] * od[u][2] + od[u][3] * od[u][3];
      ssg[u] = go[u][0] * go[u][0] + go[u][1] * go[u][1] + go[u][2] * go[u][2] + go[u][3] * go[u][3];
    }
#pragma unroll
    for (int o = 8; o >= 1; o >>= 1) {
#pragma unroll
      for (int u = 0; u < 2; ++u) { ssb[u] += __shfl_xor(ssb[u], o); ssg[u] += __shfl_xor(ssg[u], o); }
    }
#pragma unroll
    for (int u = 0; u < 2; ++u) {
      const size_t t = t0 + u;
      const f32x4 yb = od[u] * (rsqrtf(ssb[u] * (1.f / 64.f) + 1e-6f)) * dg;
      const f32x4 z = {bflo(zz[u][0]), bfhi(zz[u][0]), bflo(zz[u][1]), bfhi(zz[u][1])};
      const f32x4 sz = {siluf(z[0]), siluf(z[1]), siluf(z[2]), siluf(z[3])};
      const f32x4 yd = go[u] * (rsqrtf(ssg[u] * (1.f / 64.f) + 1e-6f)) * gg * sz;
      u32x2 pb, pd;
      pb[0] = pack2(yb[0], yb[1]); pb[1] = pack2(yb[2], yb[3]);
      pd[0] = pack2(yd[0], yd[1]); pd[1] = pack2(yd[2], yd[3]);
      *(u32x2*)(Y + t * 1024 + 256 + hd * 64 + d0) = pb;
      *(u32x2*)(Y + t * 1024 + 768 + hd * 64 + d0) = pd;
    }
  }
}

constexpr int RLD = 1026;
DEVI void st_norm2_route(const Params& p, int l, int vb, int nvb, char* smem) {
  const int lane = p.tid & 63, wid = p.tid >> 6, i15 = lane & 15, q = lane >> 4;
  float* shh = (float*)smem;
  float* slog = shh + 16 * RLD;
  const float* g = pin(p, I_N2G) + l * 1024;
  const float* wr = pin(p, I_WR) + (size_t)l * 1024 * 64;
  const float bias = pin(p, I_RB)[l * 64 + lane];
  float* WTS = (float*)(p.ws + O_WTS); int* CNT = (int*)(p.ws + O_CNT); int* LIST = (int*)(p.ws + O_LIST);
  const int ntok = l == 0 ? T : TL;
  for (int grp = vb; grp < ntok / 16; grp += nvb) {
    const int tb = grp * 16 + wid * 4;
    const int mv = tok_mv(tb);
    const float* sh = modp(p, l, mv, 3); const float* sc = modp(p, l, mv, 4);
    {
      f32x4 v[4][4]; float ss[4];
#pragma unroll
      for (int u = 0; u < 4; ++u) {
        const f32x4* xr = (const f32x4*)((const float*)(p.ws + O_XA) + (size_t)(tb + u) * 1024);
#pragma unroll
        for (int i = 0; i < 4; ++i) v[u][i] = xr[i * 64 + lane];
      }
#pragma unroll
      for (int u = 0; u < 4; ++u) {
        float a = 0.f;
#pragma unroll
        for (int i = 0; i < 4; ++i) a += v[u][i][0] * v[u][i][0] + v[u][i][1] * v[u][i][1] + v[u][i][2] * v[u][i][2] + v[u][i][3] * v[u][i][3];
        ss[u] = a;
      }
#pragma unroll
      for (int o = 32; o >= 1; o >>= 1) {
#pragma unroll
        for (int u = 0; u < 4; ++u) ss[u] += __shfl_xor(ss[u], o);
      }
#pragma unroll
      for (int i = 0; i < 4; ++i) {
        const int c = i * 256 + lane * 4;
        const f32x4 gg = *(const f32x4*)(g + c), s4 = *(const f32x4*)(sc + c), h4 = *(const f32x4*)(sh + c);
        const f32x4 gs = gg * (1.f + s4);
#pragma unroll
        for (int u = 0; u < 4; ++u) {
          const float rstd = rsqrtf(ss[u] * (1.f / 1024.f) + 1e-6f);
          const f32x4 o = v[u][i] * rstd * gs + h4;
          u32x2 pk; pk[0] = pack2(o[0], o[1]); pk[1] = pack2(o[2], o[3]);
          *(u32x2*)((u16*)(p.ws + O_H) + (size_t)(tb + u) * LDH + c) = pk;
          float* d = shh + (wid * 4 + u) * RLD + c;
          *(f32x2*)d = f32x2{o[0], o[1]}; *(f32x2*)(d + 2) = f32x2{o[2], o[3]};
        }
      }
    }
    __syncthreads();
    {
      f32x4 a0 = fzero4(), a1 = a0;
      const float* ap = shh + i15 * RLD + q;
      const float* bp = wr + (size_t)q * 64 + wid * 16 + i15;
#pragma unroll 1
      for (int kb = 0; kb < 256; kb += 32) {
        float bv[32];
#pragma unroll
        for (int j = 0; j < 32; ++j) bv[j] = bp[(size_t)(4 * (kb + j)) * 64];
#pragma unroll
        for (int j = 0; j < 32; j += 2) {
          a0 = __builtin_amdgcn_mfma_f32_16x16x4f32(ap[4 * (kb + j)], bv[j], a0, 0, 0, 0);
          a1 = __builtin_amdgcn_mfma_f32_16x16x4f32(ap[4 * (kb + j) + 4], bv[j + 1], a1, 0, 0, 0);
        }
      }
#pragma unroll
      for (int r = 0; r < 4; ++r) slog[(4 * q + r) * 64 + wid * 16 + i15] = a0[r] + a1[r];
    }
    __syncthreads();
#pragma unroll 1
    for (int u = 0; u < 4; ++u) {
      const int t = tb + u;
      const float logit = slog[(wid * 4 + u) * 64 + lane];
      const float s = 1.f / (1.f + expf(-logit));
      const float c = s + bias;
      float m1 = c;
      m1 = fmaxf(m1, __shfl_xor(m1, 1)); m1 = fmaxf(m1, __shfl_xor(m1, 2)); m1 = fmaxf(m1, __shfl_xor(m1, 4));
      const unsigned long long bal = __ballot(c == m1);
      const int grpi = lane >> 3;
      const unsigned gm = (unsigned)((bal >> (grpi * 8)) & 0xffull);
      const int first = __ffs(gm) - 1;
      float m2 = ((lane & 7) == first) ? -INFINITY : c;
      m2 = fmaxf(m2, __shfl_xor(m2, 1)); m2 = fmaxf(m2, __shfl_xor(m2, 2)); m2 = fmaxf(m2, __shfl_xor(m2, 4));
      const float gs = m1 + m2;
      int grank = 0;
#pragma unroll
      for (int gg = 0; gg < 8; ++gg) { float o = __shfl(gs, gg * 8); grank += (o > gs || (o == gs && gg < grpi)) ? 1 : 0; }
      const bool gsel = grank < 4;
      const float mc = gsel ? c : -INFINITY;
      int rank = 0;
#pragma unroll
      for (int e = 0; e < 64; ++e) { float o = __shfl(mc, e); rank += (o > mc || (o == mc && e < lane)) ? 1 : 0; }
      const bool sel = gsel && rank < 6;
      const float ssum = wave_sum(sel ? s : 0.f);
      if (sel) {
        const int slot = t * 6 + rank;
        WTS[slot] = s / ssum * 2.5f;
        const int pos = atomicAdd(&CNT[lane], 1);
        LIST[(size_t)lane * T + pos] = slot;
      }
    }
    __syncthreads();
  }
}
DEVI void st_outproj(const Params& p, int l, int vb, int nvb, char* smem) {
  const u16* Y = (const u16*)(p.ws + O_Y); const u16* W = (const u16*)(p.ws + O_WOUTT); float* XA = (float*)(p.ws + O_XA);
  const int nmt = l == 0 ? 132 : 128;
  const int g = vb & 7, nmg = (nmt - g + 7) >> 3;
  for (int i = vb >> 3; i < nmg * 8; i += nvb >> 3) {
    const int m0 = (g + 8 * (i >> 3)) * 128, n0 = (i & 7) * 128;
    gemm128(p.tid, [&](int r) { return Y + (size_t)(m0 + r) * 1024; }, W + (size_t)n0 * LDW, LDW, 1024,
            [&](int r, int c, f32x4 v) {
              const int t = m0 + r; const float* gt = modp(p, l, tok_mv(t), 2) + n0 + c;
              float4* xp = (float4*)(XA + (size_t)t * 1024 + n0 + c);
              const float* xin = l == 0 ? (t < TL ? pin(p, I_X) + (size_t)t * 1024 : pin(p, I_CTX) + (size_t)(t - TL) * 1024) + n0 + c : (const float*)xp;
              float4 x = *(const float4*)xin;
              x.x += gt[0] * v[0]; x.y += gt[1] * v[1]; x.z += gt[2] * v[2]; x.w += gt[3] * v[3]; *xp = x;
              __builtin_amdgcn_sched_barrier(0);
            }, smem);
  }
}

DEVI void grp_tiles(const Params& p, int* tst, int g, int shift, int nshared) {
  __syncthreads();
  if (p.tid < 64) {
    const int* CNT = (const int*)(p.ws + O_CNT);
    const int lane = p.tid;
    int c = 0;
    if (lane < 8) c = (__hip_atomic_load(&CNT[g + 8 * lane], __ATOMIC_RELAXED, __HIP_MEMORY_SCOPE_AGENT) + (1 << shift) - 1) >> shift;
    int incl = c;
#pragma unroll
    for (int o = 1; o < 8; o <<= 1) { int u = __shfl_up(incl, o); if (lane >= o) incl += u; }
    if (lane < 8) tst[lane] = incl - c;
    if (lane == 7) { tst[8] = incl; tst[9] = incl + (nshared - g + 7) / 8; }
  }
  __syncthreads();
}
DEVI void grp_find(const int* tst, int tile, int g, int& e, int& lt) {
  int j = 0;
#pragma unroll
  for (int k = 1; k <= 8; ++k) j += tile >= tst[k] ? 1 : 0;
  if (j < 8) { e = g + 8 * j; lt = tile - tst[j]; } else { e = 64; lt = g + 8 * (tile - tst[8]); }
}
DEVI void st_moe1(const Params& p, int l, int vb, int nvb, char* smem) {
  const int* CNT = (const int*)(p.ws + O_CNT); const int* LIST = (const int*)(p.ws + O_LIST);
  const u16* H = (const u16*)(p.ws + O_H); u16* HB = (u16*)(p.ws + O_HB);
  int* sslot = (int*)(smem + 4 * 128 * GLD * 2);
  int* TST = sslot + 128;
  const int g = vb & 7;
  const int nsh = l == 0 ? T : TL;
  grp_tiles(p, TST, g, 7, nsh / 128);
  const int total = TST[9];
  for (int item = vb >> 3; item < total * 4; item += nvb >> 3) {
    const int tile = item >> 2, n0 = (item & 3) * 128;
    int e, lt; grp_find(TST, tile, g, e, lt);
    const int cnt = e < 64 ? __hip_atomic_load(&CNT[e], __ATOMIC_RELAXED, __HIP_MEMORY_SCOPE_AGENT) : nsh;
    __syncthreads();
    if (p.tid < 128) {
      int i = lt * 128 + p.tid;
      int slot = -1;
      if (i < cnt) slot = e < 64 ? LIST[(size_t)e * T + i] : NSLOT + i;
      sslot[p.tid] = slot;
    }
    __syncthreads();
    gemm128(p.tid, [&](int r) { int sl = sslot[r]; int tk = sl < 0 ? 0 : (sl < NSLOT ? sl / 6 : sl - NSLOT); return H + (size_t)tk * LDH; },
            (const u16*)(p.ws + O_WGUT) + ((size_t)e * 512 + n0) * LDW, LDW, 1024,
            [&](int r, int c, f32x4 v) {
              int sl = sslot[r]; if (sl < 0) return;
              float h0 = siluf(v[0]) * v[1], h1 = siluf(v[2]) * v[3];
              *(unsigned*)(HB + (size_t)sl * 256 + ((n0 + c) >> 1)) = pack2(h0, h1);
            }, smem);
  }
}
DEVI void st_moe2(const Params& p, int l, int vb, int nvb, char* smem) {
  const int* CNT = (const int*)(p.ws + O_CNT); const int* LIST = (const int*)(p.ws + O_LIST);
  const u16* HB = (const u16*)(p.ws + O_HB); u16* SO = (u16*)(p.ws + O_SLOT); const float* WTS = (const float*)(p.ws + O_WTS);
  constexpr int ALD = 264;
  u16* sA = (u16*)smem;
  u16* sB = sA + 64 * ALD;
  int* sslot = (int*)(sB + 2 * 128 * 72);
  int* TST = sslot + 64;
  const int tid = p.tid, lane = tid & 63, wid = tid >> 6, wr = wid >> 1, wc = wid & 1, fr = lane & 15, fq = lane >> 4;
  const int g = vb & 7;
  const int nsh = l == 0 ? T : TL;
  grp_tiles(p, TST, g, 6, nsh / 64);
  const int total = TST[9];
  for (int item = vb >> 3; item < total; item += nvb >> 3) {
    int e, lt; grp_find(TST, item, g, e, lt);
    const int cnt = e < 64 ? __hip_atomic_load(&CNT[e], __ATOMIC_RELAXED, __HIP_MEMORY_SCOPE_AGENT) : nsh;
    __syncthreads();
    if (tid < 64) { const int i = lt * 64 + tid; sslot[tid] = i < cnt ? (e < 64 ? LIST[(size_t)e * T + i] : NSLOT + i) : -1; }
    __syncthreads();
    const u16* Bbase = (const u16*)(p.ws + O_WDT) + (size_t)e * 1024 * 256;
    u32x4 rb0[4], rb1[4], rb2[4];
    const u16* bthr = Bbase + (size_t)(tid >> 3) * 256 + (tid & 7) * 8;
    auto gloadB = [&](u32x4 (&rb)[4], int bt) {
      int off = (bt >> 2) * 128 * 256 + (bt & 3) * 64;
      asm volatile("" : "+s"(off));
      const u16* src = bthr + off;
#pragma unroll
      for (int i = 0; i < 4; ++i) rb[i] = *(const u32x4*)(src + i * 32 * 256);
    };
    auto lstoreB = [&](const u32x4 (&rb)[4], int buf) {
      u16* d = sB + buf * 128 * 72;
#pragma unroll
      for (int i = 0; i < 4; ++i) { const int q = tid + 256 * i, r = q >> 3, cc = q & 7; *(u32x4*)&d[r * 72 + cc * 8] = rb[i]; }
    };
    gloadB(rb0, 0); gloadB(rb1, 1); gloadB(rb2, 2);
#pragma unroll
    for (int hf = 0; hf < 2; ++hf) {
      u32x4 ra[4];
#pragma unroll
      for (int i = 0; i < 4; ++i) { const int q = tid + 256 * (4 * hf + i), r = q >> 5, cc = q & 31; const int sl = sslot[r]; ra[i] = *(const u32x4*)(HB + (size_t)(sl < 0 ? 0 : sl) * 256 + cc * 8); }
#pragma unroll
      for (int i = 0; i < 4; ++i) { const int q = tid + 256 * (4 * hf + i), r = q >> 5, cc = q & 31; *(u32x4*)&sA[r * ALD + cc * 8] = ra[i]; }
      __builtin_amdgcn_sched_barrier(0);
    }
    int slot_m[2]; float w_m[2];
#pragma unroll
    for (int m = 0; m < 2; ++m) { const int sl = sslot[wr * 32 + m * 16 + fr]; slot_m[m] = sl; w_m[m] = (sl >= 0 && sl < NSLOT) ? WTS[sl] : 1.f; }
    lstoreB(rb0, 0); gloadB(rb0, 3);
    __syncthreads();
    f32x4 acc[2][4];
    auto compute = [&](int bt, int buf) {
      const int nt = bt >> 2, kt = bt & 3;
      const u16* b = sB + buf * 128 * 72;
      if (kt == 0) {
#pragma unroll
        for (int m = 0; m < 2; ++m)
#pragma unroll
          for (int n = 0; n < 4; ++n) acc[m][n] = fzero4();
      }
#pragma unroll
      for (int ks = 0; ks < 2; ++ks) {
        bf16x8 af[2], bfr[4];
#pragma unroll
        for (int m = 0; m < 2; ++m) af[m] = *(const bf16x8*)&sA[(wr * 32 + m * 16 + fr) * ALD + kt * 64 + ks * 32 + fq * 8];
#pragma unroll
        for (int n = 0; n < 4; ++n) bfr[n] = *(const bf16x8*)&b[(wc * 64 + n * 16 + fr) * 72 + ks * 32 + fq * 8];
#pragma unroll
        for (int m = 0; m < 2; ++m)
#pragma unroll
          for (int n = 0; n < 4; ++n) acc[m][n] = MFMA16(bfr[n], af[m], acc[m][n]);
      }
      if (kt == 3) {
#pragma unroll
        for (int m = 0; m < 2; ++m) {
          if (slot_m[m] >= 0) {
            const float w = w_m[m];
#pragma unroll
            for (int n = 0; n < 4; ++n) {
              u32x2 pk; pk[0] = pack2(acc[m][n][0] * w, acc[m][n][1] * w); pk[1] = pack2(acc[m][n][2] * w, acc[m][n][3] * w);
              *(u32x2*)(SO + (size_t)slot_m[m] * 1024 + nt * 128 + wc * 64 + n * 16 + fq * 4) = pk;
            }
          }
        }
      }
    };
#pragma unroll
    for (int bt = 0; bt < 30; bt += 3) {
      compute(bt, bt & 1);           lstoreB(rb1, (bt + 1) & 1); if (bt + 4 < 32) gloadB(rb1, bt + 4); __syncthreads(); __builtin_amdgcn_sched_barrier(0);
      compute(bt + 1, (bt + 1) & 1); lstoreB(rb2, (bt + 2) & 1); if (bt + 5 < 32) gloadB(rb2, bt + 5); __syncthreads(); __builtin_amdgcn_sched_barrier(0);
      compute(bt + 2, (bt + 2) & 1); lstoreB(rb0, (bt + 3) & 1); if (bt + 6 < 32) gloadB(rb0, bt + 6); __syncthreads(); __builtin_amdgcn_sched_barrier(0);
    }
    compute(30, 0); lstoreB(rb1, 1); __syncthreads(); __builtin_amdgcn_sched_barrier(0);
    compute(31, 1); __syncthreads();
  }
}

DEVI void st_combine(const Params& p, int l, int vb, int nvb) {
  const int lane = p.tid & 63, wid = p.tid >> 6;
  const u16* SO = (const u16*)(p.ws + O_SLOT);
  const bool last = l == 1;
  const float* gnext = last ? pin(p, I_FNG) : pin(p, I_N1G) + 1024;
  const int tend = last ? TL : T;
  for (int t0 = (vb * 4 + wid) * 2; t0 < tend; t0 += nvb * 8) {
    const int mv = tok_mv(t0);
    const float* g5 = modp(p, l, mv, 5);
    u32x4 sv[2][7][2]; f32x4 xv[2][4];
#pragma unroll
    for (int u = 0; u < 2; ++u) {
      const int t = t0 + u;
#pragma unroll
      for (int k = 0; k < 7; ++k) {
        const u16* row = SO + (size_t)(k < 6 ? t * 6 + k : NSLOT + t) * 1024;
        sv[u][k][0] = *(const u32x4*)(row + lane * 8); sv[u][k][1] = *(const u32x4*)(row + 512 + lane * 8);
      }
      const float* xr = (const float*)(p.ws + O_XA) + (size_t)t * 1024;
      xv[u][0] = *(const f32x4*)(xr + lane * 8); xv[u][1] = *(const f32x4*)(xr + lane * 8 + 4);
      xv[u][2] = *(const f32x4*)(xr + 512 + lane * 8); xv[u][3] = *(const f32x4*)(xr + 512 + lane * 8 + 4);
    }
    f32x4 gq[4];
    gq[0] = *(const f32x4*)(g5 + lane * 8); gq[1] = *(const f32x4*)(g5 + lane * 8 + 4);
    gq[2] = *(const f32x4*)(g5 + 512 + lane * 8); gq[3] = *(const f32x4*)(g5 + 512 + lane * 8 + 4);
    float ss[2];
#pragma unroll
    for (int u = 0; u < 2; ++u) {
      float acc = 0.f;
#pragma unroll
      for (int hf = 0; hf < 2; ++hf) {
        f32x4 a0 = fzero4(), a1 = a0;
#pragma unroll
        for (int k = 0; k < 7; ++k) {
          const u32x4 v = sv[u][k][hf];
          a0[0] += bflo(v[0]); a0[1] += bfhi(v[0]); a0[2] += bflo(v[1]); a0[3] += bfhi(v[1]);
          a1[0] += bflo(v[2]); a1[1] += bfhi(v[2]); a1[2] += bflo(v[3]); a1[3] += bfhi(v[3]);
        }
        xv[u][2 * hf] += gq[2 * hf] * a0; xv[u][2 * hf + 1] += gq[2 * hf + 1] * a1;
#pragma unroll
        for (int e = 0; e < 4; ++e) acc += xv[u][2 * hf][e] * xv[u][2 * hf][e] + xv[u][2 * hf + 1][e] * xv[u][2 * hf + 1][e];
      }
      ss[u] = acc;
    }
#pragma unroll
    for (int o = 32; o >= 1; o >>= 1) { ss[0] += __shfl_xor(ss[0], o); ss[1] += __shfl_xor(ss[1], o); }
    f32x4 gn[4];
    gn[0] = *(const f32x4*)(gnext + lane * 8); gn[1] = *(const f32x4*)(gnext + lane * 8 + 4);
    gn[2] = *(const f32x4*)(gnext + 512 + lane * 8); gn[3] = *(const f32x4*)(gnext + 512 + lane * 8 + 4);
    if (!last) {
      const float* sh = modp(p, 1, mv, 0); const float* sc = modp(p, 1, mv, 1);
#pragma unroll
      for (int q = 0; q < 4; ++q) {
        const int c = (q >> 1) * 512 + lane * 8 + (q & 1) * 4;
        const f32x4 s4 = *(const f32x4*)(sc + c), h4 = *(const f32x4*)(sh + c);
        const f32x4 gs = gn[q] * (1.f + s4);
#pragma unroll
        for (int u = 0; u < 2; ++u) {
          const size_t t = t0 + u;
          const float rstd = rsqrtf(ss[u] * (1.f / 1024.f) + 1e-6f);
          *(f32x4*)((float*)(p.ws + O_XA) + t * 1024 + c) = xv[u][q];
          const f32x4 o = xv[u][q] * rstd * gs + h4;
          u32x2 pk; pk[0] = pack2(o[0], o[1]); pk[1] = pack2(o[2], o[3]);
          *(u32x2*)((u16*)(p.ws + O_H) + t * LDH + c) = pk;
        }
      }
    } else {
#pragma unroll
      for (int q = 0; q < 4; ++q) {
        const int c = (q >> 1) * 512 + lane * 8 + (q & 1) * 4;
#pragma unroll
        for (int u = 0; u < 2; ++u) {
          const size_t t = t0 + u;
          const float rstd = rsqrtf(ss[u] * (1.f / 1024.f) + 1e-6f);
          *(f32x4*)(p.out + t * 1024 + c) = xv[u][q] * rstd * gn[q];
        }
      }
    }
  }
}


#define STAGE(call) { const Params p = mkctx(a); call; }

#define XB_TMO      128
#define XB_XCNT(j)  (256  + 64 * (j))
#define XB_XSUB(j)  (1280 + 64 * (j))
#define XB_XGEN(j)  (2304 + 64 * (j))
#define XB_TOP      3328
#define XB_TOPGEN   3392
#define XCD_BAR_WORDS 3456
#define XB_SPIN_CAP (1u << 20)
#define LAS __attribute__((address_space(3)))
DEVI unsigned xb_ld(unsigned* p)              { return __hip_atomic_load(p, __ATOMIC_RELAXED, __HIP_MEMORY_SCOPE_AGENT); }
DEVI unsigned xb_add(unsigned* p, unsigned v) { return __hip_atomic_fetch_add(p, v, __ATOMIC_RELAXED, __HIP_MEMORY_SCOPE_AGENT); }
DEVI unsigned xb_xcc_id() { return (unsigned)__builtin_amdgcn_s_getreg((3 << 11) | 20) & 0xFu; }
#define XB_SPIN(cond, bar) do { unsigned _sp = 0; while (cond) { __builtin_amdgcn_s_sleep(1); \
    if ((++_sp & 255u) == 0u) { if (xb_ld(&(bar)[XB_TMO])) break; if (_sp > XB_SPIN_CAP) { atomicAdd(&(bar)[XB_TMO], 1u); break; } } } } while (0)
struct XcdBarrier { unsigned* bar; unsigned x; volatile LAS unsigned* st; };
DEVI XcdBarrier xcd_barrier_post(unsigned* bar, volatile LAS unsigned* st) {
  XcdBarrier b; b.bar = bar; b.x = xb_xcc_id(); b.st = st;
  if (threadIdx.x == 0) (void)xb_add(&bar[XB_XCNT(b.x)], 1u);
  return b;
}
DEVI void xcd_barrier_complete(unsigned* bar, unsigned x, unsigned& nloc, unsigned& nx) {
  const unsigned G = gridDim.x * gridDim.y * gridDim.z;
  unsigned sum, cnt, mine, sp = 0u;
  for (;;) {
    sum = 0u; cnt = 0u; mine = 0u;
#pragma unroll
    for (unsigned j = 0; j < 16; ++j) { const unsigned c = xb_ld(&bar[XB_XCNT(j)]); sum += c; cnt += (c > 0u) ? 1u : 0u; mine = (j == x) ? c : mine; }
    if (sum == G) break;
    __builtin_amdgcn_s_sleep(1);
    if ((++sp & 255u) == 0u) { if (xb_ld(&bar[XB_TMO])) break; if (sp > XB_SPIN_CAP) { atomicAdd(&bar[XB_TMO], 1u); break; } }
  }
  nloc = mine > 0u ? mine : 1u; nx = cnt > 0u ? cnt : 1u;
}
DEVI void xcd_barrier(const XcdBarrier& b) {
  asm volatile("s_waitcnt vmcnt(0)" ::: "memory");
  __syncthreads();
  if (threadIdx.x == 0) {
    unsigned* bar = b.bar;
    __builtin_amdgcn_s_waitcnt(0);
    unsigned nloc = b.st[0], nx = b.st[1];
    if (nloc == 0u) { xcd_barrier_complete(bar, b.x, nloc, nx); b.st[0] = nloc; b.st[1] = nx; }
    const unsigned old = xb_add(&bar[XB_XSUB(b.x)], 1u);
    const unsigned gen = old / nloc;
    if (old + 1u == (gen + 1u) * nloc) {
      __builtin_amdgcn_fence(__ATOMIC_RELEASE, "agent");
      asm volatile("s_waitcnt vmcnt(0)" ::: "memory");
      const unsigned og = xb_add(&bar[XB_TOP], 1u);
      const unsigned tg = og / nx;
      if (og + 1u == (tg + 1u) * nx) xb_add(&bar[XB_TOPGEN], 1u);
      else XB_SPIN(xb_ld(&bar[XB_TOPGEN]) == tg, bar);
      __builtin_amdgcn_fence(__ATOMIC_ACQUIRE, "agent");
      xb_add(&bar[XB_XGEN(b.x)], 1u);
      asm volatile("s_waitcnt vmcnt(0)" ::: "memory");
    } else {
      XB_SPIN(xb_ld(&bar[XB_XGEN(b.x)]) == gen, bar);
      __builtin_amdgcn_fence(__ATOMIC_ACQUIRE, "agent");
      asm volatile("s_waitcnt vmcnt(0)" ::: "memory");
    }
  }
  __syncthreads();
}
#define GSYNC() { XcdBarrier xb_; xb_.bar = (unsigned*)(mkctx(a).ws + O_XBAR); xb_.x = xb_xcc_id(); xb_.st = (volatile LAS unsigned*)(smem + SMEM_BYTES - 32); xcd_barrier(xb_); }

__global__ void __launch_bounds__(256, 2) mega(KArgs a) {
  extern __shared__ __attribute__((aligned(16))) char smem[];
  cg::grid_group grid = cg::this_grid();
  const int vb = blockIdx.x, nvb = gridDim.x;
  volatile LAS unsigned* xst = (volatile LAS unsigned*)(smem + SMEM_BYTES - 32);
  if (threadIdx.x == 0) { xst[0] = 0u; xst[1] = 0u; }
  __syncthreads();
  (void)xcd_barrier_post((unsigned*)(a.ws + O_XBAR), xst);
  if (threadIdx.x == 0) {
    const float** tab = (const float**)(a.ws + O_TAB);
#pragma unroll
    for (int i = 0; i < 35; ++i) tab[i] = a.in[i];
  }
  __syncthreads();
  STAGE(st_rope_table(p, vb, nvb));
  STAGE(st_mod(p, vb, nvb, smem));
  STAGE(st_prep_w1(p, 0, vb, nvb, smem));
  if (a.ws == nullptr) grid.sync();
  GSYNC();
  for (int l = 0; l < 2; ++l) {
    if (l == 0) { STAGE(st_norm1(p, 0, vb, nvb)); GSYNC(); }
    {
      const int g = vb & 7;
      for (int i = vb >> 3; i < 363; i += nvb >> 3) {
        int mt, nt;
        if (i < 264) { mt = i >> 1; nt = g + 8 * (i & 1); }
        else { const int j = i - 264, pc = g + 8 * (j / 33); nt = 16 + (pc >> 2); mt = (pc & 3) * 33 + (j % 33); }
        const Params p = mkctx(a); inproj_item(p, mt * 22 + nt, smem);
      }
    }
    GSYNC();
    STAGE(st_tokprep(p, l, vb, nvb));
    GSYNC();
    {
      for (int item = vb; item < 132 * 7 + NGITEM; item += nvb) {
        const Params p = mkctx(a);
        if (item < 132 * 7) mla_up_tile(p, item / 7, item % 7, smem);
        else gdn_chunk_item(p, item - 132 * 7, smem);
      }
    }
    GSYNC();
    st_mixer_queue(a, l, smem);
    GSYNC();
    STAGE(st_mix_finish(p, l, vb, nvb));
    GSYNC();
    STAGE(st_outproj(p, l, vb, nvb, smem));
    GSYNC();
    STAGE(st_norm2_route(p, l, vb, nvb, smem));
    GSYNC();
    STAGE(st_moe1(p, l, vb, nvb, smem));
    GSYNC();
    STAGE(st_moe2(p, l, vb, nvb, smem));
    GSYNC();
    if (l == 0) STAGE(st_prep_w1(p, 1, vb, nvb, smem));
    STAGE(st_combine(p, l, vb, nvb));
    if (l == 0) GSYNC();
  }
}

extern "C" void kernel_launch(void* const* d_in, const int* in_sizes, int n_in, void* d_out, int out_size, void* d_ws, size_t ws_size,
                              hipStream_t stream) {
  static int grid_blocks = 0;
  if (!grid_blocks) {
    int dev = 0, cus = 0, per_cu = 0;
    (void)hipGetDevice(&dev);
    (void)hipDeviceGetAttribute(&cus, hipDeviceAttributeMultiprocessorCount, dev);
    (void)hipFuncSetAttribute((const void*)mega, hipFuncAttributeMaxDynamicSharedMemorySize, SMEM_BYTES);
    (void)hipOccupancyMaxActiveBlocksPerMultiprocessor(&per_cu, mega, 256, SMEM_BYTES);
    if (per_cu > 2) per_cu = 2;
    if (per_cu < 1) per_cu = 1;
    grid_blocks = cus * per_cu;
  }
  KArgs p{};
  for (int i = 0; i < 35; ++i) p.in[i] = (const float*)d_in[i];
  p.out = (float*)d_out; p.ws = (char*)d_ws;
  if (ws_size < WS_NEED) { fprintf(stderr, "workspace too small: %zu < %zu\n", ws_size, (size_t)WS_NEED); return; }
  (void)hipMemsetAsync((char*)d_ws + O_BAR, 0, 256 + 16384, stream);
  void* args[] = {&p};
  hipError_t e = hipLaunchCooperativeKernel((void*)mega, dim3(grid_blocks), dim3(256), args, SMEM_BYTES, stream);
  if (e != hipSuccess) fprintf(stderr, "cooperative launch failed: %s (grid %d)\n", hipGetErrorString(e), grid_blocks);
}
```

```cpp
#include <hip/hip_runtime.h>
#include <hip/hip_cooperative_groups.h>
#include <cstdio>
#include <cstdint>
namespace cg = cooperative_groups;

#define DEVI __device__ __forceinline__
typedef unsigned short u16;
using bf16x8 = __attribute__((ext_vector_type(8))) short;
using f32x4  = __attribute__((ext_vector_type(4))) float;
using f32x2  = __attribute__((ext_vector_type(2))) float;
using f32x16 = __attribute__((ext_vector_type(16))) float;
using u32x4 = __attribute__((ext_vector_type(4))) unsigned;
using u32x2 = __attribute__((ext_vector_type(2))) unsigned;
typedef __bf16 bf16x2_t __attribute__((ext_vector_type(2)));

constexpr int DM = 1024, SEQ = 8192, CTXL = 256, NKEY = SEQ + CTXL;
constexpr int TL = 2 * SEQ, TC = 2 * CTXL, T = TL + TC;
constexpr int INW = 2672;
constexpr int NIN = 2816;
constexpr int LDPP = 1408;
constexpr int PP_CQ = 0, PP_CKV = 192, PP_DQKV = 320, PP_DZ = 1088, PP_GATE = 1344;
constexpr int NE = 64, NSLOT = 6 * T;
constexpr int LDW = 1088;
constexpr int LDH = 1088;
constexpr int NCHUNK = T / 64;
constexpr int NGITEM = NCHUNK * 8;
constexpr float LOG2E = 1.4426950408889634f;

constexpr size_t al256(size_t x) { return (x + 255) & ~(size_t)255; }
constexpr size_t O_MOD   = 0;
constexpr size_t O_ROPE  = O_MOD + al256((size_t)2 * 3 * 6144 * 4);
constexpr size_t O_XA    = O_ROPE + (size_t)SEQ * 48 * 8;
constexpr size_t O_H     = O_XA + (size_t)T * DM * 4;
constexpr size_t O_WINT  = O_H + (size_t)T * LDH * 2;
constexpr size_t O_WOUTT = O_WINT + (size_t)NIN * LDW * 2;
constexpr size_t O_WUQT  = O_WOUTT + (size_t)1024 * LDW * 2;
constexpr size_t O_WUKVT = O_WUQT + (size_t)384 * 192 * 2;
constexpr size_t O_WGUT  = O_WUKVT + (size_t)512 * 128 * 2;
constexpr size_t O_WDT   = O_WGUT + (size_t)65 * 512 * LDW * 2;
constexpr size_t O_WTS   = O_WDT + (size_t)65 * 1024 * 256 * 2;
constexpr size_t O_CNT   = O_WTS + al256((size_t)NSLOT * 4);
constexpr size_t O_TAB   = O_CNT + 256;
constexpr size_t O_BAR   = O_TAB + 512;
constexpr size_t O_XBAR  = O_BAR + 256;
constexpr size_t O_LIST  = O_XBAR + 16384;
constexpr size_t O_R     = O_LIST + (size_t)NE * T * 4;
constexpr size_t O_Y     = O_R;
constexpr size_t O_PP    = O_Y + (size_t)T * DM * 2;
constexpr size_t O_QA    = O_PP + (size_t)T * LDPP * 2;
constexpr size_t O_KA    = O_QA + (size_t)2 * 4 * NKEY * 64 * 2;
constexpr size_t O_VTA   = O_KA + (size_t)2 * 2 * NKEY * 64 * 2;
constexpr size_t O_QB    = O_VTA + (size_t)2 * 2 * NKEY * 64 * 2;
constexpr size_t O_KB    = O_QB + (size_t)2 * 8 * NKEY * 32 * 2;
constexpr size_t O_VTB   = O_KB + (size_t)2 * 8 * NKEY * 32 * 2;
constexpr size_t O_QC    = O_VTB + (size_t)2 * 4 * NKEY * 64 * 2;
constexpr size_t O_KC    = O_QC + (size_t)2 * 4 * NKEY * 96 * 2;
constexpr size_t O_VTC   = O_KC + (size_t)2 * 4 * NKEY * 96 * 2;
constexpr size_t O_CQN   = O_VTC + (size_t)2 * 4 * NKEY * 64 * 2;
constexpr size_t O_CKVN  = O_CQN + (size_t)T * 192 * 2;
constexpr size_t O_OB    = O_CKVN + (size_t)T * 128 * 2;
constexpr size_t O_GQ    = O_OB + (size_t)T * 512 * 2;
constexpr size_t O_GK    = O_GQ + (size_t)T * 256 * 2;
constexpr size_t O_GV    = O_GK + (size_t)T * 256 * 2;
constexpr size_t O_GG    = O_GV + (size_t)T * 256 * 2;
constexpr size_t O_GBETA = O_GG + (size_t)2 * T * 4 * 4;
constexpr size_t O_GM    = O_GBETA + (size_t)2 * T * 4 * 4;
constexpr size_t O_GQP   = O_GM + (size_t)NGITEM * 4096 * 2;
constexpr size_t O_GN    = O_GQP + (size_t)NGITEM * 4096 * 2;
constexpr size_t O_GLO   = O_GN + (size_t)NGITEM * 4096 * 2;
constexpr size_t O_GO    = O_GLO + (size_t)NGITEM * 4096 * 2;
constexpr size_t O_MIX_END = O_GO + (size_t)2 * T * 256 * 4;
constexpr size_t O_HB    = O_R;
constexpr size_t O_SLOT  = O_HB + (size_t)7 * T * 256 * 2;
constexpr size_t O_MOE_END = O_SLOT + (size_t)7 * T * 1024 * 2;
constexpr size_t cmax(size_t a, size_t b) { return a > b ? a : b; }
constexpr size_t WS_NEED = cmax(O_MIX_END, O_MOE_END);
static_assert(WS_NEED < (size_t)556000000, "workspace too large");

struct KArgs {
  const float* in[35];
  float* out;
  char* ws;
};
typedef const __attribute__((address_space(1))) float gcfloat;
struct Params {
  char* ws;
  float* out;
  gcfloat* const* in;
  int tid;
};
#define pin(p, i) ((const float*)(p).in[i])
enum { I_X = 0, I_C, I_CTX, I_CCTX, I_WADA, I_BADA, I_N1G, I_N2G, I_WIN, I_WOUT, I_SINK, I_LQ1, I_LK1, I_LQ2, I_LK2,
       I_DNG, I_MQG, I_MKVG, I_WUQ, I_WUKV, I_CONVW, I_ALF, I_ALB, I_DTF, I_DTB, I_GNG, I_WR, I_RB, I_WG, I_WU, I_WD,
       I_SG, I_SU, I_SD, I_FNG };

DEVI u16 f2bf(float f) { unsigned u = __float_as_uint(f); u += 0x7fffu + ((u >> 16) & 1u); return (u16)(u >> 16); }
DEVI float bf2f(u16 h) { return __uint_as_float(((unsigned)h) << 16); }
DEVI float bflo(unsigned v) { return __uint_as_float(v << 16); }
DEVI float bfhi(unsigned v) { return __uint_as_float(v & 0xffff0000u); }
DEVI unsigned pack2(float a, float b) { f32x2 v = {a, b}; return __builtin_bit_cast(unsigned, __builtin_convertvector(v, bf16x2_t)); }
DEVI f32x4 fzero4() { float z = 0.f; asm volatile("" : "+v"(z)); return f32x4{z, z, z, z}; }
DEVI float wave_sum(float v) {
#pragma unroll
  for (int o = 32; o >= 1; o >>= 1) v += __shfl_xor(v, o);
  return v;
}
DEVI float half_sum(float v) {
#pragma unroll
  for (int o = 16; o >= 1; o >>= 1) v += __shfl_xor(v, o);
  return v;
}
DEVI float siluf(float x) { return x / (1.f + __expf(-x)); }
DEVI float sigmf(float x) { return 1.f / (1.f + __expf(-x)); }
DEVI int tok_mv(int t) { return t < TL ? (t >> 13) : 2; }
DEVI int tok_b(int t) { return t < TL ? (t >> 13) : ((t - TL) >> 8); }
DEVI int tok_row(int t) { return t < TL ? (t & (SEQ - 1)) : (SEQ + ((t - TL) & (CTXL - 1))); }
DEVI const float* modp(const Params& p, int l, int mv, int j) { return (const float*)(p.ws + O_MOD) + ((size_t)(l * 3 + mv) * 6 + j) * 1024; }

#define MFMA16(a, b, c) __builtin_amdgcn_mfma_f32_16x16x32_bf16((a), (b), (c), 0, 0, 0)
#define MFMA32(a, b, c) __builtin_amdgcn_mfma_f32_32x32x16_bf16((a), (b), (c), 0, 0, 0)

DEVI void st_copy_in(const Params& p, int vb, int nvb) {
  float4* xa = (float4*)(p.ws + O_XA);
  const float4* x = (const float4*)pin(p, I_X);
  const float4* cx = (const float4*)pin(p, I_CTX);
  const size_t n4 = (size_t)T * DM / 4, nl4 = (size_t)TL * DM / 4;
  for (size_t i = (size_t)vb * 256 + p.tid; i < n4; i += (size_t)nvb * 256) xa[i] = i < nl4 ? x[i] : cx[i - nl4];
}
DEVI void rope_cs(int i, int half, int s, float& c, float& sn) {
  const int quarter = half >> 1;
  const int ii = i < quarter ? i : i - quarter;
  const float pos = i < quarter ? (float)(s >> 6) : (float)(s & 63);
  const float inv = powf(10000.f, -(float)ii / (float)quarter);
  const float ang = pos * inv;
  c = cosf(ang); sn = sinf(ang);
}
DEVI void st_rope_table(const Params& p, int vb, int nvb) {
  f32x2* R = (f32x2*)(p.ws + O_ROPE);
  for (int e = vb * 256 + p.tid; e < SEQ * 48; e += nvb * 256) {
    const int s = e / 48, i = e % 48;
    float c, sn;
    if (i < 32) rope_cs(i, 32, s, c, sn); else rope_cs(i - 32, 16, s, c, sn);
    R[e] = f32x2{c, sn};
  }
}
DEVI void st_mod(const Params& p, int vb, int nvb, char* smem) {
  float* sv = (float*)smem;
  float* red = sv + 3 * 1024;
  for (int i = p.tid; i < 3 * 1024; i += 256) {
    int v = i >> 10, k = i & 1023;
    float c = v < 2 ? pin(p, I_C)[v * 1024 + k] : pin(p, I_CCTX)[k];
    sv[i] = siluf(c);
  }
  __syncthreads();
  const int cgp = p.tid & 7, kg = p.tid >> 3;
  for (int item = vb; item < 2 * 192; item += nvb) {
    const int l = item / 192, c0 = (item % 192) * 32;
    const float* w = pin(p, I_WADA) + (size_t)l * 1024 * 6144 + c0 + cgp * 4;
    f32x4 a0 = fzero4(), a1 = a0, a2 = a0;
#pragma unroll 8
    for (int kk = 0; kk < 32; ++kk) {
      const int k = kg * 32 + kk;
      const f32x4 wv = *(const f32x4*)(w + (size_t)k * 6144);
      a0 += sv[k] * wv; a1 += sv[1024 + k] * wv; a2 += sv[2048 + k] * wv;
    }
    float* rp = red + (kg * 8 + cgp) * 12;
    *(f32x4*)rp = a0; *(f32x4*)(rp + 4) = a1; *(f32x4*)(rp + 8) = a2;
    __syncthreads();
    if (p.tid < 96) {
      const int v = p.tid >> 5, c = p.tid & 31;
      float s = 0.f;
#pragma unroll 8
      for (int g = 0; g < 32; ++g) s += red[(g * 8 + (c >> 2)) * 12 + v * 4 + (c & 3)];
      ((float*)(p.ws + O_MOD))[(size_t)(l * 3 + v) * 6144 + c0 + c] = s + pin(p, I_BADA)[l * 6144 + c0 + c];
    }
    __syncthreads();
  }
}

template <class RowFn>
DEVI void tr_tile(int tid, const float* __restrict__ src, int N, u16* __restrict__ dst, int ldd, RowFn drow, int k0, int n0, float* tile) {
  {
    const int kq = tid >> 4, n4 = (tid & 15) * 4;
    f32x4 v[4];
#pragma unroll
    for (int r = 0; r < 4; ++r) {
      const int k = r * 16 + kq;
      v[r] = n0 + n4 < N ? *(const f32x4*)(src + (size_t)(k0 + k) * N + n0 + n4) : fzero4();
    }
#pragma unroll
    for (int r = 0; r < 4; ++r) {
      const int k = r * 16 + kq;
      tile[k * 65 + n4] = v[r][0]; tile[k * 65 + n4 + 1] = v[r][1]; tile[k * 65 + n4 + 2] = v[r][2]; tile[k * 65 + n4 + 3] = v[r][3];
    }
  }
  __syncthreads();
  {
    const int n = tid >> 2, kc = (tid & 3) * 16;
    const int dr = drow(n0 + n);
    if (dr >= 0) {
      u32x4 o0, o1;
#pragma unroll
      for (int e = 0; e < 4; ++e) {
        o0[e] = pack2(tile[(kc + 2 * e) * 65 + n], tile[(kc + 2 * e + 1) * 65 + n]);
        o1[e] = pack2(tile[(kc + 8 + 2 * e) * 65 + n], tile[(kc + 8 + 2 * e + 1) * 65 + n]);
      }
      u16* d = dst + (size_t)dr * ldd + k0 + kc;
      *(u32x4*)d = o0; *(u32x4*)(d + 8) = o1;
    }
  }
  __syncthreads();
}
DEVI int win_row(int n) {
  if (n < 1280) return n;
  if (n < 1600) return 1408 + (n - 1280);
  if (n < 1632) return 1280 + (n - 1600);
  if (n < INW) return 1408 + 320 + (n - 1632);
  return -1;
}
constexpr int TR_IN = 16 * 42, TR_OUT = 256, TR_UQ = 18, TR_UKV = 16, TR_E = 4096, TR_S = 64;
constexpr int TR_P1 = TR_IN + TR_OUT + TR_UQ + TR_UKV;
constexpr int TR_P2 = 3 * TR_E + 3 * TR_S;
DEVI void prep_w1_tile(const Params& p, int l, int it, float* tile) {
  if (it < TR_IN) { tr_tile(p.tid, pin(p, I_WIN) + (size_t)l * 1024 * INW, INW, (u16*)(p.ws + O_WINT), LDW, [](int n) { return win_row(n); }, (it / 42) * 64, (it % 42) * 64, tile); return; }
  it -= TR_IN;
  if (it < TR_OUT) { tr_tile(p.tid, pin(p, I_WOUT) + (size_t)l * 1024 * 1024, 1024, (u16*)(p.ws + O_WOUTT), LDW, [](int n) { return n; }, (it / 16) * 64, (it % 16) * 64, tile); return; }
  it -= TR_OUT;
  if (it < TR_UQ) { tr_tile(p.tid, pin(p, I_WUQ) + (size_t)l * 192 * 384, 384, (u16*)(p.ws + O_WUQT), 192, [](int n) { return n; }, (it / 6) * 64, (it % 6) * 64, tile); return; }
  it -= TR_UQ;
  tr_tile(p.tid, pin(p, I_WUKV) + (size_t)l * 128 * 512, 512, (u16*)(p.ws + O_WUKVT), 128,
          [](int n) { const int h = n >> 7, j = n & 127; return j < 64 ? h * 64 + j : 256 + h * 64 + (j - 64); }, (it / 8) * 64, (it % 8) * 64, tile);
}
DEVI void prep_w2_tile(const Params& p, int l, int it, float* tile) {
  if (it < 2 * TR_E) {
    const int which = it / TR_E; it %= TR_E;
    const int e = it >> 6, tt = it & 63;
    const float* src = pin(p, which ? I_WU : I_WG) + ((size_t)l * NE + e) * 1024 * 256;
    tr_tile(p.tid, src, 256, (u16*)(p.ws + O_WGUT) + (size_t)e * 512 * LDW, LDW, [which](int n) { return 2 * n + which; }, (tt >> 2) * 64, (tt & 3) * 64, tile); return;
  }
  it -= 2 * TR_E;
  if (it < TR_E) {
    const int e = it >> 6, tt = it & 63;
    const float* src = pin(p, I_WD) + ((size_t)l * NE + e) * 256 * 1024;
    tr_tile(p.tid, src, 1024, (u16*)(p.ws + O_WDT) + (size_t)e * 1024 * 256, 256, [](int n) { return n; }, (tt >> 4) * 64, (tt & 15) * 64, tile); return;
  }
  it -= TR_E;
  if (it < 2 * TR_S) {
    const int which = it / TR_S; const int tt = it % TR_S;
    const float* src = pin(p, which ? I_SU : I_SG) + (size_t)l * 1024 * 256;
    tr_tile(p.tid, src, 256, (u16*)(p.ws + O_WGUT) + (size_t)64 * 512 * LDW, LDW, [which](int n) { return 2 * n + which; }, (tt >> 2) * 64, (tt & 3) * 64, tile); return;
  }
  it -= 2 * TR_S;
  { const int tt = it;
    const float* src = pin(p, I_SD) + (size_t)l * 256 * 1024;
    tr_tile(p.tid, src, 1024, (u16*)(p.ws + O_WDT) + (size_t)64 * 1024 * 256, 256, [](int n) { return n; }, (tt >> 4) * 64, (tt & 15) * 64, tile); }
}
struct TrDesc { const float* src; u16* dst; int N, ldd, rs, ro, k0, n0; };
DEVI TrDesc w2_desc(const Params& p, int l, int it) {
  TrDesc d;
  if (it < 2 * TR_E) {
    const int which = it / TR_E; it %= TR_E;
    const int e = it >> 6, tt = it & 63;
    d.src = pin(p, which ? I_WU : I_WG) + ((size_t)l * NE + e) * 1024 * 256; d.N = 256;
    d.dst = (u16*)(p.ws + O_WGUT) + (size_t)e * 512 * LDW; d.ldd = LDW; d.rs = 2; d.ro = which; d.k0 = (tt >> 2) * 64; d.n0 = (tt & 3) * 64;
    return d;
  }
  it -= 2 * TR_E;
  if (it < TR_E) {
    const int e = it >> 6, tt = it & 63;
    d.src = pin(p, I_WD) + ((size_t)l * NE + e) * 256 * 1024; d.N = 1024;
    d.dst = (u16*)(p.ws + O_WDT) + (size_t)e * 1024 * 256; d.ldd = 256; d.rs = 1; d.ro = 0; d.k0 = (tt >> 4) * 64; d.n0 = (tt & 15) * 64;
    return d;
  }
  it -= TR_E;
  if (it < 2 * TR_S) {
    const int which = it / TR_S; const int tt = it % TR_S;
    d.src = pin(p, which ? I_SU : I_SG) + (size_t)l * 1024 * 256; d.N = 256;
    d.dst = (u16*)(p.ws + O_WGUT) + (size_t)64 * 512 * LDW; d.ldd = LDW; d.rs = 2; d.ro = which; d.k0 = (tt >> 2) * 64; d.n0 = (tt & 3) * 64;
    return d;
  }
  it -= 2 * TR_S;
  d.src = pin(p, I_SD) + (size_t)l * 256 * 1024; d.N = 1024;
  d.dst = (u16*)(p.ws + O_WDT) + (size_t)64 * 1024 * 256; d.ldd = 256; d.rs = 1; d.ro = 0; d.k0 = (it >> 4) * 64; d.n0 = (it & 15) * 64;
  return d;
}
DEVI void tr_load(int tid, const TrDesc& d, f32x4 (&v)[4]) {
  const int kq = tid >> 4, n4 = (tid & 15) * 4;
#pragma unroll
  for (int r = 0; r < 4; ++r) v[r] = *(const f32x4*)(d.src + (size_t)(d.k0 + r * 16 + kq) * d.N + d.n0 + n4);
}
DEVI void tr_process(int tid, const TrDesc& d, const f32x4 (&v)[4], float* tile) {
  {
    const int kq = tid >> 4, n4 = (tid & 15) * 4;
#pragma unroll
    for (int r = 0; r < 4; ++r) {
      const int k = r * 16 + kq;
      tile[k * 65 + n4] = v[r][0]; tile[k * 65 + n4 + 1] = v[r][1]; tile[k * 65 + n4 + 2] = v[r][2]; tile[k * 65 + n4 + 3] = v[r][3];
    }
  }
  __syncthreads();
  {
    const int n = tid >> 2, kc = (tid & 3) * 16;
    u32x4 o0, o1;
#pragma unroll
    for (int e = 0; e < 4; ++e) {
      o0[e] = pack2(tile[(kc + 2 * e) * 65 + n], tile[(kc + 2 * e + 1) * 65 + n]);
      o1[e] = pack2(tile[(kc + 8 + 2 * e) * 65 + n], tile[(kc + 8 + 2 * e + 1) * 65 + n]);
    }
    u16* o = d.dst + (size_t)((d.n0 + n) * d.rs + d.ro) * d.ldd + d.k0 + kc;
    *(u32x4*)o = o0; *(u32x4*)(o + 8) = o1;
  }
  __syncthreads();
}
DEVI void prep_w2_run8(const Params& p, int l, int it0, float* tile) {
  f32x4 va[4], vb4[4];
  TrDesc da = w2_desc(p, l, it0), db = da;
  __syncthreads();
  tr_load(p.tid, da, va);
#pragma unroll 1
  for (int k = 0; k < 8; k += 2) {
    db = w2_desc(p, l, it0 + k + 1);
    tr_load(p.tid, db, vb4);
    tr_process(p.tid, da, va, tile);
    if (k + 2 < 8) { da = w2_desc(p, l, it0 + k + 2); tr_load(p.tid, da, va); }
    tr_process(p.tid, db, vb4, tile);
  }
}
DEVI void st_prep_w1(const Params& p, int l, int vb, int nvb, char* smem) {
  float* tile = (float*)smem;
  if (vb == 0 && p.tid < 64) ((int*)(p.ws + O_CNT))[p.tid] = 0;
  for (int e = vb * 256 + p.tid; e < 144 * 128; e += nvb * 256) {
    const int r = e >> 7, c8 = e & 127;
    const int row = r < 96 ? 1312 + r : 2768 + (r - 96);
    *(u32x4*)((u16*)(p.ws + O_WINT) + (size_t)row * LDW + c8 * 8) = __builtin_bit_cast(u32x4, fzero4());
  }
  for (int item = vb; item < TR_P1; item += nvb) prep_w1_tile(p, l, item, tile);
}

DEVI void st_norm1(const Params& p, int l, int vb, int nvb) {
  const int lane = p.tid & 63, wid = p.tid >> 6;
  const float* g = pin(p, I_N1G) + l * 1024;
  for (int t4 = (vb * 4 + wid) * 4; t4 < T; t4 += nvb * 16) {
    const int mv = tok_mv(t4);
    const float* sh = modp(p, l, mv, 0); const float* sc = modp(p, l, mv, 1);
    f32x4 v[4][4]; float ss[4];
#pragma unroll
    for (int u = 0; u < 4; ++u) {
      const int t = t4 + u;
      const f32x4* xr = (const f32x4*)(t < TL ? pin(p, I_X) + (size_t)t * 1024 : pin(p, I_CTX) + (size_t)(t - TL) * 1024);
#pragma unroll
      for (int i = 0; i < 4; ++i) v[u][i] = xr[i * 64 + lane];
    }
#pragma unroll
    for (int u = 0; u < 4; ++u) {
      float a = 0.f;
#pragma unroll
      for (int i = 0; i < 4; ++i) a += v[u][i][0] * v[u][i][0] + v[u][i][1] * v[u][i][1] + v[u][i][2] * v[u][i][2] + v[u][i][3] * v[u][i][3];
      ss[u] = a;
    }
#pragma unroll
    for (int o = 32; o >= 1; o >>= 1) {
#pragma unroll
      for (int u = 0; u < 4; ++u) ss[u] += __shfl_xor(ss[u], o);
    }
#pragma unroll
    for (int i = 0; i < 4; ++i) {
      const int c = i * 256 + lane * 4;
      const f32x4 gg = *(const f32x4*)(g + c), s4 = *(const f32x4*)(sc + c), h4 = *(const f32x4*)(sh + c);
      const f32x4 gs = gg * (1.f + s4);
#pragma unroll
      for (int u = 0; u < 4; ++u) {
        const float rstd = rsqrtf(ss[u] * (1.f / 1024.f) + 1e-6f);
        const f32x4 o = v[u][i] * rstd * gs + h4;
        u32x2 pk; pk[0] = pack2(o[0], o[1]); pk[1] = pack2(o[2], o[3]);
        *(u32x2*)((u16*)(p.ws + O_H) + (size_t)(t4 + u) * LDH + c) = pk;
      }
    }
  }
}

constexpr int GLD = 72;
typedef const __attribute__((address_space(1))) unsigned gcu32;
typedef __attribute__((address_space(3))) unsigned lu32;
template <bool SWAP, class ARow>
DEVI void gemm_core(int tid, ARow arow, const u16* __restrict__ Bt, int ldb, int K, f32x4 (&acc)[4][4], char* smem) {
  constexpr int TILE = 128 * 64;
  u16* sbuf = (u16*)smem;
  const int lane = tid & 63, wid = tid >> 6, wr = wid >> 1, wc = wid & 1, fr = lane & 15, fq = lane >> 4;
  const u16* ap[4]; const u16* bp[4];
#pragma unroll
  for (int i = 0; i < 4; ++i) {
    const int q = tid + 256 * i, row = q >> 3, cs = (q & 7) ^ (row & 7);
    ap[i] = arow(row) + cs * 8; bp[i] = Bt + (size_t)row * ldb + cs * 8;
  }
  const int nk = K >> 6;
  auto stage = [&](int kt, int buf) {
    int off = kt * 64; asm volatile("" : "+s"(off));
    u16* dA = sbuf + buf * 2 * TILE + tid * 8; u16* dB = dA + TILE;
#pragma unroll
    for (int i = 0; i < 4; ++i) {
      __builtin_amdgcn_global_load_lds((gcu32*)(ap[i] + off), (lu32*)(dA + i * 2048), 16, 0, 0);
      __builtin_amdgcn_global_load_lds((gcu32*)(bp[i] + off), (lu32*)(dB + i * 2048), 16, 0, 0);
    }
  };
  auto compute = [&](int buf) {
    const u16* sA = sbuf + buf * 2 * TILE; const u16* sB = sA + TILE;
#pragma unroll
    for (int ks = 0; ks < 2; ++ks) {
      bf16x8 af[4], bfr[4];
#pragma unroll
      for (int m = 0; m < 4; ++m) { const int R = wr * 64 + m * 16 + fr; af[m] = *(const bf16x8*)&sA[R * 64 + (((ks * 4 + fq) ^ (R & 7)) << 3)]; }
#pragma unroll
      for (int n = 0; n < 4; ++n) { const int R = wc * 64 + n * 16 + fr; bfr[n] = *(const bf16x8*)&sB[R * 64 + (((ks * 4 + fq) ^ (R & 7)) << 3)]; }
#pragma unroll
      for (int m = 0; m < 4; ++m)
#pragma unroll
        for (int n = 0; n < 4; ++n) acc[m][n] = SWAP ? MFMA16(af[m], bfr[n], acc[m][n]) : MFMA16(bfr[n], af[m], acc[m][n]);
    }
  };
#pragma unroll
  for (int m = 0; m < 4; ++m)
#pragma unroll
    for (int n = 0; n < 4; ++n) acc[m][n] = fzero4();
  __syncthreads();
  stage(0, 0);
  asm volatile("s_waitcnt vmcnt(0)" ::: "memory");
  __syncthreads();
  for (int kt = 0; kt < nk; ++kt) {
    if (kt + 1 < nk) stage(kt + 1, (kt + 1) & 1);
    compute(kt & 1);
    asm volatile("s_waitcnt vmcnt(0)" ::: "memory");
    __syncthreads();
  }
}
template <class ARow, class Epi>
DEVI void gemm128(int tid, ARow arow, const u16* __restrict__ Bt, int ldb, int K, Epi epi, char* smem) {
  f32x4 acc[4][4];
  gemm_core<false>(tid, arow, Bt, ldb, K, acc, smem);
  const int lane = tid & 63, wid = tid >> 6, wr = wid >> 1, wc = wid & 1, fr = lane & 15, fq = lane >> 4;
#pragma unroll
  for (int m = 0; m < 4; ++m)
#pragma unroll
    for (int n = 0; n < 4; ++n) epi(wr * 64 + m * 16 + fr, wc * 64 + n * 16 + fq * 4, acc[m][n]);
}

DEVI void rope4(const f32x4 x1, const f32x4 x2, const f32x2* rp, bool lat, float scale, u32x2& o1, u32x2& o2) {
  f32x4 s = fzero4(), c = s + 1.f;
  if (lat) {
    const f32x4 a = *(const f32x4*)rp, b = *(const f32x4*)(rp + 2);
    c = f32x4{a[0], a[2], b[0], b[2]}; s = f32x4{a[1], a[3], b[1], b[3]};
  }
  const f32x4 y1 = (x1 * c - x2 * s) * scale, y2 = (x2 * c + x1 * s) * scale;
  o1[0] = pack2(y1[0], y1[1]); o1[1] = pack2(y1[2], y1[3]);
  o2[0] = pack2(y2[0], y2[1]); o2[1] = pack2(y2[2], y2[3]);
}
DEVI void inproj_item(const Params& p, int item, char* smem) {
  const u16* H = (const u16*)(p.ws + O_H); const u16* W = (const u16*)(p.ws + O_WINT);
  const f32x2* ROPE = (const f32x2*)(p.ws + O_ROPE);
  const int tid = p.tid, lane = tid & 63, wid = tid >> 6, wr = wid >> 1, wc = wid & 1, fr = lane & 15, fq = lane >> 4;
  {
    const int m0 = (item / 22) * 128, nt = item % 22;
    const bool lat = m0 < TL;
    const int b = tok_b(m0), rowbase = tok_row(m0);
    f32x4 acc[4][4];
    auto arow = [&](int r) { return H + (size_t)(m0 + r) * LDH; };
    if (nt == 3 || nt == 8 || nt == 9) {
      gemm_core<true>(tid, arow, W + (size_t)nt * 128 * LDW, LDW, 1024, acc, smem);
      u16* vt = nt == 3 ? (u16*)(p.ws + O_VTA) + (size_t)(b * 2 + wc) * 64 * NKEY
                        : (u16*)(p.ws + O_VTB) + (size_t)(b * 4 + (nt - 8) * 2 + wc) * 64 * NKEY;
#pragma unroll
      for (int m = 0; m < 4; ++m)
#pragma unroll
        for (int n = 0; n < 4; ++n) {
          u32x2 pk; pk[0] = pack2(acc[m][n][0], acc[m][n][1]); pk[1] = pack2(acc[m][n][2], acc[m][n][3]);
          *(u32x2*)(vt + (size_t)(n * 16 + fr) * NKEY + rowbase + wr * 64 + m * 16 + (((fq & 1) << 1) | (fq >> 1)) * 4) = pk;
        }
      return;
    }
    gemm_core<false>(tid, arow, W + (size_t)nt * 128 * LDW, LDW, 1024, acc, smem);
    if (nt < 3) {
      u16* dst; float scale;
      if (nt < 2) { dst = (u16*)(p.ws + O_QA) + ((size_t)(b * 4 + nt * 2 + wc) * NKEY + rowbase) * 64; scale = 0.125f * LOG2E; }
      else { dst = (u16*)(p.ws + O_KA) + ((size_t)(b * 2 + wc) * NKEY + rowbase) * 64; scale = 1.f; }
#pragma unroll
      for (int m = 0; m < 4; ++m) {
        const int rl = wr * 64 + m * 16 + fr;
#pragma unroll
        for (int pi = 0; pi < 2; ++pi) {
          const int d0 = pi * 16 + fq * 4;
          u32x2 o1, o2;
          rope4(acc[m][pi], acc[m][pi + 2], ROPE + (size_t)(rowbase + rl) * 48 + d0, lat, scale, o1, o2);
          *(u32x2*)(dst + (size_t)rl * 64 + d0) = o1; *(u32x2*)(dst + (size_t)rl * 64 + 32 + d0) = o2;
        }
      }
    } else if (nt < 8) {
      const bool isq = nt < 6;
      u16* base = isq ? (u16*)(p.ws + O_QB) : (u16*)(p.ws + O_KB);
      const float scale = isq ? 0.17677669529663687f * LOG2E : 1.f;
      const int hm0 = ((nt - 4) & 1) * 4 + wc * 2;
#pragma unroll
      for (int m = 0; m < 4; ++m) {
        const int rl = wr * 64 + m * 16 + fr;
#pragma unroll
        for (int g = 0; g < 2; ++g) {
          u16* dst = base + ((size_t)(b * 8 + hm0 + g) * NKEY + rowbase + rl) * 32;
          u32x2 o1, o2;
          rope4(acc[m][2 * g], acc[m][2 * g + 1], ROPE + (size_t)(rowbase + rl) * 48 + 32 + fq * 4, lat, scale, o1, o2);
          *(u32x2*)(dst + fq * 4) = o1; *(u32x2*)(dst + 16 + fq * 4) = o2;
        }
      }
    } else if (nt == 10) {
      if (wc == 0) {
#pragma unroll
        for (int m = 0; m < 4; ++m) {
          const int rl = wr * 64 + m * 16 + fr;
          u32x2 o1, o2;
          rope4(acc[m][0], acc[m][1], ROPE + (size_t)(rowbase + rl) * 48 + 32 + fq * 4, lat, 1.f, o1, o2);
#pragma unroll
          for (int h = 0; h < 4; ++h) {
            u16* dst = (u16*)(p.ws + O_KC) + ((size_t)(b * 4 + h) * NKEY + rowbase + rl) * 96 + 64;
            *(u32x2*)(dst + fq * 4) = o1; *(u32x2*)(dst + 16 + fq * 4) = o2;
          }
        }
      }
    } else {
      u16* PP = (u16*)(p.ws + O_PP);
#pragma unroll
      for (int m = 0; m < 4; ++m)
#pragma unroll
        for (int n = 0; n < 4; ++n) {
          u32x2 pk; pk[0] = pack2(acc[m][n][0], acc[m][n][1]); pk[1] = pack2(acc[m][n][2], acc[m][n][3]);
          *(u32x2*)(PP + (size_t)(m0 + wr * 64 + m * 16 + fr) * LDPP + (nt - 11) * 128 + wc * 64 + n * 16 + fq * 4) = pk;
        }
    }
  }
}

DEVI void st_tokprep(const Params& p, int l, int vb, int nvb) {
  const int lane = p.tid & 63, wid = p.tid >> 6;
  const u16* PP = (const u16*)(p.ws + O_PP);
  u16* GQ = (u16*)(p.ws + O_GQ); u16* GK = (u16*)(p.ws + O_GK); u16* GV = (u16*)(p.ws + O_GV);
  float* GG = (float*)(p.ws + O_GG); float* GB = (float*)(p.ws + O_GBETA);
  u16* CQN = (u16*)(p.ws + O_CQN); u16* CKVN = (u16*)(p.ws + O_CKVN);
  const float* cwp = pin(p, I_CONVW) + (size_t)l * 5 * 768;
  f32x2 cw[6][5];
#pragma unroll
  for (int i = 0; i < 6; ++i)
#pragma unroll
    for (int j = 0; j < 5; ++j) cw[i][j] = *(const f32x2*)(cwp + j * 768 + 2 * lane + 128 * i);
  const float* gq = pin(p, I_MQG) + l * 192; const float* gkv = pin(p, I_MKVG) + l * 128;
  const float gq0 = gq[lane], gq1 = gq[64 + lane], gq2 = gq[128 + lane], gk0 = gkv[lane], gk1 = gkv[64 + lane];
  for (int t = vb * 4 + wid; t < T; t += nvb * 4) {
    int base, pos, len;
    if (t < TL) { base = t & ~(SEQ - 1); pos = t & (SEQ - 1); len = SEQ; } else { int j = t - TL; base = TL + (j & ~(CTXL - 1)); pos = j & (CTXL - 1); len = CTXL; }
    unsigned xin[5][6];
#pragma unroll
    for (int j = 0; j < 5; ++j) {
      const int pp = pos + j - 2;
      const bool ok = pp >= 0 && pp < len;
      const u16* row = PP + (size_t)(base + (ok ? pp : pos)) * LDPP + PP_DQKV + 2 * lane;
#pragma unroll
      for (int i = 0; i < 6; ++i) { unsigned v = *(const unsigned*)(row + 128 * i); xin[j][i] = ok ? v : 0u; }
    }
    const u16* pr = PP + (size_t)t * LDPP;
    const float q0 = bf2f(pr[PP_CQ + lane]), q1 = bf2f(pr[PP_CQ + 64 + lane]), q2 = bf2f(pr[PP_CQ + 128 + lane]);
    const float k0 = bf2f(pr[PP_CKV + lane]), k1 = bf2f(pr[PP_CKV + 64 + lane]);
    const float gate_in = lane < 16 ? bf2f(pr[PP_GATE + lane]) : 0.f;
#pragma unroll
    for (int i = 0; i < 6; ++i) {
      float a0 = 0.f, a1 = 0.f;
#pragma unroll
      for (int j = 0; j < 5; ++j) { a0 += cw[i][j][0] * bflo(xin[j][i]); a1 += cw[i][j][1] * bfhi(xin[j][i]); }
      float y0 = siluf(a0), y1 = siluf(a1);
      const int c = 2 * lane + 128 * i;
      if (i < 4) {
        const float ss = half_sum(y0 * y0 + y1 * y1);
        const float r = rsqrtf(ss + 1e-6f) * (i < 2 ? 0.125f : 1.f);
        u16* dst = i < 2 ? GQ + (size_t)t * 256 + c : GK + (size_t)t * 256 + (c - 256);
        *(unsigned*)dst = pack2(y0 * r, y1 * r);
      } else *(unsigned*)(GV + (size_t)t * 256 + (c - 512)) = pack2(y0, y1);
    }
    if (lane < 16) {
      const int which = lane >> 2, hd = lane & 3;
      if (which < 2) {
        const float al = which ? pin(p, I_ALB)[l * 4 + hd] : pin(p, I_ALF)[l * 4 + hd];
        const float dt = which ? pin(p, I_DTB)[l * 4 + hd] : pin(p, I_DTF)[l * 4 + hd];
        const float xx = gate_in + dt;
        const float sp = fmaxf(xx, 0.f) + log1pf(expf(-fabsf(xx)));
        GG[((size_t)which * T + t) * 4 + hd] = -expf(al) * sp;
      } else GB[((size_t)(which - 2) * T + t) * 4 + hd] = sigmf(gate_in);
    }
    {
      float ss = q0 * q0 + q1 * q1 + q2 * q2, s2 = k0 * k0 + k1 * k1;
#pragma unroll
      for (int o = 32; o >= 1; o >>= 1) { ss += __shfl_xor(ss, o); s2 += __shfl_xor(s2, o); }
      const float rs = rsqrtf(ss * (1.f / 192.f) + 1e-6f), r2 = rsqrtf(s2 * (1.f / 128.f) + 1e-6f);
      u16* d = CQN + (size_t)t * 192;
      d[lane] = f2bf(q0 * rs * gq0); d[64 + lane] = f2bf(q1 * rs * gq1); d[128 + lane] = f2bf(q2 * rs * gq2);
      u16* d2 = CKVN + (size_t)t * 128;
      d2[lane] = f2bf(k0 * r2 * gk0); d2[64 + lane] = f2bf(k1 * r2 * gk1);
    }
  }
}

DEVI void mla_up_tile(const Params& p, int mt, int nn, char* smem) {
  const int tid = p.tid, lane = tid & 63, wid = tid >> 6, wr = wid >> 1, wc = wid & 1, fr = lane & 15, fq = lane >> 4;
  const int m0 = mt * 128;
  const bool lat = m0 < TL;
  const int b = tok_b(m0), rowbase = tok_row(m0);
  f32x4 acc[4][4];
  if (nn < 3) {
    const u16* CQN = (const u16*)(p.ws + O_CQN);
    gemm_core<false>(tid, [&](int r) { return CQN + (size_t)(m0 + r) * 192; }, (const u16*)(p.ws + O_WUQT) + (size_t)nn * 128 * 192, 192, 192, acc, smem);
    const f32x2* ROPE = (const f32x2*)(p.ws + O_ROPE);
    const float scale = 0.10206207261596577f * LOG2E;
    u16* QC = (u16*)(p.ws + O_QC);
#pragma unroll
    for (int m = 0; m < 4; ++m) {
      const int rl = wr * 64 + m * 16 + fr;
#pragma unroll
      for (int n = 0; n < 4; ++n) {
        const int cb = nn * 128 + wc * 64 + n * 16;
        const int h = cb / 96, db = cb - h * 96;
        u16* dst = QC + ((size_t)(b * 4 + h) * NKEY + rowbase + rl) * 96;
        if (db < 64) {
          u32x2 pk; pk[0] = pack2(acc[m][n][0] * scale, acc[m][n][1] * scale); pk[1] = pack2(acc[m][n][2] * scale, acc[m][n][3] * scale);
          *(u32x2*)(dst + db + fq * 4) = pk;
        } else if (db == 64 && n < 3) {
          u32x2 o1, o2;
          rope4(acc[m][n], acc[m][n + 1], ROPE + (size_t)(rowbase + rl) * 48 + 32 + fq * 4, lat, scale, o1, o2);
          *(u32x2*)(dst + 64 + fq * 4) = o1; *(u32x2*)(dst + 80 + fq * 4) = o2;
        }
      }
    }
  } else {
    const u16* CKVN = (const u16*)(p.ws + O_CKVN);
    auto arow = [&](int r) { return CKVN + (size_t)(m0 + r) * 128; };
    const u16* Wt = (const u16*)(p.ws + O_WUKVT) + (size_t)(nn - 3) * 128 * 128;
    if (nn < 5) {
      gemm_core<false>(tid, arow, Wt, 128, 128, acc, smem);
      u16* KC = (u16*)(p.ws + O_KC) + ((size_t)(b * 4 + (nn - 3) * 2 + wc) * NKEY + rowbase) * 96;
#pragma unroll
      for (int m = 0; m < 4; ++m)
#pragma unroll
        for (int n = 0; n < 4; ++n) {
          u32x2 pk; pk[0] = pack2(acc[m][n][0], acc[m][n][1]); pk[1] = pack2(acc[m][n][2], acc[m][n][3]);
          *(u32x2*)(KC + (size_t)(wr * 64 + m * 16 + fr) * 96 + n * 16 + fq * 4) = pk;
        }
    } else {
      gemm_core<true>(tid, arow, Wt, 128, 128, acc, smem);
      u16* vt = (u16*)(p.ws + O_VTC) + (size_t)(b * 4 + (nn - 5) * 2 + wc) * 64 * NKEY;
#pragma unroll
      for (int m = 0; m < 4; ++m)
#pragma unroll
        for (int n = 0; n < 4; ++n) {
          u32x2 pk; pk[0] = pack2(acc[m][n][0], acc[m][n][1]); pk[1] = pack2(acc[m][n][2], acc[m][n][3]);
          *(u32x2*)(vt + (size_t)(n * 16 + fr) * NKEY + rowbase + wr * 64 + m * 16 + (((fq & 1) << 1) | (fq >> 1)) * 4) = pk;
        }
    }
  }
}
DEVI int permcol(int x) { return (x & 32) + 8 * ((x >> 2) & 3) + 4 * ((x >> 4) & 1) + (x & 3); }
DEVI int cidx(int d, int e) { return ((((e >> 4) * 4 + (d >> 4)) * 64) + (e & 15) + 16 * ((d >> 2) & 3)) * 4 + (d & 3); }
DEVI int gdn_chunk_t0(int ci) { return ci < 256 ? (ci >> 7) * SEQ + (ci & 127) * 64 : TL + ((ci - 256) >> 2) * CTXL + ((ci - 256) & 3) * 64; }

DEVI void gdn_chunk_item(const Params& p, int item, char* smem) {
  u16* sK = (u16*)smem;
  float* sA = (float*)(smem + 9216);
  u16* sXt = (u16*)smem;
  u16* sAt = (u16*)(smem + 26624);
  u16* sKt = (u16*)(smem + 35840);
  float* sX = (float*)(smem + 45056);
  float* sgc = (float*)(smem + 77824); float* sbeta = sgc + 64; float* seg = sbeta + 64; float* skd = seg + 64;
  const u16* GQ = (const u16*)(p.ws + O_GQ); const u16* GK = (const u16*)(p.ws + O_GK); const u16* GV = (const u16*)(p.ws + O_GV);
  const float* GG = (const float*)(p.ws + O_GG); const float* GB = (const float*)(p.ws + O_GBETA);
  u16* GM = (u16*)(p.ws + O_GM); u16* GQP = (u16*)(p.ws + O_GQP); u16* GN = (u16*)(p.ws + O_GN); u16* GLO = (u16*)(p.ws + O_GLO);
  const int tid = p.tid, lane = tid & 63, w = tid >> 6, i15 = lane & 15, q = lane >> 4;
  {
    const int ci = item >> 3, hd = (item >> 1) & 3, dir = item & 1;
    const int t0 = gdn_chunk_t0(ci);
    auto tok = [&](int i) { return dir ? t0 + 63 - i : t0 + i; };
    __syncthreads();
    if (tid < 64) {
      float g = GG[((size_t)dir * T + tok(tid)) * 4 + hd];
#pragma unroll
      for (int o = 1; o < 64; o <<= 1) { float u = __shfl_up(g, o); if (lane >= o) g += u; }
      const float gl = __shfl(g, 63);
      sgc[tid] = g; sbeta[tid] = GB[((size_t)dir * T + tok(tid)) * 4 + hd]; seg[tid] = expf(g); skd[tid] = expf(gl - g);
    }
    __syncthreads();
    const float eglast = seg[63];
#pragma unroll
    for (int i = 0; i < 2; ++i) {
      const int ch = tid + 256 * i, j = ch >> 3, cc = ch & 7;
      const u32x4 kv = *(const u32x4*)(GK + (size_t)tok(j) * 256 + hd * 64 + cc * 8);
      *(u32x4*)&sK[j * 72 + cc * 8] = kv;
      const float kd = skd[j];
#pragma unroll
      for (int e = 0; e < 4; ++e) {
        sKt[(cc * 8 + 2 * e) * 72 + j] = f2bf(bf2f((u16)(kv[e] & 0xffff)) * kd);
        sKt[(cc * 8 + 2 * e + 1) * 72 + j] = f2bf(bf2f((u16)(kv[e] >> 16)) * kd);
      }
    }
#pragma unroll
    for (int i = 0; i < 2; ++i) {
      const int ch = tid + 256 * i, j = ch >> 3, cc = ch & 7;
      const u32x4 vv = *(const u32x4*)(GV + (size_t)tok(j) * 256 + hd * 64 + cc * 8);
      const float bj = sbeta[j];
      float* d = sX + j * 128 + cc * 8;
#pragma unroll
      for (int e = 0; e < 4; ++e) { d[2 * e] = bflo(vv[e]) * bj; d[2 * e + 1] = bfhi(vv[e]) * bj; }
    }
    __syncthreads();
    for (int e = tid; e < 64 * 64; e += 256) {
      const int j = e >> 6, c = e & 63;
      sX[j * 128 + 64 + c] = bf2f(sK[j * 72 + c]) * sbeta[j] * seg[j];
    }
    {
      f32x4 kk[4], qk[4];
#pragma unroll
      for (int nt = 0; nt < 4; ++nt) { kk[nt] = fzero4(); qk[nt] = fzero4(); }
#pragma unroll
      for (int ks = 0; ks < 2; ++ks) {
        const bf16x8 ak = *(const bf16x8*)&sK[(16 * w + i15) * 72 + ks * 32 + q * 8];
        const bf16x8 aq = *(const bf16x8*)(GQ + (size_t)tok(16 * w + i15) * 256 + hd * 64 + ks * 32 + q * 8);
#pragma unroll
        for (int nt = 0; nt < 4; ++nt) {
          const bf16x8 bk = *(const bf16x8*)&sK[(16 * nt + i15) * 72 + ks * 32 + q * 8];
          kk[nt] = MFMA16(ak, bk, kk[nt]); qk[nt] = MFMA16(aq, bk, qk[nt]);
        }
      }
#pragma unroll
      for (int nt = 0; nt < 4; ++nt)
#pragma unroll
        for (int r = 0; r < 4; ++r) {
          const int i = 16 * w + 4 * q + r, j = 16 * nt + i15;
          const float dec = i >= j ? expf(sgc[i] - sgc[j]) : 0.f;
          sA[i * 68 + j] = i > j ? sbeta[i] * kk[nt][r] * dec : 0.f;
          sAt[i * 72 + j] = f2bf(i >= j ? qk[nt][r] * dec : 0.f);
        }
    }
    __syncthreads();
    if (tid < 128) {
      const int c = tid;
      for (int ib = 0; ib < 16; ++ib) {
        float a0 = sX[(4 * ib) * 128 + c], a1 = sX[(4 * ib + 1) * 128 + c], a2 = sX[(4 * ib + 2) * 128 + c], a3 = sX[(4 * ib + 3) * 128 + c];
#pragma unroll 4
        for (int g = 0; g < ib; ++g) {
          const float x0 = sX[(4 * g) * 128 + c], x1 = sX[(4 * g + 1) * 128 + c], x2 = sX[(4 * g + 2) * 128 + c], x3 = sX[(4 * g + 3) * 128 + c];
          const f32x4 r0 = *(const f32x4*)&sA[(4 * ib) * 68 + 4 * g], r1 = *(const f32x4*)&sA[(4 * ib + 1) * 68 + 4 * g];
          const f32x4 r2 = *(const f32x4*)&sA[(4 * ib + 2) * 68 + 4 * g], r3 = *(const f32x4*)&sA[(4 * ib + 3) * 68 + 4 * g];
          a0 -= r0[0] * x0 + r0[1] * x1 + r0[2] * x2 + r0[3] * x3;
          a1 -= r1[0] * x0 + r1[1] * x1 + r1[2] * x2 + r1[3] * x3;
          a2 -= r2[0] * x0 + r2[1] * x1 + r2[2] * x2 + r2[3] * x3;
          a3 -= r3[0] * x0 + r3[1] * x1 + r3[2] * x2 + r3[3] * x3;
        }
        const f32x4 d1 = *(const f32x4*)&sA[(4 * ib + 1) * 68 + 4 * ib], d2 = *(const f32x4*)&sA[(4 * ib + 2) * 68 + 4 * ib], d3 = *(const f32x4*)&sA[(4 * ib + 3) * 68 + 4 * ib];
        a1 -= d1[0] * a0;
        a2 -= d2[0] * a0 + d2[1] * a1;
        a3 -= d3[0] * a0 + d3[1] * a1 + d3[2] * a2;
        sX[(4 * ib) * 128 + c] = a0; sX[(4 * ib + 1) * 128 + c] = a1; sX[(4 * ib + 2) * 128 + c] = a2; sX[(4 * ib + 3) * 128 + c] = a3;
      }
    }
    __syncthreads();
    {
      const int c = tid & 127, jh = (tid >> 7) * 32;
#pragma unroll
      for (int g = 0; g < 4; ++g) {
        u32x4 pk;
#pragma unroll
        for (int e = 0; e < 4; ++e) pk[e] = pack2(sX[(jh + 8 * g + 2 * e) * 128 + c], sX[(jh + 8 * g + 2 * e + 1) * 128 + c]);
        *(u32x4*)&sXt[c * 72 + jh + 8 * g] = pk;
      }
    }
    __syncthreads();
    {
      f32x4 r1[8], r2[8];
#pragma unroll
      for (int ct = 0; ct < 8; ++ct) { r1[ct] = fzero4(); r2[ct] = fzero4(); }
#pragma unroll
      for (int ks = 0; ks < 2; ++ks) {
        const bf16x8 aa = *(const bf16x8*)&sAt[(16 * w + i15) * 72 + ks * 32 + q * 8];
        const bf16x8 ak = *(const bf16x8*)&sKt[(16 * w + i15) * 72 + ks * 32 + q * 8];
#pragma unroll
        for (int ct = 0; ct < 8; ++ct) {
          const bf16x8 bx = *(const bf16x8*)&sXt[(16 * ct + i15) * 72 + ks * 32 + q * 8];
          r1[ct] = MFMA16(aa, bx, r1[ct]); r2[ct] = MFMA16(ak, bx, r2[ct]);
        }
      }
      const size_t ib = (size_t)item * 4096;
#pragma unroll
      for (int ct = 0; ct < 4; ++ct) {
        u32x2 a, b;
        a[0] = pack2(r1[ct][0], r1[ct][1]); a[1] = pack2(r1[ct][2], r1[ct][3]);
        b[0] = pack2(r2[ct][0], r2[ct][1]); b[1] = pack2(r2[ct][2], r2[ct][3]);
        *(u32x2*)(GLO + ib + ((ct * 4 + w) * 64 + lane) * 4) = a;
        *(u32x2*)(GN + ib + ((ct * 4 + w) * 64 + lane) * 4) = b;
      }
#pragma unroll
      for (int ct = 4; ct < 8; ++ct)
#pragma unroll
        for (int r = 0; r < 4; ++r) {
          const int row = 16 * w + 4 * q + r, col = 16 * (ct - 4) + i15;
          const float qv = bf2f(GQ[(size_t)tok(row) * 256 + hd * 64 + col]);
          GQP[ib + row * 64 + permcol(col)] = f2bf(qv * seg[row] - r1[ct][r]);
          GM[ib + row * 64 + permcol(col)] = f2bf((row == col ? eglast : 0.f) - r2[ct][r]);
        }
    }
    __syncthreads();
  }
}

DEVI void gdn_scan_chain(const Params& p, int chain, char* smem) {
  const int tid = p.tid, lane = tid & 63, w = tid >> 6, i15 = lane & 15, q = lane >> 4;
  u16* sM = (u16*)smem;
  u16* sQ = sM + 2 * 64 * 72;
  const u16* GM = (const u16*)(p.ws + O_GM); const u16* GQP = (const u16*)(p.ws + O_GQP);
  const u16* GN = (const u16*)(p.ws + O_GN); const u16* GLO = (const u16*)(p.ws + O_GLO);
  float* GO = (float*)(p.ws + O_GO);
  {
    const int b = chain >> 3, hd = (chain >> 1) & 3, dir = chain & 1;
    f32x4 S[4];
#pragma unroll
    for (int r = 0; r < 4; ++r) S[r] = fzero4();
    auto item_of = [&](int n) {
      int ci = n < 4 ? 256 + b * 4 + (dir ? 3 - n : n) : b * 128 + (dir ? 127 - (n - 4) : (n - 4));
      return ci * 8 + hd * 2 + dir;
    };
    u32x4 pm[2], pq[2]; u32x2 pn[4], pl[4];
    auto prefetch = [&](int n) {
      const size_t base = (size_t)item_of(n) * 4096;
#pragma unroll
      for (int i = 0; i < 2; ++i) {
        const int ch = tid + 256 * i;
        pm[i] = *(const u32x4*)(GM + base + ch * 8);
        pq[i] = *(const u32x4*)(GQP + base + ch * 8);
      }
#pragma unroll
      for (int rb = 0; rb < 4; ++rb) {
        pn[rb] = *(const u32x2*)(GN + base + ((w * 4 + rb) * 64 + lane) * 4);
        pl[rb] = *(const u32x2*)(GLO + base + ((w * 4 + rb) * 64 + lane) * 4);
      }
    };
    prefetch(0);
    __syncthreads();
    for (int n = 0; n < 132; ++n) {
      const int buf = n & 1;
      u16* bM = sM + buf * 64 * 72; u16* bQ = sQ + buf * 64 * 72;
#pragma unroll
      for (int i = 0; i < 2; ++i) {
        const int ch = tid + 256 * i, row = ch >> 3, cc = ch & 7;
        *(u32x4*)&bM[row * 72 + cc * 8] = pm[i];
        *(u32x4*)&bQ[row * 72 + cc * 8] = pq[i];
      }
      f32x4 accs[4], acco[4];
#pragma unroll
      for (int rb = 0; rb < 4; ++rb) {
        accs[rb] = f32x4{bf2f((u16)(pn[rb][0] & 0xffff)), bf2f((u16)(pn[rb][0] >> 16)), bf2f((u16)(pn[rb][1] & 0xffff)), bf2f((u16)(pn[rb][1] >> 16))};
        acco[rb] = f32x4{bf2f((u16)(pl[rb][0] & 0xffff)), bf2f((u16)(pl[rb][0] >> 16)), bf2f((u16)(pl[rb][1] & 0xffff)), bf2f((u16)(pl[rb][1] >> 16))};
      }
      const int ci = n < 4 ? 256 + b * 4 + (dir ? 3 - n : n) : b * 128 + (dir ? 127 - (n - 4) : (n - 4));
      const int t0 = gdn_chunk_t0(ci);
      __syncthreads();
      if (n + 1 < 132) prefetch(n + 1);
      bf16x8 sb[2];
#pragma unroll
      for (int kb = 0; kb < 2; ++kb)
#pragma unroll
        for (int jj = 0; jj < 8; ++jj) sb[kb][jj] = (short)f2bf(S[2 * kb + (jj >> 2)][jj & 3]);
#pragma unroll
      for (int kb = 0; kb < 2; ++kb)
#pragma unroll
        for (int rb = 0; rb < 4; ++rb) {
          const bf16x8 am = *(const bf16x8*)&bM[(rb * 16 + i15) * 72 + kb * 32 + q * 8];
          const bf16x8 aq = *(const bf16x8*)&bQ[(rb * 16 + i15) * 72 + kb * 32 + q * 8];
          accs[rb] = MFMA16(am, sb[kb], accs[rb]);
          acco[rb] = MFMA16(aq, sb[kb], acco[rb]);
        }
#pragma unroll
      for (int rb = 0; rb < 4; ++rb) {
        S[rb] = accs[rb];
#pragma unroll
        for (int r = 0; r < 4; ++r) {
          const int i = rb * 16 + q * 4 + r;
          const int t = dir ? t0 + 63 - i : t0 + i;
          GO[(size_t)dir * T * 256 + (size_t)t * 256 + hd * 64 + w * 16 + i15] = acco[rb][r];
        }
      }
    }
    __syncthreads();
  }
}


template <int DQK>
DEVI void attn_run(int tid, const u16* __restrict__ Qp, int qrow0, const u16* __restrict__ Kp, const u16* __restrict__ Vtp,
                   int a0, int a1, int b0, int b1, int qpos0, float sink2, f32x16 (&O)[2], char* smem) {
  constexpr int KLD = DQK + 8, NS = DQK / 16, KCH = DQK / 8, NKL = (64 * KCH) / 256;
  constexpr int BUF = 64 * KLD + 64 * 72;
  u16* sbase = (u16*)smem;
  const int lane = tid & 63, wid = tid >> 6, r31 = lane & 31, hh = lane >> 5;
  const int qrow = qrow0 + wid * 32 + r31;
  bf16x8 qf[NS];
#pragma unroll
  for (int s = 0; s < NS; ++s) qf[s] = *(const bf16x8*)(Qp + (size_t)qrow * DQK + s * 16 + hh * 8);
#pragma unroll
  for (int i = 0; i < 16; ++i) { O[0][i] = 0.f; O[1][i] = 0.f; }
  float m = -30000.f, lsum = 0.f;
  const int na = (a1 - a0) >> 6, nt = na + ((b1 - b0) >> 6);
  const int qpos = qpos0 + wid * 32 + r31;
  u32x4 rk[NKL], rv[2];
  auto gload = [&](int ti) {
    const int key0 = ti >= na ? b0 + (ti - na) * 64 : a0 + ti * 64;
#pragma unroll
    for (int i = 0; i < NKL; ++i) { const int q = tid + 256 * i, r = q / KCH, cc = q % KCH; rk[i] = *(const u32x4*)(Kp + (size_t)(key0 + r) * DQK + cc * 8); }
#pragma unroll
    for (int i = 0; i < 2; ++i) { const int q = tid + 256 * i, r = q >> 3, cc = q & 7; rv[i] = *(const u32x4*)(Vtp + (size_t)r * NKEY + key0 + cc * 8); }
  };
  auto lstore = [&](int buf) {
    u16* sK = sbase + buf * BUF; u16* sV = sK + 64 * KLD;
#pragma unroll
    for (int i = 0; i < NKL; ++i) { const int q = tid + 256 * i, r = q / KCH, cc = q % KCH; *(u32x4*)&sK[r * KLD + cc * 8] = rk[i]; }
#pragma unroll
    for (int i = 0; i < 2; ++i) { const int q = tid + 256 * i, r = q >> 3, cc = q & 7; *(u32x4*)&sV[r * 72 + cc * 8] = rv[i]; }
  };
  m = 0.f;
  f32x16 negm;
#pragma unroll
  for (int i = 0; i < 16; ++i) negm[i] = 0.f;
  gload(0);
  __syncthreads();
  lstore(0);
  __syncthreads();
  for (int ti = 0; ti < nt; ++ti) {
    if (ti + 1 < nt) gload(ti + 1);
    const u16* sK = sbase + (ti & 1) * BUF; const u16* sV = sK + 64 * KLD;
    const bool inB = ti >= na;
    const int key0 = inB ? b0 + (ti - na) * 64 : a0 + ti * 64;
    f32x16 st[2];
#pragma unroll
    for (int k2 = 0; k2 < 2; ++k2) {
      {
        const bf16x8 kf = *(const bf16x8*)&sK[(k2 * 32 + r31) * KLD + hh * 8];
        asm volatile("v_mfma_f32_32x32x16_bf16 %0, %1, %2, %3" : "=&v"(st[k2]) : "v"(kf), "v"(qf[0]), "v"(negm));
      }
#pragma unroll
      for (int s = 1; s < NS; ++s) {
        const bf16x8 kf = *(const bf16x8*)&sK[(k2 * 32 + r31) * KLD + s * 16 + hh * 8];
        st[k2] = MFMA32(kf, qf[s], st[k2]);
      }
    }
    if (inB) {
#pragma unroll
      for (int k2 = 0; k2 < 2; ++k2)
#pragma unroll
        for (int g = 0; g < 16; ++g) {
          const int d = key0 + k2 * 32 + (g & 3) + 8 * (g >> 2) + 4 * hh - qpos;
          if (d > 128 || d < -128) st[k2][g] = -1e30f;
        }
    }
    bf16x8 vfr[2][2][2];
#pragma unroll
    for (int k2 = 0; k2 < 2; ++k2)
#pragma unroll
      for (int s2 = 0; s2 < 2; ++s2)
#pragma unroll
        for (int dvt = 0; dvt < 2; ++dvt) vfr[k2][s2][dvt] = *(const bf16x8*)&sV[(dvt * 32 + r31) * 72 + k2 * 32 + s2 * 16 + 8 * hh];
    float mx = st[0][0];
#pragma unroll
    for (int g = 1; g < 16; ++g) mx = fmaxf(mx, st[0][g]);
#pragma unroll
    for (int g = 0; g < 16; ++g) mx = fmaxf(mx, st[1][g]);
    { auto rr = __builtin_amdgcn_permlane32_swap(__float_as_uint(mx), __float_as_uint(mx), false, false);
      mx = fmaxf(__uint_as_float(rr[0]), __uint_as_float(rr[1])); }
    if (ti == 0 || __any(mx > 8.f)) {
      const float delta = ti == 0 ? fmaxf(mx, -1e4f) : fmaxf(mx, 0.f);
      if (ti != 0) {
        const float alpha = __builtin_amdgcn_exp2f(-delta);
        lsum *= alpha;
#pragma unroll
        for (int i = 0; i < 16; ++i) { O[0][i] *= alpha; O[1][i] *= alpha; }
      }
      m += delta;
#pragma unroll
      for (int i = 0; i < 16; ++i) { negm[i] = -m; st[0][i] -= delta; st[1][i] -= delta; }
    }
    f32x2 ps2 = {0.f, 0.f};
#pragma unroll
    for (int k2 = 0; k2 < 2; ++k2)
#pragma unroll
      for (int g = 0; g < 16; g += 2) {
        const float p0 = __builtin_amdgcn_exp2f(st[k2][g]), p1 = __builtin_amdgcn_exp2f(st[k2][g + 1]);
        st[k2][g] = p0; st[k2][g + 1] = p1;
        ps2 += f32x2{p0, p1};
      }
    lsum += ps2[0] + ps2[1];
#pragma unroll
    for (int k2 = 0; k2 < 2; ++k2)
#pragma unroll
      for (int s2 = 0; s2 < 2; ++s2) {
        u32x4 pp;
#pragma unroll
        for (int j = 0; j < 4; ++j) pp[j] = pack2(st[k2][8 * s2 + 2 * j], st[k2][8 * s2 + 2 * j + 1]);
        const bf16x8 pf = __builtin_bit_cast(bf16x8, pp);
#pragma unroll
        for (int dvt = 0; dvt < 2; ++dvt) {
          O[dvt] = MFMA32(vfr[k2][s2][dvt], pf, O[dvt]);
        }
      }
    if (ti + 1 < nt) lstore((ti + 1) & 1);
    __syncthreads();
  }
  if (sink2 > -1e29f) {
    const float mn = fmaxf(m, sink2);
    const float alpha = __builtin_amdgcn_exp2f(m - mn);
    lsum = lsum * alpha + (hh == 0 ? __builtin_amdgcn_exp2f(sink2 - mn) : 0.f);
#pragma unroll
    for (int i = 0; i < 16; ++i) { O[0][i] *= alpha; O[1][i] *= alpha; }
  }
  const float ltot = lsum + __shfl_xor(lsum, 32);
  const float inv = 1.f / ltot;
#pragma unroll
  for (int i = 0; i < 16; ++i) { O[0][i] *= inv; O[1][i] *= inv; }
}
DEVI void attn_store(int tid, const f32x16 (&O)[2], u16* dst, int ld, int b, int qrow0, int col0) {
  const int lane = tid & 63, wid = tid >> 6, r31 = lane & 31, hh = lane >> 5;
  const int qrow = qrow0 + wid * 32 + r31;
  const int t = qrow < SEQ ? b * SEQ + qrow : TL + b * CTXL + (qrow - SEQ);
  u16* yr = dst + (size_t)t * ld + col0;
#pragma unroll
  for (int dvt = 0; dvt < 2; ++dvt)
#pragma unroll
    for (int g4 = 0; g4 < 4; ++g4) {
      u32x2 pk; pk[0] = pack2(O[dvt][g4 * 4 + 0], O[dvt][g4 * 4 + 1]); pk[1] = pack2(O[dvt][g4 * 4 + 2], O[dvt][g4 * 4 + 3]);
      *(u32x2*)(yr + dvt * 32 + 8 * g4 + 4 * hh) = pk;
    }
}
DEVI void attn_item(const Params& p, int l, int mixer, int b, int h, int qb, char* smem) {
  const bool lat = qb < 64;
  const int qrow0 = qb * 128;
  f32x16 O[2];
  if (mixer == 0) {
    attn_run<32>(p.tid, (const u16*)(p.ws + O_QB) + (size_t)(b * 8 + h) * NKEY * 32, qrow0, (const u16*)(p.ws + O_KB) + (size_t)(b * 8 + h) * NKEY * 32,
                 (const u16*)(p.ws + O_VTB) + (size_t)(b * 4 + (h >> 1)) * 64 * NKEY, lat ? 0 : SEQ, NKEY, 0, 0, 0, -1e30f, O, smem);
    attn_store(p.tid, O, (u16*)(p.ws + O_OB), 512, b, qrow0, h * 64);
  } else if (mixer == 1) {
    attn_run<96>(p.tid, (const u16*)(p.ws + O_QC) + (size_t)(b * 4 + h) * NKEY * 96, qrow0, (const u16*)(p.ws + O_KC) + (size_t)(b * 4 + h) * NKEY * 96,
                 (const u16*)(p.ws + O_VTC) + (size_t)(b * 4 + h) * 64 * NKEY, lat ? 0 : SEQ, NKEY, 0, 0, 0, -1e30f, O, smem);
    attn_store(p.tid, O, (u16*)(p.ws + O_Y), 1024, b, qrow0, 512 + h * 64);
  } else {
    const float sink2 = pin(p, I_SINK)[l * 4 + h] * LOG2E;
    const int hk = h >> 1;
    int b0 = 0, b1 = 0;
    if (lat) { b0 = (qb - 1) * 128; if (b0 < 0) b0 = 0; b1 = (qb + 2) * 128; if (b1 > SEQ) b1 = SEQ; }
    attn_run<64>(p.tid, (const u16*)(p.ws + O_QA) + (size_t)(b * 4 + h) * NKEY * 64, qrow0, (const u16*)(p.ws + O_KA) + (size_t)(b * 2 + hk) * NKEY * 64,
                 (const u16*)(p.ws + O_VTA) + (size_t)(b * 2 + hk) * 64 * NKEY, SEQ, NKEY, b0, b1, qrow0, sink2, O, smem);
    attn_store(p.tid, O, (u16*)(p.ws + O_Y), 1024, b, qrow0, h * 64);
  }
}

constexpr int SMEM_BYTES = 78848 + 64;

DEVI unsigned long long launder_ptr(unsigned long long v) {
  unsigned lo = __builtin_amdgcn_readfirstlane((unsigned)v), hi = __builtin_amdgcn_readfirstlane((unsigned)(v >> 32));
  asm volatile("s_mov_b32 %0, %1" : "=s"(lo) : "s"(lo));
  asm volatile("s_mov_b32 %0, %1" : "=s"(hi) : "s"(hi));
  return ((unsigned long long)hi << 32) | lo;
}
DEVI Params mkctx(const KArgs& a) {
  Params c;
  typedef __attribute__((address_space(1))) char gchar;
  typedef __attribute__((address_space(1))) float gfloat;
  c.ws = (char*)(gchar*)launder_ptr((unsigned long long)a.ws);
  c.out = (float*)(gfloat*)launder_ptr((unsigned long long)a.out);
  c.in = (gcfloat* const*)(c.ws + O_TAB);
  c.tid = threadIdx.x;
  asm volatile("" : "+v"(c.tid));
  return c;
}
DEVI void st_mixer_queue(const KArgs& a, int l, char* smem) {
  int* sitem = (int*)(smem + SMEM_BYTES - 16);
  const int g = blockIdx.x & 7;
  const int nctx = l == 0 ? 8 : 0;
  constexpr int NPREP = TR_P2 / 8 / 8;
  const int total = 2 + 128 + 64 + 64 + nctx + NPREP;
  for (;;) {
    const Params p = mkctx(a);
    unsigned* head = (unsigned*)(p.ws + O_BAR) + 16 + l * 8 + g;
    __syncthreads();
    if (p.tid == 0) *sitem = (int)atomicAdd(head, 1u);
    __syncthreads();
    int it = *sitem;
    if (it >= total) break;
    if (it < 2) { gdn_scan_chain(p, 2 * g + it, smem); continue; }
    it -= 2;
    if (it < 256 + nctx) {
      int mixer, b, h, qb;
      if (it < 128) { const int pr = 2 * g + (it >> 6); mixer = 0; b = pr >> 3; h = pr & 7; qb = it & 63; }
      else if (it < 256) { mixer = 1 + ((it - 128) >> 6); b = g >> 2; h = g & 3; qb = it & 63; }
      else {
        const int j = it - 256;
        if (j < 4) { const int pr = 2 * g + (j >> 1); mixer = 0; b = pr >> 3; h = pr & 7; qb = 64 + (j & 1); }
        else { mixer = 1 + ((j - 4) >> 1); b = g >> 2; h = g & 3; qb = 64 + (j & 1); }
      }
      attn_item(p, l, mixer, b, h, qb, smem);
      continue;
    }
    it -= 256 + nctx;
    prep_w2_run8(p, l, (it * 8 + g) * 8, (float*)smem);
  }
}

DEVI void st_mix_finish(const Params& p, int l, int vb, int nvb) {
  const int lane = p.tid & 63, wid = p.tid >> 6;
  const float* GO = (const float*)(p.ws + O_GO); const u16* PP = (const u16*)(p.ws + O_PP); const u16* OB = (const u16*)(p.ws + O_OB);
  u16* Y = (u16*)(p.ws + O_Y);
  const float lam_init = 0.8f - 0.6f * expf(-0.3f * (float)l);
  float d1 = lane < 32 ? pin(p, I_LQ1)[l * 32 + lane] * pin(p, I_LK1)[l * 32 + lane] : 0.f;
  float d2 = lane < 32 ? pin(p, I_LQ2)[l * 32 + lane] * pin(p, I_LK2)[l * 32 + lane] : 0.f;
  const float lam = expf(wave_sum(d1)) - expf(wave_sum(d2)) + lam_init;
  const int hd = lane >> 4, d0 = (lane & 15) * 4;
  const f32x4 gg = *(const f32x4*)(pin(p, I_GNG) + l * 64 + d0);
  const f32x4 dg = *(const f32x4*)(pin(p, I_DNG) + l * 64 + d0) * (1.f - lam_init);
  const int tend = l == 0 ? T : TL;
  for (int t0 = (vb * 4 + wid) * 2; t0 < tend; t0 += nvb * 8) {
    u32x2 o0[2], o1[2], zz[2]; f32x4 gf[2], gb[2];
#pragma unroll
    for (int u = 0; u < 2; ++u) {
      const size_t t = t0 + u;
      o0[u] = *(const u32x2*)(OB + t * 512 + (hd * 2) * 64 + d0);
      o1[u] = *(const u32x2*)(OB + t * 512 + (hd * 2 + 1) * 64 + d0);
      gf[u] = *(const f32x4*)(GO + t * 256 + hd * 64 + d0);
      gb[u] = *(const f32x4*)(GO + (size_t)T * 256 + t * 256 + hd * 64 + d0);
      zz[u] = *(const u32x2*)(PP + t * LDPP + PP_DZ + hd * 64 + d0);
    }
    f32x4 od[2], go[2]; float ssb[2], ssg[2];
#pragma unroll
    for (int u = 0; u < 2; ++u) {
      const f32x4 a = {bflo(o0[u][0]), bfhi(o0[u][0]), bflo(o0[u][1]), bfhi(o0[u][1])};
      const f32x4 b = {bflo(o1[u][0]), bfhi(o1[u][0]), bflo(o1[u][1]), bfhi(o1[u][1])};
      od[u] = a - lam * b; go[u] = gf[u] + gb[u];
      ssb[u] = od[u][0] * od[u][0] + od[u][1] * od[u][1] + od[u][2] * od[u][2] + od[u][3] * od[u][3];
      ssg[u] = go[u][0] * go[u][0] + go[u][1] * go[u][1] + go[u][2] * go[u][2] + go[u][3] * go[u][3];
    }
#pragma unroll
    for (int o = 8; o >= 1; o >>= 1) {
#pragma unroll
      for (int u = 0; u < 2; ++u) { ssb[u] += __shfl_xor(ssb[u], o); ssg[u] += __shfl_xor(ssg[u], o); }
    }
#pragma unroll
    for (int u = 0; u < 2; ++u) {
      const size_t t = t0 + u;
      const f32x4 yb = od[u] * (rsqrtf(ssb[u] * (1.f / 64.f) + 1e-6f)) * dg;
      const f32x4 z = {bflo(zz[u][0]), bfhi(zz[u][0]), bflo(zz[u][1]), bfhi(zz[u][1])};
      const f32x4 sz = {siluf(z[0]), siluf(z[1]), siluf(z[2]), siluf(z[3])};
      const f32x4 yd = go[u] * (rsqrtf(ssg[u] * (1.f / 64.f) + 1e-6f)) * gg * sz;
      u32x2 pb, pd;
      pb[0] = pack2(yb[0], yb[1]); pb[1] = pack2(yb[2], yb[3]);
      pd[0] = pack2(yd[0], yd[1]); pd[1] = pack2(yd[2], yd[3]);
      *(u32x2*)(Y + t * 1024 + 256 + hd * 64 + d0) = pb;
      *(u32x2*)(Y + t * 1024 + 768 + hd * 64 + d0) = pd;
    }
  }
}

constexpr int RLD = 1026;
DEVI void st_norm2_route(const Params& p, int l, int vb, int nvb, char* smem) {
  const int lane = p.tid & 63, wid = p.tid >> 6, i15 = lane & 15, q = lane >> 4;
  float* shh = (float*)smem;
  float* slog = shh + 16 * RLD;
  const float* g = pin(p, I_N2G) + l * 1024;
  const float* wr = pin(p, I_WR) + (size_t)l * 1024 * 64;
  const float bias = pin(p, I_RB)[l * 64 + lane];
  float* WTS = (float*)(p.ws + O_WTS); int* CNT = (int*)(p.ws + O_CNT); int* LIST = (int*)(p.ws + O_LIST);
  const int ntok = l == 0 ? T : TL;
  for (int grp = vb; grp < ntok / 16; grp += nvb) {
    const int tb = grp * 16 + wid * 4;
    const int mv = tok_mv(tb);
    const float* sh = modp(p, l, mv, 3); const float* sc = modp(p, l, mv, 4);
    {
      f32x4 v[4][4]; float ss[4];
#pragma unroll
      for (int u = 0; u < 4; ++u) {
        const f32x4* xr = (const f32x4*)((const float*)(p.ws + O_XA) + (size_t)(tb + u) * 1024);
#pragma unroll
        for (int i = 0; i < 4; ++i) v[u][i] = xr[i * 64 + lane];
      }
#pragma unroll
      for (int u = 0; u < 4; ++u) {
        float a = 0.f;
#pragma unroll
        for (int i = 0; i < 4; ++i) a += v[u][i][0] * v[u][i][0] + v[u][i][1] * v[u][i][1] + v[u][i][2] * v[u][i][2] + v[u][i][3] * v[u][i][3];
        ss[u] = a;
      }
#pragma unroll
      for (int o = 32; o >= 1; o >>= 1) {
#pragma unroll
        for (int u = 0; u < 4; ++u) ss[u] += __shfl_xor(ss[u], o);
      }
#pragma unroll
      for (int i = 0; i < 4; ++i) {
        const int c = i * 256 + lane * 4;
        const f32x4 gg = *(const f32x4*)(g + c), s4 = *(const f32x4*)(sc + c), h4 = *(const f32x4*)(sh + c);
        const f32x4 gs = gg * (1.f + s4);
#pragma unroll
        for (int u = 0; u < 4; ++u) {
          const float rstd = rsqrtf(ss[u] * (1.f / 1024.f) + 1e-6f);
          const f32x4 o = v[u][i] * rstd * gs + h4;
          u32x2 pk; pk[0] = pack2(o[0], o[1]); pk[1] = pack2(o[2], o[3]);
          *(u32x2*)((u16*)(p.ws + O_H) + (size_t)(tb + u) * LDH + c) = pk;
          float* d = shh + (wid * 4 + u) * RLD + c;
          *(f32x2*)d = f32x2{o[0], o[1]}; *(f32x2*)(d + 2) = f32x2{o[2], o[3]};
        }
      }
    }
    __syncthreads();
    {
      f32x4 a0 = fzero4(), a1 = a0;
      const float* ap = shh + i15 * RLD + q;
      const float* bp = wr + (size_t)q * 64 + wid * 16 + i15;
#pragma unroll 1
      for (int kb = 0; kb < 256; kb += 32) {
        float bv[32];
#pragma unroll
        for (int j = 0; j < 32; ++j) bv[j] = bp[(size_t)(4 * (kb + j)) * 64];
#pragma unroll
        for (int j = 0; j < 32; j += 2) {
          a0 = __builtin_amdgcn_mfma_f32_16x16x4f32(ap[4 * (kb + j)], bv[j], a0, 0, 0, 0);
          a1 = __builtin_amdgcn_mfma_f32_16x16x4f32(ap[4 * (kb + j) + 4], bv[j + 1], a1, 0, 0, 0);
        }
      }
#pragma unroll
      for (int r = 0; r < 4; ++r) slog[(4 * q + r) * 64 + wid * 16 + i15] = a0[r] + a1[r];
    }
    __syncthreads();
#pragma unroll 1
    for (int u = 0; u < 4; ++u) {
      const int t = tb + u;
      const float logit = slog[(wid * 4 + u) * 64 + lane];
      const float s = 1.f / (1.f + expf(-logit));
      const float c = s + bias;
      float m1 = c;
      m1 = fmaxf(m1, __shfl_xor(m1, 1)); m1 = fmaxf(m1, __shfl_xor(m1, 2)); m1 = fmaxf(m1, __shfl_xor(m1, 4));
      const unsigned long long bal = __ballot(c == m1);
      const int grpi = lane >> 3;
      const unsigned gm = (unsigned)((bal >> (grpi * 8)) & 0xffull);
      const int first = __ffs(gm) - 1;
      float m2 = ((lane & 7) == first) ? -INFINITY : c;
      m2 = fmaxf(m2, __shfl_xor(m2, 1)); m2 = fmaxf(m2, __shfl_xor(m2, 2)); m2 = fmaxf(m2, __shfl_xor(m2, 4));
      const float gs = m1 + m2;
      int grank = 0;
#pragma unroll
      for (int gg = 0; gg < 8; ++gg) { float o = __shfl(gs, gg * 8); grank += (o > gs || (o == gs && gg < grpi)) ? 1 : 0; }
      const bool gsel = grank < 4;
      const float mc = gsel ? c : -INFINITY;
      int rank = 0;
#pragma unroll
      for (int e = 0; e < 64; ++e) { float o = __shfl(mc, e); rank += (o > mc || (o == mc && e < lane)) ? 1 : 0; }
      const bool sel = gsel && rank < 6;
      const float ssum = wave_sum(sel ? s : 0.f);
      if (sel) {
        const int slot = t * 6 + rank;
        WTS[slot] = s / ssum * 2.5f;
        const int pos = atomicAdd(&CNT[lane], 1);
        LIST[(size_t)lane * T + pos] = slot;
      }
    }
    __syncthreads();
  }
}
DEVI void st_outproj(const Params& p, int l, int vb, int nvb, char* smem) {
  const u16* Y = (const u16*)(p.ws + O_Y); const u16* W = (const u16*)(p.ws + O_WOUTT); float* XA = (float*)(p.ws + O_XA);
  const int tid = p.tid, lane = tid & 63, wid = tid >> 6, wr = wid >> 1, wc = wid & 1, fr = lane & 15, fq = lane >> 4;
  const int nmt = l == 0 ? 132 : 128;
  const int g = vb & 7, nmg = (nmt - g + 7) >> 3;
  for (int i = vb >> 3; i < nmg * 8; i += nvb >> 3) {
    const int m0 = (g + 8 * (i >> 3)) * 128, n0 = (i & 7) * 128;
    f32x4 acc[4][4];
    gemm_core<false>(tid, [&](int r) { return Y + (size_t)(m0 + r) * 1024; }, W + (size_t)n0 * LDW, LDW, 1024, acc, smem);
    const float* gbase = modp(p, l, tok_mv(m0), 2) + n0 + wc * 64 + fq * 4;
#pragma unroll
    for (int hf = 0; hf < 2; ++hf) {
      f32x4 xin[2][4], gt[4];
#pragma unroll
      for (int n = 0; n < 4; ++n) gt[n] = *(const f32x4*)(gbase + n * 16);
#pragma unroll
      for (int mm = 0; mm < 2; ++mm) {
        const int t = m0 + wr * 64 + (hf * 2 + mm) * 16 + fr;
        const float* src = l == 0 ? (t < TL ? pin(p, I_X) + (size_t)t * 1024 : pin(p, I_CTX) + (size_t)(t - TL) * 1024) : (const float*)(XA + (size_t)t * 1024);
#pragma unroll
        for (int n = 0; n < 4; ++n) xin[mm][n] = *(const f32x4*)(src + n0 + wc * 64 + n * 16 + fq * 4);
      }
#pragma unroll
      for (int mm = 0; mm < 2; ++mm) {
        const int t = m0 + wr * 64 + (hf * 2 + mm) * 16 + fr;
#pragma unroll
        for (int n = 0; n < 4; ++n) *(f32x4*)(XA + (size_t)t * 1024 + n0 + wc * 64 + n * 16 + fq * 4) = xin[mm][n] + gt[n] * acc[hf * 2 + mm][n];
      }
    }
  }
}

DEVI void grp_tiles(const Params& p, int* tst, int g, int shift, int nshared) {
  __syncthreads();
  if (p.tid < 64) {
    const int* CNT = (const int*)(p.ws + O_CNT);
    const int lane = p.tid;
    int c = 0;
    if (lane < 8) c = (__hip_atomic_load(&CNT[g + 8 * lane], __ATOMIC_RELAXED, __HIP_MEMORY_SCOPE_AGENT) + (1 << shift) - 1) >> shift;
    int incl = c;
#pragma unroll
    for (int o = 1; o < 8; o <<= 1) { int u = __shfl_up(incl, o); if (lane >= o) incl += u; }
    if (lane < 8) tst[lane] = incl - c;
    if (lane == 7) { tst[8] = incl; tst[9] = incl + (nshared - g + 7) / 8; }
  }
  __syncthreads();
}
DEVI void grp_find(const int* tst, int tile, int g, int& e, int& lt) {
  int j = 0;
#pragma unroll
  for (int k = 1; k <= 8; ++k) j += tile >= tst[k] ? 1 : 0;
  if (j < 8) { e = g + 8 * j; lt = tile - tst[j]; } else { e = 64; lt = g + 8 * (tile - tst[8]); }
}
DEVI void st_moe1(const Params& p, int l, int vb, int nvb, char* smem) {
  const int* CNT = (const int*)(p.ws + O_CNT); const int* LIST = (const int*)(p.ws + O_LIST);
  const u16* H = (const u16*)(p.ws + O_H); u16* HB = (u16*)(p.ws + O_HB);
  int* sslot = (int*)(smem + 4 * 128 * GLD * 2);
  int* TST = sslot + 128;
  const int g = vb & 7;
  const int nsh = l == 0 ? T : TL;
  grp_tiles(p, TST, g, 7, nsh / 128);
  const int total = TST[9];
  auto fetch_slot = [&](int item, int& e, int& n0) {
    const int tile = item >> 2; n0 = (item & 3) * 128;
    int lt; grp_find(TST, tile, g, e, lt);
    int slot = -1;
    if (p.tid < 128) {
      const int cnt = e < 64 ? __hip_atomic_load(&CNT[e], __ATOMIC_RELAXED, __HIP_MEMORY_SCOPE_AGENT) : nsh;
      const int i = lt * 128 + p.tid;
      if (i < cnt) slot = e < 64 ? LIST[(size_t)e * T + i] : NSLOT + i;
    }
    return slot;
  };
  int e = 0, n0 = 0, e_nx = 0, n0_nx = 0;
  int slot_nx = (vb >> 3) < total * 4 ? fetch_slot(vb >> 3, e_nx, n0_nx) : -1;
  for (int item = vb >> 3; item < total * 4; item += nvb >> 3) {
    e = e_nx; n0 = n0_nx;
    __syncthreads();
    if (p.tid < 128) sslot[p.tid] = slot_nx;
    __syncthreads();
    if (item + (nvb >> 3) < total * 4) slot_nx = fetch_slot(item + (nvb >> 3), e_nx, n0_nx);
    gemm128(p.tid, [&](int r) { int sl = sslot[r]; int tk = sl < 0 ? 0 : (sl < NSLOT ? sl / 6 : sl - NSLOT); return H + (size_t)tk * LDH; },
            (const u16*)(p.ws + O_WGUT) + ((size_t)e * 512 + n0) * LDW, LDW, 1024,
            [&](int r, int c, f32x4 v) {
              int sl = sslot[r]; if (sl < 0) return;
              float h0 = siluf(v[0]) * v[1], h1 = siluf(v[2]) * v[3];
              *(unsigned*)(HB + (size_t)sl * 256 + ((n0 + c) >> 1)) = pack2(h0, h1);
            }, smem);
  }
}
DEVI void st_moe2(const Params& p, int l, int vb, int nvb, char* smem) {
  const int* CNT = (const int*)(p.ws + O_CNT); const int* LIST = (const int*)(p.ws + O_LIST);
  const u16* HB = (const u16*)(p.ws + O_HB); u16* SO = (u16*)(p.ws + O_SLOT); const float* WTS = (const float*)(p.ws + O_WTS);
  constexpr int ALD = 264;
  u16* sA = (u16*)smem;
  u16* sB = sA + 64 * ALD;
  int* sslot = (int*)(sB + 2 * 128 * 72);
  int* TST = sslot + 64;
  const int tid = p.tid, lane = tid & 63, wid = tid >> 6, wr = wid >> 1, wc = wid & 1, fr = lane & 15, fq = lane >> 4;
  const int g = vb & 7;
  const int nsh = l == 0 ? T : TL;
  grp_tiles(p, TST, g, 6, nsh / 64);
  const int total = TST[9];
  for (int item = vb >> 3; item < total; item += nvb >> 3) {
    int e, lt; grp_find(TST, item, g, e, lt);
    const int cnt = e < 64 ? __hip_atomic_load(&CNT[e], __ATOMIC_RELAXED, __HIP_MEMORY_SCOPE_AGENT) : nsh;
    __syncthreads();
    if (tid < 64) { const int i = lt * 64 + tid; sslot[tid] = i < cnt ? (e < 64 ? LIST[(size_t)e * T + i] : NSLOT + i) : -1; }
    __syncthreads();
    const u16* Bbase = (const u16*)(p.ws + O_WDT) + (size_t)e * 1024 * 256;
    u32x4 rb0[4], rb1[4], rb2[4];
    const u16* bthr = Bbase + (size_t)(tid >> 3) * 256 + (tid & 7) * 8;
    auto gloadB = [&](u32x4 (&rb)[4], int bt) {
      int off = (bt >> 2) * 128 * 256 + (bt & 3) * 64;
      asm volatile("" : "+s"(off));
      const u16* src = bthr + off;
#pragma unroll
      for (int i = 0; i < 4; ++i) rb[i] = *(const u32x4*)(src + i * 32 * 256);
    };
    auto lstoreB = [&](const u32x4 (&rb)[4], int buf) {
      u16* d = sB + buf * 128 * 72;
#pragma unroll
      for (int i = 0; i < 4; ++i) { const int q = tid + 256 * i, r = q >> 3, cc = q & 7; *(u32x4*)&d[r * 72 + cc * 8] = rb[i]; }
    };
    gloadB(rb0, 0); gloadB(rb1, 1); gloadB(rb2, 2);
#pragma unroll
    for (int hf = 0; hf < 2; ++hf) {
      u32x4 ra[4];
#pragma unroll
      for (int i = 0; i < 4; ++i) { const int q = tid + 256 * (4 * hf + i), r = q >> 5, cc = q & 31; const int sl = sslot[r]; ra[i] = *(const u32x4*)(HB + (size_t)(sl < 0 ? 0 : sl) * 256 + cc * 8); }
#pragma unroll
      for (int i = 0; i < 4; ++i) { const int q = tid + 256 * (4 * hf + i), r = q >> 5, cc = q & 31; *(u32x4*)&sA[r * ALD + cc * 8] = ra[i]; }
      __builtin_amdgcn_sched_barrier(0);
    }
    int slot_m[2]; float w_m[2];
#pragma unroll
    for (int m = 0; m < 2; ++m) { const int sl = sslot[wr * 32 + m * 16 + fr]; slot_m[m] = sl; w_m[m] = (sl >= 0 && sl < NSLOT) ? WTS[sl] : 1.f; }
    lstoreB(rb0, 0); gloadB(rb0, 3);
    __syncthreads();
    f32x4 acc[2][4];
    auto compute = [&](int bt, int buf) {
      const int nt = bt >> 2, kt = bt & 3;
      const u16* b = sB + buf * 128 * 72;
      if (kt == 0) {
#pragma unroll
        for (int m = 0; m < 2; ++m)
#pragma unroll
          for (int n = 0; n < 4; ++n) acc[m][n] = fzero4();
      }
#pragma unroll
      for (int ks = 0; ks < 2; ++ks) {
        bf16x8 af[2], bfr[4];
#pragma unroll
        for (int m = 0; m < 2; ++m) af[m] = *(const bf16x8*)&sA[(wr * 32 + m * 16 + fr) * ALD + kt * 64 + ks * 32 + fq * 8];
#pragma unroll
        for (int n = 0; n < 4; ++n) bfr[n] = *(const bf16x8*)&b[(wc * 64 + n * 16 + fr) * 72 + ks * 32 + fq * 8];
#pragma unroll
        for (int m = 0; m < 2; ++m)
#pragma unroll
          for (int n = 0; n < 4; ++n) acc[m][n] = MFMA16(bfr[n], af[m], acc[m][n]);
      }
      if (kt == 3) {
#pragma unroll
        for (int m = 0; m < 2; ++m) {
          if (slot_m[m] >= 0) {
            const float w = w_m[m];
#pragma unroll
            for (int n = 0; n < 4; ++n) {
              u32x2 pk; pk[0] = pack2(acc[m][n][0] * w, acc[m][n][1] * w); pk[1] = pack2(acc[m][n][2] * w, acc[m][n][3] * w);
              *(u32x2*)(SO + (size_t)slot_m[m] * 1024 + nt * 128 + wc * 64 + n * 16 + fq * 4) = pk;
            }
          }
        }
      }
    };
#pragma unroll
    for (int bt = 0; bt < 30; bt += 3) {
      compute(bt, bt & 1);           lstoreB(rb1, (bt + 1) & 1); if (bt + 4 < 32) gloadB(rb1, bt + 4); __syncthreads(); __builtin_amdgcn_sched_barrier(0);
      compute(bt + 1, (bt + 1) & 1); lstoreB(rb2, (bt + 2) & 1); if (bt + 5 < 32) gloadB(rb2, bt + 5); __syncthreads(); __builtin_amdgcn_sched_barrier(0);
      compute(bt + 2, (bt + 2) & 1); lstoreB(rb0, (bt + 3) & 1); if (bt + 6 < 32) gloadB(rb0, bt + 6); __syncthreads(); __builtin_amdgcn_sched_barrier(0);
    }
    compute(30, 0); lstoreB(rb1, 1); __syncthreads(); __builtin_amdgcn_sched_barrier(0);
    compute(31, 1); __syncthreads();
  }
}

DEVI void st_combine(const Params& p, int l, int vb, int nvb) {
  const int lane = p.tid & 63, wid = p.tid >> 6;
  const u16* SO = (const u16*)(p.ws + O_SLOT);
  const bool last = l == 1;
  const float* gnext = last ? pin(p, I_FNG) : pin(p, I_N1G) + 1024;
  const int tend = last ? TL : T;
  for (int t0 = (vb * 4 + wid) * 2; t0 < tend; t0 += nvb * 8) {
    const int mv = tok_mv(t0);
    const float* g5 = modp(p, l, mv, 5);
    u32x4 sv[2][7][2]; f32x4 xv[2][4];
#pragma unroll
    for (int u = 0; u < 2; ++u) {
      const int t = t0 + u;
#pragma unroll
      for (int k = 0; k < 7; ++k) {
        const u16* row = SO + (size_t)(k < 6 ? t * 6 + k : NSLOT + t) * 1024;
        sv[u][k][0] = *(const u32x4*)(row + lane * 8); sv[u][k][1] = *(const u32x4*)(row + 512 + lane * 8);
      }
      const float* xr = (const float*)(p.ws + O_XA) + (size_t)t * 1024;
      xv[u][0] = *(const f32x4*)(xr + lane * 8); xv[u][1] = *(const f32x4*)(xr + lane * 8 + 4);
      xv[u][2] = *(const f32x4*)(xr + 512 + lane * 8); xv[u][3] = *(const f32x4*)(xr + 512 + lane * 8 + 4);
    }
    f32x4 gq[4];
    gq[0] = *(const f32x4*)(g5 + lane * 8); gq[1] = *(const f32x4*)(g5 + lane * 8 + 4);
    gq[2] = *(const f32x4*)(g5 + 512 + lane * 8); gq[3] = *(const f32x4*)(g5 + 512 + lane * 8 + 4);
    float ss[2];
#pragma unroll
    for (int u = 0; u < 2; ++u) {
      float acc = 0.f;
#pragma unroll
      for (int hf = 0; hf < 2; ++hf) {
        f32x4 a0 = fzero4(), a1 = a0;
#pragma unroll
        for (int k = 0; k < 7; ++k) {
          const u32x4 v = sv[u][k][hf];
          a0[0] += bflo(v[0]); a0[1] += bfhi(v[0]); a0[2] += bflo(v[1]); a0[3] += bfhi(v[1]);
          a1[0] += bflo(v[2]); a1[1] += bfhi(v[2]); a1[2] += bflo(v[3]); a1[3] += bfhi(v[3]);
        }
        xv[u][2 * hf] += gq[2 * hf] * a0; xv[u][2 * hf + 1] += gq[2 * hf + 1] * a1;
#pragma unroll
        for (int e = 0; e < 4; ++e) acc += xv[u][2 * hf][e] * xv[u][2 * hf][e] + xv[u][2 * hf + 1][e] * xv[u][2 * hf + 1][e];
      }
      ss[u] = acc;
    }
#pragma unroll
    for (int o = 32; o >= 1; o >>= 1) { ss[0] += __shfl_xor(ss[0], o); ss[1] += __shfl_xor(ss[1], o); }
    f32x4 gn[4];
    gn[0] = *(const f32x4*)(gnext + lane * 8); gn[1] = *(const f32x4*)(gnext + lane * 8 + 4);
    gn[2] = *(const f32x4*)(gnext + 512 + lane * 8); gn[3] = *(const f32x4*)(gnext + 512 + lane * 8 + 4);
    if (!last) {
      const float* sh = modp(p, 1, mv, 0); const float* sc = modp(p, 1, mv, 1);
#pragma unroll
      for (int q = 0; q < 4; ++q) {
        const int c = (q >> 1) * 512 + lane * 8 + (q & 1) * 4;
        const f32x4 s4 = *(const f32x4*)(sc + c), h4 = *(const f32x4*)(sh + c);
        const f32x4 gs = gn[q] * (1.f + s4);
#pragma unroll
        for (int u = 0; u < 2; ++u) {
          const size_t t = t0 + u;
          const float rstd = rsqrtf(ss[u] * (1.f / 1024.f) + 1e-6f);
          *(f32x4*)((float*)(p.ws + O_XA) + t * 1024 + c) = xv[u][q];
          const f32x4 o = xv[u][q] * rstd * gs + h4;
          u32x2 pk; pk[0] = pack2(o[0], o[1]); pk[1] = pack2(o[2], o[3]);
          *(u32x2*)((u16*)(p.ws + O_H) + t * LDH + c) = pk;
        }
      }
    } else {
#pragma unroll
      for (int q = 0; q < 4; ++q) {
        const int c = (q >> 1) * 512 + lane * 8 + (q & 1) * 4;
#pragma unroll
        for (int u = 0; u < 2; ++u) {
          const size_t t = t0 + u;
          const float rstd = rsqrtf(ss[u] * (1.f / 1024.f) + 1e-6f);
          *(f32x4*)(p.out + t * 1024 + c) = xv[u][q] * rstd * gn[q];
        }
      }
    }
  }
}


#define STAGE(call) { const Params p = mkctx(a); call; }

#define XB_TMO      128
#define XB_XCNT(j)  (256  + 64 * (j))
#define XB_XSUB(j)  (1280 + 64 * (j))
#define XB_XGEN(j)  (2304 + 64 * (j))
#define XB_TOP      3328
#define XB_TOPGEN   3392
#define XCD_BAR_WORDS 3456
#define XB_SPIN_CAP (1u << 20)
#define LAS __attribute__((address_space(3)))
DEVI unsigned xb_ld(unsigned* p)              { return __hip_atomic_load(p, __ATOMIC_RELAXED, __HIP_MEMORY_SCOPE_AGENT); }
DEVI unsigned xb_add(unsigned* p, unsigned v) { return __hip_atomic_fetch_add(p, v, __ATOMIC_RELAXED, __HIP_MEMORY_SCOPE_AGENT); }
DEVI unsigned xb_xcc_id() { return (unsigned)__builtin_amdgcn_s_getreg((3 << 11) | 20) & 0xFu; }
#define XB_SPIN(cond, bar) do { unsigned _sp = 0; while (cond) { __builtin_amdgcn_s_sleep(1); \
    if ((++_sp & 255u) == 0u) { if (xb_ld(&(bar)[XB_TMO])) break; if (_sp > XB_SPIN_CAP) { atomicAdd(&(bar)[XB_TMO], 1u); break; } } } } while (0)
struct XcdBarrier { unsigned* bar; unsigned x; volatile LAS unsigned* st; };
DEVI XcdBarrier xcd_barrier_post(unsigned* bar, volatile LAS unsigned* st) {
  XcdBarrier b; b.bar = bar; b.x = xb_xcc_id(); b.st = st;
  if (threadIdx.x == 0) (void)xb_add(&bar[XB_XCNT(b.x)], 1u);
  return b;
}
DEVI void xcd_barrier_complete(unsigned* bar, unsigned x, unsigned& nloc, unsigned& nx) {
  const unsigned G = gridDim.x * gridDim.y * gridDim.z;
  unsigned sum, cnt, mine, sp = 0u;
  for (;;) {
    sum = 0u; cnt = 0u; mine = 0u;
#pragma unroll
    for (unsigned j = 0; j < 16; ++j) { const unsigned c = xb_ld(&bar[XB_XCNT(j)]); sum += c; cnt += (c > 0u) ? 1u : 0u; mine = (j == x) ? c : mine; }
    if (sum == G) break;
    __builtin_amdgcn_s_sleep(1);
    if ((++sp & 255u) == 0u) { if (xb_ld(&bar[XB_TMO])) break; if (sp > XB_SPIN_CAP) { atomicAdd(&bar[XB_TMO], 1u); break; } }
  }
  nloc = mine > 0u ? mine : 1u; nx = cnt > 0u ? cnt : 1u;
}
DEVI void xcd_barrier(const XcdBarrier& b) {
  asm volatile("s_waitcnt vmcnt(0)" ::: "memory");
  __syncthreads();
  if (threadIdx.x == 0) {
    unsigned* bar = b.bar;
    __builtin_amdgcn_s_waitcnt(0);
    unsigned nloc = b.st[0], nx = b.st[1];
    if (nloc == 0u) { xcd_barrier_complete(bar, b.x, nloc, nx); b.st[0] = nloc; b.st[1] = nx; }
    const unsigned old = xb_add(&bar[XB_XSUB(b.x)], 1u);
    const unsigned gen = old / nloc;
    if (old + 1u == (gen + 1u) * nloc) {
      __builtin_amdgcn_fence(__ATOMIC_RELEASE, "agent");
      asm volatile("s_waitcnt vmcnt(0)" ::: "memory");
      const unsigned og = xb_add(&bar[XB_TOP], 1u);
      const unsigned tg = og / nx;
      if (og + 1u == (tg + 1u) * nx) xb_add(&bar[XB_TOPGEN], 1u);
      else XB_SPIN(xb_ld(&bar[XB_TOPGEN]) == tg, bar);
      __builtin_amdgcn_fence(__ATOMIC_ACQUIRE, "agent");
      xb_add(&bar[XB_XGEN(b.x)], 1u);
      asm volatile("s_waitcnt vmcnt(0)" ::: "memory");
    } else {
      XB_SPIN(xb_ld(&bar[XB_XGEN(b.x)]) == gen, bar);
      __builtin_amdgcn_fence(__ATOMIC_ACQUIRE, "agent");
      asm volatile("s_waitcnt vmcnt(0)" ::: "memory");
    }
  }
  __syncthreads();
}
#define GSYNC() { XcdBarrier xb_; xb_.bar = (unsigned*)(mkctx(a).ws + O_XBAR); xb_.x = xb_xcc_id(); xb_.st = (volatile LAS unsigned*)(smem + SMEM_BYTES - 32); xcd_barrier(xb_); }

__global__ void __launch_bounds__(256, 2) mega(KArgs a) {
  extern __shared__ __attribute__((aligned(16))) char smem[];
  cg::grid_group grid = cg::this_grid();
  const int vb = blockIdx.x, nvb = gridDim.x;
  volatile LAS unsigned* xst = (volatile LAS unsigned*)(smem + SMEM_BYTES - 32);
  if (threadIdx.x == 0) { xst[0] = 0u; xst[1] = 0u; }
  __syncthreads();
  (void)xcd_barrier_post((unsigned*)(a.ws + O_XBAR), xst);
  if (threadIdx.x == 0) {
    const float** tab = (const float**)(a.ws + O_TAB);
#pragma unroll
    for (int i = 0; i < 35; ++i) tab[i] = a.in[i];
  }
  __syncthreads();
  STAGE(st_rope_table(p, vb, nvb));
  STAGE(st_mod(p, vb, nvb, smem));
  STAGE(st_prep_w1(p, 0, vb, nvb, smem));
  if (a.ws == nullptr) grid.sync();
  GSYNC();
  for (int l = 0; l < 2; ++l) {
    if (l == 0) { STAGE(st_norm1(p, 0, vb, nvb)); GSYNC(); }
    {
      const int g = vb & 7;
      for (int i = vb >> 3; i < 363; i += nvb >> 3) {
        int mt, nt;
        if (i < 264) { mt = i >> 1; nt = g + 8 * (i & 1); }
        else { const int j = i - 264, pc = g + 8 * (j / 33); nt = 16 + (pc >> 2); mt = (pc & 3) * 33 + (j % 33); }
        const Params p = mkctx(a); inproj_item(p, mt * 22 + nt, smem);
      }
    }
    GSYNC();
    STAGE(st_tokprep(p, l, vb, nvb));
    GSYNC();
    {
      for (int item = vb; item < 132 * 7 + NGITEM; item += nvb) {
        const Params p = mkctx(a);
        if (item < 132 * 7) mla_up_tile(p, item / 7, item % 7, smem);
        else gdn_chunk_item(p, item - 132 * 7, smem);
      }
    }
    GSYNC();
    st_mixer_queue(a, l, smem);
    GSYNC();
    STAGE(st_mix_finish(p, l, vb, nvb));
    GSYNC();
    STAGE(st_outproj(p, l, vb, nvb, smem));
    GSYNC();
    STAGE(st_norm2_route(p, l, vb, nvb, smem));
    GSYNC();
    STAGE(st_moe1(p, l, vb, nvb, smem));
    GSYNC();
    STAGE(st_moe2(p, l, vb, nvb, smem));
    GSYNC();
    if (l == 0) STAGE(st_prep_w1(p, 1, vb, nvb, smem));
    STAGE(st_combine(p, l, vb, nvb));
    if (l == 0) GSYNC();
  }
}

extern "C" void kernel_launch(void* const* d_in, const int* in_sizes, int n_in, void* d_out, int out_size, void* d_ws, size_t ws_size,
                              hipStream_t stream) {
  static int grid_blocks = 0;
  if (!grid_blocks) {
    int dev = 0, cus = 0, per_cu = 0;
    (void)hipGetDevice(&dev);
    (void)hipDeviceGetAttribute(&cus, hipDeviceAttributeMultiprocessorCount, dev);
    (void)hipFuncSetAttribute((const void*)mega, hipFuncAttributeMaxDynamicSharedMemorySize, SMEM_BYTES);
    (void)hipOccupancyMaxActiveBlocksPerMultiprocessor(&per_cu, mega, 256, SMEM_BYTES);
    if (per_cu > 2) per_cu = 2;
    if (per_cu < 1) per_cu = 1;
    grid_blocks = cus * per_cu;
  }
  KArgs p{};
  for (int i = 0; i < 35; ++i) p.in[i] = (const float*)d_in[i];
  p.out = (float*)d_out; p.ws = (char*)d_ws;
  if (ws_size < WS_NEED) { fprintf(stderr, "workspace too small: %zu < %zu\n", ws_size, (size_t)WS_NEED); return; }
  (void)hipMemsetAsync((char*)d_ws + O_BAR, 0, 256 + 16384, stream);
  void* args[] = {&p};
  hipError_t e = hipLaunchCooperativeKernel((void*)mega, dim3(grid_blocks), dim3(256), args, SMEM_BYTES, stream);
  if (e != hipSuccess) fprintf(stderr, "cooperative launch failed: %s (grid %d)\n", hipGetErrorString(e), grid_blocks);
}
```

```cpp
#include <hip/hip_runtime.h>
#include <hip/hip_cooperative_groups.h>
#include <cstdio>
#include <cstdint>
namespace cg = cooperative_groups;

#define DEVI __device__ __forceinline__
typedef unsigned short u16;
using bf16x8 = __attribute__((ext_vector_type(8))) short;
using f32x4  = __attribute__((ext_vector_type(4))) float;
using f32x2  = __attribute__((ext_vector_type(2))) float;
using f32x16 = __attribute__((ext_vector_type(16))) float;
using u32x4 = __attribute__((ext_vector_type(4))) unsigned;
using u32x2 = __attribute__((ext_vector_type(2))) unsigned;
typedef __bf16 bf16x2_t __attribute__((ext_vector_type(2)));

constexpr int DM = 1024, SEQ = 8192, CTXL = 256, NKEY = SEQ + CTXL;
constexpr int TL = 2 * SEQ, TC = 2 * CTXL, T = TL + TC;
constexpr int INW = 2672;
constexpr int NIN = 2816;
constexpr int LDPP = 1408;
constexpr int PP_CQ = 0, PP_CKV = 192, PP_DQKV = 320, PP_DZ = 1088, PP_GATE = 1344;
constexpr int NE = 64, NSLOT = 6 * T;
constexpr int LDW = 1088;
constexpr int LDH = 1088;
constexpr int NCHUNK = T / 64;
constexpr int NGITEM = NCHUNK * 8;
constexpr float LOG2E = 1.4426950408889634f;

constexpr size_t al256(size_t x) { return (x + 255) & ~(size_t)255; }
constexpr size_t O_MOD   = 0;
constexpr size_t O_ROPE  = O_MOD + al256((size_t)2 * 3 * 6144 * 4);
constexpr size_t O_XA    = O_ROPE + (size_t)SEQ * 48 * 8;
constexpr size_t O_H     = O_XA + (size_t)T * DM * 4;
constexpr size_t O_WINT  = O_H + (size_t)T * LDH * 2;
constexpr size_t O_WOUTT = O_WINT + (size_t)NIN * LDW * 2;
constexpr size_t O_WUQT  = O_WOUTT + (size_t)1024 * LDW * 2;
constexpr size_t O_WUKVT = O_WUQT + (size_t)384 * 192 * 2;
constexpr size_t O_WGUT  = O_WUKVT + (size_t)512 * 128 * 2;
constexpr size_t O_WDT   = O_WGUT + (size_t)65 * 512 * LDW * 2;
constexpr size_t O_WTS   = O_WDT + (size_t)65 * 1024 * 256 * 2;
constexpr size_t O_CNT   = O_WTS + al256((size_t)NSLOT * 4);
constexpr size_t O_TAB   = O_CNT + 256;
constexpr size_t O_BAR   = O_TAB + 512;
constexpr size_t O_XBAR  = O_BAR + 256;
constexpr size_t O_LIST  = O_XBAR + 16384;
constexpr size_t O_R     = O_LIST + (size_t)NE * T * 4;
constexpr size_t O_Y     = O_R;
constexpr size_t O_PP    = O_Y + (size_t)T * DM * 2;
constexpr size_t O_QA    = O_PP + (size_t)T * LDPP * 2;
constexpr size_t O_KA    = O_QA + (size_t)2 * 4 * NKEY * 64 * 2;
constexpr size_t O_VTA   = O_KA + (size_t)2 * 2 * NKEY * 64 * 2;
constexpr size_t O_QB    = O_VTA + (size_t)2 * 2 * NKEY * 64 * 2;
constexpr size_t O_KB    = O_QB + (size_t)2 * 8 * NKEY * 32 * 2;
constexpr size_t O_VTB   = O_KB + (size_t)2 * 8 * NKEY * 32 * 2;
constexpr size_t O_QC    = O_VTB + (size_t)2 * 4 * NKEY * 64 * 2;
constexpr size_t O_KC    = O_QC + (size_t)2 * 4 * NKEY * 96 * 2;
constexpr size_t O_VTC   = O_KC + (size_t)2 * 4 * NKEY * 96 * 2;
constexpr size_t O_CQN   = O_VTC + (size_t)2 * 4 * NKEY * 64 * 2;
constexpr size_t O_CKVN  = O_CQN + (size_t)T * 192 * 2;
constexpr size_t O_OB    = O_CKVN + (size_t)T * 128 * 2;
constexpr size_t O_GQ    = O_OB + (size_t)T * 512 * 2;
constexpr size_t O_GK    = O_GQ + (size_t)T * 256 * 2;
constexpr size_t O_GV    = O_GK + (size_t)T * 256 * 2;
constexpr size_t O_GG    = O_GV + (size_t)T * 256 * 2;
constexpr size_t O_GBETA = O_GG + (size_t)2 * T * 4 * 4;
constexpr size_t O_GM    = O_GBETA + (size_t)2 * T * 4 * 4;
constexpr size_t O_GQP   = O_GM + (size_t)NGITEM * 4096 * 2;
constexpr size_t O_GN    = O_GQP + (size_t)NGITEM * 4096 * 2;
constexpr size_t O_GLO   = O_GN + (size_t)NGITEM * 4096 * 2;
constexpr size_t O_GO    = O_GLO + (size_t)NGITEM * 4096 * 2;
constexpr size_t O_MIX_END = O_GO + (size_t)2 * T * 256 * 4;
constexpr size_t O_HB    = O_R;
constexpr size_t O_SLOT  = O_HB + (size_t)7 * T * 256 * 2;
constexpr size_t O_MOE_END = O_SLOT + (size_t)7 * T * 1024 * 2;
constexpr size_t cmax(size_t a, size_t b) { return a > b ? a : b; }
constexpr size_t WS_NEED = cmax(O_MIX_END, O_MOE_END);
static_assert(WS_NEED < (size_t)556000000, "workspace too large");

struct KArgs {
  const float* in[35];
  float* out;
  char* ws;
};
typedef const __attribute__((address_space(1))) float gcfloat;
struct Params {
  char* ws;
  float* out;
  gcfloat* const* in;
  int tid;
};
#define pin(p, i) ((const float*)(p).in[i])
enum { I_X = 0, I_C, I_CTX, I_CCTX, I_WADA, I_BADA, I_N1G, I_N2G, I_WIN, I_WOUT, I_SINK, I_LQ1, I_LK1, I_LQ2, I_LK2,
       I_DNG, I_MQG, I_MKVG, I_WUQ, I_WUKV, I_CONVW, I_ALF, I_ALB, I_DTF, I_DTB, I_GNG, I_WR, I_RB, I_WG, I_WU, I_WD,
       I_SG, I_SU, I_SD, I_FNG };

DEVI u16 f2bf(float f) { unsigned u = __float_as_uint(f); u += 0x7fffu + ((u >> 16) & 1u); return (u16)(u >> 16); }
DEVI float bf2f(u16 h) { return __uint_as_float(((unsigned)h) << 16); }
DEVI float bflo(unsigned v) { return __uint_as_float(v << 16); }
DEVI float bfhi(unsigned v) { return __uint_as_float(v & 0xffff0000u); }
DEVI unsigned pack2(float a, float b) { f32x2 v = {a, b}; return __builtin_bit_cast(unsigned, __builtin_convertvector(v, bf16x2_t)); }
DEVI f32x4 fzero4() { float z = 0.f; asm volatile("" : "+v"(z)); return f32x4{z, z, z, z}; }
DEVI float wave_sum(float v) {
#pragma unroll
  for (int o = 32; o >= 1; o >>= 1) v += __shfl_xor(v, o);
  return v;
}
DEVI float half_sum(float v) {
#pragma unroll
  for (int o = 16; o >= 1; o >>= 1) v += __shfl_xor(v, o);
  return v;
}
DEVI float siluf(float x) { return x / (1.f + __expf(-x)); }
DEVI float sigmf(float x) { return 1.f / (1.f + __expf(-x)); }
DEVI int tok_mv(int t) { return t < TL ? (t >> 13) : 2; }
DEVI int tok_b(int t) { return t < TL ? (t >> 13) : ((t - TL) >> 8); }
DEVI int tok_row(int t) { return t < TL ? (t & (SEQ - 1)) : (SEQ + ((t - TL) & (CTXL - 1))); }
DEVI const float* modp(const Params& p, int l, int mv, int j) { return (const float*)(p.ws + O_MOD) + ((size_t)(l * 3 + mv) * 6 + j) * 1024; }

#define MFMA16(a, b, c) __builtin_amdgcn_mfma_f32_16x16x32_bf16((a), (b), (c), 0, 0, 0)
#define MFMA32(a, b, c) __builtin_amdgcn_mfma_f32_32x32x16_bf16((a), (b), (c), 0, 0, 0)

DEVI void st_copy_in(const Params& p, int vb, int nvb) {
  float4* xa = (float4*)(p.ws + O_XA);
  const float4* x = (const float4*)pin(p, I_X);
  const float4* cx = (const float4*)pin(p, I_CTX);
  const size_t n4 = (size_t)T * DM / 4, nl4 = (size_t)TL * DM / 4;
  for (size_t i = (size_t)vb * 256 + p.tid; i < n4; i += (size_t)nvb * 256) xa[i] = i < nl4 ? x[i] : cx[i - nl4];
}
DEVI void rope_cs(int i, int half, int s, float& c, float& sn) {
  const int quarter = half >> 1;
  const int ii = i < quarter ? i : i - quarter;
  const float pos = i < quarter ? (float)(s >> 6) : (float)(s & 63);
  const float inv = powf(10000.f, -(float)ii / (float)quarter);
  const float ang = pos * inv;
  c = cosf(ang); sn = sinf(ang);
}
DEVI void st_rope_table(const Params& p, int vb, int nvb) {
  f32x2* R = (f32x2*)(p.ws + O_ROPE);
  for (int e = vb * 256 + p.tid; e < SEQ * 48; e += nvb * 256) {
    const int s = e / 48, i = e % 48;
    float c, sn;
    if (i < 32) rope_cs(i, 32, s, c, sn); else rope_cs(i - 32, 16, s, c, sn);
    R[e] = f32x2{c, sn};
  }
}
DEVI void st_mod(const Params& p, int vb, int nvb, char* smem) {
  float* sv = (float*)smem;
  float* red = sv + 3 * 1024;
  for (int i = p.tid; i < 3 * 1024; i += 256) {
    int v = i >> 10, k = i & 1023;
    float c = v < 2 ? pin(p, I_C)[v * 1024 + k] : pin(p, I_CCTX)[k];
    sv[i] = siluf(c);
  }
  __syncthreads();
  const int cgp = p.tid & 7, kg = p.tid >> 3;
  for (int item = vb; item < 2 * 192; item += nvb) {
    const int l = item / 192, c0 = (item % 192) * 32;
    const float* w = pin(p, I_WADA) + (size_t)l * 1024 * 6144 + c0 + cgp * 4;
    f32x4 a0 = fzero4(), a1 = a0, a2 = a0;
#pragma unroll 8
    for (int kk = 0; kk < 32; ++kk) {
      const int k = kg * 32 + kk;
      const f32x4 wv = *(const f32x4*)(w + (size_t)k * 6144);
      a0 += sv[k] * wv; a1 += sv[1024 + k] * wv; a2 += sv[2048 + k] * wv;
    }
    float* rp = red + (kg * 8 + cgp) * 12;
    *(f32x4*)rp = a0; *(f32x4*)(rp + 4) = a1; *(f32x4*)(rp + 8) = a2;
    __syncthreads();
    if (p.tid < 96) {
      const int v = p.tid >> 5, c = p.tid & 31;
      float s = 0.f;
#pragma unroll 8
      for (int g = 0; g < 32; ++g) s += red[(g * 8 + (c >> 2)) * 12 + v * 4 + (c & 3)];
      ((float*)(p.ws + O_MOD))[(size_t)(l * 3 + v) * 6144 + c0 + c] = s + pin(p, I_BADA)[l * 6144 + c0 + c];
    }
    __syncthreads();
  }
}

template <class RowFn>
DEVI void tr_tile(int tid, const float* __restrict__ src, int N, u16* __restrict__ dst, int ldd, RowFn drow, int k0, int n0, float* tile) {
  {
    const int kq = tid >> 4, n4 = (tid & 15) * 4;
    f32x4 v[4];
#pragma unroll
    for (int r = 0; r < 4; ++r) {
      const int k = r * 16 + kq;
      v[r] = n0 + n4 < N ? *(const f32x4*)(src + (size_t)(k0 + k) * N + n0 + n4) : fzero4();
    }
#pragma unroll
    for (int r = 0; r < 4; ++r) {
      const int k = r * 16 + kq;
      tile[k * 65 + n4] = v[r][0]; tile[k * 65 + n4 + 1] = v[r][1]; tile[k * 65 + n4 + 2] = v[r][2]; tile[k * 65 + n4 + 3] = v[r][3];
    }
  }
  __syncthreads();
  {
    const int n = tid >> 2, kc = (tid & 3) * 16;
    const int dr = drow(n0 + n);
    if (dr >= 0) {
      u32x4 o0, o1;
#pragma unroll
      for (int e = 0; e < 4; ++e) {
        o0[e] = pack2(tile[(kc + 2 * e) * 65 + n], tile[(kc + 2 * e + 1) * 65 + n]);
        o1[e] = pack2(tile[(kc + 8 + 2 * e) * 65 + n], tile[(kc + 8 + 2 * e + 1) * 65 + n]);
      }
      u16* d = dst + (size_t)dr * ldd + k0 + kc;
      *(u32x4*)d = o0; *(u32x4*)(d + 8) = o1;
    }
  }
  __syncthreads();
}
DEVI int win_row(int n) {
  if (n < 1280) return n;
  if (n < 1600) return 1408 + (n - 1280);
  if (n < 1632) return 1280 + (n - 1600);
  if (n < INW) return 1408 + 320 + (n - 1632);
  return -1;
}
constexpr int TR_IN = 16 * 42, TR_OUT = 256, TR_UQ = 18, TR_UKV = 16, TR_E = 4096, TR_S = 64;
constexpr int TR_P1 = TR_IN + TR_OUT + TR_UQ + TR_UKV;
constexpr int TR_P2 = 3 * TR_E + 3 * TR_S;
DEVI void prep_w1_tile(const Params& p, int l, int it, float* tile) {
  if (it < TR_IN) { tr_tile(p.tid, pin(p, I_WIN) + (size_t)l * 1024 * INW, INW, (u16*)(p.ws + O_WINT), LDW, [](int n) { return win_row(n); }, (it / 42) * 64, (it % 42) * 64, tile); return; }
  it -= TR_IN;
  if (it < TR_OUT) { tr_tile(p.tid, pin(p, I_WOUT) + (size_t)l * 1024 * 1024, 1024, (u16*)(p.ws + O_WOUTT), LDW, [](int n) { return n; }, (it / 16) * 64, (it % 16) * 64, tile); return; }
  it -= TR_OUT;
  if (it < TR_UQ) { tr_tile(p.tid, pin(p, I_WUQ) + (size_t)l * 192 * 384, 384, (u16*)(p.ws + O_WUQT), 192, [](int n) { return n; }, (it / 6) * 64, (it % 6) * 64, tile); return; }
  it -= TR_UQ;
  tr_tile(p.tid, pin(p, I_WUKV) + (size_t)l * 128 * 512, 512, (u16*)(p.ws + O_WUKVT), 128,
          [](int n) { const int h = n >> 7, j = n & 127; return j < 64 ? h * 64 + j : 256 + h * 64 + (j - 64); }, (it / 8) * 64, (it % 8) * 64, tile);
}
DEVI void prep_w2_tile(const Params& p, int l, int it, float* tile) {
  if (it < 2 * TR_E) {
    const int which = it / TR_E; it %= TR_E;
    const int e = it >> 6, tt = it & 63;
    const float* src = pin(p, which ? I_WU : I_WG) + ((size_t)l * NE + e) * 1024 * 256;
    tr_tile(p.tid, src, 256, (u16*)(p.ws + O_WGUT) + (size_t)e * 512 * LDW, LDW, [which](int n) { return 2 * n + which; }, (tt >> 2) * 64, (tt & 3) * 64, tile); return;
  }
  it -= 2 * TR_E;
  if (it < TR_E) {
    const int e = it >> 6, tt = it & 63;
    const float* src = pin(p, I_WD) + ((size_t)l * NE + e) * 256 * 1024;
    tr_tile(p.tid, src, 1024, (u16*)(p.ws + O_WDT) + (size_t)e * 1024 * 256, 256, [](int n) { return n; }, (tt >> 4) * 64, (tt & 15) * 64, tile); return;
  }
  it -= TR_E;
  if (it < 2 * TR_S) {
    const int which = it / TR_S; const int tt = it % TR_S;
    const float* src = pin(p, which ? I_SU : I_SG) + (size_t)l * 1024 * 256;
    tr_tile(p.tid, src, 256, (u16*)(p.ws + O_WGUT) + (size_t)64 * 512 * LDW, LDW, [which](int n) { return 2 * n + which; }, (tt >> 2) * 64, (tt & 3) * 64, tile); return;
  }
  it -= 2 * TR_S;
  { const int tt = it;
    const float* src = pin(p, I_SD) + (size_t)l * 256 * 1024;
    tr_tile(p.tid, src, 1024, (u16*)(p.ws + O_WDT) + (size_t)64 * 1024 * 256, 256, [](int n) { return n; }, (tt >> 4) * 64, (tt & 15) * 64, tile); }
}
struct TrDesc { const float* src; u16* dst; int N, ldd, rs, ro, k0, n0; };
DEVI TrDesc w2_desc(const Params& p, int l, int it) {
  TrDesc d;
  if (it < 2 * TR_E) {
    const int which = it / TR_E; it %= TR_E;
    const int e = it >> 6, tt = it & 63;
    d.src = pin(p, which ? I_WU : I_WG) + ((size_t)l * NE + e) * 1024 * 256; d.N = 256;
    d.dst = (u16*)(p.ws + O_WGUT) + (size_t)e * 512 * LDW; d.ldd = LDW; d.rs = 2; d.ro = which; d.k0 = (tt >> 2) * 64; d.n0 = (tt & 3) * 64;
    return d;
  }
  it -= 2 * TR_E;
  if (it < TR_E) {
    const int e = it >> 6, tt = it & 63;
    d.src = pin(p, I_WD) + ((size_t)l * NE + e) * 256 * 1024; d.N = 1024;
    d.dst = (u16*)(p.ws + O_WDT) + (size_t)e * 1024 * 256; d.ldd = 256; d.rs = 1; d.ro = 0; d.k0 = (tt >> 4) * 64; d.n0 = (tt & 15) * 64;
    return d;
  }
  it -= TR_E;
  if (it < 2 * TR_S) {
    const int which = it / TR_S; const int tt = it % TR_S;
    d.src = pin(p, which ? I_SU : I_SG) + (size_t)l * 1024 * 256; d.N = 256;
    d.dst = (u16*)(p.ws + O_WGUT) + (size_t)64 * 512 * LDW; d.ldd = LDW; d.rs = 2; d.ro = which; d.k0 = (tt >> 2) * 64; d.n0 = (tt & 3) * 64;
    return d;
  }
  it -= 2 * TR_S;
  d.src = pin(p, I_SD) + (size_t)l * 256 * 1024; d.N = 1024;
  d.dst = (u16*)(p.ws + O_WDT) + (size_t)64 * 1024 * 256; d.ldd = 256; d.rs = 1; d.ro = 0; d.k0 = (it >> 4) * 64; d.n0 = (it & 15) * 64;
  return d;
}
DEVI void tr_load(int tid, const TrDesc& d, f32x4 (&v)[4]) {
  const int kq = tid >> 4, n4 = (tid & 15) * 4;
#pragma unroll
  for (int r = 0; r < 4; ++r) v[r] = *(const f32x4*)(d.src + (size_t)(d.k0 + r * 16 + kq) * d.N + d.n0 + n4);
}
DEVI void tr_process(int tid, const TrDesc& d, const f32x4 (&v)[4], float* tile) {
  {
    const int kq = tid >> 4, n4 = (tid & 15) * 4;
#pragma unroll
    for (int r = 0; r < 4; ++r) {
      const int k = r * 16 + kq;
      tile[k * 65 + n4] = v[r][0]; tile[k * 65 + n4 + 1] = v[r][1]; tile[k * 65 + n4 + 2] = v[r][2]; tile[k * 65 + n4 + 3] = v[r][3];
    }
  }
  __syncthreads();
  {
    const int n = tid >> 2, kc = (tid & 3) * 16;
    u32x4 o0, o1;
#pragma unroll
    for (int e = 0; e < 4; ++e) {
      o0[e] = pack2(tile[(kc + 2 * e) * 65 + n], tile[(kc + 2 * e + 1) * 65 + n]);
      o1[e] = pack2(tile[(kc + 8 + 2 * e) * 65 + n], tile[(kc + 8 + 2 * e + 1) * 65 + n]);
    }
    u16* o = d.dst + (size_t)((d.n0 + n) * d.rs + d.ro) * d.ldd + d.k0 + kc;
    *(u32x4*)o = o0; *(u32x4*)(o + 8) = o1;
  }
  __syncthreads();
}
DEVI void prep_w2_run8(const Params& p, int l, int it0, float* tile) {
  f32x4 va[4], vb4[4];
  TrDesc da = w2_desc(p, l, it0), db = da;
  __syncthreads();
  tr_load(p.tid, da, va);
#pragma unroll 1
  for (int k = 0; k < 8; k += 2) {
    db = w2_desc(p, l, it0 + k + 1);
    tr_load(p.tid, db, vb4);
    tr_process(p.tid, da, va, tile);
    if (k + 2 < 8) { da = w2_desc(p, l, it0 + k + 2); tr_load(p.tid, da, va); }
    tr_process(p.tid, db, vb4, tile);
  }
}
DEVI void st_prep_w1(const Params& p, int l, int vb, int nvb, char* smem) {
  float* tile = (float*)smem;
  if (vb == 0 && p.tid < 64) ((int*)(p.ws + O_CNT))[p.tid] = 0;
  for (int e = vb * 256 + p.tid; e < 144 * 128; e += nvb * 256) {
    const int r = e >> 7, c8 = e & 127;
    const int row = r < 96 ? 1312 + r : 2768 + (r - 96);
    *(u32x4*)((u16*)(p.ws + O_WINT) + (size_t)row * LDW + c8 * 8) = __builtin_bit_cast(u32x4, fzero4());
  }
  for (int item = vb; item < TR_P1; item += nvb) prep_w1_tile(p, l, item, tile);
}

DEVI void st_norm1(const Params& p, int l, int vb, int nvb) {
  const int lane = p.tid & 63, wid = p.tid >> 6;
  const float* g = pin(p, I_N1G) + l * 1024;
  for (int t4 = (vb * 4 + wid) * 4; t4 < T; t4 += nvb * 16) {
    const int mv = tok_mv(t4);
    const float* sh = modp(p, l, mv, 0); const float* sc = modp(p, l, mv, 1);
    f32x4 v[4][4]; float ss[4];
#pragma unroll
    for (int u = 0; u < 4; ++u) {
      const int t = t4 + u;
      const f32x4* xr = (const f32x4*)(t < TL ? pin(p, I_X) + (size_t)t * 1024 : pin(p, I_CTX) + (size_t)(t - TL) * 1024);
#pragma unroll
      for (int i = 0; i < 4; ++i) v[u][i] = xr[i * 64 + lane];
    }
#pragma unroll
    for (int u = 0; u < 4; ++u) {
      float a = 0.f;
#pragma unroll
      for (int i = 0; i < 4; ++i) a += v[u][i][0] * v[u][i][0] + v[u][i][1] * v[u][i][1] + v[u][i][2] * v[u][i][2] + v[u][i][3] * v[u][i][3];
      ss[u] = a;
    }
#pragma unroll
    for (int o = 32; o >= 1; o >>= 1) {
#pragma unroll
      for (int u = 0; u < 4; ++u) ss[u] += __shfl_xor(ss[u], o);
    }
#pragma unroll
    for (int i = 0; i < 4; ++i) {
      const int c = i * 256 + lane * 4;
      const f32x4 gg = *(const f32x4*)(g + c), s4 = *(const f32x4*)(sc + c), h4 = *(const f32x4*)(sh + c);
      const f32x4 gs = gg * (1.f + s4);
#pragma unroll
      for (int u = 0; u < 4; ++u) {
        const float rstd = rsqrtf(ss[u] * (1.f / 1024.f) + 1e-6f);
        const f32x4 o = v[u][i] * rstd * gs + h4;
        u32x2 pk; pk[0] = pack2(o[0], o[1]); pk[1] = pack2(o[2], o[3]);
        *(u32x2*)((u16*)(p.ws + O_H) + (size_t)(t4 + u) * LDH + c) = pk;
      }
    }
  }
}

constexpr int GLD = 72;
typedef const __attribute__((address_space(1))) unsigned gcu32;
typedef __attribute__((address_space(3))) unsigned lu32;
template <bool SWAP, class ARow>
DEVI void gemm_core(int tid, ARow arow, const u16* __restrict__ Bt, int ldb, int K, f32x4 (&acc)[4][4], char* smem) {
  constexpr int TILE = 128 * 64;
  u16* sbuf = (u16*)smem;
  const int lane = tid & 63, wid = tid >> 6, wr = wid >> 1, wc = wid & 1, fr = lane & 15, fq = lane >> 4;
  const u16* ap[4]; const u16* bp[4];
#pragma unroll
  for (int i = 0; i < 4; ++i) {
    const int q = tid + 256 * i, row = q >> 3, cs = (q & 7) ^ (row & 7);
    ap[i] = arow(row) + cs * 8; bp[i] = Bt + (size_t)row * ldb + cs * 8;
  }
  const int nk = K >> 6;
  auto stage = [&](int kt, int buf) {
    int off = kt * 64; asm volatile("" : "+s"(off));
    u16* dA = sbuf + buf * 2 * TILE + tid * 8; u16* dB = dA + TILE;
#pragma unroll
    for (int i = 0; i < 4; ++i) {
      __builtin_amdgcn_global_load_lds((gcu32*)(ap[i] + off), (lu32*)(dA + i * 2048), 16, 0, 0);
      __builtin_amdgcn_global_load_lds((gcu32*)(bp[i] + off), (lu32*)(dB + i * 2048), 16, 0, 0);
    }
  };
  auto compute = [&](int buf) {
    const u16* sA = sbuf + buf * 2 * TILE; const u16* sB = sA + TILE;
#pragma unroll
    for (int ks = 0; ks < 2; ++ks) {
      bf16x8 af[4], bfr[4];
#pragma unroll
      for (int m = 0; m < 4; ++m) { const int R = wr * 64 + m * 16 + fr; af[m] = *(const bf16x8*)&sA[R * 64 + (((ks * 4 + fq) ^ (R & 7)) << 3)]; }
#pragma unroll
      for (int n = 0; n < 4; ++n) { const int R = wc * 64 + n * 16 + fr; bfr[n] = *(const bf16x8*)&sB[R * 64 + (((ks * 4 + fq) ^ (R & 7)) << 3)]; }
#pragma unroll
      for (int m = 0; m < 4; ++m)
#pragma unroll
        for (int n = 0; n < 4; ++n) acc[m][n] = SWAP ? MFMA16(af[m], bfr[n], acc[m][n]) : MFMA16(bfr[n], af[m], acc[m][n]);
    }
  };
#pragma unroll
  for (int m = 0; m < 4; ++m)
#pragma unroll
    for (int n = 0; n < 4; ++n) acc[m][n] = fzero4();
  __syncthreads();
  stage(0, 0);
  asm volatile("s_waitcnt vmcnt(0)" ::: "memory");
  __syncthreads();
  for (int kt = 0; kt < nk; ++kt) {
    if (kt + 1 < nk) stage(kt + 1, (kt + 1) & 1);
    compute(kt & 1);
    asm volatile("s_waitcnt vmcnt(0)" ::: "memory");
    __syncthreads();
  }
}
template <class ARow, class Epi>
DEVI void gemm128(int tid, ARow arow, const u16* __restrict__ Bt, int ldb, int K, Epi epi, char* smem) {
  f32x4 acc[4][4];
  gemm_core<false>(tid, arow, Bt, ldb, K, acc, smem);
  const int lane = tid & 63, wid = tid >> 6, wr = wid >> 1, wc = wid & 1, fr = lane & 15, fq = lane >> 4;
#pragma unroll
  for (int m = 0; m < 4; ++m)
#pragma unroll
    for (int n = 0; n < 4; ++n) epi(wr * 64 + m * 16 + fr, wc * 64 + n * 16 + fq * 4, acc[m][n]);
}

DEVI void rope4(const f32x4 x1, const f32x4 x2, const f32x2* rp, bool lat, float scale, u32x2& o1, u32x2& o2) {
  f32x4 s = fzero4(), c = s + 1.f;
  if (lat) {
    const f32x4 a = *(const f32x4*)rp, b = *(const f32x4*)(rp + 2);
    c = f32x4{a[0], a[2], b[0], b[2]}; s = f32x4{a[1], a[3], b[1], b[3]};
  }
  const f32x4 y1 = (x1 * c - x2 * s) * scale, y2 = (x2 * c + x1 * s) * scale;
  o1[0] = pack2(y1[0], y1[1]); o1[1] = pack2(y1[2], y1[3]);
  o2[0] = pack2(y2[0], y2[1]); o2[1] = pack2(y2[2], y2[3]);
}
DEVI void inproj_item(const Params& p, int item, char* smem) {
  const u16* H = (const u16*)(p.ws + O_H); const u16* W = (const u16*)(p.ws + O_WINT);
  const f32x2* ROPE = (const f32x2*)(p.ws + O_ROPE);
  const int tid = p.tid, lane = tid & 63, wid = tid >> 6, wr = wid >> 1, wc = wid & 1, fr = lane & 15, fq = lane >> 4;
  {
    const int m0 = (item / 22) * 128, nt = item % 22;
    const bool lat = m0 < TL;
    const int b = tok_b(m0), rowbase = tok_row(m0);
    f32x4 acc[4][4];
    auto arow = [&](int r) { return H + (size_t)(m0 + r) * LDH; };
    if (nt == 3 || nt == 8 || nt == 9) {
      gemm_core<true>(tid, arow, W + (size_t)nt * 128 * LDW, LDW, 1024, acc, smem);
      u16* vt = nt == 3 ? (u16*)(p.ws + O_VTA) + (size_t)(b * 2 + wc) * 64 * NKEY
                        : (u16*)(p.ws + O_VTB) + (size_t)(b * 4 + (nt - 8) * 2 + wc) * 64 * NKEY;
#pragma unroll
      for (int m = 0; m < 4; ++m)
#pragma unroll
        for (int n = 0; n < 4; ++n) {
          u32x2 pk; pk[0] = pack2(acc[m][n][0], acc[m][n][1]); pk[1] = pack2(acc[m][n][2], acc[m][n][3]);
          *(u32x2*)(vt + (size_t)(n * 16 + fr) * NKEY + rowbase + wr * 64 + m * 16 + (((fq & 1) << 1) | (fq >> 1)) * 4) = pk;
        }
      return;
    }
    gemm_core<false>(tid, arow, W + (size_t)nt * 128 * LDW, LDW, 1024, acc, smem);
    if (nt < 3) {
      u16* dst; float scale;
      if (nt < 2) { dst = (u16*)(p.ws + O_QA) + ((size_t)(b * 4 + nt * 2 + wc) * NKEY + rowbase) * 64; scale = 0.125f * LOG2E; }
      else { dst = (u16*)(p.ws + O_KA) + ((size_t)(b * 2 + wc) * NKEY + rowbase) * 64; scale = 1.f; }
#pragma unroll
      for (int m = 0; m < 4; ++m) {
        const int rl = wr * 64 + m * 16 + fr;
#pragma unroll
        for (int pi = 0; pi < 2; ++pi) {
          const int d0 = pi * 16 + fq * 4;
          u32x2 o1, o2;
          rope4(acc[m][pi], acc[m][pi + 2], ROPE + (size_t)(rowbase + rl) * 48 + d0, lat, scale, o1, o2);
          *(u32x2*)(dst + (size_t)rl * 64 + d0) = o1; *(u32x2*)(dst + (size_t)rl * 64 + 32 + d0) = o2;
        }
      }
    } else if (nt < 8) {
      const bool isq = nt < 6;
      u16* base = isq ? (u16*)(p.ws + O_QB) : (u16*)(p.ws + O_KB);
      const float scale = isq ? 0.17677669529663687f * LOG2E : 1.f;
      const int hm0 = ((nt - 4) & 1) * 4 + wc * 2;
#pragma unroll
      for (int m = 0; m < 4; ++m) {
        const int rl = wr * 64 + m * 16 + fr;
#pragma unroll
        for (int g = 0; g < 2; ++g) {
          u16* dst = base + ((size_t)(b * 8 + hm0 + g) * NKEY + rowbase + rl) * 32;
          u32x2 o1, o2;
          rope4(acc[m][2 * g], acc[m][2 * g + 1], ROPE + (size_t)(rowbase + rl) * 48 + 32 + fq * 4, lat, scale, o1, o2);
          *(u32x2*)(dst + fq * 4) = o1; *(u32x2*)(dst + 16 + fq * 4) = o2;
        }
      }
    } else if (nt == 10) {
      if (wc == 0) {
#pragma unroll
        for (int m = 0; m < 4; ++m) {
          const int rl = wr * 64 + m * 16 + fr;
          u32x2 o1, o2;
          rope4(acc[m][0], acc[m][1], ROPE + (size_t)(rowbase + rl) * 48 + 32 + fq * 4, lat, 1.f, o1, o2);
#pragma unroll
          for (int h = 0; h < 4; ++h) {
            u16* dst = (u16*)(p.ws + O_KC) + ((size_t)(b * 4 + h) * NKEY + rowbase + rl) * 96 + 64;
            *(u32x2*)(dst + fq * 4) = o1; *(u32x2*)(dst + 16 + fq * 4) = o2;
          }
        }
      }
    } else {
      u16* PP = (u16*)(p.ws + O_PP);
#pragma unroll
      for (int m = 0; m < 4; ++m)
#pragma unroll
        for (int n = 0; n < 4; ++n) {
          u32x2 pk; pk[0] = pack2(acc[m][n][0], acc[m][n][1]); pk[1] = pack2(acc[m][n][2], acc[m][n][3]);
          *(u32x2*)(PP + (size_t)(m0 + wr * 64 + m * 16 + fr) * LDPP + (nt - 11) * 128 + wc * 64 + n * 16 + fq * 4) = pk;
        }
    }
  }
}

DEVI void st_tokprep(const Params& p, int l, int vb, int nvb) {
  const int lane = p.tid & 63, wid = p.tid >> 6;
  const u16* PP = (const u16*)(p.ws + O_PP);
  u16* GQ = (u16*)(p.ws + O_GQ); u16* GK = (u16*)(p.ws + O_GK); u16* GV = (u16*)(p.ws + O_GV);
  float* GG = (float*)(p.ws + O_GG); float* GB = (float*)(p.ws + O_GBETA);
  u16* CQN = (u16*)(p.ws + O_CQN); u16* CKVN = (u16*)(p.ws + O_CKVN);
  const float* cwp = pin(p, I_CONVW) + (size_t)l * 5 * 768;
  f32x2 cw[6][5];
#pragma unroll
  for (int i = 0; i < 6; ++i)
#pragma unroll
    for (int j = 0; j < 5; ++j) cw[i][j] = *(const f32x2*)(cwp + j * 768 + 2 * lane + 128 * i);
  const float* gq = pin(p, I_MQG) + l * 192; const float* gkv = pin(p, I_MKVG) + l * 128;
  const float gq0 = gq[lane], gq1 = gq[64 + lane], gq2 = gq[128 + lane], gk0 = gkv[lane], gk1 = gkv[64 + lane];
  for (int t = vb * 4 + wid; t < T; t += nvb * 4) {
    int base, pos, len;
    if (t < TL) { base = t & ~(SEQ - 1); pos = t & (SEQ - 1); len = SEQ; } else { int j = t - TL; base = TL + (j & ~(CTXL - 1)); pos = j & (CTXL - 1); len = CTXL; }
    unsigned xin[5][6];
#pragma unroll
    for (int j = 0; j < 5; ++j) {
      const int pp = pos + j - 2;
      const bool ok = pp >= 0 && pp < len;
      const u16* row = PP + (size_t)(base + (ok ? pp : pos)) * LDPP + PP_DQKV + 2 * lane;
#pragma unroll
      for (int i = 0; i < 6; ++i) { unsigned v = *(const unsigned*)(row + 128 * i); xin[j][i] = ok ? v : 0u; }
    }
    const u16* pr = PP + (size_t)t * LDPP;
    const float q0 = bf2f(pr[PP_CQ + lane]), q1 = bf2f(pr[PP_CQ + 64 + lane]), q2 = bf2f(pr[PP_CQ + 128 + lane]);
    const float k0 = bf2f(pr[PP_CKV + lane]), k1 = bf2f(pr[PP_CKV + 64 + lane]);
    const float gate_in = lane < 16 ? bf2f(pr[PP_GATE + lane]) : 0.f;
#pragma unroll
    for (int i = 0; i < 6; ++i) {
      float a0 = 0.f, a1 = 0.f;
#pragma unroll
      for (int j = 0; j < 5; ++j) { a0 += cw[i][j][0] * bflo(xin[j][i]); a1 += cw[i][j][1] * bfhi(xin[j][i]); }
      float y0 = siluf(a0), y1 = siluf(a1);
      const int c = 2 * lane + 128 * i;
      if (i < 4) {
        const float ss = half_sum(y0 * y0 + y1 * y1);
        const float r = rsqrtf(ss + 1e-6f) * (i < 2 ? 0.125f : 1.f);
        u16* dst = i < 2 ? GQ + (size_t)t * 256 + c : GK + (size_t)t * 256 + (c - 256);
        *(unsigned*)dst = pack2(y0 * r, y1 * r);
      } else *(unsigned*)(GV + (size_t)t * 256 + (c - 512)) = pack2(y0, y1);
    }
    if (lane < 16) {
      const int which = lane >> 2, hd = lane & 3;
      if (which < 2) {
        const float al = which ? pin(p, I_ALB)[l * 4 + hd] : pin(p, I_ALF)[l * 4 + hd];
        const float dt = which ? pin(p, I_DTB)[l * 4 + hd] : pin(p, I_DTF)[l * 4 + hd];
        const float xx = gate_in + dt;
        const float sp = fmaxf(xx, 0.f) + log1pf(expf(-fabsf(xx)));
        GG[((size_t)which * T + t) * 4 + hd] = -expf(al) * sp;
      } else GB[((size_t)(which - 2) * T + t) * 4 + hd] = sigmf(gate_in);
    }
    {
      float ss = q0 * q0 + q1 * q1 + q2 * q2, s2 = k0 * k0 + k1 * k1;
#pragma unroll
      for (int o = 32; o >= 1; o >>= 1) { ss += __shfl_xor(ss, o); s2 += __shfl_xor(s2, o); }
      const float rs = rsqrtf(ss * (1.f / 192.f) + 1e-6f), r2 = rsqrtf(s2 * (1.f / 128.f) + 1e-6f);
      u16* d = CQN + (size_t)t * 192;
      d[lane] = f2bf(q0 * rs * gq0); d[64 + lane] = f2bf(q1 * rs * gq1); d[128 + lane] = f2bf(q2 * rs * gq2);
      u16* d2 = CKVN + (size_t)t * 128;
      d2[lane] = f2bf(k0 * r2 * gk0); d2[64 + lane] = f2bf(k1 * r2 * gk1);
    }
  }
}

DEVI void mla_up_tile(const Params& p, int mt, int nn, char* smem) {
  const int tid = p.tid, lane = tid & 63, wid = tid >> 6, wr = wid >> 1, wc = wid & 1, fr = lane & 15, fq = lane >> 4;
  const int m0 = mt * 128;
  const bool lat = m0 < TL;
  const int b = tok_b(m0), rowbase = tok_row(m0);
  f32x4 acc[4][4];
  if (nn < 3) {
    const u16* CQN = (const u16*)(p.ws + O_CQN);
    gemm_core<false>(tid, [&](int r) { return CQN + (size_t)(m0 + r) * 192; }, (const u16*)(p.ws + O_WUQT) + (size_t)nn * 128 * 192, 192, 192, acc, smem);
    const f32x2* ROPE = (const f32x2*)(p.ws + O_ROPE);
    const float scale = 0.10206207261596577f * LOG2E;
    u16* QC = (u16*)(p.ws + O_QC);
#pragma unroll
    for (int m = 0; m < 4; ++m) {
      const int rl = wr * 64 + m * 16 + fr;
#pragma unroll
      for (int n = 0; n < 4; ++n) {
        const int cb = nn * 128 + wc * 64 + n * 16;
        const int h = cb / 96, db = cb - h * 96;
        u16* dst = QC + ((size_t)(b * 4 + h) * NKEY + rowbase + rl) * 96;
        if (db < 64) {
          u32x2 pk; pk[0] = pack2(acc[m][n][0] * scale, acc[m][n][1] * scale); pk[1] = pack2(acc[m][n][2] * scale, acc[m][n][3] * scale);
          *(u32x2*)(dst + db + fq * 4) = pk;
        } else if (db == 64 && n < 3) {
          u32x2 o1, o2;
          rope4(acc[m][n], acc[m][n + 1], ROPE + (size_t)(rowbase + rl) * 48 + 32 + fq * 4, lat, scale, o1, o2);
          *(u32x2*)(dst + 64 + fq * 4) = o1; *(u32x2*)(dst + 80 + fq * 4) = o2;
        }
      }
    }
  } else {
    const u16* CKVN = (const u16*)(p.ws + O_CKVN);
    auto arow = [&](int r) { return CKVN + (size_t)(m0 + r) * 128; };
    const u16* Wt = (const u16*)(p.ws + O_WUKVT) + (size_t)(nn - 3) * 128 * 128;
    if (nn < 5) {
      gemm_core<false>(tid, arow, Wt, 128, 128, acc, smem);
      u16* KC = (u16*)(p.ws + O_KC) + ((size_t)(b * 4 + (nn - 3) * 2 + wc) * NKEY + rowbase) * 96;
#pragma unroll
      for (int m = 0; m < 4; ++m)
#pragma unroll
        for (int n = 0; n < 4; ++n) {
          u32x2 pk; pk[0] = pack2(acc[m][n][0], acc[m][n][1]); pk[1] = pack2(acc[m][n][2], acc[m][n][3]);
          *(u32x2*)(KC + (size_t)(wr * 64 + m * 16 + fr) * 96 + n * 16 + fq * 4) = pk;
        }
    } else {
      gemm_core<true>(tid, arow, Wt, 128, 128, acc, smem);
      u16* vt = (u16*)(p.ws + O_VTC) + (size_t)(b * 4 + (nn - 5) * 2 + wc) * 64 * NKEY;
#pragma unroll
      for (int m = 0; m < 4; ++m)
#pragma unroll
        for (int n = 0; n < 4; ++n) {
          u32x2 pk; pk[0] = pack2(acc[m][n][0], acc[m][n][1]); pk[1] = pack2(acc[m][n][2], acc[m][n][3]);
          *(u32x2*)(vt + (size_t)(n * 16 + fr) * NKEY + rowbase + wr * 64 + m * 16 + (((fq & 1) << 1) | (fq >> 1)) * 4) = pk;
        }
    }
  }
}
DEVI int permcol(int x) { return (x & 32) + 8 * ((x >> 2) & 3) + 4 * ((x >> 4) & 1) + (x & 3); }
DEVI int cidx(int d, int e) { return ((((e >> 4) * 4 + (d >> 4)) * 64) + (e & 15) + 16 * ((d >> 2) & 3)) * 4 + (d & 3); }
DEVI int gdn_chunk_t0(int ci) { return ci < 256 ? (ci >> 7) * SEQ + (ci & 127) * 64 : TL + ((ci - 256) >> 2) * CTXL + ((ci - 256) & 3) * 64; }

DEVI void gdn_chunk_item(const Params& p, int item, char* smem) {
  u16* sK = (u16*)smem;
  float* sA = (float*)(smem + 9216);
  u16* sXt = (u16*)smem;
  u16* sAt = (u16*)(smem + 26624);
  u16* sKt = (u16*)(smem + 35840);
  float* sX = (float*)(smem + 45056);
  float* sgc = (float*)(smem + 77824); float* sbeta = sgc + 64; float* seg = sbeta + 64; float* skd = seg + 64;
  const u16* GQ = (const u16*)(p.ws + O_GQ); const u16* GK = (const u16*)(p.ws + O_GK); const u16* GV = (const u16*)(p.ws + O_GV);
  const float* GG = (const float*)(p.ws + O_GG); const float* GB = (const float*)(p.ws + O_GBETA);
  u16* GM = (u16*)(p.ws + O_GM); u16* GQP = (u16*)(p.ws + O_GQP); u16* GN = (u16*)(p.ws + O_GN); u16* GLO = (u16*)(p.ws + O_GLO);
  const int tid = p.tid, lane = tid & 63, w = tid >> 6, i15 = lane & 15, q = lane >> 4;
  {
    const int ci = item >> 3, hd = (item >> 1) & 3, dir = item & 1;
    const int t0 = gdn_chunk_t0(ci);
    auto tok = [&](int i) { return dir ? t0 + 63 - i : t0 + i; };
    __syncthreads();
    if (tid < 64) {
      float g = GG[((size_t)dir * T + tok(tid)) * 4 + hd];
#pragma unroll
      for (int o = 1; o < 64; o <<= 1) { float u = __shfl_up(g, o); if (lane >= o) g += u; }
      const float gl = __shfl(g, 63);
      sgc[tid] = g; sbeta[tid] = GB[((size_t)dir * T + tok(tid)) * 4 + hd]; seg[tid] = expf(g); skd[tid] = expf(gl - g);
    }
    __syncthreads();
    const float eglast = seg[63];
#pragma unroll
    for (int i = 0; i < 2; ++i) {
      const int ch = tid + 256 * i, j = ch >> 3, cc = ch & 7;
      const u32x4 kv = *(const u32x4*)(GK + (size_t)tok(j) * 256 + hd * 64 + cc * 8);
      *(u32x4*)&sK[j * 72 + cc * 8] = kv;
      const float kd = skd[j];
#pragma unroll
      for (int e = 0; e < 4; ++e) {
        sKt[(cc * 8 + 2 * e) * 72 + j] = f2bf(bf2f((u16)(kv[e] & 0xffff)) * kd);
        sKt[(cc * 8 + 2 * e + 1) * 72 + j] = f2bf(bf2f((u16)(kv[e] >> 16)) * kd);
      }
    }
#pragma unroll
    for (int i = 0; i < 2; ++i) {
      const int ch = tid + 256 * i, j = ch >> 3, cc = ch & 7;
      const u32x4 vv = *(const u32x4*)(GV + (size_t)tok(j) * 256 + hd * 64 + cc * 8);
      const float bj = sbeta[j];
      float* d = sX + j * 128 + cc * 8;
#pragma unroll
      for (int e = 0; e < 4; ++e) { d[2 * e] = bflo(vv[e]) * bj; d[2 * e + 1] = bfhi(vv[e]) * bj; }
    }
    __syncthreads();
    for (int e = tid; e < 64 * 64; e += 256) {
      const int j = e >> 6, c = e & 63;
      sX[j * 128 + 64 + c] = bf2f(sK[j * 72 + c]) * sbeta[j] * seg[j];
    }
    {
      f32x4 kk[4], qk[4];
#pragma unroll
      for (int nt = 0; nt < 4; ++nt) { kk[nt] = fzero4(); qk[nt] = fzero4(); }
#pragma unroll
      for (int ks = 0; ks < 2; ++ks) {
        const bf16x8 ak = *(const bf16x8*)&sK[(16 * w + i15) * 72 + ks * 32 + q * 8];
        const bf16x8 aq = *(const bf16x8*)(GQ + (size_t)tok(16 * w + i15) * 256 + hd * 64 + ks * 32 + q * 8);
#pragma unroll
        for (int nt = 0; nt < 4; ++nt) {
          const bf16x8 bk = *(const bf16x8*)&sK[(16 * nt + i15) * 72 + ks * 32 + q * 8];
          kk[nt] = MFMA16(ak, bk, kk[nt]); qk[nt] = MFMA16(aq, bk, qk[nt]);
        }
      }
#pragma unroll
      for (int nt = 0; nt < 4; ++nt)
#pragma unroll
        for (int r = 0; r < 4; ++r) {
          const int i = 16 * w + 4 * q + r, j = 16 * nt + i15;
          const float dec = i >= j ? expf(sgc[i] - sgc[j]) : 0.f;
          sA[i * 68 + j] = i > j ? sbeta[i] * kk[nt][r] * dec : 0.f;
          sAt[i * 72 + j] = f2bf(i >= j ? qk[nt][r] * dec : 0.f);
        }
    }
    __syncthreads();
    if (tid < 128) {
      const int c = tid;
      for (int ib = 0; ib < 16; ++ib) {
        float a0 = sX[(4 * ib) * 128 + c], a1 = sX[(4 * ib + 1) * 128 + c], a2 = sX[(4 * ib + 2) * 128 + c], a3 = sX[(4 * ib + 3) * 128 + c];
#pragma unroll 4
        for (int g = 0; g < ib; ++g) {
          const float x0 = sX[(4 * g) * 128 + c], x1 = sX[(4 * g + 1) * 128 + c], x2 = sX[(4 * g + 2) * 128 + c], x3 = sX[(4 * g + 3) * 128 + c];
          const f32x4 r0 = *(const f32x4*)&sA[(4 * ib) * 68 + 4 * g], r1 = *(const f32x4*)&sA[(4 * ib + 1) * 68 + 4 * g];
          const f32x4 r2 = *(const f32x4*)&sA[(4 * ib + 2) * 68 + 4 * g], r3 = *(const f32x4*)&sA[(4 * ib + 3) * 68 + 4 * g];
          a0 -= r0[0] * x0 + r0[1] * x1 + r0[2] * x2 + r0[3] * x3;
          a1 -= r1[0] * x0 + r1[1] * x1 + r1[2] * x2 + r1[3] * x3;
          a2 -= r2[0] * x0 + r2[1] * x1 + r2[2] * x2 + r2[3] * x3;
          a3 -= r3[0] * x0 + r3[1] * x1 + r3[2] * x2 + r3[3] * x3;
        }
        const f32x4 d1 = *(const f32x4*)&sA[(4 * ib + 1) * 68 + 4 * ib], d2 = *(const f32x4*)&sA[(4 * ib + 2) * 68 + 4 * ib], d3 = *(const f32x4*)&sA[(4 * ib + 3) * 68 + 4 * ib];
        a1 -= d1[0] * a0;
        a2 -= d2[0] * a0 + d2[1] * a1;
        a3 -= d3[0] * a0 + d3[1] * a1 + d3[2] * a2;
        sX[(4 * ib) * 128 + c] = a0; sX[(4 * ib + 1) * 128 + c] = a1; sX[(4 * ib + 2) * 128 + c] = a2; sX[(4 * ib + 3) * 128 + c] = a3;
      }
    }
    __syncthreads();
    {
      const int c = tid & 127, jh = (tid >> 7) * 32;
#pragma unroll
      for (int g = 0; g < 4; ++g) {
        u32x4 pk;
#pragma unroll
        for (int e = 0; e < 4; ++e) pk[e] = pack2(sX[(jh + 8 * g + 2 * e) * 128 + c], sX[(jh + 8 * g + 2 * e + 1) * 128 + c]);
        *(u32x4*)&sXt[c * 72 + jh + 8 * g] = pk;
      }
    }
    __syncthreads();
    {
      f32x4 r1[8], r2[8];
#pragma unroll
      for (int ct = 0; ct < 8; ++ct) { r1[ct] = fzero4(); r2[ct] = fzero4(); }
#pragma unroll
      for (int ks = 0; ks < 2; ++ks) {
        const bf16x8 aa = *(const bf16x8*)&sAt[(16 * w + i15) * 72 + ks * 32 + q * 8];
        const bf16x8 ak = *(const bf16x8*)&sKt[(16 * w + i15) * 72 + ks * 32 + q * 8];
#pragma unroll
        for (int ct = 0; ct < 8; ++ct) {
          const bf16x8 bx = *(const bf16x8*)&sXt[(16 * ct + i15) * 72 + ks * 32 + q * 8];
          r1[ct] = MFMA16(aa, bx, r1[ct]); r2[ct] = MFMA16(ak, bx, r2[ct]);
        }
      }
      const size_t ib = (size_t)item * 4096;
#pragma unroll
      for (int ct = 0; ct < 4; ++ct) {
        u32x2 a, b;
        a[0] = pack2(r1[ct][0], r1[ct][1]); a[1] = pack2(r1[ct][2], r1[ct][3]);
        b[0] = pack2(r2[ct][0], r2[ct][1]); b[1] = pack2(r2[ct][2], r2[ct][3]);
        *(u32x2*)(GLO + ib + ((ct * 4 + w) * 64 + lane) * 4) = a;
        *(u32x2*)(GN + ib + ((ct * 4 + w) * 64 + lane) * 4) = b;
      }
#pragma unroll
      for (int ct = 4; ct < 8; ++ct)
#pragma unroll
        for (int r = 0; r < 4; ++r) {
          const int row = 16 * w + 4 * q + r, col = 16 * (ct - 4) + i15;
          const float qv = bf2f(GQ[(size_t)tok(row) * 256 + hd * 64 + col]);
          GQP[ib + row * 64 + permcol(col)] = f2bf(qv * seg[row] - r1[ct][r]);
          GM[ib + row * 64 + permcol(col)] = f2bf((row == col ? eglast : 0.f) - r2[ct][r]);
        }
    }
    __syncthreads();
  }
}

DEVI void gdn_scan_chain(const Params& p, int chain, char* smem) {
  const int tid = p.tid, lane = tid & 63, w = tid >> 6, i15 = lane & 15, q = lane >> 4;
  u16* sM = (u16*)smem;
  u16* sQ = sM + 2 * 64 * 72;
  const u16* GM = (const u16*)(p.ws + O_GM); const u16* GQP = (const u16*)(p.ws + O_GQP);
  const u16* GN = (const u16*)(p.ws + O_GN); const u16* GLO = (const u16*)(p.ws + O_GLO);
  float* GO = (float*)(p.ws + O_GO);
  {
    const int b = chain >> 3, hd = (chain >> 1) & 3, dir = chain & 1;
    f32x4 S[4];
#pragma unroll
    for (int r = 0; r < 4; ++r) S[r] = fzero4();
    auto item_of = [&](int n) {
      int ci = n < 4 ? 256 + b * 4 + (dir ? 3 - n : n) : b * 128 + (dir ? 127 - (n - 4) : (n - 4));
      return ci * 8 + hd * 2 + dir;
    };
    u32x4 pm[2], pq[2]; u32x2 pn[4], pl[4];
    auto prefetch = [&](int n) {
      const size_t base = (size_t)item_of(n) * 4096;
#pragma unroll
      for (int i = 0; i < 2; ++i) {
        const int ch = tid + 256 * i;
        pm[i] = *(const u32x4*)(GM + base + ch * 8);
        pq[i] = *(const u32x4*)(GQP + base + ch * 8);
      }
#pragma unroll
      for (int rb = 0; rb < 4; ++rb) {
        pn[rb] = *(const u32x2*)(GN + base + ((w * 4 + rb) * 64 + lane) * 4);
        pl[rb] = *(const u32x2*)(GLO + base + ((w * 4 + rb) * 64 + lane) * 4);
      }
    };
    prefetch(0);
    __syncthreads();
    for (int n = 0; n < 132; ++n) {
      const int buf = n & 1;
      u16* bM = sM + buf * 64 * 72; u16* bQ = sQ + buf * 64 * 72;
#pragma unroll
      for (int i = 0; i < 2; ++i) {
        const int ch = tid + 256 * i, row = ch >> 3, cc = ch & 7;
        *(u32x4*)&bM[row * 72 + cc * 8] = pm[i];
        *(u32x4*)&bQ[row * 72 + cc * 8] = pq[i];
      }
      f32x4 accs[4], acco[4];
#pragma unroll
      for (int rb = 0; rb < 4; ++rb) {
        accs[rb] = f32x4{bf2f((u16)(pn[rb][0] & 0xffff)), bf2f((u16)(pn[rb][0] >> 16)), bf2f((u16)(pn[rb][1] & 0xffff)), bf2f((u16)(pn[rb][1] >> 16))};
        acco[rb] = f32x4{bf2f((u16)(pl[rb][0] & 0xffff)), bf2f((u16)(pl[rb][0] >> 16)), bf2f((u16)(pl[rb][1] & 0xffff)), bf2f((u16)(pl[rb][1] >> 16))};
      }
      const int ci = n < 4 ? 256 + b * 4 + (dir ? 3 - n : n) : b * 128 + (dir ? 127 - (n - 4) : (n - 4));
      const int t0 = gdn_chunk_t0(ci);
      __syncthreads();
      if (n + 1 < 132) prefetch(n + 1);
      bf16x8 sb[2];
#pragma unroll
      for (int kb = 0; kb < 2; ++kb)
#pragma unroll
        for (int jj = 0; jj < 8; ++jj) sb[kb][jj] = (short)f2bf(S[2 * kb + (jj >> 2)][jj & 3]);
#pragma unroll
      for (int kb = 0; kb < 2; ++kb)
#pragma unroll
        for (int rb = 0; rb < 4; ++rb) {
          const bf16x8 am = *(const bf16x8*)&bM[(rb * 16 + i15) * 72 + kb * 32 + q * 8];
          const bf16x8 aq = *(const bf16x8*)&bQ[(rb * 16 + i15) * 72 + kb * 32 + q * 8];
          accs[rb] = MFMA16(am, sb[kb], accs[rb]);
          acco[rb] = MFMA16(aq, sb[kb], acco[rb]);
        }
#pragma unroll
      for (int rb = 0; rb < 4; ++rb) {
        S[rb] = accs[rb];
#pragma unroll
        for (int r = 0; r < 4; ++r) {
          const int i = rb * 16 + q * 4 + r;
          const int t = dir ? t0 + 63 - i : t0 + i;
          GO[(size_t)dir * T * 256 + (size_t)t * 256 + hd * 64 + w * 16 + i15] = acco[rb][r];
        }
      }
    }
    __syncthreads();
  }
}


template <int DQK>
DEVI void attn_run(int tid, const u16* __restrict__ Qp, int qrow0, const u16* __restrict__ Kp, const u16* __restrict__ Vtp,
                   int a0, int a1, int b0, int b1, int qpos0, float sink2, f32x16 (&O)[2], char* smem) {
  constexpr int KLD = DQK + 8, NS = DQK / 16, KCH = DQK / 8, NKL = (64 * KCH) / 256;
  constexpr int BUF = 64 * KLD + 64 * 72;
  u16* sbase = (u16*)smem;
  const int lane = tid & 63, wid = tid >> 6, r31 = lane & 31, hh = lane >> 5;
  const int qrow = qrow0 + wid * 32 + r31;
  bf16x8 qf[NS];
#pragma unroll
  for (int s = 0; s < NS; ++s) qf[s] = *(const bf16x8*)(Qp + (size_t)qrow * DQK + s * 16 + hh * 8);
#pragma unroll
  for (int i = 0; i < 16; ++i) { O[0][i] = 0.f; O[1][i] = 0.f; }
  float m = -30000.f, lsum = 0.f;
  const int na = (a1 - a0) >> 6, nt = na + ((b1 - b0) >> 6);
  const int qpos = qpos0 + wid * 32 + r31;
  u32x4 rk[NKL], rv[2];
  auto gload = [&](int ti) {
    const int key0 = ti >= na ? b0 + (ti - na) * 64 : a0 + ti * 64;
#pragma unroll
    for (int i = 0; i < NKL; ++i) { const int q = tid + 256 * i, r = q / KCH, cc = q % KCH; rk[i] = *(const u32x4*)(Kp + (size_t)(key0 + r) * DQK + cc * 8); }
#pragma unroll
    for (int i = 0; i < 2; ++i) { const int q = tid + 256 * i, r = q >> 3, cc = q & 7; rv[i] = *(const u32x4*)(Vtp + (size_t)r * NKEY + key0 + cc * 8); }
  };
  auto lstore = [&](int buf) {
    u16* sK = sbase + buf * BUF; u16* sV = sK + 64 * KLD;
#pragma unroll
    for (int i = 0; i < NKL; ++i) { const int q = tid + 256 * i, r = q / KCH, cc = q % KCH; *(u32x4*)&sK[r * KLD + cc * 8] = rk[i]; }
#pragma unroll
    for (int i = 0; i < 2; ++i) { const int q = tid + 256 * i, r = q >> 3, cc = q & 7; *(u32x4*)&sV[r * 72 + cc * 8] = rv[i]; }
  };
  m = 0.f;
  f32x16 negm;
#pragma unroll
  for (int i = 0; i < 16; ++i) negm[i] = 0.f;
  gload(0);
  __syncthreads();
  lstore(0);
  __syncthreads();
  for (int ti = 0; ti < nt; ++ti) {
    if (ti + 1 < nt) gload(ti + 1);
    const u16* sK = sbase + (ti & 1) * BUF; const u16* sV = sK + 64 * KLD;
    const bool inB = ti >= na;
    const int key0 = inB ? b0 + (ti - na) * 64 : a0 + ti * 64;
    f32x16 st[2];
#pragma unroll
    for (int k2 = 0; k2 < 2; ++k2) {
      {
        const bf16x8 kf = *(const bf16x8*)&sK[(k2 * 32 + r31) * KLD + hh * 8];
        asm volatile("v_mfma_f32_32x32x16_bf16 %0, %1, %2, %3" : "=&v"(st[k2]) : "v"(kf), "v"(qf[0]), "v"(negm));
      }
#pragma unroll
      for (int s = 1; s < NS; ++s) {
        const bf16x8 kf = *(const bf16x8*)&sK[(k2 * 32 + r31) * KLD + s * 16 + hh * 8];
        st[k2] = MFMA32(kf, qf[s], st[k2]);
      }
    }
    if (inB) {
#pragma unroll
      for (int k2 = 0; k2 < 2; ++k2)
#pragma unroll
        for (int g = 0; g < 16; ++g) {
          const int d = key0 + k2 * 32 + (g & 3) + 8 * (g >> 2) + 4 * hh - qpos;
          if (d > 128 || d < -128) st[k2][g] = -1e30f;
        }
    }
    bf16x8 vfr[2][2][2];
#pragma unroll
    for (int k2 = 0; k2 < 2; ++k2)
#pragma unroll
      for (int s2 = 0; s2 < 2; ++s2)
#pragma unroll
        for (int dvt = 0; dvt < 2; ++dvt) vfr[k2][s2][dvt] = *(const bf16x8*)&sV[(dvt * 32 + r31) * 72 + k2 * 32 + s2 * 16 + 8 * hh];
    float mx = st[0][0];
#pragma unroll
    for (int g = 1; g < 16; ++g) mx = fmaxf(mx, st[0][g]);
#pragma unroll
    for (int g = 0; g < 16; ++g) mx = fmaxf(mx, st[1][g]);
    { auto rr = __builtin_amdgcn_permlane32_swap(__float_as_uint(mx), __float_as_uint(mx), false, false);
      mx = fmaxf(__uint_as_float(rr[0]), __uint_as_float(rr[1])); }
    if (ti == 0 || __any(mx > 8.f)) {
      const float delta = ti == 0 ? fmaxf(mx, -1e4f) : fmaxf(mx, 0.f);
      if (ti != 0) {
        const float alpha = __builtin_amdgcn_exp2f(-delta);
        lsum *= alpha;
#pragma unroll
        for (int i = 0; i < 16; ++i) { O[0][i] *= alpha; O[1][i] *= alpha; }
      }
      m += delta;
#pragma unroll
      for (int i = 0; i < 16; ++i) { negm[i] = -m; st[0][i] -= delta; st[1][i] -= delta; }
    }
    f32x2 ps2 = {0.f, 0.f};
#pragma unroll
    for (int k2 = 0; k2 < 2; ++k2)
#pragma unroll
      for (int g = 0; g < 16; g += 2) {
        const float p0 = __builtin_amdgcn_exp2f(st[k2][g]), p1 = __builtin_amdgcn_exp2f(st[k2][g + 1]);
        st[k2][g] = p0; st[k2][g + 1] = p1;
        ps2 += f32x2{p0, p1};
      }
    lsum += ps2[0] + ps2[1];
#pragma unroll
    for (int k2 = 0; k2 < 2; ++k2)
#pragma unroll
      for (int s2 = 0; s2 < 2; ++s2) {
        u32x4 pp;
#pragma unroll
        for (int j = 0; j < 4; ++j) pp[j] = pack2(st[k2][8 * s2 + 2 * j], st[k2][8 * s2 + 2 * j + 1]);
        const bf16x8 pf = __builtin_bit_cast(bf16x8, pp);
#pragma unroll
        for (int dvt = 0; dvt < 2; ++dvt) {
          O[dvt] = MFMA32(vfr[k2][s2][dvt], pf, O[dvt]);
        }
      }
    if (ti + 1 < nt) lstore((ti + 1) & 1);
    __syncthreads();
  }
  if (sink2 > -1e29f) {
    const float mn = fmaxf(m, sink2);
    const float alpha = __builtin_amdgcn_exp2f(m - mn);
    lsum = lsum * alpha + (hh == 0 ? __builtin_amdgcn_exp2f(sink2 - mn) : 0.f);
#pragma unroll
    for (int i = 0; i < 16; ++i) { O[0][i] *= alpha; O[1][i] *= alpha; }
  }
  const float ltot = lsum + __shfl_xor(lsum, 32);
  const float inv = 1.f / ltot;
#pragma unroll
  for (int i = 0; i < 16; ++i) { O[0][i] *= inv; O[1][i] *= inv; }
}
DEVI void attn_store(int tid, const f32x16 (&O)[2], u16* dst, int ld, int b, int qrow0, int col0) {
  const int lane = tid & 63, wid = tid >> 6, r31 = lane & 31, hh = lane >> 5;
  const int qrow = qrow0 + wid * 32 + r31;
  const int t = qrow < SEQ ? b * SEQ + qrow : TL + b * CTXL + (qrow - SEQ);
  u16* yr = dst + (size_t)t * ld + col0;
#pragma unroll
  for (int dvt = 0; dvt < 2; ++dvt)
#pragma unroll
    for (int g4 = 0; g4 < 4; ++g4) {
      u32x2 pk; pk[0] = pack2(O[dvt][g4 * 4 + 0], O[dvt][g4 * 4 + 1]); pk[1] = pack2(O[dvt][g4 * 4 + 2], O[dvt][g4 * 4 + 3]);
      *(u32x2*)(yr + dvt * 32 + 8 * g4 + 4 * hh) = pk;
    }
}
DEVI void attn_item(const Params& p, int l, int mixer, int b, int h, int qb, char* smem) {
  const bool lat = qb < 64;
  const int qrow0 = qb * 128;
  f32x16 O[2];
  if (mixer == 0) {
    attn_run<32>(p.tid, (const u16*)(p.ws + O_QB) + (size_t)(b * 8 + h) * NKEY * 32, qrow0, (const u16*)(p.ws + O_KB) + (size_t)(b * 8 + h) * NKEY * 32,
                 (const u16*)(p.ws + O_VTB) + (size_t)(b * 4 + (h >> 1)) * 64 * NKEY, lat ? 0 : SEQ, NKEY, 0, 0, 0, -1e30f, O, smem);
    attn_store(p.tid, O, (u16*)(p.ws + O_OB), 512, b, qrow0, h * 64);
  } else if (mixer == 1) {
    attn_run<96>(p.tid, (const u16*)(p.ws + O_QC) + (size_t)(b * 4 + h) * NKEY * 96, qrow0, (const u16*)(p.ws + O_KC) + (size_t)(b * 4 + h) * NKEY * 96,
                 (const u16*)(p.ws + O_VTC) + (size_t)(b * 4 + h) * 64 * NKEY, lat ? 0 : SEQ, NKEY, 0, 0, 0, -1e30f, O, smem);
    attn_store(p.tid, O, (u16*)(p.ws + O_Y), 1024, b, qrow0, 512 + h * 64);
  } else {
    const float sink2 = pin(p, I_SINK)[l * 4 + h] * LOG2E;
    const int hk = h >> 1;
    int b0 = 0, b1 = 0;
    if (lat) { b0 = (qb - 1) * 128; if (b0 < 0) b0 = 0; b1 = (qb + 2) * 128; if (b1 > SEQ) b1 = SEQ; }
    attn_run<64>(p.tid, (const u16*)(p.ws + O_QA) + (size_t)(b * 4 + h) * NKEY * 64, qrow0, (const u16*)(p.ws + O_KA) + (size_t)(b * 2 + hk) * NKEY * 64,
                 (const u16*)(p.ws + O_VTA) + (size_t)(b * 2 + hk) * 64 * NKEY, SEQ, NKEY, b0, b1, qrow0, sink2, O, smem);
    attn_store(p.tid, O, (u16*)(p.ws + O_Y), 1024, b, qrow0, h * 64);
  }
}

constexpr int SMEM_BYTES = 78848 + 64;

DEVI unsigned long long launder_ptr(unsigned long long v) {
  unsigned lo = __builtin_amdgcn_readfirstlane((unsigned)v), hi = __builtin_amdgcn_readfirstlane((unsigned)(v >> 32));
  asm volatile("s_mov_b32 %0, %1" : "=s"(lo) : "s"(lo));
  asm volatile("s_mov_b32 %0, %1" : "=s"(hi) : "s"(hi));
  return ((unsigned long long)hi << 32) | lo;
}
DEVI Params mkctx(const KArgs& a) {
  Params c;
  typedef __attribute__((address_space(1))) char gchar;
  typedef __attribute__((address_space(1))) float gfloat;
  c.ws = (char*)(gchar*)launder_ptr((unsigned long long)a.ws);
  c.out = (float*)(gfloat*)launder_ptr((unsigned long long)a.out);
  c.in = (gcfloat* const*)(c.ws + O_TAB);
  c.tid = threadIdx.x;
  asm volatile("" : "+v"(c.tid));
  return c;
}
DEVI void st_mixer_queue(const KArgs& a, int l, char* smem) {
  int* sitem = (int*)(smem + SMEM_BYTES - 16);
  const int g = blockIdx.x & 7;
  const int nctx = l == 0 ? 8 : 0;
  constexpr int NPREP = TR_P2 / 8 / 8;
  const int total = 2 + 128 + 64 + 64 + nctx + NPREP;
  for (;;) {
    const Params p = mkctx(a);
    unsigned* head = (unsigned*)(p.ws + O_BAR) + 16 + l * 8 + g;
    __syncthreads();
    if (p.tid == 0) *sitem = (int)atomicAdd(head, 1u);
    __syncthreads();
    int it = *sitem;
    if (it >= total) break;
    if (it < 2) { gdn_scan_chain(p, 2 * g + it, smem); continue; }
    it -= 2;
    if (it < 256 + nctx) {
      int mixer, b, h, qb;
      if (it < 128) { const int pr = 2 * g + (it >> 6); mixer = 0; b = pr >> 3; h = pr & 7; qb = it & 63; }
      else if (it < 256) { mixer = 1 + ((it - 128) >> 6); b = g >> 2; h = g & 3; qb = it & 63; }
      else {
        const int j = it - 256;
        if (j < 4) { const int pr = 2 * g + (j >> 1); mixer = 0; b = pr >> 3; h = pr & 7; qb = 64 + (j & 1); }
        else { mixer = 1 + ((j - 4) >> 1); b = g >> 2; h = g & 3; qb = 64 + (j & 1); }
      }
      attn_item(p, l, mixer, b, h, qb, smem);
      continue;
    }
    it -= 256 + nctx;
    prep_w2_run8(p, l, (it * 8 + g) * 8, (float*)smem);
  }
}

DEVI void st_mix_finish(const Params& p, int l, int vb, int nvb) {
  const int lane = p.tid & 63, wid = p.tid >> 6;
  const float* GO = (const float*)(p.ws + O_GO); const u16* PP = (const u16*)(p.ws + O_PP); const u16* OB = (const u16*)(p.ws + O_OB);
  u16* Y = (u16*)(p.ws + O_Y);
  const float lam_init = 0.8f - 0.6f * expf(-0.3f * (float)l);
  float d1 = lane < 32 ? pin(p, I_LQ1)[l * 32 + lane] * pin(p, I_LK1)[l * 32 + lane] : 0.f;
  float d2 = lane < 32 ? pin(p, I_LQ2)[l * 32 + lane] * pin(p, I_LK2)[l * 32 + lane] : 0.f;
  const float lam = expf(wave_sum(d1)) - expf(wave_sum(d2)) + lam_init;
  const int hd = lane >> 4, d0 = (lane & 15) * 4;
  const f32x4 gg = *(const f32x4*)(pin(p, I_GNG) + l * 64 + d0);
  const f32x4 dg = *(const f32x4*)(pin(p, I_DNG) + l * 64 + d0) * (1.f - lam_init);
  const int tend = l == 0 ? T : TL;
  for (int t0 = (vb * 4 + wid) * 2; t0 < tend; t0 += nvb * 8) {
    u32x2 o0[2], o1[2], zz[2]; f32x4 gf[2], gb[2];
#pragma unroll
    for (int u = 0; u < 2; ++u) {
      const size_t t = t0 + u;
      o0[u] = *(const u32x2*)(OB + t * 512 + (hd * 2) * 64 + d0);
      o1[u] = *(const u32x2*)(OB + t * 512 + (hd * 2 + 1) * 64 + d0);
      gf[u] = *(const f32x4*)(GO + t * 256 + hd * 64 + d0);
      gb[u] = *(const f32x4*)(GO + (size_t)T * 256 + t * 256 + hd * 64 + d0);
      zz[u] = *(const u32x2*)(PP + t * LDPP + PP_DZ + hd * 64 + d0);
    }
    f32x4 od[2], go[2]; float ssb[2], ssg[2];
#pragma unroll
    for (int u = 0; u < 2; ++u) {
      const f32x4 a = {bflo(o0[u][0]), bfhi(o0[u][0]), bflo(o0[u][1]), bfhi(o0[u][1])};
      const f32x4 b = {bflo(o1[u][0]), bfhi(o1[u][0]), bflo(o1[u][1]), bfhi(o1[u][1])};
      od[u] = a - lam * b; go[u] = gf[u] + gb[u];
      ssb[u] = od[u][0] * od[u][0] + od[u][1] * od[u][1] + od[u][2] * od[u][2] + od[u][3] * od[u][3];
      ssg[u] = go[u][0] * go[u][0] + go[u][1] * go[u][1] + go[u][2] * go[u][2] + go[u][3] * go[u][3];
    }
#pragma unroll
    for (int o = 8; o >= 1; o >>= 1) {
#pragma unroll
      for (int u = 0; u < 2; ++u) { ssb[u] += __shfl_xor(ssb[u], o); ssg[u] += __shfl_xor(ssg[u], o); }
    }
#pragma unroll
    for (int u = 0; u < 2; ++u) {
      const size_t t = t0 + u;
      const f32x4 yb = od[u] * (rsqrtf(ssb[u] * (1.f / 64.f) + 1e-6f)) * dg;
      const f32x4 z = {bflo(zz[u][0]), bfhi(zz[u][0]), bflo(zz[u][1]), bfhi(zz[u][1])};
      const f32x4 sz = {siluf(z[0]), siluf(z[1]), siluf(z[2]), siluf(z[3])};
      const f32x4 yd = go[u] * (rsqrtf(ssg[u] * (1.f / 64.f) + 1e-6f)) * gg * sz;
      u32x2 pb, pd;
      pb[0] = pack2(yb[0], yb[1]); pb[1] = pack2(yb[2], yb[3]);
      pd[0] = pack2(yd[0], yd[1]); pd[1] = pack2(yd[2], yd[3]);
      *(u32x2*)(Y + t * 1024 + 256 + hd * 64 + d0) = pb;
      *(u32x2*)(Y + t * 1024 + 768 + hd * 64 + d0) = pd;
    }
  }
}

constexpr int RLD = 1026;
DEVI void st_norm2_route(const Params& p, int l, int vb, int nvb, char* smem) {
  const int lane = p.tid & 63, wid = p.tid >> 6, i15 = lane & 15, q = lane >> 4;
  float* shh = (float*)smem;
  float* slog = shh + 16 * RLD;
  const float* g = pin(p, I_N2G) + l * 1024;
  const float* wr = pin(p, I_WR) + (size_t)l * 1024 * 64;
  const float bias = pin(p, I_RB)[l * 64 + lane];
  float* WTS = (float*)(p.ws + O_WTS); int* CNT = (int*)(p.ws + O_CNT); int* LIST = (int*)(p.ws + O_LIST);
  const int ntok = l == 0 ? T : TL;
  for (int grp = vb; grp < ntok / 16; grp += nvb) {
    const int tb = grp * 16 + wid * 4;
    const int mv = tok_mv(tb);
    const float* sh = modp(p, l, mv, 3); const float* sc = modp(p, l, mv, 4);
    {
      f32x4 v[4][4]; float ss[4];
#pragma unroll
      for (int u = 0; u < 4; ++u) {
        const f32x4* xr = (const f32x4*)((const float*)(p.ws + O_XA) + (size_t)(tb + u) * 1024);
#pragma unroll
        for (int i = 0; i < 4; ++i) v[u][i] = xr[i * 64 + lane];
      }
#pragma unroll
      for (int u = 0; u < 4; ++u) {
        float a = 0.f;
#pragma unroll
        for (int i = 0; i < 4; ++i) a += v[u][i][0] * v[u][i][0] + v[u][i][1] * v[u][i][1] + v[u][i][2] * v[u][i][2] + v[u][i][3] * v[u][i][3];
        ss[u] = a;
      }
#pragma unroll
      for (int o = 32; o >= 1; o >>= 1) {
#pragma unroll
        for (int u = 0; u < 4; ++u) ss[u] += __shfl_xor(ss[u], o);
      }
#pragma unroll
      for (int i = 0; i < 4; ++i) {
        const int c = i * 256 + lane * 4;
        const f32x4 gg = *(const f32x4*)(g + c), s4 = *(const f32x4*)(sc + c), h4 = *(const f32x4*)(sh + c);
        const f32x4 gs = gg * (1.f + s4);
#pragma unroll
        for (int u = 0; u < 4; ++u) {
          const float rstd = rsqrtf(ss[u] * (1.f / 1024.f) + 1e-6f);
          const f32x4 o = v[u][i] * rstd * gs + h4;
          u32x2 pk; pk[0] = pack2(o[0], o[1]); pk[1] = pack2(o[2], o[3]);
          *(u32x2*)((u16*)(p.ws + O_H) + (size_t)(tb + u) * LDH + c) = pk;
          float* d = shh + (wid * 4 + u) * RLD + c;
          *(f32x2*)d = f32x2{o[0], o[1]}; *(f32x2*)(d + 2) = f32x2{o[2], o[3]};
        }
      }
    }
    __syncthreads();
    {
      f32x4 a0 = fzero4(), a1 = a0;
      const float* ap = shh + i15 * RLD + q;
      const float* bp = wr + (size_t)q * 64 + wid * 16 + i15;
#pragma unroll 1
      for (int kb = 0; kb < 256; kb += 32) {
        float bv[32];
#pragma unroll
        for (int j = 0; j < 32; ++j) bv[j] = bp[(size_t)(4 * (kb + j)) * 64];
#pragma unroll
        for (int j = 0; j < 32; j += 2) {
          a0 = __builtin_amdgcn_mfma_f32_16x16x4f32(ap[4 * (kb + j)], bv[j], a0, 0, 0, 0);
          a1 = __builtin_amdgcn_mfma_f32_16x16x4f32(ap[4 * (kb + j) + 4], bv[j + 1], a1, 0, 0, 0);
        }
      }
#pragma unroll
      for (int r = 0; r < 4; ++r) slog[(4 * q + r) * 64 + wid * 16 + i15] = a0[r] + a1[r];
    }
    __syncthreads();
#pragma unroll 1
    for (int u = 0; u < 4; ++u) {
      const int t = tb + u;
      const float logit = slog[(wid * 4 + u) * 64 + lane];
      const float s = 1.f / (1.f + expf(-logit));
      const float c = s + bias;
      float m1 = c;
      m1 = fmaxf(m1, __shfl_xor(m1, 1)); m1 = fmaxf(m1, __shfl_xor(m1, 2)); m1 = fmaxf(m1, __shfl_xor(m1, 4));
      const unsigned long long bal = __ballot(c == m1);
      const int grpi = lane >> 3;
      const unsigned gm = (unsigned)((bal >> (grpi * 8)) & 0xffull);
      const int first = __ffs(gm) - 1;
      float m2 = ((lane & 7) == first) ? -INFINITY : c;
      m2 = fmaxf(m2, __shfl_xor(m2, 1)); m2 = fmaxf(m2, __shfl_xor(m2, 2)); m2 = fmaxf(m2, __shfl_xor(m2, 4));
      const float gs = m1 + m2;
      int grank = 0;
#pragma unroll
      for (int gg = 0; gg < 8; ++gg) { float o = __shfl(gs, gg * 8); grank += (o > gs || (o == gs && gg < grpi)) ? 1 : 0; }
      const bool gsel = grank < 4;
      const float mc = gsel ? c : -INFINITY;
      int rank = 0;
#pragma unroll
      for (int e = 0; e < 64; ++e) { float o = __shfl(mc, e); rank += (o > mc || (o == mc && e < lane)) ? 1 : 0; }
      const bool sel = gsel && rank < 6;
      const float ssum = wave_sum(sel ? s : 0.f);
      if (sel) {
        const int slot = t * 6 + rank;
        WTS[slot] = s / ssum * 2.5f;
        const int pos = atomicAdd(&CNT[lane], 1);
        LIST[(size_t)lane * T + pos] = slot;
      }
    }
    __syncthreads();
  }
}
DEVI void st_outproj(const Params& p, int l, int vb, int nvb, char* smem) {
  const u16* Y = (const u16*)(p.ws + O_Y); const u16* W = (const u16*)(p.ws + O_WOUTT); float* XA = (float*)(p.ws + O_XA);
  const int tid = p.tid, lane = tid & 63, wid = tid >> 6, wr = wid >> 1, wc = wid & 1, fr = lane & 15, fq = lane >> 4;
  const int nmt = l == 0 ? 132 : 128;
  const int g = vb & 7, nmg = (nmt - g + 7) >> 3;
  for (int i = vb >> 3; i < nmg * 8; i += nvb >> 3) {
    const int m0 = (g + 8 * (i >> 3)) * 128, n0 = (i & 7) * 128;
    f32x4 acc[4][4];
    gemm_core<false>(tid, [&](int r) { return Y + (size_t)(m0 + r) * 1024; }, W + (size_t)n0 * LDW, LDW, 1024, acc, smem);
    const float* gbase = modp(p, l, tok_mv(m0), 2) + n0 + wc * 64 + fq * 4;
#pragma unroll
    for (int hf = 0; hf < 2; ++hf) {
      f32x4 xin[2][4], gt[4];
#pragma unroll
      for (int n = 0; n < 4; ++n) gt[n] = *(const f32x4*)(gbase + n * 16);
#pragma unroll
      for (int mm = 0; mm < 2; ++mm) {
        const int t = m0 + wr * 64 + (hf * 2 + mm) * 16 + fr;
        const float* src = l == 0 ? (t < TL ? pin(p, I_X) + (size_t)t * 1024 : pin(p, I_CTX) + (size_t)(t - TL) * 1024) : (const float*)(XA + (size_t)t * 1024);
#pragma unroll
        for (int n = 0; n < 4; ++n) xin[mm][n] = *(const f32x4*)(src + n0 + wc * 64 + n * 16 + fq * 4);
      }
#pragma unroll
      for (int mm = 0; mm < 2; ++mm) {
        const int t = m0 + wr * 64 + (hf * 2 + mm) * 16 + fr;
#pragma unroll
        for (int n = 0; n < 4; ++n) *(f32x4*)(XA + (size_t)t * 1024 + n0 + wc * 64 + n * 16 + fq * 4) = xin[mm][n] + gt[n] * acc[hf * 2 + mm][n];
      }
    }
  }
}

DEVI void grp_tiles(const Params& p, int* tst, int g, int shift, int nshared) {
  __syncthreads();
  if (p.tid < 64) {
    const int* CNT = (const int*)(p.ws + O_CNT);
    const int lane = p.tid;
    int c = 0;
    if (lane < 8) c = (__hip_atomic_load(&CNT[g + 8 * lane], __ATOMIC_RELAXED, __HIP_MEMORY_SCOPE_AGENT) + (1 << shift) - 1) >> shift;
    int incl = c;
#pragma unroll
    for (int o = 1; o < 8; o <<= 1) { int u = __shfl_up(incl, o); if (lane >= o) incl += u; }
    if (lane < 8) tst[lane] = incl - c;
    if (lane == 7) { tst[8] = incl; tst[9] = incl + (nshared - g + 7) / 8; }
  }
  __syncthreads();
}
DEVI void grp_find(const int* tst, int tile, int g, int& e, int& lt) {
  int j = 0;
#pragma unroll
  for (int k = 1; k <= 8; ++k) j += tile >= tst[k] ? 1 : 0;
  if (j < 8) { e = g + 8 * j; lt = tile - tst[j]; } else { e = 64; lt = g + 8 * (tile - tst[8]); }
}
DEVI void st_moe1(const Params& p, int l, int vb, int nvb, char* smem) {
  const int* CNT = (const int*)(p.ws + O_CNT); const int* LIST = (const int*)(p.ws + O_LIST);
  const u16* H = (const u16*)(p.ws + O_H); u16* HB = (u16*)(p.ws + O_HB);
  int* sslot = (int*)(smem + 4 * 128 * GLD * 2);
  int* TST = sslot + 128;
  const int g = vb & 7;
  const int nsh = l == 0 ? T : TL;
  grp_tiles(p, TST, g, 7, nsh / 128);
  const int total = TST[9];
  auto fetch_slot = [&](int item, int& e, int& n0) {
    const int tile = item >> 2; n0 = (item & 3) * 128;
    int lt; grp_find(TST, tile, g, e, lt);
    int slot = -1;
    if (p.tid < 128) {
      const int cnt = e < 64 ? __hip_atomic_load(&CNT[e], __ATOMIC_RELAXED, __HIP_MEMORY_SCOPE_AGENT) : nsh;
      const int i = lt * 128 + p.tid;
      if (i < cnt) slot = e < 64 ? LIST[(size_t)e * T + i] : NSLOT + i;
    }
    return slot;
  };
  int e = 0, n0 = 0, e_nx = 0, n0_nx = 0;
  int slot_nx = (vb >> 3) < total * 4 ? fetch_slot(vb >> 3, e_nx, n0_nx) : -1;
  for (int item = vb >> 3; item < total * 4; item += nvb >> 3) {
    e = e_nx; n0 = n0_nx;
    __syncthreads();
    if (p.tid < 128) sslot[p.tid] = slot_nx;
    __syncthreads();
    if (item + (nvb >> 3) < total * 4) slot_nx = fetch_slot(item + (nvb >> 3), e_nx, n0_nx);
    gemm128(p.tid, [&](int r) { int sl = sslot[r]; int tk = sl < 0 ? 0 : (sl < NSLOT ? sl / 6 : sl - NSLOT); return H + (size_t)tk * LDH; },
            (const u16*)(p.ws + O_WGUT) + ((size_t)e * 512 + n0) * LDW, LDW, 1024,
            [&](int r, int c, f32x4 v) {
              int sl = sslot[r]; if (sl < 0) return;
              float h0 = siluf(v[0]) * v[1], h1 = siluf(v[2]) * v[3];
              *(unsigned*)(HB + (size_t)sl * 256 + ((n0 + c) >> 1)) = pack2(h0, h1);
            }, smem);
  }
}
DEVI void st_moe2(const Params& p, int l, int vb, int nvb, char* smem) {
  const int* CNT = (const int*)(p.ws + O_CNT); const int* LIST = (const int*)(p.ws + O_LIST);
  const u16* HB = (const u16*)(p.ws + O_HB); u16* SO = (u16*)(p.ws + O_SLOT); const float* WTS = (const float*)(p.ws + O_WTS);
  constexpr int ALD = 264;
  u16* sA = (u16*)smem;
  u16* sB = sA + 64 * ALD;
  int* sslot = (int*)(sB + 2 * 128 * 72);
  int* TST = sslot + 64;
  const int tid = p.tid, lane = tid & 63, wid = tid >> 6, wr = wid >> 1, wc = wid & 1, fr = lane & 15, fq = lane >> 4;
  const int g = vb & 7;
  const int nsh = l == 0 ? T : TL;
  grp_tiles(p, TST, g, 6, nsh / 64);
  const int total = TST[9];
  for (int item = vb >> 3; item < total; item += nvb >> 3) {
    int e, lt; grp_find(TST, item, g, e, lt);
    const int cnt = e < 64 ? __hip_atomic_load(&CNT[e], __ATOMIC_RELAXED, __HIP_MEMORY_SCOPE_AGENT) : nsh;
    __syncthreads();
    if (tid < 64) { const int i = lt * 64 + tid; sslot[tid] = i < cnt ? (e < 64 ? LIST[(size_t)e * T + i] : NSLOT + i) : -1; }
    __syncthreads();
    const u16* Bbase = (const u16*)(p.ws + O_WDT) + (size_t)e * 1024 * 256;
    u32x4 rb0[4], rb1[4], rb2[4];
    const u16* bthr = Bbase + (size_t)(tid >> 3) * 256 + (tid & 7) * 8;
    auto gloadB = [&](u32x4 (&rb)[4], int bt) {
      int off = (bt >> 2) * 128 * 256 + (bt & 3) * 64;
      asm volatile("" : "+s"(off));
      const u16* src = bthr + off;
#pragma unroll
      for (int i = 0; i < 4; ++i) rb[i] = *(const u32x4*)(src + i * 32 * 256);
    };
    auto lstoreB = [&](const u32x4 (&rb)[4], int buf) {
      u16* d = sB + buf * 128 * 72;
#pragma unroll
      for (int i = 0; i < 4; ++i) { const int q = tid + 256 * i, r = q >> 3, cc = q & 7; *(u32x4*)&d[r * 72 + cc * 8] = rb[i]; }
    };
    gloadB(rb0, 0); gloadB(rb1, 1); gloadB(rb2, 2);
#pragma unroll
    for (int hf = 0; hf < 2; ++hf) {
      u32x4 ra[4];
#pragma unroll
      for (int i = 0; i < 4; ++i) { const int q = tid + 256 * (4 * hf + i), r = q >> 5, cc = q & 31; const int sl = sslot[r]; ra[i] = *(const u32x4*)(HB + (size_t)(sl < 0 ? 0 : sl) * 256 + cc * 8); }
#pragma unroll
      for (int i = 0; i < 4; ++i) { const int q = tid + 256 * (4 * hf + i), r = q >> 5, cc = q & 31; *(u32x4*)&sA[r * ALD + cc * 8] = ra[i]; }
      __builtin_amdgcn_sched_barrier(0);
    }
    int slot_m[2]; float w_m[2];
#pragma unroll
    for (int m = 0; m < 2; ++m) { const int sl = sslot[wr * 32 + m * 16 + fr]; slot_m[m] = sl; w_m[m] = (sl >= 0 && sl < NSLOT) ? WTS[sl] : 1.f; }
    lstoreB(rb0, 0); gloadB(rb0, 3);
    __syncthreads();
    f32x4 acc[2][4];
    auto compute = [&](int bt, int buf) {
      const int nt = bt >> 2, kt = bt & 3;
      const u16* b = sB + buf * 128 * 72;
      if (kt == 0) {
#pragma unroll
        for (int m = 0; m < 2; ++m)
#pragma unroll
          for (int n = 0; n < 4; ++n) acc[m][n] = fzero4();
      }
#pragma unroll
      for (int ks = 0; ks < 2; ++ks) {
        bf16x8 af[2], bfr[4];
#pragma unroll
        for (int m = 0; m < 2; ++m) af[m] = *(const bf16x8*)&sA[(wr * 32 + m * 16 + fr) * ALD + kt * 64 + ks * 32 + fq * 8];
#pragma unroll
        for (int n = 0; n < 4; ++n) bfr[n] = *(const bf16x8*)&b[(wc * 64 + (n >> 1) * 32 + (fr >> 2) * 8 + (n & 1) * 4 + (fr & 3)) * 72 + ks * 32 + fq * 8];
#pragma unroll
        for (int m = 0; m < 2; ++m)
#pragma unroll
          for (int n = 0; n < 4; ++n) acc[m][n] = MFMA16(bfr[n], af[m], acc[m][n]);
      }
      if (kt == 3) {
#pragma unroll
        for (int m = 0; m < 2; ++m) {
          if (slot_m[m] >= 0) {
            const float w = w_m[m];
#pragma unroll
            for (int h = 0; h < 2; ++h) {
              u32x4 pk;
              pk[0] = pack2(acc[m][2 * h][0] * w, acc[m][2 * h][1] * w); pk[1] = pack2(acc[m][2 * h][2] * w, acc[m][2 * h][3] * w);
              pk[2] = pack2(acc[m][2 * h + 1][0] * w, acc[m][2 * h + 1][1] * w); pk[3] = pack2(acc[m][2 * h + 1][2] * w, acc[m][2 * h + 1][3] * w);
              *(u32x4*)(SO + (size_t)slot_m[m] * 1024 + nt * 128 + wc * 64 + h * 32 + fq * 8) = pk;
            }
          }
        }
      }
    };
#pragma unroll
    for (int bt = 0; bt < 30; bt += 3) {
      compute(bt, bt & 1);           lstoreB(rb1, (bt + 1) & 1); if (bt + 4 < 32) gloadB(rb1, bt + 4); __syncthreads(); __builtin_amdgcn_sched_barrier(0);
      compute(bt + 1, (bt + 1) & 1); lstoreB(rb2, (bt + 2) & 1); if (bt + 5 < 32) gloadB(rb2, bt + 5); __syncthreads(); __builtin_amdgcn_sched_barrier(0);
      compute(bt + 2, (bt + 2) & 1); lstoreB(rb0, (bt + 3) & 1); if (bt + 6 < 32) gloadB(rb0, bt + 6); __syncthreads(); __builtin_amdgcn_sched_barrier(0);
    }
    compute(30, 0); lstoreB(rb1, 1); __syncthreads(); __builtin_amdgcn_sched_barrier(0);
    compute(31, 1); __syncthreads();
  }
}

DEVI void st_combine(const Params& p, int l, int vb, int nvb) {
  const int lane = p.tid & 63, wid = p.tid >> 6;
  const u16* SO = (const u16*)(p.ws + O_SLOT);
  const bool last = l == 1;
  const float* gnext = last ? pin(p, I_FNG) : pin(p, I_N1G) + 1024;
  const int tend = last ? TL : T;
  for (int t0 = (vb * 4 + wid) * 2; t0 < tend; t0 += nvb * 8) {
    const int mv = tok_mv(t0);
    const float* g5 = modp(p, l, mv, 5);
    u32x4 sv[2][7][2]; f32x4 xv[2][4];
#pragma unroll
    for (int u = 0; u < 2; ++u) {
      const int t = t0 + u;
#pragma unroll
      for (int k = 0; k < 7; ++k) {
        const u16* row = SO + (size_t)(k < 6 ? t * 6 + k : NSLOT + t) * 1024;
        sv[u][k][0] = *(const u32x4*)(row + lane * 8); sv[u][k][1] = *(const u32x4*)(row + 512 + lane * 8);
      }
      const float* xr = (const float*)(p.ws + O_XA) + (size_t)t * 1024;
      xv[u][0] = *(const f32x4*)(xr + lane * 8); xv[u][1] = *(const f32x4*)(xr + lane * 8 + 4);
      xv[u][2] = *(const f32x4*)(xr + 512 + lane * 8); xv[u][3] = *(const f32x4*)(xr + 512 + lane * 8 + 4);
    }
    f32x4 gq[4];
    gq[0] = *(const f32x4*)(g5 + lane * 8); gq[1] = *(const f32x4*)(g5 + lane * 8 + 4);
    gq[2] = *(const f32x4*)(g5 + 512 + lane * 8); gq[3] = *(const f32x4*)(g5 + 512 + lane * 8 + 4);
    float ss[2];
#pragma unroll
    for (int u = 0; u < 2; ++u) {
      float acc = 0.f;
#pragma unroll
      for (int hf = 0; hf < 2; ++hf) {
        f32x4 a0 = fzero4(), a1 = a0;
#pragma unroll
        for (int k = 0; k < 7; ++k) {
          const u32x4 v = sv[u][k][hf];
          a0[0] += bflo(v[0]); a0[1] += bfhi(v[0]); a0[2] += bflo(v[1]); a0[3] += bfhi(v[1]);
          a1[0] += bflo(v[2]); a1[1] += bfhi(v[2]); a1[2] += bflo(v[3]); a1[3] += bfhi(v[3]);
        }
        xv[u][2 * hf] += gq[2 * hf] * a0; xv[u][2 * hf + 1] += gq[2 * hf + 1] * a1;
#pragma unroll
        for (int e = 0; e < 4; ++e) acc += xv[u][2 * hf][e] * xv[u][2 * hf][e] + xv[u][2 * hf + 1][e] * xv[u][2 * hf + 1][e];
      }
      ss[u] = acc;
    }
#pragma unroll
    for (int o = 32; o >= 1; o >>= 1) { ss[0] += __shfl_xor(ss[0], o); ss[1] += __shfl_xor(ss[1], o); }
    f32x4 gn[4];
    gn[0] = *(const f32x4*)(gnext + lane * 8); gn[1] = *(const f32x4*)(gnext + lane * 8 + 4);
    gn[2] = *(const f32x4*)(gnext + 512 + lane * 8); gn[3] = *(const f32x4*)(gnext + 512 + lane * 8 + 4);
    if (!last) {
      const float* sh = modp(p, 1, mv, 0); const float* sc = modp(p, 1, mv, 1);
#pragma unroll
      for (int q = 0; q < 4; ++q) {
        const int c = (q >> 1) * 512 + lane * 8 + (q & 1) * 4;
        const f32x4 s4 = *(const f32x4*)(sc + c), h4 = *(const f32x4*)(sh + c);
        const f32x4 gs = gn[q] * (1.f + s4);
#pragma unroll
        for (int u = 0; u < 2; ++u) {
          const size_t t = t0 + u;
          const float rstd = rsqrtf(ss[u] * (1.f / 1024.f) + 1e-6f);
          *(f32x4*)((float*)(p.ws + O_XA) + t * 1024 + c) = xv[u][q];
          const f32x4 o = xv[u][q] * rstd * gs + h4;
          u32x2 pk; pk[0] = pack2(o[0], o[1]); pk[1] = pack2(o[2], o[3]);
          *(u32x2*)((u16*)(p.ws + O_H) + t * LDH + c) = pk;
        }
      }
    } else {
#pragma unroll
      for (int q = 0; q < 4; ++q) {
        const int c = (q >> 1) * 512 + lane * 8 + (q & 1) * 4;
#pragma unroll
        for (int u = 0; u < 2; ++u) {
          const size_t t = t0 + u;
          const float rstd = rsqrtf(ss[u] * (1.f / 1024.f) + 1e-6f);
          *(f32x4*)(p.out + t * 1024 + c) = xv[u][q] * rstd * gn[q];
        }
      }
    }
  }
}


#define STAGE(call) { const Params p = mkctx(a); call; }

#define XB_TMO      128
#define XB_XCNT(j)  (256  + 64 * (j))
#define XB_XSUB(j)  (1280 + 64 * (j))
#define XB_XGEN(j)  (2304 + 64 * (j))
#define XB_TOP      3328
#define XB_TOPGEN   3392
#define XCD_BAR_WORDS 3456
#define XB_SPIN_CAP (1u << 20)
#define LAS __attribute__((address_space(3)))
DEVI unsigned xb_ld(unsigned* p)              { return __hip_atomic_load(p, __ATOMIC_RELAXED, __HIP_MEMORY_SCOPE_AGENT); }
DEVI unsigned xb_add(unsigned* p, unsigned v) { return __hip_atomic_fetch_add(p, v, __ATOMIC_RELAXED, __HIP_MEMORY_SCOPE_AGENT); }
DEVI unsigned xb_xcc_id() { return (unsigned)__builtin_amdgcn_s_getreg((3 << 11) | 20) & 0xFu; }
#define XB_SPIN(cond, bar) do { unsigned _sp = 0; while (cond) { __builtin_amdgcn_s_sleep(1); \
    if ((++_sp & 255u) == 0u) { if (xb_ld(&(bar)[XB_TMO])) break; if (_sp > XB_SPIN_CAP) { atomicAdd(&(bar)[XB_TMO], 1u); break; } } } } while (0)
struct XcdBarrier { unsigned* bar; unsigned x; volatile LAS unsigned* st; };
DEVI XcdBarrier xcd_barrier_post(unsigned* bar, volatile LAS unsigned* st) {
  XcdBarrier b; b.bar = bar; b.x = xb_xcc_id(); b.st = st;
  if (threadIdx.x == 0) (void)xb_add(&bar[XB_XCNT(b.x)], 1u);
  return b;
}
DEVI void xcd_barrier_complete(unsigned* bar, unsigned x, unsigned& nloc, unsigned& nx) {
  const unsigned G = gridDim.x * gridDim.y * gridDim.z;
  unsigned sum, cnt, mine, sp = 0u;
  for (;;) {
    sum = 0u; cnt = 0u; mine = 0u;
#pragma unroll
    for (unsigned j = 0; j < 16; ++j) { const unsigned c = xb_ld(&bar[XB_XCNT(j)]); sum += c; cnt += (c > 0u) ? 1u : 0u; mine = (j == x) ? c : mine; }
    if (sum == G) break;
    __builtin_amdgcn_s_sleep(1);
    if ((++sp & 255u) == 0u) { if (xb_ld(&bar[XB_TMO])) break; if (sp > XB_SPIN_CAP) { atomicAdd(&bar[XB_TMO], 1u); break; } }
  }
  nloc = mine > 0u ? mine : 1u; nx = cnt > 0u ? cnt : 1u;
}
DEVI void xcd_barrier(const XcdBarrier& b) {
  asm volatile("s_waitcnt vmcnt(0)" ::: "memory");
  __syncthreads();
  if (threadIdx.x == 0) {
    unsigned* bar = b.bar;
    __builtin_amdgcn_s_waitcnt(0);
    unsigned nloc = b.st[0], nx = b.st[1];
    if (nloc == 0u) { xcd_barrier_complete(bar, b.x, nloc, nx); b.st[0] = nloc; b.st[1] = nx; }
    const unsigned old = xb_add(&bar[XB_XSUB(b.x)], 1u);
    const unsigned gen = old / nloc;
    if (old + 1u == (gen + 1u) * nloc) {
      __builtin_amdgcn_fence(__ATOMIC_RELEASE, "agent");
      asm volatile("s_waitcnt vmcnt(0)" ::: "memory");
      const unsigned og = xb_add(&bar[XB_TOP], 1u);
      const unsigned tg = og / nx;
      if (og + 1u == (tg + 1u) * nx) xb_add(&bar[XB_TOPGEN], 1u);
      else XB_SPIN(xb_ld(&bar[XB_TOPGEN]) == tg, bar);
      __builtin_amdgcn_fence(__ATOMIC_ACQUIRE, "agent");
      xb_add(&bar[XB_XGEN(b.x)], 1u);
      asm volatile("s_waitcnt vmcnt(0)" ::: "memory");
    } else {
      XB_SPIN(xb_ld(&bar[XB_XGEN(b.x)]) == gen, bar);
      __builtin_amdgcn_fence(__ATOMIC_ACQUIRE, "agent");
      asm volatile("s_waitcnt vmcnt(0)" ::: "memory");
    }
  }
  __syncthreads();
}
#define GSYNC() { XcdBarrier xb_; xb_.bar = (unsigned*)(mkctx(a).ws + O_XBAR); xb_.x = xb_xcc_id(); xb_.st = (volatile LAS unsigned*)(smem + SMEM_BYTES - 32); xcd_barrier(xb_); }

__global__ void __launch_bounds__(256, 2) mega(KArgs a) {
  extern __shared__ __attribute__((aligned(16))) char smem[];
  cg::grid_group grid = cg::this_grid();
  const int vb = blockIdx.x, nvb = gridDim.x;
  volatile LAS unsigned* xst = (volatile LAS unsigned*)(smem + SMEM_BYTES - 32);
  if (threadIdx.x == 0) { xst[0] = 0u; xst[1] = 0u; }
  __syncthreads();
  (void)xcd_barrier_post((unsigned*)(a.ws + O_XBAR), xst);
  if (threadIdx.x == 0) {
    const float** tab = (const float**)(a.ws + O_TAB);
#pragma unroll
    for (int i = 0; i < 35; ++i) tab[i] = a.in[i];
  }
  __syncthreads();
  STAGE(st_rope_table(p, vb, nvb));
  STAGE(st_mod(p, vb, nvb, smem));
  STAGE(st_prep_w1(p, 0, vb, nvb, smem));
  if (a.ws == nullptr) grid.sync();
  GSYNC();
  for (int l = 0; l < 2; ++l) {
    if (l == 0) { STAGE(st_norm1(p, 0, vb, nvb)); GSYNC(); }
    {
      const int g = vb & 7;
      for (int i = vb >> 3; i < 363; i += nvb >> 3) {
        int mt, nt;
        if (i < 264) { mt = i >> 1; nt = g + 8 * (i & 1); }
        else { const int j = i - 264, pc = g + 8 * (j / 33); nt = 16 + (pc >> 2); mt = (pc & 3) * 33 + (j % 33); }
        const Params p = mkctx(a); inproj_item(p, mt * 22 + nt, smem);
      }
    }
    GSYNC();
    STAGE(st_tokprep(p, l, vb, nvb));
    GSYNC();
    {
      for (int item = vb; item < 132 * 7 + NGITEM; item += nvb) {
        const Params p = mkctx(a);
        if (item < 132 * 7) mla_up_tile(p, item / 7, item % 7, smem);
        else gdn_chunk_item(p, item - 132 * 7, smem);
      }
    }
    GSYNC();
    st_mixer_queue(a, l, smem);
    GSYNC();
    STAGE(st_mix_finish(p, l, vb, nvb));
    GSYNC();
    STAGE(st_outproj(p, l, vb, nvb, smem));
    GSYNC();
    STAGE(st_norm2_route(p, l, vb, nvb, smem));
    GSYNC();
    STAGE(st_moe1(p, l, vb, nvb, smem));
    GSYNC();
    STAGE(st_moe2(p, l, vb, nvb, smem));
    GSYNC();
    if (l == 0) STAGE(st_prep_w1(p, 1, vb, nvb, smem));
    STAGE(st_combine(p, l, vb, nvb));
    if (l == 0) GSYNC();
  }
}

extern "C" void kernel_launch(void* const* d_in, const int* in_sizes, int n_in, void* d_out, int out_size, void* d_ws, size_t ws_size,
                              hipStream_t stream) {
  static int grid_blocks = 0;
  if (!grid_blocks) {
    int dev = 0, cus = 0, per_cu = 0;
    (void)hipGetDevice(&dev);
    (void)hipDeviceGetAttribute(&cus, hipDeviceAttributeMultiprocessorCount, dev);
    (void)hipFuncSetAttribute((const void*)mega, hipFuncAttributeMaxDynamicSharedMemorySize, SMEM_BYTES);
    (void)hipOccupancyMaxActiveBlocksPerMultiprocessor(&per_cu, mega, 256, SMEM_BYTES);
    if (per_cu > 2) per_cu = 2;
    if (per_cu < 1) per_cu = 1;
    grid_blocks = cus * per_cu;
  }
  KArgs p{};
  for (int i = 0; i < 35; ++i) p.in[i] = (const float*)d_in[i];
  p.out = (float*)d_out; p.ws = (char*)d_ws;
  if (ws_size < WS_NEED) { fprintf(stderr, "workspace too small: %zu < %zu\n", ws_size, (size_t)WS_NEED); return; }
  (void)hipMemsetAsync((char*)d_ws + O_BAR, 0, 256 + 16384, stream);
  void* args[] = {&p};
  hipError_t e = hipLaunchCooperativeKernel((void*)mega, dim3(grid_blocks), dim3(256), args, SMEM_BYTES, stream);
  if (e != hipSuccess) fprintf(stderr, "cooperative launch failed: %s (grid %d)\n", hipGetErrorString(e), grid_blocks);
}
```

```cpp
#include <hip/hip_runtime.h>
#include <hip/hip_cooperative_groups.h>
#include <cstdio>
#include <cstdint>
namespace cg = cooperative_groups;

#define DEVI __device__ __forceinline__
typedef unsigned short u16;
using bf16x8 = __attribute__((ext_vector_type(8))) short;
using f32x4  = __attribute__((ext_vector_type(4))) float;
using f32x2  = __attribute__((ext_vector_type(2))) float;
using f32x16 = __attribute__((ext_vector_type(16))) float;
using u32x4 = __attribute__((ext_vector_type(4))) unsigned;
using u32x2 = __attribute__((ext_vector_type(2))) unsigned;
typedef __bf16 bf16x2_t __attribute__((ext_vector_type(2)));

constexpr int DM = 1024, SEQ = 8192, CTXL = 256, NKEY = SEQ + CTXL;
constexpr int TL = 2 * SEQ, TC = 2 * CTXL, T = TL + TC;
constexpr int INW = 2672;
constexpr int NIN = 2816;
constexpr int LDPP = 1408;
constexpr int PP_CQ = 0, PP_CKV = 192, PP_DQKV = 320, PP_DZ = 1088, PP_GATE = 1344;
constexpr int NE = 64, NSLOT = 6 * T;
constexpr int LDW = 1088;
constexpr int LDH = 1088;
constexpr int NCHUNK = T / 64;
constexpr int NGITEM = NCHUNK * 8;
constexpr float LOG2E = 1.4426950408889634f;

constexpr size_t al256(size_t x) { return (x + 255) & ~(size_t)255; }
constexpr size_t O_MOD   = 0;
constexpr size_t O_ROPE  = O_MOD + al256((size_t)2 * 3 * 6144 * 4);
constexpr size_t O_XA    = O_ROPE + (size_t)SEQ * 48 * 8;
constexpr size_t O_H     = O_XA + (size_t)T * DM * 4;
constexpr size_t O_WINT  = O_H + (size_t)T * LDH * 2;
constexpr size_t O_WOUTT = O_WINT + (size_t)NIN * LDW * 2;
constexpr size_t O_WUQT  = O_WOUTT + (size_t)1024 * LDW * 2;
constexpr size_t O_WUKVT = O_WUQT + (size_t)384 * 192 * 2;
constexpr size_t O_WGUT  = O_WUKVT + (size_t)512 * 128 * 2;
constexpr size_t O_WDT   = O_WGUT + (size_t)65 * 512 * LDW * 2;
constexpr size_t O_WTS   = O_WDT + (size_t)65 * 1024 * 256 * 2;
constexpr size_t O_CNT   = O_WTS + al256((size_t)NSLOT * 4);
constexpr size_t O_TAB   = O_CNT + 256;
constexpr size_t O_BAR   = O_TAB + 512;
constexpr size_t O_XBAR  = O_BAR + 256;
constexpr size_t O_LIST  = O_XBAR + 16384;
constexpr size_t O_R     = O_LIST + (size_t)NE * T * 4;
constexpr size_t O_Y     = O_R;
constexpr size_t O_PP    = O_Y + (size_t)T * DM * 2;
constexpr size_t O_QA    = O_PP + (size_t)T * LDPP * 2;
constexpr size_t O_KA    = O_QA + (size_t)2 * 4 * NKEY * 64 * 2;
constexpr size_t O_VTA   = O_KA + (size_t)2 * 2 * NKEY * 64 * 2;
constexpr size_t O_QB    = O_VTA + (size_t)2 * 2 * NKEY * 64 * 2;
constexpr size_t O_KB    = O_QB + (size_t)2 * 8 * NKEY * 32 * 2;
constexpr size_t O_VTB   = O_KB + (size_t)2 * 8 * NKEY * 32 * 2;
constexpr size_t O_QC    = O_VTB + (size_t)2 * 4 * NKEY * 64 * 2;
constexpr size_t O_KC    = O_QC + (size_t)2 * 4 * NKEY * 96 * 2;
constexpr size_t O_VTC   = O_KC + (size_t)2 * 4 * NKEY * 96 * 2;
constexpr size_t O_CQN   = O_VTC + (size_t)2 * 4 * NKEY * 64 * 2;
constexpr size_t O_CKVN  = O_CQN + (size_t)T * 192 * 2;
constexpr size_t O_OB    = O_CKVN + (size_t)T * 128 * 2;
constexpr size_t O_GQ    = O_OB + (size_t)T * 512 * 2;
constexpr size_t O_GK    = O_GQ + (size_t)T * 256 * 2;
constexpr size_t O_GV    = O_GK + (size_t)T * 256 * 2;
constexpr size_t O_GG    = O_GV + (size_t)T * 256 * 2;
constexpr size_t O_GBETA = O_GG + (size_t)2 * T * 4 * 4;
constexpr size_t O_GM    = O_GBETA + (size_t)2 * T * 4 * 4;
constexpr size_t O_GQP   = O_GM + (size_t)NGITEM * 4096 * 2;
constexpr size_t O_GN    = O_GQP + (size_t)NGITEM * 4096 * 2;
constexpr size_t O_GLO   = O_GN + (size_t)NGITEM * 4096 * 2;
constexpr size_t O_GO    = O_GLO + (size_t)NGITEM * 4096 * 2;
constexpr size_t O_MIX_END = O_GO + (size_t)2 * T * 256 * 4;
constexpr size_t O_HB    = O_R;
constexpr size_t O_SLOT  = O_HB + (size_t)7 * T * 256 * 2;
constexpr size_t O_MOE_END = O_SLOT + (size_t)7 * T * 1024 * 2;
constexpr size_t cmax(size_t a, size_t b) { return a > b ? a : b; }
constexpr size_t WS_NEED = cmax(O_MIX_END, O_MOE_END);
static_assert(WS_NEED < (size_t)556000000, "workspace too large");

struct KArgs {
  const float* in[35];
  float* out;
  char* ws;
};
typedef const __attribute__((address_space(1))) float gcfloat;
struct Params {
  char* ws;
  float* out;
  gcfloat* const* in;
  int tid;
};
#define pin(p, i) ((const float*)(p).in[i])
enum { I_X = 0, I_C, I_CTX, I_CCTX, I_WADA, I_BADA, I_N1G, I_N2G, I_WIN, I_WOUT, I_SINK, I_LQ1, I_LK1, I_LQ2, I_LK2,
       I_DNG, I_MQG, I_MKVG, I_WUQ, I_WUKV, I_CONVW, I_ALF, I_ALB, I_DTF, I_DTB, I_GNG, I_WR, I_RB, I_WG, I_WU, I_WD,
       I_SG, I_SU, I_SD, I_FNG };

DEVI u16 f2bf(float f) { unsigned u = __float_as_uint(f); u += 0x7fffu + ((u >> 16) & 1u); return (u16)(u >> 16); }
DEVI float bf2f(u16 h) { return __uint_as_float(((unsigned)h) << 16); }
DEVI float bflo(unsigned v) { return __uint_as_float(v << 16); }
DEVI float bfhi(unsigned v) { return __uint_as_float(v & 0xffff0000u); }
DEVI unsigned pack2(float a, float b) { f32x2 v = {a, b}; return __builtin_bit_cast(unsigned, __builtin_convertvector(v, bf16x2_t)); }
DEVI f32x4 fzero4() { float z = 0.f; asm volatile("" : "+v"(z)); return f32x4{z, z, z, z}; }
DEVI float wave_sum(float v) {
#pragma unroll
  for (int o = 32; o >= 1; o >>= 1) v += __shfl_xor(v, o);
  return v;
}
DEVI float half_sum(float v) {
#pragma unroll
  for (int o = 16; o >= 1; o >>= 1) v += __shfl_xor(v, o);
  return v;
}
DEVI float siluf(float x) { return x / (1.f + __expf(-x)); }
DEVI float sigmf(float x) { return 1.f / (1.f + __expf(-x)); }
DEVI int tok_mv(int t) { return t < TL ? (t >> 13) : 2; }
DEVI int tok_b(int t) { return t < TL ? (t >> 13) : ((t - TL) >> 8); }
DEVI int tok_row(int t) { return t < TL ? (t & (SEQ - 1)) : (SEQ + ((t - TL) & (CTXL - 1))); }
DEVI const float* modp(const Params& p, int l, int mv, int j) { return (const float*)(p.ws + O_MOD) + ((size_t)(l * 3 + mv) * 6 + j) * 1024; }

#define MFMA16(a, b, c) __builtin_amdgcn_mfma_f32_16x16x32_bf16((a), (b), (c), 0, 0, 0)
#define MFMA32(a, b, c) __builtin_amdgcn_mfma_f32_32x32x16_bf16((a), (b), (c), 0, 0, 0)

DEVI void st_copy_in(const Params& p, int vb, int nvb) {
  float4* xa = (float4*)(p.ws + O_XA);
  const float4* x = (const float4*)pin(p, I_X);
  const float4* cx = (const float4*)pin(p, I_CTX);
  const size_t n4 = (size_t)T * DM / 4, nl4 = (size_t)TL * DM / 4;
  for (size_t i = (size_t)vb * 256 + p.tid; i < n4; i += (size_t)nvb * 256) xa[i] = i < nl4 ? x[i] : cx[i - nl4];
}
DEVI void rope_cs(int i, int half, int s, float& c, float& sn) {
  const int quarter = half >> 1;
  const int ii = i < quarter ? i : i - quarter;
  const float pos = i < quarter ? (float)(s >> 6) : (float)(s & 63);
  const float inv = powf(10000.f, -(float)ii / (float)quarter);
  const float ang = pos * inv;
  c = cosf(ang); sn = sinf(ang);
}
DEVI void st_rope_table(const Params& p, int vb, int nvb) {
  f32x2* R = (f32x2*)(p.ws + O_ROPE);
  for (int e = vb * 256 + p.tid; e < SEQ * 48; e += nvb * 256) {
    const int s = e / 48, i = e % 48;
    float c, sn;
    if (i < 32) rope_cs(i, 32, s, c, sn); else rope_cs(i - 32, 16, s, c, sn);
    R[e] = f32x2{c, sn};
  }
}
DEVI void st_mod(const Params& p, int vb, int nvb, char* smem) {
  float* sv = (float*)smem;
  float* red = sv + 3 * 1024;
  for (int i = p.tid; i < 3 * 1024; i += 256) {
    int v = i >> 10, k = i & 1023;
    float c = v < 2 ? pin(p, I_C)[v * 1024 + k] : pin(p, I_CCTX)[k];
    sv[i] = siluf(c);
  }
  __syncthreads();
  const int cgp = p.tid & 7, kg = p.tid >> 3;
  for (int item = vb; item < 2 * 192; item += nvb) {
    const int l = item / 192, c0 = (item % 192) * 32;
    const float* w = pin(p, I_WADA) + (size_t)l * 1024 * 6144 + c0 + cgp * 4;
    f32x4 a0 = fzero4(), a1 = a0, a2 = a0;
#pragma unroll 8
    for (int kk = 0; kk < 32; ++kk) {
      const int k = kg * 32 + kk;
      const f32x4 wv = *(const f32x4*)(w + (size_t)k * 6144);
      a0 += sv[k] * wv; a1 += sv[1024 + k] * wv; a2 += sv[2048 + k] * wv;
    }
    float* rp = red + (kg * 8 + cgp) * 12;
    *(f32x4*)rp = a0; *(f32x4*)(rp + 4) = a1; *(f32x4*)(rp + 8) = a2;
    __syncthreads();
    if (p.tid < 96) {
      const int v = p.tid >> 5, c = p.tid & 31;
      float s = 0.f;
#pragma unroll 8
      for (int g = 0; g < 32; ++g) s += red[(g * 8 + (c >> 2)) * 12 + v * 4 + (c & 3)];
      ((float*)(p.ws + O_MOD))[(size_t)(l * 3 + v) * 6144 + c0 + c] = s + pin(p, I_BADA)[l * 6144 + c0 + c];
    }
    __syncthreads();
  }
}

template <class RowFn>
DEVI void tr_tile(int tid, const float* __restrict__ src, int N, u16* __restrict__ dst, int ldd, RowFn drow, int k0, int n0, float* tile) {
  {
    const int kq = tid >> 4, n4 = (tid & 15) * 4;
    f32x4 v[4];
#pragma unroll
    for (int r = 0; r < 4; ++r) {
      const int k = r * 16 + kq;
      v[r] = n0 + n4 < N ? *(const f32x4*)(src + (size_t)(k0 + k) * N + n0 + n4) : fzero4();
    }
#pragma unroll
    for (int r = 0; r < 4; ++r) {
      const int k = r * 16 + kq;
      tile[k * 65 + n4] = v[r][0]; tile[k * 65 + n4 + 1] = v[r][1]; tile[k * 65 + n4 + 2] = v[r][2]; tile[k * 65 + n4 + 3] = v[r][3];
    }
  }
  __syncthreads();
  {
    const int n = tid >> 2, kc = (tid & 3) * 16;
    const int dr = drow(n0 + n);
    if (dr >= 0) {
      u32x4 o0, o1;
#pragma unroll
      for (int e = 0; e < 4; ++e) {
        o0[e] = pack2(tile[(kc + 2 * e) * 65 + n], tile[(kc + 2 * e + 1) * 65 + n]);
        o1[e] = pack2(tile[(kc + 8 + 2 * e) * 65 + n], tile[(kc + 8 + 2 * e + 1) * 65 + n]);
      }
      u16* d = dst + (size_t)dr * ldd + k0 + kc;
      *(u32x4*)d = o0; *(u32x4*)(d + 8) = o1;
    }
  }
  __syncthreads();
}
DEVI int win_row(int n) {
  if (n < 1280) return n;
  if (n < 1600) return 1408 + (n - 1280);
  if (n < 1632) return 1280 + (n - 1600);
  if (n < INW) return 1408 + 320 + (n - 1632);
  return -1;
}
constexpr int TR_IN = 16 * 42, TR_OUT = 256, TR_UQ = 18, TR_UKV = 16, TR_E = 4096, TR_S = 64;
constexpr int TR_P1 = TR_IN + TR_OUT + TR_UQ + TR_UKV;
constexpr int TR_P2 = 3 * TR_E + 3 * TR_S;
DEVI void prep_w1_tile(const Params& p, int l, int it, float* tile) {
  if (it < TR_IN) { tr_tile(p.tid, pin(p, I_WIN) + (size_t)l * 1024 * INW, INW, (u16*)(p.ws + O_WINT), LDW, [](int n) { return win_row(n); }, (it / 42) * 64, (it % 42) * 64, tile); return; }
  it -= TR_IN;
  if (it < TR_OUT) { tr_tile(p.tid, pin(p, I_WOUT) + (size_t)l * 1024 * 1024, 1024, (u16*)(p.ws + O_WOUTT), LDW, [](int n) { return n; }, (it / 16) * 64, (it % 16) * 64, tile); return; }
  it -= TR_OUT;
  if (it < TR_UQ) { tr_tile(p.tid, pin(p, I_WUQ) + (size_t)l * 192 * 384, 384, (u16*)(p.ws + O_WUQT), 192, [](int n) { return n; }, (it / 6) * 64, (it % 6) * 64, tile); return; }
  it -= TR_UQ;
  tr_tile(p.tid, pin(p, I_WUKV) + (size_t)l * 128 * 512, 512, (u16*)(p.ws + O_WUKVT), 128,
          [](int n) { const int h = n >> 7, j = n & 127; return j < 64 ? h * 64 + j : 256 + h * 64 + (j - 64); }, (it / 8) * 64, (it % 8) * 64, tile);
}
DEVI void prep_w2_tile(const Params& p, int l, int it, float* tile) {
  if (it < 2 * TR_E) {
    const int which = it / TR_E; it %= TR_E;
    const int e = it >> 6, tt = it & 63;
    const float* src = pin(p, which ? I_WU : I_WG) + ((size_t)l * NE + e) * 1024 * 256;
    tr_tile(p.tid, src, 256, (u16*)(p.ws + O_WGUT) + (size_t)e * 512 * LDW, LDW, [which](int n) { return 2 * n + which; }, (tt >> 2) * 64, (tt & 3) * 64, tile); return;
  }
  it -= 2 * TR_E;
  if (it < TR_E) {
    const int e = it >> 6, tt = it & 63;
    const float* src = pin(p, I_WD) + ((size_t)l * NE + e) * 256 * 1024;
    tr_tile(p.tid, src, 1024, (u16*)(p.ws + O_WDT) + (size_t)e * 1024 * 256, 256, [](int n) { return n; }, (tt >> 4) * 64, (tt & 15) * 64, tile); return;
  }
  it -= TR_E;
  if (it < 2 * TR_S) {
    const int which = it / TR_S; const int tt = it % TR_S;
    const float* src = pin(p, which ? I_SU : I_SG) + (size_t)l * 1024 * 256;
    tr_tile(p.tid, src, 256, (u16*)(p.ws + O_WGUT) + (size_t)64 * 512 * LDW, LDW, [which](int n) { return 2 * n + which; }, (tt >> 2) * 64, (tt & 3) * 64, tile); return;
  }
  it -= 2 * TR_S;
  { const int tt = it;
    const float* src = pin(p, I_SD) + (size_t)l * 256 * 1024;
    tr_tile(p.tid, src, 1024, (u16*)(p.ws + O_WDT) + (size_t)64 * 1024 * 256, 256, [](int n) { return n; }, (tt >> 4) * 64, (tt & 15) * 64, tile); }
}
struct TrDesc { const float* src; u16* dst; int N, ldd, rs, ro, k0, n0; };
DEVI TrDesc w2_desc(const Params& p, int l, int it) {
  TrDesc d;
  if (it < 2 * TR_E) {
    const int which = it / TR_E; it %= TR_E;
    const int e = it >> 6, tt = it & 63;
    d.src = pin(p, which ? I_WU : I_WG) + ((size_t)l * NE + e) * 1024 * 256; d.N = 256;
    d.dst = (u16*)(p.ws + O_WGUT) + (size_t)e * 512 * LDW; d.ldd = LDW; d.rs = 2; d.ro = which; d.k0 = (tt >> 2) * 64; d.n0 = (tt & 3) * 64;
    return d;
  }
  it -= 2 * TR_E;
  if (it < TR_E) {
    const int e = it >> 6, tt = it & 63;
    d.src = pin(p, I_WD) + ((size_t)l * NE + e) * 256 * 1024; d.N = 1024;
    d.dst = (u16*)(p.ws + O_WDT) + (size_t)e * 1024 * 256; d.ldd = 256; d.rs = 1; d.ro = 0; d.k0 = (tt >> 4) * 64; d.n0 = (tt & 15) * 64;
    return d;
  }
  it -= TR_E;
  if (it < 2 * TR_S) {
    const int which = it / TR_S; const int tt = it % TR_S;
    d.src = pin(p, which ? I_SU : I_SG) + (size_t)l * 1024 * 256; d.N = 256;
    d.dst = (u16*)(p.ws + O_WGUT) + (size_t)64 * 512 * LDW; d.ldd = LDW; d.rs = 2; d.ro = which; d.k0 = (tt >> 2) * 64; d.n0 = (tt & 3) * 64;
    return d;
  }
  it -= 2 * TR_S;
  d.src = pin(p, I_SD) + (size_t)l * 256 * 1024; d.N = 1024;
  d.dst = (u16*)(p.ws + O_WDT) + (size_t)64 * 1024 * 256; d.ldd = 256; d.rs = 1; d.ro = 0; d.k0 = (it >> 4) * 64; d.n0 = (it & 15) * 64;
  return d;
}
DEVI void tr_load(int tid, const TrDesc& d, f32x4 (&v)[4]) {
  const int kq = tid >> 4, n4 = (tid & 15) * 4;
#pragma unroll
  for (int r = 0; r < 4; ++r) v[r] = *(const f32x4*)(d.src + (size_t)(d.k0 + r * 16 + kq) * d.N + d.n0 + n4);
}
DEVI void tr_process(int tid, const TrDesc& d, const f32x4 (&v)[4], float* tile) {
  {
    const int kq = tid >> 4, n4 = (tid & 15) * 4;
#pragma unroll
    for (int r = 0; r < 4; ++r) {
      const int k = r * 16 + kq;
      tile[k * 65 + n4] = v[r][0]; tile[k * 65 + n4 + 1] = v[r][1]; tile[k * 65 + n4 + 2] = v[r][2]; tile[k * 65 + n4 + 3] = v[r][3];
    }
  }
  __syncthreads();
  {
    const int n = tid >> 2, kc = (tid & 3) * 16;
    u32x4 o0, o1;
#pragma unroll
    for (int e = 0; e < 4; ++e) {
      o0[e] = pack2(tile[(kc + 2 * e) * 65 + n], tile[(kc + 2 * e + 1) * 65 + n]);
      o1[e] = pack2(tile[(kc + 8 + 2 * e) * 65 + n], tile[(kc + 8 + 2 * e + 1) * 65 + n]);
    }
    u16* o = d.dst + (size_t)((d.n0 + n) * d.rs + d.ro) * d.ldd + d.k0 + kc;
    *(u32x4*)o = o0; *(u32x4*)(o + 8) = o1;
  }
  __syncthreads();
}
DEVI void prep_w2_run8(const Params& p, int l, int it0, float* tile) {
  f32x4 va[4], vb4[4];
  TrDesc da = w2_desc(p, l, it0), db = da;
  __syncthreads();
  tr_load(p.tid, da, va);
#pragma unroll 1
  for (int k = 0; k < 8; k += 2) {
    db = w2_desc(p, l, it0 + k + 1);
    tr_load(p.tid, db, vb4);
    tr_process(p.tid, da, va, tile);
    if (k + 2 < 8) { da = w2_desc(p, l, it0 + k + 2); tr_load(p.tid, da, va); }
    tr_process(p.tid, db, vb4, tile);
  }
}
DEVI void st_prep_w1(const Params& p, int l, int vb, int nvb, char* smem) {
  float* tile = (float*)smem;
  if (vb == 0 && p.tid < 64) ((int*)(p.ws + O_CNT))[p.tid] = 0;
  for (int e = vb * 256 + p.tid; e < 144 * 128; e += nvb * 256) {
    const int r = e >> 7, c8 = e & 127;
    const int row = r < 96 ? 1312 + r : 2768 + (r - 96);
    *(u32x4*)((u16*)(p.ws + O_WINT) + (size_t)row * LDW + c8 * 8) = __builtin_bit_cast(u32x4, fzero4());
  }
  for (int item = vb; item < TR_P1; item += nvb) prep_w1_tile(p, l, item, tile);
}

DEVI void st_norm1(const Params& p, int l, int vb, int nvb) {
  const int lane = p.tid & 63, wid = p.tid >> 6;
  const float* g = pin(p, I_N1G) + l * 1024;
  for (int t4 = (vb * 4 + wid) * 4; t4 < T; t4 += nvb * 16) {
    const int mv = tok_mv(t4);
    const float* sh = modp(p, l, mv, 0); const float* sc = modp(p, l, mv, 1);
    f32x4 v[4][4]; float ss[4];
#pragma unroll
    for (int u = 0; u < 4; ++u) {
      const int t = t4 + u;
      const f32x4* xr = (const f32x4*)(t < TL ? pin(p, I_X) + (size_t)t * 1024 : pin(p, I_CTX) + (size_t)(t - TL) * 1024);
#pragma unroll
      for (int i = 0; i < 4; ++i) v[u][i] = xr[i * 64 + lane];
    }
#pragma unroll
    for (int u = 0; u < 4; ++u) {
      float a = 0.f;
#pragma unroll
      for (int i = 0; i < 4; ++i) a += v[u][i][0] * v[u][i][0] + v[u][i][1] * v[u][i][1] + v[u][i][2] * v[u][i][2] + v[u][i][3] * v[u][i][3];
      ss[u] = a;
    }
#pragma unroll
    for (int o = 32; o >= 1; o >>= 1) {
#pragma unroll
      for (int u = 0; u < 4; ++u) ss[u] += __shfl_xor(ss[u], o);
    }
#pragma unroll
    for (int i = 0; i < 4; ++i) {
      const int c = i * 256 + lane * 4;
      const f32x4 gg = *(const f32x4*)(g + c), s4 = *(const f32x4*)(sc + c), h4 = *(const f32x4*)(sh + c);
      const f32x4 gs = gg * (1.f + s4);
#pragma unroll
      for (int u = 0; u < 4; ++u) {
        const float rstd = rsqrtf(ss[u] * (1.f / 1024.f) + 1e-6f);
        const f32x4 o = v[u][i] * rstd * gs + h4;
        u32x2 pk; pk[0] = pack2(o[0], o[1]); pk[1] = pack2(o[2], o[3]);
        *(u32x2*)((u16*)(p.ws + O_H) + (size_t)(t4 + u) * LDH + c) = pk;
      }
    }
  }
}

constexpr int GLD = 72;
typedef const __attribute__((address_space(1))) unsigned gcu32;
typedef __attribute__((address_space(3))) unsigned lu32;
DEVI int bperm_row(int BP, int n, int fr) {
  return BP == 0 ? n * 16 + fr : BP == 1 ? (n >> 1) * 32 + (fr >> 2) * 8 + (n & 1) * 4 + (fr & 3) : (fr >> 2) * 16 + n * 4 + (fr & 3);
}
DEVI int bperm_swz(int BP, int R) { return BP == 0 ? (R & 7) : BP == 1 ? ((R & 3) | ((R >> 1) & 4)) : ((R & 3) | ((R >> 2) & 4)); }
template <bool SWAP, int BP = 0, bool AP = false, class ARow>
DEVI void gemm_core(int tid, ARow arow, const u16* __restrict__ Bt, int ldb, int K, f32x4 (&acc)[4][4], char* smem) {
  constexpr int TILE = 128 * 64;
  u16* sbuf = (u16*)smem;
  const int lane = tid & 63, wid = tid >> 6, wr = wid >> 1, wc = wid & 1, fr = lane & 15, fq = lane >> 4;
  const u16* ap[4]; const u16* bp[4];
#pragma unroll
  for (int i = 0; i < 4; ++i) {
    const int q = tid + 256 * i, row = q >> 3, cs = (q & 7) ^ (row & 7), csb = (q & 7) ^ bperm_swz(BP, row);
    ap[i] = arow(row) + cs * 8; bp[i] = Bt + (size_t)row * ldb + csb * 8;
  }
  const int nk = K >> 6;
  auto stage = [&](int kt, int buf) {
    int off = kt * 64; asm volatile("" : "+s"(off));
    u16* dA = sbuf + buf * 2 * TILE + tid * 8; u16* dB = dA + TILE;
#pragma unroll
    for (int i = 0; i < 4; ++i) {
      __builtin_amdgcn_global_load_lds((gcu32*)(ap[i] + off), (lu32*)(dA + i * 2048), 16, 0, 0);
      __builtin_amdgcn_global_load_lds((gcu32*)(bp[i] + off), (lu32*)(dB + i * 2048), 16, 0, 0);
    }
  };
  auto compute = [&](int buf) {
    const u16* sA = sbuf + buf * 2 * TILE; const u16* sB = sA + TILE;
#pragma unroll
    for (int ks = 0; ks < 2; ++ks) {
      bf16x8 af[4], bfr[4];
#pragma unroll
      for (int m = 0; m < 4; ++m) {
        int R = wr * 64 + m * 16 + fr;
        if (AP) { const int pos = (m >> 1) * 32 + (fr >> 2) * 8 + (m & 1) * 4 + (fr & 3), j = (pos >> 2) & 3; R = wr * 64 + ((pos & ~15) | ((((j & 1) << 1) | (j >> 1)) << 2) | (pos & 3)); }
        af[m] = *(const bf16x8*)&sA[R * 64 + (((ks * 4 + fq) ^ (R & 7)) << 3)];
      }
#pragma unroll
      for (int n = 0; n < 4; ++n) { const int R = wc * 64 + bperm_row(BP, n, fr); bfr[n] = *(const bf16x8*)&sB[R * 64 + (((ks * 4 + fq) ^ bperm_swz(BP, R)) << 3)]; }
#pragma unroll
      for (int m = 0; m < 4; ++m)
#pragma unroll
        for (int n = 0; n < 4; ++n) acc[m][n] = SWAP ? MFMA16(af[m], bfr[n], acc[m][n]) : MFMA16(bfr[n], af[m], acc[m][n]);
    }
  };
#pragma unroll
  for (int m = 0; m < 4; ++m)
#pragma unroll
    for (int n = 0; n < 4; ++n) acc[m][n] = fzero4();
  __syncthreads();
  stage(0, 0);
  asm volatile("s_waitcnt vmcnt(0)" ::: "memory");
  __syncthreads();
  for (int kt = 0; kt < nk; ++kt) {
    if (kt + 1 < nk) stage(kt + 1, (kt + 1) & 1);
    compute(kt & 1);
    asm volatile("s_waitcnt vmcnt(0)" ::: "memory");
    __syncthreads();
  }
}
template <class ARow, class Epi>
DEVI void gemm128(int tid, ARow arow, const u16* __restrict__ Bt, int ldb, int K, Epi epi, char* smem) {
  f32x4 acc[4][4];
  gemm_core<false>(tid, arow, Bt, ldb, K, acc, smem);
  const int lane = tid & 63, wid = tid >> 6, wr = wid >> 1, wc = wid & 1, fr = lane & 15, fq = lane >> 4;
#pragma unroll
  for (int m = 0; m < 4; ++m)
#pragma unroll
    for (int n = 0; n < 4; ++n) epi(wr * 64 + m * 16 + fr, wc * 64 + n * 16 + fq * 4, acc[m][n]);
}

DEVI void rope4(const f32x4 x1, const f32x4 x2, const f32x2* rp, bool lat, float scale, u32x2& o1, u32x2& o2) {
  f32x4 s = fzero4(), c = s + 1.f;
  if (lat) {
    const f32x4 a = *(const f32x4*)rp, b = *(const f32x4*)(rp + 2);
    c = f32x4{a[0], a[2], b[0], b[2]}; s = f32x4{a[1], a[3], b[1], b[3]};
  }
  const f32x4 y1 = (x1 * c - x2 * s) * scale, y2 = (x2 * c + x1 * s) * scale;
  o1[0] = pack2(y1[0], y1[1]); o1[1] = pack2(y1[2], y1[3]);
  o2[0] = pack2(y2[0], y2[1]); o2[1] = pack2(y2[2], y2[3]);
}
DEVI void inproj_item(const Params& p, int item, char* smem) {
  const u16* H = (const u16*)(p.ws + O_H); const u16* W = (const u16*)(p.ws + O_WINT);
  const f32x2* ROPE = (const f32x2*)(p.ws + O_ROPE);
  const int tid = p.tid, lane = tid & 63, wid = tid >> 6, wr = wid >> 1, wc = wid & 1, fr = lane & 15, fq = lane >> 4;
  {
    const int m0 = (item / 22) * 128, nt = item % 22;
    const bool lat = m0 < TL;
    const int b = tok_b(m0), rowbase = tok_row(m0);
    f32x4 acc[4][4];
    auto arow = [&](int r) { return H + (size_t)(m0 + r) * LDH; };
    if (nt == 3 || nt == 8 || nt == 9) {
      gemm_core<true, 0, true>(tid, arow, W + (size_t)nt * 128 * LDW, LDW, 1024, acc, smem);
      u16* vt = nt == 3 ? (u16*)(p.ws + O_VTA) + (size_t)(b * 2 + wc) * 64 * NKEY
                        : (u16*)(p.ws + O_VTB) + (size_t)(b * 4 + (nt - 8) * 2 + wc) * 64 * NKEY;
#pragma unroll
      for (int mh = 0; mh < 2; ++mh)
#pragma unroll
        for (int n = 0; n < 4; ++n) {
          u32x4 pk;
          pk[0] = pack2(acc[2 * mh][n][0], acc[2 * mh][n][1]); pk[1] = pack2(acc[2 * mh][n][2], acc[2 * mh][n][3]);
          pk[2] = pack2(acc[2 * mh + 1][n][0], acc[2 * mh + 1][n][1]); pk[3] = pack2(acc[2 * mh + 1][n][2], acc[2 * mh + 1][n][3]);
          *(u32x4*)(vt + (size_t)(n * 16 + fr) * NKEY + rowbase + wr * 64 + mh * 32 + fq * 8) = pk;
        }
      return;
    }
    if (nt < 3 || nt >= 11) gemm_core<false, 1>(tid, arow, W + (size_t)nt * 128 * LDW, LDW, 1024, acc, smem);
    else gemm_core<false>(tid, arow, W + (size_t)nt * 128 * LDW, LDW, 1024, acc, smem);
    if (nt < 3) {
      u16* dst; float scale;
      if (nt < 2) { dst = (u16*)(p.ws + O_QA) + ((size_t)(b * 4 + nt * 2 + wc) * NKEY + rowbase) * 64; scale = 0.125f * LOG2E; }
      else { dst = (u16*)(p.ws + O_KA) + ((size_t)(b * 2 + wc) * NKEY + rowbase) * 64; scale = 1.f; }
#pragma unroll
      for (int m = 0; m < 4; ++m) {
        const int rl = wr * 64 + m * 16 + fr;
        u32x2 a1, a2, b1, b2;
        rope4(acc[m][0], acc[m][2], ROPE + (size_t)(rowbase + rl) * 48 + fq * 8, lat, scale, a1, a2);
        rope4(acc[m][1], acc[m][3], ROPE + (size_t)(rowbase + rl) * 48 + fq * 8 + 4, lat, scale, b1, b2);
        *(u32x4*)(dst + (size_t)rl * 64 + fq * 8) = u32x4{a1[0], a1[1], b1[0], b1[1]};
        *(u32x4*)(dst + (size_t)rl * 64 + 32 + fq * 8) = u32x4{a2[0], a2[1], b2[0], b2[1]};
      }
    } else if (nt < 8) {
      const bool isq = nt < 6;
      u16* base = isq ? (u16*)(p.ws + O_QB) : (u16*)(p.ws + O_KB);
      const float scale = isq ? 0.17677669529663687f * LOG2E : 1.f;
      const int hm0 = ((nt - 4) & 1) * 4 + wc * 2;
#pragma unroll
      for (int m = 0; m < 4; ++m) {
        const int rl = wr * 64 + m * 16 + fr;
#pragma unroll
        for (int g = 0; g < 2; ++g) {
          u16* dst = base + ((size_t)(b * 8 + hm0 + g) * NKEY + rowbase + rl) * 32;
          u32x2 o1, o2;
          rope4(acc[m][2 * g], acc[m][2 * g + 1], ROPE + (size_t)(rowbase + rl) * 48 + 32 + fq * 4, lat, scale, o1, o2);
          *(u32x2*)(dst + fq * 4) = o1; *(u32x2*)(dst + 16 + fq * 4) = o2;
        }
      }
    } else if (nt == 10) {
      if (wc == 0) {
#pragma unroll
        for (int m = 0; m < 4; ++m) {
          const int rl = wr * 64 + m * 16 + fr;
          u32x2 o1, o2;
          rope4(acc[m][0], acc[m][1], ROPE + (size_t)(rowbase + rl) * 48 + 32 + fq * 4, lat, 1.f, o1, o2);
#pragma unroll
          for (int h = 0; h < 4; ++h) {
            u16* dst = (u16*)(p.ws + O_KC) + ((size_t)(b * 4 + h) * NKEY + rowbase + rl) * 96 + 64;
            *(u32x2*)(dst + fq * 4) = o1; *(u32x2*)(dst + 16 + fq * 4) = o2;
          }
        }
      }
    } else {
      u16* PP = (u16*)(p.ws + O_PP);
#pragma unroll
      for (int m = 0; m < 4; ++m)
#pragma unroll
        for (int h = 0; h < 2; ++h) {
          u32x4 pk;
          pk[0] = pack2(acc[m][2 * h][0], acc[m][2 * h][1]); pk[1] = pack2(acc[m][2 * h][2], acc[m][2 * h][3]);
          pk[2] = pack2(acc[m][2 * h + 1][0], acc[m][2 * h + 1][1]); pk[3] = pack2(acc[m][2 * h + 1][2], acc[m][2 * h + 1][3]);
          *(u32x4*)(PP + (size_t)(m0 + wr * 64 + m * 16 + fr) * LDPP + (nt - 11) * 128 + wc * 64 + h * 32 + fq * 8) = pk;
        }
    }
  }
}

DEVI void st_tokprep(const Params& p, int l, int vb, int nvb) {
  const int lane = p.tid & 63, wid = p.tid >> 6;
  const u16* PP = (const u16*)(p.ws + O_PP);
  u16* GQ = (u16*)(p.ws + O_GQ); u16* GK = (u16*)(p.ws + O_GK); u16* GV = (u16*)(p.ws + O_GV);
  float* GG = (float*)(p.ws + O_GG); float* GB = (float*)(p.ws + O_GBETA);
  u16* CQN = (u16*)(p.ws + O_CQN); u16* CKVN = (u16*)(p.ws + O_CKVN);
  const float* cwp = pin(p, I_CONVW) + (size_t)l * 5 * 768;
  f32x2 cw[6][5];
#pragma unroll
  for (int i = 0; i < 6; ++i)
#pragma unroll
    for (int j = 0; j < 5; ++j) cw[i][j] = *(const f32x2*)(cwp + j * 768 + 2 * lane + 128 * i);
  const float* gq = pin(p, I_MQG) + l * 192; const float* gkv = pin(p, I_MKVG) + l * 128;
  const float gq0 = gq[lane], gq1 = gq[64 + lane], gq2 = gq[128 + lane], gk0 = gkv[lane], gk1 = gkv[64 + lane];
  for (int t = vb * 4 + wid; t < T; t += nvb * 4) {
    int base, pos, len;
    if (t < TL) { base = t & ~(SEQ - 1); pos = t & (SEQ - 1); len = SEQ; } else { int j = t - TL; base = TL + (j & ~(CTXL - 1)); pos = j & (CTXL - 1); len = CTXL; }
    unsigned xin[5][6];
#pragma unroll
    for (int j = 0; j < 5; ++j) {
      const int pp = pos + j - 2;
      const bool ok = pp >= 0 && pp < len;
      const u16* row = PP + (size_t)(base + (ok ? pp : pos)) * LDPP + PP_DQKV + 2 * lane;
#pragma unroll
      for (int i = 0; i < 6; ++i) { unsigned v = *(const unsigned*)(row + 128 * i); xin[j][i] = ok ? v : 0u; }
    }
    const u16* pr = PP + (size_t)t * LDPP;
    const float q0 = bf2f(pr[PP_CQ + lane]), q1 = bf2f(pr[PP_CQ + 64 + lane]), q2 = bf2f(pr[PP_CQ + 128 + lane]);
    const float k0 = bf2f(pr[PP_CKV + lane]), k1 = bf2f(pr[PP_CKV + 64 + lane]);
    const float gate_in = lane < 16 ? bf2f(pr[PP_GATE + lane]) : 0.f;
#pragma unroll
    for (int i = 0; i < 6; ++i) {
      float a0 = 0.f, a1 = 0.f;
#pragma unroll
      for (int j = 0; j < 5; ++j) { a0 += cw[i][j][0] * bflo(xin[j][i]); a1 += cw[i][j][1] * bfhi(xin[j][i]); }
      float y0 = siluf(a0), y1 = siluf(a1);
      const int c = 2 * lane + 128 * i;
      if (i < 4) {
        const float ss = half_sum(y0 * y0 + y1 * y1);
        const float r = rsqrtf(ss + 1e-6f) * (i < 2 ? 0.125f : 1.f);
        u16* dst = i < 2 ? GQ + (size_t)t * 256 + c : GK + (size_t)t * 256 + (c - 256);
        *(unsigned*)dst = pack2(y0 * r, y1 * r);
      } else *(unsigned*)(GV + (size_t)t * 256 + (c - 512)) = pack2(y0, y1);
    }
    if (lane < 16) {
      const int which = lane >> 2, hd = lane & 3;
      if (which < 2) {
        const float al = which ? pin(p, I_ALB)[l * 4 + hd] : pin(p, I_ALF)[l * 4 + hd];
        const float dt = which ? pin(p, I_DTB)[l * 4 + hd] : pin(p, I_DTF)[l * 4 + hd];
        const float xx = gate_in + dt;
        const float sp = fmaxf(xx, 0.f) + log1pf(expf(-fabsf(xx)));
        GG[((size_t)which * T + t) * 4 + hd] = -expf(al) * sp;
      } else GB[((size_t)(which - 2) * T + t) * 4 + hd] = sigmf(gate_in);
    }
    {
      float ss = q0 * q0 + q1 * q1 + q2 * q2, s2 = k0 * k0 + k1 * k1;
#pragma unroll
      for (int o = 32; o >= 1; o >>= 1) { ss += __shfl_xor(ss, o); s2 += __shfl_xor(s2, o); }
      const float rs = rsqrtf(ss * (1.f / 192.f) + 1e-6f), r2 = rsqrtf(s2 * (1.f / 128.f) + 1e-6f);
      u16* d = CQN + (size_t)t * 192;
      d[lane] = f2bf(q0 * rs * gq0); d[64 + lane] = f2bf(q1 * rs * gq1); d[128 + lane] = f2bf(q2 * rs * gq2);
      u16* d2 = CKVN + (size_t)t * 128;
      d2[lane] = f2bf(k0 * r2 * gk0); d2[64 + lane] = f2bf(k1 * r2 * gk1);
    }
  }
}

DEVI void mla_up_tile(const Params& p, int mt, int nn, char* smem) {
  const int tid = p.tid, lane = tid & 63, wid = tid >> 6, wr = wid >> 1, wc = wid & 1, fr = lane & 15, fq = lane >> 4;
  const int m0 = mt * 128;
  const bool lat = m0 < TL;
  const int b = tok_b(m0), rowbase = tok_row(m0);
  f32x4 acc[4][4];
  if (nn < 3) {
    const u16* CQN = (const u16*)(p.ws + O_CQN);
    gemm_core<false>(tid, [&](int r) { return CQN + (size_t)(m0 + r) * 192; }, (const u16*)(p.ws + O_WUQT) + (size_t)nn * 128 * 192, 192, 192, acc, smem);
    const f32x2* ROPE = (const f32x2*)(p.ws + O_ROPE);
    const float scale = 0.10206207261596577f * LOG2E;
    u16* QC = (u16*)(p.ws + O_QC);
#pragma unroll
    for (int m = 0; m < 4; ++m) {
      const int rl = wr * 64 + m * 16 + fr;
#pragma unroll
      for (int n = 0; n < 4; ++n) {
        const int cb = nn * 128 + wc * 64 + n * 16;
        const int h = cb / 96, db = cb - h * 96;
        u16* dst = QC + ((size_t)(b * 4 + h) * NKEY + rowbase + rl) * 96;
        if (db < 64) {
          u32x2 pk; pk[0] = pack2(acc[m][n][0] * scale, acc[m][n][1] * scale); pk[1] = pack2(acc[m][n][2] * scale, acc[m][n][3] * scale);
          *(u32x2*)(dst + db + fq * 4) = pk;
        } else if (db == 64 && n < 3) {
          u32x2 o1, o2;
          rope4(acc[m][n], acc[m][n + 1], ROPE + (size_t)(rowbase + rl) * 48 + 32 + fq * 4, lat, scale, o1, o2);
          *(u32x2*)(dst + 64 + fq * 4) = o1; *(u32x2*)(dst + 80 + fq * 4) = o2;
        }
      }
    }
  } else {
    const u16* CKVN = (const u16*)(p.ws + O_CKVN);
    auto arow = [&](int r) { return CKVN + (size_t)(m0 + r) * 128; };
    const u16* Wt = (const u16*)(p.ws + O_WUKVT) + (size_t)(nn - 3) * 128 * 128;
    if (nn < 5) {
      gemm_core<false>(tid, arow, Wt, 128, 128, acc, smem);
      u16* KC = (u16*)(p.ws + O_KC) + ((size_t)(b * 4 + (nn - 3) * 2 + wc) * NKEY + rowbase) * 96;
#pragma unroll
      for (int m = 0; m < 4; ++m)
#pragma unroll
        for (int n = 0; n < 4; ++n) {
          u32x2 pk; pk[0] = pack2(acc[m][n][0], acc[m][n][1]); pk[1] = pack2(acc[m][n][2], acc[m][n][3]);
          *(u32x2*)(KC + (size_t)(wr * 64 + m * 16 + fr) * 96 + n * 16 + fq * 4) = pk;
        }
    } else {
      gemm_core<true>(tid, arow, Wt, 128, 128, acc, smem);
      u16* vt = (u16*)(p.ws + O_VTC) + (size_t)(b * 4 + (nn - 5) * 2 + wc) * 64 * NKEY;
#pragma unroll
      for (int m = 0; m < 4; ++m)
#pragma unroll
        for (int n = 0; n < 4; ++n) {
          u32x2 pk; pk[0] = pack2(acc[m][n][0], acc[m][n][1]); pk[1] = pack2(acc[m][n][2], acc[m][n][3]);
          *(u32x2*)(vt + (size_t)(n * 16 + fr) * NKEY + rowbase + wr * 64 + m * 16 + (((fq & 1) << 1) | (fq >> 1)) * 4) = pk;
        }
    }
  }
}
DEVI int permcol(int x) { return (x & 32) + 8 * ((x >> 2) & 3) + 4 * ((x >> 4) & 1) + (x & 3); }
DEVI int cidx(int d, int e) { return ((((e >> 4) * 4 + (d >> 4)) * 64) + (e & 15) + 16 * ((d >> 2) & 3)) * 4 + (d & 3); }
DEVI int gdn_chunk_t0(int ci) { return ci < 256 ? (ci >> 7) * SEQ + (ci & 127) * 64 : TL + ((ci - 256) >> 2) * CTXL + ((ci - 256) & 3) * 64; }

DEVI void gdn_chunk_item(const Params& p, int item, char* smem) {
  u16* sK = (u16*)smem;
  float* sA = (float*)(smem + 9216);
  u16* sXt = (u16*)smem;
  u16* sAt = (u16*)(smem + 26624);
  u16* sKt = (u16*)(smem + 35840);
  float* sX = (float*)(smem + 45056);
  float* sgc = (float*)(smem + 77824); float* sbeta = sgc + 64; float* seg = sbeta + 64; float* skd = seg + 64;
  const u16* GQ = (const u16*)(p.ws + O_GQ); const u16* GK = (const u16*)(p.ws + O_GK); const u16* GV = (const u16*)(p.ws + O_GV);
  const float* GG = (const float*)(p.ws + O_GG); const float* GB = (const float*)(p.ws + O_GBETA);
  u16* GM = (u16*)(p.ws + O_GM); u16* GQP = (u16*)(p.ws + O_GQP); u16* GN = (u16*)(p.ws + O_GN); u16* GLO = (u16*)(p.ws + O_GLO);
  const int tid = p.tid, lane = tid & 63, w = tid >> 6, i15 = lane & 15, q = lane >> 4;
  {
    const int ci = item >> 3, hd = (item >> 1) & 3, dir = item & 1;
    const int t0 = gdn_chunk_t0(ci);
    auto tok = [&](int i) { return dir ? t0 + 63 - i : t0 + i; };
    __syncthreads();
    if (tid < 64) {
      float g = GG[((size_t)dir * T + tok(tid)) * 4 + hd];
#pragma unroll
      for (int o = 1; o < 64; o <<= 1) { float u = __shfl_up(g, o); if (lane >= o) g += u; }
      const float gl = __shfl(g, 63);
      sgc[tid] = g; sbeta[tid] = GB[((size_t)dir * T + tok(tid)) * 4 + hd]; seg[tid] = expf(g); skd[tid] = expf(gl - g);
    }
    __syncthreads();
    const float eglast = seg[63];
#pragma unroll
    for (int i = 0; i < 2; ++i) {
      const int ch = tid + 256 * i, j = ch >> 3, cc = ch & 7;
      const u32x4 kv = *(const u32x4*)(GK + (size_t)tok(j) * 256 + hd * 64 + cc * 8);
      *(u32x4*)&sK[j * 72 + cc * 8] = kv;
      const float kd = skd[j];
#pragma unroll
      for (int e = 0; e < 4; ++e) {
        sKt[(cc * 8 + 2 * e) * 72 + j] = f2bf(bf2f((u16)(kv[e] & 0xffff)) * kd);
        sKt[(cc * 8 + 2 * e + 1) * 72 + j] = f2bf(bf2f((u16)(kv[e] >> 16)) * kd);
      }
    }
#pragma unroll
    for (int i = 0; i < 2; ++i) {
      const int ch = tid + 256 * i, j = ch >> 3, cc = ch & 7;
      const u32x4 vv = *(const u32x4*)(GV + (size_t)tok(j) * 256 + hd * 64 + cc * 8);
      const float bj = sbeta[j];
      float* d = sX + j * 128 + cc * 8;
#pragma unroll
      for (int e = 0; e < 4; ++e) { d[2 * e] = bflo(vv[e]) * bj; d[2 * e + 1] = bfhi(vv[e]) * bj; }
    }
    __syncthreads();
    for (int e = tid; e < 64 * 64; e += 256) {
      const int j = e >> 6, c = e & 63;
      sX[j * 128 + 64 + c] = bf2f(sK[j * 72 + c]) * sbeta[j] * seg[j];
    }
    {
      f32x4 kk[4], qk[4];
#pragma unroll
      for (int nt = 0; nt < 4; ++nt) { kk[nt] = fzero4(); qk[nt] = fzero4(); }
#pragma unroll
      for (int ks = 0; ks < 2; ++ks) {
        const bf16x8 ak = *(const bf16x8*)&sK[(16 * w + i15) * 72 + ks * 32 + q * 8];
        const bf16x8 aq = *(const bf16x8*)(GQ + (size_t)tok(16 * w + i15) * 256 + hd * 64 + ks * 32 + q * 8);
#pragma unroll
        for (int nt = 0; nt < 4; ++nt) {
          const bf16x8 bk = *(const bf16x8*)&sK[(16 * nt + i15) * 72 + ks * 32 + q * 8];
          kk[nt] = MFMA16(ak, bk, kk[nt]); qk[nt] = MFMA16(aq, bk, qk[nt]);
        }
      }
#pragma unroll
      for (int nt = 0; nt < 4; ++nt)
#pragma unroll
        for (int r = 0; r < 4; ++r) {
          const int i = 16 * w + 4 * q + r, j = 16 * nt + i15;
          const float dec = i >= j ? expf(sgc[i] - sgc[j]) : 0.f;
          sA[i * 68 + j] = i > j ? sbeta[i] * kk[nt][r] * dec : 0.f;
          sAt[i * 72 + j] = f2bf(i >= j ? qk[nt][r] * dec : 0.f);
        }
    }
    __syncthreads();
    if (tid < 128) {
      const int c = tid;
      for (int ib = 0; ib < 16; ++ib) {
        float a0 = sX[(4 * ib) * 128 + c], a1 = sX[(4 * ib + 1) * 128 + c], a2 = sX[(4 * ib + 2) * 128 + c], a3 = sX[(4 * ib + 3) * 128 + c];
#pragma unroll 4
        for (int g = 0; g < ib; ++g) {
          const float x0 = sX[(4 * g) * 128 + c], x1 = sX[(4 * g + 1) * 128 + c], x2 = sX[(4 * g + 2) * 128 + c], x3 = sX[(4 * g + 3) * 128 + c];
          const f32x4 r0 = *(const f32x4*)&sA[(4 * ib) * 68 + 4 * g], r1 = *(const f32x4*)&sA[(4 * ib + 1) * 68 + 4 * g];
          const f32x4 r2 = *(const f32x4*)&sA[(4 * ib + 2) * 68 + 4 * g], r3 = *(const f32x4*)&sA[(4 * ib + 3) * 68 + 4 * g];
          a0 -= r0[0] * x0 + r0[1] * x1 + r0[2] * x2 + r0[3] * x3;
          a1 -= r1[0] * x0 + r1[1] * x1 + r1[2] * x2 + r1[3] * x3;
          a2 -= r2[0] * x0 + r2[1] * x1 + r2[2] * x2 + r2[3] * x3;
          a3 -= r3[0] * x0 + r3[1] * x1 + r3[2] * x2 + r3[3] * x3;
        }
        const f32x4 d1 = *(const f32x4*)&sA[(4 * ib + 1) * 68 + 4 * ib], d2 = *(const f32x4*)&sA[(4 * ib + 2) * 68 + 4 * ib], d3 = *(const f32x4*)&sA[(4 * ib + 3) * 68 + 4 * ib];
        a1 -= d1[0] * a0;
        a2 -= d2[0] * a0 + d2[1] * a1;
        a3 -= d3[0] * a0 + d3[1] * a1 + d3[2] * a2;
        sX[(4 * ib) * 128 + c] = a0; sX[(4 * ib + 1) * 128 + c] = a1; sX[(4 * ib + 2) * 128 + c] = a2; sX[(4 * ib + 3) * 128 + c] = a3;
      }
    }
    __syncthreads();
    {
      const int c = tid & 127, jh = (tid >> 7) * 32;
#pragma unroll
      for (int g = 0; g < 4; ++g) {
        u32x4 pk;
#pragma unroll
        for (int e = 0; e < 4; ++e) pk[e] = pack2(sX[(jh + 8 * g + 2 * e) * 128 + c], sX[(jh + 8 * g + 2 * e + 1) * 128 + c]);
        *(u32x4*)&sXt[c * 72 + jh + 8 * g] = pk;
      }
    }
    __syncthreads();
    {
      f32x4 r1[8], r2[8];
#pragma unroll
      for (int ct = 0; ct < 8; ++ct) { r1[ct] = fzero4(); r2[ct] = fzero4(); }
#pragma unroll
      for (int ks = 0; ks < 2; ++ks) {
        const bf16x8 aa = *(const bf16x8*)&sAt[(16 * w + i15) * 72 + ks * 32 + q * 8];
        const bf16x8 ak = *(const bf16x8*)&sKt[(16 * w + i15) * 72 + ks * 32 + q * 8];
#pragma unroll
        for (int ct = 0; ct < 8; ++ct) {
          const bf16x8 bx = *(const bf16x8*)&sXt[(16 * ct + i15) * 72 + ks * 32 + q * 8];
          r1[ct] = MFMA16(aa, bx, r1[ct]); r2[ct] = MFMA16(ak, bx, r2[ct]);
        }
      }
      const size_t ib = (size_t)item * 4096;
#pragma unroll
      for (int ct = 0; ct < 4; ++ct) {
        u32x2 a, b;
        a[0] = pack2(r1[ct][0], r1[ct][1]); a[1] = pack2(r1[ct][2], r1[ct][3]);
        b[0] = pack2(r2[ct][0], r2[ct][1]); b[1] = pack2(r2[ct][2], r2[ct][3]);
        *(u32x2*)(GLO + ib + ((ct * 4 + w) * 64 + lane) * 4) = a;
        *(u32x2*)(GN + ib + ((ct * 4 + w) * 64 + lane) * 4) = b;
      }
#pragma unroll
      for (int ct = 4; ct < 8; ++ct)
#pragma unroll
        for (int r = 0; r < 4; ++r) {
          const int row = 16 * w + 4 * q + r, col = 16 * (ct - 4) + i15;
          const float qv = bf2f(GQ[(size_t)tok(row) * 256 + hd * 64 + col]);
          GQP[ib + row * 64 + permcol(col)] = f2bf(qv * seg[row] - r1[ct][r]);
          GM[ib + row * 64 + permcol(col)] = f2bf((row == col ? eglast : 0.f) - r2[ct][r]);
        }
    }
    __syncthreads();
  }
}

DEVI void gdn_scan_chain(const Params& p, int chain, char* smem) {
  const int tid = p.tid, lane = tid & 63, w = tid >> 6, i15 = lane & 15, q = lane >> 4;
  u16* sM = (u16*)smem;
  u16* sQ = sM + 2 * 64 * 72;
  const u16* GM = (const u16*)(p.ws + O_GM); const u16* GQP = (const u16*)(p.ws + O_GQP);
  const u16* GN = (const u16*)(p.ws + O_GN); const u16* GLO = (const u16*)(p.ws + O_GLO);
  float* GO = (float*)(p.ws + O_GO);
  {
    const int b = chain >> 3, hd = (chain >> 1) & 3, dir = chain & 1;
    f32x4 S[4];
#pragma unroll
    for (int r = 0; r < 4; ++r) S[r] = fzero4();
    auto item_of = [&](int n) {
      int ci = n < 4 ? 256 + b * 4 + (dir ? 3 - n : n) : b * 128 + (dir ? 127 - (n - 4) : (n - 4));
      return ci * 8 + hd * 2 + dir;
    };
    u32x4 pm[2], pq[2]; u32x2 pn[4], pl[4];
    auto prefetch = [&](int n) {
      const size_t base = (size_t)item_of(n) * 4096;
#pragma unroll
      for (int i = 0; i < 2; ++i) {
        const int ch = tid + 256 * i;
        pm[i] = *(const u32x4*)(GM + base + ch * 8);
        pq[i] = *(const u32x4*)(GQP + base + ch * 8);
      }
#pragma unroll
      for (int rb = 0; rb < 4; ++rb) {
        pn[rb] = *(const u32x2*)(GN + base + ((w * 4 + rb) * 64 + lane) * 4);
        pl[rb] = *(const u32x2*)(GLO + base + ((w * 4 + rb) * 64 + lane) * 4);
      }
    };
    prefetch(0);
    __syncthreads();
    for (int n = 0; n < 132; ++n) {
      const int buf = n & 1;
      u16* bM = sM + buf * 64 * 72; u16* bQ = sQ + buf * 64 * 72;
#pragma unroll
      for (int i = 0; i < 2; ++i) {
        const int ch = tid + 256 * i, row = ch >> 3, cc = ch & 7;
        *(u32x4*)&bM[row * 72 + cc * 8] = pm[i];
        *(u32x4*)&bQ[row * 72 + cc * 8] = pq[i];
      }
      f32x4 accs[4], acco[4];
#pragma unroll
      for (int rb = 0; rb < 4; ++rb) {
        accs[rb] = f32x4{bf2f((u16)(pn[rb][0] & 0xffff)), bf2f((u16)(pn[rb][0] >> 16)), bf2f((u16)(pn[rb][1] & 0xffff)), bf2f((u16)(pn[rb][1] >> 16))};
        acco[rb] = f32x4{bf2f((u16)(pl[rb][0] & 0xffff)), bf2f((u16)(pl[rb][0] >> 16)), bf2f((u16)(pl[rb][1] & 0xffff)), bf2f((u16)(pl[rb][1] >> 16))};
      }
      const int ci = n < 4 ? 256 + b * 4 + (dir ? 3 - n : n) : b * 128 + (dir ? 127 - (n - 4) : (n - 4));
      const int t0 = gdn_chunk_t0(ci);
      __syncthreads();
      if (n + 1 < 132) prefetch(n + 1);
      bf16x8 sb[2];
#pragma unroll
      for (int kb = 0; kb < 2; ++kb)
#pragma unroll
        for (int jj = 0; jj < 8; ++jj) sb[kb][jj] = (short)f2bf(S[2 * kb + (jj >> 2)][jj & 3]);
#pragma unroll
      for (int kb = 0; kb < 2; ++kb)
#pragma unroll
        for (int rb = 0; rb < 4; ++rb) {
          const bf16x8 am = *(const bf16x8*)&bM[(rb * 16 + i15) * 72 + kb * 32 + q * 8];
          const bf16x8 aq = *(const bf16x8*)&bQ[(rb * 16 + i15) * 72 + kb * 32 + q * 8];
          accs[rb] = MFMA16(am, sb[kb], accs[rb]);
          acco[rb] = MFMA16(aq, sb[kb], acco[rb]);
        }
#pragma unroll
      for (int rb = 0; rb < 4; ++rb) {
        S[rb] = accs[rb];
#pragma unroll
        for (int r = 0; r < 4; ++r) {
          const int i = rb * 16 + q * 4 + r;
          const int t = dir ? t0 + 63 - i : t0 + i;
          GO[(size_t)dir * T * 256 + (size_t)t * 256 + hd * 64 + w * 16 + i15] = acco[rb][r];
        }
      }
    }
    __syncthreads();
  }
}


template <int DQK>
DEVI void attn_run(int tid, const u16* __restrict__ Qp, int qrow0, const u16* __restrict__ Kp, const u16* __restrict__ Vtp,
                   int a0, int a1, int b0, int b1, int qpos0, float sink2, f32x16 (&O)[2], char* smem) {
  constexpr int KLD = DQK + 8, NS = DQK / 16, KCH = DQK / 8, NKL = (64 * KCH) / 256;
  constexpr int BUF = 64 * KLD + 64 * 72;
  u16* sbase = (u16*)smem;
  const int lane = tid & 63, wid = tid >> 6, r31 = lane & 31, hh = lane >> 5;
  const int qrow = qrow0 + wid * 32 + r31;
  bf16x8 qf[NS];
#pragma unroll
  for (int s = 0; s < NS; ++s) qf[s] = *(const bf16x8*)(Qp + (size_t)qrow * DQK + s * 16 + hh * 8);
#pragma unroll
  for (int i = 0; i < 16; ++i) { O[0][i] = 0.f; O[1][i] = 0.f; }
  float m = -30000.f, lsum = 0.f;
  const int na = (a1 - a0) >> 6, nt = na + ((b1 - b0) >> 6);
  const int qpos = qpos0 + wid * 32 + r31;
  u32x4 rk[NKL], rv[2];
  auto gload = [&](int ti) {
    const int key0 = ti >= na ? b0 + (ti - na) * 64 : a0 + ti * 64;
#pragma unroll
    for (int i = 0; i < NKL; ++i) { const int q = tid + 256 * i, r = q / KCH, cc = q % KCH; rk[i] = *(const u32x4*)(Kp + (size_t)(key0 + r) * DQK + cc * 8); }
#pragma unroll
    for (int i = 0; i < 2; ++i) { const int q = tid + 256 * i, r = q >> 3, cc = q & 7; rv[i] = *(const u32x4*)(Vtp + (size_t)r * NKEY + key0 + cc * 8); }
  };
  auto lstore = [&](int buf) {
    u16* sK = sbase + buf * BUF; u16* sV = sK + 64 * KLD;
#pragma unroll
    for (int i = 0; i < NKL; ++i) { const int q = tid + 256 * i, r = q / KCH, cc = q % KCH; *(u32x4*)&sK[r * KLD + cc * 8] = rk[i]; }
#pragma unroll
    for (int i = 0; i < 2; ++i) { const int q = tid + 256 * i, r = q >> 3, cc = q & 7; *(u32x4*)&sV[r * 72 + cc * 8] = rv[i]; }
  };
  m = 0.f;
  f32x16 negm;
#pragma unroll
  for (int i = 0; i < 16; ++i) negm[i] = 0.f;
  gload(0);
  __syncthreads();
  lstore(0);
  __syncthreads();
  for (int ti = 0; ti < nt; ++ti) {
    if (ti + 1 < nt) gload(ti + 1);
    const u16* sK = sbase + (ti & 1) * BUF; const u16* sV = sK + 64 * KLD;
    const bool inB = ti >= na;
    const int key0 = inB ? b0 + (ti - na) * 64 : a0 + ti * 64;
    f32x16 st[2];
#pragma unroll
    for (int k2 = 0; k2 < 2; ++k2) {
      {
        const bf16x8 kf = *(const bf16x8*)&sK[(k2 * 32 + r31) * KLD + hh * 8];
        asm volatile("v_mfma_f32_32x32x16_bf16 %0, %1, %2, %3" : "=&v"(st[k2]) : "v"(kf), "v"(qf[0]), "v"(negm));
      }
#pragma unroll
      for (int s = 1; s < NS; ++s) {
        const bf16x8 kf = *(const bf16x8*)&sK[(k2 * 32 + r31) * KLD + s * 16 + hh * 8];
        st[k2] = MFMA32(kf, qf[s], st[k2]);
      }
    }
    if (inB) {
#pragma unroll
      for (int k2 = 0; k2 < 2; ++k2)
#pragma unroll
        for (int g = 0; g < 16; ++g) {
          const int d = key0 + k2 * 32 + (g & 3) + 8 * (g >> 2) + 4 * hh - qpos;
          if (d > 128 || d < -128) st[k2][g] = -1e30f;
        }
    }
    bf16x8 vfr[2][2][2];
#pragma unroll
    for (int k2 = 0; k2 < 2; ++k2)
#pragma unroll
      for (int s2 = 0; s2 < 2; ++s2)
#pragma unroll
        for (int dvt = 0; dvt < 2; ++dvt) vfr[k2][s2][dvt] = *(const bf16x8*)&sV[(dvt * 32 + r31) * 72 + k2 * 32 + s2 * 16 + 8 * hh];
    float mx = st[0][0];
#pragma unroll
    for (int g = 1; g < 16; ++g) mx = fmaxf(mx, st[0][g]);
#pragma unroll
    for (int g = 0; g < 16; ++g) mx = fmaxf(mx, st[1][g]);
    { auto rr = __builtin_amdgcn_permlane32_swap(__float_as_uint(mx), __float_as_uint(mx), false, false);
      mx = fmaxf(__uint_as_float(rr[0]), __uint_as_float(rr[1])); }
    if (ti == 0 || __any(mx > 8.f)) {
      const float delta = ti == 0 ? fmaxf(mx, -1e4f) : fmaxf(mx, 0.f);
      if (ti != 0) {
        const float alpha = __builtin_amdgcn_exp2f(-delta);
        lsum *= alpha;
#pragma unroll
        for (int i = 0; i < 16; ++i) { O[0][i] *= alpha; O[1][i] *= alpha; }
      }
      m += delta;
#pragma unroll
      for (int i = 0; i < 16; ++i) { negm[i] = -m; st[0][i] -= delta; st[1][i] -= delta; }
    }
    f32x2 ps2 = {0.f, 0.f};
#pragma unroll
    for (int k2 = 0; k2 < 2; ++k2)
#pragma unroll
      for (int g = 0; g < 16; g += 2) {
        const float p0 = __builtin_amdgcn_exp2f(st[k2][g]), p1 = __builtin_amdgcn_exp2f(st[k2][g + 1]);
        st[k2][g] = p0; st[k2][g + 1] = p1;
        ps2 += f32x2{p0, p1};
      }
    lsum += ps2[0] + ps2[1];
#pragma unroll
    for (int k2 = 0; k2 < 2; ++k2)
#pragma unroll
      for (int s2 = 0; s2 < 2; ++s2) {
        u32x4 pp;
#pragma unroll
        for (int j = 0; j < 4; ++j) pp[j] = pack2(st[k2][8 * s2 + 2 * j], st[k2][8 * s2 + 2 * j + 1]);
        const bf16x8 pf = __builtin_bit_cast(bf16x8, pp);
#pragma unroll
        for (int dvt = 0; dvt < 2; ++dvt) {
          O[dvt] = MFMA32(vfr[k2][s2][dvt], pf, O[dvt]);
        }
      }
    if (ti + 1 < nt) lstore((ti + 1) & 1);
    __syncthreads();
  }
  if (sink2 > -1e29f) {
    const float mn = fmaxf(m, sink2);
    const float alpha = __builtin_amdgcn_exp2f(m - mn);
    lsum = lsum * alpha + (hh == 0 ? __builtin_amdgcn_exp2f(sink2 - mn) : 0.f);
#pragma unroll
    for (int i = 0; i < 16; ++i) { O[0][i] *= alpha; O[1][i] *= alpha; }
  }
  const float ltot = lsum + __shfl_xor(lsum, 32);
  const float inv = 1.f / ltot;
#pragma unroll
  for (int i = 0; i < 16; ++i) { O[0][i] *= inv; O[1][i] *= inv; }
}
DEVI void attn_store(int tid, const f32x16 (&O)[2], u16* dst, int ld, int b, int qrow0, int col0) {
  const int lane = tid & 63, wid = tid >> 6, r31 = lane & 31, hh = lane >> 5;
  const int qrow = qrow0 + wid * 32 + r31;
  const int t = qrow < SEQ ? b * SEQ + qrow : TL + b * CTXL + (qrow - SEQ);
  u16* yr = dst + (size_t)t * ld + col0;
#pragma unroll
  for (int dvt = 0; dvt < 2; ++dvt)
#pragma unroll
    for (int g4 = 0; g4 < 4; ++g4) {
      u32x2 pk; pk[0] = pack2(O[dvt][g4 * 4 + 0], O[dvt][g4 * 4 + 1]); pk[1] = pack2(O[dvt][g4 * 4 + 2], O[dvt][g4 * 4 + 3]);
      *(u32x2*)(yr + dvt * 32 + 8 * g4 + 4 * hh) = pk;
    }
}
DEVI void attn_item(const Params& p, int l, int mixer, int b, int h, int qb, char* smem) {
  const bool lat = qb < 64;
  const int qrow0 = qb * 128;
  f32x16 O[2];
  if (mixer == 0) {
    attn_run<32>(p.tid, (const u16*)(p.ws + O_QB) + (size_t)(b * 8 + h) * NKEY * 32, qrow0, (const u16*)(p.ws + O_KB) + (size_t)(b * 8 + h) * NKEY * 32,
                 (const u16*)(p.ws + O_VTB) + (size_t)(b * 4 + (h >> 1)) * 64 * NKEY, lat ? 0 : SEQ, NKEY, 0, 0, 0, -1e30f, O, smem);
    attn_store(p.tid, O, (u16*)(p.ws + O_OB), 512, b, qrow0, h * 64);
  } else if (mixer == 1) {
    attn_run<96>(p.tid, (const u16*)(p.ws + O_QC) + (size_t)(b * 4 + h) * NKEY * 96, qrow0, (const u16*)(p.ws + O_KC) + (size_t)(b * 4 + h) * NKEY * 96,
                 (const u16*)(p.ws + O_VTC) + (size_t)(b * 4 + h) * 64 * NKEY, lat ? 0 : SEQ, NKEY, 0, 0, 0, -1e30f, O, smem);
    attn_store(p.tid, O, (u16*)(p.ws + O_Y), 1024, b, qrow0, 512 + h * 64);
  } else {
    const float sink2 = pin(p, I_SINK)[l * 4 + h] * LOG2E;
    const int hk = h >> 1;
    int b0 = 0, b1 = 0;
    if (lat) { b0 = (qb - 1) * 128; if (b0 < 0) b0 = 0; b1 = (qb + 2) * 128; if (b1 > SEQ) b1 = SEQ; }
    attn_run<64>(p.tid, (const u16*)(p.ws + O_QA) + (size_t)(b * 4 + h) * NKEY * 64, qrow0, (const u16*)(p.ws + O_KA) + (size_t)(b * 2 + hk) * NKEY * 64,
                 (const u16*)(p.ws + O_VTA) + (size_t)(b * 2 + hk) * 64 * NKEY, SEQ, NKEY, b0, b1, qrow0, sink2, O, smem);
    attn_store(p.tid, O, (u16*)(p.ws + O_Y), 1024, b, qrow0, h * 64);
  }
}

constexpr int SMEM_BYTES = 78848 + 64;

DEVI unsigned long long launder_ptr(unsigned long long v) {
  unsigned lo = __builtin_amdgcn_readfirstlane((unsigned)v), hi = __builtin_amdgcn_readfirstlane((unsigned)(v >> 32));
  asm volatile("s_mov_b32 %0, %1" : "=s"(lo) : "s"(lo));
  asm volatile("s_mov_b32 %0, %1" : "=s"(hi) : "s"(hi));
  return ((unsigned long long)hi << 32) | lo;
}
DEVI Params mkctx(const KArgs& a) {
  Params c;
  typedef __attribute__((address_space(1))) char gchar;
  typedef __attribute__((address_space(1))) float gfloat;
  c.ws = (char*)(gchar*)launder_ptr((unsigned long long)a.ws);
  c.out = (float*)(gfloat*)launder_ptr((unsigned long long)a.out);
  c.in = (gcfloat* const*)(c.ws + O_TAB);
  c.tid = threadIdx.x;
  asm volatile("" : "+v"(c.tid));
  return c;
}
DEVI void st_mixer_queue(const KArgs& a, int l, char* smem) {
  int* sitem = (int*)(smem + SMEM_BYTES - 16);
  const int g = blockIdx.x & 7;
  const int nctx = l == 0 ? 8 : 0;
  constexpr int NPREP = TR_P2 / 8 / 8;
  const int total = 2 + 128 + 64 + 64 + nctx + NPREP;
  for (;;) {
    const Params p = mkctx(a);
    unsigned* head = (unsigned*)(p.ws + O_BAR) + 16 + l * 8 + g;
    __syncthreads();
    if (p.tid == 0) *sitem = (int)atomicAdd(head, 1u);
    __syncthreads();
    int it = *sitem;
    if (it >= total) break;
    if (it < 2) { gdn_scan_chain(p, 2 * g + it, smem); continue; }
    it -= 2;
    if (it < 256 + nctx) {
      int mixer, b, h, qb;
      if (it < 128) { const int pr = 2 * g + (it >> 6); mixer = 0; b = pr >> 3; h = pr & 7; qb = it & 63; }
      else if (it < 256) { mixer = 1 + ((it - 128) >> 6); b = g >> 2; h = g & 3; qb = it & 63; }
      else {
        const int j = it - 256;
        if (j < 4) { const int pr = 2 * g + (j >> 1); mixer = 0; b = pr >> 3; h = pr & 7; qb = 64 + (j & 1); }
        else { mixer = 1 + ((j - 4) >> 1); b = g >> 2; h = g & 3; qb = 64 + (j & 1); }
      }
      attn_item(p, l, mixer, b, h, qb, smem);
      continue;
    }
    it -= 256 + nctx;
    prep_w2_run8(p, l, (it * 8 + g) * 8, (float*)smem);
  }
}

DEVI void st_mix_finish(const Params& p, int l, int vb, int nvb) {
  const int lane = p.tid & 63, wid = p.tid >> 6;
  const float* GO = (const float*)(p.ws + O_GO); const u16* PP = (const u16*)(p.ws + O_PP); const u16* OB = (const u16*)(p.ws + O_OB);
  u16* Y = (u16*)(p.ws + O_Y);
  const float lam_init = 0.8f - 0.6f * expf(-0.3f * (float)l);
  float d1 = lane < 32 ? pin(p, I_LQ1)[l * 32 + lane] * pin(p, I_LK1)[l * 32 + lane] : 0.f;
  float d2 = lane < 32 ? pin(p, I_LQ2)[l * 32 + lane] * pin(p, I_LK2)[l * 32 + lane] : 0.f;
  const float lam = expf(wave_sum(d1)) - expf(wave_sum(d2)) + lam_init;
  const int hd = lane >> 4, d0 = (lane & 15) * 4;
  const f32x4 gg = *(const f32x4*)(pin(p, I_GNG) + l * 64 + d0);
  const f32x4 dg = *(const f32x4*)(pin(p, I_DNG) + l * 64 + d0) * (1.f - lam_init);
  const int tend = l == 0 ? T : TL;
  for (int t0 = (vb * 4 + wid) * 2; t0 < tend; t0 += nvb * 8) {
    u32x2 o0[2], o1[2], zz[2]; f32x4 gf[2], gb[2];
#pragma unroll
    for (int u = 0; u < 2; ++u) {
      const size_t t = t0 + u;
      o0[u] = *(const u32x2*)(OB + t * 512 + (hd * 2) * 64 + d0);
      o1[u] = *(const u32x2*)(OB + t * 512 + (hd * 2 + 1) * 64 + d0);
      gf[u] = *(const f32x4*)(GO + t * 256 + hd * 64 + d0);
      gb[u] = *(const f32x4*)(GO + (size_t)T * 256 + t * 256 + hd * 64 + d0);
      zz[u] = *(const u32x2*)(PP + t * LDPP + PP_DZ + hd * 64 + d0);
    }
    f32x4 od[2], go[2]; float ssb[2], ssg[2];
#pragma unroll
    for (int u = 0; u < 2; ++u) {
      const f32x4 a = {bflo(o0[u][0]), bfhi(o0[u][0]), bflo(o0[u][1]), bfhi(o0[u][1])};
      const f32x4 b = {bflo(o1[u][0]), bfhi(o1[u][0]), bflo(o1[u][1]), bfhi(o1[u][1])};
      od[u] = a - lam * b; go[u] = gf[u] + gb[u];
      ssb[u] = od[u][0] * od[u][0] + od[u][1] * od[u][1] + od[u][2] * od[u][2] + od[u][3] * od[u][3];
      ssg[u] = go[u][0] * go[u][0] + go[u][1] * go[u][1] + go[u][2] * go[u][2] + go[u][3] * go[u][3];
    }
#pragma unroll
    for (int o = 8; o >= 1; o >>= 1) {
#pragma unroll
      for (int u = 0; u < 2; ++u) { ssb[u] += __shfl_xor(ssb[u], o); ssg[u] += __shfl_xor(ssg[u], o); }
    }
#pragma unroll
    for (int u = 0; u < 2; ++u) {
      const size_t t = t0 + u;
      const f32x4 yb = od[u] * (rsqrtf(ssb[u] * (1.f / 64.f) + 1e-6f)) * dg;
      const f32x4 z = {bflo(zz[u][0]), bfhi(zz[u][0]), bflo(zz[u][1]), bfhi(zz[u][1])};
      const f32x4 sz = {siluf(z[0]), siluf(z[1]), siluf(z[2]), siluf(z[3])};
      const f32x4 yd = go[u] * (rsqrtf(ssg[u] * (1.f / 64.f) + 1e-6f)) * gg * sz;
      u32x2 pb, pd;
      pb[0] = pack2(yb[0], yb[1]); pb[1] = pack2(yb[2], yb[3]);
      pd[0] = pack2(yd[0], yd[1]); pd[1] = pack2(yd[2], yd[3]);
      *(u32x2*)(Y + t * 1024 + 256 + hd * 64 + d0) = pb;
      *(u32x2*)(Y + t * 1024 + 768 + hd * 64 + d0) = pd;
    }
  }
}

constexpr int RLD = 1026;
DEVI void st_norm2_route(const Params& p, int l, int vb, int nvb, char* smem) {
  const int lane = p.tid & 63, wid = p.tid >> 6, i15 = lane & 15, q = lane >> 4;
  float* shh = (float*)smem;
  float* slog = shh + 16 * RLD;
  const float* g = pin(p, I_N2G) + l * 1024;
  const float* wr = pin(p, I_WR) + (size_t)l * 1024 * 64;
  const float bias = pin(p, I_RB)[l * 64 + lane];
  float* WTS = (float*)(p.ws + O_WTS); int* CNT = (int*)(p.ws + O_CNT); int* LIST = (int*)(p.ws + O_LIST);
  const int ntok = l == 0 ? T : TL;
  for (int grp = vb; grp < ntok / 16; grp += nvb) {
    const int tb = grp * 16 + wid * 4;
    const int mv = tok_mv(tb);
    const float* sh = modp(p, l, mv, 3); const float* sc = modp(p, l, mv, 4);
    {
      f32x4 v[4][4]; float ss[4];
#pragma unroll
      for (int u = 0; u < 4; ++u) {
        const f32x4* xr = (const f32x4*)((const float*)(p.ws + O_XA) + (size_t)(tb + u) * 1024);
#pragma unroll
        for (int i = 0; i < 4; ++i) v[u][i] = xr[i * 64 + lane];
      }
#pragma unroll
      for (int u = 0; u < 4; ++u) {
        float a = 0.f;
#pragma unroll
        for (int i = 0; i < 4; ++i) a += v[u][i][0] * v[u][i][0] + v[u][i][1] * v[u][i][1] + v[u][i][2] * v[u][i][2] + v[u][i][3] * v[u][i][3];
        ss[u] = a;
      }
#pragma unroll
      for (int o = 32; o >= 1; o >>= 1) {
#pragma unroll
        for (int u = 0; u < 4; ++u) ss[u] += __shfl_xor(ss[u], o);
      }
#pragma unroll
      for (int i = 0; i < 4; ++i) {
        const int c = i * 256 + lane * 4;
        const f32x4 gg = *(const f32x4*)(g + c), s4 = *(const f32x4*)(sc + c), h4 = *(const f32x4*)(sh + c);
        const f32x4 gs = gg * (1.f + s4);
#pragma unroll
        for (int u = 0; u < 4; ++u) {
          const float rstd = rsqrtf(ss[u] * (1.f / 1024.f) + 1e-6f);
          const f32x4 o = v[u][i] * rstd * gs + h4;
          u32x2 pk; pk[0] = pack2(o[0], o[1]); pk[1] = pack2(o[2], o[3]);
          *(u32x2*)((u16*)(p.ws + O_H) + (size_t)(tb + u) * LDH + c) = pk;
          float* d = shh + (wid * 4 + u) * RLD + c;
          *(f32x2*)d = f32x2{o[0], o[1]}; *(f32x2*)(d + 2) = f32x2{o[2], o[3]};
        }
      }
    }
    __syncthreads();
    {
      f32x4 a0 = fzero4(), a1 = a0;
      const float* ap = shh + i15 * RLD + q;
      const float* bp = wr + (size_t)q * 64 + wid * 16 + i15;
#pragma unroll 1
      for (int kb = 0; kb < 256; kb += 32) {
        float bv[32];
#pragma unroll
        for (int j = 0; j < 32; ++j) bv[j] = bp[(size_t)(4 * (kb + j)) * 64];
#pragma unroll
        for (int j = 0; j < 32; j += 2) {
          a0 = __builtin_amdgcn_mfma_f32_16x16x4f32(ap[4 * (kb + j)], bv[j], a0, 0, 0, 0);
          a1 = __builtin_amdgcn_mfma_f32_16x16x4f32(ap[4 * (kb + j) + 4], bv[j + 1], a1, 0, 0, 0);
        }
      }
#pragma unroll
      for (int r = 0; r < 4; ++r) slog[(4 * q + r) * 64 + wid * 16 + i15] = a0[r] + a1[r];
    }
    __syncthreads();
#pragma unroll 1
    for (int u = 0; u < 4; ++u) {
      const int t = tb + u;
      const float logit = slog[(wid * 4 + u) * 64 + lane];
      const float s = 1.f / (1.f + expf(-logit));
      const float c = s + bias;
      float m1 = c;
      m1 = fmaxf(m1, __shfl_xor(m1, 1)); m1 = fmaxf(m1, __shfl_xor(m1, 2)); m1 = fmaxf(m1, __shfl_xor(m1, 4));
      const unsigned long long bal = __ballot(c == m1);
      const int grpi = lane >> 3;
      const unsigned gm = (unsigned)((bal >> (grpi * 8)) & 0xffull);
      const int first = __ffs(gm) - 1;
      float m2 = ((lane & 7) == first) ? -INFINITY : c;
      m2 = fmaxf(m2, __shfl_xor(m2, 1)); m2 = fmaxf(m2, __shfl_xor(m2, 2)); m2 = fmaxf(m2, __shfl_xor(m2, 4));
      const float gs = m1 + m2;
      int grank = 0;
#pragma unroll
      for (int gg = 0; gg < 8; ++gg) { float o = __shfl(gs, gg * 8); grank += (o > gs || (o == gs && gg < grpi)) ? 1 : 0; }
      const bool gsel = grank < 4;
      const float mc = gsel ? c : -INFINITY;
      int rank = 0;
#pragma unroll
      for (int e = 0; e < 64; ++e) { float o = __shfl(mc, e); rank += (o > mc || (o == mc && e < lane)) ? 1 : 0; }
      const bool sel = gsel && rank < 6;
      const float ssum = wave_sum(sel ? s : 0.f);
      if (sel) {
        const int slot = t * 6 + rank;
        WTS[slot] = s / ssum * 2.5f;
        const int pos = atomicAdd(&CNT[lane], 1);
        LIST[(size_t)lane * T + pos] = slot;
      }
    }
    __syncthreads();
  }
}
DEVI void st_outproj(const Params& p, int l, int vb, int nvb, char* smem) {
  const u16* Y = (const u16*)(p.ws + O_Y); const u16* W = (const u16*)(p.ws + O_WOUTT); float* XA = (float*)(p.ws + O_XA);
  const int tid = p.tid, lane = tid & 63, wid = tid >> 6, wr = wid >> 1, wc = wid & 1, fr = lane & 15, fq = lane >> 4;
  const int nmt = l == 0 ? 132 : 128;
  const int g = vb & 7, nmg = (nmt - g + 7) >> 3;
  for (int i = vb >> 3; i < nmg * 8; i += nvb >> 3) {
    const int m0 = (g + 8 * (i >> 3)) * 128, n0 = (i & 7) * 128;
    f32x4 acc[4][4];
    gemm_core<false>(tid, [&](int r) { return Y + (size_t)(m0 + r) * 1024; }, W + (size_t)n0 * LDW, LDW, 1024, acc, smem);
    const float* gbase = modp(p, l, tok_mv(m0), 2) + n0 + wc * 64 + fq * 4;
#pragma unroll
    for (int hf = 0; hf < 2; ++hf) {
      f32x4 xin[2][4], gt[4];
#pragma unroll
      for (int n = 0; n < 4; ++n) gt[n] = *(const f32x4*)(gbase + n * 16);
#pragma unroll
      for (int mm = 0; mm < 2; ++mm) {
        const int t = m0 + wr * 64 + (hf * 2 + mm) * 16 + fr;
        const float* src = l == 0 ? (t < TL ? pin(p, I_X) + (size_t)t * 1024 : pin(p, I_CTX) + (size_t)(t - TL) * 1024) : (const float*)(XA + (size_t)t * 1024);
#pragma unroll
        for (int n = 0; n < 4; ++n) xin[mm][n] = *(const f32x4*)(src + n0 + wc * 64 + n * 16 + fq * 4);
      }
#pragma unroll
      for (int mm = 0; mm < 2; ++mm) {
        const int t = m0 + wr * 64 + (hf * 2 + mm) * 16 + fr;
#pragma unroll
        for (int n = 0; n < 4; ++n) *(f32x4*)(XA + (size_t)t * 1024 + n0 + wc * 64 + n * 16 + fq * 4) = xin[mm][n] + gt[n] * acc[hf * 2 + mm][n];
      }
    }
  }
}

DEVI void grp_tiles(const Params& p, int* tst, int g, int shift, int nshared) {
  __syncthreads();
  if (p.tid < 64) {
    const int* CNT = (const int*)(p.ws + O_CNT);
    const int lane = p.tid;
    int c = 0;
    if (lane < 8) c = (__hip_atomic_load(&CNT[g + 8 * lane], __ATOMIC_RELAXED, __HIP_MEMORY_SCOPE_AGENT) + (1 << shift) - 1) >> shift;
    int incl = c;
#pragma unroll
    for (int o = 1; o < 8; o <<= 1) { int u = __shfl_up(incl, o); if (lane >= o) incl += u; }
    if (lane < 8) tst[lane] = incl - c;
    if (lane == 7) { tst[8] = incl; tst[9] = incl + (nshared - g + 7) / 8; }
  }
  __syncthreads();
}
DEVI void grp_find(const int* tst, int tile, int g, int& e, int& lt) {
  int j = 0;
#pragma unroll
  for (int k = 1; k <= 8; ++k) j += tile >= tst[k] ? 1 : 0;
  if (j < 8) { e = g + 8 * j; lt = tile - tst[j]; } else { e = 64; lt = g + 8 * (tile - tst[8]); }
}
DEVI void st_moe1(const Params& p, int l, int vb, int nvb, char* smem) {
  const int* CNT = (const int*)(p.ws + O_CNT); const int* LIST = (const int*)(p.ws + O_LIST);
  const u16* H = (const u16*)(p.ws + O_H); u16* HB = (u16*)(p.ws + O_HB);
  int* sslot = (int*)(smem + 4 * 128 * GLD * 2);
  int* TST = sslot + 128;
  const int g = vb & 7;
  const int nsh = l == 0 ? T : TL;
  grp_tiles(p, TST, g, 7, nsh / 128);
  const int total = TST[9];
  auto fetch_slot = [&](int item, int& e, int& n0) {
    const int tile = item >> 2; n0 = (item & 3) * 128;
    int lt; grp_find(TST, tile, g, e, lt);
    int slot = -1;
    if (p.tid < 128) {
      const int cnt = e < 64 ? __hip_atomic_load(&CNT[e], __ATOMIC_RELAXED, __HIP_MEMORY_SCOPE_AGENT) : nsh;
      const int i = lt * 128 + p.tid;
      if (i < cnt) slot = e < 64 ? LIST[(size_t)e * T + i] : NSLOT + i;
    }
    return slot;
  };
  int e = 0, n0 = 0, e_nx = 0, n0_nx = 0;
  int slot_nx = (vb >> 3) < total * 4 ? fetch_slot(vb >> 3, e_nx, n0_nx) : -1;
  for (int item = vb >> 3; item < total * 4; item += nvb >> 3) {
    e = e_nx; n0 = n0_nx;
    __syncthreads();
    if (p.tid < 128) sslot[p.tid] = slot_nx;
    __syncthreads();
    if (item + (nvb >> 3) < total * 4) slot_nx = fetch_slot(item + (nvb >> 3), e_nx, n0_nx);
    f32x4 acc[4][4];
    gemm_core<false, 2>(p.tid, [&](int r) { int sl = sslot[r]; int tk = sl < 0 ? 0 : (sl < NSLOT ? sl / 6 : sl - NSLOT); return H + (size_t)tk * LDH; },
                        (const u16*)(p.ws + O_WGUT) + ((size_t)e * 512 + n0) * LDW, LDW, 1024, acc, smem);
    {
      const int lane = p.tid & 63, wid = p.tid >> 6, wr = wid >> 1, wc = wid & 1, fr = lane & 15, fq = lane >> 4;
#pragma unroll
      for (int m = 0; m < 4; ++m) {
        const int sl = sslot[wr * 64 + m * 16 + fr];
        if (sl >= 0) {
          u32x4 pk;
#pragma unroll
          for (int n = 0; n < 4; ++n) pk[n] = pack2(siluf(acc[m][n][0]) * acc[m][n][1], siluf(acc[m][n][2]) * acc[m][n][3]);
          *(u32x4*)(HB + (size_t)sl * 256 + (n0 >> 1) + wc * 32 + fq * 8) = pk;
        }
      }
    }
  }
}
DEVI void st_moe2(const Params& p, int l, int vb, int nvb, char* smem) {
  const int* CNT = (const int*)(p.ws + O_CNT); const int* LIST = (const int*)(p.ws + O_LIST);
  const u16* HB = (const u16*)(p.ws + O_HB); u16* SO = (u16*)(p.ws + O_SLOT); const float* WTS = (const float*)(p.ws + O_WTS);
  constexpr int ALD = 264;
  u16* sA = (u16*)smem;
  u16* sB = sA + 64 * ALD;
  int* sslot = (int*)(sB + 2 * 128 * 72);
  int* TST = sslot + 64;
  const int tid = p.tid, lane = tid & 63, wid = tid >> 6, wr = wid >> 1, wc = wid & 1, fr = lane & 15, fq = lane >> 4;
  const int g = vb & 7;
  const int nsh = l == 0 ? T : TL;
  grp_tiles(p, TST, g, 6, nsh / 64);
  const int total = TST[9];
  for (int item = vb >> 3; item < total; item += nvb >> 3) {
    int e, lt; grp_find(TST, item, g, e, lt);
    const int cnt = e < 64 ? __hip_atomic_load(&CNT[e], __ATOMIC_RELAXED, __HIP_MEMORY_SCOPE_AGENT) : nsh;
    __syncthreads();
    if (tid < 64) { const int i = lt * 64 + tid; sslot[tid] = i < cnt ? (e < 64 ? LIST[(size_t)e * T + i] : NSLOT + i) : -1; }
    __syncthreads();
    const u16* Bbase = (const u16*)(p.ws + O_WDT) + (size_t)e * 1024 * 256;
    u32x4 rb0[4], rb1[4], rb2[4];
    const u16* bthr = Bbase + (size_t)(tid >> 3) * 256 + (tid & 7) * 8;
    auto gloadB = [&](u32x4 (&rb)[4], int bt) {
      int off = (bt >> 2) * 128 * 256 + (bt & 3) * 64;
      asm volatile("" : "+s"(off));
      const u16* src = bthr + off;
#pragma unroll
      for (int i = 0; i < 4; ++i) rb[i] = *(const u32x4*)(src + i * 32 * 256);
    };
    auto lstoreB = [&](const u32x4 (&rb)[4], int buf) {
      u16* d = sB + buf * 128 * 72;
#pragma unroll
      for (int i = 0; i < 4; ++i) { const int q = tid + 256 * i, r = q >> 3, cc = q & 7; *(u32x4*)&d[r * 72 + cc * 8] = rb[i]; }
    };
    gloadB(rb0, 0); gloadB(rb1, 1); gloadB(rb2, 2);
#pragma unroll
    for (int hf = 0; hf < 2; ++hf) {
      u32x4 ra[4];
#pragma unroll
      for (int i = 0; i < 4; ++i) { const int q = tid + 256 * (4 * hf + i), r = q >> 5, cc = q & 31; const int sl = sslot[r]; ra[i] = *(const u32x4*)(HB + (size_t)(sl < 0 ? 0 : sl) * 256 + cc * 8); }
#pragma unroll
      for (int i = 0; i < 4; ++i) { const int q = tid + 256 * (4 * hf + i), r = q >> 5, cc = q & 31; *(u32x4*)&sA[r * ALD + cc * 8] = ra[i]; }
      __builtin_amdgcn_sched_barrier(0);
    }
    int slot_m[2]; float w_m[2];
#pragma unroll
    for (int m = 0; m < 2; ++m) { const int sl = sslot[wr * 32 + m * 16 + fr]; slot_m[m] = sl; w_m[m] = (sl >= 0 && sl < NSLOT) ? WTS[sl] : 1.f; }
    lstoreB(rb0, 0); gloadB(rb0, 3);
    __syncthreads();
    f32x4 acc[2][4];
    auto compute = [&](int bt, int buf) {
      const int nt = bt >> 2, kt = bt & 3;
      const u16* b = sB + buf * 128 * 72;
      if (kt == 0) {
#pragma unroll
        for (int m = 0; m < 2; ++m)
#pragma unroll
          for (int n = 0; n < 4; ++n) acc[m][n] = fzero4();
      }
#pragma unroll
      for (int ks = 0; ks < 2; ++ks) {
        bf16x8 af[2], bfr[4];
#pragma unroll
        for (int m = 0; m < 2; ++m) af[m] = *(const bf16x8*)&sA[(wr * 32 + m * 16 + fr) * ALD + kt * 64 + ks * 32 + fq * 8];
#pragma unroll
        for (int n = 0; n < 4; ++n) bfr[n] = *(const bf16x8*)&b[(wc * 64 + (n >> 1) * 32 + (fr >> 2) * 8 + (n & 1) * 4 + (fr & 3)) * 72 + ks * 32 + fq * 8];
#pragma unroll
        for (int m = 0; m < 2; ++m)
#pragma unroll
          for (int n = 0; n < 4; ++n) acc[m][n] = MFMA16(bfr[n], af[m], acc[m][n]);
      }
      if (kt == 3) {
#pragma unroll
        for (int m = 0; m < 2; ++m) {
          if (slot_m[m] >= 0) {
            const float w = w_m[m];
#pragma unroll
            for (int h = 0; h < 2; ++h) {
              u32x4 pk;
              pk[0] = pack2(acc[m][2 * h][0] * w, acc[m][2 * h][1] * w); pk[1] = pack2(acc[m][2 * h][2] * w, acc[m][2 * h][3] * w);
              pk[2] = pack2(acc[m][2 * h + 1][0] * w, acc[m][2 * h + 1][1] * w); pk[3] = pack2(acc[m][2 * h + 1][2] * w, acc[m][2 * h + 1][3] * w);
              *(u32x4*)(SO + (size_t)slot_m[m] * 1024 + nt * 128 + wc * 64 + h * 32 + fq * 8) = pk;
            }
          }
        }
      }
    };
#pragma unroll
    for (int bt = 0; bt < 30; bt += 3) {
      compute(bt, bt & 1);           lstoreB(rb1, (bt + 1) & 1); if (bt + 4 < 32) gloadB(rb1, bt + 4); __syncthreads(); __builtin_amdgcn_sched_barrier(0);
      compute(bt + 1, (bt + 1) & 1); lstoreB(rb2, (bt + 2) & 1); if (bt + 5 < 32) gloadB(rb2, bt + 5); __syncthreads(); __builtin_amdgcn_sched_barrier(0);
      compute(bt + 2, (bt + 2) & 1); lstoreB(rb0, (bt + 3) & 1); if (bt + 6 < 32) gloadB(rb0, bt + 6); __syncthreads(); __builtin_amdgcn_sched_barrier(0);
    }
    compute(30, 0); lstoreB(rb1, 1); __syncthreads(); __builtin_amdgcn_sched_barrier(0);
    compute(31, 1); __syncthreads();
  }
}

DEVI void st_combine(const Params& p, int l, int vb, int nvb) {
  const int lane = p.tid & 63, wid = p.tid >> 6;
  const u16* SO = (const u16*)(p.ws + O_SLOT);
  const bool last = l == 1;
  const float* gnext = last ? pin(p, I_FNG) : pin(p, I_N1G) + 1024;
  const int tend = last ? TL : T;
  for (int t0 = (vb * 4 + wid) * 2; t0 < tend; t0 += nvb * 8) {
    const int mv = tok_mv(t0);
    const float* g5 = modp(p, l, mv, 5);
    u32x4 sv[2][7][2]; f32x4 xv[2][4];
#pragma unroll
    for (int u = 0; u < 2; ++u) {
      const int t = t0 + u;
#pragma unroll
      for (int k = 0; k < 7; ++k) {
        const u16* row = SO + (size_t)(k < 6 ? t * 6 + k : NSLOT + t) * 1024;
        sv[u][k][0] = *(const u32x4*)(row + lane * 8); sv[u][k][1] = *(const u32x4*)(row + 512 + lane * 8);
      }
      const float* xr = (const float*)(p.ws + O_XA) + (size_t)t * 1024;
      xv[u][0] = *(const f32x4*)(xr + lane * 8); xv[u][1] = *(const f32x4*)(xr + lane * 8 + 4);
      xv[u][2] = *(const f32x4*)(xr + 512 + lane * 8); xv[u][3] = *(const f32x4*)(xr + 512 + lane * 8 + 4);
    }
    f32x4 gq[4];
    gq[0] = *(const f32x4*)(g5 + lane * 8); gq[1] = *(const f32x4*)(g5 + lane * 8 + 4);
    gq[2] = *(const f32x4*)(g5 + 512 + lane * 8); gq[3] = *(const f32x4*)(g5 + 512 + lane * 8 + 4);
    float ss[2];
#pragma unroll
    for (int u = 0; u < 2; ++u) {
      float acc = 0.f;
#pragma unroll
      for (int hf = 0; hf < 2; ++hf) {
        f32x4 a0 = fzero4(), a1 = a0;
#pragma unroll
        for (int k = 0; k < 7; ++k) {
          const u32x4 v = sv[u][k][hf];
          a0[0] += bflo(v[0]); a0[1] += bfhi(v[0]); a0[2] += bflo(v[1]); a0[3] += bfhi(v[1]);
          a1[0] += bflo(v[2]); a1[1] += bfhi(v[2]); a1[2] += bflo(v[3]); a1[3] += bfhi(v[3]);
        }
        xv[u][2 * hf] += gq[2 * hf] * a0; xv[u][2 * hf + 1] += gq[2 * hf + 1] * a1;
#pragma unroll
        for (int e = 0; e < 4; ++e) acc += xv[u][2 * hf][e] * xv[u][2 * hf][e] + xv[u][2 * hf + 1][e] * xv[u][2 * hf + 1][e];
      }
      ss[u] = acc;
    }
#pragma unroll
    for (int o = 32; o >= 1; o >>= 1) { ss[0] += __shfl_xor(ss[0], o); ss[1] += __shfl_xor(ss[1], o); }
    f32x4 gn[4];
    gn[0] = *(const f32x4*)(gnext + lane * 8); gn[1] = *(const f32x4*)(gnext + lane * 8 + 4);
    gn[2] = *(const f32x4*)(gnext + 512 + lane * 8); gn[3] = *(const f32x4*)(gnext + 512 + lane * 8 + 4);
    if (!last) {
      const float* sh = modp(p, 1, mv, 0); const float* sc = modp(p, 1, mv, 1);
#pragma unroll
      for (int q = 0; q < 4; ++q) {
        const int c = (q >> 1) * 512 + lane * 8 + (q & 1) * 4;
        const f32x4 s4 = *(const f32x4*)(sc + c), h4 = *(const f32x4*)(sh + c);
        const f32x4 gs = gn[q] * (1.f + s4);
#pragma unroll
        for (int u = 0; u < 2; ++u) {
          const size_t t = t0 + u;
          const float rstd = rsqrtf(ss[u] * (1.f / 1024.f) + 1e-6f);
          *(f32x4*)((float*)(p.ws + O_XA) + t * 1024 + c) = xv[u][q];
          const f32x4 o = xv[u][q] * rstd * gs + h4;
          u32x2 pk; pk[0] = pack2(o[0], o[1]); pk[1] = pack2(o[2], o[3]);
          *(u32x2*)((u16*)(p.ws + O_H) + t * LDH + c) = pk;
        }
      }
    } else {
#pragma unroll
      for (int q = 0; q < 4; ++q) {
        const int c = (q >> 1) * 512 + lane * 8 + (q & 1) * 4;
#pragma unroll
        for (int u = 0; u < 2; ++u) {
          const size_t t = t0 + u;
          const float rstd = rsqrtf(ss[u] * (1.f / 1024.f) + 1e-6f);
          *(f32x4*)(p.out + t * 1024 + c) = xv[u][q] * rstd * gn[q];
        }
      }
    }
  }
}


#define STAGE(call) { const Params p = mkctx(a); call; }

#define XB_TMO      128
#define XB_XCNT(j)  (256  + 64 * (j))
#define XB_XSUB(j)  (1280 + 64 * (j))
#define XB_XGEN(j)  (2304 + 64 * (j))
#define XB_TOP      3328
#define XB_TOPGEN   3392
#define XCD_BAR_WORDS 3456
#define XB_SPIN_CAP (1u << 20)
#define LAS __attribute__((address_space(3)))
DEVI unsigned xb_ld(unsigned* p)              { return __hip_atomic_load(p, __ATOMIC_RELAXED, __HIP_MEMORY_SCOPE_AGENT); }
DEVI unsigned xb_add(unsigned* p, unsigned v) { return __hip_atomic_fetch_add(p, v, __ATOMIC_RELAXED, __HIP_MEMORY_SCOPE_AGENT); }
DEVI unsigned xb_xcc_id() { return (unsigned)__builtin_amdgcn_s_getreg((3 << 11) | 20) & 0xFu; }
#define XB_SPIN(cond, bar) do { unsigned _sp = 0; while (cond) { __builtin_amdgcn_s_sleep(1); \
    if ((++_sp & 255u) == 0u) { if (xb_ld(&(bar)[XB_TMO])) break; if (_sp > XB_SPIN_CAP) { atomicAdd(&(bar)[XB_TMO], 1u); break; } } } } while (0)
struct XcdBarrier { unsigned* bar; unsigned x; volatile LAS unsigned* st; };
DEVI XcdBarrier xcd_barrier_post(unsigned* bar, volatile LAS unsigned* st) {
  XcdBarrier b; b.bar = bar; b.x = xb_xcc_id(); b.st = st;
  if (threadIdx.x == 0) (void)xb_add(&bar[XB_XCNT(b.x)], 1u);
  return b;
}
DEVI void xcd_barrier_complete(unsigned* bar, unsigned x, unsigned& nloc, unsigned& nx) {
  const unsigned G = gridDim.x * gridDim.y * gridDim.z;
  unsigned sum, cnt, mine, sp = 0u;
  for (;;) {
    sum = 0u; cnt = 0u; mine = 0u;
#pragma unroll
    for (unsigned j = 0; j < 16; ++j) { const unsigned c = xb_ld(&bar[XB_XCNT(j)]); sum += c; cnt += (c > 0u) ? 1u : 0u; mine = (j == x) ? c : mine; }
    if (sum == G) break;
    __builtin_amdgcn_s_sleep(1);
    if ((++sp & 255u) == 0u) { if (xb_ld(&bar[XB_TMO])) break; if (sp > XB_SPIN_CAP) { atomicAdd(&bar[XB_TMO], 1u); break; } }
  }
  nloc = mine > 0u ? mine : 1u; nx = cnt > 0u ? cnt : 1u;
}
DEVI void xcd_barrier(const XcdBarrier& b) {
  asm volatile("s_waitcnt vmcnt(0)" ::: "memory");
  __syncthreads();
  if (threadIdx.x == 0) {
    unsigned* bar = b.bar;
    __builtin_amdgcn_s_waitcnt(0);
    unsigned nloc = b.st[0], nx = b.st[1];
    if (nloc == 0u) { xcd_barrier_complete(bar, b.x, nloc, nx); b.st[0] = nloc; b.st[1] = nx; }
    const unsigned old = xb_add(&bar[XB_XSUB(b.x)], 1u);
    const unsigned gen = old / nloc;
    if (old + 1u == (gen + 1u) * nloc) {
      __builtin_amdgcn_fence(__ATOMIC_RELEASE, "agent");
      asm volatile("s_waitcnt vmcnt(0)" ::: "memory");
      const unsigned og = xb_add(&bar[XB_TOP], 1u);
      const unsigned tg = og / nx;
      if (og + 1u == (tg + 1u) * nx) xb_add(&bar[XB_TOPGEN], 1u);
      else XB_SPIN(xb_ld(&bar[XB_TOPGEN]) == tg, bar);
      __builtin_amdgcn_fence(__ATOMIC_ACQUIRE, "agent");
      xb_add(&bar[XB_XGEN(b.x)], 1u);
      asm volatile("s_waitcnt vmcnt(0)" ::: "memory");
    } else {
      XB_SPIN(xb_ld(&bar[XB_XGEN(b.x)]) == gen, bar);
      __builtin_amdgcn_fence(__ATOMIC_ACQUIRE, "agent");
      asm volatile("s_waitcnt vmcnt(0)" ::: "memory");
    }
  }
  __syncthreads();
}
#define GSYNC() { XcdBarrier xb_; xb_.bar = (unsigned*)(mkctx(a).ws + O_XBAR); xb_.x = xb_xcc_id(); xb_.st = (volatile LAS unsigned*)(smem + SMEM_BYTES - 32); xcd_barrier(xb_); }

__global__ void __launch_bounds__(256, 2) mega(KArgs a) {
  extern __shared__ __attribute__((aligned(16))) char smem[];
  cg::grid_group grid = cg::this_grid();
  const int vb = blockIdx.x, nvb = gridDim.x;
  volatile LAS unsigned* xst = (volatile LAS unsigned*)(smem + SMEM_BYTES - 32);
  if (threadIdx.x == 0) { xst[0] = 0u; xst[1] = 0u; }
  __syncthreads();
  (void)xcd_barrier_post((unsigned*)(a.ws + O_XBAR), xst);
  if (threadIdx.x == 0) {
    const float** tab = (const float**)(a.ws + O_TAB);
#pragma unroll
    for (int i = 0; i < 35; ++i) tab[i] = a.in[i];
  }
  __syncthreads();
  STAGE(st_rope_table(p, vb, nvb));
  STAGE(st_mod(p, vb, nvb, smem));
  STAGE(st_prep_w1(p, 0, vb, nvb, smem));
  if (a.ws == nullptr) grid.sync();
  GSYNC();
  for (int l = 0; l < 2; ++l) {
    if (l == 0) { STAGE(st_norm1(p, 0, vb, nvb)); GSYNC(); }
    {
      const int g = vb & 7;
      for (int i = vb >> 3; i < 363; i += nvb >> 3) {
        int mt, nt;
        if (i < 264) { mt = i >> 1; nt = g + 8 * (i & 1); }
        else { const int j = i - 264, pc = g + 8 * (j / 33); nt = 16 + (pc >> 2); mt = (pc & 3) * 33 + (j % 33); }
        const Params p = mkctx(a); inproj_item(p, mt * 22 + nt, smem);
      }
    }
    GSYNC();
    STAGE(st_tokprep(p, l, vb, nvb));
    GSYNC();
    {
      for (int item = vb; item < 132 * 7 + NGITEM; item += nvb) {
        const Params p = mkctx(a);
        if (item < 132 * 7) mla_up_tile(p, item / 7, item % 7, smem);
        else gdn_chunk_item(p, item - 132 * 7, smem);
      }
    }
    GSYNC();
    st_mixer_queue(a, l, smem);
    GSYNC();
    STAGE(st_mix_finish(p, l, vb, nvb));
    GSYNC();
    STAGE(st_outproj(p, l, vb, nvb, smem));
    GSYNC();
    STAGE(st_norm2_route(p, l, vb, nvb, smem));
    GSYNC();
    STAGE(st_moe1(p, l, vb, nvb, smem));
    GSYNC();
    STAGE(st_moe2(p, l, vb, nvb, smem));
    GSYNC();
    if (l == 0) STAGE(st_prep_w1(p, 1, vb, nvb, smem));
    STAGE(st_combine(p, l, vb, nvb));
    if (l == 0) GSYNC();
  }
}

extern "C" void kernel_launch(void* const* d_in, const int* in_sizes, int n_in, void* d_out, int out_size, void* d_ws, size_t ws_size,
                              hipStream_t stream) {
  static int grid_blocks = 0;
  if (!grid_blocks) {
    int dev = 0, cus = 0, per_cu = 0;
    (void)hipGetDevice(&dev);
    (void)hipDeviceGetAttribute(&cus, hipDeviceAttributeMultiprocessorCount, dev);
    (void)hipFuncSetAttribute((const void*)mega, hipFuncAttributeMaxDynamicSharedMemorySize, SMEM_BYTES);
    (void)hipOccupancyMaxActiveBlocksPerMultiprocessor(&per_cu, mega, 256, SMEM_BYTES);
    if (per_cu > 2) per_cu = 2;
    if (per_cu < 1) per_cu = 1;
    grid_blocks = cus * per_cu;
  }
  KArgs p{};
  for (int i = 0; i < 35; ++i) p.in[i] = (const float*)d_in[i];
  p.out = (float*)d_out; p.ws = (char*)d_ws;
  if (ws_size < WS_NEED) { fprintf(stderr, "workspace too small: %zu < %zu\n", ws_size, (size_t)WS_NEED); return; }
  (void)hipMemsetAsync((char*)d_ws + O_BAR, 0, 256 + 16384, stream);
  void* args[] = {&p};
  hipError_t e = hipLaunchCooperativeKernel((void*)mega, dim3(grid_blocks), dim3(256), args, SMEM_BYTES, stream);
  if (e != hipSuccess) fprintf(stderr, "cooperative launch failed: %s (grid %d)\n", hipGetErrorString(e), grid_blocks);
}
```

```cpp
#include <hip/hip_runtime.h>
#include <hip/hip_cooperative_groups.h>
#include <cstdio>
#include <cstdint>
namespace cg = cooperative_groups;

#define DEVI __device__ __forceinline__
typedef unsigned short u16;
using bf16x8 = __attribute__((ext_vector_type(8))) short;
using f32x4  = __attribute__((ext_vector_type(4))) float;
using f32x2  = __attribute__((ext_vector_type(2))) float;
using f32x16 = __attribute__((ext_vector_type(16))) float;
using u32x4 = __attribute__((ext_vector_type(4))) unsigned;
using u32x2 = __attribute__((ext_vector_type(2))) unsigned;
typedef __bf16 bf16x2_t __attribute__((ext_vector_type(2)));

constexpr int DM = 1024, SEQ = 8192, CTXL = 256, NKEY = SEQ + CTXL;
constexpr int TL = 2 * SEQ, TC = 2 * CTXL, T = TL + TC;
constexpr int INW = 2672;
constexpr int NIN = 2816;
constexpr int LDPP = 1408;
constexpr int PP_CQ = 0, PP_CKV = 192, PP_DQKV = 320, PP_DZ = 1088, PP_GATE = 1344;
constexpr int NE = 64, NSLOT = 6 * T;
constexpr int LDW = 1088;
constexpr int LDH = 1088;
constexpr int NCHUNK = T / 64;
constexpr int NGITEM = NCHUNK * 8;
constexpr float LOG2E = 1.4426950408889634f;

constexpr size_t al256(size_t x) { return (x + 255) & ~(size_t)255; }
constexpr size_t O_MOD   = 0;
constexpr size_t O_ROPE  = O_MOD + al256((size_t)2 * 3 * 6144 * 4);
constexpr size_t O_XA    = O_ROPE + (size_t)SEQ * 48 * 8;
constexpr size_t O_H     = O_XA + (size_t)T * DM * 4;
constexpr size_t O_WINT  = O_H + (size_t)T * LDH * 2;
constexpr size_t O_WOUTT = O_WINT + (size_t)NIN * LDW * 2;
constexpr size_t O_WUQT  = O_WOUTT + (size_t)1024 * LDW * 2;
constexpr size_t O_WUKVT = O_WUQT + (size_t)384 * 192 * 2;
constexpr size_t O_WGUT  = O_WUKVT + (size_t)512 * 128 * 2;
constexpr size_t O_WDT   = O_WGUT + (size_t)65 * 512 * LDW * 2;
constexpr size_t O_WTS   = O_WDT + (size_t)65 * 1024 * 256 * 2;
constexpr size_t O_CNT   = O_WTS + al256((size_t)NSLOT * 4);
constexpr size_t O_TAB   = O_CNT + 256;
constexpr size_t O_BAR   = O_TAB + 512;
constexpr size_t O_XBAR  = O_BAR + 256;
constexpr size_t O_LIST  = O_XBAR + 16384;
constexpr size_t O_R     = O_LIST + (size_t)NE * T * 4;
constexpr size_t O_Y     = O_R;
constexpr size_t O_PP    = O_Y + (size_t)T * DM * 2;
constexpr size_t O_QA    = O_PP + (size_t)T * LDPP * 2;
constexpr size_t O_KA    = O_QA + (size_t)2 * 4 * NKEY * 64 * 2;
constexpr size_t O_VTA   = O_KA + (size_t)2 * 2 * NKEY * 64 * 2;
constexpr size_t O_QB    = O_VTA + (size_t)2 * 2 * NKEY * 64 * 2;
constexpr size_t O_KB    = O_QB + (size_t)2 * 8 * NKEY * 32 * 2;
constexpr size_t O_VTB   = O_KB + (size_t)2 * 8 * NKEY * 32 * 2;
constexpr size_t O_QC    = O_VTB + (size_t)2 * 4 * NKEY * 64 * 2;
constexpr size_t O_KC    = O_QC + (size_t)2 * 4 * NKEY * 96 * 2;
constexpr size_t O_VTC   = O_KC + (size_t)2 * 4 * NKEY * 96 * 2;
constexpr size_t O_CQN   = O_VTC + (size_t)2 * 4 * NKEY * 64 * 2;
constexpr size_t O_CKVN  = O_CQN + (size_t)T * 192 * 2;
constexpr size_t O_OB    = O_CKVN + (size_t)T * 128 * 2;
constexpr size_t O_GQ    = O_OB + (size_t)T * 512 * 2;
constexpr size_t O_GK    = O_GQ + (size_t)T * 256 * 2;
constexpr size_t O_GV    = O_GK + (size_t)T * 256 * 2;
constexpr size_t O_GG    = O_GV + (size_t)T * 256 * 2;
constexpr size_t O_GBETA = O_GG + (size_t)2 * T * 4 * 4;
constexpr size_t O_GM    = O_GBETA + (size_t)2 * T * 4 * 4;
constexpr size_t O_GQP   = O_GM + (size_t)NGITEM * 4096 * 2;
constexpr size_t O_GN    = O_GQP + (size_t)NGITEM * 4096 * 2;
constexpr size_t O_GLO   = O_GN + (size_t)NGITEM * 4096 * 2;
constexpr size_t O_GO    = O_GLO + (size_t)NGITEM * 4096 * 2;
constexpr size_t O_MIX_END = O_GO + (size_t)2 * T * 256 * 4;
constexpr size_t O_HB    = O_R;
constexpr size_t O_SLOT  = O_HB + (size_t)7 * T * 256 * 2;
constexpr size_t O_MOE_END = O_SLOT + (size_t)7 * T * 1024 * 2;
constexpr size_t cmax(size_t a, size_t b) { return a > b ? a : b; }
constexpr size_t WS_NEED = cmax(O_MIX_END, O_MOE_END);
static_assert(WS_NEED < (size_t)556000000, "workspace too large");

struct KArgs {
  const float* in[35];
  float* out;
  char* ws;
};
typedef const __attribute__((address_space(1))) float gcfloat;
struct Params {
  char* ws;
  float* out;
  gcfloat* const* in;
  int tid;
};
#define pin(p, i) ((const float*)(p).in[i])
enum { I_X = 0, I_C, I_CTX, I_CCTX, I_WADA, I_BADA, I_N1G, I_N2G, I_WIN, I_WOUT, I_SINK, I_LQ1, I_LK1, I_LQ2, I_LK2,
       I_DNG, I_MQG, I_MKVG, I_WUQ, I_WUKV, I_CONVW, I_ALF, I_ALB, I_DTF, I_DTB, I_GNG, I_WR, I_RB, I_WG, I_WU, I_WD,
       I_SG, I_SU, I_SD, I_FNG };

DEVI u16 f2bf(float f) { unsigned u = __float_as_uint(f); u += 0x7fffu + ((u >> 16) & 1u); return (u16)(u >> 16); }
DEVI float bf2f(u16 h) { return __uint_as_float(((unsigned)h) << 16); }
DEVI float bflo(unsigned v) { return __uint_as_float(v << 16); }
DEVI float bfhi(unsigned v) { return __uint_as_float(v & 0xffff0000u); }
DEVI unsigned pack2(float a, float b) { f32x2 v = {a, b}; return __builtin_bit_cast(unsigned, __builtin_convertvector(v, bf16x2_t)); }
DEVI f32x4 fzero4() { float z = 0.f; asm volatile("" : "+v"(z)); return f32x4{z, z, z, z}; }
DEVI float wave_sum(float v) {
#pragma unroll
  for (int o = 32; o >= 1; o >>= 1) v += __shfl_xor(v, o);
  return v;
}
DEVI float half_sum(float v) {
#pragma unroll
  for (int o = 16; o >= 1; o >>= 1) v += __shfl_xor(v, o);
  return v;
}
DEVI float siluf(float x) { return x / (1.f + __expf(-x)); }
DEVI float sigmf(float x) { return 1.f / (1.f + __expf(-x)); }
DEVI int tok_mv(int t) { return t < TL ? (t >> 13) : 2; }
DEVI int tok_b(int t) { return t < TL ? (t >> 13) : ((t - TL) >> 8); }
DEVI int tok_row(int t) { return t < TL ? (t & (SEQ - 1)) : (SEQ + ((t - TL) & (CTXL - 1))); }
DEVI const float* modp(const Params& p, int l, int mv, int j) { return (const float*)(p.ws + O_MOD) + ((size_t)(l * 3 + mv) * 6 + j) * 1024; }

#define MFMA16(a, b, c) __builtin_amdgcn_mfma_f32_16x16x32_bf16((a), (b), (c), 0, 0, 0)
#define MFMA32(a, b, c) __builtin_amdgcn_mfma_f32_32x32x16_bf16((a), (b), (c), 0, 0, 0)

DEVI void st_copy_in(const Params& p, int vb, int nvb) {
  float4* xa = (float4*)(p.ws + O_XA);
  const float4* x = (const float4*)pin(p, I_X);
  const float4* cx = (const float4*)pin(p, I_CTX);
  const size_t n4 = (size_t)T * DM / 4, nl4 = (size_t)TL * DM / 4;
  for (size_t i = (size_t)vb * 256 + p.tid; i < n4; i += (size_t)nvb * 256) xa[i] = i < nl4 ? x[i] : cx[i - nl4];
}
DEVI void rope_cs(int i, int half, int s, float& c, float& sn) {
  const int quarter = half >> 1;
  const int ii = i < quarter ? i : i - quarter;
  const float pos = i < quarter ? (float)(s >> 6) : (float)(s & 63);
  const float inv = powf(10000.f, -(float)ii / (float)quarter);
  const float ang = pos * inv;
  c = cosf(ang); sn = sinf(ang);
}
DEVI void st_rope_table(const Params& p, int vb, int nvb) {
  f32x2* R = (f32x2*)(p.ws + O_ROPE);
  for (int e = vb * 256 + p.tid; e < SEQ * 48; e += nvb * 256) {
    const int s = e / 48, i = e % 48;
    float c, sn;
    if (i < 32) rope_cs(i, 32, s, c, sn); else rope_cs(i - 32, 16, s, c, sn);
    R[e] = f32x2{c, sn};
  }
}
DEVI void st_mod(const Params& p, int vb, int nvb, char* smem) {
  float* sv = (float*)smem;
  float* red = sv + 3 * 1024;
  for (int i = p.tid; i < 3 * 1024; i += 256) {
    int v = i >> 10, k = i & 1023;
    float c = v < 2 ? pin(p, I_C)[v * 1024 + k] : pin(p, I_CCTX)[k];
    sv[i] = siluf(c);
  }
  __syncthreads();
  const int cgp = p.tid & 7, kg = p.tid >> 3;
  for (int item = vb; item < 2 * 192; item += nvb) {
    const int l = item / 192, c0 = (item % 192) * 32;
    const float* w = pin(p, I_WADA) + (size_t)l * 1024 * 6144 + c0 + cgp * 4;
    f32x4 a0 = fzero4(), a1 = a0, a2 = a0;
#pragma unroll 8
    for (int kk = 0; kk < 32; ++kk) {
      const int k = kg * 32 + kk;
      const f32x4 wv = *(const f32x4*)(w + (size_t)k * 6144);
      a0 += sv[k] * wv; a1 += sv[1024 + k] * wv; a2 += sv[2048 + k] * wv;
    }
    float* rp = red + (kg * 8 + cgp) * 12;
    *(f32x4*)rp = a0; *(f32x4*)(rp + 4) = a1; *(f32x4*)(rp + 8) = a2;
    __syncthreads();
    if (p.tid < 96) {
      const int v = p.tid >> 5, c = p.tid & 31;
      float s = 0.f;
#pragma unroll 8
      for (int g = 0; g < 32; ++g) s += red[(g * 8 + (c >> 2)) * 12 + v * 4 + (c & 3)];
      ((float*)(p.ws + O_MOD))[(size_t)(l * 3 + v) * 6144 + c0 + c] = s + pin(p, I_BADA)[l * 6144 + c0 + c];
    }
    __syncthreads();
  }
}

template <class RowFn>
DEVI void tr_tile(int tid, const float* __restrict__ src, int N, u16* __restrict__ dst, int ldd, RowFn drow, int k0, int n0, float* tile) {
  {
    const int kq = tid >> 4, n4 = (tid & 15) * 4;
    f32x4 v[4];
#pragma unroll
    for (int r = 0; r < 4; ++r) {
      const int k = r * 16 + kq;
      v[r] = n0 + n4 < N ? *(const f32x4*)(src + (size_t)(k0 + k) * N + n0 + n4) : fzero4();
    }
#pragma unroll
    for (int r = 0; r < 4; ++r) {
      const int k = r * 16 + kq;
      tile[k * 65 + n4] = v[r][0]; tile[k * 65 + n4 + 1] = v[r][1]; tile[k * 65 + n4 + 2] = v[r][2]; tile[k * 65 + n4 + 3] = v[r][3];
    }
  }
  __syncthreads();
  {
    const int n = tid >> 2, kc = (tid & 3) * 16;
    const int dr = drow(n0 + n);
    if (dr >= 0) {
      u32x4 o0, o1;
#pragma unroll
      for (int e = 0; e < 4; ++e) {
        o0[e] = pack2(tile[(kc + 2 * e) * 65 + n], tile[(kc + 2 * e + 1) * 65 + n]);
        o1[e] = pack2(tile[(kc + 8 + 2 * e) * 65 + n], tile[(kc + 8 + 2 * e + 1) * 65 + n]);
      }
      u16* d = dst + (size_t)dr * ldd + k0 + kc;
      *(u32x4*)d = o0; *(u32x4*)(d + 8) = o1;
    }
  }
  __syncthreads();
}
DEVI int win_row(int n) {
  if (n < 1280) return n;
  if (n < 1600) return 1408 + (n - 1280);
  if (n < 1632) return 1280 + (n - 1600);
  if (n < INW) return 1408 + 320 + (n - 1632);
  return -1;
}
constexpr int TR_IN = 16 * 42, TR_OUT = 256, TR_UQ = 18, TR_UKV = 16, TR_E = 4096, TR_S = 64;
constexpr int TR_P1 = TR_IN + TR_OUT + TR_UQ + TR_UKV;
constexpr int TR_P2 = 3 * TR_E + 3 * TR_S;
DEVI void prep_w1_tile(const Params& p, int l, int it, float* tile) {
  if (it < TR_IN) { tr_tile(p.tid, pin(p, I_WIN) + (size_t)l * 1024 * INW, INW, (u16*)(p.ws + O_WINT), LDW, [](int n) { return win_row(n); }, (it / 42) * 64, (it % 42) * 64, tile); return; }
  it -= TR_IN;
  if (it < TR_OUT) { tr_tile(p.tid, pin(p, I_WOUT) + (size_t)l * 1024 * 1024, 1024, (u16*)(p.ws + O_WOUTT), LDW, [](int n) { return n; }, (it / 16) * 64, (it % 16) * 64, tile); return; }
  it -= TR_OUT;
  if (it < TR_UQ) { tr_tile(p.tid, pin(p, I_WUQ) + (size_t)l * 192 * 384, 384, (u16*)(p.ws + O_WUQT), 192, [](int n) { return n; }, (it / 6) * 64, (it % 6) * 64, tile); return; }
  it -= TR_UQ;
  tr_tile(p.tid, pin(p, I_WUKV) + (size_t)l * 128 * 512, 512, (u16*)(p.ws + O_WUKVT), 128,
          [](int n) { const int h = n >> 7, j = n & 127; return j < 64 ? h * 64 + j : 256 + h * 64 + (j - 64); }, (it / 8) * 64, (it % 8) * 64, tile);
}
DEVI void prep_w2_tile(const Params& p, int l, int it, float* tile) {
  if (it < 2 * TR_E) {
    const int which = it / TR_E; it %= TR_E;
    const int e = it >> 6, tt = it & 63;
    const float* src = pin(p, which ? I_WU : I_WG) + ((size_t)l * NE + e) * 1024 * 256;
    tr_tile(p.tid, src, 256, (u16*)(p.ws + O_WGUT) + (size_t)e * 512 * LDW, LDW, [which](int n) { return 2 * n + which; }, (tt >> 2) * 64, (tt & 3) * 64, tile); return;
  }
  it -= 2 * TR_E;
  if (it < TR_E) {
    const int e = it >> 6, tt = it & 63;
    const float* src = pin(p, I_WD) + ((size_t)l * NE + e) * 256 * 1024;
    tr_tile(p.tid, src, 1024, (u16*)(p.ws + O_WDT) + (size_t)e * 1024 * 256, 256, [](int n) { return n; }, (tt >> 4) * 64, (tt & 15) * 64, tile); return;
  }
  it -= TR_E;
  if (it < 2 * TR_S) {
    const int which = it / TR_S; const int tt = it % TR_S;
    const float* src = pin(p, which ? I_SU : I_SG) + (size_t)l * 1024 * 256;
    tr_tile(p.tid, src, 256, (u16*)(p.ws + O_WGUT) + (size_t)64 * 512 * LDW, LDW, [which](int n) { return 2 * n + which; }, (tt >> 2) * 64, (tt & 3) * 64, tile); return;
  }
  it -= 2 * TR_S;
  { const int tt = it;
    const float* src = pin(p, I_SD) + (size_t)l * 256 * 1024;
    tr_tile(p.tid, src, 1024, (u16*)(p.ws + O_WDT) + (size_t)64 * 1024 * 256, 256, [](int n) { return n; }, (tt >> 4) * 64, (tt & 15) * 64, tile); }
}
struct TrDesc { const float* src; u16* dst; int N, ldd, rs, ro, k0, n0; };
DEVI TrDesc w2_desc(const Params& p, int l, int it) {
  TrDesc d;
  if (it < 2 * TR_E) {
    const int which = it / TR_E; it %= TR_E;
    const int e = it >> 6, tt = it & 63;
    d.src = pin(p, which ? I_WU : I_WG) + ((size_t)l * NE + e) * 1024 * 256; d.N = 256;
    d.dst = (u16*)(p.ws + O_WGUT) + (size_t)e * 512 * LDW; d.ldd = LDW; d.rs = 2; d.ro = which; d.k0 = (tt >> 2) * 64; d.n0 = (tt & 3) * 64;
    return d;
  }
  it -= 2 * TR_E;
  if (it < TR_E) {
    const int e = it >> 6, tt = it & 63;
    d.src = pin(p, I_WD) + ((size_t)l * NE + e) * 256 * 1024; d.N = 1024;
    d.dst = (u16*)(p.ws + O_WDT) + (size_t)e * 1024 * 256; d.ldd = 256; d.rs = 1; d.ro = 0; d.k0 = (tt >> 4) * 64; d.n0 = (tt & 15) * 64;
    return d;
  }
  it -= TR_E;
  if (it < 2 * TR_S) {
    const int which = it / TR_S; const int tt = it % TR_S;
    d.src = pin(p, which ? I_SU : I_SG) + (size_t)l * 1024 * 256; d.N = 256;
    d.dst = (u16*)(p.ws + O_WGUT) + (size_t)64 * 512 * LDW; d.ldd = LDW; d.rs = 2; d.ro = which; d.k0 = (tt >> 2) * 64; d.n0 = (tt & 3) * 64;
    return d;
  }
  it -= 2 * TR_S;
  d.src = pin(p, I_SD) + (size_t)l * 256 * 1024; d.N = 1024;
  d.dst = (u16*)(p.ws + O_WDT) + (size_t)64 * 1024 * 256; d.ldd = 256; d.rs = 1; d.ro = 0; d.k0 = (it >> 4) * 64; d.n0 = (it & 15) * 64;
  return d;
}
DEVI void tr_load(int tid, const TrDesc& d, f32x4 (&v)[4]) {
  const int kq = tid >> 4, n4 = (tid & 15) * 4;
#pragma unroll
  for (int r = 0; r < 4; ++r) v[r] = *(const f32x4*)(d.src + (size_t)(d.k0 + r * 16 + kq) * d.N + d.n0 + n4);
}
DEVI void tr_process(int tid, const TrDesc& d, const f32x4 (&v)[4], float* tile) {
  {
    const int kq = tid >> 4, n4 = (tid & 15) * 4;
#pragma unroll
    for (int r = 0; r < 4; ++r) {
      const int k = r * 16 + kq;
      tile[k * 65 + n4] = v[r][0]; tile[k * 65 + n4 + 1] = v[r][1]; tile[k * 65 + n4 + 2] = v[r][2]; tile[k * 65 + n4 + 3] = v[r][3];
    }
  }
  __syncthreads();
  {
    const int n = tid >> 2, kc = (tid & 3) * 16;
    u32x4 o0, o1;
#pragma unroll
    for (int e = 0; e < 4; ++e) {
      o0[e] = pack2(tile[(kc + 2 * e) * 65 + n], tile[(kc + 2 * e + 1) * 65 + n]);
      o1[e] = pack2(tile[(kc + 8 + 2 * e) * 65 + n], tile[(kc + 8 + 2 * e + 1) * 65 + n]);
    }
    u16* o = d.dst + (size_t)((d.n0 + n) * d.rs + d.ro) * d.ldd + d.k0 + kc;
    *(u32x4*)o = o0; *(u32x4*)(o + 8) = o1;
  }
  __syncthreads();
}
DEVI void prep_w2_run8(const Params& p, int l, int it0, float* tile) {
  f32x4 va[4], vb4[4];
  TrDesc da = w2_desc(p, l, it0), db = da;
  __syncthreads();
  tr_load(p.tid, da, va);
#pragma unroll 1
  for (int k = 0; k < 8; k += 2) {
    db = w2_desc(p, l, it0 + k + 1);
    tr_load(p.tid, db, vb4);
    tr_process(p.tid, da, va, tile);
    if (k + 2 < 8) { da = w2_desc(p, l, it0 + k + 2); tr_load(p.tid, da, va); }
    tr_process(p.tid, db, vb4, tile);
  }
}
DEVI void st_prep_w1(const Params& p, int l, int vb, int nvb, char* smem) {
  float* tile = (float*)smem;
  if (vb == 0 && p.tid < 64) ((int*)(p.ws + O_CNT))[p.tid] = 0;
  for (int e = vb * 256 + p.tid; e < 144 * 128; e += nvb * 256) {
    const int r = e >> 7, c8 = e & 127;
    const int row = r < 96 ? 1312 + r : 2768 + (r - 96);
    *(u32x4*)((u16*)(p.ws + O_WINT) + (size_t)row * LDW + c8 * 8) = __builtin_bit_cast(u32x4, fzero4());
  }
  for (int item = vb; item < TR_P1; item += nvb) prep_w1_tile(p, l, item, tile);
}

DEVI void st_norm1(const Params& p, int l, int vb, int nvb) {
  const int lane = p.tid & 63, wid = p.tid >> 6;
  const float* g = pin(p, I_N1G) + l * 1024;
  for (int t4 = (vb * 4 + wid) * 4; t4 < T; t4 += nvb * 16) {
    const int mv = tok_mv(t4);
    const float* sh = modp(p, l, mv, 0); const float* sc = modp(p, l, mv, 1);
    f32x4 v[4][4]; float ss[4];
#pragma unroll
    for (int u = 0; u < 4; ++u) {
      const int t = t4 + u;
      const f32x4* xr = (const f32x4*)(t < TL ? pin(p, I_X) + (size_t)t * 1024 : pin(p, I_CTX) + (size_t)(t - TL) * 1024);
#pragma unroll
      for (int i = 0; i < 4; ++i) v[u][i] = xr[i * 64 + lane];
    }
#pragma unroll
    for (int u = 0; u < 4; ++u) {
      float a = 0.f;
#pragma unroll
      for (int i = 0; i < 4; ++i) a += v[u][i][0] * v[u][i][0] + v[u][i][1] * v[u][i][1] + v[u][i][2] * v[u][i][2] + v[u][i][3] * v[u][i][3];
      ss[u] = a;
    }
#pragma unroll
    for (int o = 32; o >= 1; o >>= 1) {
#pragma unroll
      for (int u = 0; u < 4; ++u) ss[u] += __shfl_xor(ss[u], o);
    }
#pragma unroll
    for (int i = 0; i < 4; ++i) {
      const int c = i * 256 + lane * 4;
      const f32x4 gg = *(const f32x4*)(g + c), s4 = *(const f32x4*)(sc + c), h4 = *(const f32x4*)(sh + c);
      const f32x4 gs = gg * (1.f + s4);
#pragma unroll
      for (int u = 0; u < 4; ++u) {
        const float rstd = rsqrtf(ss[u] * (1.f / 1024.f) + 1e-6f);
        const f32x4 o = v[u][i] * rstd * gs + h4;
        u32x2 pk; pk[0] = pack2(o[0], o[1]); pk[1] = pack2(o[2], o[3]);
        *(u32x2*)((u16*)(p.ws + O_H) + (size_t)(t4 + u) * LDH + c) = pk;
      }
    }
  }
}

constexpr int GLD = 72;
typedef const __attribute__((address_space(1))) unsigned gcu32;
typedef __attribute__((address_space(3))) unsigned lu32;
DEVI int bperm_row(int BP, int n, int fr) {
  return BP == 0 ? n * 16 + fr : BP == 1 ? (n >> 1) * 32 + (fr >> 2) * 8 + (n & 1) * 4 + (fr & 3) : (fr >> 2) * 16 + n * 4 + (fr & 3);
}
DEVI int bperm_swz(int BP, int R) { return BP == 0 ? (R & 7) : BP == 1 ? ((R & 3) | ((R >> 1) & 4)) : ((R & 3) | ((R >> 2) & 4)); }
template <bool SWAP, int BP = 0, bool AP = false, class ARow>
DEVI void gemm_core(int tid, ARow arow, const u16* __restrict__ Bt, int ldb, int K, f32x4 (&acc)[4][4], char* smem) {
  constexpr int TILE = 128 * 64;
  u16* sbuf = (u16*)smem;
  const int lane = tid & 63, wid = tid >> 6, wr = wid >> 1, wc = wid & 1, fr = lane & 15, fq = lane >> 4;
  const u16* ap[4]; const u16* bp[4];
#pragma unroll
  for (int i = 0; i < 4; ++i) {
    const int q = tid + 256 * i, row = q >> 3, cs = (q & 7) ^ (row & 7), csb = (q & 7) ^ bperm_swz(BP, row);
    ap[i] = arow(row) + cs * 8; bp[i] = Bt + (size_t)row * ldb + csb * 8;
  }
  const int nk = K >> 6;
  auto stage = [&](int kt, int buf) {
    int off = kt * 64; asm volatile("" : "+s"(off));
    u16* dA = sbuf + buf * 2 * TILE + tid * 8; u16* dB = dA + TILE;
#pragma unroll
    for (int i = 0; i < 4; ++i) {
      __builtin_amdgcn_global_load_lds((gcu32*)(ap[i] + off), (lu32*)(dA + i * 2048), 16, 0, 0);
      __builtin_amdgcn_global_load_lds((gcu32*)(bp[i] + off), (lu32*)(dB + i * 2048), 16, 0, 0);
    }
  };
  auto compute = [&](int buf) {
    const u16* sA = sbuf + buf * 2 * TILE; const u16* sB = sA + TILE;
#pragma unroll
    for (int ks = 0; ks < 2; ++ks) {
      bf16x8 af[4], bfr[4];
#pragma unroll
      for (int m = 0; m < 4; ++m) {
        int R = wr * 64 + m * 16 + fr;
        if (AP) { const int pos = (m >> 1) * 32 + (fr >> 2) * 8 + (m & 1) * 4 + (fr & 3), j = (pos >> 2) & 3; R = wr * 64 + ((pos & ~15) | ((((j & 1) << 1) | (j >> 1)) << 2) | (pos & 3)); }
        af[m] = *(const bf16x8*)&sA[R * 64 + (((ks * 4 + fq) ^ (R & 7)) << 3)];
      }
#pragma unroll
      for (int n = 0; n < 4; ++n) { const int R = wc * 64 + bperm_row(BP, n, fr); bfr[n] = *(const bf16x8*)&sB[R * 64 + (((ks * 4 + fq) ^ bperm_swz(BP, R)) << 3)]; }
#pragma unroll
      for (int m = 0; m < 4; ++m)
#pragma unroll
        for (int n = 0; n < 4; ++n) acc[m][n] = SWAP ? MFMA16(af[m], bfr[n], acc[m][n]) : MFMA16(bfr[n], af[m], acc[m][n]);
    }
  };
#pragma unroll
  for (int m = 0; m < 4; ++m)
#pragma unroll
    for (int n = 0; n < 4; ++n) acc[m][n] = fzero4();
  __syncthreads();
  stage(0, 0);
  asm volatile("s_waitcnt vmcnt(0)" ::: "memory");
  __syncthreads();
  for (int kt = 0; kt < nk; ++kt) {
    if (kt + 1 < nk) stage(kt + 1, (kt + 1) & 1);
    compute(kt & 1);
    asm volatile("s_waitcnt vmcnt(0)" ::: "memory");
    __syncthreads();
  }
}
template <class ARow, class Epi>
DEVI void gemm128(int tid, ARow arow, const u16* __restrict__ Bt, int ldb, int K, Epi epi, char* smem) {
  f32x4 acc[4][4];
  gemm_core<false>(tid, arow, Bt, ldb, K, acc, smem);
  const int lane = tid & 63, wid = tid >> 6, wr = wid >> 1, wc = wid & 1, fr = lane & 15, fq = lane >> 4;
#pragma unroll
  for (int m = 0; m < 4; ++m)
#pragma unroll
    for (int n = 0; n < 4; ++n) epi(wr * 64 + m * 16 + fr, wc * 64 + n * 16 + fq * 4, acc[m][n]);
}

DEVI void rope4(const f32x4 x1, const f32x4 x2, const f32x2* rp, bool lat, float scale, u32x2& o1, u32x2& o2) {
  f32x4 s = fzero4(), c = s + 1.f;
  if (lat) {
    const f32x4 a = *(const f32x4*)rp, b = *(const f32x4*)(rp + 2);
    c = f32x4{a[0], a[2], b[0], b[2]}; s = f32x4{a[1], a[3], b[1], b[3]};
  }
  const f32x4 y1 = (x1 * c - x2 * s) * scale, y2 = (x2 * c + x1 * s) * scale;
  o1[0] = pack2(y1[0], y1[1]); o1[1] = pack2(y1[2], y1[3]);
  o2[0] = pack2(y2[0], y2[1]); o2[1] = pack2(y2[2], y2[3]);
}
DEVI void inproj_item(const Params& p, int item, char* smem) {
  const u16* H = (const u16*)(p.ws + O_H); const u16* W = (const u16*)(p.ws + O_WINT);
  const f32x2* ROPE = (const f32x2*)(p.ws + O_ROPE);
  const int tid = p.tid, lane = tid & 63, wid = tid >> 6, wr = wid >> 1, wc = wid & 1, fr = lane & 15, fq = lane >> 4;
  {
    const int m0 = (item / 22) * 128, nt = item % 22;
    const bool lat = m0 < TL;
    const int b = tok_b(m0), rowbase = tok_row(m0);
    f32x4 acc[4][4];
    auto arow = [&](int r) { return H + (size_t)(m0 + r) * LDH; };
    if (nt == 3 || nt == 8 || nt == 9) {
      gemm_core<true, 0, true>(tid, arow, W + (size_t)nt * 128 * LDW, LDW, 1024, acc, smem);
      u16* vt = nt == 3 ? (u16*)(p.ws + O_VTA) + (size_t)(b * 2 + wc) * 64 * NKEY
                        : (u16*)(p.ws + O_VTB) + (size_t)(b * 4 + (nt - 8) * 2 + wc) * 64 * NKEY;
#pragma unroll
      for (int mh = 0; mh < 2; ++mh)
#pragma unroll
        for (int n = 0; n < 4; ++n) {
          u32x4 pk;
          pk[0] = pack2(acc[2 * mh][n][0], acc[2 * mh][n][1]); pk[1] = pack2(acc[2 * mh][n][2], acc[2 * mh][n][3]);
          pk[2] = pack2(acc[2 * mh + 1][n][0], acc[2 * mh + 1][n][1]); pk[3] = pack2(acc[2 * mh + 1][n][2], acc[2 * mh + 1][n][3]);
          *(u32x4*)(vt + (size_t)(n * 16 + fr) * NKEY + rowbase + wr * 64 + mh * 32 + fq * 8) = pk;
        }
      return;
    }
    if (nt < 3 || nt >= 11) gemm_core<false, 1>(tid, arow, W + (size_t)nt * 128 * LDW, LDW, 1024, acc, smem);
    else gemm_core<false>(tid, arow, W + (size_t)nt * 128 * LDW, LDW, 1024, acc, smem);
    if (nt < 3) {
      u16* dst; float scale;
      if (nt < 2) { dst = (u16*)(p.ws + O_QA) + ((size_t)(b * 4 + nt * 2 + wc) * NKEY + rowbase) * 64; scale = 0.125f * LOG2E; }
      else { dst = (u16*)(p.ws + O_KA) + ((size_t)(b * 2 + wc) * NKEY + rowbase) * 64; scale = 1.f; }
#pragma unroll
      for (int m = 0; m < 4; ++m) {
        const int rl = wr * 64 + m * 16 + fr;
        u32x2 a1, a2, b1, b2;
        rope4(acc[m][0], acc[m][2], ROPE + (size_t)(rowbase + rl) * 48 + fq * 8, lat, scale, a1, a2);
        rope4(acc[m][1], acc[m][3], ROPE + (size_t)(rowbase + rl) * 48 + fq * 8 + 4, lat, scale, b1, b2);
        *(u32x4*)(dst + (size_t)rl * 64 + fq * 8) = u32x4{a1[0], a1[1], b1[0], b1[1]};
        *(u32x4*)(dst + (size_t)rl * 64 + 32 + fq * 8) = u32x4{a2[0], a2[1], b2[0], b2[1]};
      }
    } else if (nt < 8) {
      const bool isq = nt < 6;
      u16* base = isq ? (u16*)(p.ws + O_QB) : (u16*)(p.ws + O_KB);
      const float scale = isq ? 0.17677669529663687f * LOG2E : 1.f;
      const int hm0 = ((nt - 4) & 1) * 4 + wc * 2;
#pragma unroll
      for (int m = 0; m < 4; ++m) {
        const int rl = wr * 64 + m * 16 + fr;
#pragma unroll
        for (int g = 0; g < 2; ++g) {
          u16* dst = base + ((size_t)(b * 8 + hm0 + g) * NKEY + rowbase + rl) * 32;
          u32x2 o1, o2;
          rope4(acc[m][2 * g], acc[m][2 * g + 1], ROPE + (size_t)(rowbase + rl) * 48 + 32 + fq * 4, lat, scale, o1, o2);
          *(u32x2*)(dst + fq * 4) = o1; *(u32x2*)(dst + 16 + fq * 4) = o2;
        }
      }
    } else if (nt == 10) {
      if (wc == 0) {
#pragma unroll
        for (int m = 0; m < 4; ++m) {
          const int rl = wr * 64 + m * 16 + fr;
          u32x2 o1, o2;
          rope4(acc[m][0], acc[m][1], ROPE + (size_t)(rowbase + rl) * 48 + 32 + fq * 4, lat, 1.f, o1, o2);
#pragma unroll
          for (int h = 0; h < 4; ++h) {
            u16* dst = (u16*)(p.ws + O_KC) + ((size_t)(b * 4 + h) * NKEY + rowbase + rl) * 96 + 64;
            *(u32x2*)(dst + fq * 4) = o1; *(u32x2*)(dst + 16 + fq * 4) = o2;
          }
        }
      }
    } else {
      u16* PP = (u16*)(p.ws + O_PP);
#pragma unroll
      for (int m = 0; m < 4; ++m)
#pragma unroll
        for (int h = 0; h < 2; ++h) {
          u32x4 pk;
          pk[0] = pack2(acc[m][2 * h][0], acc[m][2 * h][1]); pk[1] = pack2(acc[m][2 * h][2], acc[m][2 * h][3]);
          pk[2] = pack2(acc[m][2 * h + 1][0], acc[m][2 * h + 1][1]); pk[3] = pack2(acc[m][2 * h + 1][2], acc[m][2 * h + 1][3]);
          *(u32x4*)(PP + (size_t)(m0 + wr * 64 + m * 16 + fr) * LDPP + (nt - 11) * 128 + wc * 64 + h * 32 + fq * 8) = pk;
        }
    }
  }
}

DEVI void st_tokprep(const Params& p, int l, int vb, int nvb) {
  const int lane = p.tid & 63, wid = p.tid >> 6;
  const u16* PP = (const u16*)(p.ws + O_PP);
  u16* GQ = (u16*)(p.ws + O_GQ); u16* GK = (u16*)(p.ws + O_GK); u16* GV = (u16*)(p.ws + O_GV);
  float* GG = (float*)(p.ws + O_GG); float* GB = (float*)(p.ws + O_GBETA);
  u16* CQN = (u16*)(p.ws + O_CQN); u16* CKVN = (u16*)(p.ws + O_CKVN);
  const float* cwp = pin(p, I_CONVW) + (size_t)l * 5 * 768;
  f32x2 cw[6][5];
#pragma unroll
  for (int i = 0; i < 6; ++i)
#pragma unroll
    for (int j = 0; j < 5; ++j) cw[i][j] = *(const f32x2*)(cwp + j * 768 + 2 * lane + 128 * i);
  const float* gq = pin(p, I_MQG) + l * 192; const float* gkv = pin(p, I_MKVG) + l * 128;
  const float gq0 = gq[lane], gq1 = gq[64 + lane], gq2 = gq[128 + lane], gk0 = gkv[lane], gk1 = gkv[64 + lane];
  for (int t = vb * 4 + wid; t < T; t += nvb * 4) {
    int base, pos, len;
    if (t < TL) { base = t & ~(SEQ - 1); pos = t & (SEQ - 1); len = SEQ; } else { int j = t - TL; base = TL + (j & ~(CTXL - 1)); pos = j & (CTXL - 1); len = CTXL; }
    unsigned xin[5][6];
#pragma unroll
    for (int j = 0; j < 5; ++j) {
      const int pp = pos + j - 2;
      const bool ok = pp >= 0 && pp < len;
      const u16* row = PP + (size_t)(base + (ok ? pp : pos)) * LDPP + PP_DQKV + 2 * lane;
#pragma unroll
      for (int i = 0; i < 6; ++i) { unsigned v = *(const unsigned*)(row + 128 * i); xin[j][i] = ok ? v : 0u; }
    }
    const u16* pr = PP + (size_t)t * LDPP;
    const float q0 = bf2f(pr[PP_CQ + lane]), q1 = bf2f(pr[PP_CQ + 64 + lane]), q2 = bf2f(pr[PP_CQ + 128 + lane]);
    const float k0 = bf2f(pr[PP_CKV + lane]), k1 = bf2f(pr[PP_CKV + 64 + lane]);
    const float gate_in = lane < 16 ? bf2f(pr[PP_GATE + lane]) : 0.f;
#pragma unroll
    for (int i = 0; i < 6; ++i) {
      float a0 = 0.f, a1 = 0.f;
#pragma unroll
      for (int j = 0; j < 5; ++j) { a0 += cw[i][j][0] * bflo(xin[j][i]); a1 += cw[i][j][1] * bfhi(xin[j][i]); }
      float y0 = siluf(a0), y1 = siluf(a1);
      const int c = 2 * lane + 128 * i;
      if (i < 4) {
        const float ss = half_sum(y0 * y0 + y1 * y1);
        const float r = rsqrtf(ss + 1e-6f) * (i < 2 ? 0.125f : 1.f);
        u16* dst = i < 2 ? GQ + (size_t)t * 256 + c : GK + (size_t)t * 256 + (c - 256);
        *(unsigned*)dst = pack2(y0 * r, y1 * r);
      } else *(unsigned*)(GV + (size_t)t * 256 + (c - 512)) = pack2(y0, y1);
    }
    if (lane < 16) {
      const int which = lane >> 2, hd = lane & 3;
      if (which < 2) {
        const float al = which ? pin(p, I_ALB)[l * 4 + hd] : pin(p, I_ALF)[l * 4 + hd];
        const float dt = which ? pin(p, I_DTB)[l * 4 + hd] : pin(p, I_DTF)[l * 4 + hd];
        const float xx = gate_in + dt;
        const float sp = fmaxf(xx, 0.f) + log1pf(expf(-fabsf(xx)));
        GG[((size_t)which * T + t) * 4 + hd] = -expf(al) * sp;
      } else GB[((size_t)(which - 2) * T + t) * 4 + hd] = sigmf(gate_in);
    }
    {
      float ss = q0 * q0 + q1 * q1 + q2 * q2, s2 = k0 * k0 + k1 * k1;
#pragma unroll
      for (int o = 32; o >= 1; o >>= 1) { ss += __shfl_xor(ss, o); s2 += __shfl_xor(s2, o); }
      const float rs = rsqrtf(ss * (1.f / 192.f) + 1e-6f), r2 = rsqrtf(s2 * (1.f / 128.f) + 1e-6f);
      u16* d = CQN + (size_t)t * 192;
      d[lane] = f2bf(q0 * rs * gq0); d[64 + lane] = f2bf(q1 * rs * gq1); d[128 + lane] = f2bf(q2 * rs * gq2);
      u16* d2 = CKVN + (size_t)t * 128;
      d2[lane] = f2bf(k0 * r2 * gk0); d2[64 + lane] = f2bf(k1 * r2 * gk1);
    }
  }
}

DEVI void mla_up_tile(const Params& p, int mt, int nn, char* smem) {
  const int tid = p.tid, lane = tid & 63, wid = tid >> 6, wr = wid >> 1, wc = wid & 1, fr = lane & 15, fq = lane >> 4;
  const int m0 = mt * 128;
  const bool lat = m0 < TL;
  const int b = tok_b(m0), rowbase = tok_row(m0);
  f32x4 acc[4][4];
  if (nn < 3) {
    const u16* CQN = (const u16*)(p.ws + O_CQN);
    gemm_core<false>(tid, [&](int r) { return CQN + (size_t)(m0 + r) * 192; }, (const u16*)(p.ws + O_WUQT) + (size_t)nn * 128 * 192, 192, 192, acc, smem);
    const f32x2* ROPE = (const f32x2*)(p.ws + O_ROPE);
    const float scale = 0.10206207261596577f * LOG2E;
    u16* QC = (u16*)(p.ws + O_QC);
#pragma unroll
    for (int m = 0; m < 4; ++m) {
      const int rl = wr * 64 + m * 16 + fr;
#pragma unroll
      for (int n = 0; n < 4; ++n) {
        const int cb = nn * 128 + wc * 64 + n * 16;
        const int h = cb / 96, db = cb - h * 96;
        u16* dst = QC + ((size_t)(b * 4 + h) * NKEY + rowbase + rl) * 96;
        if (db < 64) {
          u32x2 pk; pk[0] = pack2(acc[m][n][0] * scale, acc[m][n][1] * scale); pk[1] = pack2(acc[m][n][2] * scale, acc[m][n][3] * scale);
          *(u32x2*)(dst + db + fq * 4) = pk;
        } else if (db == 64 && n < 3) {
          u32x2 o1, o2;
          rope4(acc[m][n], acc[m][n + 1], ROPE + (size_t)(rowbase + rl) * 48 + 32 + fq * 4, lat, scale, o1, o2);
          *(u32x2*)(dst + 64 + fq * 4) = o1; *(u32x2*)(dst + 80 + fq * 4) = o2;
        }
      }
    }
  } else {
    const u16* CKVN = (const u16*)(p.ws + O_CKVN);
    auto arow = [&](int r) { return CKVN + (size_t)(m0 + r) * 128; };
    const u16* Wt = (const u16*)(p.ws + O_WUKVT) + (size_t)(nn - 3) * 128 * 128;
    if (nn < 5) {
      gemm_core<false>(tid, arow, Wt, 128, 128, acc, smem);
      u16* KC = (u16*)(p.ws + O_KC) + ((size_t)(b * 4 + (nn - 3) * 2 + wc) * NKEY + rowbase) * 96;
#pragma unroll
      for (int m = 0; m < 4; ++m)
#pragma unroll
        for (int n = 0; n < 4; ++n) {
          u32x2 pk; pk[0] = pack2(acc[m][n][0], acc[m][n][1]); pk[1] = pack2(acc[m][n][2], acc[m][n][3]);
          *(u32x2*)(KC + (size_t)(wr * 64 + m * 16 + fr) * 96 + n * 16 + fq * 4) = pk;
        }
    } else {
      gemm_core<true>(tid, arow, Wt, 128, 128, acc, smem);
      u16* vt = (u16*)(p.ws + O_VTC) + (size_t)(b * 4 + (nn - 5) * 2 + wc) * 64 * NKEY;
#pragma unroll
      for (int m = 0; m < 4; ++m)
#pragma unroll
        for (int n = 0; n < 4; ++n) {
          u32x2 pk; pk[0] = pack2(acc[m][n][0], acc[m][n][1]); pk[1] = pack2(acc[m][n][2], acc[m][n][3]);
          *(u32x2*)(vt + (size_t)(n * 16 + fr) * NKEY + rowbase + wr * 64 + m * 16 + (((fq & 1) << 1) | (fq >> 1)) * 4) = pk;
        }
    }
  }
}
DEVI int permcol(int x) { return (x & 32) + 8 * ((x >> 2) & 3) + 4 * ((x >> 4) & 1) + (x & 3); }
DEVI int cidx(int d, int e) { return ((((e >> 4) * 4 + (d >> 4)) * 64) + (e & 15) + 16 * ((d >> 2) & 3)) * 4 + (d & 3); }
DEVI int gdn_chunk_t0(int ci) { return ci < 256 ? (ci >> 7) * SEQ + (ci & 127) * 64 : TL + ((ci - 256) >> 2) * CTXL + ((ci - 256) & 3) * 64; }

DEVI void gdn_chunk_item(const Params& p, int item, char* smem) {
  u16* sK = (u16*)smem;
  float* sA = (float*)(smem + 9216);
  u16* sXt = (u16*)smem;
  u16* sAt = (u16*)(smem + 26624);
  u16* sKt = (u16*)(smem + 35840);
  float* sX = (float*)(smem + 45056);
  float* sgc = (float*)(smem + 77824); float* sbeta = sgc + 64; float* seg = sbeta + 64; float* skd = seg + 64;
  const u16* GQ = (const u16*)(p.ws + O_GQ); const u16* GK = (const u16*)(p.ws + O_GK); const u16* GV = (const u16*)(p.ws + O_GV);
  const float* GG = (const float*)(p.ws + O_GG); const float* GB = (const float*)(p.ws + O_GBETA);
  u16* GM = (u16*)(p.ws + O_GM); u16* GQP = (u16*)(p.ws + O_GQP); u16* GN = (u16*)(p.ws + O_GN); u16* GLO = (u16*)(p.ws + O_GLO);
  const int tid = p.tid, lane = tid & 63, w = tid >> 6, i15 = lane & 15, q = lane >> 4;
  {
    const int ci = item >> 3, hd = (item >> 1) & 3, dir = item & 1;
    const int t0 = gdn_chunk_t0(ci);
    auto tok = [&](int i) { return dir ? t0 + 63 - i : t0 + i; };
    __syncthreads();
    if (tid < 64) {
      float g = GG[((size_t)dir * T + tok(tid)) * 4 + hd];
#pragma unroll
      for (int o = 1; o < 64; o <<= 1) { float u = __shfl_up(g, o); if (lane >= o) g += u; }
      const float gl = __shfl(g, 63);
      sgc[tid] = g; sbeta[tid] = GB[((size_t)dir * T + tok(tid)) * 4 + hd]; seg[tid] = expf(g); skd[tid] = expf(gl - g);
    }
    __syncthreads();
    const float eglast = seg[63];
#pragma unroll
    for (int i = 0; i < 2; ++i) {
      const int ch = tid + 256 * i, j = ch >> 3, cc = ch & 7;
      const u32x4 kv = *(const u32x4*)(GK + (size_t)tok(j) * 256 + hd * 64 + cc * 8);
      *(u32x4*)&sK[j * 72 + cc * 8] = kv;
      const float kd = skd[j];
#pragma unroll
      for (int e = 0; e < 4; ++e) {
        sKt[(cc * 8 + 2 * e) * 72 + j] = f2bf(bf2f((u16)(kv[e] & 0xffff)) * kd);
        sKt[(cc * 8 + 2 * e + 1) * 72 + j] = f2bf(bf2f((u16)(kv[e] >> 16)) * kd);
      }
    }
#pragma unroll
    for (int i = 0; i < 2; ++i) {
      const int ch = tid + 256 * i, j = ch >> 3, cc = ch & 7;
      const u32x4 vv = *(const u32x4*)(GV + (size_t)tok(j) * 256 + hd * 64 + cc * 8);
      const float bj = sbeta[j];
      float* d = sX + j * 128 + cc * 8;
#pragma unroll
      for (int e = 0; e < 4; ++e) { d[2 * e] = bflo(vv[e]) * bj; d[2 * e + 1] = bfhi(vv[e]) * bj; }
    }
    __syncthreads();
    for (int e = tid; e < 64 * 64; e += 256) {
      const int j = e >> 6, c = e & 63;
      sX[j * 128 + 64 + c] = bf2f(sK[j * 72 + c]) * sbeta[j] * seg[j];
    }
    {
      f32x4 kk[4], qk[4];
#pragma unroll
      for (int nt = 0; nt < 4; ++nt) { kk[nt] = fzero4(); qk[nt] = fzero4(); }
#pragma unroll
      for (int ks = 0; ks < 2; ++ks) {
        const bf16x8 ak = *(const bf16x8*)&sK[(16 * w + i15) * 72 + ks * 32 + q * 8];
        const bf16x8 aq = *(const bf16x8*)(GQ + (size_t)tok(16 * w + i15) * 256 + hd * 64 + ks * 32 + q * 8);
#pragma unroll
        for (int nt = 0; nt < 4; ++nt) {
          const bf16x8 bk = *(const bf16x8*)&sK[(16 * nt + i15) * 72 + ks * 32 + q * 8];
          kk[nt] = MFMA16(ak, bk, kk[nt]); qk[nt] = MFMA16(aq, bk, qk[nt]);
        }
      }
#pragma unroll
      for (int nt = 0; nt < 4; ++nt)
#pragma unroll
        for (int r = 0; r < 4; ++r) {
          const int i = 16 * w + 4 * q + r, j = 16 * nt + i15;
          const float dec = i >= j ? expf(sgc[i] - sgc[j]) : 0.f;
          sA[i * 68 + j] = i > j ? sbeta[i] * kk[nt][r] * dec : 0.f;
          sAt[i * 72 + j] = f2bf(i >= j ? qk[nt][r] * dec : 0.f);
        }
    }
    __syncthreads();
    if (tid < 128) {
      const int c = tid;
      for (int ib = 0; ib < 16; ++ib) {
        float a0 = sX[(4 * ib) * 128 + c], a1 = sX[(4 * ib + 1) * 128 + c], a2 = sX[(4 * ib + 2) * 128 + c], a3 = sX[(4 * ib + 3) * 128 + c];
#pragma unroll 4
        for (int g = 0; g < ib; ++g) {
          const float x0 = sX[(4 * g) * 128 + c], x1 = sX[(4 * g + 1) * 128 + c], x2 = sX[(4 * g + 2) * 128 + c], x3 = sX[(4 * g + 3) * 128 + c];
          const f32x4 r0 = *(const f32x4*)&sA[(4 * ib) * 68 + 4 * g], r1 = *(const f32x4*)&sA[(4 * ib + 1) * 68 + 4 * g];
          const f32x4 r2 = *(const f32x4*)&sA[(4 * ib + 2) * 68 + 4 * g], r3 = *(const f32x4*)&sA[(4 * ib + 3) * 68 + 4 * g];
          a0 -= r0[0] * x0 + r0[1] * x1 + r0[2] * x2 + r0[3] * x3;
          a1 -= r1[0] * x0 + r1[1] * x1 + r1[2] * x2 + r1[3] * x3;
          a2 -= r2[0] * x0 + r2[1] * x1 + r2[2] * x2 + r2[3] * x3;
          a3 -= r3[0] * x0 + r3[1] * x1 + r3[2] * x2 + r3[3] * x3;
        }
        const f32x4 d1 = *(const f32x4*)&sA[(4 * ib + 1) * 68 + 4 * ib], d2 = *(const f32x4*)&sA[(4 * ib + 2) * 68 + 4 * ib], d3 = *(const f32x4*)&sA[(4 * ib + 3) * 68 + 4 * ib];
        a1 -= d1[0] * a0;
        a2 -= d2[0] * a0 + d2[1] * a1;
        a3 -= d3[0] * a0 + d3[1] * a1 + d3[2] * a2;
        sX[(4 * ib) * 128 + c] = a0; sX[(4 * ib + 1) * 128 + c] = a1; sX[(4 * ib + 2) * 128 + c] = a2; sX[(4 * ib + 3) * 128 + c] = a3;
      }
    }
    __syncthreads();
    {
      const int c = tid & 127, jh = (tid >> 7) * 32;
#pragma unroll
      for (int g = 0; g < 4; ++g) {
        u32x4 pk;
#pragma unroll
        for (int e = 0; e < 4; ++e) pk[e] = pack2(sX[(jh + 8 * g + 2 * e) * 128 + c], sX[(jh + 8 * g + 2 * e + 1) * 128 + c]);
        *(u32x4*)&sXt[c * 72 + jh + 8 * g] = pk;
      }
    }
    __syncthreads();
    {
      f32x4 r1[8], r2[8];
#pragma unroll
      for (int ct = 0; ct < 8; ++ct) { r1[ct] = fzero4(); r2[ct] = fzero4(); }
#pragma unroll
      for (int ks = 0; ks < 2; ++ks) {
        const bf16x8 aa = *(const bf16x8*)&sAt[(16 * w + i15) * 72 + ks * 32 + q * 8];
        const bf16x8 ak = *(const bf16x8*)&sKt[(16 * w + i15) * 72 + ks * 32 + q * 8];
#pragma unroll
        for (int ct = 0; ct < 8; ++ct) {
          const bf16x8 bx = *(const bf16x8*)&sXt[(16 * ct + i15) * 72 + ks * 32 + q * 8];
          r1[ct] = MFMA16(aa, bx, r1[ct]); r2[ct] = MFMA16(ak, bx, r2[ct]);
        }
      }
      const size_t ib = (size_t)item * 4096;
#pragma unroll
      for (int ct = 0; ct < 4; ++ct) {
        u32x2 a, b;
        a[0] = pack2(r1[ct][0], r1[ct][1]); a[1] = pack2(r1[ct][2], r1[ct][3]);
        b[0] = pack2(r2[ct][0], r2[ct][1]); b[1] = pack2(r2[ct][2], r2[ct][3]);
        *(u32x2*)(GLO + ib + ((ct * 4 + w) * 64 + lane) * 4) = a;
        *(u32x2*)(GN + ib + ((ct * 4 + w) * 64 + lane) * 4) = b;
      }
#pragma unroll
      for (int ct = 4; ct < 8; ++ct)
#pragma unroll
        for (int r = 0; r < 4; ++r) {
          const int row = 16 * w + 4 * q + r, col = 16 * (ct - 4) + i15;
          const float qv = bf2f(GQ[(size_t)tok(row) * 256 + hd * 64 + col]);
          GQP[ib + row * 64 + permcol(col)] = f2bf(qv * seg[row] - r1[ct][r]);
          GM[ib + row * 64 + permcol(col)] = f2bf((row == col ? eglast : 0.f) - r2[ct][r]);
        }
    }
    __syncthreads();
  }
}

DEVI void gdn_scan_chain(const Params& p, int chain, char* smem) {
  const int tid = p.tid, lane = tid & 63, w = tid >> 6, i15 = lane & 15, q = lane >> 4;
  u16* sM = (u16*)smem;
  u16* sQ = sM + 2 * 64 * 72;
  const u16* GM = (const u16*)(p.ws + O_GM); const u16* GQP = (const u16*)(p.ws + O_GQP);
  const u16* GN = (const u16*)(p.ws + O_GN); const u16* GLO = (const u16*)(p.ws + O_GLO);
  float* GO = (float*)(p.ws + O_GO);
  {
    const int b = chain >> 3, hd = (chain >> 1) & 3, dir = chain & 1;
    f32x4 S[4];
#pragma unroll
    for (int r = 0; r < 4; ++r) S[r] = fzero4();
    auto item_of = [&](int n) {
      int ci = n < 4 ? 256 + b * 4 + (dir ? 3 - n : n) : b * 128 + (dir ? 127 - (n - 4) : (n - 4));
      return ci * 8 + hd * 2 + dir;
    };
    u32x4 pm[2], pq[2]; u32x2 pn[4], pl[4];
    auto prefetch = [&](int n) {
      const size_t base = (size_t)item_of(n) * 4096;
#pragma unroll
      for (int i = 0; i < 2; ++i) {
        const int ch = tid + 256 * i;
        pm[i] = *(const u32x4*)(GM + base + ch * 8);
        pq[i] = *(const u32x4*)(GQP + base + ch * 8);
      }
#pragma unroll
      for (int rb = 0; rb < 4; ++rb) {
        pn[rb] = *(const u32x2*)(GN + base + ((w * 4 + rb) * 64 + lane) * 4);
        pl[rb] = *(const u32x2*)(GLO + base + ((w * 4 + rb) * 64 + lane) * 4);
      }
    };
    prefetch(0);
    __syncthreads();
    for (int n = 0; n < 132; ++n) {
      const int buf = n & 1;
      u16* bM = sM + buf * 64 * 72; u16* bQ = sQ + buf * 64 * 72;
#pragma unroll
      for (int i = 0; i < 2; ++i) {
        const int ch = tid + 256 * i, row = ch >> 3, cc = ch & 7;
        *(u32x4*)&bM[row * 72 + cc * 8] = pm[i];
        *(u32x4*)&bQ[row * 72 + cc * 8] = pq[i];
      }
      f32x4 accs[4], acco[4];
#pragma unroll
      for (int rb = 0; rb < 4; ++rb) {
        accs[rb] = f32x4{bf2f((u16)(pn[rb][0] & 0xffff)), bf2f((u16)(pn[rb][0] >> 16)), bf2f((u16)(pn[rb][1] & 0xffff)), bf2f((u16)(pn[rb][1] >> 16))};
        acco[rb] = f32x4{bf2f((u16)(pl[rb][0] & 0xffff)), bf2f((u16)(pl[rb][0] >> 16)), bf2f((u16)(pl[rb][1] & 0xffff)), bf2f((u16)(pl[rb][1] >> 16))};
      }
      const int ci = n < 4 ? 256 + b * 4 + (dir ? 3 - n : n) : b * 128 + (dir ? 127 - (n - 4) : (n - 4));
      const int t0 = gdn_chunk_t0(ci);
      __syncthreads();
      if (n + 1 < 132) prefetch(n + 1);
      bf16x8 sb[2];
#pragma unroll
      for (int kb = 0; kb < 2; ++kb)
#pragma unroll
        for (int jj = 0; jj < 8; ++jj) sb[kb][jj] = (short)f2bf(S[2 * kb + (jj >> 2)][jj & 3]);
#pragma unroll
      for (int kb = 0; kb < 2; ++kb)
#pragma unroll
        for (int rb = 0; rb < 4; ++rb) {
          const bf16x8 am = *(const bf16x8*)&bM[(rb * 16 + i15) * 72 + kb * 32 + q * 8];
          const bf16x8 aq = *(const bf16x8*)&bQ[(rb * 16 + i15) * 72 + kb * 32 + q * 8];
          accs[rb] = MFMA16(am, sb[kb], accs[rb]);
          acco[rb] = MFMA16(aq, sb[kb], acco[rb]);
        }
#pragma unroll
      for (int rb = 0; rb < 4; ++rb) {
        S[rb] = accs[rb];
#pragma unroll
        for (int r = 0; r < 4; ++r) {
          const int i = rb * 16 + q * 4 + r;
          const int t = dir ? t0 + 63 - i : t0 + i;
          GO[(size_t)dir * T * 256 + (size_t)t * 256 + hd * 64 + w * 16 + i15] = acco[rb][r];
        }
      }
    }
    __syncthreads();
  }
}


template <int DQK>
DEVI void attn_run(int tid, const u16* __restrict__ Qp, int qrow0, const u16* __restrict__ Kp, const u16* __restrict__ Vtp,
                   int a0, int a1, int b0, int b1, int qpos0, float sink2, f32x16 (&O)[2], char* smem) {
  constexpr int KLD = DQK + 8, NS = DQK / 16, KCH = DQK / 8, NKL = (64 * KCH) / 256;
  constexpr int BUF = 64 * KLD + 64 * 72;
  u16* sbase = (u16*)smem;
  const int lane = tid & 63, wid = tid >> 6, r31 = lane & 31, hh = lane >> 5;
  const int qrow = qrow0 + wid * 32 + r31;
  bf16x8 qf[NS];
#pragma unroll
  for (int s = 0; s < NS; ++s) qf[s] = *(const bf16x8*)(Qp + (size_t)qrow * DQK + s * 16 + hh * 8);
#pragma unroll
  for (int i = 0; i < 16; ++i) { O[0][i] = 0.f; O[1][i] = 0.f; }
  float m = -30000.f, lsum = 0.f;
  const int na = (a1 - a0) >> 6, nt = na + ((b1 - b0) >> 6);
  const int qpos = qpos0 + wid * 32 + r31;
  u32x4 rk[NKL], rv[2];
  auto gload = [&](int ti) {
    const int key0 = ti >= na ? b0 + (ti - na) * 64 : a0 + ti * 64;
#pragma unroll
    for (int i = 0; i < NKL; ++i) { const int q = tid + 256 * i, r = q / KCH, cc = q % KCH; rk[i] = *(const u32x4*)(Kp + (size_t)(key0 + r) * DQK + cc * 8); }
#pragma unroll
    for (int i = 0; i < 2; ++i) { const int q = tid + 256 * i, r = q >> 3, cc = q & 7; rv[i] = *(const u32x4*)(Vtp + (size_t)r * NKEY + key0 + cc * 8); }
  };
  auto lstore = [&](int buf) {
    u16* sK = sbase + buf * BUF; u16* sV = sK + 64 * KLD;
#pragma unroll
    for (int i = 0; i < NKL; ++i) { const int q = tid + 256 * i, r = q / KCH, cc = q % KCH; *(u32x4*)&sK[r * KLD + cc * 8] = rk[i]; }
#pragma unroll
    for (int i = 0; i < 2; ++i) { const int q = tid + 256 * i, r = q >> 3, cc = q & 7; *(u32x4*)&sV[r * 72 + cc * 8] = rv[i]; }
  };
  m = 0.f;
  f32x16 negm;
#pragma unroll
  for (int i = 0; i < 16; ++i) negm[i] = 0.f;
  gload(0);
  __syncthreads();
  lstore(0);
  __syncthreads();
  for (int ti = 0; ti < nt; ++ti) {
    if (ti + 1 < nt) gload(ti + 1);
    const u16* sK = sbase + (ti & 1) * BUF; const u16* sV = sK + 64 * KLD;
    const bool inB = ti >= na;
    const int key0 = inB ? b0 + (ti - na) * 64 : a0 + ti * 64;
    f32x16 st[2];
#pragma unroll
    for (int k2 = 0; k2 < 2; ++k2) {
      {
        const bf16x8 kf = *(const bf16x8*)&sK[(k2 * 32 + r31) * KLD + hh * 8];
        asm volatile("v_mfma_f32_32x32x16_bf16 %0, %1, %2, %3" : "=&v"(st[k2]) : "v"(kf), "v"(qf[0]), "v"(negm));
      }
#pragma unroll
      for (int s = 1; s < NS; ++s) {
        const bf16x8 kf = *(const bf16x8*)&sK[(k2 * 32 + r31) * KLD + s * 16 + hh * 8];
        st[k2] = MFMA32(kf, qf[s], st[k2]);
      }
    }
    if (inB) {
#pragma unroll
      for (int k2 = 0; k2 < 2; ++k2)
#pragma unroll
        for (int g = 0; g < 16; ++g) {
          const int d = key0 + k2 * 32 + (g & 3) + 8 * (g >> 2) + 4 * hh - qpos;
          if (d > 128 || d < -128) st[k2][g] = -1e30f;
        }
    }
    bf16x8 vfr[2][2][2];
#pragma unroll
    for (int k2 = 0; k2 < 2; ++k2)
#pragma unroll
      for (int s2 = 0; s2 < 2; ++s2)
#pragma unroll
        for (int dvt = 0; dvt < 2; ++dvt) vfr[k2][s2][dvt] = *(const bf16x8*)&sV[(dvt * 32 + r31) * 72 + k2 * 32 + s2 * 16 + 8 * hh];
    float mx = st[0][0];
#pragma unroll
    for (int g = 1; g < 16; ++g) mx = fmaxf(mx, st[0][g]);
#pragma unroll
    for (int g = 0; g < 16; ++g) mx = fmaxf(mx, st[1][g]);
    { auto rr = __builtin_amdgcn_permlane32_swap(__float_as_uint(mx), __float_as_uint(mx), false, false);
      mx = fmaxf(__uint_as_float(rr[0]), __uint_as_float(rr[1])); }
    if (ti == 0 || __any(mx > 8.f)) {
      const float delta = ti == 0 ? fmaxf(mx, -1e4f) : fmaxf(mx, 0.f);
      if (ti != 0) {
        const float alpha = __builtin_amdgcn_exp2f(-delta);
        lsum *= alpha;
#pragma unroll
        for (int i = 0; i < 16; ++i) { O[0][i] *= alpha; O[1][i] *= alpha; }
      }
      m += delta;
#pragma unroll
      for (int i = 0; i < 16; ++i) { negm[i] = -m; st[0][i] -= delta; st[1][i] -= delta; }
    }
    f32x2 ps2 = {0.f, 0.f};
#pragma unroll
    for (int k2 = 0; k2 < 2; ++k2)
#pragma unroll
      for (int g = 0; g < 16; g += 2) {
        const float p0 = __builtin_amdgcn_exp2f(st[k2][g]), p1 = __builtin_amdgcn_exp2f(st[k2][g + 1]);
        st[k2][g] = p0; st[k2][g + 1] = p1;
        ps2 += f32x2{p0, p1};
      }
    lsum += ps2[0] + ps2[1];
#pragma unroll
    for (int k2 = 0; k2 < 2; ++k2)
#pragma unroll
      for (int s2 = 0; s2 < 2; ++s2) {
        u32x4 pp;
#pragma unroll
        for (int j = 0; j < 4; ++j) pp[j] = pack2(st[k2][8 * s2 + 2 * j], st[k2][8 * s2 + 2 * j + 1]);
        const bf16x8 pf = __builtin_bit_cast(bf16x8, pp);
#pragma unroll
        for (int dvt = 0; dvt < 2; ++dvt) {
          O[dvt] = MFMA32(vfr[k2][s2][dvt], pf, O[dvt]);
        }
      }
    if (ti + 1 < nt) lstore((ti + 1) & 1);
    __syncthreads();
  }
  if (sink2 > -1e29f) {
    const float mn = fmaxf(m, sink2);
    const float alpha = __builtin_amdgcn_exp2f(m - mn);
    lsum = lsum * alpha + (hh == 0 ? __builtin_amdgcn_exp2f(sink2 - mn) : 0.f);
#pragma unroll
    for (int i = 0; i < 16; ++i) { O[0][i] *= alpha; O[1][i] *= alpha; }
  }
  const float ltot = lsum + __shfl_xor(lsum, 32);
  const float inv = 1.f / ltot;
#pragma unroll
  for (int i = 0; i < 16; ++i) { O[0][i] *= inv; O[1][i] *= inv; }
}
DEVI void attn_store(int tid, const f32x16 (&O)[2], u16* dst, int ld, int b, int qrow0, int col0) {
  const int lane = tid & 63, wid = tid >> 6, r31 = lane & 31, hh = lane >> 5;
  const int qrow = qrow0 + wid * 32 + r31;
  const int t = qrow < SEQ ? b * SEQ + qrow : TL + b * CTXL + (qrow - SEQ);
  u16* yr = dst + (size_t)t * ld + col0;
#pragma unroll
  for (int dvt = 0; dvt < 2; ++dvt)
#pragma unroll
    for (int g4 = 0; g4 < 4; ++g4) {
      u32x2 pk; pk[0] = pack2(O[dvt][g4 * 4 + 0], O[dvt][g4 * 4 + 1]); pk[1] = pack2(O[dvt][g4 * 4 + 2], O[dvt][g4 * 4 + 3]);
      *(u32x2*)(yr + dvt * 32 + 8 * g4 + 4 * hh) = pk;
    }
}
DEVI void attn_item(const Params& p, int l, int mixer, int b, int h, int qb, char* smem) {
  const bool lat = qb < 64;
  const int qrow0 = qb * 128;
  f32x16 O[2];
  if (mixer == 0) {
    attn_run<32>(p.tid, (const u16*)(p.ws + O_QB) + (size_t)(b * 8 + h) * NKEY * 32, qrow0, (const u16*)(p.ws + O_KB) + (size_t)(b * 8 + h) * NKEY * 32,
                 (const u16*)(p.ws + O_VTB) + (size_t)(b * 4 + (h >> 1)) * 64 * NKEY, lat ? 0 : SEQ, NKEY, 0, 0, 0, -1e30f, O, smem);
    attn_store(p.tid, O, (u16*)(p.ws + O_OB), 512, b, qrow0, h * 64);
  } else if (mixer == 1) {
    attn_run<96>(p.tid, (const u16*)(p.ws + O_QC) + (size_t)(b * 4 + h) * NKEY * 96, qrow0, (const u16*)(p.ws + O_KC) + (size_t)(b * 4 + h) * NKEY * 96,
                 (const u16*)(p.ws + O_VTC) + (size_t)(b * 4 + h) * 64 * NKEY, lat ? 0 : SEQ, NKEY, 0, 0, 0, -1e30f, O, smem);
    attn_store(p.tid, O, (u16*)(p.ws + O_Y), 1024, b, qrow0, 512 + h * 64);
  } else {
    const float sink2 = pin(p, I_SINK)[l * 4 + h] * LOG2E;
    const int hk = h >> 1;
    int b0 = 0, b1 = 0;
    if (lat) { b0 = (qb - 1) * 128; if (b0 < 0) b0 = 0; b1 = (qb + 2) * 128; if (b1 > SEQ) b1 = SEQ; }
    attn_run<64>(p.tid, (const u16*)(p.ws + O_QA) + (size_t)(b * 4 + h) * NKEY * 64, qrow0, (const u16*)(p.ws + O_KA) + (size_t)(b * 2 + hk) * NKEY * 64,
                 (const u16*)(p.ws + O_VTA) + (size_t)(b * 2 + hk) * 64 * NKEY, SEQ, NKEY, b0, b1, qrow0, sink2, O, smem);
    attn_store(p.tid, O, (u16*)(p.ws + O_Y), 1024, b, qrow0, h * 64);
  }
}

constexpr int SMEM_BYTES = 78848 + 64;

DEVI unsigned long long launder_ptr(unsigned long long v) {
  unsigned lo = __builtin_amdgcn_readfirstlane((unsigned)v), hi = __builtin_amdgcn_readfirstlane((unsigned)(v >> 32));
  asm volatile("s_mov_b32 %0, %1" : "=s"(lo) : "s"(lo));
  asm volatile("s_mov_b32 %0, %1" : "=s"(hi) : "s"(hi));
  return ((unsigned long long)hi << 32) | lo;
}
DEVI Params mkctx(const KArgs& a) {
  Params c;
  typedef __attribute__((address_space(1))) char gchar;
  typedef __attribute__((address_space(1))) float gfloat;
  c.ws = (char*)(gchar*)launder_ptr((unsigned long long)a.ws);
  c.out = (float*)(gfloat*)launder_ptr((unsigned long long)a.out);
  c.in = (gcfloat* const*)(c.ws + O_TAB);
  c.tid = threadIdx.x;
  asm volatile("" : "+v"(c.tid));
  return c;
}
DEVI void st_mixer_queue(const KArgs& a, int l, char* smem) {
  int* sitem = (int*)(smem + SMEM_BYTES - 16);
  const int g = blockIdx.x & 7;
  const int nctx = l == 0 ? 8 : 0;
  constexpr int NPREP = TR_P2 / 8 / 8;
  const int total = 2 + 128 + 64 + 64 + nctx + NPREP;
  for (;;) {
    const Params p = mkctx(a);
    unsigned* head = (unsigned*)(p.ws + O_BAR) + 16 + l * 8 + g;
    __syncthreads();
    if (p.tid == 0) *sitem = (int)atomicAdd(head, 1u);
    __syncthreads();
    int it = *sitem;
    if (it >= total) break;
    if (it < 2) { gdn_scan_chain(p, 2 * g + it, smem); continue; }
    it -= 2;
    if (it < 256 + nctx) {
      int mixer, b, h, qb;
      if (it < 128) { const int pr = 2 * g + (it >> 6); mixer = 0; b = pr >> 3; h = pr & 7; qb = it & 63; }
      else if (it < 256) { mixer = 1 + ((it - 128) >> 6); b = g >> 2; h = g & 3; qb = it & 63; }
      else {
        const int j = it - 256;
        if (j < 4) { const int pr = 2 * g + (j >> 1); mixer = 0; b = pr >> 3; h = pr & 7; qb = 64 + (j & 1); }
        else { mixer = 1 + ((j - 4) >> 1); b = g >> 2; h = g & 3; qb = 64 + (j & 1); }
      }
      attn_item(p, l, mixer, b, h, qb, smem);
      continue;
    }
    it -= 256 + nctx;
    prep_w2_run8(p, l, (it * 8 + g) * 8, (float*)smem);
  }
}

DEVI void st_mix_finish(const Params& p, int l, int vb, int nvb) {
  const int lane = p.tid & 63, wid = p.tid >> 6;
  const float* GO = (const float*)(p.ws + O_GO); const u16* PP = (const u16*)(p.ws + O_PP); const u16* OB = (const u16*)(p.ws + O_OB);
  u16* Y = (u16*)(p.ws + O_Y);
  const float lam_init = 0.8f - 0.6f * expf(-0.3f * (float)l);
  float d1 = lane < 32 ? pin(p, I_LQ1)[l * 32 + lane] * pin(p, I_LK1)[l * 32 + lane] : 0.f;
  float d2 = lane < 32 ? pin(p, I_LQ2)[l * 32 + lane] * pin(p, I_LK2)[l * 32 + lane] : 0.f;
  const float lam = expf(wave_sum(d1)) - expf(wave_sum(d2)) + lam_init;
  const int hd = lane >> 4, d0 = (lane & 15) * 4;
  const f32x4 gg = *(const f32x4*)(pin(p, I_GNG) + l * 64 + d0);
  const f32x4 dg = *(const f32x4*)(pin(p, I_DNG) + l * 64 + d0) * (1.f - lam_init);
  const int tend = l == 0 ? T : TL;
  for (int t0 = (vb * 4 + wid) * 2; t0 < tend; t0 += nvb * 8) {
    u32x2 o0[2], o1[2], zz[2]; f32x4 gf[2], gb[2];
#pragma unroll
    for (int u = 0; u < 2; ++u) {
      const size_t t = t0 + u;
      o0[u] = *(const u32x2*)(OB + t * 512 + (hd * 2) * 64 + d0);
      o1[u] = *(const u32x2*)(OB + t * 512 + (hd * 2 + 1) * 64 + d0);
      gf[u] = *(const f32x4*)(GO + t * 256 + hd * 64 + d0);
      gb[u] = *(const f32x4*)(GO + (size_t)T * 256 + t * 256 + hd * 64 + d0);
      zz[u] = *(const u32x2*)(PP + t * LDPP + PP_DZ + hd * 64 + d0);
    }
    f32x4 od[2], go[2]; float ssb[2], ssg[2];
#pragma unroll
    for (int u = 0; u < 2; ++u) {
      const f32x4 a = {bflo(o0[u][0]), bfhi(o0[u][0]), bflo(o0[u][1]), bfhi(o0[u][1])};
      const f32x4 b = {bflo(o1[u][0]), bfhi(o1[u][0]), bflo(o1[u][1]), bfhi(o1[u][1])};
      od[u] = a - lam * b; go[u] = gf[u] + gb[u];
      ssb[u] = od[u][0] * od[u][0] + od[u][1] * od[u][1] + od[u][2] * od[u][2] + od[u][3] * od[u][3];
      ssg[u] = go[u][0] * go[u][0] + go[u][1] * go[u][1] + go[u][2] * go[u][2] + go[u][3] * go[u][3];
    }
#pragma unroll
    for (int o = 8; o >= 1; o >>= 1) {
#pragma unroll
      for (int u = 0; u < 2; ++u) { ssb[u] += __shfl_xor(ssb[u], o); ssg[u] += __shfl_xor(ssg[u], o); }
    }
#pragma unroll
    for (int u = 0; u < 2; ++u) {
      const size_t t = t0 + u;
      const f32x4 yb = od[u] * (rsqrtf(ssb[u] * (1.f / 64.f) + 1e-6f)) * dg;
      const f32x4 z = {bflo(zz[u][0]), bfhi(zz[u][0]), bflo(zz[u][1]), bfhi(zz[u][1])};
      const f32x4 sz = {siluf(z[0]), siluf(z[1]), siluf(z[2]), siluf(z[3])};
      const f32x4 yd = go[u] * (rsqrtf(ssg[u] * (1.f / 64.f) + 1e-6f)) * gg * sz;
      u32x2 pb, pd;
      pb[0] = pack2(yb[0], yb[1]); pb[1] = pack2(yb[2], yb[3]);
      pd[0] = pack2(yd[0], yd[1]); pd[1] = pack2(yd[2], yd[3]);
      *(u32x2*)(Y + t * 1024 + 256 + hd * 64 + d0) = pb;
      *(u32x2*)(Y + t * 1024 + 768 + hd * 64 + d0) = pd;
    }
  }
}

constexpr int RLD = 1026;
DEVI void st_norm2_route(const Params& p, int l, int vb, int nvb, char* smem) {
  const int lane = p.tid & 63, wid = p.tid >> 6, i15 = lane & 15, q = lane >> 4;
  float* shh = (float*)smem;
  float* slog = shh + 16 * RLD;
  const float* g = pin(p, I_N2G) + l * 1024;
  const float* wr = pin(p, I_WR) + (size_t)l * 1024 * 64;
  const float bias = pin(p, I_RB)[l * 64 + lane];
  float* WTS = (float*)(p.ws + O_WTS); int* CNT = (int*)(p.ws + O_CNT); int* LIST = (int*)(p.ws + O_LIST);
  const int ntok = l == 0 ? T : TL;
  for (int grp = vb; grp < ntok / 16; grp += nvb) {
    const int tb = grp * 16 + wid * 4;
    const int mv = tok_mv(tb);
    const float* sh = modp(p, l, mv, 3); const float* sc = modp(p, l, mv, 4);
    {
      f32x4 v[4][4]; float ss[4];
#pragma unroll
      for (int u = 0; u < 4; ++u) {
        const f32x4* xr = (const f32x4*)((const float*)(p.ws + O_XA) + (size_t)(tb + u) * 1024);
#pragma unroll
        for (int i = 0; i < 4; ++i) v[u][i] = xr[i * 64 + lane];
      }
#pragma unroll
      for (int u = 0; u < 4; ++u) {
        float a = 0.f;
#pragma unroll
        for (int i = 0; i < 4; ++i) a += v[u][i][0] * v[u][i][0] + v[u][i][1] * v[u][i][1] + v[u][i][2] * v[u][i][2] + v[u][i][3] * v[u][i][3];
        ss[u] = a;
      }
#pragma unroll
      for (int o = 32; o >= 1; o >>= 1) {
#pragma unroll
        for (int u = 0; u < 4; ++u) ss[u] += __shfl_xor(ss[u], o);
      }
#pragma unroll
      for (int i = 0; i < 4; ++i) {
        const int c = i * 256 + lane * 4;
        const f32x4 gg = *(const f32x4*)(g + c), s4 = *(const f32x4*)(sc + c), h4 = *(const f32x4*)(sh + c);
        const f32x4 gs = gg * (1.f + s4);
#pragma unroll
        for (int u = 0; u < 4; ++u) {
          const float rstd = rsqrtf(ss[u] * (1.f / 1024.f) + 1e-6f);
          const f32x4 o = v[u][i] * rstd * gs + h4;
          u32x2 pk; pk[0] = pack2(o[0], o[1]); pk[1] = pack2(o[2], o[3]);
          *(u32x2*)((u16*)(p.ws + O_H) + (size_t)(tb + u) * LDH + c) = pk;
          float* d = shh + (wid * 4 + u) * RLD + c;
          *(f32x2*)d = f32x2{o[0], o[1]}; *(f32x2*)(d + 2) = f32x2{o[2], o[3]};
        }
      }
    }
    __syncthreads();
    {
      f32x4 a0 = fzero4(), a1 = a0;
      const float* ap = shh + i15 * RLD + q;
      const float* bp = wr + (size_t)q * 64 + wid * 16 + i15;
#pragma unroll 1
      for (int kb = 0; kb < 256; kb += 32) {
        float bv[32];
#pragma unroll
        for (int j = 0; j < 32; ++j) bv[j] = bp[(size_t)(4 * (kb + j)) * 64];
#pragma unroll
        for (int j = 0; j < 32; j += 2) {
          a0 = __builtin_amdgcn_mfma_f32_16x16x4f32(ap[4 * (kb + j)], bv[j], a0, 0, 0, 0);
          a1 = __builtin_amdgcn_mfma_f32_16x16x4f32(ap[4 * (kb + j) + 4], bv[j + 1], a1, 0, 0, 0);
        }
      }
#pragma unroll
      for (int r = 0; r < 4; ++r) slog[(4 * q + r) * 64 + wid * 16 + i15] = a0[r] + a1[r];
    }
    __syncthreads();
#pragma unroll 1
    for (int u = 0; u < 4; ++u) {
      const int t = tb + u;
      const float logit = slog[(wid * 4 + u) * 64 + lane];
      const float s = 1.f / (1.f + expf(-logit));
      const float c = s + bias;
      float m1 = c;
      m1 = fmaxf(m1, __shfl_xor(m1, 1)); m1 = fmaxf(m1, __shfl_xor(m1, 2)); m1 = fmaxf(m1, __shfl_xor(m1, 4));
      const unsigned long long bal = __ballot(c == m1);
      const int grpi = lane >> 3;
      const unsigned gm = (unsigned)((bal >> (grpi * 8)) & 0xffull);
      const int first = __ffs(gm) - 1;
      float m2 = ((lane & 7) == first) ? -INFINITY : c;
      m2 = fmaxf(m2, __shfl_xor(m2, 1)); m2 = fmaxf(m2, __shfl_xor(m2, 2)); m2 = fmaxf(m2, __shfl_xor(m2, 4));
      const float gs = m1 + m2;
      int grank = 0;
#pragma unroll
      for (int gg = 0; gg < 8; ++gg) { float o = __shfl(gs, gg * 8); grank += (o > gs || (o == gs && gg < grpi)) ? 1 : 0; }
      const bool gsel = grank < 4;
      const float mc = gsel ? c : -INFINITY;
      int rank = 0;
#pragma unroll
      for (int e = 0; e < 64; ++e) { float o = __shfl(mc, e); rank += (o > mc || (o == mc && e < lane)) ? 1 : 0; }
      const bool sel = gsel && rank < 6;
      const float ssum = wave_sum(sel ? s : 0.f);
      if (sel) {
        const int slot = t * 6 + rank;
        WTS[slot] = s / ssum * 2.5f;
        const int pos = atomicAdd(&CNT[lane], 1);
        LIST[(size_t)lane * T + pos] = slot;
      }
    }
    __syncthreads();
  }
}
DEVI void st_outproj(const Params& p, int l, int vb, int nvb, char* smem) {
  const u16* Y = (const u16*)(p.ws + O_Y); const u16* W = (const u16*)(p.ws + O_WOUTT); float* XA = (float*)(p.ws + O_XA);
  const int tid = p.tid, lane = tid & 63, wid = tid >> 6, wr = wid >> 1, wc = wid & 1, fr = lane & 15, fq = lane >> 4;
  const int nmt = l == 0 ? 132 : 128;
  const int g = vb & 7, nmg = (nmt - g + 7) >> 3;
  for (int i = vb >> 3; i < nmg * 8; i += nvb >> 3) {
    const int m0 = (g + 8 * (i >> 3)) * 128, n0 = (i & 7) * 128;
    f32x4 acc[4][4];
    gemm_core<false>(tid, [&](int r) { return Y + (size_t)(m0 + r) * 1024; }, W + (size_t)n0 * LDW, LDW, 1024, acc, smem);
    const float* gbase = modp(p, l, tok_mv(m0), 2) + n0 + wc * 64 + fq * 4;
#pragma unroll
    for (int hf = 0; hf < 2; ++hf) {
      f32x4 xin[2][4], gt[4];
#pragma unroll
      for (int n = 0; n < 4; ++n) gt[n] = *(const f32x4*)(gbase + n * 16);
#pragma unroll
      for (int mm = 0; mm < 2; ++mm) {
        const int t = m0 + wr * 64 + (hf * 2 + mm) * 16 + fr;
        const float* src = l == 0 ? (t < TL ? pin(p, I_X) + (size_t)t * 1024 : pin(p, I_CTX) + (size_t)(t - TL) * 1024) : (const float*)(XA + (size_t)t * 1024);
#pragma unroll
        for (int n = 0; n < 4; ++n) xin[mm][n] = *(const f32x4*)(src + n0 + wc * 64 + n * 16 + fq * 4);
      }
#pragma unroll
      for (int mm = 0; mm < 2; ++mm) {
        const int t = m0 + wr * 64 + (hf * 2 + mm) * 16 + fr;
#pragma unroll
        for (int n = 0; n < 4; ++n) *(f32x4*)(XA + (size_t)t * 1024 + n0 + wc * 64 + n * 16 + fq * 4) = xin[mm][n] + gt[n] * acc[hf * 2 + mm][n];
      }
    }
  }
}

DEVI void grp_tiles(const Params& p, int* tst, int g, int shift, int nshared) {
  __syncthreads();
  if (p.tid < 64) {
    const int* CNT = (const int*)(p.ws + O_CNT);
    const int lane = p.tid;
    int c = 0;
    if (lane < 8) c = (__hip_atomic_load(&CNT[g + 8 * lane], __ATOMIC_RELAXED, __HIP_MEMORY_SCOPE_AGENT) + (1 << shift) - 1) >> shift;
    int incl = c;
#pragma unroll
    for (int o = 1; o < 8; o <<= 1) { int u = __shfl_up(incl, o); if (lane >= o) incl += u; }
    if (lane < 8) tst[lane] = incl - c;
    if (lane == 7) { tst[8] = incl; tst[9] = incl + (nshared - g + 7) / 8; }
  }
  __syncthreads();
}
DEVI void grp_find(const int* tst, int tile, int g, int& e, int& lt) {
  int j = 0;
#pragma unroll
  for (int k = 1; k <= 8; ++k) j += tile >= tst[k] ? 1 : 0;
  if (j < 8) { e = g + 8 * j; lt = tile - tst[j]; } else { e = 64; lt = g + 8 * (tile - tst[8]); }
}
DEVI void st_moe1(const Params& p, int l, int vb, int nvb, char* smem) {
  const int* CNT = (const int*)(p.ws + O_CNT); const int* LIST = (const int*)(p.ws + O_LIST);
  const u16* H = (const u16*)(p.ws + O_H); u16* HB = (u16*)(p.ws + O_HB);
  int* sslot = (int*)(smem + 4 * 128 * GLD * 2);
  int* TST = sslot + 128;
  const int g = vb & 7;
  const int nsh = l == 0 ? T : TL;
  grp_tiles(p, TST, g, 7, nsh / 128);
  const int total = TST[9];
  auto fetch_slot = [&](int item, int& e, int& n0) {
    const int tile = item >> 2; n0 = (item & 3) * 128;
    int lt; grp_find(TST, tile, g, e, lt);
    int slot = -1;
    if (p.tid < 128) {
      const int cnt = e < 64 ? __hip_atomic_load(&CNT[e], __ATOMIC_RELAXED, __HIP_MEMORY_SCOPE_AGENT) : nsh;
      const int i = lt * 128 + p.tid;
      if (i < cnt) slot = e < 64 ? LIST[(size_t)e * T + i] : NSLOT + i;
    }
    return slot;
  };
  int e = 0, n0 = 0, e_nx = 0, n0_nx = 0;
  int slot_nx = (vb >> 3) < total * 4 ? fetch_slot(vb >> 3, e_nx, n0_nx) : -1;
  for (int item = vb >> 3; item < total * 4; item += nvb >> 3) {
    e = e_nx; n0 = n0_nx;
    __syncthreads();
    if (p.tid < 128) sslot[p.tid] = slot_nx;
    __syncthreads();
    if (item + (nvb >> 3) < total * 4) slot_nx = fetch_slot(item + (nvb >> 3), e_nx, n0_nx);
    f32x4 acc[4][4];
    gemm_core<false, 2>(p.tid, [&](int r) { int sl = sslot[r]; int tk = sl < 0 ? 0 : (sl < NSLOT ? sl / 6 : sl - NSLOT); return H + (size_t)tk * LDH; },
                        (const u16*)(p.ws + O_WGUT) + ((size_t)e * 512 + n0) * LDW, LDW, 1024, acc, smem);
    {
      const int lane = p.tid & 63, wid = p.tid >> 6, wr = wid >> 1, wc = wid & 1, fr = lane & 15, fq = lane >> 4;
#pragma unroll
      for (int m = 0; m < 4; ++m) {
        const int sl = sslot[wr * 64 + m * 16 + fr];
        if (sl >= 0) {
          u32x4 pk;
#pragma unroll
          for (int n = 0; n < 4; ++n) pk[n] = pack2(siluf(acc[m][n][0]) * acc[m][n][1], siluf(acc[m][n][2]) * acc[m][n][3]);
          *(u32x4*)(HB + (size_t)sl * 256 + (n0 >> 1) + wc * 32 + fq * 8) = pk;
        }
      }
    }
  }
}
DEVI void st_moe2(const Params& p, int l, int vb, int nvb, char* smem) {
  const int* CNT = (const int*)(p.ws + O_CNT); const int* LIST = (const int*)(p.ws + O_LIST);
  const u16* HB = (const u16*)(p.ws + O_HB); u16* SO = (u16*)(p.ws + O_SLOT); const float* WTS = (const float*)(p.ws + O_WTS);
  constexpr int ALD = 264;
  u16* sA = (u16*)smem;
  u16* sB = sA + 64 * ALD;
  int* sslot = (int*)(sB + 2 * 128 * 72);
  int* TST = sslot + 64;
  const int tid = p.tid, lane = tid & 63, wid = tid >> 6, wr = wid >> 1, wc = wid & 1, fr = lane & 15, fq = lane >> 4;
  const int g = vb & 7;
  const int nsh = l == 0 ? T : TL;
  grp_tiles(p, TST, g, 6, nsh / 64);
  const int total = TST[9];
  for (int item = vb >> 3; item < total; item += nvb >> 3) {
    int e, lt; grp_find(TST, item, g, e, lt);
    const int cnt = e < 64 ? __hip_atomic_load(&CNT[e], __ATOMIC_RELAXED, __HIP_MEMORY_SCOPE_AGENT) : nsh;
    __syncthreads();
    if (tid < 64) { const int i = lt * 64 + tid; sslot[tid] = i < cnt ? (e < 64 ? LIST[(size_t)e * T + i] : NSLOT + i) : -1; }
    __syncthreads();
    const u16* Bbase = (const u16*)(p.ws + O_WDT) + (size_t)e * 1024 * 256;
    constexpr int NR = 5;
    u32x4 rb[NR][4];
    const u16* bthr = Bbase + (size_t)(tid >> 3) * 256 + (tid & 7) * 8;
    auto gloadB = [&](u32x4 (&rb)[4], int bt) {
      int off = (bt >> 2) * 128 * 256 + (bt & 3) * 64;
      asm volatile("" : "+s"(off));
      const u16* src = bthr + off;
#pragma unroll
      for (int i = 0; i < 4; ++i) rb[i] = *(const u32x4*)(src + i * 32 * 256);
    };
    auto lstoreB = [&](const u32x4 (&rb)[4], int buf) {
      u16* d = sB + buf * 128 * 72;
#pragma unroll
      for (int i = 0; i < 4; ++i) { const int q = tid + 256 * i, r = q >> 3, cc = q & 7; *(u32x4*)&d[r * 72 + cc * 8] = rb[i]; }
    };
#pragma unroll
    for (int t = 0; t < NR; ++t) gloadB(rb[t], t);
#pragma unroll
    for (int hf = 0; hf < 2; ++hf) {
      u32x4 ra[4];
#pragma unroll
      for (int i = 0; i < 4; ++i) { const int q = tid + 256 * (4 * hf + i), r = q >> 5, cc = q & 31; const int sl = sslot[r]; ra[i] = *(const u32x4*)(HB + (size_t)(sl < 0 ? 0 : sl) * 256 + cc * 8); }
#pragma unroll
      for (int i = 0; i < 4; ++i) { const int q = tid + 256 * (4 * hf + i), r = q >> 5, cc = q & 31; *(u32x4*)&sA[r * ALD + cc * 8] = ra[i]; }
      __builtin_amdgcn_sched_barrier(0);
    }
    int slot_m[2]; float w_m[2];
#pragma unroll
    for (int m = 0; m < 2; ++m) { const int sl = sslot[wr * 32 + m * 16 + fr]; slot_m[m] = sl; w_m[m] = (sl >= 0 && sl < NSLOT) ? WTS[sl] : 1.f; }
    lstoreB(rb[0], 0); gloadB(rb[0], NR);
    __syncthreads();
    f32x4 acc[2][4];
    auto compute = [&](int bt, int buf) {
      const int nt = bt >> 2, kt = bt & 3;
      const u16* b = sB + buf * 128 * 72;
      if (kt == 0) {
#pragma unroll
        for (int m = 0; m < 2; ++m)
#pragma unroll
          for (int n = 0; n < 4; ++n) acc[m][n] = fzero4();
      }
#pragma unroll
      for (int ks = 0; ks < 2; ++ks) {
        bf16x8 af[2], bfr[4];
#pragma unroll
        for (int m = 0; m < 2; ++m) af[m] = *(const bf16x8*)&sA[(wr * 32 + m * 16 + fr) * ALD + kt * 64 + ks * 32 + fq * 8];
#pragma unroll
        for (int n = 0; n < 4; ++n) bfr[n] = *(const bf16x8*)&b[(wc * 64 + (n >> 1) * 32 + (fr >> 2) * 8 + (n & 1) * 4 + (fr & 3)) * 72 + ks * 32 + fq * 8];
#pragma unroll
        for (int m = 0; m < 2; ++m)
#pragma unroll
          for (int n = 0; n < 4; ++n) acc[m][n] = MFMA16(bfr[n], af[m], acc[m][n]);
      }
      if (kt == 3) {
#pragma unroll
        for (int m = 0; m < 2; ++m) {
          if (slot_m[m] >= 0) {
            const float w = w_m[m];
#pragma unroll
            for (int h = 0; h < 2; ++h) {
              u32x4 pk;
              pk[0] = pack2(acc[m][2 * h][0] * w, acc[m][2 * h][1] * w); pk[1] = pack2(acc[m][2 * h][2] * w, acc[m][2 * h][3] * w);
              pk[2] = pack2(acc[m][2 * h + 1][0] * w, acc[m][2 * h + 1][1] * w); pk[3] = pack2(acc[m][2 * h + 1][2] * w, acc[m][2 * h + 1][3] * w);
              *(u32x4*)(SO + (size_t)slot_m[m] * 1024 + nt * 128 + wc * 64 + h * 32 + fq * 8) = pk;
            }
          }
        }
      }
    };
#pragma unroll
    for (int bt = 0; bt < 32; ++bt) {
      compute(bt, bt & 1);
      if (bt + 1 < 32) lstoreB(rb[(bt + 1) % NR], (bt + 1) & 1);
      if (bt + 1 + NR < 32) gloadB(rb[(bt + 1) % NR], bt + 1 + NR);
      __syncthreads(); __builtin_amdgcn_sched_barrier(0);
    }
  }
}

DEVI void st_combine(const Params& p, int l, int vb, int nvb) {
  const int lane = p.tid & 63, wid = p.tid >> 6;
  const u16* SO = (const u16*)(p.ws + O_SLOT);
  const bool last = l == 1;
  const float* gnext = last ? pin(p, I_FNG) : pin(p, I_N1G) + 1024;
  const int tend = last ? TL : T;
  for (int t0 = (vb * 4 + wid) * 2; t0 < tend; t0 += nvb * 8) {
    const int mv = tok_mv(t0);
    const float* g5 = modp(p, l, mv, 5);
    u32x4 sv[2][7][2]; f32x4 xv[2][4];
#pragma unroll
    for (int u = 0; u < 2; ++u) {
      const int t = t0 + u;
#pragma unroll
      for (int k = 0; k < 7; ++k) {
        const u16* row = SO + (size_t)(k < 6 ? t * 6 + k : NSLOT + t) * 1024;
        sv[u][k][0] = *(const u32x4*)(row + lane * 8); sv[u][k][1] = *(const u32x4*)(row + 512 + lane * 8);
      }
      const float* xr = (const float*)(p.ws + O_XA) + (size_t)t * 1024;
      xv[u][0] = *(const f32x4*)(xr + lane * 8); xv[u][1] = *(const f32x4*)(xr + lane * 8 + 4);
      xv[u][2] = *(const f32x4*)(xr + 512 + lane * 8); xv[u][3] = *(const f32x4*)(xr + 512 + lane * 8 + 4);
    }
    f32x4 gq[4];
    gq[0] = *(const f32x4*)(g5 + lane * 8); gq[1] = *(const f32x4*)(g5 + lane * 8 + 4);
    gq[2] = *(const f32x4*)(g5 + 512 + lane * 8); gq[3] = *(const f32x4*)(g5 + 512 + lane * 8 + 4);
    float ss[2];
#pragma unroll
    for (int u = 0; u < 2; ++u) {
      float acc = 0.f;
#pragma unroll
      for (int hf = 0; hf < 2; ++hf) {
        f32x4 a0 = fzero4(), a1 = a0;
#pragma unroll
        for (int k = 0; k < 7; ++k) {
          const u32x4 v = sv[u][k][hf];
          a0[0] += bflo(v[0]); a0[1] += bfhi(v[0]); a0[2] += bflo(v[1]); a0[3] += bfhi(v[1]);
          a1[0] += bflo(v[2]); a1[1] += bfhi(v[2]); a1[2] += bflo(v[3]); a1[3] += bfhi(v[3]);
        }
        xv[u][2 * hf] += gq[2 * hf] * a0; xv[u][2 * hf + 1] += gq[2 * hf + 1] * a1;
#pragma unroll
        for (int e = 0; e < 4; ++e) acc += xv[u][2 * hf][e] * xv[u][2 * hf][e] + xv[u][2 * hf + 1][e] * xv[u][2 * hf + 1][e];
      }
      ss[u] = acc;
    }
#pragma unroll
    for (int o = 32; o >= 1; o >>= 1) { ss[0] += __shfl_xor(ss[0], o); ss[1] += __shfl_xor(ss[1], o); }
    f32x4 gn[4];
    gn[0] = *(const f32x4*)(gnext + lane * 8); gn[1] = *(const f32x4*)(gnext + lane * 8 + 4);
    gn[2] = *(const f32x4*)(gnext + 512 + lane * 8); gn[3] = *(const f32x4*)(gnext + 512 + lane * 8 + 4);
    if (!last) {
      const float* sh = modp(p, 1, mv, 0); const float* sc = modp(p, 1, mv, 1);
#pragma unroll
      for (int q = 0; q < 4; ++q) {
        const int c = (q >> 1) * 512 + lane * 8 + (q & 1) * 4;
        const f32x4 s4 = *(const f32x4*)(sc + c), h4 = *(const f32x4*)(sh + c);
        const f32x4 gs = gn[q] * (1.f + s4);
#pragma unroll
        for (int u = 0; u < 2; ++u) {
          const size_t t = t0 + u;
          const float rstd = rsqrtf(ss[u] * (1.f / 1024.f) + 1e-6f);
          *(f32x4*)((float*)(p.ws + O_XA) + t * 1024 + c) = xv[u][q];
          const f32x4 o = xv[u][q] * rstd * gs + h4;
          u32x2 pk; pk[0] = pack2(o[0], o[1]); pk[1] = pack2(o[2], o[3]);
          *(u32x2*)((u16*)(p.ws + O_H) + t * LDH + c) = pk;
        }
      }
    } else {
#pragma unroll
      for (int q = 0; q < 4; ++q) {
        const int c = (q >> 1) * 512 + lane * 8 + (q & 1) * 4;
#pragma unroll
        for (int u = 0; u < 2; ++u) {
          const size_t t = t0 + u;
          const float rstd = rsqrtf(ss[u] * (1.f / 1024.f) + 1e-6f);
          *(f32x4*)(p.out + t * 1024 + c) = xv[u][q] * rstd * gn[q];
        }
      }
    }
  }
}


#define STAGE(call) { const Params p = mkctx(a); call; }

#define XB_TMO      128
#define XB_XCNT(j)  (256  + 64 * (j))
#define XB_XSUB(j)  (1280 + 64 * (j))
#define XB_XGEN(j)  (2304 + 64 * (j))
#define XB_TOP      3328
#define XB_TOPGEN   3392
#define XCD_BAR_WORDS 3456
#define XB_SPIN_CAP (1u << 20)
#define LAS __attribute__((address_space(3)))
DEVI unsigned xb_ld(unsigned* p)              { return __hip_atomic_load(p, __ATOMIC_RELAXED, __HIP_MEMORY_SCOPE_AGENT); }
DEVI unsigned xb_add(unsigned* p, unsigned v) { return __hip_atomic_fetch_add(p, v, __ATOMIC_RELAXED, __HIP_MEMORY_SCOPE_AGENT); }
DEVI unsigned xb_xcc_id() { return (unsigned)__builtin_amdgcn_s_getreg((3 << 11) | 20) & 0xFu; }
#define XB_SPIN(cond, bar) do { unsigned _sp = 0; while (cond) { __builtin_amdgcn_s_sleep(1); \
    if ((++_sp & 255u) == 0u) { if (xb_ld(&(bar)[XB_TMO])) break; if (_sp > XB_SPIN_CAP) { atomicAdd(&(bar)[XB_TMO], 1u); break; } } } } while (0)
struct XcdBarrier { unsigned* bar; unsigned x; volatile LAS unsigned* st; };
DEVI XcdBarrier xcd_barrier_post(unsigned* bar, volatile LAS unsigned* st) {
  XcdBarrier b; b.bar = bar; b.x = xb_xcc_id(); b.st = st;
  if (threadIdx.x == 0) (void)xb_add(&bar[XB_XCNT(b.x)], 1u);
  return b;
}
DEVI void xcd_barrier_complete(unsigned* bar, unsigned x, unsigned& nloc, unsigned& nx) {
  const unsigned G = gridDim.x * gridDim.y * gridDim.z;
  unsigned sum, cnt, mine, sp = 0u;
  for (;;) {
    sum = 0u; cnt = 0u; mine = 0u;
#pragma unroll
    for (unsigned j = 0; j < 16; ++j) { const unsigned c = xb_ld(&bar[XB_XCNT(j)]); sum += c; cnt += (c > 0u) ? 1u : 0u; mine = (j == x) ? c : mine; }
    if (sum == G) break;
    __builtin_amdgcn_s_sleep(1);
    if ((++sp & 255u) == 0u) { if (xb_ld(&bar[XB_TMO])) break; if (sp > XB_SPIN_CAP) { atomicAdd(&bar[XB_TMO], 1u); break; } }
  }
  nloc = mine > 0u ? mine : 1u; nx = cnt > 0u ? cnt : 1u;
}
DEVI void xcd_barrier(const XcdBarrier& b) {
  asm volatile("s_waitcnt vmcnt(0)" ::: "memory");
  __syncthreads();
  if (threadIdx.x == 0) {
    unsigned* bar = b.bar;
    __builtin_amdgcn_s_waitcnt(0);
    unsigned nloc = b.st[0], nx = b.st[1];
    if (nloc == 0u) { xcd_barrier_complete(bar, b.x, nloc, nx); b.st[0] = nloc; b.st[1] = nx; }
    const unsigned old = xb_add(&bar[XB_XSUB(b.x)], 1u);
    const unsigned gen = old / nloc;
    if (old + 1u == (gen + 1u) * nloc) {
      __builtin_amdgcn_fence(__ATOMIC_RELEASE, "agent");
      asm volatile("s_waitcnt vmcnt(0)" ::: "memory");
      const unsigned og = xb_add(&bar[XB_TOP], 1u);
      const unsigned tg = og / nx;
      if (og + 1u == (tg + 1u) * nx) xb_add(&bar[XB_TOPGEN], 1u);
      else XB_SPIN(xb_ld(&bar[XB_TOPGEN]) == tg, bar);
      __builtin_amdgcn_fence(__ATOMIC_ACQUIRE, "agent");
      xb_add(&bar[XB_XGEN(b.x)], 1u);
      asm volatile("s_waitcnt vmcnt(0)" ::: "memory");
    } else {
      XB_SPIN(xb_ld(&bar[XB_XGEN(b.x)]) == gen, bar);
      __builtin_amdgcn_fence(__ATOMIC_ACQUIRE, "agent");
      asm volatile("s_waitcnt vmcnt(0)" ::: "memory");
    }
  }
  __syncthreads();
}
#define GSYNC() { XcdBarrier xb_; xb_.bar = (unsigned*)(mkctx(a).ws + O_XBAR); xb_.x = xb_xcc_id(); xb_.st = (volatile LAS unsigned*)(smem + SMEM_BYTES - 32); xcd_barrier(xb_); }

__global__ void __launch_bounds__(256, 2) mega(KArgs a) {
  extern __shared__ __attribute__((aligned(16))) char smem[];
  cg::grid_group grid = cg::this_grid();
  const int vb = blockIdx.x, nvb = gridDim.x;
  volatile LAS unsigned* xst = (volatile LAS unsigned*)(smem + SMEM_BYTES - 32);
  if (threadIdx.x == 0) { xst[0] = 0u; xst[1] = 0u; }
  __syncthreads();
  (void)xcd_barrier_post((unsigned*)(a.ws + O_XBAR), xst);
  if (threadIdx.x == 0) {
    const float** tab = (const float**)(a.ws + O_TAB);
#pragma unroll
    for (int i = 0; i < 35; ++i) tab[i] = a.in[i];
  }
  __syncthreads();
  STAGE(st_rope_table(p, vb, nvb));
  STAGE(st_mod(p, vb, nvb, smem));
  STAGE(st_prep_w1(p, 0, vb, nvb, smem));
  if (a.ws == nullptr) grid.sync();
  GSYNC();
  for (int l = 0; l < 2; ++l) {
    if (l == 0) { STAGE(st_norm1(p, 0, vb, nvb)); GSYNC(); }
    {
      const int g = vb & 7;
      for (int i = vb >> 3; i < 363; i += nvb >> 3) {
        int mt, nt;
        if (i < 264) { mt = i >> 1; nt = g + 8 * (i & 1); }
        else { const int j = i - 264, pc = g + 8 * (j / 33); nt = 16 + (pc >> 2); mt = (pc & 3) * 33 + (j % 33); }
        const Params p = mkctx(a); inproj_item(p, mt * 22 + nt, smem);
      }
    }
    GSYNC();
    STAGE(st_tokprep(p, l, vb, nvb));
    GSYNC();
    {
      for (int item = vb; item < 132 * 7 + NGITEM; item += nvb) {
        const Params p = mkctx(a);
        if (item < 132 * 7) mla_up_tile(p, item / 7, item % 7, smem);
        else gdn_chunk_item(p, item - 132 * 7, smem);
      }
    }
    GSYNC();
    st_mixer_queue(a, l, smem);
    GSYNC();
    STAGE(st_mix_finish(p, l, vb, nvb));
    GSYNC();
    STAGE(st_outproj(p, l, vb, nvb, smem));
    GSYNC();
    STAGE(st_norm2_route(p, l, vb, nvb, smem));
    GSYNC();
    STAGE(st_moe1(p, l, vb, nvb, smem));
    GSYNC();
    STAGE(st_moe2(p, l, vb, nvb, smem));
    GSYNC();
    if (l == 0) STAGE(st_prep_w1(p, 1, vb, nvb, smem));
    STAGE(st_combine(p, l, vb, nvb));
    if (l == 0) GSYNC();
  }
}

extern "C" void kernel_launch(void* const* d_in, const int* in_sizes, int n_in, void* d_out, int out_size, void* d_ws, size_t ws_size,
                              hipStream_t stream) {
  static int grid_blocks = 0;
  if (!grid_blocks) {
    int dev = 0, cus = 0, per_cu = 0;
    (void)hipGetDevice(&dev);
    (void)hipDeviceGetAttribute(&cus, hipDeviceAttributeMultiprocessorCount, dev);
    (void)hipFuncSetAttribute((const void*)mega, hipFuncAttributeMaxDynamicSharedMemorySize, SMEM_BYTES);
    (void)hipOccupancyMaxActiveBlocksPerMultiprocessor(&per_cu, mega, 256, SMEM_BYTES);
    if (per_cu > 2) per_cu = 2;
    if (per_cu < 1) per_cu = 1;
    grid_blocks = cus * per_cu;
  }
  KArgs p{};
  for (int i = 0; i < 35; ++i) p.in[i] = (const float*)d_in[i];
  p.out = (float*)d_out; p.ws = (char*)d_ws;
  if (ws_size < WS_NEED) { fprintf(stderr, "workspace too small: %zu < %zu\n", ws_size, (size_t)WS_NEED); return; }
  (void)hipMemsetAsync((char*)d_ws + O_BAR, 0, 256 + 16384, stream);
  void* args[] = {&p};
  hipError_t e = hipLaunchCooperativeKernel((void*)mega, dim3(grid_blocks), dim3(256), args, SMEM_BYTES, stream);
  if (e != hipSuccess) fprintf(stderr, "cooperative launch failed: %s (grid %d)\n", hipGetErrorString(e), grid_blocks);
}
```

```cpp
#include <hip/hip_runtime.h>
#include <hip/hip_cooperative_groups.h>
#include <cstdio>
#include <cstdint>
namespace cg = cooperative_groups;

#define DEVI __device__ __forceinline__
typedef unsigned short u16;
using bf16x8 = __attribute__((ext_vector_type(8))) short;
using f32x4  = __attribute__((ext_vector_type(4))) float;
using f32x2  = __attribute__((ext_vector_type(2))) float;
using f32x16 = __attribute__((ext_vector_type(16))) float;
using u32x4 = __attribute__((ext_vector_type(4))) unsigned;
using u32x2 = __attribute__((ext_vector_type(2))) unsigned;
typedef __bf16 bf16x2_t __attribute__((ext_vector_type(2)));

constexpr int DM = 1024, SEQ = 8192, CTXL = 256, NKEY = SEQ + CTXL;
constexpr int TL = 2 * SEQ, TC = 2 * CTXL, T = TL + TC;
constexpr int INW = 2672;
constexpr int NIN = 2816;
constexpr int LDPP = 1408;
constexpr int PP_CQ = 0, PP_CKV = 192, PP_DQKV = 320, PP_DZ = 1088, PP_GATE = 1344;
constexpr int NE = 64, NSLOT = 6 * T;
constexpr int LDW = 1088;
constexpr int LDH = 1088;
constexpr int NCHUNK = T / 64;
constexpr int NGITEM = NCHUNK * 8;
constexpr float LOG2E = 1.4426950408889634f;

constexpr size_t al256(size_t x) { return (x + 255) & ~(size_t)255; }
constexpr size_t O_MOD   = 0;
constexpr size_t O_ROPE  = O_MOD + al256((size_t)2 * 3 * 6144 * 4);
constexpr size_t O_XA    = O_ROPE + (size_t)SEQ * 48 * 8;
constexpr size_t O_H     = O_XA + (size_t)T * DM * 4;
constexpr size_t O_WINT  = O_H + (size_t)T * LDH * 2;
constexpr size_t O_WOUTT = O_WINT + (size_t)NIN * LDW * 2;
constexpr size_t O_WUQT  = O_WOUTT + (size_t)1024 * LDW * 2;
constexpr size_t O_WUKVT = O_WUQT + (size_t)384 * 192 * 2;
constexpr size_t O_WGUT  = O_WUKVT + (size_t)512 * 128 * 2;
constexpr size_t O_WDT   = O_WGUT + (size_t)65 * 512 * LDW * 2;
constexpr size_t O_WTS   = O_WDT + (size_t)65 * 1024 * 256 * 2;
constexpr size_t O_CNT   = O_WTS + al256((size_t)NSLOT * 4);
constexpr size_t O_TAB   = O_CNT + 256;
constexpr size_t O_BAR   = O_TAB + 512;
constexpr size_t O_XBAR  = O_BAR + 256;
constexpr size_t O_LIST  = O_XBAR + 16384;
constexpr size_t O_R     = O_LIST + (size_t)NE * T * 4;
constexpr size_t O_Y     = O_R;
constexpr size_t O_PP    = O_Y + (size_t)T * DM * 2;
constexpr size_t O_QA    = O_PP + (size_t)T * LDPP * 2;
constexpr size_t O_KA    = O_QA + (size_t)2 * 4 * NKEY * 64 * 2;
constexpr size_t O_VTA   = O_KA + (size_t)2 * 2 * NKEY * 64 * 2;
constexpr size_t O_QB    = O_VTA + (size_t)2 * 2 * NKEY * 64 * 2;
constexpr size_t O_KB    = O_QB + (size_t)2 * 8 * NKEY * 32 * 2;
constexpr size_t O_VTB   = O_KB + (size_t)2 * 8 * NKEY * 32 * 2;
constexpr size_t O_QC    = O_VTB + (size_t)2 * 4 * NKEY * 64 * 2;
constexpr size_t O_KC    = O_QC + (size_t)2 * 4 * NKEY * 96 * 2;
constexpr size_t O_VTC   = O_KC + (size_t)2 * 4 * NKEY * 96 * 2;
constexpr size_t O_CQN   = O_VTC + (size_t)2 * 4 * NKEY * 64 * 2;
constexpr size_t O_CKVN  = O_CQN + (size_t)T * 192 * 2;
constexpr size_t O_OB    = O_CKVN + (size_t)T * 128 * 2;
constexpr size_t O_GQ    = O_OB + (size_t)T * 512 * 2;
constexpr size_t O_GK    = O_GQ + (size_t)T * 256 * 2;
constexpr size_t O_GV    = O_GK + (size_t)T * 256 * 2;
constexpr size_t O_GG    = O_GV + (size_t)T * 256 * 2;
constexpr size_t O_GBETA = O_GG + (size_t)2 * T * 4 * 4;
constexpr size_t O_GM    = O_GBETA + (size_t)2 * T * 4 * 4;
constexpr size_t O_GQP   = O_GM + (size_t)NGITEM * 4096 * 2;
constexpr size_t O_GN    = O_GQP + (size_t)NGITEM * 4096 * 2;
constexpr size_t O_GLO   = O_GN + (size_t)NGITEM * 4096 * 2;
constexpr size_t O_GO    = O_GLO + (size_t)NGITEM * 4096 * 2;
constexpr size_t O_MIX_END = O_GO + (size_t)2 * T * 256 * 4;
constexpr size_t O_HB    = O_R;
constexpr size_t O_SLOT  = O_HB + (size_t)7 * T * 256 * 2;
constexpr size_t O_MOE_END = O_SLOT + (size_t)7 * T * 1024 * 2;
constexpr size_t cmax(size_t a, size_t b) { return a > b ? a : b; }
constexpr size_t WS_NEED = cmax(O_MIX_END, O_MOE_END);
static_assert(WS_NEED < (size_t)556000000, "workspace too large");

struct KArgs {
  const float* in[35];
  float* out;
  char* ws;
};
typedef const __attribute__((address_space(1))) float gcfloat;
struct Params {
  char* ws;
  float* out;
  gcfloat* const* in;
  int tid;
};
#define pin(p, i) ((const float*)(p).in[i])
enum { I_X = 0, I_C, I_CTX, I_CCTX, I_WADA, I_BADA, I_N1G, I_N2G, I_WIN, I_WOUT, I_SINK, I_LQ1, I_LK1, I_LQ2, I_LK2,
       I_DNG, I_MQG, I_MKVG, I_WUQ, I_WUKV, I_CONVW, I_ALF, I_ALB, I_DTF, I_DTB, I_GNG, I_WR, I_RB, I_WG, I_WU, I_WD,
       I_SG, I_SU, I_SD, I_FNG };

DEVI u16 f2bf(float f) { unsigned u = __float_as_uint(f); u += 0x7fffu + ((u >> 16) & 1u); return (u16)(u >> 16); }
DEVI float bf2f(u16 h) { return __uint_as_float(((unsigned)h) << 16); }
DEVI float bflo(unsigned v) { return __uint_as_float(v << 16); }
DEVI float bfhi(unsigned v) { return __uint_as_float(v & 0xffff0000u); }
DEVI unsigned pack2(float a, float b) { f32x2 v = {a, b}; return __builtin_bit_cast(unsigned, __builtin_convertvector(v, bf16x2_t)); }
DEVI f32x4 fzero4() { float z = 0.f; asm volatile("" : "+v"(z)); return f32x4{z, z, z, z}; }
DEVI float wave_sum(float v) {
#pragma unroll
  for (int o = 32; o >= 1; o >>= 1) v += __shfl_xor(v, o);
  return v;
}
DEVI float half_sum(float v) {
#pragma unroll
  for (int o = 16; o >= 1; o >>= 1) v += __shfl_xor(v, o);
  return v;
}
DEVI float siluf(float x) { return x / (1.f + __expf(-x)); }
DEVI float sigmf(float x) { return 1.f / (1.f + __expf(-x)); }
DEVI int tok_mv(int t) { return t < TL ? (t >> 13) : 2; }
DEVI int tok_b(int t) { return t < TL ? (t >> 13) : ((t - TL) >> 8); }
DEVI int tok_row(int t) { return t < TL ? (t & (SEQ - 1)) : (SEQ + ((t - TL) & (CTXL - 1))); }
DEVI const float* modp(const Params& p, int l, int mv, int j) { return (const float*)(p.ws + O_MOD) + ((size_t)(l * 3 + mv) * 6 + j) * 1024; }

#define MFMA16(a, b, c) __builtin_amdgcn_mfma_f32_16x16x32_bf16((a), (b), (c), 0, 0, 0)
#define MFMA32(a, b, c) __builtin_amdgcn_mfma_f32_32x32x16_bf16((a), (b), (c), 0, 0, 0)

DEVI void st_copy_in(const Params& p, int vb, int nvb) {
  float4* xa = (float4*)(p.ws + O_XA);
  const float4* x = (const float4*)pin(p, I_X);
  const float4* cx = (const float4*)pin(p, I_CTX);
  const size_t n4 = (size_t)T * DM / 4, nl4 = (size_t)TL * DM / 4;
  for (size_t i = (size_t)vb * 256 + p.tid; i < n4; i += (size_t)nvb * 256) xa[i] = i < nl4 ? x[i] : cx[i - nl4];
}
DEVI void rope_cs(int i, int half, int s, float& c, float& sn) {
  const int quarter = half >> 1;
  const int ii = i < quarter ? i : i - quarter;
  const float pos = i < quarter ? (float)(s >> 6) : (float)(s & 63);
  const float inv = powf(10000.f, -(float)ii / (float)quarter);
  const float ang = pos * inv;
  c = cosf(ang); sn = sinf(ang);
}
DEVI void st_rope_table(const Params& p, int vb, int nvb) {
  f32x2* R = (f32x2*)(p.ws + O_ROPE);
  for (int e = vb * 256 + p.tid; e < SEQ * 48; e += nvb * 256) {
    const int s = e / 48, i = e % 48;
    float c, sn;
    if (i < 32) rope_cs(i, 32, s, c, sn); else rope_cs(i - 32, 16, s, c, sn);
    R[e] = f32x2{c, sn};
  }
}
DEVI void st_mod(const Params& p, int vb, int nvb, char* smem) {
  float* sv = (float*)smem;
  float* red = sv + 3 * 1024;
  for (int i = p.tid; i < 3 * 1024; i += 256) {
    int v = i >> 10, k = i & 1023;
    float c = v < 2 ? pin(p, I_C)[v * 1024 + k] : pin(p, I_CCTX)[k];
    sv[i] = siluf(c);
  }
  __syncthreads();
  const int cgp = p.tid & 7, kg = p.tid >> 3;
  for (int item = vb; item < 2 * 192; item += nvb) {
    const int l = item / 192, c0 = (item % 192) * 32;
    const float* w = pin(p, I_WADA) + (size_t)l * 1024 * 6144 + c0 + cgp * 4;
    f32x4 a0 = fzero4(), a1 = a0, a2 = a0;
#pragma unroll 8
    for (int kk = 0; kk < 32; ++kk) {
      const int k = kg * 32 + kk;
      const f32x4 wv = *(const f32x4*)(w + (size_t)k * 6144);
      a0 += sv[k] * wv; a1 += sv[1024 + k] * wv; a2 += sv[2048 + k] * wv;
    }
    float* rp = red + (kg * 8 + cgp) * 12;
    *(f32x4*)rp = a0; *(f32x4*)(rp + 4) = a1; *(f32x4*)(rp + 8) = a2;
    __syncthreads();
    if (p.tid < 96) {
      const int v = p.tid >> 5, c = p.tid & 31;
      float s = 0.f;
#pragma unroll 8
      for (int g = 0; g < 32; ++g) s += red[(g * 8 + (c >> 2)) * 12 + v * 4 + (c & 3)];
      ((float*)(p.ws + O_MOD))[(size_t)(l * 3 + v) * 6144 + c0 + c] = s + pin(p, I_BADA)[l * 6144 + c0 + c];
    }
    __syncthreads();
  }
}

template <class RowFn>
DEVI void tr_tile(int tid, const float* __restrict__ src, int N, u16* __restrict__ dst, int ldd, RowFn drow, int k0, int n0, float* tile) {
  {
    const int kq = tid >> 4, n4 = (tid & 15) * 4;
    f32x4 v[4];
#pragma unroll
    for (int r = 0; r < 4; ++r) {
      const int k = r * 16 + kq;
      v[r] = n0 + n4 < N ? *(const f32x4*)(src + (size_t)(k0 + k) * N + n0 + n4) : fzero4();
    }
#pragma unroll
    for (int r = 0; r < 4; ++r) {
      const int k = r * 16 + kq;
      tile[k * 65 + n4] = v[r][0]; tile[k * 65 + n4 + 1] = v[r][1]; tile[k * 65 + n4 + 2] = v[r][2]; tile[k * 65 + n4 + 3] = v[r][3];
    }
  }
  __syncthreads();
  {
    const int n = tid >> 2, kc = (tid & 3) * 16;
    const int dr = drow(n0 + n);
    if (dr >= 0) {
      u32x4 o0, o1;
#pragma unroll
      for (int e = 0; e < 4; ++e) {
        o0[e] = pack2(tile[(kc + 2 * e) * 65 + n], tile[(kc + 2 * e + 1) * 65 + n]);
        o1[e] = pack2(tile[(kc + 8 + 2 * e) * 65 + n], tile[(kc + 8 + 2 * e + 1) * 65 + n]);
      }
      u16* d = dst + (size_t)dr * ldd + k0 + kc;
      *(u32x4*)d = o0; *(u32x4*)(d + 8) = o1;
    }
  }
  __syncthreads();
}
DEVI int win_row(int n) {
  if (n < 1280) return n;
  if (n < 1600) return 1408 + (n - 1280);
  if (n < 1632) return 1280 + (n - 1600);
  if (n < INW) return 1408 + 320 + (n - 1632);
  return -1;
}
constexpr int TR_IN = 16 * 42, TR_OUT = 256, TR_UQ = 18, TR_UKV = 16, TR_E = 4096, TR_S = 64;
constexpr int TR_P1 = TR_IN + TR_OUT + TR_UQ + TR_UKV;
constexpr int TR_P2 = 3 * TR_E + 3 * TR_S;
DEVI void prep_w1_tile(const Params& p, int l, int it, float* tile) {
  if (it < TR_IN) { tr_tile(p.tid, pin(p, I_WIN) + (size_t)l * 1024 * INW, INW, (u16*)(p.ws + O_WINT), LDW, [](int n) { return win_row(n); }, (it / 42) * 64, (it % 42) * 64, tile); return; }
  it -= TR_IN;
  if (it < TR_OUT) { tr_tile(p.tid, pin(p, I_WOUT) + (size_t)l * 1024 * 1024, 1024, (u16*)(p.ws + O_WOUTT), LDW, [](int n) { return n; }, (it / 16) * 64, (it % 16) * 64, tile); return; }
  it -= TR_OUT;
  if (it < TR_UQ) { tr_tile(p.tid, pin(p, I_WUQ) + (size_t)l * 192 * 384, 384, (u16*)(p.ws + O_WUQT), 192, [](int n) { return n; }, (it / 6) * 64, (it % 6) * 64, tile); return; }
  it -= TR_UQ;
  tr_tile(p.tid, pin(p, I_WUKV) + (size_t)l * 128 * 512, 512, (u16*)(p.ws + O_WUKVT), 128,
          [](int n) { const int h = n >> 7, j = n & 127; return j < 64 ? h * 64 + j : 256 + h * 64 + (j - 64); }, (it / 8) * 64, (it % 8) * 64, tile);
}
DEVI void prep_w2_tile(const Params& p, int l, int it, float* tile) {
  if (it < 2 * TR_E) {
    const int which = it / TR_E; it %= TR_E;
    const int e = it >> 6, tt = it & 63;
    const float* src = pin(p, which ? I_WU : I_WG) + ((size_t)l * NE + e) * 1024 * 256;
    tr_tile(p.tid, src, 256, (u16*)(p.ws + O_WGUT) + (size_t)e * 512 * LDW, LDW, [which](int n) { return 2 * n + which; }, (tt >> 2) * 64, (tt & 3) * 64, tile); return;
  }
  it -= 2 * TR_E;
  if (it < TR_E) {
    const int e = it >> 6, tt = it & 63;
    const float* src = pin(p, I_WD) + ((size_t)l * NE + e) * 256 * 1024;
    tr_tile(p.tid, src, 1024, (u16*)(p.ws + O_WDT) + (size_t)e * 1024 * 256, 256, [](int n) { return n; }, (tt >> 4) * 64, (tt & 15) * 64, tile); return;
  }
  it -= TR_E;
  if (it < 2 * TR_S) {
    const int which = it / TR_S; const int tt = it % TR_S;
    const float* src = pin(p, which ? I_SU : I_SG) + (size_t)l * 1024 * 256;
    tr_tile(p.tid, src, 256, (u16*)(p.ws + O_WGUT) + (size_t)64 * 512 * LDW, LDW, [which](int n) { return 2 * n + which; }, (tt >> 2) * 64, (tt & 3) * 64, tile); return;
  }
  it -= 2 * TR_S;
  { const int tt = it;
    const float* src = pin(p, I_SD) + (size_t)l * 256 * 1024;
    tr_tile(p.tid, src, 1024, (u16*)(p.ws + O_WDT) + (size_t)64 * 1024 * 256, 256, [](int n) { return n; }, (tt >> 4) * 64, (tt & 15) * 64, tile); }
}
struct TrDesc { const float* src; u16* dst; int N, ldd, rs, ro, k0, n0; };
DEVI TrDesc w2_desc(const Params& p, int l, int it) {
  TrDesc d;
  if (it < 2 * TR_E) {
    const int which = it / TR_E; it %= TR_E;
    const int e = it >> 6, tt = it & 63;
    d.src = pin(p, which ? I_WU : I_WG) + ((size_t)l * NE + e) * 1024 * 256; d.N = 256;
    d.dst = (u16*)(p.ws + O_WGUT) + (size_t)e * 512 * LDW; d.ldd = LDW; d.rs = 2; d.ro = which; d.k0 = (tt >> 2) * 64; d.n0 = (tt & 3) * 64;
    return d;
  }
  it -= 2 * TR_E;
  if (it < TR_E) {
    const int e = it >> 6, tt = it & 63;
    d.src = pin(p, I_WD) + ((size_t)l * NE + e) * 256 * 1024; d.N = 1024;
    d.dst = (u16*)(p.ws + O_WDT) + (size_t)e * 1024 * 256; d.ldd = 256; d.rs = 1; d.ro = 0; d.k0 = (tt >> 4) * 64; d.n0 = (tt & 15) * 64;
    return d;
  }
  it -= TR_E;
  if (it < 2 * TR_S) {
    const int which = it / TR_S; const int tt = it % TR_S;
    d.src = pin(p, which ? I_SU : I_SG) + (size_t)l * 1024 * 256; d.N = 256;
    d.dst = (u16*)(p.ws + O_WGUT) + (size_t)64 * 512 * LDW; d.ldd = LDW; d.rs = 2; d.ro = which; d.k0 = (tt >> 2) * 64; d.n0 = (tt & 3) * 64;
    return d;
  }
  it -= 2 * TR_S;
  d.src = pin(p, I_SD) + (size_t)l * 256 * 1024; d.N = 1024;
  d.dst = (u16*)(p.ws + O_WDT) + (size_t)64 * 1024 * 256; d.ldd = 256; d.rs = 1; d.ro = 0; d.k0 = (it >> 4) * 64; d.n0 = (it & 15) * 64;
  return d;
}
DEVI void tr_load(int tid, const TrDesc& d, f32x4 (&v)[4]) {
  const int kq = tid >> 4, n4 = (tid & 15) * 4;
#pragma unroll
  for (int r = 0; r < 4; ++r) v[r] = *(const f32x4*)(d.src + (size_t)(d.k0 + r * 16 + kq) * d.N + d.n0 + n4);
}
DEVI void tr_process(int tid, const TrDesc& d, const f32x4 (&v)[4], float* tile) {
  {
    const int kq = tid >> 4, n4 = (tid & 15) * 4;
#pragma unroll
    for (int r = 0; r < 4; ++r) {
      const int k = r * 16 + kq;
      tile[k * 65 + n4] = v[r][0]; tile[k * 65 + n4 + 1] = v[r][1]; tile[k * 65 + n4 + 2] = v[r][2]; tile[k * 65 + n4 + 3] = v[r][3];
    }
  }
  __syncthreads();
  {
    const int n = tid >> 2, kc = (tid & 3) * 16;
    u32x4 o0, o1;
#pragma unroll
    for (int e = 0; e < 4; ++e) {
      o0[e] = pack2(tile[(kc + 2 * e) * 65 + n], tile[(kc + 2 * e + 1) * 65 + n]);
      o1[e] = pack2(tile[(kc + 8 + 2 * e) * 65 + n], tile[(kc + 8 + 2 * e + 1) * 65 + n]);
    }
    u16* o = d.dst + (size_t)((d.n0 + n) * d.rs + d.ro) * d.ldd + d.k0 + kc;
    *(u32x4*)o = o0; *(u32x4*)(o + 8) = o1;
  }
  __syncthreads();
}
DEVI void prep_w2_run8(const Params& p, int l, int it0, float* tile) {
  f32x4 va[4], vb4[4];
  TrDesc da = w2_desc(p, l, it0), db = da;
  __syncthreads();
  tr_load(p.tid, da, va);
#pragma unroll 1
  for (int k = 0; k < 8; k += 2) {
    db = w2_desc(p, l, it0 + k + 1);
    tr_load(p.tid, db, vb4);
    tr_process(p.tid, da, va, tile);
    if (k + 2 < 8) { da = w2_desc(p, l, it0 + k + 2); tr_load(p.tid, da, va); }
    tr_process(p.tid, db, vb4, tile);
  }
}
DEVI void st_prep_w1(const Params& p, int l, int vb, int nvb, char* smem) {
  float* tile = (float*)smem;
  if (vb == 0 && p.tid < 64) ((int*)(p.ws + O_CNT))[p.tid] = 0;
  for (int e = vb * 256 + p.tid; e < 144 * 128; e += nvb * 256) {
    const int r = e >> 7, c8 = e & 127;
    const int row = r < 96 ? 1312 + r : 2768 + (r - 96);
    *(u32x4*)((u16*)(p.ws + O_WINT) + (size_t)row * LDW + c8 * 8) = __builtin_bit_cast(u32x4, fzero4());
  }
  for (int item = vb; item < TR_P1; item += nvb) prep_w1_tile(p, l, item, tile);
}

DEVI void st_norm1(const Params& p, int l, int vb, int nvb) {
  const int lane = p.tid & 63, wid = p.tid >> 6;
  const float* g = pin(p, I_N1G) + l * 1024;
  for (int t4 = (vb * 4 + wid) * 4; t4 < T; t4 += nvb * 16) {
    const int mv = tok_mv(t4);
    const float* sh = modp(p, l, mv, 0); const float* sc = modp(p, l, mv, 1);
    f32x4 v[4][4]; float ss[4];
#pragma unroll
    for (int u = 0; u < 4; ++u) {
      const int t = t4 + u;
      const f32x4* xr = (const f32x4*)(t < TL ? pin(p, I_X) + (size_t)t * 1024 : pin(p, I_CTX) + (size_t)(t - TL) * 1024);
#pragma unroll
      for (int i = 0; i < 4; ++i) v[u][i] = xr[i * 64 + lane];
    }
#pragma unroll
    for (int u = 0; u < 4; ++u) {
      float a = 0.f;
#pragma unroll
      for (int i = 0; i < 4; ++i) a += v[u][i][0] * v[u][i][0] + v[u][i][1] * v[u][i][1] + v[u][i][2] * v[u][i][2] + v[u][i][3] * v[u][i][3];
      ss[u] = a;
    }
#pragma unroll
    for (int o = 32; o >= 1; o >>= 1) {
#pragma unroll
      for (int u = 0; u < 4; ++u) ss[u] += __shfl_xor(ss[u], o);
    }
#pragma unroll
    for (int i = 0; i < 4; ++i) {
      const int c = i * 256 + lane * 4;
      const f32x4 gg = *(const f32x4*)(g + c), s4 = *(const f32x4*)(sc + c), h4 = *(const f32x4*)(sh + c);
      const f32x4 gs = gg * (1.f + s4);
#pragma unroll
      for (int u = 0; u < 4; ++u) {
        const float rstd = rsqrtf(ss[u] * (1.f / 1024.f) + 1e-6f);
        const f32x4 o = v[u][i] * rstd * gs + h4;
        u32x2 pk; pk[0] = pack2(o[0], o[1]); pk[1] = pack2(o[2], o[3]);
        *(u32x2*)((u16*)(p.ws + O_H) + (size_t)(t4 + u) * LDH + c) = pk;
      }
    }
  }
}

constexpr int GLD = 72;
typedef const __attribute__((address_space(1))) unsigned gcu32;
typedef __attribute__((address_space(3))) unsigned lu32;
DEVI int bperm_row(int BP, int n, int fr) {
  return BP == 0 ? n * 16 + fr : BP == 1 ? (n >> 1) * 32 + (fr >> 2) * 8 + (n & 1) * 4 + (fr & 3) : (fr >> 2) * 16 + n * 4 + (fr & 3);
}
DEVI int bperm_swz(int BP, int R) { return BP == 0 ? (R & 7) : BP == 1 ? ((R & 3) | ((R >> 1) & 4)) : ((R & 3) | ((R >> 2) & 4)); }
template <bool SWAP, int BP = 0, bool AP = false, class ARow>
DEVI void gemm_core(int tid, ARow arow, const u16* __restrict__ Bt, int ldb, int K, f32x4 (&acc)[4][4], char* smem) {
  constexpr int TILE = 128 * 64;
  u16* sbuf = (u16*)smem;
  const int lane = tid & 63, wid = tid >> 6, wr = wid >> 1, wc = wid & 1, fr = lane & 15, fq = lane >> 4;
  const u16* ap[4]; const u16* bp[4];
#pragma unroll
  for (int i = 0; i < 4; ++i) {
    const int q = tid + 256 * i, row = q >> 3, cs = (q & 7) ^ (row & 7), csb = (q & 7) ^ bperm_swz(BP, row);
    ap[i] = arow(row) + cs * 8; bp[i] = Bt + (size_t)row * ldb + csb * 8;
  }
  const int nk = K >> 6;
  auto stage = [&](int kt, int buf) {
    int off = kt * 64; asm volatile("" : "+s"(off));
    u16* dA = sbuf + buf * 2 * TILE + tid * 8; u16* dB = dA + TILE;
#pragma unroll
    for (int i = 0; i < 4; ++i) {
      __builtin_amdgcn_global_load_lds((gcu32*)(ap[i] + off), (lu32*)(dA + i * 2048), 16, 0, 0);
      __builtin_amdgcn_global_load_lds((gcu32*)(bp[i] + off), (lu32*)(dB + i * 2048), 16, 0, 0);
    }
  };
  auto compute = [&](int buf) {
    const u16* sA = sbuf + buf * 2 * TILE; const u16* sB = sA + TILE;
#pragma unroll
    for (int ks = 0; ks < 2; ++ks) {
      bf16x8 af[4], bfr[4];
#pragma unroll
      for (int m = 0; m < 4; ++m) {
        int R = wr * 64 + m * 16 + fr;
        if (AP) { const int pos = (m >> 1) * 32 + (fr >> 2) * 8 + (m & 1) * 4 + (fr & 3), j = (pos >> 2) & 3; R = wr * 64 + ((pos & ~15) | ((((j & 1) << 1) | (j >> 1)) << 2) | (pos & 3)); }
        af[m] = *(const bf16x8*)&sA[R * 64 + (((ks * 4 + fq) ^ (R & 7)) << 3)];
      }
#pragma unroll
      for (int n = 0; n < 4; ++n) { const int R = wc * 64 + bperm_row(BP, n, fr); bfr[n] = *(const bf16x8*)&sB[R * 64 + (((ks * 4 + fq) ^ bperm_swz(BP, R)) << 3)]; }
#pragma unroll
      for (int m = 0; m < 4; ++m)
#pragma unroll
        for (int n = 0; n < 4; ++n) acc[m][n] = SWAP ? MFMA16(af[m], bfr[n], acc[m][n]) : MFMA16(bfr[n], af[m], acc[m][n]);
    }
  };
#pragma unroll
  for (int m = 0; m < 4; ++m)
#pragma unroll
    for (int n = 0; n < 4; ++n) acc[m][n] = fzero4();
  __syncthreads();
  stage(0, 0);
  asm volatile("s_waitcnt vmcnt(0)" ::: "memory");
  __syncthreads();
  for (int kt = 0; kt < nk; ++kt) {
    if (kt + 1 < nk) stage(kt + 1, (kt + 1) & 1);
    compute(kt & 1);
    asm volatile("s_waitcnt vmcnt(0)" ::: "memory");
    __syncthreads();
  }
}
template <class ARow, class Epi>
DEVI void gemm128(int tid, ARow arow, const u16* __restrict__ Bt, int ldb, int K, Epi epi, char* smem) {
  f32x4 acc[4][4];
  gemm_core<false>(tid, arow, Bt, ldb, K, acc, smem);
  const int lane = tid & 63, wid = tid >> 6, wr = wid >> 1, wc = wid & 1, fr = lane & 15, fq = lane >> 4;
#pragma unroll
  for (int m = 0; m < 4; ++m)
#pragma unroll
    for (int n = 0; n < 4; ++n) epi(wr * 64 + m * 16 + fr, wc * 64 + n * 16 + fq * 4, acc[m][n]);
}

DEVI void rope4(const f32x4 x1, const f32x4 x2, const f32x2* rp, bool lat, float scale, u32x2& o1, u32x2& o2) {
  f32x4 s = fzero4(), c = s + 1.f;
  if (lat) {
    const f32x4 a = *(const f32x4*)rp, b = *(const f32x4*)(rp + 2);
    c = f32x4{a[0], a[2], b[0], b[2]}; s = f32x4{a[1], a[3], b[1], b[3]};
  }
  const f32x4 y1 = (x1 * c - x2 * s) * scale, y2 = (x2 * c + x1 * s) * scale;
  o1[0] = pack2(y1[0], y1[1]); o1[1] = pack2(y1[2], y1[3]);
  o2[0] = pack2(y2[0], y2[1]); o2[1] = pack2(y2[2], y2[3]);
}
DEVI void inproj_item(const Params& p, int item, char* smem) {
  const u16* H = (const u16*)(p.ws + O_H); const u16* W = (const u16*)(p.ws + O_WINT);
  const f32x2* ROPE = (const f32x2*)(p.ws + O_ROPE);
  const int tid = p.tid, lane = tid & 63, wid = tid >> 6, wr = wid >> 1, wc = wid & 1, fr = lane & 15, fq = lane >> 4;
  {
    const int m0 = (item / 22) * 128, nt = item % 22;
    const bool lat = m0 < TL;
    const int b = tok_b(m0), rowbase = tok_row(m0);
    f32x4 acc[4][4];
    auto arow = [&](int r) { return H + (size_t)(m0 + r) * LDH; };
    if (nt == 3 || nt == 8 || nt == 9) {
      gemm_core<true, 0, true>(tid, arow, W + (size_t)nt * 128 * LDW, LDW, 1024, acc, smem);
      u16* vt = nt == 3 ? (u16*)(p.ws + O_VTA) + (size_t)(b * 2 + wc) * 64 * NKEY
                        : (u16*)(p.ws + O_VTB) + (size_t)(b * 4 + (nt - 8) * 2 + wc) * 64 * NKEY;
#pragma unroll
      for (int mh = 0; mh < 2; ++mh)
#pragma unroll
        for (int n = 0; n < 4; ++n) {
          u32x4 pk;
          pk[0] = pack2(acc[2 * mh][n][0], acc[2 * mh][n][1]); pk[1] = pack2(acc[2 * mh][n][2], acc[2 * mh][n][3]);
          pk[2] = pack2(acc[2 * mh + 1][n][0], acc[2 * mh + 1][n][1]); pk[3] = pack2(acc[2 * mh + 1][n][2], acc[2 * mh + 1][n][3]);
          *(u32x4*)(vt + (size_t)(n * 16 + fr) * NKEY + rowbase + wr * 64 + mh * 32 + fq * 8) = pk;
        }
      return;
    }
    if (nt < 3 || nt >= 11) gemm_core<false, 1>(tid, arow, W + (size_t)nt * 128 * LDW, LDW, 1024, acc, smem);
    else gemm_core<false>(tid, arow, W + (size_t)nt * 128 * LDW, LDW, 1024, acc, smem);
    if (nt < 3) {
      u16* dst; float scale;
      if (nt < 2) { dst = (u16*)(p.ws + O_QA) + ((size_t)(b * 4 + nt * 2 + wc) * NKEY + rowbase) * 64; scale = 0.125f * LOG2E; }
      else { dst = (u16*)(p.ws + O_KA) + ((size_t)(b * 2 + wc) * NKEY + rowbase) * 64; scale = 1.f; }
#pragma unroll
      for (int m = 0; m < 4; ++m) {
        const int rl = wr * 64 + m * 16 + fr;
        u32x2 a1, a2, b1, b2;
        rope4(acc[m][0], acc[m][2], ROPE + (size_t)(rowbase + rl) * 48 + fq * 8, lat, scale, a1, a2);
        rope4(acc[m][1], acc[m][3], ROPE + (size_t)(rowbase + rl) * 48 + fq * 8 + 4, lat, scale, b1, b2);
        *(u32x4*)(dst + (size_t)rl * 64 + fq * 8) = u32x4{a1[0], a1[1], b1[0], b1[1]};
        *(u32x4*)(dst + (size_t)rl * 64 + 32 + fq * 8) = u32x4{a2[0], a2[1], b2[0], b2[1]};
      }
    } else if (nt < 8) {
      const bool isq = nt < 6;
      u16* base = isq ? (u16*)(p.ws + O_QB) : (u16*)(p.ws + O_KB);
      const float scale = isq ? 0.17677669529663687f * LOG2E : 1.f;
      const int hm0 = ((nt - 4) & 1) * 4 + wc * 2;
#pragma unroll
      for (int m = 0; m < 4; ++m) {
        const int rl = wr * 64 + m * 16 + fr;
#pragma unroll
        for (int g = 0; g < 2; ++g) {
          u16* dst = base + ((size_t)(b * 8 + hm0 + g) * NKEY + rowbase + rl) * 32;
          u32x2 o1, o2;
          rope4(acc[m][2 * g], acc[m][2 * g + 1], ROPE + (size_t)(rowbase + rl) * 48 + 32 + fq * 4, lat, scale, o1, o2);
          *(u32x2*)(dst + fq * 4) = o1; *(u32x2*)(dst + 16 + fq * 4) = o2;
        }
      }
    } else if (nt == 10) {
      if (wc == 0) {
#pragma unroll
        for (int m = 0; m < 4; ++m) {
          const int rl = wr * 64 + m * 16 + fr;
          u32x2 o1, o2;
          rope4(acc[m][0], acc[m][1], ROPE + (size_t)(rowbase + rl) * 48 + 32 + fq * 4, lat, 1.f, o1, o2);
#pragma unroll
          for (int h = 0; h < 4; ++h) {
            u16* dst = (u16*)(p.ws + O_KC) + ((size_t)(b * 4 + h) * NKEY + rowbase + rl) * 96 + 64;
            *(u32x2*)(dst + fq * 4) = o1; *(u32x2*)(dst + 16 + fq * 4) = o2;
          }
        }
      }
    } else {
      u16* PP = (u16*)(p.ws + O_PP);
#pragma unroll
      for (int m = 0; m < 4; ++m)
#pragma unroll
        for (int h = 0; h < 2; ++h) {
          u32x4 pk;
          pk[0] = pack2(acc[m][2 * h][0], acc[m][2 * h][1]); pk[1] = pack2(acc[m][2 * h][2], acc[m][2 * h][3]);
          pk[2] = pack2(acc[m][2 * h + 1][0], acc[m][2 * h + 1][1]); pk[3] = pack2(acc[m][2 * h + 1][2], acc[m][2 * h + 1][3]);
          *(u32x4*)(PP + (size_t)(m0 + wr * 64 + m * 16 + fr) * LDPP + (nt - 11) * 128 + wc * 64 + h * 32 + fq * 8) = pk;
        }
    }
  }
}

DEVI void st_tokprep(const Params& p, int l, int vb, int nvb) {
  const int lane = p.tid & 63, wid = p.tid >> 6;
  const u16* PP = (const u16*)(p.ws + O_PP);
  u16* GQ = (u16*)(p.ws + O_GQ); u16* GK = (u16*)(p.ws + O_GK); u16* GV = (u16*)(p.ws + O_GV);
  float* GG = (float*)(p.ws + O_GG); float* GB = (float*)(p.ws + O_GBETA);
  u16* CQN = (u16*)(p.ws + O_CQN); u16* CKVN = (u16*)(p.ws + O_CKVN);
  const float* cwp = pin(p, I_CONVW) + (size_t)l * 5 * 768;
  f32x2 cw[6][5];
#pragma unroll
  for (int i = 0; i < 6; ++i)
#pragma unroll
    for (int j = 0; j < 5; ++j) cw[i][j] = *(const f32x2*)(cwp + j * 768 + 2 * lane + 128 * i);
  const float* gq = pin(p, I_MQG) + l * 192; const float* gkv = pin(p, I_MKVG) + l * 128;
  const float gq0 = gq[lane], gq1 = gq[64 + lane], gq2 = gq[128 + lane], gk0 = gkv[lane], gk1 = gkv[64 + lane];
  for (int t = vb * 4 + wid; t < T; t += nvb * 4) {
    int base, pos, len;
    if (t < TL) { base = t & ~(SEQ - 1); pos = t & (SEQ - 1); len = SEQ; } else { int j = t - TL; base = TL + (j & ~(CTXL - 1)); pos = j & (CTXL - 1); len = CTXL; }
    unsigned xin[5][6];
#pragma unroll
    for (int j = 0; j < 5; ++j) {
      const int pp = pos + j - 2;
      const bool ok = pp >= 0 && pp < len;
      const u16* row = PP + (size_t)(base + (ok ? pp : pos)) * LDPP + PP_DQKV + 2 * lane;
#pragma unroll
      for (int i = 0; i < 6; ++i) { unsigned v = *(const unsigned*)(row + 128 * i); xin[j][i] = ok ? v : 0u; }
    }
    const u16* pr = PP + (size_t)t * LDPP;
    const float q0 = bf2f(pr[PP_CQ + lane]), q1 = bf2f(pr[PP_CQ + 64 + lane]), q2 = bf2f(pr[PP_CQ + 128 + lane]);
    const float k0 = bf2f(pr[PP_CKV + lane]), k1 = bf2f(pr[PP_CKV + 64 + lane]);
    const float gate_in = lane < 16 ? bf2f(pr[PP_GATE + lane]) : 0.f;
#pragma unroll
    for (int i = 0; i < 6; ++i) {
      float a0 = 0.f, a1 = 0.f;
#pragma unroll
      for (int j = 0; j < 5; ++j) { a0 += cw[i][j][0] * bflo(xin[j][i]); a1 += cw[i][j][1] * bfhi(xin[j][i]); }
      float y0 = siluf(a0), y1 = siluf(a1);
      const int c = 2 * lane + 128 * i;
      if (i < 4) {
        const float ss = half_sum(y0 * y0 + y1 * y1);
        const float r = rsqrtf(ss + 1e-6f) * (i < 2 ? 0.125f : 1.f);
        u16* dst = i < 2 ? GQ + (size_t)t * 256 + c : GK + (size_t)t * 256 + (c - 256);
        *(unsigned*)dst = pack2(y0 * r, y1 * r);
      } else *(unsigned*)(GV + (size_t)t * 256 + (c - 512)) = pack2(y0, y1);
    }
    if (lane < 16) {
      const int which = lane >> 2, hd = lane & 3;
      if (which < 2) {
        const float al = which ? pin(p, I_ALB)[l * 4 + hd] : pin(p, I_ALF)[l * 4 + hd];
        const float dt = which ? pin(p, I_DTB)[l * 4 + hd] : pin(p, I_DTF)[l * 4 + hd];
        const float xx = gate_in + dt;
        const float sp = fmaxf(xx, 0.f) + log1pf(expf(-fabsf(xx)));
        GG[((size_t)which * T + t) * 4 + hd] = -expf(al) * sp;
      } else GB[((size_t)(which - 2) * T + t) * 4 + hd] = sigmf(gate_in);
    }
    {
      float ss = q0 * q0 + q1 * q1 + q2 * q2, s2 = k0 * k0 + k1 * k1;
#pragma unroll
      for (int o = 32; o >= 1; o >>= 1) { ss += __shfl_xor(ss, o); s2 += __shfl_xor(s2, o); }
      const float rs = rsqrtf(ss * (1.f / 192.f) + 1e-6f), r2 = rsqrtf(s2 * (1.f / 128.f) + 1e-6f);
      u16* d = CQN + (size_t)t * 192;
      d[lane] = f2bf(q0 * rs * gq0); d[64 + lane] = f2bf(q1 * rs * gq1); d[128 + lane] = f2bf(q2 * rs * gq2);
      u16* d2 = CKVN + (size_t)t * 128;
      d2[lane] = f2bf(k0 * r2 * gk0); d2[64 + lane] = f2bf(k1 * r2 * gk1);
    }
  }
}

DEVI void mla_up_tile(const Params& p, int mt, int nn, char* smem) {
  const int tid = p.tid, lane = tid & 63, wid = tid >> 6, wr = wid >> 1, wc = wid & 1, fr = lane & 15, fq = lane >> 4;
  const int m0 = mt * 128;
  const bool lat = m0 < TL;
  const int b = tok_b(m0), rowbase = tok_row(m0);
  f32x4 acc[4][4];
  if (nn < 3) {
    const u16* CQN = (const u16*)(p.ws + O_CQN);
    gemm_core<false>(tid, [&](int r) { return CQN + (size_t)(m0 + r) * 192; }, (const u16*)(p.ws + O_WUQT) + (size_t)nn * 128 * 192, 192, 192, acc, smem);
    const f32x2* ROPE = (const f32x2*)(p.ws + O_ROPE);
    const float scale = 0.10206207261596577f * LOG2E;
    u16* QC = (u16*)(p.ws + O_QC);
#pragma unroll
    for (int m = 0; m < 4; ++m) {
      const int rl = wr * 64 + m * 16 + fr;
#pragma unroll
      for (int n = 0; n < 4; ++n) {
        const int cb = nn * 128 + wc * 64 + n * 16;
        const int h = cb / 96, db = cb - h * 96;
        u16* dst = QC + ((size_t)(b * 4 + h) * NKEY + rowbase + rl) * 96;
        if (db < 64) {
          u32x2 pk; pk[0] = pack2(acc[m][n][0] * scale, acc[m][n][1] * scale); pk[1] = pack2(acc[m][n][2] * scale, acc[m][n][3] * scale);
          *(u32x2*)(dst + db + fq * 4) = pk;
        } else if (db == 64 && n < 3) {
          u32x2 o1, o2;
          rope4(acc[m][n], acc[m][n + 1], ROPE + (size_t)(rowbase + rl) * 48 + 32 + fq * 4, lat, scale, o1, o2);
          *(u32x2*)(dst + 64 + fq * 4) = o1; *(u32x2*)(dst + 80 + fq * 4) = o2;
        }
      }
    }
  } else {
    const u16* CKVN = (const u16*)(p.ws + O_CKVN);
    auto arow = [&](int r) { return CKVN + (size_t)(m0 + r) * 128; };
    const u16* Wt = (const u16*)(p.ws + O_WUKVT) + (size_t)(nn - 3) * 128 * 128;
    if (nn < 5) {
      gemm_core<false>(tid, arow, Wt, 128, 128, acc, smem);
      u16* KC = (u16*)(p.ws + O_KC) + ((size_t)(b * 4 + (nn - 3) * 2 + wc) * NKEY + rowbase) * 96;
#pragma unroll
      for (int m = 0; m < 4; ++m)
#pragma unroll
        for (int n = 0; n < 4; ++n) {
          u32x2 pk; pk[0] = pack2(acc[m][n][0], acc[m][n][1]); pk[1] = pack2(acc[m][n][2], acc[m][n][3]);
          *(u32x2*)(KC + (size_t)(wr * 64 + m * 16 + fr) * 96 + n * 16 + fq * 4) = pk;
        }
    } else {
      gemm_core<true>(tid, arow, Wt, 128, 128, acc, smem);
      u16* vt = (u16*)(p.ws + O_VTC) + (size_t)(b * 4 + (nn - 5) * 2 + wc) * 64 * NKEY;
#pragma unroll
      for (int m = 0; m < 4; ++m)
#pragma unroll
        for (int n = 0; n < 4; ++n) {
          u32x2 pk; pk[0] = pack2(acc[m][n][0], acc[m][n][1]); pk[1] = pack2(acc[m][n][2], acc[m][n][3]);
          *(u32x2*)(vt + (size_t)(n * 16 + fr) * NKEY + rowbase + wr * 64 + m * 16 + (((fq & 1) << 1) | (fq >> 1)) * 4) = pk;
        }
    }
  }
}
DEVI int permcol(int x) { return (x & 32) + 8 * ((x >> 2) & 3) + 4 * ((x >> 4) & 1) + (x & 3); }
DEVI int cidx(int d, int e) { return ((((e >> 4) * 4 + (d >> 4)) * 64) + (e & 15) + 16 * ((d >> 2) & 3)) * 4 + (d & 3); }
DEVI int gdn_chunk_t0(int ci) { return ci < 256 ? (ci >> 7) * SEQ + (ci & 127) * 64 : TL + ((ci - 256) >> 2) * CTXL + ((ci - 256) & 3) * 64; }

DEVI void gdn_chunk_item(const Params& p, int item, char* smem) {
  u16* sK = (u16*)smem;
  float* sA = (float*)(smem + 9216);
  u16* sXt = (u16*)smem;
  u16* sAt = (u16*)(smem + 26624);
  u16* sKt = (u16*)(smem + 35840);
  float* sX = (float*)(smem + 45056);
  float* sgc = (float*)(smem + 77824); float* sbeta = sgc + 64; float* seg = sbeta + 64; float* skd = seg + 64;
  const u16* GQ = (const u16*)(p.ws + O_GQ); const u16* GK = (const u16*)(p.ws + O_GK); const u16* GV = (const u16*)(p.ws + O_GV);
  const float* GG = (const float*)(p.ws + O_GG); const float* GB = (const float*)(p.ws + O_GBETA);
  u16* GM = (u16*)(p.ws + O_GM); u16* GQP = (u16*)(p.ws + O_GQP); u16* GN = (u16*)(p.ws + O_GN); u16* GLO = (u16*)(p.ws + O_GLO);
  const int tid = p.tid, lane = tid & 63, w = tid >> 6, i15 = lane & 15, q = lane >> 4;
  {
    const int ci = item >> 3, hd = (item >> 1) & 3, dir = item & 1;
    const int t0 = gdn_chunk_t0(ci);
    auto tok = [&](int i) { return dir ? t0 + 63 - i : t0 + i; };
    __syncthreads();
    if (tid < 64) {
      float g = GG[((size_t)dir * T + tok(tid)) * 4 + hd];
#pragma unroll
      for (int o = 1; o < 64; o <<= 1) { float u = __shfl_up(g, o); if (lane >= o) g += u; }
      const float gl = __shfl(g, 63);
      sgc[tid] = g; sbeta[tid] = GB[((size_t)dir * T + tok(tid)) * 4 + hd]; seg[tid] = expf(g); skd[tid] = expf(gl - g);
    }
    __syncthreads();
    const float eglast = seg[63];
#pragma unroll
    for (int i = 0; i < 2; ++i) {
      const int ch = tid + 256 * i, j = ch >> 3, cc = ch & 7;
      const u32x4 kv = *(const u32x4*)(GK + (size_t)tok(j) * 256 + hd * 64 + cc * 8);
      *(u32x4*)&sK[j * 72 + cc * 8] = kv;
      const float kd = skd[j];
#pragma unroll
      for (int e = 0; e < 4; ++e) {
        sKt[(cc * 8 + 2 * e) * 72 + j] = f2bf(bf2f((u16)(kv[e] & 0xffff)) * kd);
        sKt[(cc * 8 + 2 * e + 1) * 72 + j] = f2bf(bf2f((u16)(kv[e] >> 16)) * kd);
      }
    }
#pragma unroll
    for (int i = 0; i < 2; ++i) {
      const int ch = tid + 256 * i, j = ch >> 3, cc = ch & 7;
      const u32x4 vv = *(const u32x4*)(GV + (size_t)tok(j) * 256 + hd * 64 + cc * 8);
      const float bj = sbeta[j];
      float* d = sX + j * 128 + cc * 8;
#pragma unroll
      for (int e = 0; e < 4; ++e) { d[2 * e] = bflo(vv[e]) * bj; d[2 * e + 1] = bfhi(vv[e]) * bj; }
    }
    __syncthreads();
    for (int e = tid; e < 64 * 64; e += 256) {
      const int j = e >> 6, c = e & 63;
      sX[j * 128 + 64 + c] = bf2f(sK[j * 72 + c]) * sbeta[j] * seg[j];
    }
    {
      f32x4 kk[4], qk[4];
#pragma unroll
      for (int nt = 0; nt < 4; ++nt) { kk[nt] = fzero4(); qk[nt] = fzero4(); }
#pragma unroll
      for (int ks = 0; ks < 2; ++ks) {
        const bf16x8 ak = *(const bf16x8*)&sK[(16 * w + i15) * 72 + ks * 32 + q * 8];
        const bf16x8 aq = *(const bf16x8*)(GQ + (size_t)tok(16 * w + i15) * 256 + hd * 64 + ks * 32 + q * 8);
#pragma unroll
        for (int nt = 0; nt < 4; ++nt) {
          const bf16x8 bk = *(const bf16x8*)&sK[(16 * nt + i15) * 72 + ks * 32 + q * 8];
          kk[nt] = MFMA16(ak, bk, kk[nt]); qk[nt] = MFMA16(aq, bk, qk[nt]);
        }
      }
#pragma unroll
      for (int nt = 0; nt < 4; ++nt)
#pragma unroll
        for (int r = 0; r < 4; ++r) {
          const int i = 16 * w + 4 * q + r, j = 16 * nt + i15;
          const float dec = i >= j ? expf(sgc[i] - sgc[j]) : 0.f;
          sA[i * 68 + j] = i > j ? sbeta[i] * kk[nt][r] * dec : 0.f;
          sAt[i * 72 + j] = f2bf(i >= j ? qk[nt][r] * dec : 0.f);
        }
    }
    __syncthreads();
    if (tid < 128) {
      const int c = tid;
      for (int ib = 0; ib < 16; ++ib) {
        float a0 = sX[(4 * ib) * 128 + c], a1 = sX[(4 * ib + 1) * 128 + c], a2 = sX[(4 * ib + 2) * 128 + c], a3 = sX[(4 * ib + 3) * 128 + c];
#pragma unroll 4
        for (int g = 0; g < ib; ++g) {
          const float x0 = sX[(4 * g) * 128 + c], x1 = sX[(4 * g + 1) * 128 + c], x2 = sX[(4 * g + 2) * 128 + c], x3 = sX[(4 * g + 3) * 128 + c];
          const f32x4 r0 = *(const f32x4*)&sA[(4 * ib) * 68 + 4 * g], r1 = *(const f32x4*)&sA[(4 * ib + 1) * 68 + 4 * g];
          const f32x4 r2 = *(const f32x4*)&sA[(4 * ib + 2) * 68 + 4 * g], r3 = *(const f32x4*)&sA[(4 * ib + 3) * 68 + 4 * g];
          a0 -= r0[0] * x0 + r0[1] * x1 + r0[2] * x2 + r0[3] * x3;
          a1 -= r1[0] * x0 + r1[1] * x1 + r1[2] * x2 + r1[3] * x3;
          a2 -= r2[0] * x0 + r2[1] * x1 + r2[2] * x2 + r2[3] * x3;
          a3 -= r3[0] * x0 + r3[1] * x1 + r3[2] * x2 + r3[3] * x3;
        }
        const f32x4 d1 = *(const f32x4*)&sA[(4 * ib + 1) * 68 + 4 * ib], d2 = *(const f32x4*)&sA[(4 * ib + 2) * 68 + 4 * ib], d3 = *(const f32x4*)&sA[(4 * ib + 3) * 68 + 4 * ib];
        a1 -= d1[0] * a0;
        a2 -= d2[0] * a0 + d2[1] * a1;
        a3 -= d3[0] * a0 + d3[1] * a1 + d3[2] * a2;
        sX[(4 * ib) * 128 + c] = a0; sX[(4 * ib + 1) * 128 + c] = a1; sX[(4 * ib + 2) * 128 + c] = a2; sX[(4 * ib + 3) * 128 + c] = a3;
      }
    }
    __syncthreads();
    {
      const int c = tid & 127, jh = (tid >> 7) * 32;
#pragma unroll
      for (int g = 0; g < 4; ++g) {
        u32x4 pk;
#pragma unroll
        for (int e = 0; e < 4; ++e) pk[e] = pack2(sX[(jh + 8 * g + 2 * e) * 128 + c], sX[(jh + 8 * g + 2 * e + 1) * 128 + c]);
        *(u32x4*)&sXt[c * 72 + jh + 8 * g] = pk;
      }
    }
    __syncthreads();
    {
      f32x4 r1[8], r2[8];
#pragma unroll
      for (int ct = 0; ct < 8; ++ct) { r1[ct] = fzero4(); r2[ct] = fzero4(); }
#pragma unroll
      for (int ks = 0; ks < 2; ++ks) {
        const bf16x8 aa = *(const bf16x8*)&sAt[(16 * w + i15) * 72 + ks * 32 + q * 8];
        const bf16x8 ak = *(const bf16x8*)&sKt[(16 * w + i15) * 72 + ks * 32 + q * 8];
#pragma unroll
        for (int ct = 0; ct < 8; ++ct) {
          const bf16x8 bx = *(const bf16x8*)&sXt[(16 * ct + i15) * 72 + ks * 32 + q * 8];
          r1[ct] = MFMA16(aa, bx, r1[ct]); r2[ct] = MFMA16(ak, bx, r2[ct]);
        }
      }
      const size_t ib = (size_t)item * 4096;
#pragma unroll
      for (int ct = 0; ct < 4; ++ct) {
        u32x2 a, b;
        a[0] = pack2(r1[ct][0], r1[ct][1]); a[1] = pack2(r1[ct][2], r1[ct][3]);
        b[0] = pack2(r2[ct][0], r2[ct][1]); b[1] = pack2(r2[ct][2], r2[ct][3]);
        *(u32x2*)(GLO + ib + ((ct * 4 + w) * 64 + lane) * 4) = a;
        *(u32x2*)(GN + ib + ((ct * 4 + w) * 64 + lane) * 4) = b;
      }
#pragma unroll
      for (int ct = 4; ct < 8; ++ct)
#pragma unroll
        for (int r = 0; r < 4; ++r) {
          const int row = 16 * w + 4 * q + r, col = 16 * (ct - 4) + i15;
          const float qv = bf2f(GQ[(size_t)tok(row) * 256 + hd * 64 + col]);
          GQP[ib + row * 64 + permcol(col)] = f2bf(qv * seg[row] - r1[ct][r]);
          GM[ib + row * 64 + permcol(col)] = f2bf((row == col ? eglast : 0.f) - r2[ct][r]);
        }
    }
    __syncthreads();
  }
}

DEVI void gdn_scan_chain(const Params& p, int chain, char* smem) {
  const int tid = p.tid, lane = tid & 63, w = tid >> 6, i15 = lane & 15, q = lane >> 4;
  u16* sM = (u16*)smem;
  u16* sQ = sM + 2 * 64 * 72;
  const u16* GM = (const u16*)(p.ws + O_GM); const u16* GQP = (const u16*)(p.ws + O_GQP);
  const u16* GN = (const u16*)(p.ws + O_GN); const u16* GLO = (const u16*)(p.ws + O_GLO);
  float* GO = (float*)(p.ws + O_GO);
  {
    const int b = chain >> 3, hd = (chain >> 1) & 3, dir = chain & 1;
    f32x4 S[4];
#pragma unroll
    for (int r = 0; r < 4; ++r) S[r] = fzero4();
    auto item_of = [&](int n) {
      int ci = n < 4 ? 256 + b * 4 + (dir ? 3 - n : n) : b * 128 + (dir ? 127 - (n - 4) : (n - 4));
      return ci * 8 + hd * 2 + dir;
    };
    u32x4 pm[2], pq[2]; u32x2 pn[4], pl[4];
    auto prefetch = [&](int n) {
      const size_t base = (size_t)item_of(n) * 4096;
#pragma unroll
      for (int i = 0; i < 2; ++i) {
        const int ch = tid + 256 * i;
        pm[i] = *(const u32x4*)(GM + base + ch * 8);
        pq[i] = *(const u32x4*)(GQP + base + ch * 8);
      }
#pragma unroll
      for (int rb = 0; rb < 4; ++rb) {
        pn[rb] = *(const u32x2*)(GN + base + ((w * 4 + rb) * 64 + lane) * 4);
        pl[rb] = *(const u32x2*)(GLO + base + ((w * 4 + rb) * 64 + lane) * 4);
      }
    };
    prefetch(0);
    __syncthreads();
    for (int n = 0; n < 132; ++n) {
      const int buf = n & 1;
      u16* bM = sM + buf * 64 * 72; u16* bQ = sQ + buf * 64 * 72;
#pragma unroll
      for (int i = 0; i < 2; ++i) {
        const int ch = tid + 256 * i, row = ch >> 3, cc = ch & 7;
        *(u32x4*)&bM[row * 72 + cc * 8] = pm[i];
        *(u32x4*)&bQ[row * 72 + cc * 8] = pq[i];
      }
      f32x4 accs[4], acco[4];
#pragma unroll
      for (int rb = 0; rb < 4; ++rb) {
        accs[rb] = f32x4{bf2f((u16)(pn[rb][0] & 0xffff)), bf2f((u16)(pn[rb][0] >> 16)), bf2f((u16)(pn[rb][1] & 0xffff)), bf2f((u16)(pn[rb][1] >> 16))};
        acco[rb] = f32x4{bf2f((u16)(pl[rb][0] & 0xffff)), bf2f((u16)(pl[rb][0] >> 16)), bf2f((u16)(pl[rb][1] & 0xffff)), bf2f((u16)(pl[rb][1] >> 16))};
      }
      const int ci = n < 4 ? 256 + b * 4 + (dir ? 3 - n : n) : b * 128 + (dir ? 127 - (n - 4) : (n - 4));
      const int t0 = gdn_chunk_t0(ci);
      __syncthreads();
      if (n + 1 < 132) prefetch(n + 1);
      bf16x8 sb[2];
#pragma unroll
      for (int kb = 0; kb < 2; ++kb)
#pragma unroll
        for (int jj = 0; jj < 8; ++jj) sb[kb][jj] = (short)f2bf(S[2 * kb + (jj >> 2)][jj & 3]);
#pragma unroll
      for (int kb = 0; kb < 2; ++kb)
#pragma unroll
        for (int rb = 0; rb < 4; ++rb) {
          const bf16x8 am = *(const bf16x8*)&bM[(rb * 16 + i15) * 72 + kb * 32 + q * 8];
          const bf16x8 aq = *(const bf16x8*)&bQ[(rb * 16 + i15) * 72 + kb * 32 + q * 8];
          accs[rb] = MFMA16(am, sb[kb], accs[rb]);
          acco[rb] = MFMA16(aq, sb[kb], acco[rb]);
        }
#pragma unroll
      for (int rb = 0; rb < 4; ++rb) {
        S[rb] = accs[rb];
#pragma unroll
        for (int r = 0; r < 4; ++r) {
          const int i = rb * 16 + q * 4 + r;
          const int t = dir ? t0 + 63 - i : t0 + i;
          GO[(size_t)dir * T * 256 + (size_t)t * 256 + hd * 64 + w * 16 + i15] = acco[rb][r];
        }
      }
    }
    __syncthreads();
  }
}


template <int DQK>
DEVI void attn_run(int tid, const u16* __restrict__ Qp, int qrow0, const u16* __restrict__ Kp, const u16* __restrict__ Vtp,
                   int a0, int a1, int b0, int b1, int qpos0, float sink2, f32x16 (&O)[2], char* smem) {
  constexpr int KLD = DQK + 8, NS = DQK / 16, KCH = DQK / 8, NKL = (64 * KCH) / 256;
  constexpr int BUF = 64 * KLD + 64 * 72;
  u16* sbase = (u16*)smem;
  const int lane = tid & 63, wid = tid >> 6, r31 = lane & 31, hh = lane >> 5;
  const int qrow = qrow0 + wid * 32 + r31;
  bf16x8 qf[NS];
#pragma unroll
  for (int s = 0; s < NS; ++s) qf[s] = *(const bf16x8*)(Qp + (size_t)qrow * DQK + s * 16 + hh * 8);
#pragma unroll
  for (int i = 0; i < 16; ++i) { O[0][i] = 0.f; O[1][i] = 0.f; }
  float m = -30000.f, lsum = 0.f;
  const int na = (a1 - a0) >> 6, nt = na + ((b1 - b0) >> 6);
  const int qpos = qpos0 + wid * 32 + r31;
  u32x4 rk[NKL], rv[2];
  auto gload = [&](int ti) {
    const int key0 = ti >= na ? b0 + (ti - na) * 64 : a0 + ti * 64;
#pragma unroll
    for (int i = 0; i < NKL; ++i) { const int q = tid + 256 * i, r = q / KCH, cc = q % KCH; rk[i] = *(const u32x4*)(Kp + (size_t)(key0 + r) * DQK + cc * 8); }
#pragma unroll
    for (int i = 0; i < 2; ++i) { const int q = tid + 256 * i, r = q >> 3, cc = q & 7; rv[i] = *(const u32x4*)(Vtp + (size_t)r * NKEY + key0 + cc * 8); }
  };
  auto lstore = [&](int buf) {
    u16* sK = sbase + buf * BUF; u16* sV = sK + 64 * KLD;
#pragma unroll
    for (int i = 0; i < NKL; ++i) { const int q = tid + 256 * i, r = q / KCH, cc = q % KCH; *(u32x4*)&sK[r * KLD + cc * 8] = rk[i]; }
#pragma unroll
    for (int i = 0; i < 2; ++i) { const int q = tid + 256 * i, r = q >> 3, cc = q & 7; *(u32x4*)&sV[r * 72 + cc * 8] = rv[i]; }
  };
  m = 0.f;
  f32x16 negm;
#pragma unroll
  for (int i = 0; i < 16; ++i) negm[i] = 0.f;
  gload(0);
  __syncthreads();
  lstore(0);
  __syncthreads();
  for (int ti = 0; ti < nt; ++ti) {
    if (ti + 1 < nt) gload(ti + 1);
    const u16* sK = sbase + (ti & 1) * BUF; const u16* sV = sK + 64 * KLD;
    const bool inB = ti >= na;
    const int key0 = inB ? b0 + (ti - na) * 64 : a0 + ti * 64;
    f32x16 st[2];
#pragma unroll
    for (int k2 = 0; k2 < 2; ++k2) {
      {
        const bf16x8 kf = *(const bf16x8*)&sK[(k2 * 32 + r31) * KLD + hh * 8];
        asm volatile("v_mfma_f32_32x32x16_bf16 %0, %1, %2, %3" : "=&v"(st[k2]) : "v"(kf), "v"(qf[0]), "v"(negm));
      }
#pragma unroll
      for (int s = 1; s < NS; ++s) {
        const bf16x8 kf = *(const bf16x8*)&sK[(k2 * 32 + r31) * KLD + s * 16 + hh * 8];
        st[k2] = MFMA32(kf, qf[s], st[k2]);
      }
    }
    if (inB) {
#pragma unroll
      for (int k2 = 0; k2 < 2; ++k2)
#pragma unroll
        for (int g = 0; g < 16; ++g) {
          const int d = key0 + k2 * 32 + (g & 3) + 8 * (g >> 2) + 4 * hh - qpos;
          if (d > 128 || d < -128) st[k2][g] = -1e30f;
        }
    }
    bf16x8 vfr[2][2][2];
#pragma unroll
    for (int k2 = 0; k2 < 2; ++k2)
#pragma unroll
      for (int s2 = 0; s2 < 2; ++s2)
#pragma unroll
        for (int dvt = 0; dvt < 2; ++dvt) vfr[k2][s2][dvt] = *(const bf16x8*)&sV[(dvt * 32 + r31) * 72 + k2 * 32 + s2 * 16 + 8 * hh];
    float mx = st[0][0];
#pragma unroll
    for (int g = 1; g < 16; ++g) mx = fmaxf(mx, st[0][g]);
#pragma unroll
    for (int g = 0; g < 16; ++g) mx = fmaxf(mx, st[1][g]);
    { auto rr = __builtin_amdgcn_permlane32_swap(__float_as_uint(mx), __float_as_uint(mx), false, false);
      mx = fmaxf(__uint_as_float(rr[0]), __uint_as_float(rr[1])); }
    if (ti == 0 || __any(mx > 8.f)) {
      const float delta = ti == 0 ? fmaxf(mx, -1e4f) : fmaxf(mx, 0.f);
      if (ti != 0) {
        const float alpha = __builtin_amdgcn_exp2f(-delta);
        lsum *= alpha;
#pragma unroll
        for (int i = 0; i < 16; ++i) { O[0][i] *= alpha; O[1][i] *= alpha; }
      }
      m += delta;
#pragma unroll
      for (int i = 0; i < 16; ++i) { negm[i] = -m; st[0][i] -= delta; st[1][i] -= delta; }
    }
    f32x2 ps2 = {0.f, 0.f};
#pragma unroll
    for (int k2 = 0; k2 < 2; ++k2)
#pragma unroll
      for (int g = 0; g < 16; g += 2) {
        const float p0 = __builtin_amdgcn_exp2f(st[k2][g]), p1 = __builtin_amdgcn_exp2f(st[k2][g + 1]);
        st[k2][g] = p0; st[k2][g + 1] = p1;
        ps2 += f32x2{p0, p1};
      }
    lsum += ps2[0] + ps2[1];
#pragma unroll
    for (int k2 = 0; k2 < 2; ++k2)
#pragma unroll
      for (int s2 = 0; s2 < 2; ++s2) {
        u32x4 pp;
#pragma unroll
        for (int j = 0; j < 4; ++j) pp[j] = pack2(st[k2][8 * s2 + 2 * j], st[k2][8 * s2 + 2 * j + 1]);
        const bf16x8 pf = __builtin_bit_cast(bf16x8, pp);
#pragma unroll
        for (int dvt = 0; dvt < 2; ++dvt) {
          O[dvt] = MFMA32(vfr[k2][s2][dvt], pf, O[dvt]);
        }
      }
    if (ti + 1 < nt) lstore((ti + 1) & 1);
    __syncthreads();
  }
  if (sink2 > -1e29f) {
    const float mn = fmaxf(m, sink2);
    const float alpha = __builtin_amdgcn_exp2f(m - mn);
    lsum = lsum * alpha + (hh == 0 ? __builtin_amdgcn_exp2f(sink2 - mn) : 0.f);
#pragma unroll
    for (int i = 0; i < 16; ++i) { O[0][i] *= alpha; O[1][i] *= alpha; }
  }
  const float ltot = lsum + __shfl_xor(lsum, 32);
  const float inv = 1.f / ltot;
#pragma unroll
  for (int i = 0; i < 16; ++i) { O[0][i] *= inv; O[1][i] *= inv; }
}
DEVI void attn_run_b2(int tid, const u16* __restrict__ Qp0, const u16* __restrict__ Qp1, int qrow0, const u16* __restrict__ Kp0, const u16* __restrict__ Kp1,
                      const u16* __restrict__ Vtp, int a0, int a1, f32x16 (&O)[2][2], char* smem) {
  constexpr int KLD = 40, BUF = 2 * 64 * KLD + 64 * 72;
  u16* sbase = (u16*)smem;
  const int lane = tid & 63, wid = tid >> 6, r31 = lane & 31, hh = lane >> 5;
  const int qrow = qrow0 + wid * 32 + r31;
  bf16x8 qf[2][2];
#pragma unroll
  for (int s = 0; s < 2; ++s) { qf[0][s] = *(const bf16x8*)(Qp0 + (size_t)qrow * 32 + s * 16 + hh * 8); qf[1][s] = *(const bf16x8*)(Qp1 + (size_t)qrow * 32 + s * 16 + hh * 8); }
  float m[2] = {0.f, 0.f}, lsum[2] = {0.f, 0.f};
  u32x4 kaug = {hh == 0 ? 0x3F80u : 0u, 0u, 0u, 0u}, qaug[2] = {{0u, 0u, 0u, 0u}, {0u, 0u, 0u, 0u}};
#pragma unroll
  for (int mp = 0; mp < 2; ++mp)
#pragma unroll
    for (int i = 0; i < 16; ++i) { O[mp][0][i] = 0.f; O[mp][1][i] = 0.f; }
  const int nt = (a1 - a0) >> 6;
  u32x4 rk[2], rv[2];
  auto gload = [&](int ti) {
    const int key0 = a0 + ti * 64;
    const int r = tid >> 2, cc = tid & 3;
    rk[0] = *(const u32x4*)(Kp0 + (size_t)(key0 + r) * 32 + cc * 8);
    rk[1] = *(const u32x4*)(Kp1 + (size_t)(key0 + r) * 32 + cc * 8);
#pragma unroll
    for (int i = 0; i < 2; ++i) { const int q = tid + 256 * i, rr = q >> 3, c8 = q & 7; rv[i] = *(const u32x4*)(Vtp + (size_t)rr * NKEY + key0 + c8 * 8); }
  };
  auto lstore = [&](int buf) {
    u16* sK = sbase + buf * BUF; u16* sV = sK + 2 * 64 * KLD;
    const int r = tid >> 2, cc = tid & 3;
    *(u32x4*)&sK[r * KLD + cc * 8] = rk[0];
    *(u32x4*)&sK[64 * KLD + r * KLD + cc * 8] = rk[1];
#pragma unroll
    for (int i = 0; i < 2; ++i) { const int q = tid + 256 * i, rr = q >> 3, c8 = q & 7; *(u32x4*)&sV[rr * 72 + c8 * 8] = rv[i]; }
  };
  gload(0);
  __syncthreads();
  lstore(0);
  __syncthreads();
  for (int ti = 0; ti < nt; ++ti) {
    if (ti + 1 < nt) gload(ti + 1);
    const u16* sK = sbase + (ti & 1) * BUF; const u16* sV = sK + 2 * 64 * KLD;
    bf16x8 vfr[2][2][2];
#pragma unroll
    for (int k2 = 0; k2 < 2; ++k2)
#pragma unroll
      for (int s2 = 0; s2 < 2; ++s2)
#pragma unroll
        for (int dvt = 0; dvt < 2; ++dvt) vfr[k2][s2][dvt] = *(const bf16x8*)&sV[(dvt * 32 + r31) * 72 + k2 * 32 + s2 * 16 + 8 * hh];
#pragma unroll
    for (int mp = 0; mp < 2; ++mp) {
      const u16* sKm = sK + mp * 64 * KLD;
      f32x16 st[2];
#pragma unroll
      for (int k2 = 0; k2 < 2; ++k2) {
        const bf16x8 kf0 = *(const bf16x8*)&sKm[(k2 * 32 + r31) * KLD + hh * 8];
        const bf16x8 kf1 = *(const bf16x8*)&sKm[(k2 * 32 + r31) * KLD + 16 + hh * 8];
#pragma unroll
        for (int i = 0; i < 16; ++i) st[k2][i] = 0.f;
        st[k2] = MFMA32(kf0, qf[mp][0], st[k2]);
        st[k2] = MFMA32(kf1, qf[mp][1], st[k2]);
        st[k2] = MFMA32(__builtin_bit_cast(bf16x8, kaug), __builtin_bit_cast(bf16x8, qaug[mp]), st[k2]);
      }
      float mx = st[0][0];
#pragma unroll
      for (int g = 1; g < 16; ++g) mx = fmaxf(mx, st[0][g]);
#pragma unroll
      for (int g = 0; g < 16; ++g) mx = fmaxf(mx, st[1][g]);
      { auto rr = __builtin_amdgcn_permlane32_swap(__float_as_uint(mx), __float_as_uint(mx), false, false);
        mx = fmaxf(__uint_as_float(rr[0]), __uint_as_float(rr[1])); }
      if (ti == 0 || __any(mx > 8.f)) {
        const float want = m[mp] + (ti == 0 ? fmaxf(mx, -1e4f) : fmaxf(mx, 0.f));
        const float mnew = bf2f(f2bf(want));
        const float delta = mnew - m[mp];
        if (ti != 0) {
          const float alpha = __builtin_amdgcn_exp2f(-delta);
          lsum[mp] *= alpha;
#pragma unroll
          for (int i = 0; i < 16; ++i) { O[mp][0][i] *= alpha; O[mp][1][i] *= alpha; }
        }
        m[mp] = mnew;
        qaug[mp][0] = hh == 0 ? (unsigned)f2bf(-mnew) : 0u;
#pragma unroll
        for (int i = 0; i < 16; ++i) { st[0][i] -= delta; st[1][i] -= delta; }
      }
      f32x2 ps2 = {0.f, 0.f};
#pragma unroll
      for (int k2 = 0; k2 < 2; ++k2)
#pragma unroll
        for (int g = 0; g < 16; g += 2) {
          const float p0 = __builtin_amdgcn_exp2f(st[k2][g]), p1 = __builtin_amdgcn_exp2f(st[k2][g + 1]);
          st[k2][g] = p0; st[k2][g + 1] = p1;
          ps2 += f32x2{p0, p1};
        }
      lsum[mp] += ps2[0] + ps2[1];
#pragma unroll
      for (int k2 = 0; k2 < 2; ++k2)
#pragma unroll
        for (int s2 = 0; s2 < 2; ++s2) {
          u32x4 pp;
#pragma unroll
          for (int j = 0; j < 4; ++j) pp[j] = pack2(st[k2][8 * s2 + 2 * j], st[k2][8 * s2 + 2 * j + 1]);
          const bf16x8 pf = __builtin_bit_cast(bf16x8, pp);
#pragma unroll
          for (int dvt = 0; dvt < 2; ++dvt) O[mp][dvt] = MFMA32(vfr[k2][s2][dvt], pf, O[mp][dvt]);
        }
    }
    if (ti + 1 < nt) lstore((ti + 1) & 1);
    __syncthreads();
  }
#pragma unroll
  for (int mp = 0; mp < 2; ++mp) {
    const float ltot = lsum[mp] + __shfl_xor(lsum[mp], 32);
    const float inv = 1.f / ltot;
#pragma unroll
    for (int i = 0; i < 16; ++i) { O[mp][0][i] *= inv; O[mp][1][i] *= inv; }
  }
}
DEVI void attn_store(int tid, const f32x16 (&O)[2], u16* dst, int ld, int b, int qrow0, int col0) {
  const int lane = tid & 63, wid = tid >> 6, r31 = lane & 31, hh = lane >> 5;
  const int qrow = qrow0 + wid * 32 + r31;
  const int t = qrow < SEQ ? b * SEQ + qrow : TL + b * CTXL + (qrow - SEQ);
  u16* yr = dst + (size_t)t * ld + col0;
#pragma unroll
  for (int dvt = 0; dvt < 2; ++dvt)
#pragma unroll
    for (int g4 = 0; g4 < 4; ++g4) {
      u32x2 pk; pk[0] = pack2(O[dvt][g4 * 4 + 0], O[dvt][g4 * 4 + 1]); pk[1] = pack2(O[dvt][g4 * 4 + 2], O[dvt][g4 * 4 + 3]);
      *(u32x2*)(yr + dvt * 32 + 8 * g4 + 4 * hh) = pk;
    }
}
DEVI void attn_item(const Params& p, int l, int mixer, int b, int h, int qb, char* smem) {
  const bool lat = qb < 64;
  const int qrow0 = qb * 128;
  f32x16 O[2];
  if (mixer == 0) {
    f32x16 O2[2][2];
    const u16* QB = (const u16*)(p.ws + O_QB) + (size_t)(b * 8 + 2 * h) * NKEY * 32; const u16* KB = (const u16*)(p.ws + O_KB) + (size_t)(b * 8 + 2 * h) * NKEY * 32;
    attn_run_b2(p.tid, QB, QB + (size_t)NKEY * 32, qrow0, KB, KB + (size_t)NKEY * 32,
                (const u16*)(p.ws + O_VTB) + (size_t)(b * 4 + h) * 64 * NKEY, lat ? 0 : SEQ, NKEY, O2, smem);
    attn_store(p.tid, O2[0], (u16*)(p.ws + O_OB), 512, b, qrow0, (2 * h) * 64);
    attn_store(p.tid, O2[1], (u16*)(p.ws + O_OB), 512, b, qrow0, (2 * h + 1) * 64);
  } else if (mixer == 1) {
    attn_run<96>(p.tid, (const u16*)(p.ws + O_QC) + (size_t)(b * 4 + h) * NKEY * 96, qrow0, (const u16*)(p.ws + O_KC) + (size_t)(b * 4 + h) * NKEY * 96,
                 (const u16*)(p.ws + O_VTC) + (size_t)(b * 4 + h) * 64 * NKEY, lat ? 0 : SEQ, NKEY, 0, 0, 0, -1e30f, O, smem);
    attn_store(p.tid, O, (u16*)(p.ws + O_Y), 1024, b, qrow0, 512 + h * 64);
  } else {
    const float sink2 = pin(p, I_SINK)[l * 4 + h] * LOG2E;
    const int hk = h >> 1;
    int b0 = 0, b1 = 0;
    if (lat) { b0 = (qb - 1) * 128; if (b0 < 0) b0 = 0; b1 = (qb + 2) * 128; if (b1 > SEQ) b1 = SEQ; }
    attn_run<64>(p.tid, (const u16*)(p.ws + O_QA) + (size_t)(b * 4 + h) * NKEY * 64, qrow0, (const u16*)(p.ws + O_KA) + (size_t)(b * 2 + hk) * NKEY * 64,
                 (const u16*)(p.ws + O_VTA) + (size_t)(b * 2 + hk) * 64 * NKEY, SEQ, NKEY, b0, b1, qrow0, sink2, O, smem);
    attn_store(p.tid, O, (u16*)(p.ws + O_Y), 1024, b, qrow0, h * 64);
  }
}

constexpr int SMEM_BYTES = 78848 + 64;

DEVI unsigned long long launder_ptr(unsigned long long v) {
  unsigned lo = __builtin_amdgcn_readfirstlane((unsigned)v), hi = __builtin_amdgcn_readfirstlane((unsigned)(v >> 32));
  asm volatile("s_mov_b32 %0, %1" : "=s"(lo) : "s"(lo));
  asm volatile("s_mov_b32 %0, %1" : "=s"(hi) : "s"(hi));
  return ((unsigned long long)hi << 32) | lo;
}
DEVI Params mkctx(const KArgs& a) {
  Params c;
  typedef __attribute__((address_space(1))) char gchar;
  typedef __attribute__((address_space(1))) float gfloat;
  c.ws = (char*)(gchar*)launder_ptr((unsigned long long)a.ws);
  c.out = (float*)(gfloat*)launder_ptr((unsigned long long)a.out);
  c.in = (gcfloat* const*)(c.ws + O_TAB);
  c.tid = threadIdx.x;
  asm volatile("" : "+v"(c.tid));
  return c;
}
DEVI void st_mixer_queue(const KArgs& a, int l, char* smem) {
  int* sitem = (int*)(smem + SMEM_BYTES - 16);
  const int g = blockIdx.x & 7;
  const int nctx = l == 0 ? 6 : 0;
  constexpr int NPREP = TR_P2 / 8 / 8;
  const int total = 2 + 64 + 64 + 64 + nctx + NPREP;
  for (;;) {
    const Params p = mkctx(a);
    unsigned* head = (unsigned*)(p.ws + O_BAR) + 16 + l * 8 + g;
    __syncthreads();
    if (p.tid == 0) *sitem = (int)atomicAdd(head, 1u);
    __syncthreads();
    int it = *sitem;
    if (it >= total) break;
    if (it < 2) { gdn_scan_chain(p, 2 * g + it, smem); continue; }
    it -= 2;
    if (it < 192 + nctx) {
      const int b = g >> 2, h = g & 3;
      int mixer, qb;
      if (it < 192) { mixer = it >> 6; qb = it & 63; }
      else { const int j = it - 192; mixer = j >> 1; qb = 64 + (j & 1); }
      attn_item(p, l, mixer, b, h, qb, smem);
      continue;
    }
    it -= 192 + nctx;
    prep_w2_run8(p, l, (it * 8 + g) * 8, (float*)smem);
  }
}

DEVI void st_mix_finish(const Params& p, int l, int vb, int nvb) {
  const int lane = p.tid & 63, wid = p.tid >> 6;
  const float* GO = (const float*)(p.ws + O_GO); const u16* PP = (const u16*)(p.ws + O_PP); const u16* OB = (const u16*)(p.ws + O_OB);
  u16* Y = (u16*)(p.ws + O_Y);
  const float lam_init = 0.8f - 0.6f * expf(-0.3f * (float)l);
  float d1 = lane < 32 ? pin(p, I_LQ1)[l * 32 + lane] * pin(p, I_LK1)[l * 32 + lane] : 0.f;
  float d2 = lane < 32 ? pin(p, I_LQ2)[l * 32 + lane] * pin(p, I_LK2)[l * 32 + lane] : 0.f;
  const float lam = expf(wave_sum(d1)) - expf(wave_sum(d2)) + lam_init;
  const int hd = lane >> 4, d0 = (lane & 15) * 4;
  const f32x4 gg = *(const f32x4*)(pin(p, I_GNG) + l * 64 + d0);
  const f32x4 dg = *(const f32x4*)(pin(p, I_DNG) + l * 64 + d0) * (1.f - lam_init);
  const int tend = l == 0 ? T : TL;
  for (int t0 = (vb * 4 + wid) * 2; t0 < tend; t0 += nvb * 8) {
    u32x2 o0[2], o1[2], zz[2]; f32x4 gf[2], gb[2];
#pragma unroll
    for (int u = 0; u < 2; ++u) {
      const size_t t = t0 + u;
      o0[u] = *(const u32x2*)(OB + t * 512 + (hd * 2) * 64 + d0);
      o1[u] = *(const u32x2*)(OB + t * 512 + (hd * 2 + 1) * 64 + d0);
      gf[u] = *(const f32x4*)(GO + t * 256 + hd * 64 + d0);
      gb[u] = *(const f32x4*)(GO + (size_t)T * 256 + t * 256 + hd * 64 + d0);
      zz[u] = *(const u32x2*)(PP + t * LDPP + PP_DZ + hd * 64 + d0);
    }
    f32x4 od[2], go[2]; float ssb[2], ssg[2];
#pragma unroll
    for (int u = 0; u < 2; ++u) {
      const f32x4 a = {bflo(o0[u][0]), bfhi(o0[u][0]), bflo(o0[u][1]), bfhi(o0[u][1])};
      const f32x4 b = {bflo(o1[u][0]), bfhi(o1[u][0]), bflo(o1[u][1]), bfhi(o1[u][1])};
      od[u] = a - lam * b; go[u] = gf[u] + gb[u];
      ssb[u] = od[u][0] * od[u][0] + od[u][1] * od[u][1] + od[u][2] * od[u][2] + od[u][3] * od[u][3];
      ssg[u] = go[u][0] * go[u][0] + go[u][1] * go[u][1] + go[u][2] * go[u][2] + go[u][3] * go[u][3];
    }
#pragma unroll
    for (int o = 8; o >= 1; o >>= 1) {
#pragma unroll
      for (int u = 0; u < 2; ++u) { ssb[u] += __shfl_xor(ssb[u], o); ssg[u] += __shfl_xor(ssg[u], o); }
    }
#pragma unroll
    for (int u = 0; u < 2; ++u) {
      const size_t t = t0 + u;
      const f32x4 yb = od[u] * (rsqrtf(ssb[u] * (1.f / 64.f) + 1e-6f)) * dg;
      const f32x4 z = {bflo(zz[u][0]), bfhi(zz[u][0]), bflo(zz[u][1]), bfhi(zz[u][1])};
      const f32x4 sz = {siluf(z[0]), siluf(z[1]), siluf(z[2]), siluf(z[3])};
      const f32x4 yd = go[u] * (rsqrtf(ssg[u] * (1.f / 64.f) + 1e-6f)) * gg * sz;
      u32x2 pb, pd;
      pb[0] = pack2(yb[0], yb[1]); pb[1] = pack2(yb[2], yb[3]);
      pd[0] = pack2(yd[0], yd[1]); pd[1] = pack2(yd[2], yd[3]);
      *(u32x2*)(Y + t * 1024 + 256 + hd * 64 + d0) = pb;
      *(u32x2*)(Y + t * 1024 + 768 + hd * 64 + d0) = pd;
    }
  }
}

constexpr int RLD = 1026;
DEVI void st_norm2_route(const Params& p, int l, int vb, int nvb, char* smem) {
  const int lane = p.tid & 63, wid = p.tid >> 6, i15 = lane & 15, q = lane >> 4;
  float* shh = (float*)smem;
  float* slog = shh + 16 * RLD;
  const float* g = pin(p, I_N2G) + l * 1024;
  const float* wr = pin(p, I_WR) + (size_t)l * 1024 * 64;
  const float bias = pin(p, I_RB)[l * 64 + lane];
  float* WTS = (float*)(p.ws + O_WTS); int* CNT = (int*)(p.ws + O_CNT); int* LIST = (int*)(p.ws + O_LIST);
  const int ntok = l == 0 ? T : TL;
  for (int grp = vb; grp < ntok / 16; grp += nvb) {
    const int tb = grp * 16 + wid * 4;
    const int mv = tok_mv(tb);
    const float* sh = modp(p, l, mv, 3); const float* sc = modp(p, l, mv, 4);
    {
      f32x4 v[4][4]; float ss[4];
#pragma unroll
      for (int u = 0; u < 4; ++u) {
        const f32x4* xr = (const f32x4*)((const float*)(p.ws + O_XA) + (size_t)(tb + u) * 1024);
#pragma unroll
        for (int i = 0; i < 4; ++i) v[u][i] = xr[i * 64 + lane];
      }
#pragma unroll
      for (int u = 0; u < 4; ++u) {
        float a = 0.f;
#pragma unroll
        for (int i = 0; i < 4; ++i) a += v[u][i][0] * v[u][i][0] + v[u][i][1] * v[u][i][1] + v[u][i][2] * v[u][i][2] + v[u][i][3] * v[u][i][3];
        ss[u] = a;
      }
#pragma unroll
      for (int o = 32; o >= 1; o >>= 1) {
#pragma unroll
        for (int u = 0; u < 4; ++u) ss[u] += __shfl_xor(ss[u], o);
      }
#pragma unroll
      for (int i = 0; i < 4; ++i) {
        const int c = i * 256 + lane * 4;
        const f32x4 gg = *(const f32x4*)(g + c), s4 = *(const f32x4*)(sc + c), h4 = *(const f32x4*)(sh + c);
        const f32x4 gs = gg * (1.f + s4);
#pragma unroll
        for (int u = 0; u < 4; ++u) {
          const float rstd = rsqrtf(ss[u] * (1.f / 1024.f) + 1e-6f);
          const f32x4 o = v[u][i] * rstd * gs + h4;
          u32x2 pk; pk[0] = pack2(o[0], o[1]); pk[1] = pack2(o[2], o[3]);
          *(u32x2*)((u16*)(p.ws + O_H) + (size_t)(tb + u) * LDH + c) = pk;
          float* d = shh + (wid * 4 + u) * RLD + c;
          *(f32x2*)d = f32x2{o[0], o[1]}; *(f32x2*)(d + 2) = f32x2{o[2], o[3]};
        }
      }
    }
    __syncthreads();
    {
      f32x4 a0 = fzero4(), a1 = a0;
      const float* ap = shh + i15 * RLD + q;
      const float* bp = wr + (size_t)q * 64 + wid * 16 + i15;
#pragma unroll 1
      for (int kb = 0; kb < 256; kb += 32) {
        float bv[32];
#pragma unroll
        for (int j = 0; j < 32; ++j) bv[j] = bp[(size_t)(4 * (kb + j)) * 64];
#pragma unroll
        for (int j = 0; j < 32; j += 2) {
          a0 = __builtin_amdgcn_mfma_f32_16x16x4f32(ap[4 * (kb + j)], bv[j], a0, 0, 0, 0);
          a1 = __builtin_amdgcn_mfma_f32_16x16x4f32(ap[4 * (kb + j) + 4], bv[j + 1], a1, 0, 0, 0);
        }
      }
#pragma unroll
      for (int r = 0; r < 4; ++r) slog[(4 * q + r) * 64 + wid * 16 + i15] = a0[r] + a1[r];
    }
    __syncthreads();
#pragma unroll 1
    for (int u = 0; u < 4; ++u) {
      const int t = tb + u;
      const float logit = slog[(wid * 4 + u) * 64 + lane];
      const float s = 1.f / (1.f + expf(-logit));
      const float c = s + bias;
      float m1 = c;
      m1 = fmaxf(m1, __shfl_xor(m1, 1)); m1 = fmaxf(m1, __shfl_xor(m1, 2)); m1 = fmaxf(m1, __shfl_xor(m1, 4));
      const unsigned long long bal = __ballot(c == m1);
      const int grpi = lane >> 3;
      const unsigned gm = (unsigned)((bal >> (grpi * 8)) & 0xffull);
      const int first = __ffs(gm) - 1;
      float m2 = ((lane & 7) == first) ? -INFINITY : c;
      m2 = fmaxf(m2, __shfl_xor(m2, 1)); m2 = fmaxf(m2, __shfl_xor(m2, 2)); m2 = fmaxf(m2, __shfl_xor(m2, 4));
      const float gs = m1 + m2;
      int grank = 0;
#pragma unroll
      for (int gg = 0; gg < 8; ++gg) { float o = __shfl(gs, gg * 8); grank += (o > gs || (o == gs && gg < grpi)) ? 1 : 0; }
      const bool gsel = grank < 4;
      const float mc = gsel ? c : -INFINITY;
      int rank = 0;
#pragma unroll
      for (int e = 0; e < 64; ++e) { float o = __shfl(mc, e); rank += (o > mc || (o == mc && e < lane)) ? 1 : 0; }
      const bool sel = gsel && rank < 6;
      const float ssum = wave_sum(sel ? s : 0.f);
      if (sel) {
        const int slot = t * 6 + rank;
        WTS[slot] = s / ssum * 2.5f;
        const int pos = atomicAdd(&CNT[lane], 1);
        LIST[(size_t)lane * T + pos] = slot;
      }
    }
    __syncthreads();
  }
}
DEVI void st_outproj(const Params& p, int l, int vb, int nvb, char* smem) {
  const u16* Y = (const u16*)(p.ws + O_Y); const u16* W = (const u16*)(p.ws + O_WOUTT); float* XA = (float*)(p.ws + O_XA);
  const int tid = p.tid, lane = tid & 63, wid = tid >> 6, wr = wid >> 1, wc = wid & 1, fr = lane & 15, fq = lane >> 4;
  const int nmt = l == 0 ? 132 : 128;
  const int g = vb & 7, nmg = (nmt - g + 7) >> 3;
  for (int i = vb >> 3; i < nmg * 8; i += nvb >> 3) {
    const int m0 = (g + 8 * (i >> 3)) * 128, n0 = (i & 7) * 128;
    f32x4 acc[4][4];
    gemm_core<false>(tid, [&](int r) { return Y + (size_t)(m0 + r) * 1024; }, W + (size_t)n0 * LDW, LDW, 1024, acc, smem);
    const float* gbase = modp(p, l, tok_mv(m0), 2) + n0 + wc * 64 + fq * 4;
#pragma unroll
    for (int hf = 0; hf < 2; ++hf) {
      f32x4 xin[2][4], gt[4];
#pragma unroll
      for (int n = 0; n < 4; ++n) gt[n] = *(const f32x4*)(gbase + n * 16);
#pragma unroll
      for (int mm = 0; mm < 2; ++mm) {
        const int t = m0 + wr * 64 + (hf * 2 + mm) * 16 + fr;
        const float* src = l == 0 ? (t < TL ? pin(p, I_X) + (size_t)t * 1024 : pin(p, I_CTX) + (size_t)(t - TL) * 1024) : (const float*)(XA + (size_t)t * 1024);
#pragma unroll
        for (int n = 0; n < 4; ++n) xin[mm][n] = *(const f32x4*)(src + n0 + wc * 64 + n * 16 + fq * 4);
      }
#pragma unroll
      for (int mm = 0; mm < 2; ++mm) {
        const int t = m0 + wr * 64 + (hf * 2 + mm) * 16 + fr;
#pragma unroll
        for (int n = 0; n < 4; ++n) *(f32x4*)(XA + (size_t)t * 1024 + n0 + wc * 64 + n * 16 + fq * 4) = xin[mm][n] + gt[n] * acc[hf * 2 + mm][n];
      }
    }
  }
}

DEVI void grp_tiles(const Params& p, int* tst, int g, int shift, int nshared) {
  __syncthreads();
  if (p.tid < 64) {
    const int* CNT = (const int*)(p.ws + O_CNT);
    const int lane = p.tid;
    int c = 0;
    if (lane < 8) c = (__hip_atomic_load(&CNT[g + 8 * lane], __ATOMIC_RELAXED, __HIP_MEMORY_SCOPE_AGENT) + (1 << shift) - 1) >> shift;
    int incl = c;
#pragma unroll
    for (int o = 1; o < 8; o <<= 1) { int u = __shfl_up(incl, o); if (lane >= o) incl += u; }
    if (lane < 8) tst[lane] = incl - c;
    if (lane == 7) { tst[8] = incl; tst[9] = incl + (nshared - g + 7) / 8; }
  }
  __syncthreads();
}
DEVI void grp_find(const int* tst, int tile, int g, int& e, int& lt) {
  int j = 0;
#pragma unroll
  for (int k = 1; k <= 8; ++k) j += tile >= tst[k] ? 1 : 0;
  if (j < 8) { e = g + 8 * j; lt = tile - tst[j]; } else { e = 64; lt = g + 8 * (tile - tst[8]); }
}
DEVI void st_moe1(const Params& p, int l, int vb, int nvb, char* smem) {
  const int* CNT = (const int*)(p.ws + O_CNT); const int* LIST = (const int*)(p.ws + O_LIST);
  const u16* H = (const u16*)(p.ws + O_H); u16* HB = (u16*)(p.ws + O_HB);
  int* sslot = (int*)(smem + 4 * 128 * GLD * 2);
  int* TST = sslot + 128;
  const int g = vb & 7;
  const int nsh = l == 0 ? T : TL;
  grp_tiles(p, TST, g, 7, nsh / 128);
  const int total = TST[9];
  auto fetch_slot = [&](int item, int& e, int& n0) {
    const int tile = item >> 2; n0 = (item & 3) * 128;
    int lt; grp_find(TST, tile, g, e, lt);
    int slot = -1;
    if (p.tid < 128) {
      const int cnt = e < 64 ? __hip_atomic_load(&CNT[e], __ATOMIC_RELAXED, __HIP_MEMORY_SCOPE_AGENT) : nsh;
      const int i = lt * 128 + p.tid;
      if (i < cnt) slot = e < 64 ? LIST[(size_t)e * T + i] : NSLOT + i;
    }
    return slot;
  };
  int e = 0, n0 = 0, e_nx = 0, n0_nx = 0;
  int slot_nx = (vb >> 3) < total * 4 ? fetch_slot(vb >> 3, e_nx, n0_nx) : -1;
  for (int item = vb >> 3; item < total * 4; item += nvb >> 3) {
    e = e_nx; n0 = n0_nx;
    __syncthreads();
    if (p.tid < 128) sslot[p.tid] = slot_nx;
    __syncthreads();
    if (item + (nvb >> 3) < total * 4) slot_nx = fetch_slot(item + (nvb >> 3), e_nx, n0_nx);
    f32x4 acc[4][4];
    gemm_core<false, 2>(p.tid, [&](int r) { int sl = sslot[r]; int tk = sl < 0 ? 0 : (sl < NSLOT ? sl / 6 : sl - NSLOT); return H + (size_t)tk * LDH; },
                        (const u16*)(p.ws + O_WGUT) + ((size_t)e * 512 + n0) * LDW, LDW, 1024, acc, smem);
    {
      const int lane = p.tid & 63, wid = p.tid >> 6, wr = wid >> 1, wc = wid & 1, fr = lane & 15, fq = lane >> 4;
#pragma unroll
      for (int m = 0; m < 4; ++m) {
        const int sl = sslot[wr * 64 + m * 16 + fr];
        if (sl >= 0) {
          u32x4 pk;
#pragma unroll
          for (int n = 0; n < 4; ++n) pk[n] = pack2(siluf(acc[m][n][0]) * acc[m][n][1], siluf(acc[m][n][2]) * acc[m][n][3]);
          *(u32x4*)(HB + (size_t)sl * 256 + (n0 >> 1) + wc * 32 + fq * 8) = pk;
        }
      }
    }
  }
}
DEVI void st_moe2(const Params& p, int l, int vb, int nvb, char* smem) {
  const int* CNT = (const int*)(p.ws + O_CNT); const int* LIST = (const int*)(p.ws + O_LIST);
  const u16* HB = (const u16*)(p.ws + O_HB); u16* SO = (u16*)(p.ws + O_SLOT); const float* WTS = (const float*)(p.ws + O_WTS);
  constexpr int ALD = 264;
  u16* sA = (u16*)smem;
  u16* sB = sA + 64 * ALD;
  int* sslot = (int*)(sB + 2 * 128 * 72);
  int* TST = sslot + 64;
  const int tid = p.tid, lane = tid & 63, wid = tid >> 6, wr = wid >> 1, wc = wid & 1, fr = lane & 15, fq = lane >> 4;
  const int g = vb & 7;
  const int nsh = l == 0 ? T : TL;
  grp_tiles(p, TST, g, 6, nsh / 64);
  const int total = TST[9];
  for (int item = vb >> 3; item < total; item += nvb >> 3) {
    int e, lt; grp_find(TST, item, g, e, lt);
    const int cnt = e < 64 ? __hip_atomic_load(&CNT[e], __ATOMIC_RELAXED, __HIP_MEMORY_SCOPE_AGENT) : nsh;
    __syncthreads();
    if (tid < 64) { const int i = lt * 64 + tid; sslot[tid] = i < cnt ? (e < 64 ? LIST[(size_t)e * T + i] : NSLOT + i) : -1; }
    __syncthreads();
    const u16* Bbase = (const u16*)(p.ws + O_WDT) + (size_t)e * 1024 * 256;
    constexpr int NR = 5;
    u32x4 rb[NR][4];
    const u16* bthr = Bbase + (size_t)(tid >> 3) * 256 + (tid & 7) * 8;
    auto gloadB = [&](u32x4 (&rb)[4], int bt) {
      int off = (bt >> 2) * 128 * 256 + (bt & 3) * 64;
      asm volatile("" : "+s"(off));
      const u16* src = bthr + off;
#pragma unroll
      for (int i = 0; i < 4; ++i) rb[i] = *(const u32x4*)(src + i * 32 * 256);
    };
    auto lstoreB = [&](const u32x4 (&rb)[4], int buf) {
      u16* d = sB + buf * 128 * 72;
#pragma unroll
      for (int i = 0; i < 4; ++i) { const int q = tid + 256 * i, r = q >> 3, cc = q & 7; *(u32x4*)&d[r * 72 + cc * 8] = rb[i]; }
    };
#pragma unroll
    for (int t = 0; t < NR; ++t) gloadB(rb[t], t);
#pragma unroll
    for (int hf = 0; hf < 2; ++hf) {
      u32x4 ra[4];
#pragma unroll
      for (int i = 0; i < 4; ++i) { const int q = tid + 256 * (4 * hf + i), r = q >> 5, cc = q & 31; const int sl = sslot[r]; ra[i] = *(const u32x4*)(HB + (size_t)(sl < 0 ? 0 : sl) * 256 + cc * 8); }
#pragma unroll
      for (int i = 0; i < 4; ++i) { const int q = tid + 256 * (4 * hf + i), r = q >> 5, cc = q & 31; *(u32x4*)&sA[r * ALD + cc * 8] = ra[i]; }
      __builtin_amdgcn_sched_barrier(0);
    }
    int slot_m[2]; float w_m[2];
#pragma unroll
    for (int m = 0; m < 2; ++m) { const int sl = sslot[wr * 32 + m * 16 + fr]; slot_m[m] = sl; w_m[m] = (sl >= 0 && sl < NSLOT) ? WTS[sl] : 1.f; }
    lstoreB(rb[0], 0); gloadB(rb[0], NR);
    __syncthreads();
    f32x4 acc[2][4];
    auto compute = [&](int bt, int buf) {
      const int nt = bt >> 2, kt = bt & 3;
      const u16* b = sB + buf * 128 * 72;
      if (kt == 0) {
#pragma unroll
        for (int m = 0; m < 2; ++m)
#pragma unroll
          for (int n = 0; n < 4; ++n) acc[m][n] = fzero4();
      }
#pragma unroll
      for (int ks = 0; ks < 2; ++ks) {
        bf16x8 af[2], bfr[4];
#pragma unroll
        for (int m = 0; m < 2; ++m) af[m] = *(const bf16x8*)&sA[(wr * 32 + m * 16 + fr) * ALD + kt * 64 + ks * 32 + fq * 8];
#pragma unroll
        for (int n = 0; n < 4; ++n) bfr[n] = *(const bf16x8*)&b[(wc * 64 + (n >> 1) * 32 + (fr >> 2) * 8 + (n & 1) * 4 + (fr & 3)) * 72 + ks * 32 + fq * 8];
#pragma unroll
        for (int m = 0; m < 2; ++m)
#pragma unroll
          for (int n = 0; n < 4; ++n) acc[m][n] = MFMA16(bfr[n], af[m], acc[m][n]);
      }
      if (kt == 3) {
#pragma unroll
        for (int m = 0; m < 2; ++m) {
          if (slot_m[m] >= 0) {
            const float w = w_m[m];
#pragma unroll
            for (int h = 0; h < 2; ++h) {
              u32x4 pk;
              pk[0] = pack2(acc[m][2 * h][0] * w, acc[m][2 * h][1] * w); pk[1] = pack2(acc[m][2 * h][2] * w, acc[m][2 * h][3] * w);
              pk[2] = pack2(acc[m][2 * h + 1][0] * w, acc[m][2 * h + 1][1] * w); pk[3] = pack2(acc[m][2 * h + 1][2] * w, acc[m][2 * h + 1][3] * w);
              *(u32x4*)(SO + (size_t)slot_m[m] * 1024 + nt * 128 + wc * 64 + h * 32 + fq * 8) = pk;
            }
          }
        }
      }
    };
#pragma unroll
    for (int bt = 0; bt < 32; ++bt) {
      compute(bt, bt & 1);
      if (bt + 1 < 32) lstoreB(rb[(bt + 1) % NR], (bt + 1) & 1);
      if (bt + 1 + NR < 32) gloadB(rb[(bt + 1) % NR], bt + 1 + NR);
      __syncthreads(); __builtin_amdgcn_sched_barrier(0);
    }
  }
}

DEVI void st_combine(const Params& p, int l, int vb, int nvb) {
  const int lane = p.tid & 63, wid = p.tid >> 6;
  const u16* SO = (const u16*)(p.ws + O_SLOT);
  const bool last = l == 1;
  const float* gnext = last ? pin(p, I_FNG) : pin(p, I_N1G) + 1024;
  const int tend = last ? TL : T;
  for (int t0 = (vb * 4 + wid) * 2; t0 < tend; t0 += nvb * 8) {
    const int mv = tok_mv(t0);
    const float* g5 = modp(p, l, mv, 5);
    u32x4 sv[2][7][2]; f32x4 xv[2][4];
#pragma unroll
    for (int u = 0; u < 2; ++u) {
      const int t = t0 + u;
#pragma unroll
      for (int k = 0; k < 7; ++k) {
        const u16* row = SO + (size_t)(k < 6 ? t * 6 + k : NSLOT + t) * 1024;
        sv[u][k][0] = *(const u32x4*)(row + lane * 8); sv[u][k][1] = *(const u32x4*)(row + 512 + lane * 8);
      }
      const float* xr = (const float*)(p.ws + O_XA) + (size_t)t * 1024;
      xv[u][0] = *(const f32x4*)(xr + lane * 8); xv[u][1] = *(const f32x4*)(xr + lane * 8 + 4);
      xv[u][2] = *(const f32x4*)(xr + 512 + lane * 8); xv[u][3] = *(const f32x4*)(xr + 512 + lane * 8 + 4);
    }
    f32x4 gq[4];
    gq[0] = *(const f32x4*)(g5 + lane * 8); gq[1] = *(const f32x4*)(g5 + lane * 8 + 4);
    gq[2] = *(const f32x4*)(g5 + 512 + lane * 8); gq[3] = *(const f32x4*)(g5 + 512 + lane * 8 + 4);
    float ss[2];
#pragma unroll
    for (int u = 0; u < 2; ++u) {
      float acc = 0.f;
#pragma unroll
      for (int hf = 0; hf < 2; ++hf) {
        f32x4 a0 = fzero4(), a1 = a0;
#pragma unroll
        for (int k = 0; k < 7; ++k) {
          const u32x4 v = sv[u][k][hf];
          a0[0] += bflo(v[0]); a0[1] += bfhi(v[0]); a0[2] += bflo(v[1]); a0[3] += bfhi(v[1]);
          a1[0] += bflo(v[2]); a1[1] += bfhi(v[2]); a1[2] += bflo(v[3]); a1[3] += bfhi(v[3]);
        }
        xv[u][2 * hf] += gq[2 * hf] * a0; xv[u][2 * hf + 1] += gq[2 * hf + 1] * a1;
#pragma unroll
        for (int e = 0; e < 4; ++e) acc += xv[u][2 * hf][e] * xv[u][2 * hf][e] + xv[u][2 * hf + 1][e] * xv[u][2 * hf + 1][e];
      }
      ss[u] = acc;
    }
#pragma unroll
    for (int o = 32; o >= 1; o >>= 1) { ss[0] += __shfl_xor(ss[0], o); ss[1] += __shfl_xor(ss[1], o); }
    f32x4 gn[4];
    gn[0] = *(const f32x4*)(gnext + lane * 8); gn[1] = *(const f32x4*)(gnext + lane * 8 + 4);
    gn[2] = *(const f32x4*)(gnext + 512 + lane * 8); gn[3] = *(const f32x4*)(gnext + 512 + lane * 8 + 4);
    if (!last) {
      const float* sh = modp(p, 1, mv, 0); const float* sc = modp(p, 1, mv, 1);
#pragma unroll
      for (int q = 0; q < 4; ++q) {
        const int c = (q >> 1) * 512 + lane * 8 + (q & 1) * 4;
        const f32x4 s4 = *(const f32x4*)(sc + c), h4 = *(const f32x4*)(sh + c);
        const f32x4 gs = gn[q] * (1.f + s4);
#pragma unroll
        for (int u = 0; u < 2; ++u) {
          const size_t t = t0 + u;
          const float rstd = rsqrtf(ss[u] * (1.f / 1024.f) + 1e-6f);
          *(f32x4*)((float*)(p.ws + O_XA) + t * 1024 + c) = xv[u][q];
          const f32x4 o = xv[u][q] * rstd * gs + h4;
          u32x2 pk; pk[0] = pack2(o[0], o[1]); pk[1] = pack2(o[2], o[3]);
          *(u32x2*)((u16*)(p.ws + O_H) + t * LDH + c) = pk;
        }
      }
    } else {
#pragma unroll
      for (int q = 0; q < 4; ++q) {
        const int c = (q >> 1) * 512 + lane * 8 + (q & 1) * 4;
#pragma unroll
        for (int u = 0; u < 2; ++u) {
          const size_t t = t0 + u;
          const float rstd = rsqrtf(ss[u] * (1.f / 1024.f) + 1e-6f);
          *(f32x4*)(p.out + t * 1024 + c) = xv[u][q] * rstd * gn[q];
        }
      }
    }
  }
}


#define STAGE(call) { const Params p = mkctx(a); call; }

#define XB_TMO      128
#define XB_XCNT(j)  (256  + 64 * (j))
#define XB_XSUB(j)  (1280 + 64 * (j))
#define XB_XGEN(j)  (2304 + 64 * (j))
#define XB_TOP      3328
#define XB_TOPGEN   3392
#define XCD_BAR_WORDS 3456
#define XB_SPIN_CAP (1u << 20)
#define LAS __attribute__((address_space(3)))
DEVI unsigned xb_ld(unsigned* p)              { return __hip_atomic_load(p, __ATOMIC_RELAXED, __HIP_MEMORY_SCOPE_AGENT); }
DEVI unsigned xb_add(unsigned* p, unsigned v) { return __hip_atomic_fetch_add(p, v, __ATOMIC_RELAXED, __HIP_MEMORY_SCOPE_AGENT); }
DEVI unsigned xb_xcc_id() { return (unsigned)__builtin_amdgcn_s_getreg((3 << 11) | 20) & 0xFu; }
#define XB_SPIN(cond, bar) do { unsigned _sp = 0; while (cond) { __builtin_amdgcn_s_sleep(1); \
    if ((++_sp & 255u) == 0u) { if (xb_ld(&(bar)[XB_TMO])) break; if (_sp > XB_SPIN_CAP) { atomicAdd(&(bar)[XB_TMO], 1u); break; } } } } while (0)
struct XcdBarrier { unsigned* bar; unsigned x; volatile LAS unsigned* st; };
DEVI XcdBarrier xcd_barrier_post(unsigned* bar, volatile LAS unsigned* st) {
  XcdBarrier b; b.bar = bar; b.x = xb_xcc_id(); b.st = st;
  if (threadIdx.x == 0) (void)xb_add(&bar[XB_XCNT(b.x)], 1u);
  return b;
}
DEVI void xcd_barrier_complete(unsigned* bar, unsigned x, unsigned& nloc, unsigned& nx) {
  const unsigned G = gridDim.x * gridDim.y * gridDim.z;
  unsigned sum, cnt, mine, sp = 0u;
  for (;;) {
    sum = 0u; cnt = 0u; mine = 0u;
#pragma unroll
    for (unsigned j = 0; j < 16; ++j) { const unsigned c = xb_ld(&bar[XB_XCNT(j)]); sum += c; cnt += (c > 0u) ? 1u : 0u; mine = (j == x) ? c : mine; }
    if (sum == G) break;
    __builtin_amdgcn_s_sleep(1);
    if ((++sp & 255u) == 0u) { if (xb_ld(&bar[XB_TMO])) break; if (sp > XB_SPIN_CAP) { atomicAdd(&bar[XB_TMO], 1u); break; } }
  }
  nloc = mine > 0u ? mine : 1u; nx = cnt > 0u ? cnt : 1u;
}
DEVI void xcd_barrier(const XcdBarrier& b) {
  asm volatile("s_waitcnt vmcnt(0)" ::: "memory");
  __syncthreads();
  if (threadIdx.x == 0) {
    unsigned* bar = b.bar;
    __builtin_amdgcn_s_waitcnt(0);
    unsigned nloc = b.st[0], nx = b.st[1];
    if (nloc == 0u) { xcd_barrier_complete(bar, b.x, nloc, nx); b.st[0] = nloc; b.st[1] = nx; }
    const unsigned old = xb_add(&bar[XB_XSUB(b.x)], 1u);
    const unsigned gen = old / nloc;
    if (old + 1u == (gen + 1u) * nloc) {
      __builtin_amdgcn_fence(__ATOMIC_RELEASE, "agent");
      asm volatile("s_waitcnt vmcnt(0)" ::: "memory");
      const unsigned og = xb_add(&bar[XB_TOP], 1u);
      const unsigned tg = og / nx;
      if (og + 1u == (tg + 1u) * nx) xb_add(&bar[XB_TOPGEN], 1u);
      else XB_SPIN(xb_ld(&bar[XB_TOPGEN]) == tg, bar);
      __builtin_amdgcn_fence(__ATOMIC_ACQUIRE, "agent");
      xb_add(&bar[XB_XGEN(b.x)], 1u);
      asm volatile("s_waitcnt vmcnt(0)" ::: "memory");
    } else {
      XB_SPIN(xb_ld(&bar[XB_XGEN(b.x)]) == gen, bar);
      __builtin_amdgcn_fence(__ATOMIC_ACQUIRE, "agent");
      asm volatile("s_waitcnt vmcnt(0)" ::: "memory");
    }
  }
  __syncthreads();
}
#define GSYNC() { XcdBarrier xb_; xb_.bar = (unsigned*)(mkctx(a).ws + O_XBAR); xb_.x = xb_xcc_id(); xb_.st = (volatile LAS unsigned*)(smem + SMEM_BYTES - 32); xcd_barrier(xb_); }

__global__ void __launch_bounds__(256, 2) mega(KArgs a) {
  extern __shared__ __attribute__((aligned(16))) char smem[];
  cg::grid_group grid = cg::this_grid();
  const int vb = blockIdx.x, nvb = gridDim.x;
  volatile LAS unsigned* xst = (volatile LAS unsigned*)(smem + SMEM_BYTES - 32);
  if (threadIdx.x == 0) { xst[0] = 0u; xst[1] = 0u; }
  __syncthreads();
  (void)xcd_barrier_post((unsigned*)(a.ws + O_XBAR), xst);
  if (threadIdx.x == 0) {
    const float** tab = (const float**)(a.ws + O_TAB);
#pragma unroll
    for (int i = 0; i < 35; ++i) tab[i] = a.in[i];
  }
  __syncthreads();
  STAGE(st_rope_table(p, vb, nvb));
  STAGE(st_mod(p, vb, nvb, smem));
  STAGE(st_prep_w1(p, 0, vb, nvb, smem));
  if (a.ws == nullptr) grid.sync();
  GSYNC();
  for (int l = 0; l < 2; ++l) {
    if (l == 0) { STAGE(st_norm1(p, 0, vb, nvb)); GSYNC(); }
    {
      const int g = vb & 7;
      for (int i = vb >> 3; i < 363; i += nvb >> 3) {
        int mt, nt;
        if (i < 264) { mt = i >> 1; nt = g + 8 * (i & 1); }
        else { const int j = i - 264, pc = g + 8 * (j / 33); nt = 16 + (pc >> 2); mt = (pc & 3) * 33 + (j % 33); }
        const Params p = mkctx(a); inproj_item(p, mt * 22 + nt, smem);
      }
    }
    GSYNC();
    STAGE(st_tokprep(p, l, vb, nvb));
    GSYNC();
    {
      for (int item = vb; item < 132 * 7 + NGITEM; item += nvb) {
        const Params p = mkctx(a);
        if (item < 132 * 7) mla_up_tile(p, item / 7, item % 7, smem);
        else gdn_chunk_item(p, item - 132 * 7, smem);
      }
    }
    GSYNC();
    st_mixer_queue(a, l, smem);
    GSYNC();
    STAGE(st_mix_finish(p, l, vb, nvb));
    GSYNC();
    STAGE(st_outproj(p, l, vb, nvb, smem));
    GSYNC();
    STAGE(st_norm2_route(p, l, vb, nvb, smem));
    GSYNC();
    STAGE(st_moe1(p, l, vb, nvb, smem));
    GSYNC();
    STAGE(st_moe2(p, l, vb, nvb, smem));
    GSYNC();
    if (l == 0) STAGE(st_prep_w1(p, 1, vb, nvb, smem));
    STAGE(st_combine(p, l, vb, nvb));
    if (l == 0) GSYNC();
  }
}

extern "C" void kernel_launch(void* const* d_in, const int* in_sizes, int n_in, void* d_out, int out_size, void* d_ws, size_t ws_size,
                              hipStream_t stream) {
  static int grid_blocks = 0;
  if (!grid_blocks) {
    int dev = 0, cus = 0, per_cu = 0;
    (void)hipGetDevice(&dev);
    (void)hipDeviceGetAttribute(&cus, hipDeviceAttributeMultiprocessorCount, dev);
    (void)hipFuncSetAttribute((const void*)mega, hipFuncAttributeMaxDynamicSharedMemorySize, SMEM_BYTES);
    (void)hipOccupancyMaxActiveBlocksPerMultiprocessor(&per_cu, mega, 256, SMEM_BYTES);
    if (per_cu > 2) per_cu = 2;
    if (per_cu < 1) per_cu = 1;
    grid_blocks = cus * per_cu;
  }
  KArgs p{};
  for (int i = 0; i < 35; ++i) p.in[i] = (const float*)d_in[i];
  p.out = (float*)d_out; p.ws = (char*)d_ws;
  if (ws_size < WS_NEED) { fprintf(stderr, "workspace too small: %zu < %zu\n", ws_size, (size_t)WS_NEED); return; }
  (void)hipMemsetAsync((char*)d_ws + O_BAR, 0, 256 + 16384, stream);
  void* args[] = {&p};
  hipError_t e = hipLaunchCooperativeKernel((void*)mega, dim3(grid_blocks), dim3(256), args, SMEM_BYTES, stream);
  if (e != hipSuccess) fprintf(stderr, "cooperative launch failed: %s (grid %d)\n", hipGetErrorString(e), grid_blocks);
}
```

```cpp
#include <hip/hip_runtime.h>
#include <hip/hip_cooperative_groups.h>
#include <cstdio>
#include <cstdint>
namespace cg = cooperative_groups;

#define DEVI __device__ __forceinline__
typedef unsigned short u16;
using bf16x8 = __attribute__((ext_vector_type(8))) short;
using f32x4  = __attribute__((ext_vector_type(4))) float;
using f32x2  = __attribute__((ext_vector_type(2))) float;
using f32x16 = __attribute__((ext_vector_type(16))) float;
using u32x4 = __attribute__((ext_vector_type(4))) unsigned;
using u32x2 = __attribute__((ext_vector_type(2))) unsigned;
typedef __bf16 bf16x2_t __attribute__((ext_vector_type(2)));

constexpr int DM = 1024, SEQ = 8192, CTXL = 256, NKEY = SEQ + CTXL;
constexpr int TL = 2 * SEQ, TC = 2 * CTXL, T = TL + TC;
constexpr int INW = 2672;
constexpr int NIN = 2816;
constexpr int LDPP = 1408;
constexpr int PP_CQ = 0, PP_CKV = 192, PP_DQKV = 320, PP_DZ = 1088, PP_GATE = 1344;
constexpr int NE = 64, NSLOT = 6 * T;
constexpr int LDW = 1088;
constexpr int LDH = 1088;
constexpr int NCHUNK = T / 64;
constexpr int NGITEM = NCHUNK * 8;
constexpr float LOG2E = 1.4426950408889634f;

constexpr size_t al256(size_t x) { return (x + 255) & ~(size_t)255; }
constexpr size_t O_MOD   = 0;
constexpr size_t O_ROPE  = O_MOD + al256((size_t)2 * 3 * 6144 * 4);
constexpr size_t O_XA    = O_ROPE + (size_t)SEQ * 48 * 8;
constexpr size_t O_H     = O_XA + (size_t)T * DM * 4;
constexpr size_t O_WINT  = O_H + (size_t)T * LDH * 2;
constexpr size_t O_WOUTT = O_WINT + (size_t)NIN * LDW * 2;
constexpr size_t O_WUQT  = O_WOUTT + (size_t)1024 * LDW * 2;
constexpr size_t O_WUKVT = O_WUQT + (size_t)384 * 192 * 2;
constexpr size_t O_WGUT  = O_WUKVT + (size_t)512 * 128 * 2;
constexpr size_t O_WDT   = O_WGUT + (size_t)65 * 512 * LDW * 2;
constexpr size_t O_WTS   = O_WDT + (size_t)65 * 1024 * 256 * 2;
constexpr size_t O_CNT   = O_WTS + al256((size_t)NSLOT * 4);
constexpr size_t O_TAB   = O_CNT + 256;
constexpr size_t O_BAR   = O_TAB + 512;
constexpr size_t O_XBAR  = O_BAR + 256;
constexpr size_t O_LIST  = O_XBAR + 16384;
constexpr size_t O_R     = O_LIST + (size_t)NE * T * 4;
constexpr size_t O_Y     = O_R;
constexpr size_t O_PP    = O_Y + (size_t)T * DM * 2;
constexpr size_t O_QA    = O_PP + (size_t)T * LDPP * 2;
constexpr size_t O_KA    = O_QA + (size_t)2 * 4 * NKEY * 64 * 2;
constexpr size_t O_VTA   = O_KA + (size_t)2 * 2 * NKEY * 64 * 2;
constexpr size_t O_QB    = O_VTA + (size_t)2 * 2 * NKEY * 64 * 2;
constexpr size_t O_KB    = O_QB + (size_t)2 * 8 * NKEY * 32 * 2;
constexpr size_t O_VTB   = O_KB + (size_t)2 * 8 * NKEY * 32 * 2;
constexpr size_t O_QC    = O_VTB + (size_t)2 * 4 * NKEY * 64 * 2;
constexpr size_t O_KC    = O_QC + (size_t)2 * 4 * NKEY * 96 * 2;
constexpr size_t O_VTC   = O_KC + (size_t)2 * 4 * NKEY * 96 * 2;
constexpr size_t O_CQN   = O_VTC + (size_t)2 * 4 * NKEY * 64 * 2;
constexpr size_t O_CKVN  = O_CQN + (size_t)T * 192 * 2;
constexpr size_t O_OB    = O_CKVN + (size_t)T * 128 * 2;
constexpr size_t O_GQ    = O_OB + (size_t)T * 512 * 2;
constexpr size_t O_GK    = O_GQ + (size_t)T * 256 * 2;
constexpr size_t O_GV    = O_GK + (size_t)T * 256 * 2;
constexpr size_t O_GG    = O_GV + (size_t)T * 256 * 2;
constexpr size_t O_GBETA = O_GG + (size_t)2 * T * 4 * 4;
constexpr size_t O_GM    = O_GBETA + (size_t)2 * T * 4 * 4;
constexpr size_t O_GQP   = O_GM + (size_t)NGITEM * 4096 * 2;
constexpr size_t O_GN    = O_GQP + (size_t)NGITEM * 4096 * 2;
constexpr size_t O_GLO   = O_GN + (size_t)NGITEM * 4096 * 2;
constexpr size_t O_GO    = O_GLO + (size_t)NGITEM * 4096 * 2;
constexpr size_t O_MIX_END = O_GO + (size_t)2 * T * 256 * 4;
constexpr size_t O_HB    = O_R;
constexpr size_t O_SLOT  = O_HB + (size_t)7 * T * 256 * 2;
constexpr size_t O_SLOTSC = O_SLOT + (size_t)7 * T * 1024;
constexpr size_t O_MOE_END = O_SLOTSC + (size_t)7 * T * 16 * 4;
constexpr size_t cmax(size_t a, size_t b) { return a > b ? a : b; }
constexpr size_t WS_NEED = cmax(O_MIX_END, O_MOE_END);
static_assert(WS_NEED < (size_t)556000000, "workspace too large");

struct KArgs {
  const float* in[35];
  float* out;
  char* ws;
};
typedef const __attribute__((address_space(1))) float gcfloat;
struct Params {
  char* ws;
  float* out;
  gcfloat* const* in;
  int tid;
};
#define pin(p, i) ((const float*)(p).in[i])
enum { I_X = 0, I_C, I_CTX, I_CCTX, I_WADA, I_BADA, I_N1G, I_N2G, I_WIN, I_WOUT, I_SINK, I_LQ1, I_LK1, I_LQ2, I_LK2,
       I_DNG, I_MQG, I_MKVG, I_WUQ, I_WUKV, I_CONVW, I_ALF, I_ALB, I_DTF, I_DTB, I_GNG, I_WR, I_RB, I_WG, I_WU, I_WD,
       I_SG, I_SU, I_SD, I_FNG };

DEVI float bf2f(u16 h) { return __uint_as_float(((unsigned)h) << 16); }
DEVI float bflo(unsigned v) { return __uint_as_float(v << 16); }
DEVI float bfhi(unsigned v) { return __uint_as_float(v & 0xffff0000u); }
DEVI unsigned pack2(float a, float b) { f32x2 v = {a, b}; return __builtin_bit_cast(unsigned, __builtin_convertvector(v, bf16x2_t)); }
DEVI u16 f2bf(float f) { return (u16)pack2(f, f); }
DEVI f32x4 fzero4() { float z = 0.f; asm volatile("" : "+v"(z)); return f32x4{z, z, z, z}; }
DEVI float wave_sum(float v) {
#pragma unroll
  for (int o = 32; o >= 1; o >>= 1) v += __shfl_xor(v, o);
  return v;
}
DEVI float half_sum(float v) {
#pragma unroll
  for (int o = 16; o >= 1; o >>= 1) v += __shfl_xor(v, o);
  return v;
}
DEVI float siluf(float x) { return x * __builtin_amdgcn_rcpf(1.f + __expf(-x)); }
DEVI float sigmf(float x) { return __builtin_amdgcn_rcpf(1.f + __expf(-x)); }
DEVI int tok_mv(int t) { return t < TL ? (t >> 13) : 2; }
DEVI int tok_b(int t) { return t < TL ? (t >> 13) : ((t - TL) >> 8); }
DEVI int tok_row(int t) { return t < TL ? (t & (SEQ - 1)) : (SEQ + ((t - TL) & (CTXL - 1))); }
DEVI const float* modp(const Params& p, int l, int mv, int j) { return (const float*)(p.ws + O_MOD) + ((size_t)(l * 3 + mv) * 6 + j) * 1024; }

#define MFMA16(a, b, c) __builtin_amdgcn_mfma_f32_16x16x32_bf16((a), (b), (c), 0, 0, 0)
#define MFMA32(a, b, c) __builtin_amdgcn_mfma_f32_32x32x16_bf16((a), (b), (c), 0, 0, 0)

DEVI void st_copy_in(const Params& p, int vb, int nvb) {
  float4* xa = (float4*)(p.ws + O_XA);
  const float4* x = (const float4*)pin(p, I_X);
  const float4* cx = (const float4*)pin(p, I_CTX);
  const size_t n4 = (size_t)T * DM / 4, nl4 = (size_t)TL * DM / 4;
  for (size_t i = (size_t)vb * 256 + p.tid; i < n4; i += (size_t)nvb * 256) xa[i] = i < nl4 ? x[i] : cx[i - nl4];
}
DEVI void rope_cs(int i, int half, int s, float& c, float& sn) {
  const int quarter = half >> 1;
  const int ii = i < quarter ? i : i - quarter;
  const float pos = i < quarter ? (float)(s >> 6) : (float)(s & 63);
  const float inv = powf(10000.f, -(float)ii / (float)quarter);
  const float ang = pos * inv;
  c = cosf(ang); sn = sinf(ang);
}
DEVI void st_rope_table(const Params& p, int vb, int nvb) {
  f32x2* R = (f32x2*)(p.ws + O_ROPE);
  for (int e = vb * 256 + p.tid; e < SEQ * 48; e += nvb * 256) {
    const int s = e / 48, i = e % 48;
    float c, sn;
    if (i < 32) rope_cs(i, 32, s, c, sn); else rope_cs(i - 32, 16, s, c, sn);
    R[e] = f32x2{c, sn};
  }
}
DEVI void st_mod(const Params& p, int vb, int nvb, char* smem) {
  float* sv = (float*)smem;
  float* red = sv + 3 * 1024;
  for (int i = p.tid; i < 3 * 1024; i += 256) {
    int v = i >> 10, k = i & 1023;
    float c = v < 2 ? pin(p, I_C)[v * 1024 + k] : pin(p, I_CCTX)[k];
    sv[i] = siluf(c);
  }
  __syncthreads();
  const int cgp = p.tid & 7, kg = p.tid >> 3;
  for (int item = vb; item < 2 * 192; item += nvb) {
    const int l = item / 192, c0 = (item % 192) * 32;
    const float* w = pin(p, I_WADA) + (size_t)l * 1024 * 6144 + c0 + cgp * 4;
    f32x4 a0 = fzero4(), a1 = a0, a2 = a0;
#pragma unroll 8
    for (int kk = 0; kk < 32; ++kk) {
      const int k = kg * 32 + kk;
      const f32x4 wv = *(const f32x4*)(w + (size_t)k * 6144);
      a0 += sv[k] * wv; a1 += sv[1024 + k] * wv; a2 += sv[2048 + k] * wv;
    }
    float* rp = red + (kg * 8 + cgp) * 12;
    *(f32x4*)rp = a0; *(f32x4*)(rp + 4) = a1; *(f32x4*)(rp + 8) = a2;
    __syncthreads();
    if (p.tid < 96) {
      const int v = p.tid >> 5, c = p.tid & 31;
      float s = 0.f;
#pragma unroll 8
      for (int g = 0; g < 32; ++g) s += red[(g * 8 + (c >> 2)) * 12 + v * 4 + (c & 3)];
      ((float*)(p.ws + O_MOD))[(size_t)(l * 3 + v) * 6144 + c0 + c] = s + pin(p, I_BADA)[l * 6144 + c0 + c];
    }
    __syncthreads();
  }
}

template <class RowFn>
DEVI void tr_tile(int tid, const float* __restrict__ src, int N, u16* __restrict__ dst, int ldd, RowFn drow, int k0, int n0, float* tile) {
  {
    const int kq = tid >> 4, n4 = (tid & 15) * 4;
    f32x4 v[4];
#pragma unroll
    for (int r = 0; r < 4; ++r) {
      const int k = r * 16 + kq;
      v[r] = n0 + n4 < N ? *(const f32x4*)(src + (size_t)(k0 + k) * N + n0 + n4) : fzero4();
    }
#pragma unroll
    for (int r = 0; r < 4; ++r) {
      const int k = r * 16 + kq;
      tile[k * 65 + n4] = v[r][0]; tile[k * 65 + n4 + 1] = v[r][1]; tile[k * 65 + n4 + 2] = v[r][2]; tile[k * 65 + n4 + 3] = v[r][3];
    }
  }
  __syncthreads();
  {
    const int n = tid >> 2, kc = (tid & 3) * 16;
    const int dr = drow(n0 + n);
    if (dr >= 0) {
      u32x4 o0, o1;
#pragma unroll
      for (int e = 0; e < 4; ++e) {
        o0[e] = pack2(tile[(kc + 2 * e) * 65 + n], tile[(kc + 2 * e + 1) * 65 + n]);
        o1[e] = pack2(tile[(kc + 8 + 2 * e) * 65 + n], tile[(kc + 8 + 2 * e + 1) * 65 + n]);
      }
      u16* d = dst + (size_t)dr * ldd + k0 + kc;
      *(u32x4*)d = o0; *(u32x4*)(d + 8) = o1;
    }
  }
  __syncthreads();
}
DEVI int win_row(int n) {
  if (n < 1280) return n;
  if (n < 1600) return 1408 + (n - 1280);
  if (n < 1632) return 1280 + (n - 1600);
  if (n < INW) return 1408 + 320 + (n - 1632);
  return -1;
}
constexpr int TR_IN = 16 * 42, TR_OUT = 256, TR_UQ = 18, TR_UKV = 16, TR_E = 4096, TR_S = 64;
constexpr int TR_P1 = TR_IN + TR_OUT + TR_UQ + TR_UKV;
constexpr int TR_P2 = 3 * TR_E + 3 * TR_S;
DEVI void prep_w1_tile(const Params& p, int l, int it, float* tile) {
  if (it < TR_IN) { tr_tile(p.tid, pin(p, I_WIN) + (size_t)l * 1024 * INW, INW, (u16*)(p.ws + O_WINT), LDW, [](int n) { return win_row(n); }, (it / 42) * 64, (it % 42) * 64, tile); return; }
  it -= TR_IN;
  if (it < TR_OUT) { tr_tile(p.tid, pin(p, I_WOUT) + (size_t)l * 1024 * 1024, 1024, (u16*)(p.ws + O_WOUTT), LDW, [](int n) { return n; }, (it / 16) * 64, (it % 16) * 64, tile); return; }
  it -= TR_OUT;
  if (it < TR_UQ) { tr_tile(p.tid, pin(p, I_WUQ) + (size_t)l * 192 * 384, 384, (u16*)(p.ws + O_WUQT), 192, [](int n) { return n; }, (it / 6) * 64, (it % 6) * 64, tile); return; }
  it -= TR_UQ;
  tr_tile(p.tid, pin(p, I_WUKV) + (size_t)l * 128 * 512, 512, (u16*)(p.ws + O_WUKVT), 128,
          [](int n) { const int h = n >> 7, j = n & 127; return j < 64 ? h * 64 + j : 256 + h * 64 + (j - 64); }, (it / 8) * 64, (it % 8) * 64, tile);
}
DEVI void prep_w2_tile(const Params& p, int l, int it, float* tile) {
  if (it < 2 * TR_E) {
    const int which = it / TR_E; it %= TR_E;
    const int e = it >> 6, tt = it & 63;
    const float* src = pin(p, which ? I_WU : I_WG) + ((size_t)l * NE + e) * 1024 * 256;
    tr_tile(p.tid, src, 256, (u16*)(p.ws + O_WGUT) + (size_t)e * 512 * LDW, LDW, [which](int n) { return 2 * n + which; }, (tt >> 2) * 64, (tt & 3) * 64, tile); return;
  }
  it -= 2 * TR_E;
  if (it < TR_E) {
    const int e = it >> 6, tt = it & 63;
    const float* src = pin(p, I_WD) + ((size_t)l * NE + e) * 256 * 1024;
    tr_tile(p.tid, src, 1024, (u16*)(p.ws + O_WDT) + (size_t)e * 1024 * 256, 256, [](int n) { return n; }, (tt >> 4) * 64, (tt & 15) * 64, tile); return;
  }
  it -= TR_E;
  if (it < 2 * TR_S) {
    const int which = it / TR_S; const int tt = it % TR_S;
    const float* src = pin(p, which ? I_SU : I_SG) + (size_t)l * 1024 * 256;
    tr_tile(p.tid, src, 256, (u16*)(p.ws + O_WGUT) + (size_t)64 * 512 * LDW, LDW, [which](int n) { return 2 * n + which; }, (tt >> 2) * 64, (tt & 3) * 64, tile); return;
  }
  it -= 2 * TR_S;
  { const int tt = it;
    const float* src = pin(p, I_SD) + (size_t)l * 256 * 1024;
    tr_tile(p.tid, src, 1024, (u16*)(p.ws + O_WDT) + (size_t)64 * 1024 * 256, 256, [](int n) { return n; }, (tt >> 4) * 64, (tt & 15) * 64, tile); }
}
struct TrDesc { const float* src; u16* dst; int N, ldd, rs, ro, k0, n0; };
DEVI TrDesc w2_desc(const Params& p, int l, int it) {
  TrDesc d;
  if (it < 2 * TR_E) {
    const int which = it / TR_E; it %= TR_E;
    const int e = it >> 6, tt = it & 63;
    d.src = pin(p, which ? I_WU : I_WG) + ((size_t)l * NE + e) * 1024 * 256; d.N = 256;
    d.dst = (u16*)(p.ws + O_WGUT) + (size_t)e * 512 * LDW; d.ldd = LDW; d.rs = 2; d.ro = which; d.k0 = (tt >> 2) * 64; d.n0 = (tt & 3) * 64;
    return d;
  }
  it -= 2 * TR_E;
  if (it < TR_E) {
    const int e = it >> 6, tt = it & 63;
    d.src = pin(p, I_WD) + ((size_t)l * NE + e) * 256 * 1024; d.N = 1024;
    d.dst = (u16*)(p.ws + O_WDT) + (size_t)e * 1024 * 256; d.ldd = 256; d.rs = 1; d.ro = 0; d.k0 = (tt >> 4) * 64; d.n0 = (tt & 15) * 64;
    return d;
  }
  it -= TR_E;
  if (it < 2 * TR_S) {
    const int which = it / TR_S; const int tt = it % TR_S;
    d.src = pin(p, which ? I_SU : I_SG) + (size_t)l * 1024 * 256; d.N = 256;
    d.dst = (u16*)(p.ws + O_WGUT) + (size_t)64 * 512 * LDW; d.ldd = LDW; d.rs = 2; d.ro = which; d.k0 = (tt >> 2) * 64; d.n0 = (tt & 3) * 64;
    return d;
  }
  it -= 2 * TR_S;
  d.src = pin(p, I_SD) + (size_t)l * 256 * 1024; d.N = 1024;
  d.dst = (u16*)(p.ws + O_WDT) + (size_t)64 * 1024 * 256; d.ldd = 256; d.rs = 1; d.ro = 0; d.k0 = (it >> 4) * 64; d.n0 = (it & 15) * 64;
  return d;
}
DEVI void tr_load(int tid, const TrDesc& d, f32x4 (&v)[4]) {
  const int kq = tid >> 4, n4 = (tid & 15) * 4;
#pragma unroll
  for (int r = 0; r < 4; ++r) v[r] = *(const f32x4*)(d.src + (size_t)(d.k0 + r * 16 + kq) * d.N + d.n0 + n4);
}
DEVI void tr_process(int tid, const TrDesc& d, const f32x4 (&v)[4], float* tile) {
  {
    const int kq = tid >> 4, n4 = (tid & 15) * 4;
#pragma unroll
    for (int r = 0; r < 4; ++r) {
      const int k = r * 16 + kq;
      tile[k * 65 + n4] = v[r][0]; tile[k * 65 + n4 + 1] = v[r][1]; tile[k * 65 + n4 + 2] = v[r][2]; tile[k * 65 + n4 + 3] = v[r][3];
    }
  }
  __syncthreads();
  {
    const int n = tid >> 2, kc = (tid & 3) * 16;
    u32x4 o0, o1;
#pragma unroll
    for (int e = 0; e < 4; ++e) {
      o0[e] = pack2(tile[(kc + 2 * e) * 65 + n], tile[(kc + 2 * e + 1) * 65 + n]);
      o1[e] = pack2(tile[(kc + 8 + 2 * e) * 65 + n], tile[(kc + 8 + 2 * e + 1) * 65 + n]);
    }
    u16* o = d.dst + (size_t)((d.n0 + n) * d.rs + d.ro) * d.ldd + d.k0 + kc;
    *(u32x4*)o = o0; *(u32x4*)(o + 8) = o1;
  }
  __syncthreads();
}
DEVI void prep_w2_run8(const Params& p, int l, int it0, float* tile) {
  f32x4 va[4], vb4[4];
  TrDesc da = w2_desc(p, l, it0), db = da;
  __syncthreads();
  tr_load(p.tid, da, va);
#pragma unroll 1
  for (int k = 0; k < 8; k += 2) {
    db = w2_desc(p, l, it0 + k + 1);
    tr_load(p.tid, db, vb4);
    tr_process(p.tid, da, va, tile);
    if (k + 2 < 8) { da = w2_desc(p, l, it0 + k + 2); tr_load(p.tid, da, va); }
    tr_process(p.tid, db, vb4, tile);
  }
}
DEVI void st_prep_w1(const Params& p, int l, int vb, int nvb, char* smem) {
  float* tile = (float*)smem;
  if (vb == 0 && p.tid < 64) ((int*)(p.ws + O_CNT))[p.tid] = 0;
  for (int e = vb * 256 + p.tid; e < 144 * 128; e += nvb * 256) {
    const int r = e >> 7, c8 = e & 127;
    const int row = r < 96 ? 1312 + r : 2768 + (r - 96);
    *(u32x4*)((u16*)(p.ws + O_WINT) + (size_t)row * LDW + c8 * 8) = __builtin_bit_cast(u32x4, fzero4());
  }
  for (int item = vb; item < TR_P1; item += nvb) prep_w1_tile(p, l, item, tile);
}

DEVI void st_norm1(const Params& p, int l, int vb, int nvb) {
  const int lane = p.tid & 63, wid = p.tid >> 6;
  const float* g = pin(p, I_N1G) + l * 1024;
  for (int t4 = (vb * 4 + wid) * 4; t4 < T; t4 += nvb * 16) {
    const int mv = tok_mv(t4);
    const float* sh = modp(p, l, mv, 0); const float* sc = modp(p, l, mv, 1);
    f32x4 v[4][4]; float ss[4];
#pragma unroll
    for (int u = 0; u < 4; ++u) {
      const int t = t4 + u;
      const f32x4* xr = (const f32x4*)(t < TL ? pin(p, I_X) + (size_t)t * 1024 : pin(p, I_CTX) + (size_t)(t - TL) * 1024);
#pragma unroll
      for (int i = 0; i < 4; ++i) v[u][i] = xr[i * 64 + lane];
    }
#pragma unroll
    for (int u = 0; u < 4; ++u) {
      float a = 0.f;
#pragma unroll
      for (int i = 0; i < 4; ++i) a += v[u][i][0] * v[u][i][0] + v[u][i][1] * v[u][i][1] + v[u][i][2] * v[u][i][2] + v[u][i][3] * v[u][i][3];
      ss[u] = a;
    }
#pragma unroll
    for (int o = 32; o >= 1; o >>= 1) {
#pragma unroll
      for (int u = 0; u < 4; ++u) ss[u] += __shfl_xor(ss[u], o);
    }
#pragma unroll
    for (int i = 0; i < 4; ++i) {
      const int c = i * 256 + lane * 4;
      const f32x4 gg = *(const f32x4*)(g + c), s4 = *(const f32x4*)(sc + c), h4 = *(const f32x4*)(sh + c);
      const f32x4 gs = gg * (1.f + s4);
#pragma unroll
      for (int u = 0; u < 4; ++u) {
        const float rstd = rsqrtf(ss[u] * (1.f / 1024.f) + 1e-6f);
        const f32x4 o = v[u][i] * rstd * gs + h4;
        u32x2 pk; pk[0] = pack2(o[0], o[1]); pk[1] = pack2(o[2], o[3]);
        *(u32x2*)((u16*)(p.ws + O_H) + (size_t)(t4 + u) * LDH + c) = pk;
      }
    }
  }
}

constexpr int GLD = 72;
typedef const __attribute__((address_space(1))) unsigned gcu32;
typedef __attribute__((address_space(3))) unsigned lu32;
DEVI int bperm_row(int BP, int n, int fr) {
  return BP == 0 ? n * 16 + fr : BP == 1 ? (n >> 1) * 32 + (fr >> 2) * 8 + (n & 1) * 4 + (fr & 3) : (fr >> 2) * 16 + n * 4 + (fr & 3);
}
DEVI int bperm_swz(int BP, int R) { return BP == 0 ? (R & 7) : BP == 1 ? ((R & 3) | ((R >> 1) & 4)) : ((R & 3) | ((R >> 2) & 4)); }
template <bool SWAP, int BP = 0, bool AP = false, class ARow>
DEVI void gemm_core(int tid, ARow arow, const u16* __restrict__ Bt, int ldb, int K, f32x4 (&acc)[4][4], char* smem) {
  constexpr int TILE = 128 * 64;
  u16* sbuf = (u16*)smem;
  const int lane = tid & 63, wid = tid >> 6, wr = wid >> 1, wc = wid & 1, fr = lane & 15, fq = lane >> 4;
  const u16* ap[4]; const u16* bp[4];
#pragma unroll
  for (int i = 0; i < 4; ++i) {
    const int q = tid + 256 * i, row = q >> 3, cs = (q & 7) ^ (row & 7), csb = (q & 7) ^ bperm_swz(BP, row);
    ap[i] = arow(row) + cs * 8; bp[i] = Bt + (size_t)row * ldb + csb * 8;
  }
  const int nk = K >> 6;
  auto stage = [&](int kt, int buf) {
    int off = kt * 64; asm volatile("" : "+s"(off));
    u16* dA = sbuf + buf * 2 * TILE + tid * 8; u16* dB = dA + TILE;
#pragma unroll
    for (int i = 0; i < 4; ++i) {
      __builtin_amdgcn_global_load_lds((gcu32*)(ap[i] + off), (lu32*)(dA + i * 2048), 16, 0, 0);
      __builtin_amdgcn_global_load_lds((gcu32*)(bp[i] + off), (lu32*)(dB + i * 2048), 16, 0, 0);
    }
  };
  auto compute = [&](int buf) {
    const u16* sA = sbuf + buf * 2 * TILE; const u16* sB = sA + TILE;
    bf16x8 af[2][4], bfr[2][4];
#pragma unroll
    for (int ks = 0; ks < 2; ++ks) {
#pragma unroll
      for (int m = 0; m < 4; ++m) {
        int R = wr * 64 + m * 16 + fr;
        if (AP) { const int pos = (m >> 1) * 32 + (fr >> 2) * 8 + (m & 1) * 4 + (fr & 3), j = (pos >> 2) & 3; R = wr * 64 + ((pos & ~15) | ((((j & 1) << 1) | (j >> 1)) << 2) | (pos & 3)); }
        af[ks][m] = *(const bf16x8*)&sA[R * 64 + (((ks * 4 + fq) ^ (R & 7)) << 3)];
      }
#pragma unroll
      for (int n = 0; n < 4; ++n) { const int R = wc * 64 + bperm_row(BP, n, fr); bfr[ks][n] = *(const bf16x8*)&sB[R * 64 + (((ks * 4 + fq) ^ bperm_swz(BP, R)) << 3)]; }
    }
    __builtin_amdgcn_sched_barrier(0);
#pragma unroll
    for (int ks = 0; ks < 2; ++ks) {
#pragma unroll
      for (int m = 0; m < 4; ++m)
#pragma unroll
        for (int n = 0; n < 4; ++n) acc[m][n] = SWAP ? MFMA16(af[ks][m], bfr[ks][n], acc[m][n]) : MFMA16(bfr[ks][n], af[ks][m], acc[m][n]);
      __builtin_amdgcn_sched_barrier(0);
    }
  };
#pragma unroll
  for (int m = 0; m < 4; ++m)
#pragma unroll
    for (int n = 0; n < 4; ++n) acc[m][n] = fzero4();
  __syncthreads();
  stage(0, 0);
  asm volatile("s_waitcnt vmcnt(0)" ::: "memory");
  __syncthreads();
  for (int kt = 0; kt < nk; ++kt) {
    if (kt + 1 < nk) stage(kt + 1, (kt + 1) & 1);
    compute(kt & 1);
    asm volatile("s_waitcnt vmcnt(0)" ::: "memory");
    __syncthreads();
  }
}
template <class ARow, class Epi>
DEVI void gemm128(int tid, ARow arow, const u16* __restrict__ Bt, int ldb, int K, Epi epi, char* smem) {
  f32x4 acc[4][4];
  gemm_core<false>(tid, arow, Bt, ldb, K, acc, smem);
  const int lane = tid & 63, wid = tid >> 6, wr = wid >> 1, wc = wid & 1, fr = lane & 15, fq = lane >> 4;
#pragma unroll
  for (int m = 0; m < 4; ++m)
#pragma unroll
    for (int n = 0; n < 4; ++n) epi(wr * 64 + m * 16 + fr, wc * 64 + n * 16 + fq * 4, acc[m][n]);
}

DEVI void rope4(const f32x4 x1, const f32x4 x2, const f32x2* rp, bool lat, float scale, u32x2& o1, u32x2& o2) {
  f32x4 s = fzero4(), c = s + 1.f;
  if (lat) {
    const f32x4 a = *(const f32x4*)rp, b = *(const f32x4*)(rp + 2);
    c = f32x4{a[0], a[2], b[0], b[2]}; s = f32x4{a[1], a[3], b[1], b[3]};
  }
  const f32x4 y1 = (x1 * c - x2 * s) * scale, y2 = (x2 * c + x1 * s) * scale;
  o1[0] = pack2(y1[0], y1[1]); o1[1] = pack2(y1[2], y1[3]);
  o2[0] = pack2(y2[0], y2[1]); o2[1] = pack2(y2[2], y2[3]);
}
DEVI void inproj_item(const Params& p, int item, char* smem) {
  const u16* H = (const u16*)(p.ws + O_H); const u16* W = (const u16*)(p.ws + O_WINT);
  const f32x2* ROPE = (const f32x2*)(p.ws + O_ROPE);
  const int tid = p.tid, lane = tid & 63, wid = tid >> 6, wr = wid >> 1, wc = wid & 1, fr = lane & 15, fq = lane >> 4;
  {
    const int m0 = (item / 22) * 128, nt = item % 22;
    const bool lat = m0 < TL;
    const int b = tok_b(m0), rowbase = tok_row(m0);
    f32x4 acc[4][4];
    auto arow = [&](int r) { return H + (size_t)(m0 + r) * LDH; };
    if (nt == 3 || nt == 8 || nt == 9) {
      gemm_core<true, 0, true>(tid, arow, W + (size_t)nt * 128 * LDW, LDW, 1024, acc, smem);
      u16* vt = nt == 3 ? (u16*)(p.ws + O_VTA) + (size_t)(b * 2 + wc) * 64 * NKEY
                        : (u16*)(p.ws + O_VTB) + (size_t)(b * 4 + (nt - 8) * 2 + wc) * 64 * NKEY;
#pragma unroll
      for (int mh = 0; mh < 2; ++mh)
#pragma unroll
        for (int n = 0; n < 4; ++n) {
          u32x4 pk;
          pk[0] = pack2(acc[2 * mh][n][0], acc[2 * mh][n][1]); pk[1] = pack2(acc[2 * mh][n][2], acc[2 * mh][n][3]);
          pk[2] = pack2(acc[2 * mh + 1][n][0], acc[2 * mh + 1][n][1]); pk[3] = pack2(acc[2 * mh + 1][n][2], acc[2 * mh + 1][n][3]);
          *(u32x4*)(vt + (size_t)(n * 16 + fr) * NKEY + rowbase + wr * 64 + mh * 32 + fq * 8) = pk;
        }
      return;
    }
    if (nt < 3 || nt >= 11) gemm_core<false, 1>(tid, arow, W + (size_t)nt * 128 * LDW, LDW, 1024, acc, smem);
    else gemm_core<false>(tid, arow, W + (size_t)nt * 128 * LDW, LDW, 1024, acc, smem);
    if (nt < 3) {
      u16* dst; float scale;
      if (nt < 2) { dst = (u16*)(p.ws + O_QA) + ((size_t)(b * 4 + nt * 2 + wc) * NKEY + rowbase) * 64; scale = 0.125f * LOG2E; }
      else { dst = (u16*)(p.ws + O_KA) + ((size_t)(b * 2 + wc) * NKEY + rowbase) * 64; scale = 1.f; }
#pragma unroll
      for (int m = 0; m < 4; ++m) {
        const int rl = wr * 64 + m * 16 + fr;
        u32x2 a1, a2, b1, b2;
        rope4(acc[m][0], acc[m][2], ROPE + (size_t)(rowbase + rl) * 48 + fq * 8, lat, scale, a1, a2);
        rope4(acc[m][1], acc[m][3], ROPE + (size_t)(rowbase + rl) * 48 + fq * 8 + 4, lat, scale, b1, b2);
        *(u32x4*)(dst + (size_t)rl * 64 + fq * 8) = u32x4{a1[0], a1[1], b1[0], b1[1]};
        *(u32x4*)(dst + (size_t)rl * 64 + 32 + fq * 8) = u32x4{a2[0], a2[1], b2[0], b2[1]};
      }
    } else if (nt < 8) {
      const bool isq = nt < 6;
      u16* base = isq ? (u16*)(p.ws + O_QB) : (u16*)(p.ws + O_KB);
      const float scale = isq ? 0.17677669529663687f * LOG2E : 1.f;
      const int hm0 = ((nt - 4) & 1) * 4 + wc * 2;
#pragma unroll
      for (int m = 0; m < 4; ++m) {
        const int rl = wr * 64 + m * 16 + fr;
#pragma unroll
        for (int g = 0; g < 2; ++g) {
          u16* dst = base + ((size_t)(b * 8 + hm0 + g) * NKEY + rowbase + rl) * 32;
          u32x2 o1, o2;
          rope4(acc[m][2 * g], acc[m][2 * g + 1], ROPE + (size_t)(rowbase + rl) * 48 + 32 + fq * 4, lat, scale, o1, o2);
          *(u32x2*)(dst + fq * 4) = o1; *(u32x2*)(dst + 16 + fq * 4) = o2;
        }
      }
    } else if (nt == 10) {
      if (wc == 0) {
#pragma unroll
        for (int m = 0; m < 4; ++m) {
          const int rl = wr * 64 + m * 16 + fr;
          u32x2 o1, o2;
          rope4(acc[m][0], acc[m][1], ROPE + (size_t)(rowbase + rl) * 48 + 32 + fq * 4, lat, 1.f, o1, o2);
#pragma unroll
          for (int h = 0; h < 4; ++h) {
            u16* dst = (u16*)(p.ws + O_KC) + ((size_t)(b * 4 + h) * NKEY + rowbase + rl) * 96 + 64;
            *(u32x2*)(dst + fq * 4) = o1; *(u32x2*)(dst + 16 + fq * 4) = o2;
          }
        }
      }
    } else {
      u16* PP = (u16*)(p.ws + O_PP);
#pragma unroll
      for (int m = 0; m < 4; ++m)
#pragma unroll
        for (int h = 0; h < 2; ++h) {
          u32x4 pk;
          pk[0] = pack2(acc[m][2 * h][0], acc[m][2 * h][1]); pk[1] = pack2(acc[m][2 * h][2], acc[m][2 * h][3]);
          pk[2] = pack2(acc[m][2 * h + 1][0], acc[m][2 * h + 1][1]); pk[3] = pack2(acc[m][2 * h + 1][2], acc[m][2 * h + 1][3]);
          *(u32x4*)(PP + (size_t)(m0 + wr * 64 + m * 16 + fr) * LDPP + (nt - 11) * 128 + wc * 64 + h * 32 + fq * 8) = pk;
        }
    }
  }
}

DEVI void st_tokprep(const Params& p, int l, int vb, int nvb) {
  const int lane = p.tid & 63, wid = p.tid >> 6;
  const u16* PP = (const u16*)(p.ws + O_PP);
  u16* GQ = (u16*)(p.ws + O_GQ); u16* GK = (u16*)(p.ws + O_GK); u16* GV = (u16*)(p.ws + O_GV);
  float* GG = (float*)(p.ws + O_GG); float* GB = (float*)(p.ws + O_GBETA);
  u16* CQN = (u16*)(p.ws + O_CQN); u16* CKVN = (u16*)(p.ws + O_CKVN);
  const float* cwp = pin(p, I_CONVW) + (size_t)l * 5 * 768;
  f32x2 cw[6][5];
#pragma unroll
  for (int i = 0; i < 6; ++i)
#pragma unroll
    for (int j = 0; j < 5; ++j) cw[i][j] = *(const f32x2*)(cwp + j * 768 + 2 * lane + 128 * i);
  const float* gq = pin(p, I_MQG) + l * 192; const float* gkv = pin(p, I_MKVG) + l * 128;
  const float gq0 = gq[lane], gq1 = gq[64 + lane], gq2 = gq[128 + lane], gk0 = gkv[lane], gk1 = gkv[64 + lane];
  struct TokIn { unsigned xin[5][6]; float q0, q1, q2, k0, k1, gate_in; };
  auto load = [&](int t, TokIn& f) {
    int base, pos, len;
    if (t < TL) { base = t & ~(SEQ - 1); pos = t & (SEQ - 1); len = SEQ; } else { int j = t - TL; base = TL + (j & ~(CTXL - 1)); pos = j & (CTXL - 1); len = CTXL; }
#pragma unroll
    for (int j = 0; j < 5; ++j) {
      const int pp = pos + j - 2;
      const bool ok = pp >= 0 && pp < len;
      const u16* row = PP + (size_t)(base + (ok ? pp : pos)) * LDPP + PP_DQKV + 2 * lane;
#pragma unroll
      for (int i = 0; i < 6; ++i) { unsigned v = *(const unsigned*)(row + 128 * i); f.xin[j][i] = ok ? v : 0u; }
    }
    const u16* pr = PP + (size_t)t * LDPP;
    f.q0 = bf2f(pr[PP_CQ + lane]); f.q1 = bf2f(pr[PP_CQ + 64 + lane]); f.q2 = bf2f(pr[PP_CQ + 128 + lane]);
    f.k0 = bf2f(pr[PP_CKV + lane]); f.k1 = bf2f(pr[PP_CKV + 64 + lane]);
    f.gate_in = lane < 16 ? bf2f(pr[PP_GATE + lane]) : 0.f;
  };
  auto process = [&](int t, const TokIn& f) {
    const float q0 = f.q0, q1 = f.q1, q2 = f.q2, k0 = f.k0, k1 = f.k1, gate_in = f.gate_in;
#pragma unroll
    for (int i = 0; i < 6; ++i) {
      float a0 = 0.f, a1 = 0.f;
#pragma unroll
      for (int j = 0; j < 5; ++j) { a0 += cw[i][j][0] * bflo(f.xin[j][i]); a1 += cw[i][j][1] * bfhi(f.xin[j][i]); }
      float y0 = siluf(a0), y1 = siluf(a1);
      const int c = 2 * lane + 128 * i;
      if (i < 4) {
        const float ss = half_sum(y0 * y0 + y1 * y1);
        const float r = rsqrtf(ss + 1e-6f) * (i < 2 ? 0.125f : 1.f);
        u16* dst = i < 2 ? GQ + (size_t)t * 256 + c : GK + (size_t)t * 256 + (c - 256);
        *(unsigned*)dst = pack2(y0 * r, y1 * r);
      } else *(unsigned*)(GV + (size_t)t * 256 + (c - 512)) = pack2(y0, y1);
    }
    if (lane < 16) {
      const int which = lane >> 2, hd = lane & 3;
      if (which < 2) {
        const float al = which ? pin(p, I_ALB)[l * 4 + hd] : pin(p, I_ALF)[l * 4 + hd];
        const float dt = which ? pin(p, I_DTB)[l * 4 + hd] : pin(p, I_DTF)[l * 4 + hd];
        const float xx = gate_in + dt;
        const float sp = fmaxf(xx, 0.f) + __logf(1.f + __expf(-fabsf(xx)));
        GG[((size_t)which * T + t) * 4 + hd] = -__expf(al) * sp;
      } else GB[((size_t)(which - 2) * T + t) * 4 + hd] = sigmf(gate_in);
    }
    {
      float ss = q0 * q0 + q1 * q1 + q2 * q2, s2 = k0 * k0 + k1 * k1;
#pragma unroll
      for (int o = 32; o >= 1; o >>= 1) { ss += __shfl_xor(ss, o); s2 += __shfl_xor(s2, o); }
      const float rs = rsqrtf(ss * (1.f / 192.f) + 1e-6f), r2 = rsqrtf(s2 * (1.f / 128.f) + 1e-6f);
      u16* d = CQN + (size_t)t * 192;
      d[lane] = f2bf(q0 * rs * gq0); d[64 + lane] = f2bf(q1 * rs * gq1); d[128 + lane] = f2bf(q2 * rs * gq2);
      u16* d2 = CKVN + (size_t)t * 128;
      d2[lane] = f2bf(k0 * r2 * gk0); d2[64 + lane] = f2bf(k1 * r2 * gk1);
    }
  };
  const int t0 = vb * 4 + wid, tstep = nvb * 4, tend = T;
  if (t0 >= tend) return;
  TokIn fa, fb;
  load(t0, fa);
#pragma unroll 1
  for (int t = t0; t < tend; t += 2 * tstep) {
    if (t + tstep < tend) load(t + tstep, fb);
    process(t, fa);
    if (t + tstep < tend) {
      if (t + 2 * tstep < tend) load(t + 2 * tstep, fa);
      process(t + tstep, fb);
    }
  }
}

DEVI void mla_up_tile(const Params& p, int mt, int nn, char* smem) {
  const int tid = p.tid, lane = tid & 63, wid = tid >> 6, wr = wid >> 1, wc = wid & 1, fr = lane & 15, fq = lane >> 4;
  const int m0 = mt * 128;
  const bool lat = m0 < TL;
  const int b = tok_b(m0), rowbase = tok_row(m0);
  f32x4 acc[4][4];
  if (nn < 3) {
    const u16* CQN = (const u16*)(p.ws + O_CQN);
    gemm_core<false>(tid, [&](int r) { return CQN + (size_t)(m0 + r) * 192; }, (const u16*)(p.ws + O_WUQT) + (size_t)nn * 128 * 192, 192, 192, acc, smem);
    const f32x2* ROPE = (const f32x2*)(p.ws + O_ROPE);
    const float scale = 0.10206207261596577f * LOG2E;
    u16* QC = (u16*)(p.ws + O_QC);
#pragma unroll
    for (int m = 0; m < 4; ++m) {
      const int rl = wr * 64 + m * 16 + fr;
#pragma unroll
      for (int n = 0; n < 4; ++n) {
        const int cb = nn * 128 + wc * 64 + n * 16;
        const int h = cb / 96, db = cb - h * 96;
        u16* dst = QC + ((size_t)(b * 4 + h) * NKEY + rowbase + rl) * 96;
        if (db < 64) {
          u32x2 pk; pk[0] = pack2(acc[m][n][0] * scale, acc[m][n][1] * scale); pk[1] = pack2(acc[m][n][2] * scale, acc[m][n][3] * scale);
          *(u32x2*)(dst + db + fq * 4) = pk;
        } else if (db == 64 && n < 3) {
          u32x2 o1, o2;
          rope4(acc[m][n], acc[m][n + 1], ROPE + (size_t)(rowbase + rl) * 48 + 32 + fq * 4, lat, scale, o1, o2);
          *(u32x2*)(dst + 64 + fq * 4) = o1; *(u32x2*)(dst + 80 + fq * 4) = o2;
        }
      }
    }
  } else {
    const u16* CKVN = (const u16*)(p.ws + O_CKVN);
    auto arow = [&](int r) { return CKVN + (size_t)(m0 + r) * 128; };
    const u16* Wt = (const u16*)(p.ws + O_WUKVT) + (size_t)(nn - 3) * 128 * 128;
    if (nn < 5) {
      gemm_core<false>(tid, arow, Wt, 128, 128, acc, smem);
      u16* KC = (u16*)(p.ws + O_KC) + ((size_t)(b * 4 + (nn - 3) * 2 + wc) * NKEY + rowbase) * 96;
#pragma unroll
      for (int m = 0; m < 4; ++m)
#pragma unroll
        for (int n = 0; n < 4; ++n) {
          u32x2 pk; pk[0] = pack2(acc[m][n][0], acc[m][n][1]); pk[1] = pack2(acc[m][n][2], acc[m][n][3]);
          *(u32x2*)(KC + (size_t)(wr * 64 + m * 16 + fr) * 96 + n * 16 + fq * 4) = pk;
        }
    } else {
      gemm_core<true>(tid, arow, Wt, 128, 128, acc, smem);
      u16* vt = (u16*)(p.ws + O_VTC) + (size_t)(b * 4 + (nn - 5) * 2 + wc) * 64 * NKEY;
#pragma unroll
      for (int m = 0; m < 4; ++m)
#pragma unroll
        for (int n = 0; n < 4; ++n) {
          u32x2 pk; pk[0] = pack2(acc[m][n][0], acc[m][n][1]); pk[1] = pack2(acc[m][n][2], acc[m][n][3]);
          *(u32x2*)(vt + (size_t)(n * 16 + fr) * NKEY + rowbase + wr * 64 + m * 16 + (((fq & 1) << 1) | (fq >> 1)) * 4) = pk;
        }
    }
  }
}
DEVI int permcol(int x) { return (x & 32) + 8 * ((x >> 2) & 3) + 4 * ((x >> 4) & 1) + (x & 3); }
DEVI int cidx(int d, int e) { return ((((e >> 4) * 4 + (d >> 4)) * 64) + (e & 15) + 16 * ((d >> 2) & 3)) * 4 + (d & 3); }
DEVI int gdn_chunk_t0(int ci) { return ci < 256 ? (ci >> 7) * SEQ + (ci & 127) * 64 : TL + ((ci - 256) >> 2) * CTXL + ((ci - 256) & 3) * 64; }

DEVI void fnma(float& a, float r, float x) { asm("v_fma_f32 %0, -%1, %2, %0" : "+v"(a) : "v"(r), "v"(x)); }
template <int IB>
DEVI void chunk_solve_block(float (&x)[64], const float* sA) {
  float a0 = x[4 * IB], a1 = x[4 * IB + 1], a2 = x[4 * IB + 2], a3 = x[4 * IB + 3];
  int z = 0;
  if (IB > 0) asm volatile("" : "+v"(z) : "v"(x[IB > 0 ? 4 * IB - 1 : 0]));
#pragma unroll
  for (int g = 0; g < IB; ++g) {
    if (g > 0 && (g & 3) == 0) asm volatile("" : "+v"(z) : "v"(a3));
    const float* sAz = sA + z;
    const f32x4 r0 = *(const f32x4*)&sAz[(4 * IB) * 68 + 4 * g], r1 = *(const f32x4*)&sAz[(4 * IB + 1) * 68 + 4 * g];
    const f32x4 r2 = *(const f32x4*)&sAz[(4 * IB + 2) * 68 + 4 * g], r3 = *(const f32x4*)&sAz[(4 * IB + 3) * 68 + 4 * g];
    const float x0 = x[4 * g], x1 = x[4 * g + 1], x2 = x[4 * g + 2], x3 = x[4 * g + 3];
    fnma(a0, r0[0], x0); fnma(a1, r1[0], x0); fnma(a2, r2[0], x0); fnma(a3, r3[0], x0);
    fnma(a0, r0[1], x1); fnma(a1, r1[1], x1); fnma(a2, r2[1], x1); fnma(a3, r3[1], x1);
    fnma(a0, r0[2], x2); fnma(a1, r1[2], x2); fnma(a2, r2[2], x2); fnma(a3, r3[2], x2);
    fnma(a0, r0[3], x3); fnma(a1, r1[3], x3); fnma(a2, r2[3], x3); fnma(a3, r3[3], x3);
  }
  const float* sAd = sA + z;
  const f32x4 d1 = *(const f32x4*)&sAd[(4 * IB + 1) * 68 + 4 * IB], d2 = *(const f32x4*)&sAd[(4 * IB + 2) * 68 + 4 * IB], d3 = *(const f32x4*)&sAd[(4 * IB + 3) * 68 + 4 * IB];
  fnma(a1, d1[0], a0);
  fnma(a2, d2[0], a0); fnma(a2, d2[1], a1);
  fnma(a3, d3[0], a0); fnma(a3, d3[1], a1); fnma(a3, d3[2], a2);
  x[4 * IB] = a0; x[4 * IB + 1] = a1; x[4 * IB + 2] = a2; x[4 * IB + 3] = a3;
  __builtin_amdgcn_sched_barrier(0);
  if constexpr (IB + 1 < 16) chunk_solve_block<IB + 1>(x, sA);
}
DEVI float hsum32(float v) {
  auto rr = __builtin_amdgcn_permlane32_swap(__float_as_uint(v), __float_as_uint(v), false, false);
  return __uint_as_float(rr[0]) + __uint_as_float(rr[1]);
}
template <int IB>
DEVI void solve_h(float (&xo)[32], const float (&rhs)[64], const float* sA, int hb, int z) {
  float a0 = hb ? 0.f : rhs[4 * IB], a1 = hb ? 0.f : rhs[4 * IB + 1], a2 = hb ? 0.f : rhs[4 * IB + 2], a3 = hb ? 0.f : rhs[4 * IB + 3];
  constexpr int NP = (IB + 1) / 2;
  if (IB > 0) asm volatile("" : "+v"(z) : "v"(xo[IB > 0 ? ((IB - 1) >> 1) * 4 + 3 : 0]));
#pragma unroll
  for (int gp = 0; gp < NP; ++gp) {
    if (gp > 0 && (gp & 1) == 0) asm volatile("" : "+v"(z) : "v"(a3));
    const float* sAz = sA + z + hb * 4;
    const bool tail = (2 * gp + 1 >= IB);
    const f32x4 r0 = *(const f32x4*)&sAz[(4 * IB) * 68 + 8 * gp], r1 = *(const f32x4*)&sAz[(4 * IB + 1) * 68 + 8 * gp];
    const f32x4 r2 = *(const f32x4*)&sAz[(4 * IB + 2) * 68 + 8 * gp], r3 = *(const f32x4*)&sAz[(4 * IB + 3) * 68 + 8 * gp];
    float x0 = xo[4 * gp], x1 = xo[4 * gp + 1], x2 = xo[4 * gp + 2], x3 = xo[4 * gp + 3];
    if (tail) { x0 = hb ? 0.f : x0; x1 = hb ? 0.f : x1; x2 = hb ? 0.f : x2; x3 = hb ? 0.f : x3; }
    fnma(a0, r0[0], x0); fnma(a1, r1[0], x0); fnma(a2, r2[0], x0); fnma(a3, r3[0], x0);
    fnma(a0, r0[1], x1); fnma(a1, r1[1], x1); fnma(a2, r2[1], x1); fnma(a3, r3[1], x1);
    fnma(a0, r0[2], x2); fnma(a1, r1[2], x2); fnma(a2, r2[2], x2); fnma(a3, r3[2], x2);
    fnma(a0, r0[3], x3); fnma(a1, r1[3], x3); fnma(a2, r2[3], x3); fnma(a3, r3[3], x3);
  }
  a0 = hsum32(a0); a1 = hsum32(a1); a2 = hsum32(a2); a3 = hsum32(a3);
  const float* sAd = sA + z;
  const f32x4 d1 = *(const f32x4*)&sAd[(4 * IB + 1) * 68 + 4 * IB], d2 = *(const f32x4*)&sAd[(4 * IB + 2) * 68 + 4 * IB], d3 = *(const f32x4*)&sAd[(4 * IB + 3) * 68 + 4 * IB];
  fnma(a1, d1[0], a0);
  fnma(a2, d2[0], a0); fnma(a2, d2[1], a1);
  fnma(a3, d3[0], a0); fnma(a3, d3[1], a1); fnma(a3, d3[2], a2);
  const bool own = (IB & 1) == hb;
  xo[(IB >> 1) * 4] = own ? a0 : xo[(IB >> 1) * 4]; xo[(IB >> 1) * 4 + 1] = own ? a1 : xo[(IB >> 1) * 4 + 1];
  xo[(IB >> 1) * 4 + 2] = own ? a2 : xo[(IB >> 1) * 4 + 2]; xo[(IB >> 1) * 4 + 3] = own ? a3 : xo[(IB >> 1) * 4 + 3];
  __builtin_amdgcn_sched_barrier(0);
  if constexpr (IB + 1 < 16) solve_h<IB + 1>(xo, rhs, sA, hb, z);
}
DEVI void gdn_chunk_item(const Params& p, int item, char* smem) {
  u16* sK = (u16*)smem;
  float* sA = (float*)(smem + 9216);
  u16* sXt = (u16*)(smem + 45056);
  u16* sAt = (u16*)(smem + 26624);
  u16* sKt = (u16*)(smem + 35840);
  float* sX = (float*)(smem + 45056);
  float* sgc = (float*)(smem + 77824); float* sbeta = sgc + 64; float* seg = sbeta + 64; float* skd = seg + 64;
  const u16* GQ = (const u16*)(p.ws + O_GQ); const u16* GK = (const u16*)(p.ws + O_GK); const u16* GV = (const u16*)(p.ws + O_GV);
  const float* GG = (const float*)(p.ws + O_GG); const float* GB = (const float*)(p.ws + O_GBETA);
  u16* GM = (u16*)(p.ws + O_GM); u16* GQP = (u16*)(p.ws + O_GQP); u16* GN = (u16*)(p.ws + O_GN); u16* GLO = (u16*)(p.ws + O_GLO);
  const int tid = p.tid, lane = tid & 63, w = tid >> 6, i15 = lane & 15, q = lane >> 4;
  {
    const int ci = item >> 3, hd = (item >> 1) & 3, dir = item & 1;
    const int t0 = gdn_chunk_t0(ci);
    auto tok = [&](int i) { return dir ? t0 + 63 - i : t0 + i; };
    __syncthreads();
    if (tid < 64) {
      float g = GG[((size_t)dir * T + tok(tid)) * 4 + hd];
#pragma unroll
      for (int o = 1; o < 64; o <<= 1) { float u = __shfl_up(g, o); if (lane >= o) g += u; }
      const float gl = __shfl(g, 63);
      sgc[tid] = g; sbeta[tid] = GB[((size_t)dir * T + tok(tid)) * 4 + hd]; seg[tid] = __expf(g); skd[tid] = __expf(gl - g);
    }
    __syncthreads();
    const float eglast = seg[63];
#pragma unroll
    for (int i = 0; i < 2; ++i) {
      const int ch = tid + 256 * i, j = ch >> 3, cc = ch & 7;
      const u32x4 kv = *(const u32x4*)(GK + (size_t)tok(j) * 256 + hd * 64 + cc * 8);
      *(u32x4*)&sK[j * 72 + cc * 8] = kv;
      const float kd = skd[j];
#pragma unroll
      for (int e = 0; e < 4; ++e) {
        sKt[(cc * 8 + 2 * e) * 72 + j] = f2bf(bf2f((u16)(kv[e] & 0xffff)) * kd);
        sKt[(cc * 8 + 2 * e + 1) * 72 + j] = f2bf(bf2f((u16)(kv[e] >> 16)) * kd);
      }
    }
#pragma unroll
    for (int i = 0; i < 2; ++i) {
      const int ch = tid + 256 * i, j = ch >> 3, cc = ch & 7;
      const u32x4 vv = *(const u32x4*)(GV + (size_t)tok(j) * 256 + hd * 64 + cc * 8);
      const float bj = sbeta[j];
      float* d = sX + j * 128 + cc * 8;
#pragma unroll
      for (int e = 0; e < 4; ++e) { d[2 * e] = bflo(vv[e]) * bj; d[2 * e + 1] = bfhi(vv[e]) * bj; }
    }
    __syncthreads();
    for (int e = tid; e < 64 * 64; e += 256) {
      const int j = e >> 6, c = e & 63;
      sX[j * 128 + 64 + c] = bf2f(sK[j * 72 + c]) * sbeta[j] * seg[j];
    }
    {
      f32x4 kk[4], qk[4];
#pragma unroll
      for (int nt = 0; nt < 4; ++nt) { kk[nt] = fzero4(); qk[nt] = fzero4(); }
#pragma unroll
      for (int ks = 0; ks < 2; ++ks) {
        const bf16x8 ak = *(const bf16x8*)&sK[(16 * w + i15) * 72 + ks * 32 + q * 8];
        const bf16x8 aq = *(const bf16x8*)(GQ + (size_t)tok(16 * w + i15) * 256 + hd * 64 + ks * 32 + q * 8);
#pragma unroll
        for (int nt = 0; nt < 4; ++nt) {
          const bf16x8 bk = *(const bf16x8*)&sK[(16 * nt + i15) * 72 + ks * 32 + q * 8];
          kk[nt] = MFMA16(ak, bk, kk[nt]); qk[nt] = MFMA16(aq, bk, qk[nt]);
        }
      }
#pragma unroll
      for (int nt = 0; nt < 4; ++nt)
#pragma unroll
        for (int r = 0; r < 4; ++r) {
          const int i = 16 * w + 4 * q + r, j = 16 * nt + i15;
          const float dec = i >= j ? __expf(sgc[i] - sgc[j]) : 0.f;
          sA[i * 68 + j] = i > j ? sbeta[i] * kk[nt][r] * dec : 0.f;
          sAt[i * 72 + j] = f2bf(i >= j ? qk[nt][r] * dec : 0.f);
        }
    }
    __syncthreads();
    {
      const int c = (tid >> 6) * 32 + (tid & 31), hb = (tid >> 5) & 1;
      float rhs[64], xo[32];
#pragma unroll
      for (int j = 0; j < 64; ++j) rhs[j] = sX[j * 128 + c];
#pragma unroll
      for (int j = 0; j < 32; ++j) xo[j] = 0.f;
      __syncthreads();
      { int z0 = 0; asm volatile("" : "+v"(z0)); solve_h<0>(xo, rhs, sA, hb, z0); }
#pragma unroll
      for (int gp = 0; gp < 8; ++gp) {
        u32x2 pk; pk[0] = pack2(xo[4 * gp], xo[4 * gp + 1]); pk[1] = pack2(xo[4 * gp + 2], xo[4 * gp + 3]);
        *(u32x2*)&sXt[c * 72 + 4 * (2 * gp + hb)] = pk;
      }
    }
    __syncthreads();
    {
      int tq = tid; asm volatile("" : "+v"(tq));
      const int lane = tq & 63, w = tq >> 6, i15 = lane & 15, q = lane >> 4;
      f32x4 r1[8], r2[8];
#pragma unroll
      for (int ct = 0; ct < 8; ++ct) { r1[ct] = fzero4(); r2[ct] = fzero4(); }
#pragma unroll
      for (int ks = 0; ks < 2; ++ks) {
        const bf16x8 aa = *(const bf16x8*)&sAt[(16 * w + i15) * 72 + ks * 32 + q * 8];
        const bf16x8 ak = *(const bf16x8*)&sKt[(16 * w + i15) * 72 + ks * 32 + q * 8];
#pragma unroll
        for (int ct = 0; ct < 8; ++ct) {
          const bf16x8 bx = *(const bf16x8*)&sXt[(16 * ct + i15) * 72 + ks * 32 + q * 8];
          r1[ct] = MFMA16(aa, bx, r1[ct]); r2[ct] = MFMA16(ak, bx, r2[ct]);
        }
      }
      const size_t ib = (size_t)item * 4096;
#pragma unroll
      for (int ct = 0; ct < 4; ++ct) {
        u32x2 a, b;
        a[0] = pack2(r1[ct][0], r1[ct][1]); a[1] = pack2(r1[ct][2], r1[ct][3]);
        b[0] = pack2(r2[ct][0], r2[ct][1]); b[1] = pack2(r2[ct][2], r2[ct][3]);
        *(u32x2*)(GLO + ib + ((ct * 4 + w) * 64 + lane) * 4) = a;
        *(u32x2*)(GN + ib + ((ct * 4 + w) * 64 + lane) * 4) = b;
      }
#pragma unroll
      for (int ct = 4; ct < 8; ++ct)
#pragma unroll
        for (int r = 0; r < 4; ++r) {
          const int row = 16 * w + 4 * q + r, col = 16 * (ct - 4) + i15;
          const float qv = bf2f(GQ[(size_t)tok(row) * 256 + hd * 64 + col]);
          GQP[ib + row * 64 + permcol(col)] = f2bf(qv * seg[row] - r1[ct][r]);
          GM[ib + row * 64 + permcol(col)] = f2bf((row == col ? eglast : 0.f) - r2[ct][r]);
        }
    }
    __syncthreads();
  }
}

DEVI void gdn_scan_chain(const Params& p, int chain, char* smem) {
  const int tid = p.tid, lane = tid & 63, w = tid >> 6, i15 = lane & 15, q = lane >> 4;
  u16* sM = (u16*)smem;
  u16* sQ = sM + 2 * 64 * 72;
  const u16* GM = (const u16*)(p.ws + O_GM); const u16* GQP = (const u16*)(p.ws + O_GQP);
  const u16* GN = (const u16*)(p.ws + O_GN); const u16* GLO = (const u16*)(p.ws + O_GLO);
  float* GO = (float*)(p.ws + O_GO);
  {
    const int b = chain >> 3, hd = (chain >> 1) & 3, dir = chain & 1;
    f32x4 S[4];
#pragma unroll
    for (int r = 0; r < 4; ++r) S[r] = fzero4();
    auto item_of = [&](int n) {
      int ci = n < 4 ? 256 + b * 4 + (dir ? 3 - n : n) : b * 128 + (dir ? 127 - (n - 4) : (n - 4));
      return ci * 8 + hd * 2 + dir;
    };
    struct Pf { u32x4 pm[2], pq[2]; u32x2 pn[4], pl[4]; };
    Pf pf[3];
    auto prefetch = [&](int n, Pf& f) {
      const size_t base = (size_t)item_of(n) * 4096;
#pragma unroll
      for (int i = 0; i < 2; ++i) {
        const int ch = tid + 256 * i;
        f.pm[i] = *(const u32x4*)(GM + base + ch * 8);
        f.pq[i] = *(const u32x4*)(GQP + base + ch * 8);
      }
#pragma unroll
      for (int rb = 0; rb < 4; ++rb) {
        f.pn[rb] = *(const u32x2*)(GN + base + ((w * 4 + rb) * 64 + lane) * 4);
        f.pl[rb] = *(const u32x2*)(GLO + base + ((w * 4 + rb) * 64 + lane) * 4);
      }
    };
    auto step = [&](int n, Pf& f) {
      const int buf = n & 1;
      u16* bM = sM + buf * 64 * 72; u16* bQ = sQ + buf * 64 * 72;
#pragma unroll
      for (int i = 0; i < 2; ++i) {
        const int ch = tid + 256 * i, row = ch >> 3, cc = ch & 7;
        *(u32x4*)&bM[row * 72 + cc * 8] = f.pm[i];
        *(u32x4*)&bQ[row * 72 + cc * 8] = f.pq[i];
      }
      f32x4 accs[4], acco[4];
#pragma unroll
      for (int rb = 0; rb < 4; ++rb) {
        accs[rb] = f32x4{bflo(f.pn[rb][0]), bfhi(f.pn[rb][0]), bflo(f.pn[rb][1]), bfhi(f.pn[rb][1])};
        acco[rb] = f32x4{bflo(f.pl[rb][0]), bfhi(f.pl[rb][0]), bflo(f.pl[rb][1]), bfhi(f.pl[rb][1])};
      }
      const int ci = n < 4 ? 256 + b * 4 + (dir ? 3 - n : n) : b * 128 + (dir ? 127 - (n - 4) : (n - 4));
      const int t0 = gdn_chunk_t0(ci);
      __syncthreads();
      if (n + 3 < 132) prefetch(n + 3, f);
      bf16x8 sb[2];
#pragma unroll
      for (int kb = 0; kb < 2; ++kb) {
        const u32x4 pk = {pack2(S[2 * kb][0], S[2 * kb][1]), pack2(S[2 * kb][2], S[2 * kb][3]), pack2(S[2 * kb + 1][0], S[2 * kb + 1][1]), pack2(S[2 * kb + 1][2], S[2 * kb + 1][3])};
        sb[kb] = __builtin_bit_cast(bf16x8, pk);
      }
#pragma unroll
      for (int kb = 0; kb < 2; ++kb)
#pragma unroll
        for (int rb = 0; rb < 4; ++rb) {
          const bf16x8 am = *(const bf16x8*)&bM[(rb * 16 + i15) * 72 + kb * 32 + q * 8];
          const bf16x8 aq = *(const bf16x8*)&bQ[(rb * 16 + i15) * 72 + kb * 32 + q * 8];
          accs[rb] = MFMA16(am, sb[kb], accs[rb]);
          acco[rb] = MFMA16(aq, sb[kb], acco[rb]);
        }
#pragma unroll
      for (int rb = 0; rb < 4; ++rb) {
        S[rb] = accs[rb];
#pragma unroll
        for (int r = 0; r < 4; ++r) {
          const int i = rb * 16 + q * 4 + r;
          const int t = dir ? t0 + 63 - i : t0 + i;
          GO[(size_t)dir * T * 256 + (size_t)t * 256 + hd * 64 + w * 16 + i15] = acco[rb][r];
        }
      }
    };
    prefetch(0, pf[0]); prefetch(1, pf[1]); prefetch(2, pf[2]);
    __syncthreads();
#pragma unroll 1
    for (int n = 0; n < 132; n += 3) { step(n, pf[0]); step(n + 1, pf[1]); step(n + 2, pf[2]); }
    __syncthreads();
  }
}


template <int DQK>
DEVI void attn_run(int tid, const u16* __restrict__ Qp, int qrow0, const u16* __restrict__ Kp, const u16* __restrict__ Vtp,
                   int a0, int a1, int b0, int b1, int qpos0, float sink2, f32x16 (&O)[2], char* smem) {
  constexpr int KLD = DQK + 8, NS = DQK / 16, KCH = DQK / 8, NKL = (64 * KCH) / 256;
  constexpr int BUF = 64 * KLD + 64 * 72;
  u16* sbase = (u16*)smem;
  const int lane = tid & 63, wid = tid >> 6, r31 = lane & 31, hh = lane >> 5;
  const int qrow = qrow0 + wid * 32 + r31;
  bf16x8 qf[NS];
#pragma unroll
  for (int s = 0; s < NS; ++s) qf[s] = *(const bf16x8*)(Qp + (size_t)qrow * DQK + s * 16 + hh * 8);
#pragma unroll
  for (int i = 0; i < 16; ++i) { O[0][i] = 0.f; O[1][i] = 0.f; }
  float m = -30000.f, lsum = 0.f;
  const int na = (a1 - a0) >> 6, nt = na + ((b1 - b0) >> 6);
  const int qpos = qpos0 + wid * 32 + r31;
  u32x4 rk[NKL], rv[2];
  auto gload = [&](int ti) {
    const int key0 = ti >= na ? b0 + (ti - na) * 64 : a0 + ti * 64;
#pragma unroll
    for (int i = 0; i < NKL; ++i) { const int q = tid + 256 * i, r = q / KCH, cc = q % KCH; rk[i] = *(const u32x4*)(Kp + (size_t)(key0 + r) * DQK + cc * 8); }
#pragma unroll
    for (int i = 0; i < 2; ++i) { const int q = tid + 256 * i, r = q >> 3, cc = q & 7; rv[i] = *(const u32x4*)(Vtp + (size_t)r * NKEY + key0 + cc * 8); }
  };
  auto lstore = [&](int buf) {
    u16* sK = sbase + buf * BUF; u16* sV = sK + 64 * KLD;
#pragma unroll
    for (int i = 0; i < NKL; ++i) { const int q = tid + 256 * i, r = q / KCH, cc = q % KCH; *(u32x4*)&sK[r * KLD + cc * 8] = rk[i]; }
#pragma unroll
    for (int i = 0; i < 2; ++i) { const int q = tid + 256 * i, r = q >> 3, cc = q & 7; *(u32x4*)&sV[r * 72 + cc * 8] = rv[i]; }
  };
  m = 0.f;
  f32x16 negm;
#pragma unroll
  for (int i = 0; i < 16; ++i) negm[i] = 0.f;
  gload(0);
  __syncthreads();
  lstore(0);
  __syncthreads();
  for (int ti = 0; ti < nt; ++ti) {
    if (ti + 1 < nt) gload(ti + 1);
    const u16* sK = sbase + (ti & 1) * BUF; const u16* sV = sK + 64 * KLD;
    const bool inB = ti >= na;
    const int key0 = inB ? b0 + (ti - na) * 64 : a0 + ti * 64;
    f32x16 st[2];
    {
      constexpr int G = NS > 4 ? 3 : NS;
#pragma unroll
      for (int s0 = 0; s0 < NS; s0 += G) {
        bf16x8 kf[2][G];
#pragma unroll
        for (int s = 0; s < G; ++s)
#pragma unroll
          for (int k2 = 0; k2 < 2; ++k2) kf[k2][s] = *(const bf16x8*)&sK[(k2 * 32 + r31) * KLD + (s0 + s) * 16 + hh * 8];
        __builtin_amdgcn_sched_barrier(0);
#pragma unroll
        for (int s = 0; s < G; ++s)
#pragma unroll
          for (int k2 = 0; k2 < 2; ++k2) {
            if (s0 + s == 0) asm volatile("v_mfma_f32_32x32x16_bf16 %0, %1, %2, %3" : "=&v"(st[k2]) : "v"(kf[k2][0]), "v"(qf[0]), "v"(negm));
            else st[k2] = MFMA32(kf[k2][s], qf[s0 + s], st[k2]);
          }
        __builtin_amdgcn_sched_barrier(0);
      }
    }
    if (inB) {
#pragma unroll
      for (int k2 = 0; k2 < 2; ++k2)
#pragma unroll
        for (int g = 0; g < 16; ++g) {
          const int d = key0 + k2 * 32 + (g & 3) + 8 * (g >> 2) + 4 * hh - qpos;
          if (d > 128 || d < -128) st[k2][g] = -1e30f;
        }
    }
    bf16x8 vfr[2][2][2];
#pragma unroll
    for (int k2 = 0; k2 < 2; ++k2)
#pragma unroll
      for (int s2 = 0; s2 < 2; ++s2)
#pragma unroll
        for (int dvt = 0; dvt < 2; ++dvt) vfr[k2][s2][dvt] = *(const bf16x8*)&sV[(dvt * 32 + r31) * 72 + k2 * 32 + s2 * 16 + 8 * hh];
    float mx = st[0][0];
#pragma unroll
    for (int g = 1; g < 16; ++g) mx = fmaxf(mx, st[0][g]);
#pragma unroll
    for (int g = 0; g < 16; ++g) mx = fmaxf(mx, st[1][g]);
    { auto rr = __builtin_amdgcn_permlane32_swap(__float_as_uint(mx), __float_as_uint(mx), false, false);
      mx = fmaxf(__uint_as_float(rr[0]), __uint_as_float(rr[1])); }
    if (ti == 0 || __any(mx > 8.f)) {
      const float delta = ti == 0 ? fmaxf(mx, -1e4f) : fmaxf(mx, 0.f);
      if (ti != 0) {
        const float alpha = __builtin_amdgcn_exp2f(-delta);
        lsum *= alpha;
#pragma unroll
        for (int i = 0; i < 16; ++i) { O[0][i] *= alpha; O[1][i] *= alpha; }
      }
      m += delta;
#pragma unroll
      for (int i = 0; i < 16; ++i) { negm[i] = -m; st[0][i] -= delta; st[1][i] -= delta; }
    }
    f32x2 ps2 = {0.f, 0.f};
#pragma unroll
    for (int k2 = 0; k2 < 2; ++k2)
#pragma unroll
      for (int g = 0; g < 16; g += 2) {
        const float p0 = __builtin_amdgcn_exp2f(st[k2][g]), p1 = __builtin_amdgcn_exp2f(st[k2][g + 1]);
        st[k2][g] = p0; st[k2][g + 1] = p1;
        ps2 += f32x2{p0, p1};
      }
    lsum += ps2[0] + ps2[1];
#pragma unroll
    for (int k2 = 0; k2 < 2; ++k2)
#pragma unroll
      for (int s2 = 0; s2 < 2; ++s2) {
        u32x4 pp;
#pragma unroll
        for (int j = 0; j < 4; ++j) pp[j] = pack2(st[k2][8 * s2 + 2 * j], st[k2][8 * s2 + 2 * j + 1]);
        const bf16x8 pf = __builtin_bit_cast(bf16x8, pp);
#pragma unroll
        for (int dvt = 0; dvt < 2; ++dvt) {
          O[dvt] = MFMA32(vfr[k2][s2][dvt], pf, O[dvt]);
        }
      }
    if (ti + 1 < nt) lstore((ti + 1) & 1);
    __syncthreads();
  }
  if (sink2 > -1e29f) {
    const float mn = fmaxf(m, sink2);
    const float alpha = __builtin_amdgcn_exp2f(m - mn);
    lsum = lsum * alpha + (hh == 0 ? __builtin_amdgcn_exp2f(sink2 - mn) : 0.f);
#pragma unroll
    for (int i = 0; i < 16; ++i) { O[0][i] *= alpha; O[1][i] *= alpha; }
  }
  const float ltot = lsum + __shfl_xor(lsum, 32);
  const float inv = 1.f / ltot;
#pragma unroll
  for (int i = 0; i < 16; ++i) { O[0][i] *= inv; O[1][i] *= inv; }
}
DEVI void attn_run_b2(int tid, const u16* __restrict__ Qp0, const u16* __restrict__ Qp1, int qrow0, const u16* __restrict__ Kp0, const u16* __restrict__ Kp1,
                      const u16* __restrict__ Vtp, int a0, int a1, f32x16 (&O)[2][2], char* smem) {
  constexpr int KLD = 40, BUF = 2 * 64 * KLD + 64 * 72;
  u16* sbase = (u16*)smem;
  const int lane = tid & 63, wid = tid >> 6, r31 = lane & 31, hh = lane >> 5;
  const int qrow = qrow0 + wid * 32 + r31;
  bf16x8 qf[2][2];
#pragma unroll
  for (int s = 0; s < 2; ++s) { qf[0][s] = *(const bf16x8*)(Qp0 + (size_t)qrow * 32 + s * 16 + hh * 8); qf[1][s] = *(const bf16x8*)(Qp1 + (size_t)qrow * 32 + s * 16 + hh * 8); }
  float m[2] = {0.f, 0.f}, lsum[2] = {0.f, 0.f};
  u32x4 kaug = {hh == 0 ? 0x3F80u : 0u, 0u, 0u, 0u}, qaug[2] = {{0u, 0u, 0u, 0u}, {0u, 0u, 0u, 0u}};
#pragma unroll
  for (int mp = 0; mp < 2; ++mp)
#pragma unroll
    for (int i = 0; i < 16; ++i) { O[mp][0][i] = 0.f; O[mp][1][i] = 0.f; }
  const int nt = (a1 - a0) >> 6;
  u32x4 rk[2], rv[2];
  auto gload = [&](int ti) {
    const int key0 = a0 + ti * 64;
    const int r = tid >> 2, cc = tid & 3;
    rk[0] = *(const u32x4*)(Kp0 + (size_t)(key0 + r) * 32 + cc * 8);
    rk[1] = *(const u32x4*)(Kp1 + (size_t)(key0 + r) * 32 + cc * 8);
#pragma unroll
    for (int i = 0; i < 2; ++i) { const int q = tid + 256 * i, rr = q >> 3, c8 = q & 7; rv[i] = *(const u32x4*)(Vtp + (size_t)rr * NKEY + key0 + c8 * 8); }
  };
  auto lstore = [&](int buf) {
    u16* sK = sbase + buf * BUF; u16* sV = sK + 2 * 64 * KLD;
    const int r = tid >> 2, cc = tid & 3;
    *(u32x4*)&sK[r * KLD + cc * 8] = rk[0];
    *(u32x4*)&sK[64 * KLD + r * KLD + cc * 8] = rk[1];
#pragma unroll
    for (int i = 0; i < 2; ++i) { const int q = tid + 256 * i, rr = q >> 3, c8 = q & 7; *(u32x4*)&sV[rr * 72 + c8 * 8] = rv[i]; }
  };
  gload(0);
  __syncthreads();
  lstore(0);
  __syncthreads();
  for (int ti = 0; ti < nt; ++ti) {
    if (ti + 1 < nt) gload(ti + 1);
    const u16* sK = sbase + (ti & 1) * BUF; const u16* sV = sK + 2 * 64 * KLD;
    bf16x8 vfr[2][2][2];
#pragma unroll
    for (int k2 = 0; k2 < 2; ++k2)
#pragma unroll
      for (int s2 = 0; s2 < 2; ++s2)
#pragma unroll
        for (int dvt = 0; dvt < 2; ++dvt) vfr[k2][s2][dvt] = *(const bf16x8*)&sV[(dvt * 32 + r31) * 72 + k2 * 32 + s2 * 16 + 8 * hh];
#pragma unroll
    for (int mp = 0; mp < 2; ++mp) {
      const u16* sKm = sK + mp * 64 * KLD;
      f32x16 st[2];
#pragma unroll
      for (int k2 = 0; k2 < 2; ++k2) {
        const bf16x8 kf0 = *(const bf16x8*)&sKm[(k2 * 32 + r31) * KLD + hh * 8];
        const bf16x8 kf1 = *(const bf16x8*)&sKm[(k2 * 32 + r31) * KLD + 16 + hh * 8];
#pragma unroll
        for (int i = 0; i < 16; ++i) st[k2][i] = 0.f;
        st[k2] = MFMA32(kf0, qf[mp][0], st[k2]);
        st[k2] = MFMA32(kf1, qf[mp][1], st[k2]);
        st[k2] = MFMA32(__builtin_bit_cast(bf16x8, kaug), __builtin_bit_cast(bf16x8, qaug[mp]), st[k2]);
      }
      float mx = st[0][0];
#pragma unroll
      for (int g = 1; g < 16; ++g) mx = fmaxf(mx, st[0][g]);
#pragma unroll
      for (int g = 0; g < 16; ++g) mx = fmaxf(mx, st[1][g]);
      { auto rr = __builtin_amdgcn_permlane32_swap(__float_as_uint(mx), __float_as_uint(mx), false, false);
        mx = fmaxf(__uint_as_float(rr[0]), __uint_as_float(rr[1])); }
      if (ti == 0 || __any(mx > 8.f)) {
        const float want = m[mp] + (ti == 0 ? fmaxf(mx, -1e4f) : fmaxf(mx, 0.f));
        const float mnew = bf2f(f2bf(want));
        const float delta = mnew - m[mp];
        if (ti != 0) {
          const float alpha = __builtin_amdgcn_exp2f(-delta);
          lsum[mp] *= alpha;
#pragma unroll
          for (int i = 0; i < 16; ++i) { O[mp][0][i] *= alpha; O[mp][1][i] *= alpha; }
        }
        m[mp] = mnew;
        qaug[mp][0] = hh == 0 ? (unsigned)f2bf(-mnew) : 0u;
#pragma unroll
        for (int i = 0; i < 16; ++i) { st[0][i] -= delta; st[1][i] -= delta; }
      }
      f32x2 ps2 = {0.f, 0.f};
#pragma unroll
      for (int k2 = 0; k2 < 2; ++k2)
#pragma unroll
        for (int g = 0; g < 16; g += 2) {
          const float p0 = __builtin_amdgcn_exp2f(st[k2][g]), p1 = __builtin_amdgcn_exp2f(st[k2][g + 1]);
          st[k2][g] = p0; st[k2][g + 1] = p1;
          ps2 += f32x2{p0, p1};
        }
      lsum[mp] += ps2[0] + ps2[1];
#pragma unroll
      for (int k2 = 0; k2 < 2; ++k2)
#pragma unroll
        for (int s2 = 0; s2 < 2; ++s2) {
          u32x4 pp;
#pragma unroll
          for (int j = 0; j < 4; ++j) pp[j] = pack2(st[k2][8 * s2 + 2 * j], st[k2][8 * s2 + 2 * j + 1]);
          const bf16x8 pf = __builtin_bit_cast(bf16x8, pp);
#pragma unroll
          for (int dvt = 0; dvt < 2; ++dvt) O[mp][dvt] = MFMA32(vfr[k2][s2][dvt], pf, O[mp][dvt]);
        }
    }
    if (ti + 1 < nt) lstore((ti + 1) & 1);
    __syncthreads();
  }
#pragma unroll
  for (int mp = 0; mp < 2; ++mp) {
    const float ltot = lsum[mp] + __shfl_xor(lsum[mp], 32);
    const float inv = 1.f / ltot;
#pragma unroll
    for (int i = 0; i < 16; ++i) { O[mp][0][i] *= inv; O[mp][1][i] *= inv; }
  }
}
DEVI void attn_store(int tid, const f32x16 (&O)[2], u16* dst, int ld, int b, int qrow0, int col0) {
  const int lane = tid & 63, wid = tid >> 6, r31 = lane & 31, hh = lane >> 5;
  const int qrow = qrow0 + wid * 32 + r31;
  const int t = qrow < SEQ ? b * SEQ + qrow : TL + b * CTXL + (qrow - SEQ);
  u16* yr = dst + (size_t)t * ld + col0;
#pragma unroll
  for (int dvt = 0; dvt < 2; ++dvt)
#pragma unroll
    for (int g4 = 0; g4 < 4; ++g4) {
      u32x2 pk; pk[0] = pack2(O[dvt][g4 * 4 + 0], O[dvt][g4 * 4 + 1]); pk[1] = pack2(O[dvt][g4 * 4 + 2], O[dvt][g4 * 4 + 3]);
      *(u32x2*)(yr + dvt * 32 + 8 * g4 + 4 * hh) = pk;
    }
}
DEVI void attn_item(const Params& p, int l, int mixer, int b, int h, int qb, char* smem) {
  const bool lat = qb < 64;
  const int qrow0 = qb * 128;
  f32x16 O[2];
  if (mixer == 0) {
    f32x16 O2[2][2];
    const u16* QB = (const u16*)(p.ws + O_QB) + (size_t)(b * 8 + 2 * h) * NKEY * 32; const u16* KB = (const u16*)(p.ws + O_KB) + (size_t)(b * 8 + 2 * h) * NKEY * 32;
    attn_run_b2(p.tid, QB, QB + (size_t)NKEY * 32, qrow0, KB, KB + (size_t)NKEY * 32,
                (const u16*)(p.ws + O_VTB) + (size_t)(b * 4 + h) * 64 * NKEY, lat ? 0 : SEQ, NKEY, O2, smem);
    attn_store(p.tid, O2[0], (u16*)(p.ws + O_OB), 512, b, qrow0, (2 * h) * 64);
    attn_store(p.tid, O2[1], (u16*)(p.ws + O_OB), 512, b, qrow0, (2 * h + 1) * 64);
  } else if (mixer == 1) {
    attn_run<96>(p.tid, (const u16*)(p.ws + O_QC) + (size_t)(b * 4 + h) * NKEY * 96, qrow0, (const u16*)(p.ws + O_KC) + (size_t)(b * 4 + h) * NKEY * 96,
                 (const u16*)(p.ws + O_VTC) + (size_t)(b * 4 + h) * 64 * NKEY, lat ? 0 : SEQ, NKEY, 0, 0, 0, -1e30f, O, smem);
    attn_store(p.tid, O, (u16*)(p.ws + O_Y), 1024, b, qrow0, 512 + h * 64);
  } else {
    const float sink2 = pin(p, I_SINK)[l * 4 + h] * LOG2E;
    const int hk = h >> 1;
    int b0 = 0, b1 = 0;
    if (lat) { b0 = (qb - 1) * 128; if (b0 < 0) b0 = 0; b1 = (qb + 2) * 128; if (b1 > SEQ) b1 = SEQ; }
    attn_run<64>(p.tid, (const u16*)(p.ws + O_QA) + (size_t)(b * 4 + h) * NKEY * 64, qrow0, (const u16*)(p.ws + O_KA) + (size_t)(b * 2 + hk) * NKEY * 64,
                 (const u16*)(p.ws + O_VTA) + (size_t)(b * 2 + hk) * 64 * NKEY, SEQ, NKEY, b0, b1, qrow0, sink2, O, smem);
    attn_store(p.tid, O, (u16*)(p.ws + O_Y), 1024, b, qrow0, h * 64);
  }
}

constexpr int SMEM_BYTES = 78848 + 64;

DEVI unsigned long long launder_ptr(unsigned long long v) {
  unsigned lo = __builtin_amdgcn_readfirstlane((unsigned)v), hi = __builtin_amdgcn_readfirstlane((unsigned)(v >> 32));
  asm volatile("s_mov_b32 %0, %1" : "=s"(lo) : "s"(lo));
  asm volatile("s_mov_b32 %0, %1" : "=s"(hi) : "s"(hi));
  return ((unsigned long long)hi << 32) | lo;
}
DEVI Params mkctx(const KArgs& a) {
  Params c;
  typedef __attribute__((address_space(1))) char gchar;
  typedef __attribute__((address_space(1))) float gfloat;
  c.ws = (char*)(gchar*)launder_ptr((unsigned long long)a.ws);
  c.out = (float*)(gfloat*)launder_ptr((unsigned long long)a.out);
  c.in = (gcfloat* const*)(c.ws + O_TAB);
  c.tid = threadIdx.x;
  asm volatile("" : "+v"(c.tid));
  return c;
}
DEVI void st_mixer_queue(const KArgs& a, int l, char* smem) {
  int* sitem = (int*)(smem + SMEM_BYTES - 16);
  const int g = blockIdx.x & 7;
  const int nctx = l == 0 ? 6 : 0;
  constexpr int NPREP = TR_P2 / 8 / 8;
  const int total = 2 + 64 + 64 + 64 + nctx + NPREP;
  for (;;) {
    const Params p = mkctx(a);
    unsigned* head = (unsigned*)(p.ws + O_BAR) + 16 + l * 8 + g;
    __syncthreads();
    if (p.tid == 0) *sitem = (int)atomicAdd(head, 1u);
    __syncthreads();
    int it = *sitem;
    if (it >= total) break;
    if (it < 2) { gdn_scan_chain(p, 2 * g + it, smem); continue; }
    it -= 2;
    if (it < 192 + nctx) {
      const int b = g >> 2, h = g & 3;
      int mixer, qb;
      if (it < 192) { mixer = it >> 6; qb = it & 63; }
      else { const int j = it - 192; mixer = j >> 1; qb = 64 + (j & 1); }
      attn_item(p, l, mixer, b, h, qb, smem);
      continue;
    }
    it -= 192 + nctx;
    prep_w2_run8(p, l, (it * 8 + g) * 8, (float*)smem);
  }
}

DEVI void st_mix_finish(const Params& p, int l, int vb, int nvb) {
  const int lane = p.tid & 63, wid = p.tid >> 6;
  const float* GO = (const float*)(p.ws + O_GO); const u16* PP = (const u16*)(p.ws + O_PP); const u16* OB = (const u16*)(p.ws + O_OB);
  u16* Y = (u16*)(p.ws + O_Y);
  const float lam_init = 0.8f - 0.6f * expf(-0.3f * (float)l);
  float d1 = lane < 32 ? pin(p, I_LQ1)[l * 32 + lane] * pin(p, I_LK1)[l * 32 + lane] : 0.f;
  float d2 = lane < 32 ? pin(p, I_LQ2)[l * 32 + lane] * pin(p, I_LK2)[l * 32 + lane] : 0.f;
  const float lam = expf(wave_sum(d1)) - expf(wave_sum(d2)) + lam_init;
  const int hd = lane >> 4, d0 = (lane & 15) * 4;
  const f32x4 gg = *(const f32x4*)(pin(p, I_GNG) + l * 64 + d0);
  const f32x4 dg = *(const f32x4*)(pin(p, I_DNG) + l * 64 + d0) * (1.f - lam_init);
  const int tend = l == 0 ? T : TL;
  for (int t0 = (vb * 4 + wid) * 2; t0 < tend; t0 += nvb * 8) {
    u32x2 o0[2], o1[2], zz[2]; f32x4 gf[2], gb[2];
#pragma unroll
    for (int u = 0; u < 2; ++u) {
      const size_t t = t0 + u;
      o0[u] = *(const u32x2*)(OB + t * 512 + (hd * 2) * 64 + d0);
      o1[u] = *(const u32x2*)(OB + t * 512 + (hd * 2 + 1) * 64 + d0);
      gf[u] = *(const f32x4*)(GO + t * 256 + hd * 64 + d0);
      gb[u] = *(const f32x4*)(GO + (size_t)T * 256 + t * 256 + hd * 64 + d0);
      zz[u] = *(const u32x2*)(PP + t * LDPP + PP_DZ + hd * 64 + d0);
    }
    f32x4 od[2], go[2]; float ssb[2], ssg[2];
#pragma unroll
    for (int u = 0; u < 2; ++u) {
      const f32x4 a = {bflo(o0[u][0]), bfhi(o0[u][0]), bflo(o0[u][1]), bfhi(o0[u][1])};
      const f32x4 b = {bflo(o1[u][0]), bfhi(o1[u][0]), bflo(o1[u][1]), bfhi(o1[u][1])};
      od[u] = a - lam * b; go[u] = gf[u] + gb[u];
      ssb[u] = od[u][0] * od[u][0] + od[u][1] * od[u][1] + od[u][2] * od[u][2] + od[u][3] * od[u][3];
      ssg[u] = go[u][0] * go[u][0] + go[u][1] * go[u][1] + go[u][2] * go[u][2] + go[u][3] * go[u][3];
    }
#pragma unroll
    for (int o = 8; o >= 1; o >>= 1) {
#pragma unroll
      for (int u = 0; u < 2; ++u) { ssb[u] += __shfl_xor(ssb[u], o); ssg[u] += __shfl_xor(ssg[u], o); }
    }
#pragma unroll
    for (int u = 0; u < 2; ++u) {
      const size_t t = t0 + u;
      const f32x4 yb = od[u] * (rsqrtf(ssb[u] * (1.f / 64.f) + 1e-6f)) * dg;
      const f32x4 z = {bflo(zz[u][0]), bfhi(zz[u][0]), bflo(zz[u][1]), bfhi(zz[u][1])};
      const f32x4 sz = {siluf(z[0]), siluf(z[1]), siluf(z[2]), siluf(z[3])};
      const f32x4 yd = go[u] * (rsqrtf(ssg[u] * (1.f / 64.f) + 1e-6f)) * gg * sz;
      u32x2 pb, pd;
      pb[0] = pack2(yb[0], yb[1]); pb[1] = pack2(yb[2], yb[3]);
      pd[0] = pack2(yd[0], yd[1]); pd[1] = pack2(yd[2], yd[3]);
      *(u32x2*)(Y + t * 1024 + 256 + hd * 64 + d0) = pb;
      *(u32x2*)(Y + t * 1024 + 768 + hd * 64 + d0) = pd;
    }
  }
}

constexpr int RLD = 1026;
DEVI void st_norm2_route(const Params& p, int l, int vb, int nvb, char* smem) {
  const int lane = p.tid & 63, wid = p.tid >> 6, i15 = lane & 15, q = lane >> 4;
  float* shh = (float*)smem;
  float* slog = shh + 16 * RLD;
  const float* g = pin(p, I_N2G) + l * 1024;
  const float* wr = pin(p, I_WR) + (size_t)l * 1024 * 64;
  const float bias = pin(p, I_RB)[l * 64 + lane];
  float* WTS = (float*)(p.ws + O_WTS); int* CNT = (int*)(p.ws + O_CNT); int* LIST = (int*)(p.ws + O_LIST);
  const int ntok = l == 0 ? T : TL;
  for (int grp = vb; grp < ntok / 16; grp += nvb) {
    const int tb = grp * 16 + wid * 4;
    const int mv = tok_mv(tb);
    const float* sh = modp(p, l, mv, 3); const float* sc = modp(p, l, mv, 4);
    {
      f32x4 v[4][4]; float ss[4];
#pragma unroll
      for (int u = 0; u < 4; ++u) {
        const f32x4* xr = (const f32x4*)((const float*)(p.ws + O_XA) + (size_t)(tb + u) * 1024);
#pragma unroll
        for (int i = 0; i < 4; ++i) v[u][i] = xr[i * 64 + lane];
      }
#pragma unroll
      for (int u = 0; u < 4; ++u) {
        float a = 0.f;
#pragma unroll
        for (int i = 0; i < 4; ++i) a += v[u][i][0] * v[u][i][0] + v[u][i][1] * v[u][i][1] + v[u][i][2] * v[u][i][2] + v[u][i][3] * v[u][i][3];
        ss[u] = a;
      }
#pragma unroll
      for (int o = 32; o >= 1; o >>= 1) {
#pragma unroll
        for (int u = 0; u < 4; ++u) ss[u] += __shfl_xor(ss[u], o);
      }
#pragma unroll
      for (int i = 0; i < 4; ++i) {
        const int c = i * 256 + lane * 4;
        const f32x4 gg = *(const f32x4*)(g + c), s4 = *(const f32x4*)(sc + c), h4 = *(const f32x4*)(sh + c);
        const f32x4 gs = gg * (1.f + s4);
#pragma unroll
        for (int u = 0; u < 4; ++u) {
          const float rstd = rsqrtf(ss[u] * (1.f / 1024.f) + 1e-6f);
          const f32x4 o = v[u][i] * rstd * gs + h4;
          u32x2 pk; pk[0] = pack2(o[0], o[1]); pk[1] = pack2(o[2], o[3]);
          *(u32x2*)((u16*)(p.ws + O_H) + (size_t)(tb + u) * LDH + c) = pk;
          float* d = shh + (wid * 4 + u) * RLD + c;
          *(f32x2*)d = f32x2{o[0], o[1]}; *(f32x2*)(d + 2) = f32x2{o[2], o[3]};
        }
      }
    }
    __syncthreads();
    {
      f32x4 a0 = fzero4(), a1 = a0;
      const float* ap = shh + i15 * RLD + q;
      const float* bp = wr + (size_t)q * 64 + wid * 16 + i15;
#pragma unroll 1
      for (int kb = 0; kb < 256; kb += 64) {
        float bv[64];
#pragma unroll
        for (int j = 0; j < 64; ++j) bv[j] = bp[(size_t)(4 * (kb + j)) * 64];
#pragma unroll
        for (int j = 0; j < 64; j += 2) {
          a0 = __builtin_amdgcn_mfma_f32_16x16x4f32(ap[4 * (kb + j)], bv[j], a0, 0, 0, 0);
          a1 = __builtin_amdgcn_mfma_f32_16x16x4f32(ap[4 * (kb + j) + 4], bv[j + 1], a1, 0, 0, 0);
        }
      }
#pragma unroll
      for (int r = 0; r < 4; ++r) slog[(4 * q + r) * 64 + wid * 16 + i15] = a0[r] + a1[r];
    }
    __syncthreads();
#pragma unroll 1
    for (int u = 0; u < 4; ++u) {
      const int t = tb + u;
      const float logit = slog[(wid * 4 + u) * 64 + lane];
      const float s = 1.f / (1.f + expf(-logit));
      const float c = s + bias;
      float m1 = c;
      m1 = fmaxf(m1, __shfl_xor(m1, 1)); m1 = fmaxf(m1, __shfl_xor(m1, 2)); m1 = fmaxf(m1, __shfl_xor(m1, 4));
      const unsigned long long bal = __ballot(c == m1);
      const int grpi = lane >> 3;
      const unsigned gm = (unsigned)((bal >> (grpi * 8)) & 0xffull);
      const int first = __ffs(gm) - 1;
      float m2 = ((lane & 7) == first) ? -INFINITY : c;
      m2 = fmaxf(m2, __shfl_xor(m2, 1)); m2 = fmaxf(m2, __shfl_xor(m2, 2)); m2 = fmaxf(m2, __shfl_xor(m2, 4));
      const float gs = m1 + m2;
      int grank = 0;
#pragma unroll
      for (int gg = 0; gg < 8; ++gg) { float o = __shfl(gs, gg * 8); grank += (o > gs || (o == gs && gg < grpi)) ? 1 : 0; }
      const bool gsel = grank < 4;
      const float mc = gsel ? c : -INFINITY;
      int rank = 0;
#pragma unroll
      for (int e = 0; e < 64; ++e) { float o = __shfl(mc, e); rank += (o > mc || (o == mc && e < lane)) ? 1 : 0; if ((e & 7) == 7) asm volatile("" : "+v"(rank)); }
      const bool sel = gsel && rank < 6;
      const float ssum = wave_sum(sel ? s : 0.f);
      if (sel) {
        const int slot = t * 6 + rank;
        WTS[slot] = s / ssum * 2.5f;
        const int pos = atomicAdd(&CNT[lane], 1);
        LIST[(size_t)lane * T + pos] = slot;
      }
    }
    __syncthreads();
  }
}
DEVI void st_outproj(const Params& p, int l, int vb, int nvb, char* smem) {
  const u16* Y = (const u16*)(p.ws + O_Y); const u16* W = (const u16*)(p.ws + O_WOUTT); float* XA = (float*)(p.ws + O_XA);
  const int tid = p.tid, lane = tid & 63, wid = tid >> 6, wr = wid >> 1, wc = wid & 1, fr = lane & 15, fq = lane >> 4;
  const int nmt = l == 0 ? 132 : 128;
  const int g = vb & 7, nmg = (nmt - g + 7) >> 3;
  for (int i = vb >> 3; i < nmg * 8; i += nvb >> 3) {
    const int m0 = (g + 8 * (i >> 3)) * 128, n0 = (i & 7) * 128;
    f32x4 acc[4][4];
    gemm_core<false>(tid, [&](int r) { return Y + (size_t)(m0 + r) * 1024; }, W + (size_t)n0 * LDW, LDW, 1024, acc, smem);
    const float* gbase = modp(p, l, tok_mv(m0), 2) + n0 + wc * 64 + fq * 4;
#pragma unroll
    for (int hf = 0; hf < 2; ++hf) {
      f32x4 xin[2][4], gt[4];
#pragma unroll
      for (int n = 0; n < 4; ++n) gt[n] = *(const f32x4*)(gbase + n * 16);
#pragma unroll
      for (int mm = 0; mm < 2; ++mm) {
        const int t = m0 + wr * 64 + (hf * 2 + mm) * 16 + fr;
        const float* src = l == 0 ? (t < TL ? pin(p, I_X) + (size_t)t * 1024 : pin(p, I_CTX) + (size_t)(t - TL) * 1024) : (const float*)(XA + (size_t)t * 1024);
#pragma unroll
        for (int n = 0; n < 4; ++n) xin[mm][n] = *(const f32x4*)(src + n0 + wc * 64 + n * 16 + fq * 4);
      }
#pragma unroll
      for (int mm = 0; mm < 2; ++mm) {
        const int t = m0 + wr * 64 + (hf * 2 + mm) * 16 + fr;
#pragma unroll
        for (int n = 0; n < 4; ++n) *(f32x4*)(XA + (size_t)t * 1024 + n0 + wc * 64 + n * 16 + fq * 4) = xin[mm][n] + gt[n] * acc[hf * 2 + mm][n];
      }
    }
  }
}

DEVI void grp_tiles(const Params& p, int* tst, int g, int shift, int nshared) {
  __syncthreads();
  if (p.tid < 64) {
    const int* CNT = (const int*)(p.ws + O_CNT);
    const int lane = p.tid;
    int c = 0;
    if (lane < 8) c = (__hip_atomic_load(&CNT[g + 8 * lane], __ATOMIC_RELAXED, __HIP_MEMORY_SCOPE_AGENT) + (1 << shift) - 1) >> shift;
    int incl = c;
#pragma unroll
    for (int o = 1; o < 8; o <<= 1) { int u = __shfl_up(incl, o); if (lane >= o) incl += u; }
    if (lane < 8) tst[lane] = incl - c;
    if (lane == 7) { tst[8] = incl; tst[9] = incl + (nshared - g + 7) / 8; }
  }
  __syncthreads();
}
DEVI void grp_find(const int* tst, int tile, int g, int& e, int& lt) {
  int j = 0;
#pragma unroll
  for (int k = 1; k <= 8; ++k) j += tile >= tst[k] ? 1 : 0;
  if (j < 8) { e = g + 8 * j; lt = tile - tst[j]; } else { e = 64; lt = g + 8 * (tile - tst[8]); }
}
DEVI void st_moe1(const Params& p, int l, int vb, int nvb, char* smem) {
  const int* CNT = (const int*)(p.ws + O_CNT); const int* LIST = (const int*)(p.ws + O_LIST);
  const u16* H = (const u16*)(p.ws + O_H); u16* HB = (u16*)(p.ws + O_HB);
  int* sslot = (int*)(smem + 4 * 128 * GLD * 2);
  int* TST = sslot + 128;
  const int g = vb & 7;
  const int nsh = l == 0 ? T : TL;
  grp_tiles(p, TST, g, 7, nsh / 128);
  const int total = TST[9];
  auto fetch_slot = [&](int item, int& e, int& n0) {
    const int tile = item >> 2; n0 = (item & 3) * 128;
    int lt; grp_find(TST, tile, g, e, lt);
    int slot = -1;
    if (p.tid < 128) {
      const int cnt = e < 64 ? __hip_atomic_load(&CNT[e], __ATOMIC_RELAXED, __HIP_MEMORY_SCOPE_AGENT) : nsh;
      const int i = lt * 128 + p.tid;
      if (i < cnt) slot = e < 64 ? LIST[(size_t)e * T + i] : NSLOT + i;
    }
    return slot;
  };
  int e = 0, n0 = 0, e_nx = 0, n0_nx = 0;
  int slot_nx = (vb >> 3) < total * 4 ? fetch_slot(vb >> 3, e_nx, n0_nx) : -1;
  for (int item = vb >> 3; item < total * 4; item += nvb >> 3) {
    e = e_nx; n0 = n0_nx;
    __syncthreads();
    if (p.tid < 128) sslot[p.tid] = slot_nx;
    __syncthreads();
    if (item + (nvb >> 3) < total * 4) slot_nx = fetch_slot(item + (nvb >> 3), e_nx, n0_nx);
    f32x4 acc[4][4];
    gemm_core<false, 2>(p.tid, [&](int r) { int sl = sslot[r]; int tk = sl < 0 ? 0 : (sl < NSLOT ? sl / 6 : sl - NSLOT); return H + (size_t)tk * LDH; },
                        (const u16*)(p.ws + O_WGUT) + ((size_t)e * 512 + n0) * LDW, LDW, 1024, acc, smem);
    {
      const int lane = p.tid & 63, wid = p.tid >> 6, wr = wid >> 1, wc = wid & 1, fr = lane & 15, fq = lane >> 4;
#pragma unroll
      for (int m = 0; m < 4; ++m) {
        const int sl = sslot[wr * 64 + m * 16 + fr];
        if (sl >= 0) {
          u32x4 pk;
#pragma unroll
          for (int n = 0; n < 4; ++n) pk[n] = pack2(siluf(acc[m][n][0]) * acc[m][n][1], siluf(acc[m][n][2]) * acc[m][n][3]);
          *(u32x4*)(HB + (size_t)sl * 256 + (n0 >> 1) + wc * 32 + fq * 8) = pk;
        }
      }
    }
  }
}
DEVI void st_moe2(const Params& p, int l, int vb, int nvb, char* smem) {
  const int* CNT = (const int*)(p.ws + O_CNT); const int* LIST = (const int*)(p.ws + O_LIST);
  const u16* HB = (const u16*)(p.ws + O_HB); const float* WTS = (const float*)(p.ws + O_WTS);
  unsigned char* SO8 = (unsigned char*)(p.ws + O_SLOT); float* SC = (float*)(p.ws + O_SLOTSC);
  constexpr int ALD = 264;
  u16* sA = (u16*)smem;
  u16* sB = sA + 64 * ALD;
  int* sslot = (int*)(sB + 2 * 128 * 72);
  int* TST = sslot + 64;
  const int tid = p.tid, lane = tid & 63, wid = tid >> 6, wr = wid >> 1, wc = wid & 1, fr = lane & 15, fq = lane >> 4;
  const int g = vb & 7;
  const int nsh = l == 0 ? T : TL;
  grp_tiles(p, TST, g, 6, nsh / 64);
  const int total = TST[9];
  for (int item = vb >> 3; item < total; item += nvb >> 3) {
    int e, lt; grp_find(TST, item, g, e, lt);
    const int cnt = e < 64 ? __hip_atomic_load(&CNT[e], __ATOMIC_RELAXED, __HIP_MEMORY_SCOPE_AGENT) : nsh;
    __syncthreads();
    if (tid < 64) { const int i = lt * 64 + tid; sslot[tid] = i < cnt ? (e < 64 ? LIST[(size_t)e * T + i] : NSLOT + i) : -1; }
    __syncthreads();
    const u16* Bbase = (const u16*)(p.ws + O_WDT) + (size_t)e * 1024 * 256;
    constexpr int NR = 5;
    u32x4 rb[NR][4];
    const u16* bthr = Bbase + (size_t)(tid >> 3) * 256 + (tid & 7) * 8;
    auto gloadB = [&](u32x4 (&rb)[4], int bt) {
      int off = (bt >> 2) * 128 * 256 + (bt & 3) * 64;
      asm volatile("" : "+s"(off));
      const u16* src = bthr + off;
#pragma unroll
      for (int i = 0; i < 4; ++i) rb[i] = *(const u32x4*)(src + i * 32 * 256);
    };
    auto lstoreB = [&](const u32x4 (&rb)[4], int buf) {
      u16* d = sB + buf * 128 * 72;
#pragma unroll
      for (int i = 0; i < 4; ++i) { const int q = tid + 256 * i, r = q >> 3, cc = q & 7; *(u32x4*)&d[r * 72 + cc * 8] = rb[i]; }
    };
#pragma unroll
    for (int t = 0; t < NR; ++t) gloadB(rb[t], t);
#pragma unroll
    for (int hf = 0; hf < 2; ++hf) {
      u32x4 ra[4];
#pragma unroll
      for (int i = 0; i < 4; ++i) { const int q = tid + 256 * (4 * hf + i), r = q >> 5, cc = q & 31; const int sl = sslot[r]; ra[i] = *(const u32x4*)(HB + (size_t)(sl < 0 ? 0 : sl) * 256 + cc * 8); }
#pragma unroll
      for (int i = 0; i < 4; ++i) { const int q = tid + 256 * (4 * hf + i), r = q >> 5, cc = q & 31; *(u32x4*)&sA[r * ALD + cc * 8] = ra[i]; }
      __builtin_amdgcn_sched_barrier(0);
    }
    int slot_m[2]; float w_m[2];
#pragma unroll
    for (int m = 0; m < 2; ++m) { const int sl = sslot[wr * 32 + m * 16 + fr]; slot_m[m] = sl; w_m[m] = (sl >= 0 && sl < NSLOT) ? WTS[sl] : 1.f; }
    lstoreB(rb[0], 0); gloadB(rb[0], NR);
    __syncthreads();
    f32x4 acc[2][4];
    auto compute = [&](int bt, int buf) {
      const int nt = bt >> 2, kt = bt & 3;
      const u16* b = sB + buf * 128 * 72;
      if (kt == 0) {
#pragma unroll
        for (int m = 0; m < 2; ++m)
#pragma unroll
          for (int n = 0; n < 4; ++n) acc[m][n] = fzero4();
      }
#pragma unroll
      for (int ks = 0; ks < 2; ++ks) {
        bf16x8 af[2], bfr[4];
#pragma unroll
        for (int m = 0; m < 2; ++m) af[m] = *(const bf16x8*)&sA[(wr * 32 + m * 16 + fr) * ALD + kt * 64 + ks * 32 + fq * 8];
#pragma unroll
        for (int n = 0; n < 4; ++n) bfr[n] = *(const bf16x8*)&b[(wc * 64 + (fr >> 2) * 16 + n * 4 + (fr & 3)) * 72 + ks * 32 + fq * 8];
#pragma unroll
        for (int m = 0; m < 2; ++m)
#pragma unroll
          for (int n = 0; n < 4; ++n) acc[m][n] = MFMA16(bfr[n], af[m], acc[m][n]);
      }
      if (kt == 3) {
#pragma unroll
        for (int m = 0; m < 2; ++m) {
          const float w = w_m[m];
          float amax = 0.f;
#pragma unroll
          for (int n = 0; n < 4; ++n) { acc[m][n] = acc[m][n] * w; amax = fmaxf(amax, fmaxf(fmaxf(fabsf(acc[m][n][0]), fabsf(acc[m][n][1])), fmaxf(fabsf(acc[m][n][2]), fabsf(acc[m][n][3])))); }
          { auto rr = __builtin_amdgcn_permlane16_swap(__float_as_uint(amax), __float_as_uint(amax), false, false);
            amax = fmaxf(__uint_as_float(rr[0]), __uint_as_float(rr[1])); }
          { auto rr = __builtin_amdgcn_permlane32_swap(__float_as_uint(amax), __float_as_uint(amax), false, false);
            amax = fmaxf(__uint_as_float(rr[0]), __uint_as_float(rr[1])); }
          const float inv = amax > 0.f ? __builtin_amdgcn_ldexpf(__builtin_amdgcn_rcpf(amax), 8) : 0.f;
          if (slot_m[m] >= 0) {
            u32x4 dd;
#pragma unroll
            for (int n = 0; n < 4; ++n) {
              int d = 0;
              d = __builtin_amdgcn_cvt_pk_fp8_f32(acc[m][n][0] * inv, acc[m][n][1] * inv, d, false);
              d = __builtin_amdgcn_cvt_pk_fp8_f32(acc[m][n][2] * inv, acc[m][n][3] * inv, d, true);
              dd[n] = (unsigned)d;
            }
            *(u32x4*)(SO8 + (size_t)slot_m[m] * 1024 + nt * 128 + wc * 64 + fq * 16) = dd;
            if (fq == 0) SC[(size_t)slot_m[m] * 16 + nt * 2 + wc] = __builtin_amdgcn_ldexpf(amax, -8);
          }
        }
      }
    };
#pragma unroll
    for (int bt = 0; bt < 32; ++bt) {
      compute(bt, bt & 1);
      if (bt + 1 < 32) lstoreB(rb[(bt + 1) % NR], (bt + 1) & 1);
      if (bt + 1 + NR < 32) gloadB(rb[(bt + 1) % NR], bt + 1 + NR);
      __syncthreads(); __builtin_amdgcn_sched_barrier(0);
    }
  }
}

DEVI void st_combine(const Params& p, int l, int vb, int nvb) {
  const int lane = p.tid & 63, wid = p.tid >> 6;
  const unsigned char* SO8 = (const unsigned char*)(p.ws + O_SLOT); const float* SC = (const float*)(p.ws + O_SLOTSC);
  const bool last = l == 1;
  const float* gnext = last ? pin(p, I_FNG) : pin(p, I_N1G) + 1024;
  const int tend = last ? TL : T;
  const int c0 = lane * 16;
  for (int t0 = (vb * 4 + wid) * 2; t0 < tend; t0 += nvb * 8) {
    const int mv = tok_mv(t0);
    const float* g5 = modp(p, l, mv, 5);
    u32x4 sv[2][7]; float sc[2][7]; f32x4 xv[2][4];
#pragma unroll
    for (int u = 0; u < 2; ++u) {
      const int t = t0 + u;
#pragma unroll
      for (int k = 0; k < 7; ++k) {
        const size_t ridx = (size_t)(k < 6 ? t * 6 + k : NSLOT + t);
        sv[u][k] = *(const u32x4*)(SO8 + ridx * 1024 + c0);
        sc[u][k] = SC[ridx * 16 + (lane >> 2)];
      }
      const float* xr = (const float*)(p.ws + O_XA) + (size_t)t * 1024 + c0;
#pragma unroll
      for (int q = 0; q < 4; ++q) xv[u][q] = *(const f32x4*)(xr + q * 4);
    }
    f32x4 gq[4];
#pragma unroll
    for (int q = 0; q < 4; ++q) gq[q] = *(const f32x4*)(g5 + c0 + q * 4);
    float ss[2];
#pragma unroll
    for (int u = 0; u < 2; ++u) {
      float acc = 0.f;
#pragma unroll
      for (int q = 0; q < 4; ++q) {
        f32x4 a0 = fzero4();
#pragma unroll
        for (int k = 0; k < 7; ++k) {
          const unsigned v = sv[u][k][q]; const float s = sc[u][k];
          const f32x2 p0 = __builtin_amdgcn_cvt_pk_f32_fp8((int)v, false), p1 = __builtin_amdgcn_cvt_pk_f32_fp8((int)v, true);
          a0[0] += s * p0[0]; a0[1] += s * p0[1]; a0[2] += s * p1[0]; a0[3] += s * p1[1];
        }
        xv[u][q] += gq[q] * a0;
#pragma unroll
        for (int e = 0; e < 4; ++e) acc += xv[u][q][e] * xv[u][q][e];
      }
      ss[u] = acc;
    }
#pragma unroll
    for (int o = 32; o >= 1; o >>= 1) { ss[0] += __shfl_xor(ss[0], o); ss[1] += __shfl_xor(ss[1], o); }
    f32x4 gn[4];
#pragma unroll
    for (int q = 0; q < 4; ++q) gn[q] = *(const f32x4*)(gnext + c0 + q * 4);
    if (!last) {
      const float* sh = modp(p, 1, mv, 0); const float* scl = modp(p, 1, mv, 1);
      f32x4 gs[4], h4[4];
#pragma unroll
      for (int q = 0; q < 4; ++q) { gs[q] = gn[q] * (1.f + *(const f32x4*)(scl + c0 + q * 4)); h4[q] = *(const f32x4*)(sh + c0 + q * 4); }
#pragma unroll
      for (int u = 0; u < 2; ++u) {
        const size_t t = t0 + u;
        const float rstd = rsqrtf(ss[u] * (1.f / 1024.f) + 1e-6f);
        u32x4 pk[2];
#pragma unroll
        for (int q = 0; q < 4; ++q) {
          *(f32x4*)((float*)(p.ws + O_XA) + t * 1024 + c0 + q * 4) = xv[u][q];
          const f32x4 o = xv[u][q] * rstd * gs[q] + h4[q];
          pk[q >> 1][(q & 1) * 2] = pack2(o[0], o[1]); pk[q >> 1][(q & 1) * 2 + 1] = pack2(o[2], o[3]);
        }
        u16* hrow = (u16*)(p.ws + O_H) + t * LDH + c0;
        *(u32x4*)hrow = pk[0]; *(u32x4*)(hrow + 8) = pk[1];
      }
    } else {
#pragma unroll
      for (int u = 0; u < 2; ++u) {
        const size_t t = t0 + u;
        const float rstd = rsqrtf(ss[u] * (1.f / 1024.f) + 1e-6f);
#pragma unroll
        for (int q = 0; q < 4; ++q) *(f32x4*)(p.out + t * 1024 + c0 + q * 4) = xv[u][q] * rstd * gn[q];
      }
    }
  }
}


#define STAGE(call) { const Params p = mkctx(a); call; }

#define XB_TMO      128
#define XB_XCNT(j)  (256  + 64 * (j))
#define XB_XSUB(j)  (1280 + 64 * (j))
#define XB_XGEN(j)  (2304 + 64 * (j))
#define XB_TOP      3328
#define XB_TOPGEN   3392
#define XCD_BAR_WORDS 3456
#define XB_SPIN_CAP (1u << 20)
#define LAS __attribute__((address_space(3)))
DEVI unsigned xb_ld(unsigned* p)              { return __hip_atomic_load(p, __ATOMIC_RELAXED, __HIP_MEMORY_SCOPE_AGENT); }
DEVI unsigned xb_add(unsigned* p, unsigned v) { return __hip_atomic_fetch_add(p, v, __ATOMIC_RELAXED, __HIP_MEMORY_SCOPE_AGENT); }
DEVI unsigned xb_xcc_id() { return (unsigned)__builtin_amdgcn_s_getreg((3 << 11) | 20) & 0xFu; }
#define XB_SPIN(cond, bar) do { unsigned _sp = 0; while (cond) { __builtin_amdgcn_s_sleep(1); \
    if ((++_sp & 255u) == 0u) { if (xb_ld(&(bar)[XB_TMO])) break; if (_sp > XB_SPIN_CAP) { atomicAdd(&(bar)[XB_TMO], 1u); break; } } } } while (0)
struct XcdBarrier { unsigned* bar; unsigned x; volatile LAS unsigned* st; };
DEVI XcdBarrier xcd_barrier_post(unsigned* bar, volatile LAS unsigned* st) {
  XcdBarrier b; b.bar = bar; b.x = xb_xcc_id(); b.st = st;
  if (threadIdx.x == 0) (void)xb_add(&bar[XB_XCNT(b.x)], 1u);
  return b;
}
DEVI void xcd_barrier_complete(unsigned* bar, unsigned x, unsigned& nloc, unsigned& nx) {
  const unsigned G = gridDim.x * gridDim.y * gridDim.z;
  unsigned sum, cnt, mine, sp = 0u;
  for (;;) {
    sum = 0u; cnt = 0u; mine = 0u;
#pragma unroll
    for (unsigned j = 0; j < 16; ++j) { const unsigned c = xb_ld(&bar[XB_XCNT(j)]); sum += c; cnt += (c > 0u) ? 1u : 0u; mine = (j == x) ? c : mine; }
    if (sum == G) break;
    __builtin_amdgcn_s_sleep(1);
    if ((++sp & 255u) == 0u) { if (xb_ld(&bar[XB_TMO])) break; if (sp > XB_SPIN_CAP) { atomicAdd(&bar[XB_TMO], 1u); break; } }
  }
  nloc = mine > 0u ? mine : 1u; nx = cnt > 0u ? cnt : 1u;
}
DEVI void xcd_barrier(const XcdBarrier& b) {
  asm volatile("s_waitcnt vmcnt(0)" ::: "memory");
  __syncthreads();
  if (threadIdx.x == 0) {
    unsigned* bar = b.bar;
    __builtin_amdgcn_s_waitcnt(0);
    unsigned nloc = b.st[0], nx = b.st[1];
    if (nloc == 0u) { xcd_barrier_complete(bar, b.x, nloc, nx); b.st[0] = nloc; b.st[1] = nx; }
    const unsigned old = xb_add(&bar[XB_XSUB(b.x)], 1u);
    const unsigned gen = old / nloc;
    if (old + 1u == (gen + 1u) * nloc) {
      __builtin_amdgcn_fence(__ATOMIC_RELEASE, "agent");
      asm volatile("s_waitcnt vmcnt(0)" ::: "memory");
      const unsigned og = xb_add(&bar[XB_TOP], 1u);
      const unsigned tg = og / nx;
      if (og + 1u == (tg + 1u) * nx) xb_add(&bar[XB_TOPGEN], 1u);
      else XB_SPIN(xb_ld(&bar[XB_TOPGEN]) == tg, bar);
      __builtin_amdgcn_fence(__ATOMIC_ACQUIRE, "agent");
      xb_add(&bar[XB_XGEN(b.x)], 1u);
      asm volatile("s_waitcnt vmcnt(0)" ::: "memory");
    } else {
      XB_SPIN(xb_ld(&bar[XB_XGEN(b.x)]) == gen, bar);
      __builtin_amdgcn_fence(__ATOMIC_ACQUIRE, "agent");
      asm volatile("s_waitcnt vmcnt(0)" ::: "memory");
    }
  }
  __syncthreads();
}
#define GSYNC() { XcdBarrier xb_; xb_.bar = (unsigned*)(mkctx(a).ws + O_XBAR); xb_.x = xb_xcc_id(); xb_.st = (volatile LAS unsigned*)(smem + SMEM_BYTES - 32); xcd_barrier(xb_); }

__global__ void __launch_bounds__(256, 2) mega(KArgs a) {
  extern __shared__ __attribute__((aligned(16))) char smem[];
  cg::grid_group grid = cg::this_grid();
  const int vb = blockIdx.x, nvb = gridDim.x;
  volatile LAS unsigned* xst = (volatile LAS unsigned*)(smem + SMEM_BYTES - 32);
  if (threadIdx.x == 0) { xst[0] = 0u; xst[1] = 0u; }
  __syncthreads();
  (void)xcd_barrier_post((unsigned*)(a.ws + O_XBAR), xst);
  if (threadIdx.x == 0) {
    const float** tab = (const float**)(a.ws + O_TAB);
#pragma unroll
    for (int i = 0; i < 35; ++i) tab[i] = a.in[i];
  }
  __syncthreads();
  STAGE(st_rope_table(p, vb, nvb));
  STAGE(st_mod(p, vb, nvb, smem));
  STAGE(st_prep_w1(p, 0, vb, nvb, smem));
  if (a.ws == nullptr) grid.sync();
  GSYNC();
  for (int l = 0; l < 2; ++l) {
    if (l == 0) { STAGE(st_norm1(p, 0, vb, nvb)); GSYNC(); }
    {
      const int g = vb & 7;
      for (int i = vb >> 3; i < 363; i += nvb >> 3) {
        int mt, nt;
        if (i < 264) { mt = i >> 1; nt = g + 8 * (i & 1); }
        else { const int j = i - 264, pc = g + 8 * (j / 33); nt = 16 + (pc >> 2); mt = (pc & 3) * 33 + (j % 33); }
        const Params p = mkctx(a); inproj_item(p, mt * 22 + nt, smem);
      }
    }
    GSYNC();
    STAGE(st_tokprep(p, l, vb, nvb));
    GSYNC();
    {
      for (int item = vb; item < 132 * 7 + NGITEM; item += nvb) {
        const Params p = mkctx(a);
        if (item < 132 * 7) mla_up_tile(p, item / 7, item % 7, smem);
        else gdn_chunk_item(p, item - 132 * 7, smem);
      }
    }
    GSYNC();
    st_mixer_queue(a, l, smem);
    GSYNC();
    STAGE(st_mix_finish(p, l, vb, nvb));
    GSYNC();
    STAGE(st_outproj(p, l, vb, nvb, smem));
    GSYNC();
    STAGE(st_norm2_route(p, l, vb, nvb, smem));
    GSYNC();
    STAGE(st_moe1(p, l, vb, nvb, smem));
    GSYNC();
    STAGE(st_moe2(p, l, vb, nvb, smem));
    GSYNC();
    if (l == 0) STAGE(st_prep_w1(p, 1, vb, nvb, smem));
    STAGE(st_combine(p, l, vb, nvb));
    if (l == 0) GSYNC();
  }
}

extern "C" void kernel_launch(void* const* d_in, const int* in_sizes, int n_in, void* d_out, int out_size, void* d_ws, size_t ws_size,
                              hipStream_t stream) {
  static int grid_blocks = 0;
  if (!grid_blocks) {
    int dev = 0, cus = 0, per_cu = 0;
    (void)hipGetDevice(&dev);
    (void)hipDeviceGetAttribute(&cus, hipDeviceAttributeMultiprocessorCount, dev);
    (void)hipFuncSetAttribute((const void*)mega, hipFuncAttributeMaxDynamicSharedMemorySize, SMEM_BYTES);
    (void)hipOccupancyMaxActiveBlocksPerMultiprocessor(&per_cu, mega, 256, SMEM_BYTES);
    if (per_cu > 2) per_cu = 2;
    if (per_cu < 1) per_cu = 1;
    grid_blocks = cus * per_cu;
  }
  KArgs p{};
  for (int i = 0; i < 35; ++i) p.in[i] = (const float*)d_in[i];
  p.out = (float*)d_out; p.ws = (char*)d_ws;
  if (ws_size < WS_NEED) { fprintf(stderr, "workspace too small: %zu < %zu\n", ws_size, (size_t)WS_NEED); return; }
  (void)hipMemsetAsync((char*)d_ws + O_BAR, 0, 256 + 16384, stream);
  void* args[] = {&p};
  hipError_t e = hipLaunchCooperativeKernel((void*)mega, dim3(grid_blocks), dim3(256), args, SMEM_BYTES, stream);
  if (e != hipSuccess) fprintf(stderr, "cooperative launch failed: %s (grid %d)\n", hipGetErrorString(e), grid_blocks);
}
```
